# Optimizing an MI355X kernel written in HIP

```python
import functools
import jax, jax.numpy as jnp
from jax import lax
import numpy as np

D_MODEL = 1024
BATCH = 16
SEQ = 256
DEPTH = 1
DEC_BATCH = 2
DEC_SEQ = 2048
PAST_LEN = 512

GRID_W = 64
HEAD_DIM = 64
N_ATT_HEADS = 8
N_RWKV_HEADS = 8
ATT_WIDTH = N_ATT_HEADS * HEAD_DIM
RWKV_WIDTH = N_RWKV_HEADS * HEAD_DIM
MIX_WIDTH = ATT_WIDTH + RWKV_WIDTH
NA_ROWS = 8
NA_COLS = 16
N_DIRS = 2
DECAY_LORA = 64
AAA_LORA = 64
GATE_LORA = 128
SHIFT_WIDTH = 3
FFN_CONV_WIDTH = 3
D_FF = 2816
EPS = 1e-6
GN_EPS = 64e-5
ATT_SCALE = HEAD_DIM ** -0.5
RWKV_COLS = 3 * RWKV_WIDTH + N_DIRS * (DECAY_LORA + AAA_LORA) + GATE_LORA
IN_WIDTH = 3 * ATT_WIDTH + RWKV_COLS

kernel_name = 'hymba_natten_rwkv7_dit_step'


def _rmsnorm(x, g):
    xf = x.astype(jnp.float32)
    y = xf * lax.rsqrt(jnp.mean(xf * xf, axis=-1, keepdims=True) + EPS)
    return (y * g.astype(jnp.float32)).astype(x.dtype)


def _dwconv(x, w):
    K = w.shape[0]
    pad = K // 2
    T = x.shape[1]
    xp = jnp.pad(x, ((0, 0), (pad, pad), (0, 0)))
    return sum(xp[:, j:j + T] * w[j] for j in range(K))


def _modulation(cond, w_ada, b_ada):
    m = jax.nn.silu(cond) @ w_ada + b_ada
    return jnp.split(m[..., None, :], 6, axis=-1)


def _heads(x, n):
    return x.reshape(x.shape[:-1] + (n, HEAD_DIM))


def _context_attention(q, k, v):
    B, L = q.shape[:2]
    s = jnp.einsum('bqhd,bkhd->bhqk', q, k).astype(jnp.float32) * ATT_SCALE
    p = jax.nn.softmax(s, axis=-1).astype(v.dtype)
    return jnp.einsum('bhqk,bkhd->bqhd', p, v).reshape(B, L, ATT_WIDTH)


def _neighbourhood_attention(q, k, v, k_ctx, v_ctx, rpb):
    B, T, H, Dh = q.shape
    R = T // GRID_W
    KH = min(NA_ROWS, R)
    KW = NA_COLS
    qg = q.reshape(B, R, GRID_W, H, Dh)
    kg = k.reshape(B, R, GRID_W, H, Dh)
    vg = v.reshape(B, R, GRID_W, H, Dh)
    k_ctx = k_ctx.astype(q.dtype)
    v_ctx = v_ctx.astype(v.dtype)
    cols = jnp.arange(GRID_W)
    col_start = jnp.clip(cols - KW // 2, 0, GRID_W - KW)
    col_idx = col_start[:, None] + jnp.arange(KW)[None, :]
    col_off = col_idx - cols[:, None] + (NA_COLS - 1)
    rpb_cols = rpb[:, :, col_off].astype(jnp.float32)

    def row_block(i):
        si = jnp.clip(i - KH // 2, 0, R - KH)
        q_i = lax.dynamic_index_in_dim(qg, i, axis=1, keepdims=False)
        k_win = lax.dynamic_slice_in_dim(kg, si, KH, axis=1)[:, :, col_idx]
        v_win = lax.dynamic_slice_in_dim(vg, si, KH, axis=1)[:, :, col_idx]
        row_off = si + jnp.arange(KH) - i + (NA_ROWS - 1)
        bias = jnp.take(rpb_cols, row_off, axis=1)
        s_loc = (jnp.einsum('bwhd,bawkhd->bhwak', q_i, k_win).astype(jnp.float32) * ATT_SCALE
                 + jnp.transpose(bias, (0, 2, 1, 3))[None])
        s_loc = s_loc.reshape(B, H, GRID_W, KH * KW)
        s_ctx = jnp.einsum('bwhd,blhd->bhwl', q_i, k_ctx).astype(jnp.float32) * ATT_SCALE
        p = jax.nn.softmax(jnp.concatenate([s_loc, s_ctx], axis=-1), axis=-1).astype(v.dtype)
        p_loc = p[..., :KH * KW].reshape(B, H, GRID_W, KH, KW)
        p_ctx = p[..., KH * KW:]
        return (jnp.einsum('bhwak,bawkhd->bwhd', p_loc, v_win)
                + jnp.einsum('bhwl,blhd->bwhd', p_ctx, v_ctx))

    o = lax.map(row_block, jnp.arange(R))
    return jnp.moveaxis(o, 0, 1).reshape(B, T, H * Dh)


def _wkv_scan(S0, r, decay, kk, kka, v, k, reverse):
    def step(S, inp):
        r_t, w_t, kk_t, b_t, v_t, k_t = inp
        sa = jnp.einsum('bhvk,bhk->bhv', S, kk_t)
        S = S * w_t[:, :, None, :] - sa[..., None] * b_t[:, :, None, :] + v_t[..., None] * k_t[:, :, None, :]
        return S, jnp.einsum('bhvk,bhk->bhv', S, r_t)
    return lax.scan(step, S0, (r, decay, kk, kka, v, k), reverse=reverse)


def _rwkv_mix(u, S0, w0, w2, a0, a2, g2, k_k, k_a, r_k, ln_g, ln_b):
    f32 = jnp.float32
    u = u.astype(f32)
    B, T, _ = u.shape
    H = N_RWKV_HEADS
    r = u[..., :RWKV_WIDTH]
    kr = u[..., RWKV_WIDTH:2 * RWKV_WIDTH]
    v = u[..., 2 * RWKV_WIDTH:3 * RWKV_WIDTH]
    o = 3 * RWKV_WIDTH
    xw = u[..., o:o + N_DIRS * DECAY_LORA].reshape(B, T, N_DIRS, DECAY_LORA)
    o += N_DIRS * DECAY_LORA
    xa = u[..., o:o + N_DIRS * AAA_LORA].reshape(B, T, N_DIRS, AAA_LORA)
    o += N_DIRS * AAA_LORA
    xg = u[..., o:o + GATE_LORA]
    w_log = -jax.nn.softplus(-(w0.astype(f32) + jnp.einsum('btnl,nlc->btnc', jnp.tanh(xw), w2.astype(f32)))) - 0.5
    decay = jnp.exp(-jnp.exp(w_log))
    a = jax.nn.sigmoid(a0.astype(f32) + jnp.einsum('btnl,nlc->btnc', xa, a2.astype(f32)))
    g = jax.nn.sigmoid(xg) @ g2.astype(f32)
    kk = _heads(kr * k_k.astype(f32), H)
    kk = kk * lax.rsqrt(jnp.sum(kk * kk, axis=-1, keepdims=True) + 1e-12)
    kd = kr[:, :, None] * (1.0 + (a - 1.0) * k_a.astype(f32))
    r_h = _heads(r, H)
    v_h = _heads(v, H)
    decay_h = _heads(decay, H)
    a_h = _heads(a, H)
    kd_h = _heads(kd, H)
    tm = lambda t: jnp.moveaxis(t, 1, 0)
    S_f, y_f = _wkv_scan(S0[:, 0].astype(f32), tm(r_h), tm(decay_h[:, :, 0]), tm(kk),
                         tm(kk * a_h[:, :, 0]), tm(v_h), tm(kd_h[:, :, 0]), reverse=False)
    S_b, y_b = _wkv_scan(S0[:, 1].astype(f32), tm(r_h), tm(decay_h[:, :, 1]), tm(kk),
                         tm(kk * a_h[:, :, 1]), tm(v_h), tm(kd_h[:, :, 1]), reverse=True)
    y = jnp.moveaxis(y_f + y_b, 0, 1)
    mu = jnp.mean(y, axis=-1, keepdims=True)
    var = jnp.mean(jnp.square(y - mu), axis=-1, keepdims=True)
    y = ((y - mu) * lax.rsqrt(var + GN_EPS)).reshape(B, T, RWKV_WIDTH) * ln_g.astype(f32) + ln_b.astype(f32)
    bonus = jnp.sum(jnp.sum(r_h[:, :, None] * kd_h * r_k.astype(f32), axis=-1, keepdims=True) * v_h[:, :, None], axis=2)
    out = (y + bonus.reshape(B, T, RWKV_WIDTH)) * g
    return out, jnp.stack([S_f, S_b], axis=1)


def _conv_ffn(h, w1, w3, wc, w2):
    return (jax.nn.silu(_dwconv(h @ w1, wc)) * (h @ w3)) @ w2


def _layer(x, mod, attend, S0, w_in, w_ts, rp, w_out, norm1, norm2, fp):
    sh1, sc1, g1, sh2, sc2, g2 = mod
    h = _rmsnorm(x, norm1) * (1 + sc1) + sh1
    z = h @ w_in
    q = _heads(z[..., :ATT_WIDTH], N_ATT_HEADS)
    k = _heads(z[..., ATT_WIDTH:2 * ATT_WIDTH], N_ATT_HEADS)
    v = _heads(z[..., 2 * ATT_WIDTH:3 * ATT_WIDTH], N_ATT_HEADS)
    a_out = attend(q, k, v)
    u = _dwconv(z[..., 3 * ATT_WIDTH:], w_ts)
    r_out, S = _rwkv_mix(u, S0, *rp)
    x = x + g1 * (jnp.concatenate([a_out, r_out.astype(x.dtype)], axis=-1) @ w_out)
    h2 = _rmsnorm(x, norm2) * (1 + sc2) + sh2
    x = x + g2 * _conv_ffn(h2, *fp)
    return x, k, v, S


def setup_inputs(seed: int = 0) -> dict:
    key = jax.random.key(seed)
    ks = jax.random.split(key, 32)
    n = lambda i, shape, s: jax.random.normal(ks[i], shape, jnp.float32) * s
    D = D_MODEL
    return {
        'x_prompt': n(0, (BATCH, SEQ, D), 1.0),
        'x_sample': n(1, (DEC_BATCH, DEC_SEQ, D), 1.0),
        'cache_k': n(2, (DEC_BATCH, DEPTH, PAST_LEN, N_ATT_HEADS, HEAD_DIM), 1.0),
        'cache_v': n(3, (DEC_BATCH, DEPTH, PAST_LEN, N_ATT_HEADS, HEAD_DIM), 1.0),
        'state_rwkv': n(4, (DEC_BATCH, DEPTH, N_DIRS, N_RWKV_HEADS, HEAD_DIM, HEAD_DIM), 0.3),
        'c': n(5, (DEC_BATCH, D), 1.0),
        'c_ctx': n(6, (D,), 1.0),
        'w_ada': n(7, (DEPTH, D, 6 * D), 0.5 * D ** -0.5),
        'b_ada': n(8, (DEPTH, 6 * D), 0.02),
        'norm1': 1.0 + n(9, (DEPTH, D), 0.05),
        'norm2': 1.0 + n(10, (DEPTH, D), 0.05),
        'w_in': n(11, (DEPTH, D, IN_WIDTH), D ** -0.5),
        'w_ts': n(12, (DEPTH, SHIFT_WIDTH, RWKV_COLS), SHIFT_WIDTH ** -0.5),
        'w0': n(13, (DEPTH, N_DIRS, RWKV_WIDTH), 0.5),
        'w2': n(14, (DEPTH, N_DIRS, DECAY_LORA, RWKV_WIDTH), 0.5 * DECAY_LORA ** -0.5),
        'a0': n(15, (DEPTH, N_DIRS, RWKV_WIDTH), 0.5),
        'a2': n(16, (DEPTH, N_DIRS, AAA_LORA, RWKV_WIDTH), AAA_LORA ** -0.5),
        'g2': n(17, (DEPTH, GATE_LORA, RWKV_WIDTH), GATE_LORA ** -0.5),
        'k_k': 0.85 + n(18, (DEPTH, RWKV_WIDTH), 0.05),
        'k_a': 1.0 + n(19, (DEPTH, RWKV_WIDTH), 0.05),
        'r_k': n(20, (DEPTH, N_RWKV_HEADS, HEAD_DIM), 0.1),
        'ln_x_g': 1.0 + n(21, (DEPTH, RWKV_WIDTH), 0.05),
        'ln_x_b': n(22, (DEPTH, RWKV_WIDTH), 0.02),
        'rpb': n(23, (DEPTH, N_ATT_HEADS, 2 * NA_ROWS - 1, 2 * NA_COLS - 1), 0.1),
        'w_out': n(24, (DEPTH, MIX_WIDTH, D), MIX_WIDTH ** -0.5),
        'w_ffn1': n(25, (DEPTH, D, D_FF), D ** -0.5),
        'w_ffn3': n(26, (DEPTH, D, D_FF), D ** -0.5),
        'w_ffn_conv': n(27, (DEPTH, FFN_CONV_WIDTH, D_FF), FFN_CONV_WIDTH ** -0.5),
        'w_ffn2': n(28, (DEPTH, D_FF, D), D_FF ** -0.5),
        'norm_f': 1.0 + n(29, (D,), 0.05),
    }


def reference(x_prompt, x_sample, cache_k, cache_v, state_rwkv, c, c_ctx, w_ada, b_ada, norm1, norm2,
              w_in, w_ts, w0, w2, a0, a2, g2, k_k, k_a, r_k, ln_x_g, ln_x_b, rpb, w_out,
              w_ffn1, w_ffn3, w_ffn_conv, w_ffn2, norm_f):
    xp = x_prompt
    xs = x_sample
    new_k, new_v, new_s = [], [], []
    zero_state = jnp.zeros((xp.shape[0], N_DIRS, N_RWKV_HEADS, HEAD_DIM, HEAD_DIM), jnp.float32)
    for l in range(DEPTH):
        rp = (w0[l], w2[l], a0[l], a2[l], g2[l], k_k[l], k_a[l], r_k[l], ln_x_g[l], ln_x_b[l])
        fp = (w_ffn1[l], w_ffn3[l], w_ffn_conv[l], w_ffn2[l])
        mod_ctx = _modulation(c_ctx[None, :], w_ada[l], b_ada[l])
        xp, kc, vc, sc = _layer(xp, mod_ctx, _context_attention, zero_state, w_in[l], w_ts[l], rp,
                                w_out[l], norm1[l], norm2[l], fp)
        new_k.append(kc)
        new_v.append(vc)
        new_s.append(sc)
        mod_lat = _modulation(c, w_ada[l], b_ada[l])
        attend = functools.partial(_neighbourhood_attention, k_ctx=cache_k[:, l], v_ctx=cache_v[:, l], rpb=rpb[l])
        xs, _, _, _ = _layer(xs, mod_lat, attend, state_rwkv[:, l], w_in[l], w_ts[l], rp,
                             w_out[l], norm1[l], norm2[l], fp)
    y_prompt = _rmsnorm(xp, norm_f)
    y_sample = _rmsnorm(xs, norm_f)
    new_cache_k = jnp.stack(new_k, axis=1)
    new_cache_v = jnp.stack(new_v, axis=1)
    new_state_rwkv = jnp.stack(new_s, axis=1)
    return (y_prompt, y_sample, new_cache_k, new_cache_v, new_state_rwkv)
```

```cpp
#include <hip/hip_runtime.h>
#include <hip/hip_cooperative_groups.h>
#include <cstdio>
#include <cstdint>
namespace cg = cooperative_groups;

#define LAS __attribute__((address_space(3)))
typedef unsigned short bf16_t;
typedef short bf16x8 __attribute__((ext_vector_type(8)));
typedef short s16x4 __attribute__((ext_vector_type(4)));
typedef float f32x2 __attribute__((ext_vector_type(2)));
typedef float f32x4 __attribute__((ext_vector_type(4)));
typedef float f32x16 __attribute__((ext_vector_type(16)));
typedef unsigned u32x2 __attribute__((ext_vector_type(2)));
typedef unsigned u32x4 __attribute__((ext_vector_type(4)));
typedef __bf16 bf16x2_t __attribute__((ext_vector_type(2)));
#define DI __device__ __forceinline__

constexpr int D = 1024, NTOK = 8192, NCTX = 4096, SEQ = 256, DSEQ = 2048;
constexpr int NIN = 3456, NINP = 3584, RC = 1920, DFF = 2816;
constexpr float EPS = 1e-6f, GN_EPS = 64e-5f;
constexpr float LOG2E = 1.4426950408889634f;
constexpr size_t MiB = 1u << 20;
constexpr size_t WS_BAR = 128 * 1024, WS_MOD = 0, WS_WTIN = 1 * MiB, WS_WTOUT = 8 * MiB, WS_WT13 = 10 * MiB, WS_WT2 = 21 * MiB, WS_WTLORA = 27 * MiB,
                 WS_H = 28 * MiB, WS_Q = 44 * MiB, WS_K = 52 * MiB, WS_V = 60 * MiB, WS_R = 68 * MiB, WS_VV = 84 * MiB, WS_KK = 100 * MiB,
                 WS_KR = 116 * MiB, WS_ALORA = 132 * MiB, WS_MIX = 138 * MiB, WS_ZR = 154 * MiB, WS_DEC = 154 * MiB, WS_AA = 186 * MiB,
                 WS_G = 218 * MiB, WS_CK = 234 * MiB, WS_CV = 235 * MiB, WS_Y = 28 * MiB, WS_PART = 176 * MiB, WS_A1 = 44 * MiB,
                 WS_A3 = 88 * MiB, WS_ACT = 132 * MiB, WS_EDGE = 250 * MiB;
constexpr size_t OUT_K = (size_t)NTOK * D, OUT_V = OUT_K + (size_t)NCTX * 512, OUT_S = OUT_V + (size_t)NCTX * 512;
constexpr int LDS_BYTES = 135168;

struct Params { const float* in[30]; float* out; unsigned char* ws; };
typedef const __attribute__((address_space(4))) Params* KP;

DI unsigned pk2(float lo, float hi) { f32x2 v = {lo, hi}; bf16x2_t b = __builtin_convertvector(v, bf16x2_t); return __builtin_bit_cast(unsigned, b); }
DI f32x4 unpk4(u32x2 w) { return (f32x4){__builtin_bit_cast(float, w.x << 16), __builtin_bit_cast(float, w.x & 0xffff0000u), __builtin_bit_cast(float, w.y << 16), __builtin_bit_cast(float, w.y & 0xffff0000u)}; }
DI f32x2 ldh2(const bf16_t* p) { const unsigned w = *(const unsigned*)p; return (f32x2){__builtin_bit_cast(float, w << 16), __builtin_bit_cast(float, w & 0xffff0000u)}; }
DI float bf2f(unsigned short u) { return __builtin_bit_cast(float, (unsigned)u << 16); }
DI float wave_sum(float v) {
#pragma unroll
    for (int o = 1; o < 64; o <<= 1) v += __shfl_xor(v, o);
    return v;
}
DI float sigmoid_f(float x) { return __builtin_amdgcn_rcpf(1.f + __builtin_amdgcn_exp2f(-1.4426950408889634f * x)); }
DI float silu_f(float x) { return x * sigmoid_f(x); }
DI float tanh_f(float x) { return 2.f * sigmoid_f(2.f * x) - 1.f; }
DI int midx_of(int r) { return r < NCTX ? 0 : 1 + ((r - NCTX) >> 11); }
DI const float* xrow_of(KP p, int r) { return r < NCTX ? p->in[0] + (size_t)r * D : p->in[1] + (size_t)(r - NCTX) * D; }

namespace pg8 {
constexpr int BM = 256, BK = 64, HALF = 128, HTB = HALF * BK * 2, NXCD = 8, WGM = 8;
__host__ __device__ __forceinline__ int lds_byte(int r, int c) { const int st = (r >> 4) * 2 + (c >> 5), rr = r & 15, cc = c & 31, ob = rr * 64 + cc * 2; return st * 1024 + (ob ^ (((ob >> 9) & 1) << 5)); }
__host__ __device__ __forceinline__ void stage_rc(int b, int& R, int& C) { const int st = b / 1024, sb = b % 1024, swz = sb ^ (((sb >> 9) & 1) << 5); R = (st >> 1) * 16 + swz / 64; C = (st & 1) * 32 + (swz % 64) / 2; }
__host__ __device__ __forceinline__ int perm32(int rho) { const int n = rho >> 4, i = rho & 15; return 8 * (i >> 2) + 4 * n + (i & 3); }
struct Unit { int pm, pn; int aoff, boff; };
struct Gemm { const bf16_t* A; const bf16_t* Bt; int K, lda, ldb; };
struct StaticOrder {
    int nM, nN, nwg, G, c;
    __device__ void init(int nM_, int nN_, int G_, int c_) { nM = nM_; nN = nN_; nwg = nM * nN; G = G_; c = c_; }
    __device__ bool next2(int i, int& pm, int& pn) const {
        const long L = (long)i * G + c; if (L >= nwg) return false;
        int wgid = (int)L; { const int q = nwg / NXCD, r = nwg % NXCD, xcd = wgid % NXCD, off = wgid / NXCD; wgid = (xcd < r ? xcd * (q + 1) : r * (q + 1) + (xcd - r) * q) + off; }
        const int nig = WGM * nN, gid = wgid / nig, fm = gid * WGM, gsz = (nM - fm) < WGM ? (nM - fm) : WGM;
        pm = fm + ((wgid % nig) % gsz); pn = (wgid % nig) / gsz; return true;
    }
};
struct SchedPlain { StaticOrder o; __device__ bool next(int i, Unit& u) const { u.aoff = 0; u.boff = 0; return o.next2(i, u.pm, u.pn); } };
struct SchedSplit2 { StaticOrder o; int nN, ksplit;
    __device__ bool next(int i, Unit& u) const { int pn2; if (!o.next2(i, u.pm, pn2)) return false; const int ks = pn2 / nN; u.pn = pn2 - ks * nN; u.aoff = ks * ksplit; u.boff = ks * ksplit; return true; } };
struct SchedLora { int G, c;
    __device__ bool next(int i, Unit& u) const { const int L = i * G + c; if (L >= 320) return false; u.pm = L & 31; u.pn = L >> 5; const int g = u.pn < 4 ? 0 : (u.pn < 8 ? 1 : 2); u.aoff = g * NTOK * 128; u.boff = 0; return true; } };

template <class Epi, class Sched>
__device__ __forceinline__ void gemm_phase(LAS unsigned char* lds, const Gemm g, const Sched& S, const Epi& E, int tid) {
    asm volatile("" : "+v"(tid));
    const int wid = __builtin_amdgcn_readfirstlane(tid >> 6), lane = tid & 63, wr = wid >> 2, wc = wid & 3, fr = lane & 15, fq = lane >> 4;
    const int nt = g.K / BK;
    unsigned voffA[2], voffB[2];
#pragma unroll
    for (int i = 0; i < 2; ++i) { int R, C; stage_rc(tid * 16 + i * 8192, R, C); const int Rb = (R & ~31) + perm32(R & 31);
        voffA[i] = (unsigned)(R * g.lda + C) * 2u; voffB[i] = (unsigned)(Rb * g.ldb + C) * 2u; }
    const size_t kstep = (size_t)(BK * 2);
    const size_t hA = (size_t)HALF * g.lda * 2, hB = (size_t)HALF * g.ldb * 2;
    const unsigned ldsw = (unsigned)wid * 1024u;
    const int aoff = lds_byte(wr * 64 + fr, fq * 8), boff = lds_byte(wc * 32 + fr, fq * 8);
#define PG8_SA(b, h) (((b) * 2 + (h)) * HTB)
#define PG8_SB(b, h) ((4 + (b) * 2 + (h)) * HTB)
#define PG8_STAGE(bufoff, gbase, voff) do { _Pragma("unroll") for (int _i = 0; _i < 2; ++_i) \
        __builtin_amdgcn_global_load_lds((const unsigned*)((const char*)(gbase) + (voff)[_i]), (LAS unsigned*)(lds + (bufoff) + ldsw + _i * 8192), 16, 0, 0); } while (0)
#define PG8_LDA(dst, b, h) do { _Pragma("unroll") for (int m = 0; m < 4; ++m) _Pragma("unroll") for (int k = 0; k < 2; ++k) dst[m][k] = *(const LAS bf16x8*)(lds + PG8_SA(b, h) + aoff + m * 2048 + k * 1024); } while (0)
#define PG8_LDB(dst, b, h) do { _Pragma("unroll") for (int n = 0; n < 2; ++n) _Pragma("unroll") for (int k = 0; k < 2; ++k) dst[n][k] = *(const LAS bf16x8*)(lds + PG8_SB(b, h) + boff + n * 2048 + k * 1024); } while (0)
#define PG8_MMA(ai, bj, At, Bt) do { __builtin_amdgcn_s_setprio(1); _Pragma("unroll") for (int m = 0; m < 4; ++m) _Pragma("unroll") for (int n = 0; n < 2; ++n) _Pragma("unroll") for (int k = 0; k < 2; ++k) \
        acc[ai][bj][m][n] = __builtin_amdgcn_mfma_f32_16x16x32_bf16(Bt[n][k], At[m][k], acc[ai][bj][m][n], 0, 0, 0); __builtin_amdgcn_s_setprio(0); } while (0)
#define PG8_WAIT_V(n) asm volatile("s_waitcnt vmcnt(" #n ")" ::: "memory")
#define PG8_WAIT_L(n) asm volatile("s_waitcnt lgkmcnt(" #n ")" ::: "memory")
#define PG8_BAR __builtin_amdgcn_s_barrier()
#define PG8_SCHED __builtin_amdgcn_sched_barrier(0)
#define PG8_TA(u) ((const char*)g.A + ((size_t)(u).pm * BM * g.lda + (size_t)(u).aoff) * 2)
#define PG8_TB(u) ((const char*)g.Bt + ((size_t)(u).pn * BM * g.ldb + (size_t)(u).boff) * 2)
    Unit cur, nxt; int ui = 0;
    if (!S.next(0, cur)) return;
    f32x4 acc[2][2][4][2];
#pragma unroll
    for (int a = 0; a < 2; ++a)
#pragma unroll
        for (int b = 0; b < 2; ++b)
#pragma unroll
            for (int m = 0; m < 4; ++m)
#pragma unroll
                for (int n = 0; n < 2; ++n) acc[a][b][m][n] = (f32x4){0.f, 0.f, 0.f, 0.f};
    bf16x8 At[4][2], B0[2][2], B1[2][2];
    const char* cA = PG8_TA(cur); const char* cB = PG8_TB(cur);
    PG8_STAGE(PG8_SB(0, 0), cB, voffB); PG8_STAGE(PG8_SB(0, 1), cB + hB, voffB); PG8_STAGE(PG8_SA(0, 0), cA, voffA); PG8_STAGE(PG8_SA(0, 1), cA + hA, voffA);
    if (wr == 1) PG8_BAR;
    PG8_WAIT_V(2); PG8_BAR;
    PG8_STAGE(PG8_SB(1, 0), cB + kstep, voffB); PG8_STAGE(PG8_SA(1, 0), cA + kstep, voffA); PG8_STAGE(PG8_SB(1, 1), cB + hB + kstep, voffB);
    PG8_WAIT_V(6); PG8_BAR;
    for (;;) {
        const bool has_next = S.next(ui + 1, nxt);
        const char* nA = has_next ? PG8_TA(nxt) : cA; const char* nB = has_next ? PG8_TB(nxt) : cB;
        for (int t = 0; t < nt; t += 2) {
            const bool last = (t == nt - 2);
            const char* a1 = cA + (size_t)(t + 1) * kstep;
            const char* a2 = last ? nA : cA + (size_t)(t + 2) * kstep; const char* b2 = last ? nB : cB + (size_t)(t + 2) * kstep;
            const char* a3 = a2 + kstep; const char* b3 = b2 + kstep;
            PG8_LDB(B0, 0, 0); PG8_LDB(B1, 0, 1); PG8_SCHED; PG8_LDA(At, 0, 0); PG8_STAGE(PG8_SA(1, 1), a1 + hA, voffA);
            PG8_WAIT_V(8); PG8_WAIT_L(0); PG8_BAR; PG8_MMA(0, 0, At, B0); PG8_MMA(0, 1, At, B1); PG8_BAR; PG8_SCHED;
            PG8_LDA(At, 0, 1); PG8_STAGE(PG8_SB(0, 0), b2, voffB); PG8_STAGE(PG8_SB(0, 1), b2 + hB, voffB); PG8_STAGE(PG8_SA(0, 0), a2, voffA);
            PG8_WAIT_V(8); PG8_WAIT_L(0); PG8_BAR; PG8_MMA(1, 0, At, B0); PG8_MMA(1, 1, At, B1); PG8_BAR; PG8_SCHED;
            PG8_LDB(B0, 1, 0); PG8_LDB(B1, 1, 1); PG8_SCHED; PG8_LDA(At, 1, 0); PG8_STAGE(PG8_SA(0, 1), a2 + hA, voffA);
            PG8_WAIT_V(8); PG8_WAIT_L(0); PG8_BAR; PG8_MMA(0, 0, At, B0); PG8_MMA(0, 1, At, B1); PG8_BAR; PG8_SCHED;
            PG8_LDA(At, 1, 1); PG8_STAGE(PG8_SB(1, 0), b3, voffB); PG8_STAGE(PG8_SB(1, 1), b3 + hB, voffB); PG8_STAGE(PG8_SA(1, 0), a3, voffA);
            PG8_WAIT_V(8); PG8_WAIT_L(0); PG8_BAR; PG8_MMA(1, 0, At, B0); PG8_MMA(1, 1, At, B1); PG8_BAR; PG8_SCHED;
        }
        E(acc, cur, wr, wc, fr, fq);
        if (!has_next) break;
#pragma unroll
        for (int a = 0; a < 2; ++a)
#pragma unroll
            for (int b = 0; b < 2; ++b)
#pragma unroll
                for (int m = 0; m < 4; ++m)
#pragma unroll
                    for (int n = 0; n < 2; ++n) acc[a][b][m][n] = (f32x4){0.f, 0.f, 0.f, 0.f};
        cur = nxt; cA = nA; cB = nB; ++ui;
    }
    PG8_WAIT_V(0);
    if (wr == 0) PG8_BAR;
    PG8_BAR;
#undef PG8_SA
#undef PG8_SB
#undef PG8_STAGE
#undef PG8_LDA
#undef PG8_LDB
#undef PG8_MMA
#undef PG8_WAIT_V
#undef PG8_WAIT_L
#undef PG8_BAR
#undef PG8_SCHED
#undef PG8_TA
#undef PG8_TB
}

struct EpiIn {
    bf16_t *Q; bf16_t* ZR; float* outK; float qscale;
    __device__ __forceinline__ void operator()(const f32x4 (&acc)[2][2][4][2], const Unit& u, int wr, int wc, int fr, int fq) const {
#pragma unroll
        for (int bj = 0; bj < 2; ++bj) {
            const int c0 = u.pn * BM + bj * HALF + wc * 32 + 8 * fq;
            if (c0 >= NIN) continue;
#pragma unroll
            for (int ai = 0; ai < 2; ++ai)
#pragma unroll
                for (int m = 0; m < 4; ++m) {
                    int r = u.pm * BM + ai * HALF + wr * 64 + m * 16 + fr; asm volatile("" : "+v"(r));
                    f32x4 v0 = acc[ai][bj][m][0], v1 = acc[ai][bj][m][1];
                    if (c0 < 1536) {
                        const int seg = c0 >> 9, cc = c0 & 511;
                        if (seg == 0) { v0 = v0 * qscale; v1 = v1 * qscale; }
                        else if (r < NCTX) { float* o = outK + (size_t)(seg - 1) * ((size_t)NCTX * 512) + (size_t)r * 512 + cc; *(f32x4*)o = v0; *(f32x4*)(o + 4) = v1; }
                        bf16_t* dst = Q + (size_t)seg * ((size_t)NTOK * 512) + (size_t)r * 512 + cc;
                        u32x4 w; w.x = pk2(v0[0], v0[1]); w.y = pk2(v0[2], v0[3]); w.z = pk2(v1[0], v1[1]); w.w = pk2(v1[2], v1[3]);
                        *(u32x4*)dst = w;
                    } else {
                        u32x4 w; w.x = pk2(v0[0], v0[1]); w.y = pk2(v0[2], v0[3]); w.z = pk2(v1[0], v1[1]); w.w = pk2(v1[2], v1[3]);
                        *(u32x4*)(ZR + (size_t)r * RC + (c0 - 1536)) = w;
                    }
                }
        }
    }
};
DI float decay1(float x) { return __expf(-0.60653065971f * sigmoid_f(x)); }
struct EpiLora {
    float *DEC, *AA, *G; const float *w0, *a0;
    __device__ __forceinline__ void operator()(const f32x4 (&acc)[2][2][4][2], const Unit& u, int wr, int wc, int fr, int fq) const {
#pragma unroll
        for (int bj = 0; bj < 2; ++bj) {
            const int c0 = u.pn * BM + bj * HALF + wc * 32 + 8 * fq;
            const int grp = c0 >> 10, cg = c0 & 1023, dir = cg >> 9, cc = cg & 511;
            const float* bp = (grp == 0 ? w0 : a0) + dir * 512 + cc;
            float* ob = DEC + (size_t)dir * NTOK * 512 + cc;
            bf16_t* obh = grp == 2 ? (bf16_t*)G + cc : (bf16_t*)AA + (size_t)dir * NTOK * 512 + cc;
#pragma unroll
            for (int ai = 0; ai < 2; ++ai)
#pragma unroll
                for (int m = 0; m < 4; ++m) {
                    int r = u.pm * BM + ai * HALF + wr * 64 + m * 16 + fr; asm volatile("" : "+v"(r));
                    f32x4 v0 = acc[ai][bj][m][0], v1 = acc[ai][bj][m][1];
                    if (grp < 2) { const float* bq = bp; asm volatile("" : "+v"(bq)); v0 += *(const f32x4*)bq; v1 += *(const f32x4*)(bq + 4); }
                    if (grp == 0) { v0.x = decay1(v0.x); v0.y = decay1(v0.y); v0.z = decay1(v0.z); v0.w = decay1(v0.w); v1.x = decay1(v1.x); v1.y = decay1(v1.y); v1.z = decay1(v1.z); v1.w = decay1(v1.w); }
                    else if (grp == 1) { v0.x = sigmoid_f(v0.x); v0.y = sigmoid_f(v0.y); v0.z = sigmoid_f(v0.z); v0.w = sigmoid_f(v0.w); v1.x = sigmoid_f(v1.x); v1.y = sigmoid_f(v1.y); v1.z = sigmoid_f(v1.z); v1.w = sigmoid_f(v1.w); }
                    if (grp == 0) { float* o = ob + (size_t)r * 512; *(f32x4*)o = v0; *(f32x4*)(o + 4) = v1; }
                    else { u32x4 w; w.x = pk2(v0[0], v0[1]); w.y = pk2(v0[2], v0[3]); w.z = pk2(v1[0], v1[1]); w.w = pk2(v1[2], v1[3]); *(u32x4*)(obh + (size_t)r * 512) = w; }
                }
        }
    }
};
struct EpiPart {
    bf16_t* P; int ksplit;
    __device__ __forceinline__ void operator()(const f32x4 (&acc)[2][2][4][2], const Unit& u, int wr, int wc, int fr, int fq) const {
        bf16_t* base = P + (u.aoff ? (size_t)NTOK * D : 0);
#pragma unroll
        for (int bj = 0; bj < 2; ++bj) {
            const int c0 = u.pn * BM + bj * HALF + wc * 32 + 8 * fq;
#pragma unroll
            for (int ai = 0; ai < 2; ++ai)
#pragma unroll
                for (int m = 0; m < 4; ++m) {
                    int r = u.pm * BM + ai * HALF + wr * 64 + m * 16 + fr; asm volatile("" : "+v"(r));
                    const f32x4 v0 = acc[ai][bj][m][0], v1 = acc[ai][bj][m][1];
                    u32x4 w; w.x = pk2(v0[0], v0[1]); w.y = pk2(v0[2], v0[3]); w.z = pk2(v1[0], v1[1]); w.w = pk2(v1[2], v1[3]);
                    *(u32x4*)(base + (size_t)r * D + c0) = w;
                }
        }
    }
};
template <int CTRL> DI float dppf(float x) { return __builtin_bit_cast(float, __builtin_amdgcn_mov_dpp(__builtin_bit_cast(int, x), CTRL, 0xf, 0xf, true)); }
struct EpiFfnAct {
    bf16_t* ACT; float* EDGE; const float* wcv; LAS unsigned char* ldsb;
    __device__ __forceinline__ void operator()(const f32x4 (&acc)[2][2][4][2], const Unit& u, int wr, int wc, int fr, int fq) const {
        LAS float* HL = (LAS float*)(ldsb + 131072);
        const int colh = wc * 32 + 8 * fq;
#pragma unroll
        for (int ai = 0; ai < 2; ++ai) { const int g = ai * 2 + wr;
            if (fr == 0) { *(LAS f32x4*)(HL + (g * 2 + 0) * 128 + colh) = acc[ai][0][0][0]; *(LAS f32x4*)(HL + (g * 2 + 0) * 128 + colh + 4) = acc[ai][0][0][1]; }
            if (fr == 15) { *(LAS f32x4*)(HL + (g * 2 + 1) * 128 + colh) = acc[ai][0][3][0]; *(LAS f32x4*)(HL + (g * 2 + 1) * 128 + colh + 4) = acc[ai][0][3][1]; } }
        asm volatile("s_waitcnt lgkmcnt(0)" ::: "memory");
        __builtin_amdgcn_s_barrier(); __builtin_amdgcn_s_barrier();
        asm volatile("" ::: "memory");
        const int cf = u.pn * HALF + colh;
        const f32x4 zero = {0.f, 0.f, 0.f, 0.f};
        const bool lat = u.pm >= 16;
#pragma unroll
        for (int ai = 0; ai < 2; ++ai) {
            const int g = ai * 2 + wr;
            f32x4 hp[2], hn[2];
            hp[0] = g > 0 ? *(const LAS f32x4*)(HL + ((g - 1) * 2 + 1) * 128 + colh) : zero; hp[1] = g > 0 ? *(const LAS f32x4*)(HL + ((g - 1) * 2 + 1) * 128 + colh + 4) : zero;
            hn[0] = g < 3 ? *(const LAS f32x4*)(HL + ((g + 1) * 2 + 0) * 128 + colh) : zero; hn[1] = g < 3 ? *(const LAS f32x4*)(HL + ((g + 1) * 2 + 0) * 128 + colh + 4) : zero;
#pragma unroll
            for (int m = 0; m < 4; ++m) {
                int r = u.pm * BM + ai * HALF + wr * 64 + m * 16 + fr; asm volatile("" : "+v"(r));
                const float* wq_ = wcv + cf; asm volatile("" : "+v"(wq_));
                f32x4 uu[2], av[2];
#pragma unroll
                for (int n = 0; n < 2; ++n) {
                    const f32x4 cur = acc[ai][0][m][n];
                    f32x4 pv, nx;
#pragma unroll
                    for (int j = 0; j < 4; ++j) {
                        if (m > 0) pv[j] = dppf<0x121>(fr == 15 ? acc[ai][0][m > 0 ? m - 1 : 0][n][j] : cur[j]);
                        else { const float a = dppf<0x121>(cur[j]); pv[j] = fr == 0 ? hp[n][j] : a; }
                        if (m < 3) nx[j] = dppf<0x12F>(fr == 0 ? acc[ai][0][m < 3 ? m + 1 : 3][n][j] : cur[j]);
                        else { const float c = dppf<0x12F>(cur[j]); nx[j] = fr == 15 ? hn[n][j] : c; }
                    }
                    const f32x4 w0 = *(const f32x4*)(wq_ + 4 * n), w1 = *(const f32x4*)(wq_ + DFF + 4 * n), w2 = *(const f32x4*)(wq_ + 2 * DFF + 4 * n);
                    uu[n] = pv * w0 + cur * w1 + nx * w2;
                    const f32x4 a3 = acc[ai][1][m][n];
                    av[n] = (f32x4){silu_f(uu[n].x) * a3.x, silu_f(uu[n].y) * a3.y, silu_f(uu[n].z) * a3.z, silu_f(uu[n].w) * a3.w};
                }
                u32x4 w; w.x = pk2(av[0][0], av[0][1]); w.y = pk2(av[0][2], av[0][3]); w.z = pk2(av[1][0], av[1][1]); w.w = pk2(av[1][2], av[1][3]);
                *(u32x4*)(ACT + (size_t)r * DFF + cf) = w;
                if (lat && ((ai == 0 && m == 0) || (ai == 1 && m == 3))) {
                    const int e = ai;
                    const bool mine = e == 0 ? (wr == 0 && fr == 0) : (wr == 1 && fr == 15);
                    if (mine) {
                        float* eb = EDGE + ((size_t)u.pm * 2 + e) * DFF + cf;
                        *(f32x4*)(eb) = acc[ai][0][m][0]; *(f32x4*)(eb + 4) = acc[ai][0][m][1];
                        *(f32x4*)(eb + 64 * DFF) = uu[0]; *(f32x4*)(eb + 64 * DFF + 4) = uu[1];
                        *(f32x4*)(eb + 128 * DFF) = acc[ai][1][m][0]; *(f32x4*)(eb + 128 * DFF + 4) = acc[ai][1][m][1];
                    }
                }
            }
        }
    }
};
}

template <int MODE>
DI void transpose_item(const float* W, int K, int N, bf16_t* WT, LAS float* scr, int item, int lane) {
    const int nblk = N / 32, kb = item / nblk, nb = item % nblk, k0 = 64 * kb, n0 = 32 * nb;
#pragma unroll 8
    for (int i = 0; i < 32; ++i) { const int kk = 2 * i + (lane >> 5); scr[kk * 33 + (lane & 31)] = W[(size_t)(k0 + kk) * N + n0 + (lane & 31)]; }
    asm volatile("s_waitcnt lgkmcnt(0)" ::: "memory");
    const int c = lane & 7;
#pragma unroll
    for (int j = 0; j < 4; ++j) { const int n = (lane >> 3) + 8 * j; const LAS float* s = scr + (8 * c) * 33 + n;
        u32x4 o; o.x = pk2(s[0 * 33], s[1 * 33]); o.y = pk2(s[2 * 33], s[3 * 33]); o.z = pk2(s[4 * 33], s[5 * 33]); o.w = pk2(s[6 * 33], s[7 * 33]);
        const int nn = n0 + n; const int drow = MODE == 0 ? nn : ((nn >> 7) * 256 + (nn & 127) + (MODE == 2 ? 128 : 0));
        *(u32x4*)(WT + (size_t)drow * K + k0 + 8 * c) = o; }
    asm volatile("s_waitcnt lgkmcnt(0)" ::: "memory");
}

DI void phase0(KP p, LAS unsigned char* lds, int gw, int NGW, int gtid, int NGT, int wave, int lane, bool defer_ffn) {
    unsigned char* ws = p->ws;
    {
        float* MOD = (float*)(ws + WS_MOD);
        const float* w_ada = p->in[7]; const float* b_ada = p->in[8]; const float* c_lat = p->in[5]; const float* c_ctx = p->in[6];
        LAS float* red = (LAS float*)(lds + 8 * 8448);
        const int tid = wave * 64 + lane, cgp = lane & 15, kr = lane >> 4;
        for (int nb = blockIdx.x; nb < 96; nb += gridDim.x) {
            f32x4 a0 = {0, 0, 0, 0}, a1 = a0, a2 = a0;
#pragma unroll 8
            for (int i = 0; i < 32; ++i) {
                const int k = wave * 128 + 4 * i + kr;
                const f32x4 w = *(const f32x4*)(w_ada + (size_t)k * 6144 + nb * 64 + 4 * cgp);
                a0 += w * silu_f(c_ctx[k]); a1 += w * silu_f(c_lat[k]); a2 += w * silu_f(c_lat[D + k]);
            }
#pragma unroll
            for (int j = 0; j < 4; ++j) {
                a0[j] += __shfl_xor(a0[j], 16); a0[j] += __shfl_xor(a0[j], 32);
                a1[j] += __shfl_xor(a1[j], 16); a1[j] += __shfl_xor(a1[j], 32);
                a2[j] += __shfl_xor(a2[j], 16); a2[j] += __shfl_xor(a2[j], 32);
            }
            if (kr == 0) { *(LAS f32x4*)(red + (wave * 3 + 0) * 64 + 4 * cgp) = a0; *(LAS f32x4*)(red + (wave * 3 + 1) * 64 + 4 * cgp) = a1; *(LAS f32x4*)(red + (wave * 3 + 2) * 64 + 4 * cgp) = a2; }
            __syncthreads();
            if (tid < 192) {
                const int i = tid >> 6, c = tid & 63; float s = b_ada[nb * 64 + c];
#pragma unroll
                for (int w = 0; w < 8; ++w) s += red[(w * 3 + i) * 64 + c];
                MOD[i * 6144 + nb * 64 + c] = s;
            }
            __syncthreads();
        }
    }
    {
        LAS float* scr = (LAS float*)(lds + wave * 8448);
        constexpr int I_IN = 16 * 108, I_OUT = 16 * 32, I_F = 16 * 88, I_2 = 44 * 32, NIT = I_IN + I_OUT + 2 * I_F + I_2;
        const int nit = defer_ffn ? I_IN + I_OUT : NIT;
        for (int it = gw; it < nit; it += NGW) {
            int r = it;
            if (r < I_IN) { transpose_item<0>(p->in[11], D, NIN, (bf16_t*)(ws + WS_WTIN), scr, r, lane); continue; } r -= I_IN;
            if (r < I_OUT) { transpose_item<0>(p->in[24], D, D, (bf16_t*)(ws + WS_WTOUT), scr, r, lane); continue; } r -= I_OUT;
            if (r < I_F) { transpose_item<1>(p->in[25], D, DFF, (bf16_t*)(ws + WS_WT13), scr, r, lane); continue; } r -= I_F;
            if (r < I_F) { transpose_item<2>(p->in[26], D, DFF, (bf16_t*)(ws + WS_WT13), scr, r, lane); continue; } r -= I_F;
            transpose_item<0>(p->in[28], DFF, D, (bf16_t*)(ws + WS_WT2), scr, r, lane);
        }
    }
    { u32x4* z = (u32x4*)((bf16_t*)(ws + WS_WTIN) + (size_t)NIN * D); for (int i = gtid; i < 128 * D / 8; i += NGT) z[i] = (u32x4){0, 0, 0, 0}; }
    {
        bf16_t* WL = (bf16_t*)(ws + WS_WTLORA); const float* w2 = p->in[14]; const float* a2 = p->in[16]; const float* g2 = p->in[17];
        for (int i = gtid; i < 2560 * 128; i += NGT) {
            const int n = i >> 7, k = i & 127; float v = 0.f;
            if (n < 2048) { const int grp = n >> 10, dir = (n >> 9) & 1, c = n & 511; const float* src = grp == 0 ? w2 : a2;
                if ((k >> 6) == dir) v = src[((size_t)dir * 64 + (k & 63)) * 512 + c]; }
            else v = g2[(size_t)k * 512 + (n - 2048)];
            WL[i] = (bf16_t)(pk2(v, 0.f) & 0xffffu);
        }
    }
    {
        const f32x4* ck = (const f32x4*)p->in[2]; const f32x4* cv = (const f32x4*)p->in[3]; u32x2* CK = (u32x2*)(ws + WS_CK); u32x2* CV = (u32x2*)(ws + WS_CV);
        for (int i = gtid; i < 1024 * 512 / 4; i += NGT) { const f32x4 a = ck[i], b = cv[i]; CK[i] = (u32x2){pk2(a[0], a[1]), pk2(a[2], a[3])}; CV[i] = (u32x2){pk2(b[0], b[1]), pk2(b[2], b[3])}; }
    }
}

DI void ffn_transposes(KP p, LAS unsigned char* lds, int which, int widx, int nw, int wave, int lane) {
    LAS float* scr = (LAS float*)(lds + wave * 8448);
    constexpr int I_F = 16 * 88, I_2 = 44 * 32;
    if (which == 0) { for (int it = widx; it < I_2; it += nw) transpose_item<0>(p->in[28], DFF, D, (bf16_t*)(p->ws + WS_WT2), scr, it, lane); }
    else { for (int it = widx; it < 2 * I_F; it += nw) { if (it < I_F) transpose_item<1>(p->in[25], D, DFF, (bf16_t*)(p->ws + WS_WT13), scr, it, lane);
                                                           else transpose_item<2>(p->in[26], D, DFF, (bf16_t*)(p->ws + WS_WT13), scr, it - I_F, lane); } }
}

template <int SRC, int NR>
DI void norm_rows(KP p, int rbase, int rstride, int lane, const float* normw, int sh_off, int sc_off, int gate_off, bf16_t* Hout, float* xout) {
    const float* MODb = (const float*)(p->ws + WS_MOD);
    const bf16_t* PART = (const bf16_t*)(p->ws + WS_PART);
    f32x4 v[NR][4];
#pragma unroll
    for (int q = 0; q < NR; ++q) { const f32x4* xr = (const f32x4*)xrow_of(p, rbase + q * rstride) + lane;
#pragma unroll
        for (int j = 0; j < 4; ++j) v[q][j] = xr[64 * j]; }
    if (SRC == 1) {
        u32x2 p0[NR][4], p1[NR][4];
#pragma unroll
        for (int q = 0; q < NR; ++q) { const int r = rbase + q * rstride;
#pragma unroll
            for (int j = 0; j < 4; ++j) { p0[q][j] = *((const u32x2*)(PART + (size_t)r * D) + lane + 64 * j); p1[q][j] = *((const u32x2*)(PART + (size_t)(NTOK + r) * D) + lane + 64 * j); } }
#pragma unroll
        for (int q = 0; q < NR; ++q) { const int r = rbase + q * rstride; const float* MOD = MODb + midx_of(r) * 6144;
#pragma unroll
            for (int j = 0; j < 4; ++j) { const f32x4 gt = *((const f32x4*)(MOD + gate_off) + lane + 64 * j); v[q][j] = v[q][j] + gt * (unpk4(p0[q][j]) + unpk4(p1[q][j])); } }
    }
    float s[NR];
#pragma unroll
    for (int q = 0; q < NR; ++q) { s[q] = 0.f;
#pragma unroll
        for (int j = 0; j < 4; ++j) s[q] += (v[q][j].x * v[q][j].x + v[q][j].y * v[q][j].y) + (v[q][j].z * v[q][j].z + v[q][j].w * v[q][j].w); }
#pragma unroll
    for (int o = 1; o < 64; o <<= 1) {
#pragma unroll
        for (int q = 0; q < NR; ++q) s[q] += __shfl_xor(s[q], o); }
#pragma unroll
    for (int q = 0; q < NR; ++q) {
        const int r = rbase + q * rstride; const float* MOD = MODb + midx_of(r) * 6144;
        const float rstd = rsqrtf(s[q] * (1.f / D) + EPS);
        u32x2* o = (u32x2*)(Hout + (size_t)r * D) + lane;
#pragma unroll
        for (int j = 0; j < 4; ++j) {
            if (SRC == 1) *((f32x4*)(xout + (size_t)r * D) + lane + 64 * j) = v[q][j];
            const f32x4 g = *((const f32x4*)normw + lane + 64 * j), sc = *((const f32x4*)(MOD + sc_off) + lane + 64 * j), sh = *((const f32x4*)(MOD + sh_off) + lane + 64 * j);
            const f32x4 h = v[q][j] * rstd * g * (sc + 1.f) + sh;
            o[64 * j] = (u32x2){pk2(h.x, h.y), pk2(h.z, h.w)};
        }
    }
}

#define MFMA32(a, b, c) __builtin_amdgcn_mfma_f32_32x32x16_bf16((a), (b), (c), 0, 0, 0)
DI int crow(int reg, int h) { return (reg & 3) + 8 * (reg >> 2) + 4 * h; }
typedef short v4i16_t __attribute__((ext_vector_type(4)));
DI s16x4 vtr(const LAS unsigned char* p) { return __builtin_bit_cast(s16x4, __builtin_amdgcn_ds_read_tr16_b64_v4i16((LAS v4i16_t*)p)); }

template <bool LATENT, int MODE>
DI void attn_unit(KP p, LAS unsigned char* vbuf, const LAS float* rpbL, int unit, int lane, int t0, int t1, LAS float* xch) {
    const bf16_t* Q = (const bf16_t*)(p->ws + WS_Q); const bf16_t* Kb = (const bf16_t*)(p->ws + WS_K); const bf16_t* Vb = (const bf16_t*)(p->ws + WS_V);
    const bf16_t* CK = (const bf16_t*)(p->ws + WS_CK); const bf16_t* CV = (const bf16_t*)(p->ws + WS_CV);
    bf16_t* MIX = (bf16_t*)(p->ws + WS_MIX);
    const int r = lane & 31, hh = lane >> 5;
    int head, qrow0, b, gi = 0, w0 = 0, si = 0, ntile;
    if (LATENT) { head = unit & 7; const int t = unit >> 3; w0 = (t & 1) * 32; gi = (t >> 1) & 31; b = t >> 6; qrow0 = NCTX + b * DSEQ + gi * 64 + w0; si = min(max(gi - 4, 0), 24); ntile = 32; }
    else { head = unit & 7; const int t = unit >> 3; const int qb = t & 7; b = t >> 3; qrow0 = b * SEQ + qb * 32; ntile = 8; }
    bf16x8 qf[4];
#pragma unroll
    for (int s = 0; s < 4; ++s) qf[s] = *(const bf16x8*)(Q + (size_t)(qrow0 + r) * 512 + head * 64 + 16 * s + 8 * hh);
    auto tile_ptrs = [&](int t, const bf16_t*& kp, const bf16_t*& vp) {
        if (LATENT) {
            if (t < 16) { const size_t row = (size_t)b * 512 + t * 32; kp = CK + row * 512; vp = CV + row * 512; }
            else { const int lt = t - 16; const size_t row = (size_t)NCTX + b * DSEQ + (si + (lt >> 1)) * 64 + (((lt & 1) * 32) ^ w0); kp = Kb + row * 512; vp = Vb + row * 512; }
        } else { const size_t row = (size_t)b * SEQ + t * 32; kp = Kb + row * 512; vp = Vb + row * 512; }
    };
    bf16x8 kf[4], kn[4]; u32x4 vn[4];
    {
        const bf16_t *kp, *vp; tile_ptrs(t0, kp, vp);
#pragma unroll
        for (int s = 0; s < 4; ++s) kf[s] = *(const bf16x8*)(kp + (size_t)r * 512 + head * 64 + 16 * s + 8 * hh);
#pragma unroll
        for (int i = 0; i < 4; ++i) { const int c = lane + 64 * i; vn[i] = *(const u32x4*)(vp + (size_t)(c >> 3) * 512 + head * 64 + (c & 7) * 8); }
#pragma unroll
        for (int i = 0; i < 4; ++i) { const int c = lane + 64 * i; *(LAS u32x4*)(vbuf + (c >> 3) * 144 + (c & 7) * 16) = vn[i]; }
    }
    f32x16 o0, o1;
#pragma unroll
    for (int i = 0; i < 16; ++i) { o0[i] = 0.f; o1[i] = 0.f; }
    float mrun = -1e30f, lrun = 0.f;
    const int i16 = lane & 15, tq = i16 >> 2, tp = i16 & 3, blk = (lane >> 4) & 1;
    const LAS unsigned char* vtbase = vbuf + (4 * hh + tq) * 144 + (16 * blk) * 2 + 8 * tp;
    const int wq = w0 + r;
    const int cs = min(max(wq - 8, 0), 48);
    for (int t = t0; t < t1; ++t) {
        const bool more = (t + 1 < t1);
        if (more) {
            const bf16_t *kp, *vp; tile_ptrs(t + 1, kp, vp);
#pragma unroll
            for (int s = 0; s < 4; ++s) kn[s] = *(const bf16x8*)(kp + (size_t)r * 512 + head * 64 + 16 * s + 8 * hh);
#pragma unroll
            for (int i = 0; i < 4; ++i) { const int c = lane + 64 * i; vn[i] = *(const u32x4*)(vp + (size_t)(c >> 3) * 512 + head * 64 + (c & 7) * 8); }
        }
        f32x16 st;
#pragma unroll
        for (int i = 0; i < 16; ++i) st[i] = 0.f;
#pragma unroll
        for (int s = 0; s < 4; ++s) st = MFMA32(kf[s], qf[s], st);
        if (LATENT && t >= 16) {
            const int lt = t - 16, a = lt >> 1, c0 = ((lt & 1) * 32) ^ w0;
            const int row_off = si + a - gi + 7;
            const int d0 = c0 + 4 * hh - cs;
            const LAS float* bp = rpbL + head * 465 + row_off * 31 + (c0 + 4 * hh - wq + 15);
#pragma unroll
            for (int i = 0; i < 16; ++i) {
                const int ci = (i & 3) + 8 * (i >> 2);
                const bool valid = (unsigned)(d0 + ci) < 16u;
                const float bias = valid ? bp[ci] : 0.f;
                st[i] = valid ? st[i] + bias : -INFINITY;
            }
        }
        float tmax = st[0];
#pragma unroll
        for (int i = 1; i < 16; ++i) tmax = fmaxf(tmax, st[i]);
        tmax = fmaxf(tmax, __shfl_xor(tmax, 32));
        const float mnew = fmaxf(mrun, tmax);
        float ps = 0.f;
#pragma unroll
        for (int i = 0; i < 16; ++i) { st[i] = __builtin_amdgcn_exp2f(st[i] - mnew); ps += st[i]; }
        if (__builtin_amdgcn_ballot_w64(tmax > mrun) != 0ull) {
            const float alpha = __builtin_amdgcn_exp2f(mrun - mnew);
            lrun *= alpha;
#pragma unroll
            for (int i = 0; i < 16; ++i) { o0[i] *= alpha; o1[i] *= alpha; }
        }
        lrun += ps; mrun = mnew;
        bf16x8 pb[2];
#pragma unroll
        for (int s = 0; s < 2; ++s) { u32x4 w; w.x = pk2(st[8 * s], st[8 * s + 1]); w.y = pk2(st[8 * s + 2], st[8 * s + 3]); w.z = pk2(st[8 * s + 4], st[8 * s + 5]); w.w = pk2(st[8 * s + 6], st[8 * s + 7]); pb[s] = __builtin_bit_cast(bf16x8, w); }
        asm volatile("s_waitcnt lgkmcnt(0)" ::: "memory");
#pragma unroll
        for (int s = 0; s < 2; ++s) {
            const LAS unsigned char* bs = vtbase + (16 * s) * 144;
            const s16x4 lo0 = vtr(bs), hi0 = vtr(bs + 8 * 144), lo1 = vtr(bs + 64), hi1 = vtr(bs + 8 * 144 + 64);
            const bf16x8 va0 = __builtin_shufflevector(lo0, hi0, 0, 1, 2, 3, 4, 5, 6, 7), va1 = __builtin_shufflevector(lo1, hi1, 0, 1, 2, 3, 4, 5, 6, 7);
            o0 = MFMA32(va0, pb[s], o0); o1 = MFMA32(va1, pb[s], o1);
        }
        asm volatile("s_waitcnt lgkmcnt(0)" ::: "memory");
        if (more) {
#pragma unroll
            for (int i = 0; i < 4; ++i) { const int c = lane + 64 * i; *(LAS u32x4*)(vbuf + (c >> 3) * 144 + (c & 7) * 16) = vn[i]; }
#pragma unroll
            for (int s = 0; s < 4; ++s) kf[s] = kn[s];
        }
    }
    if (MODE == 1) {
#pragma unroll
        for (int i = 0; i < 16; ++i) { xch[i * 64 + lane] = o0[i]; xch[(16 + i) * 64 + lane] = o1[i]; }
        xch[32 * 64 + lane] = mrun; xch[33 * 64 + lane] = lrun;
        __syncthreads();
        return;
    }
    if (MODE == 2) {
        __syncthreads();
        const float mb = xch[32 * 64 + lane], lb = xch[33 * 64 + lane];
        const float mm = fmaxf(mrun, mb), fa = exp2f(mrun - mm), fb = exp2f(mb - mm);
#pragma unroll
        for (int i = 0; i < 16; ++i) { o0[i] = o0[i] * fa + xch[i * 64 + lane] * fb; o1[i] = o1[i] * fa + xch[(16 + i) * 64 + lane] * fb; }
        lrun = lrun * fa + lb * fb;
    }
    const float ltot = lrun + __shfl_xor(lrun, 32);
    const float inv = 1.f / ltot;
    bf16_t* orow = MIX + (size_t)(qrow0 + r) * D + head * 64;
#pragma unroll
    for (int g4 = 0; g4 < 4; ++g4) {
        const int d = 8 * g4 + 4 * hh;
        *(u32x2*)(orow + d) = (u32x2){pk2(o0[4 * g4] * inv, o0[4 * g4 + 1] * inv), pk2(o0[4 * g4 + 2] * inv, o0[4 * g4 + 3] * inv)};
        *(u32x2*)(orow + 32 + d) = (u32x2){pk2(o1[4 * g4] * inv, o1[4 * g4 + 1] * inv), pk2(o1[4 * g4 + 2] * inv, o1[4 * g4 + 3] * inv)};
    }
}

DI void prep_rows8(KP p, int r0, int lane) {
    const bf16_t* ZR = (const bf16_t*)(p->ws + WS_ZR); const float* wts = p->in[12]; const float* k_k = p->in[18];
    bf16_t* R = (bf16_t*)(p->ws + WS_R); bf16_t* KR = (bf16_t*)(p->ws + WS_KR); bf16_t* VV = (bf16_t*)(p->ws + WS_VV); bf16_t* KK = (bf16_t*)(p->ws + WS_KK);
    bf16_t* AL = (bf16_t*)(p->ws + WS_ALORA);
    const int t0 = r0 < NCTX ? (r0 & 255) : ((r0 - NCTX) & 2047); const int T = r0 < NCTX ? SEQ : DSEQ;
    const bool hp = t0 > 0, hn = t0 + 8 < T;
    const bf16_t* zb = ZR + (size_t)(r0 - 1) * RC;
    const f32x4 zero = {0, 0, 0, 0};
#pragma unroll 1
    for (int seg = 0; seg < 3; ++seg) {
        const int c = seg * 512 + lane * 8;
        f32x4 z[10][2];
#pragma unroll
        for (int i = 0; i < 10; ++i) { const bool ok = (i > 0 || hp) && (i < 9 || hn);
            if (ok) { const u32x4 w = *(const u32x4*)(zb + (size_t)i * RC + c); z[i][0] = unpk4((u32x2){w.x, w.y}); z[i][1] = unpk4((u32x2){w.z, w.w}); } else { z[i][0] = zero; z[i][1] = zero; } }
        const f32x4 wa0 = *(const f32x4*)(wts + c), wa1 = *(const f32x4*)(wts + c + 4), wb0 = *(const f32x4*)(wts + RC + c), wb1 = *(const f32x4*)(wts + RC + c + 4),
                    wc0 = *(const f32x4*)(wts + 2 * RC + c), wc1 = *(const f32x4*)(wts + 2 * RC + c + 4);
        const f32x4 k0 = *(const f32x4*)(k_k + lane * 8), k1 = *(const f32x4*)(k_k + lane * 8 + 4);
        bf16_t* dstb = (seg == 0 ? R : (seg == 1 ? KR : VV)) + (size_t)r0 * 512 + lane * 8;
#pragma unroll
        for (int i = 0; i < 8; ++i) {
            const f32x4 u0 = z[i][0] * wa0 + z[i + 1][0] * wb0 + z[i + 2][0] * wc0, u1 = z[i][1] * wa1 + z[i + 1][1] * wb1 + z[i + 2][1] * wc1;
            *(u32x4*)(dstb + (size_t)i * 512) = (u32x4){pk2(u0.x, u0.y), pk2(u0.z, u0.w), pk2(u1.x, u1.y), pk2(u1.z, u1.w)};
            if (seg == 1) {
                const f32x4 a = u0 * k0, bq = u1 * k1;
                float sq = (a.x * a.x + a.y * a.y) + (a.z * a.z + a.w * a.w) + (bq.x * bq.x + bq.y * bq.y) + (bq.z * bq.z + bq.w * bq.w);
                sq += __shfl_xor(sq, 1); sq += __shfl_xor(sq, 2); sq += __shfl_xor(sq, 4);
                const float rn = rsqrtf(sq + 1e-12f);
                const f32x4 ka_ = a * rn, kb_ = bq * rn; *(u32x4*)(KK + (size_t)(r0 + i) * 512 + lane * 8) = (u32x4){pk2(ka_.x, ka_.y), pk2(ka_.z, ka_.w), pk2(kb_.x, kb_.y), pk2(kb_.z, kb_.w)};
            }
        }
    }
    {
        const int cl = lane * 6, cc = 1536 + cl;
        const f32x2 zero2 = {0, 0};
        f32x2 z[10][3];
#pragma unroll
        for (int i = 0; i < 10; ++i) { const bool ok = (i > 0 || hp) && (i < 9 || hn);
#pragma unroll
            for (int q = 0; q < 3; ++q) { if (ok) { const unsigned w = *(const unsigned*)(zb + (size_t)i * RC + cc + 2 * q); z[i][q] = (f32x2){__builtin_bit_cast(float, w << 16), __builtin_bit_cast(float, w & 0xffff0000u)}; } else z[i][q] = zero2; } }
#pragma unroll
        for (int q = 0; q < 3; ++q) {
            const f32x2 wa = *(const f32x2*)(wts + cc + 2 * q), wb = *(const f32x2*)(wts + RC + cc + 2 * q), wcq = *(const f32x2*)(wts + 2 * RC + cc + 2 * q);
            const int cq = cl + 2 * q, grp = cq >> 7, k = cq & 127;
#pragma unroll
            for (int i = 0; i < 8; ++i) {
                f32x2 u = z[i][q] * wa + z[i + 1][q] * wb + z[i + 2][q] * wcq;
                if (grp == 0) { u.x = tanh_f(u.x); u.y = tanh_f(u.y); }
                else if (grp == 2) { u.x = sigmoid_f(u.x); u.y = sigmoid_f(u.y); }
                *(unsigned*)(AL + ((size_t)grp * NTOK + r0 + i) * 128 + k) = pk2(u.x, u.y);
            }
        }
    }
}

template <int CTRL> DI float dppf_(float x) { return __builtin_bit_cast(float, __builtin_amdgcn_mov_dpp(__builtin_bit_cast(int, x), CTRL, 0xf, 0xf, true)); }
template <int CTRL> DI float dpp_add(float x) { const int y = __builtin_amdgcn_mov_dpp(__builtin_bit_cast(int, x), CTRL, 0xf, 0xf, true); return x + __builtin_bit_cast(float, y); }
DI float red16(float x) { x = dpp_add<0xB1>(x); x = dpp_add<0x4E>(x); x = dpp_add<0x141>(x); x = dpp_add<0x140>(x); return x; }

constexpr int TC = 16;
DI float tred4(float q0, float q1, float q2, float q3, bool b0, bool b1) {
    const float ka = b0 ? q2 : q0, kb = b0 ? q3 : q1, sa = b0 ? q0 : q2, sb = b0 ? q1 : q3;
    const float a = ka + dppf_<0xB1>(sa), b = kb + dppf_<0xB1>(sb);
    float c = (b1 ? b : a) + dppf_<0x4E>(b1 ? a : b);
    c += dppf_<0x124>(c);
    c += dppf_<0x128>(c);
    return c;
}
DI f32x2 lo2(f32x4 v) { return __builtin_shufflevector(v, v, 0, 1); }
DI f32x2 hi2(f32x4 v) { return __builtin_shufflevector(v, v, 2, 3); }
struct ScanOps { f32x4 kk, rr, ww, bb, kd; float vv; };
struct ScanLd { f32x4 kk, r, dec, aa, kr, v; };
DI void scan_item(KP p, LAS unsigned char* lds, int latent, int sc, int qr, int tid) {
    const bf16_t* KK = (const bf16_t*)(p->ws + WS_KK); const bf16_t* R = (const bf16_t*)(p->ws + WS_R); const bf16_t* KR = (const bf16_t*)(p->ws + WS_KR);
    const bf16_t* VV = (const bf16_t*)(p->ws + WS_VV); const float* k_a = p->in[19];
    float* Y = (float*)(p->ws + WS_Y);
    const int b = sc >> 4, dir = (sc >> 3) & 1, h = sc & 7;
    const int T = latent ? DSEQ : SEQ; const size_t rowbase = latent ? (size_t)NCTX + (size_t)b * DSEQ : (size_t)b * SEQ;
    const float* DEC = (const float*)(p->ws + WS_DEC) + (size_t)dir * NTOK * 512; const bf16_t* AA = (const bf16_t*)(p->ws + WS_AA) + (size_t)dir * NTOK * 512;
    float* Yd = Y + (size_t)dir * NTOK * 512;
    LAS float* buf = (LAS float*)lds;
    LAS float* vb = (LAS float*)(lds + 2 * TC * 320 * 4);
    const int wave = tid >> 6, lane = tid & 63;
    const bool consumer = wave < 4;
    const int nchunk = T / TC;
    const int rl = lane >> 4, ks = lane & 15, row = 16 * qr + 4 * wave + rl;
    f32x2 S01 = {0, 0}, S23 = {0, 0};
    if (consumer && latent) { const f32x4 s4 = *(const f32x4*)(p->in[4] + ((((size_t)b * 2 + dir) * 8 + h) * 64 + row) * 64 + 4 * ks); S01 = lo2(s4); S23 = hi2(s4); }
    const int lt = tid - 256, lj = lt >> 4, li = lt & 15;
    ScanLd L0, L1; f32x4 ka4 = {0, 0, 0, 0};
    if (!consumer) ka4 = *(const f32x4*)(k_a + h * 64 + 4 * li);
    float* ybase = Yd + (rowbase)*512 + h * 64 + row;
    const bool kb0 = (ks & 1) != 0, kb1 = (ks & 2) != 0; const int ystep = 4 * (ks >> 2) + 2 * (ks & 1) + ((ks >> 1) & 1);
#define SCAN_LOAD(L, c) do { const int idx = (c) * TC + lj; const int tt = dir ? T - 1 - idx : idx; const size_t off = (rowbase + tt) * 512 + h * 64 + 4 * li; \
        L.kk = unpk4(*(const u32x2*)(KK + off)); L.r = unpk4(*(const u32x2*)(R + off)); L.dec = *(const f32x4*)(DEC + off); L.aa = unpk4(*(const u32x2*)(AA + off)); L.kr = unpk4(*(const u32x2*)(KR + off)); \
        if (lt < 64) { const int vj = lt >> 2, vq = lt & 3; const int idv = (c) * TC + vj; const int tv = dir ? T - 1 - idv : idv; L.v = unpk4(*(const u32x2*)(VV + (rowbase + tv) * 512 + h * 64 + 16 * qr + 4 * vq)); } } while (0)
#define SCAN_WRITE(L, bc, vc) do { const f32x4 bb_ = L.kk * L.aa; const f32x4 kd_ = L.kr * ((L.aa - 1.f) * ka4 + 1.f); LAS float* d_ = (bc) + lj * 320 + 4 * li; \
        *(LAS f32x4*)(d_) = L.kk; *(LAS f32x4*)(d_ + 64) = L.r; *(LAS f32x4*)(d_ + 128) = L.dec; *(LAS f32x4*)(d_ + 192) = bb_; *(LAS f32x4*)(d_ + 256) = kd_; \
        if (lt < 64) *(LAS f32x4*)((vc) + (lt >> 2) * 16 + 4 * (lt & 3)) = L.v; } while (0)
#define SCAN_LDOPS(o, bc, vc, j) do { const LAS float* d_ = (bc) + (j) * 320 + 4 * ks; o.kk = *(const LAS f32x4*)(d_); o.rr = *(const LAS f32x4*)(d_ + 64); o.ww = *(const LAS f32x4*)(d_ + 128); \
        o.bb = *(const LAS f32x4*)(d_ + 192); o.kd = *(const LAS f32x4*)(d_ + 256); o.vv = (vc)[(j) * 16 + 4 * wave + rl]; } while (0)
#define SCAN_COMPUTE(bc, vc, c) do { ScanOps oc, on, on2; SCAN_LDOPS(oc, bc, vc, 0); SCAN_LDOPS(on, bc, vc, 1); float ysel = 0.f; float yp0 = 0.f, yp1 = 0.f, yp2 = 0.f; \
        _Pragma("unroll") for (int j = 0; j < TC; ++j) { \
            if (j + 2 < TC) SCAN_LDOPS(on2, bc, vc, j + 2);     \
            f32x2 pq = S01 * lo2(oc.kk); pq = S23 * hi2(oc.kk) + pq; \
            const float sa = red16(pq.x + pq.y); \
            const f32x2 t01 = S01 * lo2(oc.ww) + lo2(oc.kd) * oc.vv, t23 = S23 * hi2(oc.ww) + hi2(oc.kd) * oc.vv; \
            S01 = t01 - lo2(oc.bb) * sa; S23 = t23 - hi2(oc.bb) * sa; \
            f32x2 yq = S01 * lo2(oc.rr); yq = S23 * hi2(oc.rr) + yq; \
            const float yp = yq.x + yq.y; \
            if ((j & 3) == 0) yp0 = yp; else if ((j & 3) == 1) yp1 = yp; else if ((j & 3) == 2) yp2 = yp; \
            else { const float yr = tred4(yp0, yp1, yp2, yp, kb0, kb1); ysel = ((ks >> 2) == (j >> 2)) ? yr : ysel; } \
            oc = on; on = on2; \
            asm volatile("" ::: "memory"); } \
        { const int idx = (c) * TC + ystep; const int tt = dir ? T - 1 - idx : idx; ybase[(size_t)tt * 512] = ysel; } } while (0)
    if (!consumer) { SCAN_LOAD(L0, 0); SCAN_LOAD(L1, 1); }
    for (int c = 0; c < nchunk; c += 2) {
        if (!consumer) SCAN_WRITE(L0, buf, vb);
        __syncthreads();
        if (!consumer) { if (c + 2 < nchunk) SCAN_LOAD(L0, c + 2); }
        else SCAN_COMPUTE(buf, vb, c);
        if (!consumer) SCAN_WRITE(L1, buf + TC * 320, vb + TC * 16);
        __syncthreads();
        if (!consumer) { if (c + 3 < nchunk) SCAN_LOAD(L1, c + 3); }
        else SCAN_COMPUTE(buf + TC * 320, vb + TC * 16, c + 1);
    }
#undef SCAN_LOAD
#undef SCAN_WRITE
#undef SCAN_LDOPS
#undef SCAN_COMPUTE
    if (consumer && !latent) *(f32x4*)(p->out + OUT_S + ((((size_t)b * 2 + dir) * 8 + h) * 64 + row) * 64 + 4 * ks) = (f32x4){S01.x, S01.y, S23.x, S23.y};
    __syncthreads();
}

constexpr int CS_L = 32, CS_LAT = 2048, CS_CHUNKS = 4096;
DI unsigned char* cs_mf(unsigned char* ws, int q) { return ws + 28 * MiB + (size_t)q * 8192; }
DI unsigned char* cs_q1(unsigned char* ws, int q) { return q < CS_LAT ? ws + 60 * MiB + (size_t)q * 4096 : ws + 76 * MiB + (size_t)(q - CS_LAT) * 4096; }
DI unsigned char* cs_q2(unsigned char* ws, int q) { return q < CS_LAT ? ws + 92 * MiB + (size_t)q * 4096 : ws + 108 * MiB + (size_t)(q - CS_LAT) * 4096; }
DI unsigned char* cs_nt(unsigned char* ws, int q) { return q < CS_LAT ? ws + 202 * MiB + (size_t)q * 8192 : ws + 234 * MiB + (size_t)(q - CS_LAT) * 8192; }
constexpr int CS_G = 49152;
DI bf16x8 frag_nat(const LAS unsigned char* img, int pitch, int rc, int s, int hh) { return *(const LAS bf16x8*)(img + rc * pitch + (16 * s + 8 * hh) * 2); }
DI bf16x8 frag_krow(const LAS unsigned char* img, int pitch, int rc, int s, int hh) {
    const s16x4 lo = *(const LAS s16x4*)(img + rc * pitch + (16 * s + 4 * hh) * 2), hi = *(const LAS s16x4*)(img + rc * pitch + (16 * s + 8 + 4 * hh) * 2);
    return __builtin_shufflevector(lo, hi, 0, 1, 2, 3, 4, 5, 6, 7); }
DI bf16x8 frag_tr(const LAS unsigned char* img, int pitch, int col0, int s, int lane) {
    const int i16 = lane & 15, tq = i16 >> 2, tp = i16 & 3, blk = (lane >> 4) & 1, hh = lane >> 5;
    const LAS unsigned char* bs = img + (16 * s + 4 * hh + tq) * pitch + (col0 + 16 * blk) * 2 + 8 * tp;
    const s16x4 lo = vtr(bs), hi = vtr(bs + 8 * pitch);
    return __builtin_shufflevector(lo, hi, 0, 1, 2, 3, 4, 5, 6, 7); }
template <int S> DI bf16x8 pack8(const f32x16& x, float sg) {
    u32x4 w; w.x = pk2(sg * x[8 * S], sg * x[8 * S + 1]); w.y = pk2(sg * x[8 * S + 2], sg * x[8 * S + 3]); w.z = pk2(sg * x[8 * S + 4], sg * x[8 * S + 5]); w.w = pk2(sg * x[8 * S + 6], sg * x[8 * S + 7]);
    return __builtin_bit_cast(bf16x8, w); }
template <int S> DI bf16x8 pack8lo(const f32x16& x, bf16x8 hi) {
    const u32x4 h = __builtin_bit_cast(u32x4, hi); float d[8];
#pragma unroll
    for (int j = 0; j < 4; ++j) { d[2 * j] = x[8 * S + 2 * j] - __builtin_bit_cast(float, h[j] << 16); d[2 * j + 1] = x[8 * S + 2 * j + 1] - __builtin_bit_cast(float, h[j] & 0xffff0000u); }
    u32x4 w; w.x = pk2(d[0], d[1]); w.y = pk2(d[2], d[3]); w.z = pk2(d[4], d[5]); w.w = pk2(d[6], d[7]);
    return __builtin_bit_cast(bf16x8, w); }
DI void lds_barrier() { asm volatile("s_waitcnt lgkmcnt(0)" ::: "memory"); __builtin_amdgcn_s_barrier(); asm volatile("" ::: "memory"); }
DI f32x16 zero16() { f32x16 z;
#pragma unroll
    for (int i = 0; i < 16; ++i) z[i] = 0.f;
    return z; }

DI void cs_phaseA(KP p, LAS unsigned char* lds, int tid, int qbase, int nit, int first, int stride) {
    const bf16_t* KK = (const bf16_t*)(p->ws + WS_KK); const bf16_t* R = (const bf16_t*)(p->ws + WS_R); const bf16_t* KR = (const bf16_t*)(p->ws + WS_KR);
    const bf16_t* VV = (const bf16_t*)(p->ws + WS_VV); const float* k_a = p->in[19];
    const int wave = tid >> 6, lane = tid & 63, g = wave >> 2, wq = wave & 3, tg = wq * 64 + lane, hh = lane >> 5, r32 = lane & 31;
    LAS unsigned char* L = lds + g * CS_G;
    LAS unsigned char* MKK = L, *MBT = L + 4608, *MKT = L + 2 * 4608, *MRT = L + 3 * 4608, *MBH = L + 4 * 4608, *MKH = L + 5 * 4608, *MVM = L + 6 * 4608;
    LAS float* AF = (LAS float*)(L + 32256);
    LAS unsigned char* ST = L + 36352, *SKK = ST + 2560, *SRB = ST + 2 * 2560, *SRK = ST + 3 * 2560;
    LAS float* SEG = (LAS float*)(L + 46592); LAS float* ELv = (LAS float*)(L + 48640);
    f32x2 lwN[4], kkN[4], aaN[4], krN[4], rN[4]; u32x4 vmN;
#define CSA_FETCH(it_) do { const int q_ = qbase + (it_) * 2 + g; const bool lat_ = q_ < CS_LAT; const int sc_ = lat_ ? (q_ >> 6) : ((q_ - CS_LAT) >> 3), ci_ = lat_ ? (q_ & 63) : (q_ & 7), TT_ = lat_ ? DSEQ : SEQ; \
        const int b_ = sc_ >> 4, dir_ = (sc_ >> 3) & 1, h_ = sc_ & 7; const int rb_ = lat_ ? NCTX + b_ * DSEQ : b_ * SEQ; \
          \
        const int t0_ = dir_ ? TT_ - 1 - ci_ * CS_L : ci_ * CS_L, sg_ = dir_ ? -512 : 512; \
        const unsigned ub_ = (unsigned)((rb_ + t0_) * 512 + h_ * 64); \
        const unsigned o0_ = ub_ + (unsigned)(sg_ * 4 * (tg >> 5) + 2 * (tg & 31)); \
        const float* DEC_ = (const float*)(p->ws + WS_DEC) + (size_t)dir_ * NTOK * 512; const bf16_t* AA_ = (const bf16_t*)(p->ws + WS_AA) + (size_t)dir_ * NTOK * 512; \
        _Pragma("unroll") for (int j = 0; j < 4; ++j) { const unsigned off = o0_ + (unsigned)(sg_ * j); \
            lwN[j] = *(const f32x2*)(DEC_ + off); kkN[j] = ldh2(KK + off); aaN[j] = ldh2(AA_ + off); krN[j] = ldh2(KR + off); rN[j] = ldh2(R + off); } \
        vmN = *(const u32x4*)(VV + (ub_ + (unsigned)(sg_ * (tg >> 3) + (tg & 7) * 8))); } while (0)
    if (first < nit) CSA_FETCH(first);
    for (int it = first; it < nit; it += stride) {
        const int q = qbase + it * 2 + g; const bool lat = q < CS_LAT;
        const int sc = lat ? (q >> 6) : ((q - CS_LAT) >> 3), ci = lat ? (q & 63) : (q & 7), TT = lat ? DSEQ : SEQ;
        const int b = sc >> 4, dir = (sc >> 3) & 1, h = sc & 7;
        const size_t rowbase = lat ? (size_t)NCTX + (size_t)b * DSEQ : (size_t)b * SEQ;
        const float* DEC = (const float*)(p->ws + WS_DEC) + (size_t)dir * NTOK * 512; const bf16_t* AA = (const bf16_t*)(p->ws + WS_AA) + (size_t)dir * NTOK * 512;
        {
            const int kp = tg & 31, seg = tg >> 5;
            f32x2 lw[4], kk2[4], aa2[4], kr2[4], r2[4];
#pragma unroll
            for (int j = 0; j < 4; ++j) { lw[j] = lwN[j]; kk2[j] = kkN[j]; aa2[j] = aaN[j]; kr2[j] = krN[j]; r2[j] = rN[j]; }
            const u32x4 vmC = vmN;
            if (it + stride < nit) CSA_FETCH(it + stride);
            f32x2 ss = {0.f, 0.f};
#pragma unroll
            for (int j = 0; j < 4; ++j) { lw[j].x = __logf(lw[j].x); lw[j].y = __logf(lw[j].y); ss += lw[j]; }
            *(LAS f32x2*)(SEG + seg * 64 + 2 * kp) = ss;
            { const int i = tg >> 3, v0 = (tg & 7) * 8; *(LAS u32x4*)(MVM + i * 144 + v0 * 2) = vmC; }
            lds_barrier();
            f32x2 pre = {0.f, 0.f}, tot = {0.f, 0.f};
#pragma unroll
            for (int s8 = 0; s8 < 8; ++s8) { const f32x2 v = *(const LAS f32x2*)(SEG + s8 * 64 + 2 * kp); tot += v; if (s8 < seg) pre += v; }
            if (seg == 0) *(LAS f32x2*)(ELv + 2 * kp) = (f32x2){__expf(tot.x), __expf(tot.y)};
            const f32x2 ka = *(const f32x2*)(k_a + h * 64 + 2 * kp);
            f32x2 cwp = pre;
#pragma unroll
            for (int j = 0; j < 4; ++j) {
                const f32x2 cw = cwp + lw[j];
                const f32x2 E = {__expf(cw.x), __expf(cw.y)}, Ei = {__expf(-cw.x), __expf(-cw.y)}, Ep = {__expf(cwp.x), __expf(cwp.y)}, Eh = {__expf(tot.x - cw.x), __expf(tot.y - cw.y)};
                const f32x2 bb = kk2[j] * aa2[j], kd = kr2[j] * ((aa2[j] - 1.f) * ka + 1.f);
                const int o = (4 * seg + j) * 144 + 4 * kp;
                const f32x2 x0 = kk2[j] * Ep, x1 = bb * Ei, x2 = kd * Ei, x3 = r2[j] * E, x4 = bb * Eh, x5 = kd * Eh;
                *(LAS unsigned*)(MKK + o) = pk2(x0.x, x0.y); *(LAS unsigned*)(MBT + o) = pk2(x1.x, x1.y); *(LAS unsigned*)(MKT + o) = pk2(x2.x, x2.y);
                *(LAS unsigned*)(MRT + o) = pk2(x3.x, x3.y); *(LAS unsigned*)(MBH + o) = pk2(x4.x, x4.y); *(LAS unsigned*)(MKH + o) = pk2(x5.x, x5.y);
                cwp = cw;
            }
        }
        lds_barrier();
        {
            const LAS unsigned char* ia = wq < 2 ? MKK : MRT; const LAS unsigned char* ib = (wq & 1) ? MKT : MBT;
            f32x16 acc = zero16();
#pragma unroll
            for (int s4 = 0; s4 < 4; ++s4) acc = MFMA32(frag_nat(ia, 144, r32, s4, hh), frag_nat(ib, 144, r32, s4, hh), acc);
#pragma unroll
            for (int i = 0; i < 16; ++i) { const int row = crow(i, hh); const bool keep = wq < 2 ? (row > r32) : (row >= r32); const float v = keep ? acc[i] : 0.f;
                if (wq == 0) AF[row * 32 + r32] = v;
                else *(LAS unsigned short*)((wq == 1 ? SKK : (wq == 2 ? SRB : SRK)) + row * 80 + r32 * 2) = (unsigned short)(pk2(v, 0.f) & 0xffffu); }
        }
        lds_barrier();
        f32x16 X = zero16(), NT0 = zero16(), NT1 = zero16(), Q2 = zero16();
        const int c = wq & 1;
        if (wq == 0) {
            float Tc[32];
#pragma unroll
            for (int i = 0; i < 32; ++i) {
                float a4[4] = {(i == r32) ? 1.f : 0.f, 0.f, 0.f, 0.f};
#pragma unroll
                for (int j4 = 0; j4 < (i + 3) / 4; ++j4) { const f32x4 ar = *(const LAS f32x4*)(AF + i * 32 + 4 * j4);
#pragma unroll
                    for (int e = 0; e < 4; ++e) if (4 * j4 + e < i) a4[e] -= ar[e] * Tc[4 * j4 + e]; }
                const float a = (a4[0] + a4[1]) + (a4[2] + a4[3]);
                Tc[i] = a;
                if (lane < 32) *(LAS unsigned short*)(ST + i * 80 + r32 * 2) = (unsigned short)(pk2(a, 0.f) & 0xffffu);
            }
        } else if (wq >= 2) {
#pragma unroll
            for (int s2 = 0; s2 < 2; ++s2) {
                const bf16x8 vm = frag_tr(MVM, 144, 32 * c, s2, lane);
                X = MFMA32(frag_krow(SKK, 80, r32, s2, hh), vm, X);
                Q2 = MFMA32(frag_krow(SRK, 80, r32, s2, hh), vm, Q2);
                NT0 = MFMA32(frag_tr(MKH, 144, 0, s2, lane), vm, NT0);
                NT1 = MFMA32(frag_tr(MKH, 144, 32, s2, lane), vm, NT1);
            }
        }
        lds_barrier();
        if (wq < 2) {
            f32x16 P1 = zero16();
#pragma unroll
            for (int s2 = 0; s2 < 2; ++s2) P1 = MFMA32(frag_krow(ST, 80, r32, s2, hh), frag_tr(MKK, 144, 32 * c, s2, lane), P1);
            const bf16x8 n0 = pack8<0>(P1, -1.f), n1 = pack8<1>(P1, -1.f);
            f32x16 Q1t;
#pragma unroll
            for (int g4 = 0; g4 < 4; ++g4) { const u32x2 w = *(const LAS u32x2*)(MRT + r32 * 144 + (32 * c + 8 * g4 + 4 * hh) * 2); const f32x4 f = unpk4(w);
                Q1t[4 * g4] = f.x; Q1t[4 * g4 + 1] = f.y; Q1t[4 * g4 + 2] = f.z; Q1t[4 * g4 + 3] = f.w; }
            Q1t = MFMA32(n0, frag_krow(SRB, 80, r32, 0, hh), Q1t); Q1t = MFMA32(n1, frag_krow(SRB, 80, r32, 1, hh), Q1t);
            u32x4* q1f = (u32x4*)cs_q1(p->ws, q) + (c * 2) * 64 + lane;
            q1f[0] = __builtin_bit_cast(u32x4, pack8<0>(Q1t, 1.f)); q1f[64] = __builtin_bit_cast(u32x4, pack8<1>(Q1t, 1.f));
#pragma unroll
            for (int bq = 0; bq < 2; ++bq) {
                f32x16 M = zero16();
                if (bq == c) {
#pragma unroll
                    for (int i = 0; i < 16; ++i) M[i] = (crow(i, hh) == r32) ? ELv[32 * c + r32] : 0.f;
                }
                M = MFMA32(n0, frag_tr(MBH, 144, 32 * bq, 0, lane), M); M = MFMA32(n1, frag_tr(MBH, 144, 32 * bq, 1, lane), M);
                u32x4* mf = (u32x4*)cs_mf(p->ws, q) + ((c * 2 + bq) * 2) * 64 + lane;
                mf[0] = __builtin_bit_cast(u32x4, pack8<0>(M, 1.f)); mf[64] = __builtin_bit_cast(u32x4, pack8<1>(M, 1.f));
            }
        } else {
            f32x16 P2 = zero16();
            P2 = MFMA32(frag_krow(ST, 80, r32, 0, hh), pack8<0>(X, 1.f), P2); P2 = MFMA32(frag_krow(ST, 80, r32, 1, hh), pack8<1>(X, 1.f), P2);
            const bf16x8 n0 = pack8<0>(P2, -1.f), n1 = pack8<1>(P2, -1.f);
            Q2 = MFMA32(frag_krow(SRB, 80, r32, 0, hh), n0, Q2); Q2 = MFMA32(frag_krow(SRB, 80, r32, 1, hh), n1, Q2);
            NT0 = MFMA32(frag_tr(MBH, 144, 0, 0, lane), n0, NT0); NT0 = MFMA32(frag_tr(MBH, 144, 0, 1, lane), n1, NT0);
            NT1 = MFMA32(frag_tr(MBH, 144, 32, 0, lane), n0, NT1); NT1 = MFMA32(frag_tr(MBH, 144, 32, 1, lane), n1, NT1);
            unsigned* q2f = (unsigned*)cs_q2(p->ws, q) + c * 512 + lane;
#pragma unroll
            for (int i = 0; i < 8; ++i) q2f[i * 64] = pk2(Q2[2 * i], Q2[2 * i + 1]);
            unsigned* ntf = (unsigned*)cs_nt(p->ws, q) + (c * 2) * 512 + lane;
#pragma unroll
            for (int i = 0; i < 8; ++i) { ntf[i * 64] = pk2(NT0[2 * i], NT0[2 * i + 1]); ntf[512 + i * 64] = pk2(NT1[2 * i], NT1[2 * i + 1]); }
        }
        lds_barrier();
    }
#undef CSA_FETCH
}


constexpr int CSB_SLOT = 24576;
DI void cs_phaseB(KP p, LAS unsigned char* lds, int latent, int sc, int tid) {
    const int wave = tid >> 6, lane = tid & 63, hh = lane >> 5, r32 = lane & 31;
    const int nch = latent ? 64 : 8, q0 = latent ? sc * 64 : CS_LAT + sc * 8, TT = latent ? DSEQ : SEQ;
    const int b = sc >> 4, dir = (sc >> 3) & 1, h = sc & 7, c = wave & 1;
    const size_t rowbase = latent ? (size_t)NCTX + (size_t)b * DSEQ : (size_t)b * SEQ;
    const bool consumer = wave < 2;
    float* Yu = p->out + (size_t)dir * NTOK * 512 + rowbase * 512 + h * 64 + 32 * c;
    const unsigned ylane = (unsigned)((dir ? 4 * (1 - hh) : 4 * hh) * 512 + r32);
    f32x16 Z0 = zero16(), Z1 = zero16();
    if (consumer && latent) { const float* s0 = p->in[4] + ((((size_t)b * 2 + dir) * 8 + h) * 64 + 32 * c + r32) * 64;
#pragma unroll
      for (int g4 = 0; g4 < 4; ++g4) { const f32x4 a = *(const f32x4*)(s0 + 8 * g4 + 4 * hh), bq = *(const f32x4*)(s0 + 32 + 8 * g4 + 4 * hh);
          Z0[4 * g4] = a.x; Z0[4 * g4 + 1] = a.y; Z0[4 * g4 + 2] = a.z; Z0[4 * g4 + 3] = a.w; Z1[4 * g4] = bq.x; Z1[4 * g4 + 1] = bq.y; Z1[4 * g4 + 2] = bq.z; Z1[4 * g4 + 3] = bq.w; } }
    const int lt = tid - 128;
    u32x4 RG[4][4];
#define CSB_LOADQ(set, ch) do { const int q_ = q0 + (ch); _Pragma("unroll") for (int k_ = 0; k_ < 4; ++k_) { const int pi_ = lt + 384 * k_; \
        const unsigned char* src_ = pi_ < 512 ? cs_mf(p->ws, q_) + pi_ * 16 : (pi_ < 768 ? cs_q1(p->ws, q_) + (pi_ - 512) * 16 : (pi_ < 1280 ? cs_nt(p->ws, q_) + (pi_ - 768) * 16 : cs_q2(p->ws, q_) + (pi_ - 1280) * 16)); \
        RG[set][k_] = *(const u32x4*)src_; } } while (0)
#define CSB_WRITEQ(set, slot) do { _Pragma("unroll") for (int k_ = 0; k_ < 4; ++k_) *(LAS u32x4*)(lds + (slot) * CSB_SLOT + (lt + 384 * k_) * 16) = RG[set][k_]; } while (0)
    if (!consumer) { CSB_LOADQ(0, 0); CSB_LOADQ(1, 1); CSB_LOADQ(2, 2); CSB_LOADQ(3, 3); CSB_WRITEQ(0, 0); CSB_LOADQ(0, 4); }
    else __builtin_amdgcn_s_setprio(3);
    for (int ci0 = 0; ci0 < nch; ci0 += 4) {
#pragma unroll
        for (int u = 0; u < 4; ++u) {
            const int ci = ci0 + u;
            lds_barrier();
            if (!consumer) {
                if (ci + 1 < nch) { CSB_WRITEQ((u + 1) & 3, (ci + 1) & 1); if (ci + 5 < nch) CSB_LOADQ((u + 1) & 3, ci + 5); }
            } else {
                const LAS unsigned char* sl = lds + (ci & 1) * CSB_SLOT;
                bf16x8 MF[8], Q1[4]; f32x16 Y, N0, N1;
#pragma unroll
                for (int i = 0; i < 8; ++i) MF[i] = *(const LAS bf16x8*)(sl + (i * 64 + lane) * 16);
#pragma unroll
                for (int i = 0; i < 4; ++i) Q1[i] = *(const LAS bf16x8*)(sl + 8192 + (i * 64 + lane) * 16);
#pragma unroll
                for (int i = 0; i < 8; ++i) { const unsigned w0 = *(const LAS unsigned*)(sl + 12288 + ((c * 2) * 512 + i * 64 + lane) * 4), w1 = *(const LAS unsigned*)(sl + 12288 + ((c * 2 + 1) * 512 + i * 64 + lane) * 4),
                                                         w2 = *(const LAS unsigned*)(sl + 20480 + (c * 512 + i * 64 + lane) * 4);
                    N0[2 * i] = __builtin_bit_cast(float, w0 << 16); N0[2 * i + 1] = __builtin_bit_cast(float, w0 & 0xffff0000u);
                    N1[2 * i] = __builtin_bit_cast(float, w1 << 16); N1[2 * i + 1] = __builtin_bit_cast(float, w1 & 0xffff0000u);
                    Y[2 * i] = __builtin_bit_cast(float, w2 << 16); Y[2 * i + 1] = __builtin_bit_cast(float, w2 & 0xffff0000u); }
                const bf16x8 z00 = pack8<0>(Z0, 1.f), z01 = pack8<1>(Z0, 1.f), z10 = pack8<0>(Z1, 1.f), z11 = pack8<1>(Z1, 1.f);
                const bf16x8 l00 = pack8lo<0>(Z0, z00), l01 = pack8lo<1>(Z0, z01), l10 = pack8lo<0>(Z1, z10), l11 = pack8lo<1>(Z1, z11);
                Y = MFMA32(Q1[0], z00, Y); Y = MFMA32(Q1[1], z01, Y); Y = MFMA32(Q1[2], z10, Y); Y = MFMA32(Q1[3], z11, Y);
                N0 = MFMA32(MF[0], z00, N0); N0 = MFMA32(MF[1], z01, N0); N0 = MFMA32(MF[4], z10, N0); N0 = MFMA32(MF[5], z11, N0);
                N0 = MFMA32(MF[0], l00, N0); N0 = MFMA32(MF[1], l01, N0); N0 = MFMA32(MF[4], l10, N0); N0 = MFMA32(MF[5], l11, N0);
                N1 = MFMA32(MF[2], z00, N1); N1 = MFMA32(MF[3], z01, N1); N1 = MFMA32(MF[6], z10, N1); N1 = MFMA32(MF[7], z11, N1);
                N1 = MFMA32(MF[2], l00, N1); N1 = MFMA32(MF[3], l01, N1); N1 = MFMA32(MF[6], l10, N1); N1 = MFMA32(MF[7], l11, N1);
                Z0 = N0; Z1 = N1;
                { const int t0 = dir ? TT - CS_L - ci * CS_L : ci * CS_L;
#pragma unroll
                  for (int i = 0; i < 16; ++i) { const int ci_ = (i & 3) + 8 * (i >> 2); float* Ys = Yu + (size_t)(t0 + (dir ? 27 - ci_ : ci_)) * 512; Ys[ylane] = Y[i]; } }
            }
        }
    }
#undef CSB_LOADQ
#undef CSB_WRITEQ
    __builtin_amdgcn_s_setprio(0);
    if (consumer && !latent) { float* so = p->out + OUT_S + ((((size_t)b * 2 + dir) * 8 + h) * 64 + 32 * c + r32) * 64;
#pragma unroll
        for (int g4 = 0; g4 < 4; ++g4) { *(f32x4*)(so + 8 * g4 + 4 * hh) = (f32x4){Z0[4 * g4], Z0[4 * g4 + 1], Z0[4 * g4 + 2], Z0[4 * g4 + 3]};
                                          *(f32x4*)(so + 32 + 8 * g4 + 4 * hh) = (f32x4){Z1[4 * g4], Z1[4 * g4 + 1], Z1[4 * g4 + 2], Z1[4 * g4 + 3]}; } }
    __syncthreads();
}

DI void post_row(KP p, int r, int lane) {
    const float* Y = p->out; const bf16_t* R = (const bf16_t*)(p->ws + WS_R); const bf16_t* KR = (const bf16_t*)(p->ws + WS_KR);
    const bf16_t* VV = (const bf16_t*)(p->ws + WS_VV); const bf16_t* AA = (const bf16_t*)(p->ws + WS_AA); const bf16_t* G = (const bf16_t*)(p->ws + WS_G);
    const float* k_a = p->in[19]; const float* r_k = p->in[20]; const float* lng = p->in[21]; const float* lnb = p->in[22];
    bf16_t* MIX = (bf16_t*)(p->ws + WS_MIX);
    const int c = lane * 8; const size_t off = (size_t)r * 512 + c;
    float y[8], rr[8], kr[8], vv[8], a0[8], a1[8], gg[8], ka[8], rk[8], lg[8], lb[8];
#define LD8(dst, ptr) do { const f32x4 _a = *(const f32x4*)(ptr), _b = *(const f32x4*)((ptr) + 4); dst[0] = _a.x; dst[1] = _a.y; dst[2] = _a.z; dst[3] = _a.w; dst[4] = _b.x; dst[5] = _b.y; dst[6] = _b.z; dst[7] = _b.w; } while (0)
#define LD8H(dst, ptr) do { const u32x4 _w = *(const u32x4*)(ptr); const f32x4 _a = unpk4((u32x2){_w.x, _w.y}), _b = unpk4((u32x2){_w.z, _w.w}); dst[0] = _a.x; dst[1] = _a.y; dst[2] = _a.z; dst[3] = _a.w; dst[4] = _b.x; dst[5] = _b.y; dst[6] = _b.z; dst[7] = _b.w; } while (0)
    LD8(y, Y + off); LD8(rr, Y + (size_t)NTOK * 512 + off);
#pragma unroll
    for (int j = 0; j < 8; ++j) y[j] += rr[j];
    LD8H(rr, R + off); LD8H(kr, KR + off); LD8H(vv, VV + off); LD8H(a0, AA + off); LD8H(a1, AA + (size_t)NTOK * 512 + off); LD8H(gg, G + off);
    LD8(ka, k_a + c); LD8(rk, r_k + c); LD8(lg, lng + c); LD8(lb, lnb + c);
#undef LD8
#undef LD8H
    float s = 0.f, d0 = 0.f, d1 = 0.f;
#pragma unroll
    for (int j = 0; j < 8; ++j) { s += y[j]; const float q = rr[j] * kr[j] * rk[j]; d0 += q * (1.f + (a0[j] - 1.f) * ka[j]); d1 += q * (1.f + (a1[j] - 1.f) * ka[j]); }
    float bd = d0 + d1;
    s += __shfl_xor(s, 1); s += __shfl_xor(s, 2); s += __shfl_xor(s, 4);
    bd += __shfl_xor(bd, 1); bd += __shfl_xor(bd, 2); bd += __shfl_xor(bd, 4);
    const float mu = s * (1.f / 64.f);
    float q2 = 0.f;
#pragma unroll
    for (int j = 0; j < 8; ++j) { y[j] -= mu; q2 += y[j] * y[j]; }
    q2 += __shfl_xor(q2, 1); q2 += __shfl_xor(q2, 2); q2 += __shfl_xor(q2, 4);
    const float rs = rsqrtf(q2 * (1.f / 64.f) + GN_EPS);
    float o[8];
#pragma unroll
    for (int j = 0; j < 8; ++j) o[j] = (y[j] * rs * lg[j] + lb[j] + bd * vv[j]) * gg[j];
    *(u32x4*)(MIX + (size_t)r * D + 512 + c) = (u32x4){pk2(o[0], o[1]), pk2(o[2], o[3]), pk2(o[4], o[5]), pk2(o[6], o[7])};
}

DI void act_fix(KP p, int idx) {
    const float* EDGE = (const float*)(p->ws + WS_EDGE); bf16_t* ACT = (bf16_t*)(p->ws + WS_ACT); const float* wc = p->in[27];
    const int c = (idx % 352) * 8, e = (idx / 352) & 1, pm = 16 + idx / 704;
    const bool need = e == 0 ? (pm != 16 && pm != 24) : (pm != 23 && pm != 31);
    if (!need) return;
    const int r = pm * 256 + (e ? 255 : 0), nbpm = e ? pm + 1 : pm - 1;
    const float* nb = EDGE + ((size_t)nbpm * 2 + (1 - e)) * DFF + c;
    const float* eu = EDGE + ((size_t)pm * 2 + e) * DFF + 64 * DFF + c; const float* e3 = eu + 64 * DFF;
    const float* w = wc + (e ? 2 * DFF : 0) + c;
    float o[8];
#pragma unroll
    for (int j = 0; j < 8; ++j) o[j] = silu_f(eu[j] + w[j] * nb[j]) * e3[j];
    *(u32x4*)(ACT + (size_t)r * DFF + c) = (u32x4){pk2(o[0], o[1]), pk2(o[2], o[3]), pk2(o[4], o[5]), pk2(o[6], o[7])};
}

template <int NR>
DI void final_rows(KP p, int rbase, int rstride, int lane) {
    const float* MODb = (const float*)(p->ws + WS_MOD);
    const bf16_t* PART = (const bf16_t*)(p->ws + WS_PART); const float* nf = p->in[29];
    f32x4 v[NR][4]; u32x2 p0[NR][4], p1[NR][4];
#pragma unroll
    for (int q = 0; q < NR; ++q) { const int r = rbase + q * rstride; const f32x4* xr = (const f32x4*)(p->out + (size_t)r * D) + lane;
#pragma unroll
        for (int j = 0; j < 4; ++j) { v[q][j] = xr[64 * j]; p0[q][j] = *((const u32x2*)(PART + (size_t)r * D) + lane + 64 * j); p1[q][j] = *((const u32x2*)(PART + (size_t)(NTOK + r) * D) + lane + 64 * j); } }
    float s[NR];
#pragma unroll
    for (int q = 0; q < NR; ++q) { const int r = rbase + q * rstride; const float* MOD = MODb + midx_of(r) * 6144; s[q] = 0.f;
#pragma unroll
        for (int j = 0; j < 4; ++j) { const f32x4 gt = *((const f32x4*)(MOD + 5 * D) + lane + 64 * j); v[q][j] = v[q][j] + gt * (unpk4(p0[q][j]) + unpk4(p1[q][j]));
            s[q] += (v[q][j].x * v[q][j].x + v[q][j].y * v[q][j].y) + (v[q][j].z * v[q][j].z + v[q][j].w * v[q][j].w); } }
#pragma unroll
    for (int o = 1; o < 64; o <<= 1) {
#pragma unroll
        for (int q = 0; q < NR; ++q) s[q] += __shfl_xor(s[q], o); }
#pragma unroll
    for (int q = 0; q < NR; ++q) { const int r = rbase + q * rstride; f32x4* xr = (f32x4*)(p->out + (size_t)r * D) + lane; const float rstd = rsqrtf(s[q] * (1.f / D) + EPS);
#pragma unroll
        for (int j = 0; j < 4; ++j) xr[64 * j] = v[q][j] * rstd * *((const f32x4*)nf + lane + 64 * j); }
}

DI int lane_id() { int l; asm volatile("v_mbcnt_lo_u32_b32 %0, -1, 0\n\tv_mbcnt_hi_u32_b32 %0, -1, %0" : "=v"(l)); return l; }
DI void grid_bar(unsigned* bar, unsigned nbar, int G, int bx, int wave_s) {
    __syncthreads();
    int t = wave_s * 64 + lane_id(); asm volatile("" : "+v"(t));
    if (t == 0) {
        __atomic_thread_fence(__ATOMIC_RELEASE);
        if ((G & 7) == 0) {
            const unsigned gsz = (unsigned)G >> 3;
            const unsigned old = __hip_atomic_fetch_add(bar + 64 + 64 * (bx & 7), 1u, __ATOMIC_RELAXED, __HIP_MEMORY_SCOPE_AGENT);
            if (old + 1 == gsz * nbar) __hip_atomic_fetch_add(bar, 1u, __ATOMIC_RELAXED, __HIP_MEMORY_SCOPE_AGENT);
            while (__hip_atomic_load(bar, __ATOMIC_RELAXED, __HIP_MEMORY_SCOPE_AGENT) < 8u * nbar) __builtin_amdgcn_s_sleep(1);
        } else {
            __hip_atomic_fetch_add(bar, 1u, __ATOMIC_RELAXED, __HIP_MEMORY_SCOPE_AGENT);
            while (__hip_atomic_load(bar, __ATOMIC_RELAXED, __HIP_MEMORY_SCOPE_AGENT) < (unsigned)G * nbar) __builtin_amdgcn_s_sleep(1);
        }
        __atomic_thread_fence(__ATOMIC_ACQUIRE);
    }
    __syncthreads();
}

__global__ void __launch_bounds__(512, 2) fwd_megakernel(Params kparams) {
    const KP kp0 = (KP)__builtin_amdgcn_kernarg_segment_ptr();
    extern __shared__ __attribute__((aligned(16))) unsigned char lds_raw[];
    LAS unsigned char* lds = (LAS unsigned char*)lds_raw;
    unsigned nbar = 0;
    const int wave_s = __builtin_amdgcn_readfirstlane((int)threadIdx.x >> 6);
#define GRID_SYNC() do { ++nbar; grid_bar((unsigned*)(kp0->ws + WS_BAR), nbar, G, bx, wave_s); } while (0)
    const int G = gridDim.x, bx = blockIdx.x, NGW = G * 8, NGT = G * 512;
#define PH_VARS KP p = kp0; asm volatile("" : "+s"(p)); unsigned char* ws = p->ws; (void)ws; \
    int tid = wave_s * 64 + lane_id(); asm volatile("" : "+v"(tid)); const int lane = tid & 63, wave = wave_s, gw = bx * 8 + wave, gtid = bx * 512 + tid; (void)lane; (void)gw; (void)gtid;

    const bool defer_ffn = (G == 256);
    { PH_VARS phase0(p, lds, gw, NGW, gtid, NGT, wave, lane, defer_ffn); }
    cg::this_grid().sync();
    { PH_VARS for (int r = gw; r < NTOK; r += 4 * NGW) norm_rows<0, 4>(p, r, NGW, lane, p->in[9], 0, D, 0, (bf16_t*)(ws + WS_H), nullptr); }
    GRID_SYNC();
    {
        PH_VARS
        pg8::Gemm g{(const bf16_t*)(ws + WS_H), (const bf16_t*)(ws + WS_WTIN), D, D, D};
        pg8::SchedPlain S; S.o.init(NTOK / 256, NINP / 256, G, bx);
        pg8::EpiIn E{(bf16_t*)(ws + WS_Q), (bf16_t*)(ws + WS_ZR), p->out + OUT_K, 0.125f * LOG2E};
        pg8::gemm_phase(lds, g, S, E, tid);
        if (defer_ffn && bx >= 192) ffn_transposes(p, lds, 0, (bx - 192) * 8 + wave, 64 * 8, wave, lane);
    }
    GRID_SYNC();
    {
        PH_VARS
        LAS float* rpbL = (LAS float*)lds;
        for (int i = tid; i < 8 * 465; i += 512) rpbL[i] = p->in[23][i] * LOG2E;
        __syncthreads();
        LAS unsigned char* vbuf = lds + 16384 + wave * 4608;
        LAS float* xch = (LAS float*)(lds + 65536) + (wave & 3) * 2176;
        for (int u0 = bx * 4; u0 < 1024; u0 += G * 4) {
            if (wave < 4) { attn_unit<true, 2>(p, vbuf, rpbL, u0 + wave, lane, 0, 16, xch); attn_unit<false, 0>(p, vbuf, rpbL, u0 + wave, lane, 0, 8, xch); }
            else { attn_unit<true, 1>(p, vbuf, rpbL, u0 + wave - 4, lane, 16, 32, xch); prep_rows8(p, (u0 + wave - 4) * 8, lane); }
            __syncthreads();
        }
    }
    GRID_SYNC();
    {
        PH_VARS
        int kl = 128; asm volatile("" : "+s"(kl));
        pg8::Gemm g{(const bf16_t*)(ws + WS_ALORA), (const bf16_t*)(ws + WS_WTLORA), kl, 128, 128};
        pg8::SchedLora S; S.G = G; S.c = bx;
        pg8::EpiLora E{(float*)(ws + WS_DEC), (float*)(ws + WS_AA), (float*)(ws + WS_G), p->in[13], p->in[15]};
        pg8::gemm_phase(lds, g, S, E, tid);
        if (defer_ffn && bx >= 64) ffn_transposes(p, lds, 1, (bx - 64) * 8 + wave, 192 * 8, wave, lane);
    }
    GRID_SYNC();
    {
        int nst = 2; asm volatile("" : "+s"(nst));
        const int nl = G > 64 ? 32 : 0;
        for (int st = 0; st < nst; ++st) {
            PH_VARS
            const bool lead = bx < nl;
            if (st == 0 || !lead) cs_phaseA(p, lds, tid, st ? CS_LAT : 0, CS_LAT / 2, st ? bx - nl : bx, st ? G - nl : G);
            if (st == 0) { GRID_SYNC(); continue; }
            if (!lead) {
                unsigned* sb = (unsigned*)(kp0->ws + WS_BAR) + 640;
                __syncthreads();
                if (tid == 0) { __atomic_thread_fence(__ATOMIC_RELEASE); __hip_atomic_fetch_add(sb, 1u, __ATOMIC_RELAXED, __HIP_MEMORY_SCOPE_AGENT);
                    while (__hip_atomic_load(sb, __ATOMIC_RELAXED, __HIP_MEMORY_SCOPE_AGENT) < (unsigned)(G - nl)) __builtin_amdgcn_s_sleep(1);
                    __atomic_thread_fence(__ATOMIC_ACQUIRE); }
                __syncthreads();
            }
            const int tfirst = lead ? bx : (nl ? 32 + (bx - nl) : bx), tend = lead ? 32 : 288, tstride = lead ? 32 : (G - nl);
            for (int t = tfirst; t < tend; t += tstride) cs_phaseB(p, lds, t < 32 ? 1 : 0, t < 32 ? t : t - 32, tid);
        }
    }
    GRID_SYNC();
    { PH_VARS for (int r = gw; r < NTOK; r += NGW) post_row(p, r, lane); }
    GRID_SYNC();
    {
        PH_VARS
        pg8::Gemm g{(const bf16_t*)(ws + WS_MIX), (const bf16_t*)(ws + WS_WTOUT), 512, D, D};
        pg8::SchedSplit2 S; S.o.init(NTOK / 256, 8, G, bx); S.nN = 4; S.ksplit = 512;
        pg8::EpiPart E{(bf16_t*)(ws + WS_PART), 512};
        pg8::gemm_phase(lds, g, S, E, tid);
    }
    GRID_SYNC();
    { PH_VARS for (int r = gw; r < NTOK; r += 2 * NGW) norm_rows<1, 2>(p, r, NGW, lane, p->in[10], 3 * D, 4 * D, 2 * D, (bf16_t*)(ws + WS_H), p->out); }
    GRID_SYNC();
    {
        PH_VARS
        pg8::Gemm g{(const bf16_t*)(ws + WS_H), (const bf16_t*)(ws + WS_WT13), D, D, D};
        pg8::SchedPlain S; S.o.init(NTOK / 256, 2 * DFF / 256, G, bx);
        pg8::EpiFfnAct E{(bf16_t*)(ws + WS_ACT), (float*)(ws + WS_EDGE), p->in[27], lds};
        pg8::gemm_phase(lds, g, S, E, tid);
    }
    GRID_SYNC();
    { PH_VARS for (int i = gtid; i < 16 * 704; i += NGT) act_fix(p, i); }
    GRID_SYNC();
    {
        PH_VARS
        pg8::Gemm g{(const bf16_t*)(ws + WS_ACT), (const bf16_t*)(ws + WS_WT2), DFF / 2, DFF, DFF};
        pg8::SchedSplit2 S; S.o.init(NTOK / 256, 8, G, bx); S.nN = 4; S.ksplit = DFF / 2;
        pg8::EpiPart E{(bf16_t*)(ws + WS_PART), DFF / 2};
        pg8::gemm_phase(lds, g, S, E, tid);
    }
    GRID_SYNC();
    { PH_VARS for (int r = gw; r < NTOK; r += 2 * NGW) final_rows<2>(p, r, NGW, lane); }
}

extern "C" void kernel_launch(void* const* d_in, const int* in_sizes, int n_in, void* d_out, int out_size, void* d_ws, size_t ws_size, hipStream_t stream) {
    static int grid_blocks = 0;
    if (!grid_blocks) {
        int dev = 0, cus = 0, per_cu = 0;
        (void)hipGetDevice(&dev);
        (void)hipDeviceGetAttribute(&cus, hipDeviceAttributeMultiprocessorCount, dev);
        (void)hipFuncSetAttribute((const void*)fwd_megakernel, hipFuncAttributeMaxDynamicSharedMemorySize, LDS_BYTES);
        (void)hipOccupancyMaxActiveBlocksPerMultiprocessor(&per_cu, (const void*)fwd_megakernel, 512, LDS_BYTES);
        if (per_cu < 1) per_cu = 1;
        grid_blocks = cus * per_cu;
    }
    (void)hipMemsetAsync((char*)d_ws + WS_BAR, 0, 4096, stream);
    Params p{};
    for (int i = 0; i < 30; ++i) p.in[i] = (const float*)d_in[i];
    p.out = (float*)d_out; p.ws = (unsigned char*)d_ws;
    void* args[] = {&p};
    hipError_t e = hipLaunchCooperativeKernel((const void*)fwd_megakernel, dim3(grid_blocks), dim3(512), args, LDS_BYTES, stream);
    if (e != hipSuccess) fprintf(stderr, "cooperative launch failed: %s (grid %d)\n", hipGetErrorString(e), grid_blocks);
}
```

```cpp
#include <hip/hip_runtime.h>
#include <hip/hip_cooperative_groups.h>
#include <cstdio>
#include <cstdint>
namespace cg = cooperative_groups;

#define LAS __attribute__((address_space(3)))
typedef unsigned short bf16_t;
typedef short bf16x8 __attribute__((ext_vector_type(8)));
typedef short s16x4 __attribute__((ext_vector_type(4)));
typedef float f32x2 __attribute__((ext_vector_type(2)));
typedef float f32x4 __attribute__((ext_vector_type(4)));
typedef float f32x16 __attribute__((ext_vector_type(16)));
typedef unsigned u32x2 __attribute__((ext_vector_type(2)));
typedef unsigned u32x4 __attribute__((ext_vector_type(4)));
typedef __bf16 bf16x2_t __attribute__((ext_vector_type(2)));
#define DI __device__ __forceinline__

constexpr int D = 1024, NTOK = 8192, NCTX = 4096, SEQ = 256, DSEQ = 2048;
constexpr int NIN = 3456, NINP = 3584, RC = 1920, DFF = 2816;
constexpr float EPS = 1e-6f, GN_EPS = 64e-5f;
constexpr float LOG2E = 1.4426950408889634f;
constexpr size_t MiB = 1u << 20;
constexpr size_t WS_BAR = 128 * 1024, WS_MOD = 0, WS_WTIN = 1 * MiB, WS_WTOUT = 8 * MiB, WS_WT13 = 10 * MiB, WS_WT2 = 21 * MiB, WS_WTLORA = 27 * MiB,
                 WS_H = 28 * MiB, WS_Q = 44 * MiB, WS_K = 52 * MiB, WS_V = 60 * MiB, WS_R = 68 * MiB, WS_VV = 84 * MiB, WS_KK = 100 * MiB,
                 WS_KR = 116 * MiB, WS_ALORA = 132 * MiB, WS_MIX = 138 * MiB, WS_ZR = 154 * MiB, WS_DEC = 154 * MiB, WS_AA = 186 * MiB,
                 WS_G = 218 * MiB, WS_CK = 234 * MiB, WS_CV = 235 * MiB, WS_Y = 28 * MiB, WS_PART = 176 * MiB, WS_A1 = 44 * MiB,
                 WS_A3 = 88 * MiB, WS_ACT = 132 * MiB, WS_EDGE = 250 * MiB;
constexpr size_t OUT_K = (size_t)NTOK * D, OUT_V = OUT_K + (size_t)NCTX * 512, OUT_S = OUT_V + (size_t)NCTX * 512;
constexpr int LDS_BYTES = 135168;

struct Params { const float* in[30]; float* out; unsigned char* ws; };
typedef const __attribute__((address_space(4))) Params* KP;

DI unsigned pk2(float lo, float hi) { f32x2 v = {lo, hi}; bf16x2_t b = __builtin_convertvector(v, bf16x2_t); return __builtin_bit_cast(unsigned, b); }
DI f32x4 unpk4(u32x2 w) { return (f32x4){__builtin_bit_cast(float, w.x << 16), __builtin_bit_cast(float, w.x & 0xffff0000u), __builtin_bit_cast(float, w.y << 16), __builtin_bit_cast(float, w.y & 0xffff0000u)}; }
DI f32x2 ldh2(const bf16_t* p) { const unsigned w = *(const unsigned*)p; return (f32x2){__builtin_bit_cast(float, w << 16), __builtin_bit_cast(float, w & 0xffff0000u)}; }
DI float bf2f(unsigned short u) { return __builtin_bit_cast(float, (unsigned)u << 16); }
DI float wave_sum(float v) {
#pragma unroll
    for (int o = 1; o < 64; o <<= 1) v += __shfl_xor(v, o);
    return v;
}
DI float sigmoid_f(float x) { return __builtin_amdgcn_rcpf(1.f + __builtin_amdgcn_exp2f(-1.4426950408889634f * x)); }
DI float silu_f(float x) { return x * sigmoid_f(x); }
DI float tanh_f(float x) { return 2.f * sigmoid_f(2.f * x) - 1.f; }
DI int midx_of(int r) { return r < NCTX ? 0 : 1 + ((r - NCTX) >> 11); }
DI const float* xrow_of(KP p, int r) { return r < NCTX ? p->in[0] + (size_t)r * D : p->in[1] + (size_t)(r - NCTX) * D; }

namespace pg8 {
constexpr int BM = 256, BK = 64, HALF = 128, HTB = HALF * BK * 2, NXCD = 8, WGM = 8;
__host__ __device__ __forceinline__ int lds_byte(int r, int c) { const int st = (r >> 4) * 2 + (c >> 5), rr = r & 15, cc = c & 31, ob = rr * 64 + cc * 2; return st * 1024 + (ob ^ (((ob >> 9) & 1) << 5)); }
__host__ __device__ __forceinline__ void stage_rc(int b, int& R, int& C) { const int st = b / 1024, sb = b % 1024, swz = sb ^ (((sb >> 9) & 1) << 5); R = (st >> 1) * 16 + swz / 64; C = (st & 1) * 32 + (swz % 64) / 2; }
__host__ __device__ __forceinline__ int perm32(int rho) { const int n = rho >> 4, i = rho & 15; return 8 * (i >> 2) + 4 * n + (i & 3); }
struct Unit { int pm, pn; int aoff, boff; };
struct Gemm { const bf16_t* A; const bf16_t* Bt; int K, lda, ldb; };
struct StaticOrder {
    int nM, nN, nwg, G, c;
    __device__ void init(int nM_, int nN_, int G_, int c_) { nM = nM_; nN = nN_; nwg = nM * nN; G = G_; c = c_; }
    __device__ bool next2(int i, int& pm, int& pn) const {
        const long L = (long)i * G + c; if (L >= nwg) return false;
        int wgid = (int)L; { const int q = nwg / NXCD, r = nwg % NXCD, xcd = wgid % NXCD, off = wgid / NXCD; wgid = (xcd < r ? xcd * (q + 1) : r * (q + 1) + (xcd - r) * q) + off; }
        const int nig = WGM * nN, gid = wgid / nig, fm = gid * WGM, gsz = (nM - fm) < WGM ? (nM - fm) : WGM;
        pm = fm + ((wgid % nig) % gsz); pn = (wgid % nig) / gsz; return true;
    }
};
struct SchedPlain { StaticOrder o; __device__ bool next(int i, Unit& u) const { u.aoff = 0; u.boff = 0; return o.next2(i, u.pm, u.pn); } };
struct SchedSplit2 { StaticOrder o; int nN, ksplit;
    __device__ bool next(int i, Unit& u) const { int pn2; if (!o.next2(i, u.pm, pn2)) return false; const int ks = pn2 / nN; u.pn = pn2 - ks * nN; u.aoff = ks * ksplit; u.boff = ks * ksplit; return true; } };
struct SchedLora { int G, c;
    __device__ bool next(int i, Unit& u) const { const int L = i * G + c; if (L >= 320) return false; u.pm = L & 31; u.pn = L >> 5; const int g = u.pn < 4 ? 0 : (u.pn < 8 ? 1 : 2); u.aoff = g * NTOK * 128; u.boff = 0; return true; } };

template <class Epi, class Sched>
__device__ __forceinline__ void gemm_phase(LAS unsigned char* lds, const Gemm g, const Sched& S, const Epi& E, int tid) {
    asm volatile("" : "+v"(tid));
    const int wid = __builtin_amdgcn_readfirstlane(tid >> 6), lane = tid & 63, wr = wid >> 2, wc = wid & 3, fr = lane & 15, fq = lane >> 4;
    const int nt = g.K / BK;
    unsigned voffA[2], voffB[2];
#pragma unroll
    for (int i = 0; i < 2; ++i) { int R, C; stage_rc(tid * 16 + i * 8192, R, C); const int Rb = (R & ~31) + perm32(R & 31);
        voffA[i] = (unsigned)(R * g.lda + C) * 2u; voffB[i] = (unsigned)(Rb * g.ldb + C) * 2u; }
    const size_t kstep = (size_t)(BK * 2);
    const size_t hA = (size_t)HALF * g.lda * 2, hB = (size_t)HALF * g.ldb * 2;
    const unsigned ldsw = (unsigned)wid * 1024u;
    const int aoff = lds_byte(wr * 64 + fr, fq * 8), boff = lds_byte(wc * 32 + fr, fq * 8);
#define PG8_SA(b, h) (((b) * 2 + (h)) * HTB)
#define PG8_SB(b, h) ((4 + (b) * 2 + (h)) * HTB)
#define PG8_STAGE(bufoff, gbase, voff) do { _Pragma("unroll") for (int _i = 0; _i < 2; ++_i) \
        __builtin_amdgcn_global_load_lds((const unsigned*)((const char*)(gbase) + (voff)[_i]), (LAS unsigned*)(lds + (bufoff) + ldsw + _i * 8192), 16, 0, 0); } while (0)
#define PG8_LDA(dst, b, h) do { _Pragma("unroll") for (int m = 0; m < 4; ++m) _Pragma("unroll") for (int k = 0; k < 2; ++k) dst[m][k] = *(const LAS bf16x8*)(lds + PG8_SA(b, h) + aoff + m * 2048 + k * 1024); } while (0)
#define PG8_LDB(dst, b, h) do { _Pragma("unroll") for (int n = 0; n < 2; ++n) _Pragma("unroll") for (int k = 0; k < 2; ++k) dst[n][k] = *(const LAS bf16x8*)(lds + PG8_SB(b, h) + boff + n * 2048 + k * 1024); } while (0)
#define PG8_MMA(ai, bj, At, Bt) do { __builtin_amdgcn_s_setprio(1); _Pragma("unroll") for (int m = 0; m < 4; ++m) _Pragma("unroll") for (int n = 0; n < 2; ++n) _Pragma("unroll") for (int k = 0; k < 2; ++k) \
        acc[ai][bj][m][n] = __builtin_amdgcn_mfma_f32_16x16x32_bf16(Bt[n][k], At[m][k], acc[ai][bj][m][n], 0, 0, 0); __builtin_amdgcn_s_setprio(0); } while (0)
#define PG8_WAIT_V(n) asm volatile("s_waitcnt vmcnt(" #n ")" ::: "memory")
#define PG8_WAIT_L(n) asm volatile("s_waitcnt lgkmcnt(" #n ")" ::: "memory")
#define PG8_BAR __builtin_amdgcn_s_barrier()
#define PG8_SCHED __builtin_amdgcn_sched_barrier(0)
#define PG8_TA(u) ((const char*)g.A + ((size_t)(u).pm * BM * g.lda + (size_t)(u).aoff) * 2)
#define PG8_TB(u) ((const char*)g.Bt + ((size_t)(u).pn * BM * g.ldb + (size_t)(u).boff) * 2)
    Unit cur, nxt; int ui = 0;
    if (!S.next(0, cur)) return;
    f32x4 acc[2][2][4][2];
#pragma unroll
    for (int a = 0; a < 2; ++a)
#pragma unroll
        for (int b = 0; b < 2; ++b)
#pragma unroll
            for (int m = 0; m < 4; ++m)
#pragma unroll
                for (int n = 0; n < 2; ++n) acc[a][b][m][n] = (f32x4){0.f, 0.f, 0.f, 0.f};
    bf16x8 At[4][2], B0[2][2], B1[2][2];
    const char* cA = PG8_TA(cur); const char* cB = PG8_TB(cur);
    PG8_STAGE(PG8_SB(0, 0), cB, voffB); PG8_STAGE(PG8_SB(0, 1), cB + hB, voffB); PG8_STAGE(PG8_SA(0, 0), cA, voffA); PG8_STAGE(PG8_SA(0, 1), cA + hA, voffA);
    if (wr == 1) PG8_BAR;
    PG8_WAIT_V(2); PG8_BAR;
    PG8_STAGE(PG8_SB(1, 0), cB + kstep, voffB); PG8_STAGE(PG8_SA(1, 0), cA + kstep, voffA); PG8_STAGE(PG8_SB(1, 1), cB + hB + kstep, voffB);
    PG8_WAIT_V(6); PG8_BAR;
    for (;;) {
        const bool has_next = S.next(ui + 1, nxt);
        const char* nA = has_next ? PG8_TA(nxt) : cA; const char* nB = has_next ? PG8_TB(nxt) : cB;
        for (int t = 0; t < nt; t += 2) {
            const bool last = (t == nt - 2);
            const char* a1 = cA + (size_t)(t + 1) * kstep;
            const char* a2 = last ? nA : cA + (size_t)(t + 2) * kstep; const char* b2 = last ? nB : cB + (size_t)(t + 2) * kstep;
            const char* a3 = a2 + kstep; const char* b3 = b2 + kstep;
            PG8_LDB(B0, 0, 0); PG8_LDB(B1, 0, 1); PG8_SCHED; PG8_LDA(At, 0, 0); PG8_STAGE(PG8_SA(1, 1), a1 + hA, voffA);
            PG8_WAIT_V(8); PG8_WAIT_L(0); PG8_BAR; PG8_MMA(0, 0, At, B0); PG8_MMA(0, 1, At, B1); PG8_BAR; PG8_SCHED;
            PG8_LDA(At, 0, 1); PG8_STAGE(PG8_SB(0, 0), b2, voffB); PG8_STAGE(PG8_SB(0, 1), b2 + hB, voffB); PG8_STAGE(PG8_SA(0, 0), a2, voffA);
            PG8_WAIT_V(8); PG8_WAIT_L(0); PG8_BAR; PG8_MMA(1, 0, At, B0); PG8_MMA(1, 1, At, B1); PG8_BAR; PG8_SCHED;
            PG8_LDB(B0, 1, 0); PG8_LDB(B1, 1, 1); PG8_SCHED; PG8_LDA(At, 1, 0); PG8_STAGE(PG8_SA(0, 1), a2 + hA, voffA);
            PG8_WAIT_V(8); PG8_WAIT_L(0); PG8_BAR; PG8_MMA(0, 0, At, B0); PG8_MMA(0, 1, At, B1); PG8_BAR; PG8_SCHED;
            PG8_LDA(At, 1, 1); PG8_STAGE(PG8_SB(1, 0), b3, voffB); PG8_STAGE(PG8_SB(1, 1), b3 + hB, voffB); PG8_STAGE(PG8_SA(1, 0), a3, voffA);
            PG8_WAIT_V(8); PG8_WAIT_L(0); PG8_BAR; PG8_MMA(1, 0, At, B0); PG8_MMA(1, 1, At, B1); PG8_BAR; PG8_SCHED;
        }
        E(acc, cur, wr, wc, fr, fq);
        if (!has_next) break;
#pragma unroll
        for (int a = 0; a < 2; ++a)
#pragma unroll
            for (int b = 0; b < 2; ++b)
#pragma unroll
                for (int m = 0; m < 4; ++m)
#pragma unroll
                    for (int n = 0; n < 2; ++n) acc[a][b][m][n] = (f32x4){0.f, 0.f, 0.f, 0.f};
        cur = nxt; cA = nA; cB = nB; ++ui;
    }
    PG8_WAIT_V(0);
    if (wr == 0) PG8_BAR;
    PG8_BAR;
#undef PG8_SA
#undef PG8_SB
#undef PG8_STAGE
#undef PG8_LDA
#undef PG8_LDB
#undef PG8_MMA
#undef PG8_WAIT_V
#undef PG8_WAIT_L
#undef PG8_BAR
#undef PG8_SCHED
#undef PG8_TA
#undef PG8_TB
}

struct EpiIn {
    bf16_t *Q; bf16_t* ZR; float* outK; float qscale;
    __device__ __forceinline__ void operator()(const f32x4 (&acc)[2][2][4][2], const Unit& u, int wr, int wc, int fr, int fq) const {
#pragma unroll
        for (int bj = 0; bj < 2; ++bj) {
            const int c0 = u.pn * BM + bj * HALF + wc * 32 + 8 * fq;
            if (c0 >= NIN) continue;
#pragma unroll
            for (int ai = 0; ai < 2; ++ai)
#pragma unroll
                for (int m = 0; m < 4; ++m) {
                    int r = u.pm * BM + ai * HALF + wr * 64 + m * 16 + fr; asm volatile("" : "+v"(r));
                    f32x4 v0 = acc[ai][bj][m][0], v1 = acc[ai][bj][m][1];
                    if (c0 < 1536) {
                        const int seg = c0 >> 9, cc = c0 & 511;
                        if (seg == 0) { v0 = v0 * qscale; v1 = v1 * qscale; }
                        else if (r < NCTX) { float* o = outK + (size_t)(seg - 1) * ((size_t)NCTX * 512) + (size_t)r * 512 + cc; *(f32x4*)o = v0; *(f32x4*)(o + 4) = v1; }
                        bf16_t* dst = Q + (size_t)seg * ((size_t)NTOK * 512) + (size_t)r * 512 + cc;
                        u32x4 w; w.x = pk2(v0[0], v0[1]); w.y = pk2(v0[2], v0[3]); w.z = pk2(v1[0], v1[1]); w.w = pk2(v1[2], v1[3]);
                        *(u32x4*)dst = w;
                    } else {
                        u32x4 w; w.x = pk2(v0[0], v0[1]); w.y = pk2(v0[2], v0[3]); w.z = pk2(v1[0], v1[1]); w.w = pk2(v1[2], v1[3]);
                        *(u32x4*)(ZR + (size_t)r * RC + (c0 - 1536)) = w;
                    }
                }
        }
    }
};
DI float decay1(float x) { return __expf(-0.60653065971f * sigmoid_f(x)); }
struct EpiLora {
    float *DEC, *AA, *G; const float *w0, *a0;
    __device__ __forceinline__ void operator()(const f32x4 (&acc)[2][2][4][2], const Unit& u, int wr, int wc, int fr, int fq) const {
#pragma unroll
        for (int bj = 0; bj < 2; ++bj) {
            const int c0 = u.pn * BM + bj * HALF + wc * 32 + 8 * fq;
            const int grp = c0 >> 10, cg = c0 & 1023, dir = cg >> 9, cc = cg & 511;
            const float* bp = (grp == 0 ? w0 : a0) + dir * 512 + cc;
            float* ob = DEC + (size_t)dir * NTOK * 512 + cc;
            bf16_t* obh = grp == 2 ? (bf16_t*)G + cc : (bf16_t*)AA + (size_t)dir * NTOK * 512 + cc;
#pragma unroll
            for (int ai = 0; ai < 2; ++ai)
#pragma unroll
                for (int m = 0; m < 4; ++m) {
                    int r = u.pm * BM + ai * HALF + wr * 64 + m * 16 + fr; asm volatile("" : "+v"(r));
                    f32x4 v0 = acc[ai][bj][m][0], v1 = acc[ai][bj][m][1];
                    if (grp < 2) { const float* bq = bp; asm volatile("" : "+v"(bq)); v0 += *(const f32x4*)bq; v1 += *(const f32x4*)(bq + 4); }
                    if (grp == 0) { v0.x = decay1(v0.x); v0.y = decay1(v0.y); v0.z = decay1(v0.z); v0.w = decay1(v0.w); v1.x = decay1(v1.x); v1.y = decay1(v1.y); v1.z = decay1(v1.z); v1.w = decay1(v1.w); }
                    else if (grp == 1) { v0.x = sigmoid_f(v0.x); v0.y = sigmoid_f(v0.y); v0.z = sigmoid_f(v0.z); v0.w = sigmoid_f(v0.w); v1.x = sigmoid_f(v1.x); v1.y = sigmoid_f(v1.y); v1.z = sigmoid_f(v1.z); v1.w = sigmoid_f(v1.w); }
                    if (grp == 0) { float* o = ob + (size_t)r * 512; *(f32x4*)o = v0; *(f32x4*)(o + 4) = v1; }
                    else { u32x4 w; w.x = pk2(v0[0], v0[1]); w.y = pk2(v0[2], v0[3]); w.z = pk2(v1[0], v1[1]); w.w = pk2(v1[2], v1[3]); *(u32x4*)(obh + (size_t)r * 512) = w; }
                }
        }
    }
};
struct EpiPart {
    bf16_t* P; int ksplit;
    __device__ __forceinline__ void operator()(const f32x4 (&acc)[2][2][4][2], const Unit& u, int wr, int wc, int fr, int fq) const {
        bf16_t* base = P + (u.aoff ? (size_t)NTOK * D : 0);
#pragma unroll
        for (int bj = 0; bj < 2; ++bj) {
            const int c0 = u.pn * BM + bj * HALF + wc * 32 + 8 * fq;
#pragma unroll
            for (int ai = 0; ai < 2; ++ai)
#pragma unroll
                for (int m = 0; m < 4; ++m) {
                    int r = u.pm * BM + ai * HALF + wr * 64 + m * 16 + fr; asm volatile("" : "+v"(r));
                    const f32x4 v0 = acc[ai][bj][m][0], v1 = acc[ai][bj][m][1];
                    u32x4 w; w.x = pk2(v0[0], v0[1]); w.y = pk2(v0[2], v0[3]); w.z = pk2(v1[0], v1[1]); w.w = pk2(v1[2], v1[3]);
                    *(u32x4*)(base + (size_t)r * D + c0) = w;
                }
        }
    }
};
template <int CTRL> DI float dppf(float x) { return __builtin_bit_cast(float, __builtin_amdgcn_mov_dpp(__builtin_bit_cast(int, x), CTRL, 0xf, 0xf, true)); }
struct EpiFfnAct {
    bf16_t* ACT; float* EDGE; const float* wcv; LAS unsigned char* ldsb;
    __device__ __forceinline__ void operator()(const f32x4 (&acc)[2][2][4][2], const Unit& u, int wr, int wc, int fr, int fq) const {
        LAS float* HL = (LAS float*)(ldsb + 131072);
        const int colh = wc * 32 + 8 * fq;
#pragma unroll
        for (int ai = 0; ai < 2; ++ai) { const int g = ai * 2 + wr;
            if (fr == 0) { *(LAS f32x4*)(HL + (g * 2 + 0) * 128 + colh) = acc[ai][0][0][0]; *(LAS f32x4*)(HL + (g * 2 + 0) * 128 + colh + 4) = acc[ai][0][0][1]; }
            if (fr == 15) { *(LAS f32x4*)(HL + (g * 2 + 1) * 128 + colh) = acc[ai][0][3][0]; *(LAS f32x4*)(HL + (g * 2 + 1) * 128 + colh + 4) = acc[ai][0][3][1]; } }
        asm volatile("s_waitcnt lgkmcnt(0)" ::: "memory");
        __builtin_amdgcn_s_barrier(); __builtin_amdgcn_s_barrier();
        asm volatile("" ::: "memory");
        const int cf = u.pn * HALF + colh;
        const f32x4 zero = {0.f, 0.f, 0.f, 0.f};
        const bool lat = u.pm >= 16;
#pragma unroll
        for (int ai = 0; ai < 2; ++ai) {
            const int g = ai * 2 + wr;
            f32x4 hp[2], hn[2];
            hp[0] = g > 0 ? *(const LAS f32x4*)(HL + ((g - 1) * 2 + 1) * 128 + colh) : zero; hp[1] = g > 0 ? *(const LAS f32x4*)(HL + ((g - 1) * 2 + 1) * 128 + colh + 4) : zero;
            hn[0] = g < 3 ? *(const LAS f32x4*)(HL + ((g + 1) * 2 + 0) * 128 + colh) : zero; hn[1] = g < 3 ? *(const LAS f32x4*)(HL + ((g + 1) * 2 + 0) * 128 + colh + 4) : zero;
#pragma unroll
            for (int m = 0; m < 4; ++m) {
                int r = u.pm * BM + ai * HALF + wr * 64 + m * 16 + fr; asm volatile("" : "+v"(r));
                const float* wq_ = wcv + cf; asm volatile("" : "+v"(wq_));
                f32x4 uu[2], av[2];
#pragma unroll
                for (int n = 0; n < 2; ++n) {
                    const f32x4 cur = acc[ai][0][m][n];
                    f32x4 pv, nx;
#pragma unroll
                    for (int j = 0; j < 4; ++j) {
                        if (m > 0) pv[j] = dppf<0x121>(fr == 15 ? acc[ai][0][m > 0 ? m - 1 : 0][n][j] : cur[j]);
                        else { const float a = dppf<0x121>(cur[j]); pv[j] = fr == 0 ? hp[n][j] : a; }
                        if (m < 3) nx[j] = dppf<0x12F>(fr == 0 ? acc[ai][0][m < 3 ? m + 1 : 3][n][j] : cur[j]);
                        else { const float c = dppf<0x12F>(cur[j]); nx[j] = fr == 15 ? hn[n][j] : c; }
                    }
                    const f32x4 w0 = *(const f32x4*)(wq_ + 4 * n), w1 = *(const f32x4*)(wq_ + DFF + 4 * n), w2 = *(const f32x4*)(wq_ + 2 * DFF + 4 * n);
                    uu[n] = pv * w0 + cur * w1 + nx * w2;
                    const f32x4 a3 = acc[ai][1][m][n];
                    av[n] = (f32x4){silu_f(uu[n].x) * a3.x, silu_f(uu[n].y) * a3.y, silu_f(uu[n].z) * a3.z, silu_f(uu[n].w) * a3.w};
                }
                u32x4 w; w.x = pk2(av[0][0], av[0][1]); w.y = pk2(av[0][2], av[0][3]); w.z = pk2(av[1][0], av[1][1]); w.w = pk2(av[1][2], av[1][3]);
                *(u32x4*)(ACT + (size_t)r * DFF + cf) = w;
                if (lat && ((ai == 0 && m == 0) || (ai == 1 && m == 3))) {
                    const int e = ai;
                    const bool mine = e == 0 ? (wr == 0 && fr == 0) : (wr == 1 && fr == 15);
                    if (mine) {
                        float* eb = EDGE + ((size_t)u.pm * 2 + e) * DFF + cf;
                        *(f32x4*)(eb) = acc[ai][0][m][0]; *(f32x4*)(eb + 4) = acc[ai][0][m][1];
                        *(f32x4*)(eb + 64 * DFF) = uu[0]; *(f32x4*)(eb + 64 * DFF + 4) = uu[1];
                        *(f32x4*)(eb + 128 * DFF) = acc[ai][1][m][0]; *(f32x4*)(eb + 128 * DFF + 4) = acc[ai][1][m][1];
                    }
                }
            }
        }
    }
};
}

template <int MODE>
DI void transpose_item(const float* W, int K, int N, bf16_t* WT, LAS float* scr, int item, int lane) {
    const int nblk = N / 32, kb = item / nblk, nb = item % nblk, k0 = 64 * kb, n0 = 32 * nb;
#pragma unroll 8
    for (int i = 0; i < 32; ++i) { const int kk = 2 * i + (lane >> 5); scr[kk * 33 + (lane & 31)] = W[(size_t)(k0 + kk) * N + n0 + (lane & 31)]; }
    asm volatile("s_waitcnt lgkmcnt(0)" ::: "memory");
    const int c = lane & 7;
#pragma unroll
    for (int j = 0; j < 4; ++j) { const int n = (lane >> 3) + 8 * j; const LAS float* s = scr + (8 * c) * 33 + n;
        u32x4 o; o.x = pk2(s[0 * 33], s[1 * 33]); o.y = pk2(s[2 * 33], s[3 * 33]); o.z = pk2(s[4 * 33], s[5 * 33]); o.w = pk2(s[6 * 33], s[7 * 33]);
        const int nn = n0 + n; const int drow = MODE == 0 ? nn : ((nn >> 7) * 256 + (nn & 127) + (MODE == 2 ? 128 : 0));
        *(u32x4*)(WT + (size_t)drow * K + k0 + 8 * c) = o; }
    asm volatile("s_waitcnt lgkmcnt(0)" ::: "memory");
}

DI void phase0(KP p, LAS unsigned char* lds, int gw, int NGW, int gtid, int NGT, int wave, int lane, bool defer_ffn) {
    unsigned char* ws = p->ws;
    {
        float* MOD = (float*)(ws + WS_MOD);
        const float* w_ada = p->in[7]; const float* b_ada = p->in[8]; const float* c_lat = p->in[5]; const float* c_ctx = p->in[6];
        LAS float* red = (LAS float*)(lds + 8 * 8448);
        const int tid = wave * 64 + lane, cgp = lane & 15, kr = lane >> 4;
        for (int nb = blockIdx.x; nb < 96; nb += gridDim.x) {
            f32x4 a0 = {0, 0, 0, 0}, a1 = a0, a2 = a0;
#pragma unroll 8
            for (int i = 0; i < 32; ++i) {
                const int k = wave * 128 + 4 * i + kr;
                const f32x4 w = *(const f32x4*)(w_ada + (size_t)k * 6144 + nb * 64 + 4 * cgp);
                a0 += w * silu_f(c_ctx[k]); a1 += w * silu_f(c_lat[k]); a2 += w * silu_f(c_lat[D + k]);
            }
#pragma unroll
            for (int j = 0; j < 4; ++j) {
                a0[j] += __shfl_xor(a0[j], 16); a0[j] += __shfl_xor(a0[j], 32);
                a1[j] += __shfl_xor(a1[j], 16); a1[j] += __shfl_xor(a1[j], 32);
                a2[j] += __shfl_xor(a2[j], 16); a2[j] += __shfl_xor(a2[j], 32);
            }
            if (kr == 0) { *(LAS f32x4*)(red + (wave * 3 + 0) * 64 + 4 * cgp) = a0; *(LAS f32x4*)(red + (wave * 3 + 1) * 64 + 4 * cgp) = a1; *(LAS f32x4*)(red + (wave * 3 + 2) * 64 + 4 * cgp) = a2; }
            __syncthreads();
            if (tid < 192) {
                const int i = tid >> 6, c = tid & 63; float s = b_ada[nb * 64 + c];
#pragma unroll
                for (int w = 0; w < 8; ++w) s += red[(w * 3 + i) * 64 + c];
                MOD[i * 6144 + nb * 64 + c] = s;
            }
            __syncthreads();
        }
    }
    {
        LAS float* scr = (LAS float*)(lds + wave * 8448);
        constexpr int I_IN = 16 * 108, I_OUT = 16 * 32, I_F = 16 * 88, I_2 = 44 * 32, NIT = I_IN + I_OUT + 2 * I_F + I_2;
        const int nit = defer_ffn ? I_IN + I_OUT : NIT;
        for (int it = gw; it < nit; it += NGW) {
            int r = it;
            if (r < I_IN) { transpose_item<0>(p->in[11], D, NIN, (bf16_t*)(ws + WS_WTIN), scr, r, lane); continue; } r -= I_IN;
            if (r < I_OUT) { transpose_item<0>(p->in[24], D, D, (bf16_t*)(ws + WS_WTOUT), scr, r, lane); continue; } r -= I_OUT;
            if (r < I_F) { transpose_item<1>(p->in[25], D, DFF, (bf16_t*)(ws + WS_WT13), scr, r, lane); continue; } r -= I_F;
            if (r < I_F) { transpose_item<2>(p->in[26], D, DFF, (bf16_t*)(ws + WS_WT13), scr, r, lane); continue; } r -= I_F;
            transpose_item<0>(p->in[28], DFF, D, (bf16_t*)(ws + WS_WT2), scr, r, lane);
        }
    }
    { u32x4* z = (u32x4*)((bf16_t*)(ws + WS_WTIN) + (size_t)NIN * D); for (int i = gtid; i < 128 * D / 8; i += NGT) z[i] = (u32x4){0, 0, 0, 0}; }
    {
        bf16_t* WL = (bf16_t*)(ws + WS_WTLORA); const float* w2 = p->in[14]; const float* a2 = p->in[16]; const float* g2 = p->in[17];
        for (int i = gtid; i < 2560 * 128; i += NGT) {
            const int n = i >> 7, k = i & 127; float v = 0.f;
            if (n < 2048) { const int grp = n >> 10, dir = (n >> 9) & 1, c = n & 511; const float* src = grp == 0 ? w2 : a2;
                if ((k >> 6) == dir) v = src[((size_t)dir * 64 + (k & 63)) * 512 + c]; }
            else v = g2[(size_t)k * 512 + (n - 2048)];
            WL[i] = (bf16_t)(pk2(v, 0.f) & 0xffffu);
        }
    }
    {
        const f32x4* ck = (const f32x4*)p->in[2]; const f32x4* cv = (const f32x4*)p->in[3]; u32x2* CK = (u32x2*)(ws + WS_CK); u32x2* CV = (u32x2*)(ws + WS_CV);
        for (int i = gtid; i < 1024 * 512 / 4; i += NGT) { const f32x4 a = ck[i], b = cv[i]; CK[i] = (u32x2){pk2(a[0], a[1]), pk2(a[2], a[3])}; CV[i] = (u32x2){pk2(b[0], b[1]), pk2(b[2], b[3])}; }
    }
}

DI void ffn_transposes(KP p, LAS unsigned char* lds, int which, int widx, int nw, int wave, int lane) {
    LAS float* scr = (LAS float*)(lds + wave * 8448);
    constexpr int I_F = 16 * 88, I_2 = 44 * 32;
    if (which == 0) { for (int it = widx; it < I_2; it += nw) transpose_item<0>(p->in[28], DFF, D, (bf16_t*)(p->ws + WS_WT2), scr, it, lane); }
    else { for (int it = widx; it < 2 * I_F; it += nw) { if (it < I_F) transpose_item<1>(p->in[25], D, DFF, (bf16_t*)(p->ws + WS_WT13), scr, it, lane);
                                                           else transpose_item<2>(p->in[26], D, DFF, (bf16_t*)(p->ws + WS_WT13), scr, it - I_F, lane); } }
}

template <int SRC, int NR>
DI void norm_rows(KP p, int rbase, int rstride, int lane, const float* normw, int sh_off, int sc_off, int gate_off, bf16_t* Hout, float* xout) {
    const float* MODb = (const float*)(p->ws + WS_MOD);
    const bf16_t* PART = (const bf16_t*)(p->ws + WS_PART);
    f32x4 v[NR][4];
#pragma unroll
    for (int q = 0; q < NR; ++q) { const f32x4* xr = (const f32x4*)xrow_of(p, rbase + q * rstride) + lane;
#pragma unroll
        for (int j = 0; j < 4; ++j) v[q][j] = xr[64 * j]; }
    if (SRC == 1) {
        u32x2 p0[NR][4], p1[NR][4];
#pragma unroll
        for (int q = 0; q < NR; ++q) { const int r = rbase + q * rstride;
#pragma unroll
            for (int j = 0; j < 4; ++j) { p0[q][j] = *((const u32x2*)(PART + (size_t)r * D) + lane + 64 * j); p1[q][j] = *((const u32x2*)(PART + (size_t)(NTOK + r) * D) + lane + 64 * j); } }
#pragma unroll
        for (int q = 0; q < NR; ++q) { const int r = rbase + q * rstride; const float* MOD = MODb + midx_of(r) * 6144;
#pragma unroll
            for (int j = 0; j < 4; ++j) { const f32x4 gt = *((const f32x4*)(MOD + gate_off) + lane + 64 * j); v[q][j] = v[q][j] + gt * (unpk4(p0[q][j]) + unpk4(p1[q][j])); } }
    }
    float s[NR];
#pragma unroll
    for (int q = 0; q < NR; ++q) { s[q] = 0.f;
#pragma unroll
        for (int j = 0; j < 4; ++j) s[q] += (v[q][j].x * v[q][j].x + v[q][j].y * v[q][j].y) + (v[q][j].z * v[q][j].z + v[q][j].w * v[q][j].w); }
#pragma unroll
    for (int o = 1; o < 64; o <<= 1) {
#pragma unroll
        for (int q = 0; q < NR; ++q) s[q] += __shfl_xor(s[q], o); }
#pragma unroll
    for (int q = 0; q < NR; ++q) {
        const int r = rbase + q * rstride; const float* MOD = MODb + midx_of(r) * 6144;
        const float rstd = rsqrtf(s[q] * (1.f / D) + EPS);
        u32x2* o = (u32x2*)(Hout + (size_t)r * D) + lane;
#pragma unroll
        for (int j = 0; j < 4; ++j) {
            if (SRC == 1) *((f32x4*)(xout + (size_t)r * D) + lane + 64 * j) = v[q][j];
            const f32x4 g = *((const f32x4*)normw + lane + 64 * j), sc = *((const f32x4*)(MOD + sc_off) + lane + 64 * j), sh = *((const f32x4*)(MOD + sh_off) + lane + 64 * j);
            const f32x4 h = v[q][j] * rstd * g * (sc + 1.f) + sh;
            o[64 * j] = (u32x2){pk2(h.x, h.y), pk2(h.z, h.w)};
        }
    }
}

#define MFMA32(a, b, c) __builtin_amdgcn_mfma_f32_32x32x16_bf16((a), (b), (c), 0, 0, 0)
DI int crow(int reg, int h) { return (reg & 3) + 8 * (reg >> 2) + 4 * h; }
typedef short v4i16_t __attribute__((ext_vector_type(4)));
DI s16x4 vtr(const LAS unsigned char* p) { return __builtin_bit_cast(s16x4, __builtin_amdgcn_ds_read_tr16_b64_v4i16((LAS v4i16_t*)p)); }

template <bool LATENT, int MODE>
DI void attn_unit(KP p, LAS unsigned char* vbuf, const LAS float* rpbL, int unit, int lane, int t0, int t1, LAS float* xch) {
    const bf16_t* Q = (const bf16_t*)(p->ws + WS_Q); const bf16_t* Kb = (const bf16_t*)(p->ws + WS_K); const bf16_t* Vb = (const bf16_t*)(p->ws + WS_V);
    const bf16_t* CK = (const bf16_t*)(p->ws + WS_CK); const bf16_t* CV = (const bf16_t*)(p->ws + WS_CV);
    bf16_t* MIX = (bf16_t*)(p->ws + WS_MIX);
    const int r = lane & 31, hh = lane >> 5;
    int head, qrow0, b, gi = 0, w0 = 0, si = 0, ntile;
    if (LATENT) { head = unit & 7; const int t = unit >> 3; w0 = (t & 1) * 32; gi = (t >> 1) & 31; b = t >> 6; qrow0 = NCTX + b * DSEQ + gi * 64 + w0; si = min(max(gi - 4, 0), 24); ntile = 32; }
    else { head = unit & 7; const int t = unit >> 3; const int qb = t & 7; b = t >> 3; qrow0 = b * SEQ + qb * 32; ntile = 8; }
    bf16x8 qf[4];
#pragma unroll
    for (int s = 0; s < 4; ++s) qf[s] = *(const bf16x8*)(Q + (size_t)(qrow0 + r) * 512 + head * 64 + 16 * s + 8 * hh);
    auto tile_ptrs = [&](int t, const bf16_t*& kp, const bf16_t*& vp) {
        if (LATENT) {
            if (t < 16) { const size_t row = (size_t)b * 512 + t * 32; kp = CK + row * 512; vp = CV + row * 512; }
            else { const int lt = t - 16; const size_t row = (size_t)NCTX + b * DSEQ + (si + (lt >> 1)) * 64 + (((lt & 1) * 32) ^ w0); kp = Kb + row * 512; vp = Vb + row * 512; }
        } else { const size_t row = (size_t)b * SEQ + t * 32; kp = Kb + row * 512; vp = Vb + row * 512; }
    };
    bf16x8 kf[4], kn[4]; u32x4 vn[4];
    {
        const bf16_t *kp, *vp; tile_ptrs(t0, kp, vp);
#pragma unroll
        for (int s = 0; s < 4; ++s) kf[s] = *(const bf16x8*)(kp + (size_t)r * 512 + head * 64 + 16 * s + 8 * hh);
#pragma unroll
        for (int i = 0; i < 4; ++i) { const int c = lane + 64 * i; vn[i] = *(const u32x4*)(vp + (size_t)(c >> 3) * 512 + head * 64 + (c & 7) * 8); }
#pragma unroll
        for (int i = 0; i < 4; ++i) { const int c = lane + 64 * i; *(LAS u32x4*)(vbuf + (c >> 3) * 144 + (c & 7) * 16) = vn[i]; }
    }
    f32x16 o0, o1;
#pragma unroll
    for (int i = 0; i < 16; ++i) { o0[i] = 0.f; o1[i] = 0.f; }
    float mrun = -1e30f, lrun = 0.f;
    const int i16 = lane & 15, tq = i16 >> 2, tp = i16 & 3, blk = (lane >> 4) & 1;
    const LAS unsigned char* vtbase = vbuf + (4 * hh + tq) * 144 + (16 * blk) * 2 + 8 * tp;
    const int wq = w0 + r;
    const int cs = min(max(wq - 8, 0), 48);
    for (int t = t0; t < t1; ++t) {
        const bool more = (t + 1 < t1);
        if (more) {
            const bf16_t *kp, *vp; tile_ptrs(t + 1, kp, vp);
#pragma unroll
            for (int s = 0; s < 4; ++s) kn[s] = *(const bf16x8*)(kp + (size_t)r * 512 + head * 64 + 16 * s + 8 * hh);
#pragma unroll
            for (int i = 0; i < 4; ++i) { const int c = lane + 64 * i; vn[i] = *(const u32x4*)(vp + (size_t)(c >> 3) * 512 + head * 64 + (c & 7) * 8); }
        }
        f32x16 st;
#pragma unroll
        for (int i = 0; i < 16; ++i) st[i] = 0.f;
#pragma unroll
        for (int s = 0; s < 4; ++s) st = MFMA32(kf[s], qf[s], st);
        if (LATENT && t >= 16) {
            const int lt = t - 16, a = lt >> 1, c0 = ((lt & 1) * 32) ^ w0;
            const int row_off = si + a - gi + 7;
            const int d0 = c0 + 4 * hh - cs;
            const LAS float* bp = rpbL + head * 465 + row_off * 31 + (c0 + 4 * hh - wq + 15);
#pragma unroll
            for (int i = 0; i < 16; ++i) {
                const int ci = (i & 3) + 8 * (i >> 2);
                const bool valid = (unsigned)(d0 + ci) < 16u;
                const float bias = valid ? bp[ci] : 0.f;
                st[i] = valid ? st[i] + bias : -INFINITY;
            }
        }
        float tmax = st[0];
#pragma unroll
        for (int i = 1; i < 16; ++i) tmax = fmaxf(tmax, st[i]);
        tmax = fmaxf(tmax, __shfl_xor(tmax, 32));
        const float mnew = fmaxf(mrun, tmax);
        float ps = 0.f;
#pragma unroll
        for (int i = 0; i < 16; ++i) { st[i] = __builtin_amdgcn_exp2f(st[i] - mnew); ps += st[i]; }
        if (__builtin_amdgcn_ballot_w64(tmax > mrun) != 0ull) {
            const float alpha = __builtin_amdgcn_exp2f(mrun - mnew);
            lrun *= alpha;
#pragma unroll
            for (int i = 0; i < 16; ++i) { o0[i] *= alpha; o1[i] *= alpha; }
        }
        lrun += ps; mrun = mnew;
        bf16x8 pb[2];
#pragma unroll
        for (int s = 0; s < 2; ++s) { u32x4 w; w.x = pk2(st[8 * s], st[8 * s + 1]); w.y = pk2(st[8 * s + 2], st[8 * s + 3]); w.z = pk2(st[8 * s + 4], st[8 * s + 5]); w.w = pk2(st[8 * s + 6], st[8 * s + 7]); pb[s] = __builtin_bit_cast(bf16x8, w); }
        asm volatile("s_waitcnt lgkmcnt(0)" ::: "memory");
#pragma unroll
        for (int s = 0; s < 2; ++s) {
            const LAS unsigned char* bs = vtbase + (16 * s) * 144;
            const s16x4 lo0 = vtr(bs), hi0 = vtr(bs + 8 * 144), lo1 = vtr(bs + 64), hi1 = vtr(bs + 8 * 144 + 64);
            const bf16x8 va0 = __builtin_shufflevector(lo0, hi0, 0, 1, 2, 3, 4, 5, 6, 7), va1 = __builtin_shufflevector(lo1, hi1, 0, 1, 2, 3, 4, 5, 6, 7);
            o0 = MFMA32(va0, pb[s], o0); o1 = MFMA32(va1, pb[s], o1);
        }
        asm volatile("s_waitcnt lgkmcnt(0)" ::: "memory");
        if (more) {
#pragma unroll
            for (int i = 0; i < 4; ++i) { const int c = lane + 64 * i; *(LAS u32x4*)(vbuf + (c >> 3) * 144 + (c & 7) * 16) = vn[i]; }
#pragma unroll
            for (int s = 0; s < 4; ++s) kf[s] = kn[s];
        }
    }
    if (MODE == 1) {
#pragma unroll
        for (int i = 0; i < 16; ++i) { xch[i * 64 + lane] = o0[i]; xch[(16 + i) * 64 + lane] = o1[i]; }
        xch[32 * 64 + lane] = mrun; xch[33 * 64 + lane] = lrun;
        __syncthreads();
        return;
    }
    if (MODE == 2) {
        __syncthreads();
        const float mb = xch[32 * 64 + lane], lb = xch[33 * 64 + lane];
        const float mm = fmaxf(mrun, mb), fa = exp2f(mrun - mm), fb = exp2f(mb - mm);
#pragma unroll
        for (int i = 0; i < 16; ++i) { o0[i] = o0[i] * fa + xch[i * 64 + lane] * fb; o1[i] = o1[i] * fa + xch[(16 + i) * 64 + lane] * fb; }
        lrun = lrun * fa + lb * fb;
    }
    const float ltot = lrun + __shfl_xor(lrun, 32);
    const float inv = 1.f / ltot;
    bf16_t* orow = MIX + (size_t)(qrow0 + r) * D + head * 64;
#pragma unroll
    for (int g4 = 0; g4 < 4; ++g4) {
        const int d = 8 * g4 + 4 * hh;
        *(u32x2*)(orow + d) = (u32x2){pk2(o0[4 * g4] * inv, o0[4 * g4 + 1] * inv), pk2(o0[4 * g4 + 2] * inv, o0[4 * g4 + 3] * inv)};
        *(u32x2*)(orow + 32 + d) = (u32x2){pk2(o1[4 * g4] * inv, o1[4 * g4 + 1] * inv), pk2(o1[4 * g4 + 2] * inv, o1[4 * g4 + 3] * inv)};
    }
}

DI void prep_rows8(KP p, int r0, int lane) {
    const bf16_t* ZR = (const bf16_t*)(p->ws + WS_ZR); const float* wts = p->in[12]; const float* k_k = p->in[18];
    bf16_t* R = (bf16_t*)(p->ws + WS_R); bf16_t* KR = (bf16_t*)(p->ws + WS_KR); bf16_t* VV = (bf16_t*)(p->ws + WS_VV); bf16_t* KK = (bf16_t*)(p->ws + WS_KK);
    bf16_t* AL = (bf16_t*)(p->ws + WS_ALORA);
    const int t0 = r0 < NCTX ? (r0 & 255) : ((r0 - NCTX) & 2047); const int T = r0 < NCTX ? SEQ : DSEQ;
    const bool hp = t0 > 0, hn = t0 + 8 < T;
    const bf16_t* zb = ZR + (size_t)(r0 - 1) * RC;
    const f32x4 zero = {0, 0, 0, 0};
#pragma unroll 1
    for (int seg = 0; seg < 3; ++seg) {
        const int c = seg * 512 + lane * 8;
        f32x4 z[10][2];
#pragma unroll
        for (int i = 0; i < 10; ++i) { const bool ok = (i > 0 || hp) && (i < 9 || hn);
            if (ok) { const u32x4 w = *(const u32x4*)(zb + (size_t)i * RC + c); z[i][0] = unpk4((u32x2){w.x, w.y}); z[i][1] = unpk4((u32x2){w.z, w.w}); } else { z[i][0] = zero; z[i][1] = zero; } }
        const f32x4 wa0 = *(const f32x4*)(wts + c), wa1 = *(const f32x4*)(wts + c + 4), wb0 = *(const f32x4*)(wts + RC + c), wb1 = *(const f32x4*)(wts + RC + c + 4),
                    wc0 = *(const f32x4*)(wts + 2 * RC + c), wc1 = *(const f32x4*)(wts + 2 * RC + c + 4);
        const f32x4 k0 = *(const f32x4*)(k_k + lane * 8), k1 = *(const f32x4*)(k_k + lane * 8 + 4);
        bf16_t* dstb = (seg == 0 ? R : (seg == 1 ? KR : VV)) + (size_t)r0 * 512 + lane * 8;
#pragma unroll
        for (int i = 0; i < 8; ++i) {
            const f32x4 u0 = z[i][0] * wa0 + z[i + 1][0] * wb0 + z[i + 2][0] * wc0, u1 = z[i][1] * wa1 + z[i + 1][1] * wb1 + z[i + 2][1] * wc1;
            *(u32x4*)(dstb + (size_t)i * 512) = (u32x4){pk2(u0.x, u0.y), pk2(u0.z, u0.w), pk2(u1.x, u1.y), pk2(u1.z, u1.w)};
            if (seg == 1) {
                const f32x4 a = u0 * k0, bq = u1 * k1;
                float sq = (a.x * a.x + a.y * a.y) + (a.z * a.z + a.w * a.w) + (bq.x * bq.x + bq.y * bq.y) + (bq.z * bq.z + bq.w * bq.w);
                sq += __shfl_xor(sq, 1); sq += __shfl_xor(sq, 2); sq += __shfl_xor(sq, 4);
                const float rn = rsqrtf(sq + 1e-12f);
                const f32x4 ka_ = a * rn, kb_ = bq * rn; *(u32x4*)(KK + (size_t)(r0 + i) * 512 + lane * 8) = (u32x4){pk2(ka_.x, ka_.y), pk2(ka_.z, ka_.w), pk2(kb_.x, kb_.y), pk2(kb_.z, kb_.w)};
            }
        }
    }
    {
        const int cl = lane * 6, cc = 1536 + cl;
        const f32x2 zero2 = {0, 0};
        f32x2 z[10][3];
#pragma unroll
        for (int i = 0; i < 10; ++i) { const bool ok = (i > 0 || hp) && (i < 9 || hn);
#pragma unroll
            for (int q = 0; q < 3; ++q) { if (ok) { const unsigned w = *(const unsigned*)(zb + (size_t)i * RC + cc + 2 * q); z[i][q] = (f32x2){__builtin_bit_cast(float, w << 16), __builtin_bit_cast(float, w & 0xffff0000u)}; } else z[i][q] = zero2; } }
#pragma unroll
        for (int q = 0; q < 3; ++q) {
            const f32x2 wa = *(const f32x2*)(wts + cc + 2 * q), wb = *(const f32x2*)(wts + RC + cc + 2 * q), wcq = *(const f32x2*)(wts + 2 * RC + cc + 2 * q);
            const int cq = cl + 2 * q, grp = cq >> 7, k = cq & 127;
#pragma unroll
            for (int i = 0; i < 8; ++i) {
                f32x2 u = z[i][q] * wa + z[i + 1][q] * wb + z[i + 2][q] * wcq;
                if (grp == 0) { u.x = tanh_f(u.x); u.y = tanh_f(u.y); }
                else if (grp == 2) { u.x = sigmoid_f(u.x); u.y = sigmoid_f(u.y); }
                *(unsigned*)(AL + ((size_t)grp * NTOK + r0 + i) * 128 + k) = pk2(u.x, u.y);
            }
        }
    }
}

template <int CTRL> DI float dppf_(float x) { return __builtin_bit_cast(float, __builtin_amdgcn_mov_dpp(__builtin_bit_cast(int, x), CTRL, 0xf, 0xf, true)); }
template <int CTRL> DI float dpp_add(float x) { const int y = __builtin_amdgcn_mov_dpp(__builtin_bit_cast(int, x), CTRL, 0xf, 0xf, true); return x + __builtin_bit_cast(float, y); }
DI float red16(float x) { x = dpp_add<0xB1>(x); x = dpp_add<0x4E>(x); x = dpp_add<0x141>(x); x = dpp_add<0x140>(x); return x; }

constexpr int TC = 16;
DI float tred4(float q0, float q1, float q2, float q3, bool b0, bool b1) {
    const float ka = b0 ? q2 : q0, kb = b0 ? q3 : q1, sa = b0 ? q0 : q2, sb = b0 ? q1 : q3;
    const float a = ka + dppf_<0xB1>(sa), b = kb + dppf_<0xB1>(sb);
    float c = (b1 ? b : a) + dppf_<0x4E>(b1 ? a : b);
    c += dppf_<0x124>(c);
    c += dppf_<0x128>(c);
    return c;
}
DI f32x2 lo2(f32x4 v) { return __builtin_shufflevector(v, v, 0, 1); }
DI f32x2 hi2(f32x4 v) { return __builtin_shufflevector(v, v, 2, 3); }
struct ScanOps { f32x4 kk, rr, ww, bb, kd; float vv; };
struct ScanLd { f32x4 kk, r, dec, aa, kr, v; };
DI void scan_item(KP p, LAS unsigned char* lds, int latent, int sc, int qr, int tid) {
    const bf16_t* KK = (const bf16_t*)(p->ws + WS_KK); const bf16_t* R = (const bf16_t*)(p->ws + WS_R); const bf16_t* KR = (const bf16_t*)(p->ws + WS_KR);
    const bf16_t* VV = (const bf16_t*)(p->ws + WS_VV); const float* k_a = p->in[19];
    float* Y = (float*)(p->ws + WS_Y);
    const int b = sc >> 4, dir = (sc >> 3) & 1, h = sc & 7;
    const int T = latent ? DSEQ : SEQ; const size_t rowbase = latent ? (size_t)NCTX + (size_t)b * DSEQ : (size_t)b * SEQ;
    const float* DEC = (const float*)(p->ws + WS_DEC) + (size_t)dir * NTOK * 512; const bf16_t* AA = (const bf16_t*)(p->ws + WS_AA) + (size_t)dir * NTOK * 512;
    float* Yd = Y + (size_t)dir * NTOK * 512;
    LAS float* buf = (LAS float*)lds;
    LAS float* vb = (LAS float*)(lds + 2 * TC * 320 * 4);
    const int wave = tid >> 6, lane = tid & 63;
    const bool consumer = wave < 4;
    const int nchunk = T / TC;
    const int rl = lane >> 4, ks = lane & 15, row = 16 * qr + 4 * wave + rl;
    f32x2 S01 = {0, 0}, S23 = {0, 0};
    if (consumer && latent) { const f32x4 s4 = *(const f32x4*)(p->in[4] + ((((size_t)b * 2 + dir) * 8 + h) * 64 + row) * 64 + 4 * ks); S01 = lo2(s4); S23 = hi2(s4); }
    const int lt = tid - 256, lj = lt >> 4, li = lt & 15;
    ScanLd L0, L1; f32x4 ka4 = {0, 0, 0, 0};
    if (!consumer) ka4 = *(const f32x4*)(k_a + h * 64 + 4 * li);
    float* ybase = Yd + (rowbase)*512 + h * 64 + row;
    const bool kb0 = (ks & 1) != 0, kb1 = (ks & 2) != 0; const int ystep = 4 * (ks >> 2) + 2 * (ks & 1) + ((ks >> 1) & 1);
#define SCAN_LOAD(L, c) do { const int idx = (c) * TC + lj; const int tt = dir ? T - 1 - idx : idx; const size_t off = (rowbase + tt) * 512 + h * 64 + 4 * li; \
        L.kk = unpk4(*(const u32x2*)(KK + off)); L.r = unpk4(*(const u32x2*)(R + off)); L.dec = *(const f32x4*)(DEC + off); L.aa = unpk4(*(const u32x2*)(AA + off)); L.kr = unpk4(*(const u32x2*)(KR + off)); \
        if (lt < 64) { const int vj = lt >> 2, vq = lt & 3; const int idv = (c) * TC + vj; const int tv = dir ? T - 1 - idv : idv; L.v = unpk4(*(const u32x2*)(VV + (rowbase + tv) * 512 + h * 64 + 16 * qr + 4 * vq)); } } while (0)
#define SCAN_WRITE(L, bc, vc) do { const f32x4 bb_ = L.kk * L.aa; const f32x4 kd_ = L.kr * ((L.aa - 1.f) * ka4 + 1.f); LAS float* d_ = (bc) + lj * 320 + 4 * li; \
        *(LAS f32x4*)(d_) = L.kk; *(LAS f32x4*)(d_ + 64) = L.r; *(LAS f32x4*)(d_ + 128) = L.dec; *(LAS f32x4*)(d_ + 192) = bb_; *(LAS f32x4*)(d_ + 256) = kd_; \
        if (lt < 64) *(LAS f32x4*)((vc) + (lt >> 2) * 16 + 4 * (lt & 3)) = L.v; } while (0)
#define SCAN_LDOPS(o, bc, vc, j) do { const LAS float* d_ = (bc) + (j) * 320 + 4 * ks; o.kk = *(const LAS f32x4*)(d_); o.rr = *(const LAS f32x4*)(d_ + 64); o.ww = *(const LAS f32x4*)(d_ + 128); \
        o.bb = *(const LAS f32x4*)(d_ + 192); o.kd = *(const LAS f32x4*)(d_ + 256); o.vv = (vc)[(j) * 16 + 4 * wave + rl]; } while (0)
#define SCAN_COMPUTE(bc, vc, c) do { ScanOps oc, on, on2; SCAN_LDOPS(oc, bc, vc, 0); SCAN_LDOPS(on, bc, vc, 1); float ysel = 0.f; float yp0 = 0.f, yp1 = 0.f, yp2 = 0.f; \
        _Pragma("unroll") for (int j = 0; j < TC; ++j) { \
            if (j + 2 < TC) SCAN_LDOPS(on2, bc, vc, j + 2);     \
            f32x2 pq = S01 * lo2(oc.kk); pq = S23 * hi2(oc.kk) + pq; \
            const float sa = red16(pq.x + pq.y); \
            const f32x2 t01 = S01 * lo2(oc.ww) + lo2(oc.kd) * oc.vv, t23 = S23 * hi2(oc.ww) + hi2(oc.kd) * oc.vv; \
            S01 = t01 - lo2(oc.bb) * sa; S23 = t23 - hi2(oc.bb) * sa; \
            f32x2 yq = S01 * lo2(oc.rr); yq = S23 * hi2(oc.rr) + yq; \
            const float yp = yq.x + yq.y; \
            if ((j & 3) == 0) yp0 = yp; else if ((j & 3) == 1) yp1 = yp; else if ((j & 3) == 2) yp2 = yp; \
            else { const float yr = tred4(yp0, yp1, yp2, yp, kb0, kb1); ysel = ((ks >> 2) == (j >> 2)) ? yr : ysel; } \
            oc = on; on = on2; \
            asm volatile("" ::: "memory"); } \
        { const int idx = (c) * TC + ystep; const int tt = dir ? T - 1 - idx : idx; ybase[(size_t)tt * 512] = ysel; } } while (0)
    if (!consumer) { SCAN_LOAD(L0, 0); SCAN_LOAD(L1, 1); }
    for (int c = 0; c < nchunk; c += 2) {
        if (!consumer) SCAN_WRITE(L0, buf, vb);
        __syncthreads();
        if (!consumer) { if (c + 2 < nchunk) SCAN_LOAD(L0, c + 2); }
        else SCAN_COMPUTE(buf, vb, c);
        if (!consumer) SCAN_WRITE(L1, buf + TC * 320, vb + TC * 16);
        __syncthreads();
        if (!consumer) { if (c + 3 < nchunk) SCAN_LOAD(L1, c + 3); }
        else SCAN_COMPUTE(buf + TC * 320, vb + TC * 16, c + 1);
    }
#undef SCAN_LOAD
#undef SCAN_WRITE
#undef SCAN_LDOPS
#undef SCAN_COMPUTE
    if (consumer && !latent) *(f32x4*)(p->out + OUT_S + ((((size_t)b * 2 + dir) * 8 + h) * 64 + row) * 64 + 4 * ks) = (f32x4){S01.x, S01.y, S23.x, S23.y};
    __syncthreads();
}

constexpr int CS_L = 32, CS_LAT = 2048, CS_CHUNKS = 4096;
DI unsigned char* cs_mf(unsigned char* ws, int q) { return ws + 28 * MiB + (size_t)q * 8192; }
DI unsigned char* cs_q1(unsigned char* ws, int q) { return q < CS_LAT ? ws + 60 * MiB + (size_t)q * 4096 : ws + 76 * MiB + (size_t)(q - CS_LAT) * 4096; }
DI unsigned char* cs_q2(unsigned char* ws, int q) { return q < CS_LAT ? ws + 92 * MiB + (size_t)q * 4096 : ws + 108 * MiB + (size_t)(q - CS_LAT) * 4096; }
DI unsigned char* cs_nt(unsigned char* ws, int q) { return q < CS_LAT ? ws + 202 * MiB + (size_t)q * 8192 : ws + 234 * MiB + (size_t)(q - CS_LAT) * 8192; }
constexpr int CS_G = 49152;
DI bf16x8 frag_nat(const LAS unsigned char* img, int pitch, int rc, int s, int hh) { return *(const LAS bf16x8*)(img + rc * pitch + (16 * s + 8 * hh) * 2); }
DI bf16x8 frag_krow(const LAS unsigned char* img, int pitch, int rc, int s, int hh) {
    const s16x4 lo = *(const LAS s16x4*)(img + rc * pitch + (16 * s + 4 * hh) * 2), hi = *(const LAS s16x4*)(img + rc * pitch + (16 * s + 8 + 4 * hh) * 2);
    return __builtin_shufflevector(lo, hi, 0, 1, 2, 3, 4, 5, 6, 7); }
DI bf16x8 frag_tr(const LAS unsigned char* img, int pitch, int col0, int s, int lane) {
    const int i16 = lane & 15, tq = i16 >> 2, tp = i16 & 3, blk = (lane >> 4) & 1, hh = lane >> 5;
    const LAS unsigned char* bs = img + (16 * s + 4 * hh + tq) * pitch + (col0 + 16 * blk) * 2 + 8 * tp;
    const s16x4 lo = vtr(bs), hi = vtr(bs + 8 * pitch);
    return __builtin_shufflevector(lo, hi, 0, 1, 2, 3, 4, 5, 6, 7); }
template <int S> DI bf16x8 pack8(const f32x16& x, float sg) {
    u32x4 w; w.x = pk2(sg * x[8 * S], sg * x[8 * S + 1]); w.y = pk2(sg * x[8 * S + 2], sg * x[8 * S + 3]); w.z = pk2(sg * x[8 * S + 4], sg * x[8 * S + 5]); w.w = pk2(sg * x[8 * S + 6], sg * x[8 * S + 7]);
    return __builtin_bit_cast(bf16x8, w); }
template <int S> DI bf16x8 pack8lo(const f32x16& x, bf16x8 hi) {
    const u32x4 h = __builtin_bit_cast(u32x4, hi); float d[8];
#pragma unroll
    for (int j = 0; j < 4; ++j) { d[2 * j] = x[8 * S + 2 * j] - __builtin_bit_cast(float, h[j] << 16); d[2 * j + 1] = x[8 * S + 2 * j + 1] - __builtin_bit_cast(float, h[j] & 0xffff0000u); }
    u32x4 w; w.x = pk2(d[0], d[1]); w.y = pk2(d[2], d[3]); w.z = pk2(d[4], d[5]); w.w = pk2(d[6], d[7]);
    return __builtin_bit_cast(bf16x8, w); }
DI void lds_barrier() { asm volatile("s_waitcnt lgkmcnt(0)" ::: "memory"); __builtin_amdgcn_s_barrier(); asm volatile("" ::: "memory"); }
DI f32x16 zero16() { f32x16 z;
#pragma unroll
    for (int i = 0; i < 16; ++i) z[i] = 0.f;
    return z; }

DI void cs_phaseA(KP p, LAS unsigned char* lds, int tid, int qbase, int nit, int first, int stride) {
    const bf16_t* KK = (const bf16_t*)(p->ws + WS_KK); const bf16_t* R = (const bf16_t*)(p->ws + WS_R); const bf16_t* KR = (const bf16_t*)(p->ws + WS_KR);
    const bf16_t* VV = (const bf16_t*)(p->ws + WS_VV); const float* k_a = p->in[19];
    const int wave = tid >> 6, lane = tid & 63, g = wave >> 2, wq = wave & 3, tg = wq * 64 + lane, hh = lane >> 5, r32 = lane & 31;
    LAS unsigned char* L = lds + g * CS_G;
    LAS unsigned char* MKK = L, *MBT = L + 4608, *MKT = L + 2 * 4608, *MRT = L + 3 * 4608, *MBH = L + 4 * 4608, *MKH = L + 5 * 4608, *MVM = L + 6 * 4608;
    LAS float* AF = (LAS float*)(L + 32256);
    LAS unsigned char* ST = L + 36352, *SKK = ST + 2560, *SRB = ST + 2 * 2560, *SRK = ST + 3 * 2560;
    LAS float* SEG = (LAS float*)(L + 46592); LAS float* ELv = (LAS float*)(L + 48640);
    f32x2 lwN[4], kkN[4], aaN[4], krN[4], rN[4]; u32x4 vmN;
#define CSA_FETCH(it_) do { const int q_ = qbase + (it_) * 2 + g; const bool lat_ = q_ < CS_LAT; const int sc_ = lat_ ? (q_ >> 6) : ((q_ - CS_LAT) >> 3), ci_ = lat_ ? (q_ & 63) : (q_ & 7), TT_ = lat_ ? DSEQ : SEQ; \
        const int b_ = sc_ >> 4, dir_ = (sc_ >> 3) & 1, h_ = sc_ & 7; const int rb_ = lat_ ? NCTX + b_ * DSEQ : b_ * SEQ; \
          \
        const int t0_ = dir_ ? TT_ - 1 - ci_ * CS_L : ci_ * CS_L, sg_ = dir_ ? -512 : 512; \
        const unsigned ub_ = (unsigned)((rb_ + t0_) * 512 + h_ * 64); \
        const unsigned o0_ = ub_ + (unsigned)(sg_ * 4 * (tg >> 5) + 2 * (tg & 31)); \
        const float* DEC_ = (const float*)(p->ws + WS_DEC) + (size_t)dir_ * NTOK * 512; const bf16_t* AA_ = (const bf16_t*)(p->ws + WS_AA) + (size_t)dir_ * NTOK * 512; \
        _Pragma("unroll") for (int j = 0; j < 4; ++j) { const unsigned off = o0_ + (unsigned)(sg_ * j); \
            lwN[j] = *(const f32x2*)(DEC_ + off); kkN[j] = ldh2(KK + off); aaN[j] = ldh2(AA_ + off); krN[j] = ldh2(KR + off); rN[j] = ldh2(R + off); } \
        vmN = *(const u32x4*)(VV + (ub_ + (unsigned)(sg_ * (tg >> 3) + (tg & 7) * 8))); } while (0)
    if (first < nit) CSA_FETCH(first);
    for (int it = first; it < nit; it += stride) {
        const int q = qbase + it * 2 + g; const bool lat = q < CS_LAT;
        const int sc = lat ? (q >> 6) : ((q - CS_LAT) >> 3), ci = lat ? (q & 63) : (q & 7), TT = lat ? DSEQ : SEQ;
        const int b = sc >> 4, dir = (sc >> 3) & 1, h = sc & 7;
        const size_t rowbase = lat ? (size_t)NCTX + (size_t)b * DSEQ : (size_t)b * SEQ;
        const float* DEC = (const float*)(p->ws + WS_DEC) + (size_t)dir * NTOK * 512; const bf16_t* AA = (const bf16_t*)(p->ws + WS_AA) + (size_t)dir * NTOK * 512;
        {
            const int kp = tg & 31, seg = tg >> 5;
            f32x2 lw[4], kk2[4], aa2[4], kr2[4], r2[4];
#pragma unroll
            for (int j = 0; j < 4; ++j) { lw[j] = lwN[j]; kk2[j] = kkN[j]; aa2[j] = aaN[j]; kr2[j] = krN[j]; r2[j] = rN[j]; }
            const u32x4 vmC = vmN;
            if (it + stride < nit) CSA_FETCH(it + stride);
            f32x2 ss = {0.f, 0.f};
#pragma unroll
            for (int j = 0; j < 4; ++j) { lw[j].x = __logf(lw[j].x); lw[j].y = __logf(lw[j].y); ss += lw[j]; }
            *(LAS f32x2*)(SEG + seg * 64 + 2 * kp) = ss;
            { const int i = tg >> 3, v0 = (tg & 7) * 8; *(LAS u32x4*)(MVM + i * 144 + v0 * 2) = vmC; }
            lds_barrier();
            f32x2 pre = {0.f, 0.f}, tot = {0.f, 0.f};
#pragma unroll
            for (int s8 = 0; s8 < 8; ++s8) { const f32x2 v = *(const LAS f32x2*)(SEG + s8 * 64 + 2 * kp); tot += v; if (s8 < seg) pre += v; }
            if (seg == 0) *(LAS f32x2*)(ELv + 2 * kp) = (f32x2){__expf(tot.x), __expf(tot.y)};
            const f32x2 ka = *(const f32x2*)(k_a + h * 64 + 2 * kp);
            f32x2 cwp = pre;
#pragma unroll
            for (int j = 0; j < 4; ++j) {
                const f32x2 cw = cwp + lw[j];
                const f32x2 E = {__expf(cw.x), __expf(cw.y)}, Ei = {__expf(-cw.x), __expf(-cw.y)}, Ep = {__expf(cwp.x), __expf(cwp.y)}, Eh = {__expf(tot.x - cw.x), __expf(tot.y - cw.y)};
                const f32x2 bb = kk2[j] * aa2[j], kd = kr2[j] * ((aa2[j] - 1.f) * ka + 1.f);
                const int o = (4 * seg + j) * 144 + 4 * kp;
                const f32x2 x0 = kk2[j] * Ep, x1 = bb * Ei, x2 = kd * Ei, x3 = r2[j] * E, x4 = bb * Eh, x5 = kd * Eh;
                *(LAS unsigned*)(MKK + o) = pk2(x0.x, x0.y); *(LAS unsigned*)(MBT + o) = pk2(x1.x, x1.y); *(LAS unsigned*)(MKT + o) = pk2(x2.x, x2.y);
                *(LAS unsigned*)(MRT + o) = pk2(x3.x, x3.y); *(LAS unsigned*)(MBH + o) = pk2(x4.x, x4.y); *(LAS unsigned*)(MKH + o) = pk2(x5.x, x5.y);
                cwp = cw;
            }
        }
        lds_barrier();
        {
            const LAS unsigned char* ia = wq < 2 ? MKK : MRT; const LAS unsigned char* ib = (wq & 1) ? MKT : MBT;
            f32x16 acc = zero16();
#pragma unroll
            for (int s4 = 0; s4 < 4; ++s4) acc = MFMA32(frag_nat(ia, 144, r32, s4, hh), frag_nat(ib, 144, r32, s4, hh), acc);
#pragma unroll
            for (int i = 0; i < 16; ++i) { const int row = crow(i, hh); const bool keep = wq < 2 ? (row > r32) : (row >= r32); const float v = keep ? acc[i] : 0.f;
                if (wq == 0) AF[row * 32 + r32] = v;
                else *(LAS unsigned short*)((wq == 1 ? SKK : (wq == 2 ? SRB : SRK)) + row * 80 + r32 * 2) = (unsigned short)(pk2(v, 0.f) & 0xffffu); }
        }
        lds_barrier();
        f32x16 X = zero16(), NT0 = zero16(), NT1 = zero16(), Q2 = zero16();
        const int c = wq & 1;
        if (wq == 0) {
            float Tc[32];
#pragma unroll
            for (int i = 0; i < 32; ++i) {
                float a4[4] = {(i == r32) ? 1.f : 0.f, 0.f, 0.f, 0.f};
#pragma unroll
                for (int j4 = 0; j4 < (i + 3) / 4; ++j4) { const f32x4 ar = *(const LAS f32x4*)(AF + i * 32 + 4 * j4);
#pragma unroll
                    for (int e = 0; e < 4; ++e) if (4 * j4 + e < i) a4[e] -= ar[e] * Tc[4 * j4 + e]; }
                const float a = (a4[0] + a4[1]) + (a4[2] + a4[3]);
                Tc[i] = a;
                if (lane < 32) *(LAS unsigned short*)(ST + i * 80 + r32 * 2) = (unsigned short)(pk2(a, 0.f) & 0xffffu);
            }
        } else if (wq >= 2) {
#pragma unroll
            for (int s2 = 0; s2 < 2; ++s2) {
                const bf16x8 vm = frag_tr(MVM, 144, 32 * c, s2, lane);
                X = MFMA32(frag_krow(SKK, 80, r32, s2, hh), vm, X);
                Q2 = MFMA32(frag_krow(SRK, 80, r32, s2, hh), vm, Q2);
                NT0 = MFMA32(frag_tr(MKH, 144, 0, s2, lane), vm, NT0);
                NT1 = MFMA32(frag_tr(MKH, 144, 32, s2, lane), vm, NT1);
            }
        }
        lds_barrier();
        if (wq < 2) {
            f32x16 P1 = zero16();
#pragma unroll
            for (int s2 = 0; s2 < 2; ++s2) P1 = MFMA32(frag_krow(ST, 80, r32, s2, hh), frag_tr(MKK, 144, 32 * c, s2, lane), P1);
            const bf16x8 n0 = pack8<0>(P1, -1.f), n1 = pack8<1>(P1, -1.f);
            f32x16 Q1t;
#pragma unroll
            for (int g4 = 0; g4 < 4; ++g4) { const u32x2 w = *(const LAS u32x2*)(MRT + r32 * 144 + (32 * c + 8 * g4 + 4 * hh) * 2); const f32x4 f = unpk4(w);
                Q1t[4 * g4] = f.x; Q1t[4 * g4 + 1] = f.y; Q1t[4 * g4 + 2] = f.z; Q1t[4 * g4 + 3] = f.w; }
            Q1t = MFMA32(n0, frag_krow(SRB, 80, r32, 0, hh), Q1t); Q1t = MFMA32(n1, frag_krow(SRB, 80, r32, 1, hh), Q1t);
            u32x4* q1f = (u32x4*)cs_q1(p->ws, q) + (c * 2) * 64 + lane;
            q1f[0] = __builtin_bit_cast(u32x4, pack8<0>(Q1t, 1.f)); q1f[64] = __builtin_bit_cast(u32x4, pack8<1>(Q1t, 1.f));
#pragma unroll
            for (int bq = 0; bq < 2; ++bq) {
                f32x16 M = zero16();
                if (bq == c) {
#pragma unroll
                    for (int i = 0; i < 16; ++i) M[i] = (crow(i, hh) == r32) ? ELv[32 * c + r32] : 0.f;
                }
                M = MFMA32(n0, frag_tr(MBH, 144, 32 * bq, 0, lane), M); M = MFMA32(n1, frag_tr(MBH, 144, 32 * bq, 1, lane), M);
                u32x4* mf = (u32x4*)cs_mf(p->ws, q) + ((c * 2 + bq) * 2) * 64 + lane;
                mf[0] = __builtin_bit_cast(u32x4, pack8<0>(M, 1.f)); mf[64] = __builtin_bit_cast(u32x4, pack8<1>(M, 1.f));
            }
        } else {
            f32x16 P2 = zero16();
            P2 = MFMA32(frag_krow(ST, 80, r32, 0, hh), pack8<0>(X, 1.f), P2); P2 = MFMA32(frag_krow(ST, 80, r32, 1, hh), pack8<1>(X, 1.f), P2);
            const bf16x8 n0 = pack8<0>(P2, -1.f), n1 = pack8<1>(P2, -1.f);
            Q2 = MFMA32(frag_krow(SRB, 80, r32, 0, hh), n0, Q2); Q2 = MFMA32(frag_krow(SRB, 80, r32, 1, hh), n1, Q2);
            NT0 = MFMA32(frag_tr(MBH, 144, 0, 0, lane), n0, NT0); NT0 = MFMA32(frag_tr(MBH, 144, 0, 1, lane), n1, NT0);
            NT1 = MFMA32(frag_tr(MBH, 144, 32, 0, lane), n0, NT1); NT1 = MFMA32(frag_tr(MBH, 144, 32, 1, lane), n1, NT1);
            unsigned* q2f = (unsigned*)cs_q2(p->ws, q) + c * 512 + lane;
#pragma unroll
            for (int i = 0; i < 8; ++i) q2f[i * 64] = pk2(Q2[2 * i], Q2[2 * i + 1]);
            unsigned* ntf = (unsigned*)cs_nt(p->ws, q) + (c * 2) * 512 + lane;
#pragma unroll
            for (int i = 0; i < 8; ++i) { ntf[i * 64] = pk2(NT0[2 * i], NT0[2 * i + 1]); ntf[512 + i * 64] = pk2(NT1[2 * i], NT1[2 * i + 1]); }
        }
        lds_barrier();
    }
#undef CSA_FETCH
}


constexpr int CSB_SLOT = 24576;
DI void cs_phaseB(KP p, LAS unsigned char* lds, int latent, int sc, int tid) {
    const int wave = tid >> 6, lane = tid & 63, hh = lane >> 5, r32 = lane & 31;
    const int nch = latent ? 64 : 8, q0 = latent ? sc * 64 : CS_LAT + sc * 8, TT = latent ? DSEQ : SEQ;
    const int b = sc >> 4, dir = (sc >> 3) & 1, h = sc & 7, c = wave & 1;
    const size_t rowbase = latent ? (size_t)NCTX + (size_t)b * DSEQ : (size_t)b * SEQ;
    const bool consumer = wave < 2;
    float* Yu = p->out + (size_t)dir * NTOK * 512 + rowbase * 512 + h * 64 + 32 * c;
    const unsigned ylane = (unsigned)((dir ? 4 * (1 - hh) : 4 * hh) * 512 + r32);
    f32x16 Z0 = zero16(), Z1 = zero16();
    if (consumer && latent) { const float* s0 = p->in[4] + ((((size_t)b * 2 + dir) * 8 + h) * 64 + 32 * c + r32) * 64;
#pragma unroll
      for (int g4 = 0; g4 < 4; ++g4) { const f32x4 a = *(const f32x4*)(s0 + 8 * g4 + 4 * hh), bq = *(const f32x4*)(s0 + 32 + 8 * g4 + 4 * hh);
          Z0[4 * g4] = a.x; Z0[4 * g4 + 1] = a.y; Z0[4 * g4 + 2] = a.z; Z0[4 * g4 + 3] = a.w; Z1[4 * g4] = bq.x; Z1[4 * g4 + 1] = bq.y; Z1[4 * g4 + 2] = bq.z; Z1[4 * g4 + 3] = bq.w; } }
    const int lt = tid - 128;
    u32x4 RG[4][4];
#define CSB_LOADQ(set, ch) do { const int q_ = q0 + (ch); _Pragma("unroll") for (int k_ = 0; k_ < 4; ++k_) { const int pi_ = lt + 384 * k_; \
        const unsigned char* src_ = pi_ < 512 ? cs_mf(p->ws, q_) + pi_ * 16 : (pi_ < 768 ? cs_q1(p->ws, q_) + (pi_ - 512) * 16 : (pi_ < 1280 ? cs_nt(p->ws, q_) + (pi_ - 768) * 16 : cs_q2(p->ws, q_) + (pi_ - 1280) * 16)); \
        RG[set][k_] = *(const u32x4*)src_; } } while (0)
#define CSB_WRITEQ(set, slot) do { _Pragma("unroll") for (int k_ = 0; k_ < 4; ++k_) *(LAS u32x4*)(lds + (slot) * CSB_SLOT + (lt + 384 * k_) * 16) = RG[set][k_]; } while (0)
    if (!consumer) { CSB_LOADQ(0, 0); CSB_LOADQ(1, 1); CSB_LOADQ(2, 2); CSB_LOADQ(3, 3); CSB_WRITEQ(0, 0); CSB_LOADQ(0, 4); }
    else __builtin_amdgcn_s_setprio(3);
    for (int ci0 = 0; ci0 < nch; ci0 += 4) {
#pragma unroll
        for (int u = 0; u < 4; ++u) {
            const int ci = ci0 + u;
            lds_barrier();
            if (!consumer) {
                if (ci + 1 < nch) { CSB_WRITEQ((u + 1) & 3, (ci + 1) & 1); if (ci + 5 < nch) CSB_LOADQ((u + 1) & 3, ci + 5); }
            } else {
                const LAS unsigned char* sl = lds + (ci & 1) * CSB_SLOT;
                bf16x8 MF[8], Q1[4]; f32x16 Y, N0, N1;
#pragma unroll
                for (int i = 0; i < 8; ++i) MF[i] = *(const LAS bf16x8*)(sl + (i * 64 + lane) * 16);
#pragma unroll
                for (int i = 0; i < 4; ++i) Q1[i] = *(const LAS bf16x8*)(sl + 8192 + (i * 64 + lane) * 16);
#pragma unroll
                for (int i = 0; i < 8; ++i) { const unsigned w0 = *(const LAS unsigned*)(sl + 12288 + ((c * 2) * 512 + i * 64 + lane) * 4), w1 = *(const LAS unsigned*)(sl + 12288 + ((c * 2 + 1) * 512 + i * 64 + lane) * 4),
                                                         w2 = *(const LAS unsigned*)(sl + 20480 + (c * 512 + i * 64 + lane) * 4);
                    N0[2 * i] = __builtin_bit_cast(float, w0 << 16); N0[2 * i + 1] = __builtin_bit_cast(float, w0 & 0xffff0000u);
                    N1[2 * i] = __builtin_bit_cast(float, w1 << 16); N1[2 * i + 1] = __builtin_bit_cast(float, w1 & 0xffff0000u);
                    Y[2 * i] = __builtin_bit_cast(float, w2 << 16); Y[2 * i + 1] = __builtin_bit_cast(float, w2 & 0xffff0000u); }
                const bf16x8 z00 = pack8<0>(Z0, 1.f), z01 = pack8<1>(Z0, 1.f), z10 = pack8<0>(Z1, 1.f), z11 = pack8<1>(Z1, 1.f);
                const bf16x8 l00 = pack8lo<0>(Z0, z00), l01 = pack8lo<1>(Z0, z01), l10 = pack8lo<0>(Z1, z10), l11 = pack8lo<1>(Z1, z11);
                Y = MFMA32(Q1[0], z00, Y); Y = MFMA32(Q1[1], z01, Y); Y = MFMA32(Q1[2], z10, Y); Y = MFMA32(Q1[3], z11, Y);
                N0 = MFMA32(MF[0], z00, N0); N0 = MFMA32(MF[1], z01, N0); N0 = MFMA32(MF[4], z10, N0); N0 = MFMA32(MF[5], z11, N0);
                N0 = MFMA32(MF[0], l00, N0); N0 = MFMA32(MF[1], l01, N0); N0 = MFMA32(MF[4], l10, N0); N0 = MFMA32(MF[5], l11, N0);
                N1 = MFMA32(MF[2], z00, N1); N1 = MFMA32(MF[3], z01, N1); N1 = MFMA32(MF[6], z10, N1); N1 = MFMA32(MF[7], z11, N1);
                N1 = MFMA32(MF[2], l00, N1); N1 = MFMA32(MF[3], l01, N1); N1 = MFMA32(MF[6], l10, N1); N1 = MFMA32(MF[7], l11, N1);
                Z0 = N0; Z1 = N1;
                { const int t0 = dir ? TT - CS_L - ci * CS_L : ci * CS_L;
#pragma unroll
                  for (int i = 0; i < 16; ++i) { const int ci_ = (i & 3) + 8 * (i >> 2); float* Ys = Yu + (size_t)(t0 + (dir ? 27 - ci_ : ci_)) * 512; Ys[ylane] = Y[i]; } }
            }
        }
    }
#undef CSB_LOADQ
#undef CSB_WRITEQ
    __builtin_amdgcn_s_setprio(0);
    if (consumer && !latent) { float* so = p->out + OUT_S + ((((size_t)b * 2 + dir) * 8 + h) * 64 + 32 * c + r32) * 64;
#pragma unroll
        for (int g4 = 0; g4 < 4; ++g4) { *(f32x4*)(so + 8 * g4 + 4 * hh) = (f32x4){Z0[4 * g4], Z0[4 * g4 + 1], Z0[4 * g4 + 2], Z0[4 * g4 + 3]};
                                          *(f32x4*)(so + 32 + 8 * g4 + 4 * hh) = (f32x4){Z1[4 * g4], Z1[4 * g4 + 1], Z1[4 * g4 + 2], Z1[4 * g4 + 3]}; } }
    __syncthreads();
}

DI void post_row(KP p, int r, int lane) {
    const float* Y = p->out; const bf16_t* R = (const bf16_t*)(p->ws + WS_R); const bf16_t* KR = (const bf16_t*)(p->ws + WS_KR);
    const bf16_t* VV = (const bf16_t*)(p->ws + WS_VV); const bf16_t* AA = (const bf16_t*)(p->ws + WS_AA); const bf16_t* G = (const bf16_t*)(p->ws + WS_G);
    const float* k_a = p->in[19]; const float* r_k = p->in[20]; const float* lng = p->in[21]; const float* lnb = p->in[22];
    bf16_t* MIX = (bf16_t*)(p->ws + WS_MIX);
    const int c = lane * 8; const size_t off = (size_t)r * 512 + c;
    float y[8], rr[8], kr[8], vv[8], a0[8], a1[8], gg[8], ka[8], rk[8], lg[8], lb[8];
#define LD8(dst, ptr) do { const f32x4 _a = *(const f32x4*)(ptr), _b = *(const f32x4*)((ptr) + 4); dst[0] = _a.x; dst[1] = _a.y; dst[2] = _a.z; dst[3] = _a.w; dst[4] = _b.x; dst[5] = _b.y; dst[6] = _b.z; dst[7] = _b.w; } while (0)
#define LD8H(dst, ptr) do { const u32x4 _w = *(const u32x4*)(ptr); const f32x4 _a = unpk4((u32x2){_w.x, _w.y}), _b = unpk4((u32x2){_w.z, _w.w}); dst[0] = _a.x; dst[1] = _a.y; dst[2] = _a.z; dst[3] = _a.w; dst[4] = _b.x; dst[5] = _b.y; dst[6] = _b.z; dst[7] = _b.w; } while (0)
    LD8(y, Y + off); LD8(rr, Y + (size_t)NTOK * 512 + off);
#pragma unroll
    for (int j = 0; j < 8; ++j) y[j] += rr[j];
    LD8H(rr, R + off); LD8H(kr, KR + off); LD8H(vv, VV + off); LD8H(a0, AA + off); LD8H(a1, AA + (size_t)NTOK * 512 + off); LD8H(gg, G + off);
    LD8(ka, k_a + c); LD8(rk, r_k + c); LD8(lg, lng + c); LD8(lb, lnb + c);
#undef LD8
#undef LD8H
    float s = 0.f, d0 = 0.f, d1 = 0.f;
#pragma unroll
    for (int j = 0; j < 8; ++j) { s += y[j]; const float q = rr[j] * kr[j] * rk[j]; d0 += q * (1.f + (a0[j] - 1.f) * ka[j]); d1 += q * (1.f + (a1[j] - 1.f) * ka[j]); }
    float bd = d0 + d1;
    s += __shfl_xor(s, 1); s += __shfl_xor(s, 2); s += __shfl_xor(s, 4);
    bd += __shfl_xor(bd, 1); bd += __shfl_xor(bd, 2); bd += __shfl_xor(bd, 4);
    const float mu = s * (1.f / 64.f);
    float q2 = 0.f;
#pragma unroll
    for (int j = 0; j < 8; ++j) { y[j] -= mu; q2 += y[j] * y[j]; }
    q2 += __shfl_xor(q2, 1); q2 += __shfl_xor(q2, 2); q2 += __shfl_xor(q2, 4);
    const float rs = rsqrtf(q2 * (1.f / 64.f) + GN_EPS);
    float o[8];
#pragma unroll
    for (int j = 0; j < 8; ++j) o[j] = (y[j] * rs * lg[j] + lb[j] + bd * vv[j]) * gg[j];
    *(u32x4*)(MIX + (size_t)r * D + 512 + c) = (u32x4){pk2(o[0], o[1]), pk2(o[2], o[3]), pk2(o[4], o[5]), pk2(o[6], o[7])};
}

DI void act_fix(KP p, int idx) {
    const float* EDGE = (const float*)(p->ws + WS_EDGE); bf16_t* ACT = (bf16_t*)(p->ws + WS_ACT); const float* wc = p->in[27];
    const int c = (idx % 352) * 8, e = (idx / 352) & 1, pm = 16 + idx / 704;
    const bool need = e == 0 ? (pm != 16 && pm != 24) : (pm != 23 && pm != 31);
    if (!need) return;
    const int r = pm * 256 + (e ? 255 : 0), nbpm = e ? pm + 1 : pm - 1;
    const float* nb = EDGE + ((size_t)nbpm * 2 + (1 - e)) * DFF + c;
    const float* eu = EDGE + ((size_t)pm * 2 + e) * DFF + 64 * DFF + c; const float* e3 = eu + 64 * DFF;
    const float* w = wc + (e ? 2 * DFF : 0) + c;
    float o[8];
#pragma unroll
    for (int j = 0; j < 8; ++j) o[j] = silu_f(eu[j] + w[j] * nb[j]) * e3[j];
    *(u32x4*)(ACT + (size_t)r * DFF + c) = (u32x4){pk2(o[0], o[1]), pk2(o[2], o[3]), pk2(o[4], o[5]), pk2(o[6], o[7])};
}

template <int NR>
DI void final_rows(KP p, int rbase, int rstride, int lane) {
    const float* MODb = (const float*)(p->ws + WS_MOD);
    const bf16_t* PART = (const bf16_t*)(p->ws + WS_PART); const float* nf = p->in[29];
    f32x4 v[NR][4]; u32x2 p0[NR][4], p1[NR][4];
#pragma unroll
    for (int q = 0; q < NR; ++q) { const int r = rbase + q * rstride; const f32x4* xr = (const f32x4*)(p->out + (size_t)r * D) + lane;
#pragma unroll
        for (int j = 0; j < 4; ++j) { v[q][j] = xr[64 * j]; p0[q][j] = *((const u32x2*)(PART + (size_t)r * D) + lane + 64 * j); p1[q][j] = *((const u32x2*)(PART + (size_t)(NTOK + r) * D) + lane + 64 * j); } }
    float s[NR];
#pragma unroll
    for (int q = 0; q < NR; ++q) { const int r = rbase + q * rstride; const float* MOD = MODb + midx_of(r) * 6144; s[q] = 0.f;
#pragma unroll
        for (int j = 0; j < 4; ++j) { const f32x4 gt = *((const f32x4*)(MOD + 5 * D) + lane + 64 * j); v[q][j] = v[q][j] + gt * (unpk4(p0[q][j]) + unpk4(p1[q][j]));
            s[q] += (v[q][j].x * v[q][j].x + v[q][j].y * v[q][j].y) + (v[q][j].z * v[q][j].z + v[q][j].w * v[q][j].w); } }
#pragma unroll
    for (int o = 1; o < 64; o <<= 1) {
#pragma unroll
        for (int q = 0; q < NR; ++q) s[q] += __shfl_xor(s[q], o); }
#pragma unroll
    for (int q = 0; q < NR; ++q) { const int r = rbase + q * rstride; f32x4* xr = (f32x4*)(p->out + (size_t)r * D) + lane; const float rstd = rsqrtf(s[q] * (1.f / D) + EPS);
#pragma unroll
        for (int j = 0; j < 4; ++j) xr[64 * j] = v[q][j] * rstd * *((const f32x4*)nf + lane + 64 * j); }
}

DI int lane_id() { int l; asm volatile("v_mbcnt_lo_u32_b32 %0, -1, 0\n\tv_mbcnt_hi_u32_b32 %0, -1, %0" : "=v"(l)); return l; }
DI void grid_bar(unsigned* bar, unsigned nbar, int G, int bx, int wave_s) {
    __syncthreads();
    int t = wave_s * 64 + lane_id(); asm volatile("" : "+v"(t));
    if (t == 0) {
        __atomic_thread_fence(__ATOMIC_RELEASE);
        if ((G & 7) == 0) {
            const unsigned gsz = (unsigned)G >> 3;
            const unsigned old = __hip_atomic_fetch_add(bar + 64 + 64 * (bx & 7), 1u, __ATOMIC_RELAXED, __HIP_MEMORY_SCOPE_AGENT);
            if (old + 1 == gsz * nbar) __hip_atomic_fetch_add(bar, 1u, __ATOMIC_RELAXED, __HIP_MEMORY_SCOPE_AGENT);
            while (__hip_atomic_load(bar, __ATOMIC_RELAXED, __HIP_MEMORY_SCOPE_AGENT) < 8u * nbar) __builtin_amdgcn_s_sleep(1);
        } else {
            __hip_atomic_fetch_add(bar, 1u, __ATOMIC_RELAXED, __HIP_MEMORY_SCOPE_AGENT);
            while (__hip_atomic_load(bar, __ATOMIC_RELAXED, __HIP_MEMORY_SCOPE_AGENT) < (unsigned)G * nbar) __builtin_amdgcn_s_sleep(1);
        }
        __atomic_thread_fence(__ATOMIC_ACQUIRE);
    }
    __syncthreads();
}

__global__ void __launch_bounds__(512, 2) fwd_megakernel(Params kparams) {
    const KP kp0 = (KP)__builtin_amdgcn_kernarg_segment_ptr();
    extern __shared__ __attribute__((aligned(16))) unsigned char lds_raw[];
    LAS unsigned char* lds = (LAS unsigned char*)lds_raw;
    unsigned nbar = 0;
    const int wave_s = __builtin_amdgcn_readfirstlane((int)threadIdx.x >> 6);
#define GRID_SYNC() do { ++nbar; grid_bar((unsigned*)(kp0->ws + WS_BAR), nbar, G, bx, wave_s); } while (0)
    const int G = gridDim.x, bx = blockIdx.x, NGW = G * 8, NGT = G * 512;
#define PH_VARS KP p = kp0; asm volatile("" : "+s"(p)); unsigned char* ws = p->ws; (void)ws; \
    int tid = wave_s * 64 + lane_id(); asm volatile("" : "+v"(tid)); const int lane = tid & 63, wave = wave_s, gw = bx * 8 + wave, gtid = bx * 512 + tid; (void)lane; (void)gw; (void)gtid;

    const bool defer_ffn = (G == 256);
    { PH_VARS phase0(p, lds, gw, NGW, gtid, NGT, wave, lane, defer_ffn); }
    cg::this_grid().sync();
    { PH_VARS for (int r = gw; r < NTOK; r += 4 * NGW) norm_rows<0, 4>(p, r, NGW, lane, p->in[9], 0, D, 0, (bf16_t*)(ws + WS_H), nullptr); }
    GRID_SYNC();
    {
        PH_VARS
        pg8::Gemm g{(const bf16_t*)(ws + WS_H), (const bf16_t*)(ws + WS_WTIN), D, D, D};
        pg8::SchedPlain S; S.o.init(NTOK / 256, NINP / 256, G, bx);
        pg8::EpiIn E{(bf16_t*)(ws + WS_Q), (bf16_t*)(ws + WS_ZR), p->out + OUT_K, 0.125f * LOG2E};
        pg8::gemm_phase(lds, g, S, E, tid);
        if (defer_ffn && bx >= 192) ffn_transposes(p, lds, 0, (bx - 192) * 8 + wave, 64 * 8, wave, lane);
    }
    GRID_SYNC();
    {
        PH_VARS
        LAS float* rpbL = (LAS float*)lds;
        for (int i = tid; i < 8 * 465; i += 512) rpbL[i] = p->in[23][i] * LOG2E;
        __syncthreads();
        LAS unsigned char* vbuf = lds + 16384 + wave * 4608;
        LAS float* xch = (LAS float*)(lds + 65536) + (wave & 3) * 2176;
        for (int u0 = bx * 4; u0 < 1024; u0 += G * 4) {
            if (wave < 4) { attn_unit<true, 2>(p, vbuf, rpbL, u0 + wave, lane, 0, 20, xch); attn_unit<false, 0>(p, vbuf, rpbL, u0 + wave, lane, 0, 8, xch); }
            else { attn_unit<true, 1>(p, vbuf, rpbL, u0 + wave - 4, lane, 20, 32, xch); prep_rows8(p, (u0 + wave - 4) * 8, lane); }
            __syncthreads();
        }
    }
    GRID_SYNC();
    {
        PH_VARS
        int kl = 128; asm volatile("" : "+s"(kl));
        pg8::Gemm g{(const bf16_t*)(ws + WS_ALORA), (const bf16_t*)(ws + WS_WTLORA), kl, 128, 128};
        pg8::SchedLora S; S.G = G; S.c = bx;
        pg8::EpiLora E{(float*)(ws + WS_DEC), (float*)(ws + WS_AA), (float*)(ws + WS_G), p->in[13], p->in[15]};
        pg8::gemm_phase(lds, g, S, E, tid);
        if (defer_ffn && bx >= 64) ffn_transposes(p, lds, 1, (bx - 64) * 8 + wave, 192 * 8, wave, lane);
    }
    GRID_SYNC();
    {
        int nst = 2; asm volatile("" : "+s"(nst));
        const int nl = G > 64 ? 32 : 0;
        for (int st = 0; st < nst; ++st) {
            PH_VARS
            const bool lead = bx < nl;
            if (st == 0 || !lead) cs_phaseA(p, lds, tid, st ? CS_LAT : 0, CS_LAT / 2, st ? bx - nl : bx, st ? G - nl : G);
            if (st == 0) { GRID_SYNC(); continue; }
            if (!lead) {
                unsigned* sb = (unsigned*)(kp0->ws + WS_BAR) + 640;
                __syncthreads();
                if (tid == 0) { __atomic_thread_fence(__ATOMIC_RELEASE); __hip_atomic_fetch_add(sb, 1u, __ATOMIC_RELAXED, __HIP_MEMORY_SCOPE_AGENT);
                    while (__hip_atomic_load(sb, __ATOMIC_RELAXED, __HIP_MEMORY_SCOPE_AGENT) < (unsigned)(G - nl)) __builtin_amdgcn_s_sleep(1);
                    __atomic_thread_fence(__ATOMIC_ACQUIRE); }
                __syncthreads();
            }
            const int tfirst = lead ? bx : (nl ? 32 + (bx - nl) : bx), tend = lead ? 32 : 288, tstride = lead ? 32 : (G - nl);
            for (int t = tfirst; t < tend; t += tstride) cs_phaseB(p, lds, t < 32 ? 1 : 0, t < 32 ? t : t - 32, tid);
        }
    }
    GRID_SYNC();
    { PH_VARS for (int r = gw; r < NTOK; r += NGW) post_row(p, r, lane); }
    GRID_SYNC();
    {
        PH_VARS
        pg8::Gemm g{(const bf16_t*)(ws + WS_MIX), (const bf16_t*)(ws + WS_WTOUT), 512, D, D};
        pg8::SchedSplit2 S; S.o.init(NTOK / 256, 8, G, bx); S.nN = 4; S.ksplit = 512;
        pg8::EpiPart E{(bf16_t*)(ws + WS_PART), 512};
        pg8::gemm_phase(lds, g, S, E, tid);
    }
    GRID_SYNC();
    { PH_VARS for (int r = gw; r < NTOK; r += 2 * NGW) norm_rows<1, 2>(p, r, NGW, lane, p->in[10], 3 * D, 4 * D, 2 * D, (bf16_t*)(ws + WS_H), p->out); }
    GRID_SYNC();
    {
        PH_VARS
        pg8::Gemm g{(const bf16_t*)(ws + WS_H), (const bf16_t*)(ws + WS_WT13), D, D, D};
        pg8::SchedPlain S; S.o.init(NTOK / 256, 2 * DFF / 256, G, bx);
        pg8::EpiFfnAct E{(bf16_t*)(ws + WS_ACT), (float*)(ws + WS_EDGE), p->in[27], lds};
        pg8::gemm_phase(lds, g, S, E, tid);
    }
    GRID_SYNC();
    { PH_VARS for (int i = gtid; i < 16 * 704; i += NGT) act_fix(p, i); }
    GRID_SYNC();
    {
        PH_VARS
        pg8::Gemm g{(const bf16_t*)(ws + WS_ACT), (const bf16_t*)(ws + WS_WT2), DFF / 2, DFF, DFF};
        pg8::SchedSplit2 S; S.o.init(NTOK / 256, 8, G, bx); S.nN = 4; S.ksplit = DFF / 2;
        pg8::EpiPart E{(bf16_t*)(ws + WS_PART), DFF / 2};
        pg8::gemm_phase(lds, g, S, E, tid);
    }
    GRID_SYNC();
    { PH_VARS for (int r = gw; r < NTOK; r += 2 * NGW) final_rows<2>(p, r, NGW, lane); }
}

extern "C" void kernel_launch(void* const* d_in, const int* in_sizes, int n_in, void* d_out, int out_size, void* d_ws, size_t ws_size, hipStream_t stream) {
    static int grid_blocks = 0;
    if (!grid_blocks) {
        int dev = 0, cus = 0, per_cu = 0;
        (void)hipGetDevice(&dev);
        (void)hipDeviceGetAttribute(&cus, hipDeviceAttributeMultiprocessorCount, dev);
        (void)hipFuncSetAttribute((const void*)fwd_megakernel, hipFuncAttributeMaxDynamicSharedMemorySize, LDS_BYTES);
        (void)hipOccupancyMaxActiveBlocksPerMultiprocessor(&per_cu, (const void*)fwd_megakernel, 512, LDS_BYTES);
        if (per_cu < 1) per_cu = 1;
        grid_blocks = cus * per_cu;
    }
    (void)hipMemsetAsync((char*)d_ws + WS_BAR, 0, 4096, stream);
    Params p{};
    for (int i = 0; i < 30; ++i) p.in[i] = (const float*)d_in[i];
    p.out = (float*)d_out; p.ws = (unsigned char*)d_ws;
    void* args[] = {&p};
    hipError_t e = hipLaunchCooperativeKernel((const void*)fwd_megakernel, dim3(grid_blocks), dim3(512), args, LDS_BYTES, stream);
    if (e != hipSuccess) fprintf(stderr, "cooperative launch failed: %s (grid %d)\n", hipGetErrorString(e), grid_blocks);
}
```

```cpp
#include <hip/hip_runtime.h>
#include <hip/hip_cooperative_groups.h>
#include <cstdio>
#include <cstdint>
namespace cg = cooperative_groups;

#define LAS __attribute__((address_space(3)))
typedef unsigned short bf16_t;
typedef short bf16x8 __attribute__((ext_vector_type(8)));
typedef short s16x4 __attribute__((ext_vector_type(4)));
typedef float f32x2 __attribute__((ext_vector_type(2)));
typedef float f32x4 __attribute__((ext_vector_type(4)));
typedef float f32x16 __attribute__((ext_vector_type(16)));
typedef unsigned u32x2 __attribute__((ext_vector_type(2)));
typedef unsigned u32x4 __attribute__((ext_vector_type(4)));
typedef __bf16 bf16x2_t __attribute__((ext_vector_type(2)));
#define DI __device__ __forceinline__

constexpr int D = 1024, NTOK = 8192, NCTX = 4096, SEQ = 256, DSEQ = 2048;
constexpr int NIN = 3456, NINP = 3584, RC = 1920, DFF = 2816;
constexpr float EPS = 1e-6f, GN_EPS = 64e-5f;
constexpr float LOG2E = 1.4426950408889634f;
constexpr size_t MiB = 1u << 20;
constexpr size_t WS_BAR = 128 * 1024, WS_MOD = 0, WS_WTIN = 1 * MiB, WS_WTOUT = 8 * MiB, WS_WT13 = 10 * MiB, WS_WT2 = 21 * MiB, WS_WTLORA = 27 * MiB,
                 WS_H = 28 * MiB, WS_Q = 44 * MiB, WS_K = 52 * MiB, WS_V = 60 * MiB, WS_R = 68 * MiB, WS_VV = 84 * MiB, WS_KK = 100 * MiB,
                 WS_KR = 116 * MiB, WS_ALORA = 132 * MiB, WS_MIX = 138 * MiB, WS_ZR = 154 * MiB, WS_DEC = 154 * MiB, WS_AA = 186 * MiB,
                 WS_G = 218 * MiB, WS_CK = 234 * MiB, WS_CV = 235 * MiB, WS_Y = 28 * MiB, WS_PART = 176 * MiB, WS_A1 = 44 * MiB,
                 WS_A3 = 88 * MiB, WS_ACT = 132 * MiB, WS_EDGE = 250 * MiB;
constexpr size_t OUT_K = (size_t)NTOK * D, OUT_V = OUT_K + (size_t)NCTX * 512, OUT_S = OUT_V + (size_t)NCTX * 512;
constexpr int LDS_BYTES = 135168 + 16;
constexpr int LDS_XB = 135168;

struct Params { const float* in[30]; float* out; unsigned char* ws; };
typedef const __attribute__((address_space(4))) Params* KP;

DI unsigned pk2(float lo, float hi) { f32x2 v = {lo, hi}; bf16x2_t b = __builtin_convertvector(v, bf16x2_t); return __builtin_bit_cast(unsigned, b); }
DI f32x4 unpk4(u32x2 w) { return (f32x4){__builtin_bit_cast(float, w.x << 16), __builtin_bit_cast(float, w.x & 0xffff0000u), __builtin_bit_cast(float, w.y << 16), __builtin_bit_cast(float, w.y & 0xffff0000u)}; }
DI f32x2 ldh2(const bf16_t* p) { const unsigned w = *(const unsigned*)p; return (f32x2){__builtin_bit_cast(float, w << 16), __builtin_bit_cast(float, w & 0xffff0000u)}; }
DI float bf2f(unsigned short u) { return __builtin_bit_cast(float, (unsigned)u << 16); }
DI float wave_sum(float v) {
#pragma unroll
    for (int o = 1; o < 64; o <<= 1) v += __shfl_xor(v, o);
    return v;
}
DI float sigmoid_f(float x) { return __builtin_amdgcn_rcpf(1.f + __builtin_amdgcn_exp2f(-1.4426950408889634f * x)); }
DI float silu_f(float x) { return x * sigmoid_f(x); }
DI float tanh_f(float x) { return 2.f * sigmoid_f(2.f * x) - 1.f; }
DI int midx_of(int r) { return r < NCTX ? 0 : 1 + ((r - NCTX) >> 11); }
DI const float* xrow_of(KP p, int r) { return r < NCTX ? p->in[0] + (size_t)r * D : p->in[1] + (size_t)(r - NCTX) * D; }

namespace pg8 {
constexpr int BM = 256, BK = 64, HALF = 128, HTB = HALF * BK * 2, NXCD = 8, WGM = 8;
__host__ __device__ __forceinline__ int lds_byte(int r, int c) { const int st = (r >> 4) * 2 + (c >> 5), rr = r & 15, cc = c & 31, ob = rr * 64 + cc * 2; return st * 1024 + (ob ^ (((ob >> 9) & 1) << 5)); }
__host__ __device__ __forceinline__ void stage_rc(int b, int& R, int& C) { const int st = b / 1024, sb = b % 1024, swz = sb ^ (((sb >> 9) & 1) << 5); R = (st >> 1) * 16 + swz / 64; C = (st & 1) * 32 + (swz % 64) / 2; }
__host__ __device__ __forceinline__ int perm32(int rho) { const int n = rho >> 4, i = rho & 15; return 8 * (i >> 2) + 4 * n + (i & 3); }
struct Unit { int pm, pn; int aoff, boff; };
struct Gemm { const bf16_t* A; const bf16_t* Bt; int K, lda, ldb; };
struct StaticOrder {
    int nM, nN, nwg, G, c;
    __device__ void init(int nM_, int nN_, int G_, int c_) { nM = nM_; nN = nN_; nwg = nM * nN; G = G_; c = c_; }
    __device__ bool next2(int i, int& pm, int& pn) const {
        const long L = (long)i * G + c; if (L >= nwg) return false;
        int wgid = (int)L; { const int q = nwg / NXCD, r = nwg % NXCD, xcd = wgid % NXCD, off = wgid / NXCD; wgid = (xcd < r ? xcd * (q + 1) : r * (q + 1) + (xcd - r) * q) + off; }
        const int nig = WGM * nN, gid = wgid / nig, fm = gid * WGM, gsz = (nM - fm) < WGM ? (nM - fm) : WGM;
        pm = fm + ((wgid % nig) % gsz); pn = (wgid % nig) / gsz; return true;
    }
};
struct SchedPlain { StaticOrder o; __device__ bool next(int i, Unit& u) const { u.aoff = 0; u.boff = 0; return o.next2(i, u.pm, u.pn); } };
struct SchedSplit2 { StaticOrder o; int nN, ksplit;
    __device__ bool next(int i, Unit& u) const { int pn2; if (!o.next2(i, u.pm, pn2)) return false; const int ks = pn2 / nN; u.pn = pn2 - ks * nN; u.aoff = ks * ksplit; u.boff = ks * ksplit; return true; } };
struct SchedLora { int G, c;
    __device__ bool next(int i, Unit& u) const { const int L = i * G + c; if (L >= 320) return false; u.pm = L & 31; u.pn = L >> 5; const int g = u.pn < 4 ? 0 : (u.pn < 8 ? 1 : 2); u.aoff = g * NTOK * 128; u.boff = 0; return true; } };

template <class Epi, class Sched>
__device__ __forceinline__ void gemm_phase(LAS unsigned char* lds, const Gemm g, const Sched& S, const Epi& E, int tid) {
    asm volatile("" : "+v"(tid));
    const int wid = __builtin_amdgcn_readfirstlane(tid >> 6), lane = tid & 63, wr = wid >> 2, wc = wid & 3, fr = lane & 15, fq = lane >> 4;
    const int nt = g.K / BK;
    unsigned voffA[2], voffB[2];
#pragma unroll
    for (int i = 0; i < 2; ++i) { int R, C; stage_rc(tid * 16 + i * 8192, R, C); const int Rb = (R & ~31) + perm32(R & 31);
        voffA[i] = (unsigned)(R * g.lda + C) * 2u; voffB[i] = (unsigned)(Rb * g.ldb + C) * 2u; }
    const size_t kstep = (size_t)(BK * 2);
    const size_t hA = (size_t)HALF * g.lda * 2, hB = (size_t)HALF * g.ldb * 2;
    const unsigned ldsw = (unsigned)wid * 1024u;
    const int aoff = lds_byte(wr * 64 + fr, fq * 8), boff = lds_byte(wc * 32 + fr, fq * 8);
#define PG8_SA(b, h) (((b) * 2 + (h)) * HTB)
#define PG8_SB(b, h) ((4 + (b) * 2 + (h)) * HTB)
#define PG8_STAGE(bufoff, gbase, voff) do { _Pragma("unroll") for (int _i = 0; _i < 2; ++_i) \
        __builtin_amdgcn_global_load_lds((const unsigned*)((const char*)(gbase) + (voff)[_i]), (LAS unsigned*)(lds + (bufoff) + ldsw + _i * 8192), 16, 0, 0); } while (0)
#define PG8_LDA(dst, b, h) do { _Pragma("unroll") for (int m = 0; m < 4; ++m) _Pragma("unroll") for (int k = 0; k < 2; ++k) dst[m][k] = *(const LAS bf16x8*)(lds + PG8_SA(b, h) + aoff + m * 2048 + k * 1024); } while (0)
#define PG8_LDB(dst, b, h) do { _Pragma("unroll") for (int n = 0; n < 2; ++n) _Pragma("unroll") for (int k = 0; k < 2; ++k) dst[n][k] = *(const LAS bf16x8*)(lds + PG8_SB(b, h) + boff + n * 2048 + k * 1024); } while (0)
#define PG8_MMA(ai, bj, At, Bt) do { __builtin_amdgcn_s_setprio(1); _Pragma("unroll") for (int m = 0; m < 4; ++m) _Pragma("unroll") for (int n = 0; n < 2; ++n) _Pragma("unroll") for (int k = 0; k < 2; ++k) \
        acc[ai][bj][m][n] = __builtin_amdgcn_mfma_f32_16x16x32_bf16(Bt[n][k], At[m][k], acc[ai][bj][m][n], 0, 0, 0); __builtin_amdgcn_s_setprio(0); } while (0)
#define PG8_WAIT_V(n) asm volatile("s_waitcnt vmcnt(" #n ")" ::: "memory")
#define PG8_WAIT_L(n) asm volatile("s_waitcnt lgkmcnt(" #n ")" ::: "memory")
#define PG8_BAR __builtin_amdgcn_s_barrier()
#define PG8_SCHED __builtin_amdgcn_sched_barrier(0)
#define PG8_TA(u) ((const char*)g.A + ((size_t)(u).pm * BM * g.lda + (size_t)(u).aoff) * 2)
#define PG8_TB(u) ((const char*)g.Bt + ((size_t)(u).pn * BM * g.ldb + (size_t)(u).boff) * 2)
    Unit cur, nxt; int ui = 0;
    if (!S.next(0, cur)) return;
    f32x4 acc[2][2][4][2];
#pragma unroll
    for (int a = 0; a < 2; ++a)
#pragma unroll
        for (int b = 0; b < 2; ++b)
#pragma unroll
            for (int m = 0; m < 4; ++m)
#pragma unroll
                for (int n = 0; n < 2; ++n) acc[a][b][m][n] = (f32x4){0.f, 0.f, 0.f, 0.f};
    bf16x8 At[4][2], B0[2][2], B1[2][2];
    const char* cA = PG8_TA(cur); const char* cB = PG8_TB(cur);
    PG8_STAGE(PG8_SB(0, 0), cB, voffB); PG8_STAGE(PG8_SB(0, 1), cB + hB, voffB); PG8_STAGE(PG8_SA(0, 0), cA, voffA); PG8_STAGE(PG8_SA(0, 1), cA + hA, voffA);
    if (wr == 1) PG8_BAR;
    PG8_WAIT_V(2); PG8_BAR;
    PG8_STAGE(PG8_SB(1, 0), cB + kstep, voffB); PG8_STAGE(PG8_SA(1, 0), cA + kstep, voffA); PG8_STAGE(PG8_SB(1, 1), cB + hB + kstep, voffB);
    PG8_WAIT_V(6); PG8_BAR;
    for (;;) {
        const bool has_next = S.next(ui + 1, nxt);
        const char* nA = has_next ? PG8_TA(nxt) : cA; const char* nB = has_next ? PG8_TB(nxt) : cB;
        for (int t = 0; t < nt; t += 2) {
            const bool last = (t == nt - 2);
            const char* a1 = cA + (size_t)(t + 1) * kstep;
            const char* a2 = last ? nA : cA + (size_t)(t + 2) * kstep; const char* b2 = last ? nB : cB + (size_t)(t + 2) * kstep;
            const char* a3 = a2 + kstep; const char* b3 = b2 + kstep;
            PG8_LDB(B0, 0, 0); PG8_LDB(B1, 0, 1); PG8_SCHED; PG8_LDA(At, 0, 0); PG8_STAGE(PG8_SA(1, 1), a1 + hA, voffA);
            PG8_WAIT_V(8); PG8_WAIT_L(0); PG8_BAR; PG8_MMA(0, 0, At, B0); PG8_MMA(0, 1, At, B1); PG8_BAR; PG8_SCHED;
            PG8_LDA(At, 0, 1); PG8_STAGE(PG8_SB(0, 0), b2, voffB); PG8_STAGE(PG8_SB(0, 1), b2 + hB, voffB); PG8_STAGE(PG8_SA(0, 0), a2, voffA);
            PG8_WAIT_V(8); PG8_WAIT_L(0); PG8_BAR; PG8_MMA(1, 0, At, B0); PG8_MMA(1, 1, At, B1); PG8_BAR; PG8_SCHED;
            PG8_LDB(B0, 1, 0); PG8_LDB(B1, 1, 1); PG8_SCHED; PG8_LDA(At, 1, 0); PG8_STAGE(PG8_SA(0, 1), a2 + hA, voffA);
            PG8_WAIT_V(8); PG8_WAIT_L(0); PG8_BAR; PG8_MMA(0, 0, At, B0); PG8_MMA(0, 1, At, B1); PG8_BAR; PG8_SCHED;
            PG8_LDA(At, 1, 1); PG8_STAGE(PG8_SB(1, 0), b3, voffB); PG8_STAGE(PG8_SB(1, 1), b3 + hB, voffB); PG8_STAGE(PG8_SA(1, 0), a3, voffA);
            PG8_WAIT_V(8); PG8_WAIT_L(0); PG8_BAR; PG8_MMA(1, 0, At, B0); PG8_MMA(1, 1, At, B1); PG8_BAR; PG8_SCHED;
        }
        E(acc, cur, wr, wc, fr, fq);
        if (!has_next) break;
#pragma unroll
        for (int a = 0; a < 2; ++a)
#pragma unroll
            for (int b = 0; b < 2; ++b)
#pragma unroll
                for (int m = 0; m < 4; ++m)
#pragma unroll
                    for (int n = 0; n < 2; ++n) acc[a][b][m][n] = (f32x4){0.f, 0.f, 0.f, 0.f};
        cur = nxt; cA = nA; cB = nB; ++ui;
    }
    PG8_WAIT_V(0);
    if (wr == 0) PG8_BAR;
    PG8_BAR;
#undef PG8_SA
#undef PG8_SB
#undef PG8_STAGE
#undef PG8_LDA
#undef PG8_LDB
#undef PG8_MMA
#undef PG8_WAIT_V
#undef PG8_WAIT_L
#undef PG8_BAR
#undef PG8_SCHED
#undef PG8_TA
#undef PG8_TB
}

struct EpiIn {
    bf16_t *Q; bf16_t* ZR; float* outK; float qscale;
    __device__ __forceinline__ void operator()(const f32x4 (&acc)[2][2][4][2], const Unit& u, int wr, int wc, int fr, int fq) const {
#pragma unroll
        for (int bj = 0; bj < 2; ++bj) {
            const int c0 = u.pn * BM + bj * HALF + wc * 32 + 8 * fq;
            if (c0 >= NIN) continue;
#pragma unroll
            for (int ai = 0; ai < 2; ++ai)
#pragma unroll
                for (int m = 0; m < 4; ++m) {
                    int r = u.pm * BM + ai * HALF + wr * 64 + m * 16 + fr; asm volatile("" : "+v"(r));
                    f32x4 v0 = acc[ai][bj][m][0], v1 = acc[ai][bj][m][1];
                    if (c0 < 1536) {
                        const int seg = c0 >> 9, cc = c0 & 511;
                        if (seg == 0) { v0 = v0 * qscale; v1 = v1 * qscale; }
                        else if (r < NCTX) { float* o = outK + (size_t)(seg - 1) * ((size_t)NCTX * 512) + (size_t)r * 512 + cc; *(f32x4*)o = v0; *(f32x4*)(o + 4) = v1; }
                        bf16_t* dst = Q + (size_t)seg * ((size_t)NTOK * 512) + (size_t)r * 512 + cc;
                        u32x4 w; w.x = pk2(v0[0], v0[1]); w.y = pk2(v0[2], v0[3]); w.z = pk2(v1[0], v1[1]); w.w = pk2(v1[2], v1[3]);
                        *(u32x4*)dst = w;
                    } else {
                        u32x4 w; w.x = pk2(v0[0], v0[1]); w.y = pk2(v0[2], v0[3]); w.z = pk2(v1[0], v1[1]); w.w = pk2(v1[2], v1[3]);
                        *(u32x4*)(ZR + (size_t)r * RC + (c0 - 1536)) = w;
                    }
                }
        }
    }
};
DI float decay1(float x) { return __expf(-0.60653065971f * sigmoid_f(x)); }
struct EpiLora {
    float *DEC, *AA, *G; const float *w0, *a0;
    __device__ __forceinline__ void operator()(const f32x4 (&acc)[2][2][4][2], const Unit& u, int wr, int wc, int fr, int fq) const {
#pragma unroll
        for (int bj = 0; bj < 2; ++bj) {
            const int c0 = u.pn * BM + bj * HALF + wc * 32 + 8 * fq;
            const int grp = c0 >> 10, cg = c0 & 1023, dir = cg >> 9, cc = cg & 511;
            const float* bp = (grp == 0 ? w0 : a0) + dir * 512 + cc;
            float* ob = DEC + (size_t)dir * NTOK * 512 + cc;
            bf16_t* obh = grp == 2 ? (bf16_t*)G + cc : (bf16_t*)AA + (size_t)dir * NTOK * 512 + cc;
#pragma unroll
            for (int ai = 0; ai < 2; ++ai)
#pragma unroll
                for (int m = 0; m < 4; ++m) {
                    int r = u.pm * BM + ai * HALF + wr * 64 + m * 16 + fr; asm volatile("" : "+v"(r));
                    f32x4 v0 = acc[ai][bj][m][0], v1 = acc[ai][bj][m][1];
                    if (grp < 2) { const float* bq = bp; asm volatile("" : "+v"(bq)); v0 += *(const f32x4*)bq; v1 += *(const f32x4*)(bq + 4); }
                    if (grp == 0) { v0.x = decay1(v0.x); v0.y = decay1(v0.y); v0.z = decay1(v0.z); v0.w = decay1(v0.w); v1.x = decay1(v1.x); v1.y = decay1(v1.y); v1.z = decay1(v1.z); v1.w = decay1(v1.w); }
                    else if (grp == 1) { v0.x = sigmoid_f(v0.x); v0.y = sigmoid_f(v0.y); v0.z = sigmoid_f(v0.z); v0.w = sigmoid_f(v0.w); v1.x = sigmoid_f(v1.x); v1.y = sigmoid_f(v1.y); v1.z = sigmoid_f(v1.z); v1.w = sigmoid_f(v1.w); }
                    if (grp == 0) { float* o = ob + (size_t)r * 512; *(f32x4*)o = v0; *(f32x4*)(o + 4) = v1; }
                    else { u32x4 w; w.x = pk2(v0[0], v0[1]); w.y = pk2(v0[2], v0[3]); w.z = pk2(v1[0], v1[1]); w.w = pk2(v1[2], v1[3]); *(u32x4*)(obh + (size_t)r * 512) = w; }
                }
        }
    }
};
struct EpiPart {
    bf16_t* P; int ksplit;
    __device__ __forceinline__ void operator()(const f32x4 (&acc)[2][2][4][2], const Unit& u, int wr, int wc, int fr, int fq) const {
        bf16_t* base = P + (u.aoff ? (size_t)NTOK * D : 0);
#pragma unroll
        for (int bj = 0; bj < 2; ++bj) {
            const int c0 = u.pn * BM + bj * HALF + wc * 32 + 8 * fq;
#pragma unroll
            for (int ai = 0; ai < 2; ++ai)
#pragma unroll
                for (int m = 0; m < 4; ++m) {
                    int r = u.pm * BM + ai * HALF + wr * 64 + m * 16 + fr; asm volatile("" : "+v"(r));
                    const f32x4 v0 = acc[ai][bj][m][0], v1 = acc[ai][bj][m][1];
                    u32x4 w; w.x = pk2(v0[0], v0[1]); w.y = pk2(v0[2], v0[3]); w.z = pk2(v1[0], v1[1]); w.w = pk2(v1[2], v1[3]);
                    *(u32x4*)(base + (size_t)r * D + c0) = w;
                }
        }
    }
};
template <int CTRL> DI float dppf(float x) { return __builtin_bit_cast(float, __builtin_amdgcn_mov_dpp(__builtin_bit_cast(int, x), CTRL, 0xf, 0xf, true)); }
struct EpiFfnAct {
    bf16_t* ACT; float* EDGE; const float* wcv; LAS unsigned char* ldsb;
    __device__ __forceinline__ void operator()(const f32x4 (&acc)[2][2][4][2], const Unit& u, int wr, int wc, int fr, int fq) const {
        LAS float* HL = (LAS float*)(ldsb + 131072);
        const int colh = wc * 32 + 8 * fq;
#pragma unroll
        for (int ai = 0; ai < 2; ++ai) { const int g = ai * 2 + wr;
            if (fr == 0) { *(LAS f32x4*)(HL + (g * 2 + 0) * 128 + colh) = acc[ai][0][0][0]; *(LAS f32x4*)(HL + (g * 2 + 0) * 128 + colh + 4) = acc[ai][0][0][1]; }
            if (fr == 15) { *(LAS f32x4*)(HL + (g * 2 + 1) * 128 + colh) = acc[ai][0][3][0]; *(LAS f32x4*)(HL + (g * 2 + 1) * 128 + colh + 4) = acc[ai][0][3][1]; } }
        asm volatile("s_waitcnt lgkmcnt(0)" ::: "memory");
        __builtin_amdgcn_s_barrier(); __builtin_amdgcn_s_barrier();
        asm volatile("" ::: "memory");
        const int cf = u.pn * HALF + colh;
        const f32x4 zero = {0.f, 0.f, 0.f, 0.f};
        const bool lat = u.pm >= 16;
#pragma unroll
        for (int ai = 0; ai < 2; ++ai) {
            const int g = ai * 2 + wr;
            f32x4 hp[2], hn[2];
            hp[0] = g > 0 ? *(const LAS f32x4*)(HL + ((g - 1) * 2 + 1) * 128 + colh) : zero; hp[1] = g > 0 ? *(const LAS f32x4*)(HL + ((g - 1) * 2 + 1) * 128 + colh + 4) : zero;
            hn[0] = g < 3 ? *(const LAS f32x4*)(HL + ((g + 1) * 2 + 0) * 128 + colh) : zero; hn[1] = g < 3 ? *(const LAS f32x4*)(HL + ((g + 1) * 2 + 0) * 128 + colh + 4) : zero;
#pragma unroll
            for (int m = 0; m < 4; ++m) {
                int r = u.pm * BM + ai * HALF + wr * 64 + m * 16 + fr; asm volatile("" : "+v"(r));
                const float* wq_ = wcv + cf; asm volatile("" : "+v"(wq_));
                f32x4 uu[2], av[2];
#pragma unroll
                for (int n = 0; n < 2; ++n) {
                    const f32x4 cur = acc[ai][0][m][n];
                    f32x4 pv, nx;
#pragma unroll
                    for (int j = 0; j < 4; ++j) {
                        if (m > 0) pv[j] = dppf<0x121>(fr == 15 ? acc[ai][0][m > 0 ? m - 1 : 0][n][j] : cur[j]);
                        else { const float a = dppf<0x121>(cur[j]); pv[j] = fr == 0 ? hp[n][j] : a; }
                        if (m < 3) nx[j] = dppf<0x12F>(fr == 0 ? acc[ai][0][m < 3 ? m + 1 : 3][n][j] : cur[j]);
                        else { const float c = dppf<0x12F>(cur[j]); nx[j] = fr == 15 ? hn[n][j] : c; }
                    }
                    const f32x4 w0 = *(const f32x4*)(wq_ + 4 * n), w1 = *(const f32x4*)(wq_ + DFF + 4 * n), w2 = *(const f32x4*)(wq_ + 2 * DFF + 4 * n);
                    uu[n] = pv * w0 + cur * w1 + nx * w2;
                    const f32x4 a3 = acc[ai][1][m][n];
                    av[n] = (f32x4){silu_f(uu[n].x) * a3.x, silu_f(uu[n].y) * a3.y, silu_f(uu[n].z) * a3.z, silu_f(uu[n].w) * a3.w};
                }
                u32x4 w; w.x = pk2(av[0][0], av[0][1]); w.y = pk2(av[0][2], av[0][3]); w.z = pk2(av[1][0], av[1][1]); w.w = pk2(av[1][2], av[1][3]);
                *(u32x4*)(ACT + (size_t)r * DFF + cf) = w;
                if (lat && ((ai == 0 && m == 0) || (ai == 1 && m == 3))) {
                    const int e = ai;
                    const bool mine = e == 0 ? (wr == 0 && fr == 0) : (wr == 1 && fr == 15);
                    if (mine) {
                        float* eb = EDGE + ((size_t)u.pm * 2 + e) * DFF + cf;
                        *(f32x4*)(eb) = acc[ai][0][m][0]; *(f32x4*)(eb + 4) = acc[ai][0][m][1];
                        *(f32x4*)(eb + 64 * DFF) = uu[0]; *(f32x4*)(eb + 64 * DFF + 4) = uu[1];
                        *(f32x4*)(eb + 128 * DFF) = acc[ai][1][m][0]; *(f32x4*)(eb + 128 * DFF + 4) = acc[ai][1][m][1];
                    }
                }
            }
        }
    }
};
}

template <int MODE>
DI void transpose_item(const float* W, int K, int N, bf16_t* WT, LAS float* scr, int item, int lane) {
    const int nblk = N / 32, kb = item / nblk, nb = item % nblk, k0 = 64 * kb, n0 = 32 * nb;
#pragma unroll 8
    for (int i = 0; i < 32; ++i) { const int kk = 2 * i + (lane >> 5); scr[kk * 33 + (lane & 31)] = W[(size_t)(k0 + kk) * N + n0 + (lane & 31)]; }
    asm volatile("s_waitcnt lgkmcnt(0)" ::: "memory");
    const int c = lane & 7;
#pragma unroll
    for (int j = 0; j < 4; ++j) { const int n = (lane >> 3) + 8 * j; const LAS float* s = scr + (8 * c) * 33 + n;
        u32x4 o; o.x = pk2(s[0 * 33], s[1 * 33]); o.y = pk2(s[2 * 33], s[3 * 33]); o.z = pk2(s[4 * 33], s[5 * 33]); o.w = pk2(s[6 * 33], s[7 * 33]);
        const int nn = n0 + n; const int drow = MODE == 0 ? nn : ((nn >> 7) * 256 + (nn & 127) + (MODE == 2 ? 128 : 0));
        *(u32x4*)(WT + (size_t)drow * K + k0 + 8 * c) = o; }
    asm volatile("s_waitcnt lgkmcnt(0)" ::: "memory");
}

DI void phase0(KP p, LAS unsigned char* lds, int gw, int NGW, int gtid, int NGT, int wave, int lane, bool defer_ffn) {
    unsigned char* ws = p->ws;
    {
        float* MOD = (float*)(ws + WS_MOD);
        const float* w_ada = p->in[7]; const float* b_ada = p->in[8]; const float* c_lat = p->in[5]; const float* c_ctx = p->in[6];
        LAS float* red = (LAS float*)(lds + 8 * 8448);
        const int tid = wave * 64 + lane, cgp = lane & 15, kr = lane >> 4;
        for (int nb = blockIdx.x; nb < 96; nb += gridDim.x) {
            f32x4 a0 = {0, 0, 0, 0}, a1 = a0, a2 = a0;
#pragma unroll 8
            for (int i = 0; i < 32; ++i) {
                const int k = wave * 128 + 4 * i + kr;
                const f32x4 w = *(const f32x4*)(w_ada + (size_t)k * 6144 + nb * 64 + 4 * cgp);
                a0 += w * silu_f(c_ctx[k]); a1 += w * silu_f(c_lat[k]); a2 += w * silu_f(c_lat[D + k]);
            }
#pragma unroll
            for (int j = 0; j < 4; ++j) {
                a0[j] += __shfl_xor(a0[j], 16); a0[j] += __shfl_xor(a0[j], 32);
                a1[j] += __shfl_xor(a1[j], 16); a1[j] += __shfl_xor(a1[j], 32);
                a2[j] += __shfl_xor(a2[j], 16); a2[j] += __shfl_xor(a2[j], 32);
            }
            if (kr == 0) { *(LAS f32x4*)(red + (wave * 3 + 0) * 64 + 4 * cgp) = a0; *(LAS f32x4*)(red + (wave * 3 + 1) * 64 + 4 * cgp) = a1; *(LAS f32x4*)(red + (wave * 3 + 2) * 64 + 4 * cgp) = a2; }
            __syncthreads();
            if (tid < 192) {
                const int i = tid >> 6, c = tid & 63; float s = b_ada[nb * 64 + c];
#pragma unroll
                for (int w = 0; w < 8; ++w) s += red[(w * 3 + i) * 64 + c];
                MOD[i * 6144 + nb * 64 + c] = s;
            }
            __syncthreads();
        }
    }
    {
        LAS float* scr = (LAS float*)(lds + wave * 8448);
        constexpr int I_IN = 16 * 108, I_OUT = 16 * 32, I_F = 16 * 88, I_2 = 44 * 32, NIT = I_IN + I_OUT + 2 * I_F + I_2;
        const int nit = defer_ffn ? I_IN + I_OUT : NIT;
        for (int it = gw; it < nit; it += NGW) {
            int r = it;
            if (r < I_IN) { transpose_item<0>(p->in[11], D, NIN, (bf16_t*)(ws + WS_WTIN), scr, r, lane); continue; } r -= I_IN;
            if (r < I_OUT) { transpose_item<0>(p->in[24], D, D, (bf16_t*)(ws + WS_WTOUT), scr, r, lane); continue; } r -= I_OUT;
            if (r < I_F) { transpose_item<1>(p->in[25], D, DFF, (bf16_t*)(ws + WS_WT13), scr, r, lane); continue; } r -= I_F;
            if (r < I_F) { transpose_item<2>(p->in[26], D, DFF, (bf16_t*)(ws + WS_WT13), scr, r, lane); continue; } r -= I_F;
            transpose_item<0>(p->in[28], DFF, D, (bf16_t*)(ws + WS_WT2), scr, r, lane);
        }
    }
    { u32x4* z = (u32x4*)((bf16_t*)(ws + WS_WTIN) + (size_t)NIN * D); for (int i = gtid; i < 128 * D / 8; i += NGT) z[i] = (u32x4){0, 0, 0, 0}; }
    {
        bf16_t* WL = (bf16_t*)(ws + WS_WTLORA); const float* w2 = p->in[14]; const float* a2 = p->in[16]; const float* g2 = p->in[17];
        for (int i = gtid; i < 2560 * 128; i += NGT) {
            const int n = i >> 7, k = i & 127; float v = 0.f;
            if (n < 2048) { const int grp = n >> 10, dir = (n >> 9) & 1, c = n & 511; const float* src = grp == 0 ? w2 : a2;
                if ((k >> 6) == dir) v = src[((size_t)dir * 64 + (k & 63)) * 512 + c]; }
            else v = g2[(size_t)k * 512 + (n - 2048)];
            WL[i] = (bf16_t)(pk2(v, 0.f) & 0xffffu);
        }
    }
    {
        const f32x4* ck = (const f32x4*)p->in[2]; const f32x4* cv = (const f32x4*)p->in[3]; u32x2* CK = (u32x2*)(ws + WS_CK); u32x2* CV = (u32x2*)(ws + WS_CV);
        for (int i = gtid; i < 1024 * 512 / 4; i += NGT) { const f32x4 a = ck[i], b = cv[i]; CK[i] = (u32x2){pk2(a[0], a[1]), pk2(a[2], a[3])}; CV[i] = (u32x2){pk2(b[0], b[1]), pk2(b[2], b[3])}; }
    }
}

DI void ffn_transposes(KP p, LAS unsigned char* lds, int which, int widx, int nw, int wave, int lane) {
    LAS float* scr = (LAS float*)(lds + wave * 8448);
    constexpr int I_F = 16 * 88, I_2 = 44 * 32;
    if (which == 0) { for (int it = widx; it < I_2; it += nw) transpose_item<0>(p->in[28], DFF, D, (bf16_t*)(p->ws + WS_WT2), scr, it, lane); }
    else { for (int it = widx; it < 2 * I_F; it += nw) { if (it < I_F) transpose_item<1>(p->in[25], D, DFF, (bf16_t*)(p->ws + WS_WT13), scr, it, lane);
                                                           else transpose_item<2>(p->in[26], D, DFF, (bf16_t*)(p->ws + WS_WT13), scr, it - I_F, lane); } }
}

template <int SRC, int NR>
DI void norm_rows(KP p, int rbase, int rstride, int lane, const float* normw, int sh_off, int sc_off, int gate_off, bf16_t* Hout, float* xout) {
    const float* MODb = (const float*)(p->ws + WS_MOD);
    const bf16_t* PART = (const bf16_t*)(p->ws + WS_PART);
    f32x4 v[NR][4];
#pragma unroll
    for (int q = 0; q < NR; ++q) { const f32x4* xr = (const f32x4*)xrow_of(p, rbase + q * rstride) + lane;
#pragma unroll
        for (int j = 0; j < 4; ++j) v[q][j] = xr[64 * j]; }
    if (SRC == 1) {
        u32x2 p0[NR][4], p1[NR][4];
#pragma unroll
        for (int q = 0; q < NR; ++q) { const int r = rbase + q * rstride;
#pragma unroll
            for (int j = 0; j < 4; ++j) { p0[q][j] = *((const u32x2*)(PART + (size_t)r * D) + lane + 64 * j); p1[q][j] = *((const u32x2*)(PART + (size_t)(NTOK + r) * D) + lane + 64 * j); } }
#pragma unroll
        for (int q = 0; q < NR; ++q) { const int r = rbase + q * rstride; const float* MOD = MODb + midx_of(r) * 6144;
#pragma unroll
            for (int j = 0; j < 4; ++j) { const f32x4 gt = *((const f32x4*)(MOD + gate_off) + lane + 64 * j); v[q][j] = v[q][j] + gt * (unpk4(p0[q][j]) + unpk4(p1[q][j])); } }
    }
    float s[NR];
#pragma unroll
    for (int q = 0; q < NR; ++q) { s[q] = 0.f;
#pragma unroll
        for (int j = 0; j < 4; ++j) s[q] += (v[q][j].x * v[q][j].x + v[q][j].y * v[q][j].y) + (v[q][j].z * v[q][j].z + v[q][j].w * v[q][j].w); }
#pragma unroll
    for (int o = 1; o < 64; o <<= 1) {
#pragma unroll
        for (int q = 0; q < NR; ++q) s[q] += __shfl_xor(s[q], o); }
#pragma unroll
    for (int q = 0; q < NR; ++q) {
        const int r = rbase + q * rstride; const float* MOD = MODb + midx_of(r) * 6144;
        const float rstd = rsqrtf(s[q] * (1.f / D) + EPS);
        u32x2* o = (u32x2*)(Hout + (size_t)r * D) + lane;
#pragma unroll
        for (int j = 0; j < 4; ++j) {
            if (SRC == 1) *((f32x4*)(xout + (size_t)r * D) + lane + 64 * j) = v[q][j];
            const f32x4 g = *((const f32x4*)normw + lane + 64 * j), sc = *((const f32x4*)(MOD + sc_off) + lane + 64 * j), sh = *((const f32x4*)(MOD + sh_off) + lane + 64 * j);
            const f32x4 h = v[q][j] * rstd * g * (sc + 1.f) + sh;
            o[64 * j] = (u32x2){pk2(h.x, h.y), pk2(h.z, h.w)};
        }
    }
}

#define MFMA32(a, b, c) __builtin_amdgcn_mfma_f32_32x32x16_bf16((a), (b), (c), 0, 0, 0)
DI int crow(int reg, int h) { return (reg & 3) + 8 * (reg >> 2) + 4 * h; }
typedef short v4i16_t __attribute__((ext_vector_type(4)));
DI s16x4 vtr(const LAS unsigned char* p) { return __builtin_bit_cast(s16x4, __builtin_amdgcn_ds_read_tr16_b64_v4i16((LAS v4i16_t*)p)); }

template <bool LATENT, int MODE>
DI void attn_unit(KP p, LAS unsigned char* vbuf, const LAS float* rpbL, int unit, int lane, int t0, int t1, LAS float* xch) {
    const bf16_t* Q = (const bf16_t*)(p->ws + WS_Q); const bf16_t* Kb = (const bf16_t*)(p->ws + WS_K); const bf16_t* Vb = (const bf16_t*)(p->ws + WS_V);
    const bf16_t* CK = (const bf16_t*)(p->ws + WS_CK); const bf16_t* CV = (const bf16_t*)(p->ws + WS_CV);
    bf16_t* MIX = (bf16_t*)(p->ws + WS_MIX);
    const int r = lane & 31, hh = lane >> 5;
    int head, qrow0, b, gi = 0, w0 = 0, si = 0, ntile;
    if (LATENT) { head = unit & 7; const int t = unit >> 3; w0 = (t & 1) * 32; gi = (t >> 1) & 31; b = t >> 6; qrow0 = NCTX + b * DSEQ + gi * 64 + w0; si = min(max(gi - 4, 0), 24); ntile = 32; }
    else { head = unit & 7; const int t = unit >> 3; const int qb = t & 7; b = t >> 3; qrow0 = b * SEQ + qb * 32; ntile = 8; }
    bf16x8 qf[4];
#pragma unroll
    for (int s = 0; s < 4; ++s) qf[s] = *(const bf16x8*)(Q + (size_t)(qrow0 + r) * 512 + head * 64 + 16 * s + 8 * hh);
    auto tile_ptrs = [&](int t, const bf16_t*& kp, const bf16_t*& vp) {
        if (LATENT) {
            if (t < 16) { const size_t row = (size_t)b * 512 + t * 32; kp = CK + row * 512; vp = CV + row * 512; }
            else { const int lt = t - 16; const size_t row = (size_t)NCTX + b * DSEQ + (si + (lt >> 1)) * 64 + (((lt & 1) * 32) ^ w0); kp = Kb + row * 512; vp = Vb + row * 512; }
        } else { const size_t row = (size_t)b * SEQ + t * 32; kp = Kb + row * 512; vp = Vb + row * 512; }
    };
    bf16x8 kf[4], kn[4]; u32x4 vn[4];
    {
        const bf16_t *kp, *vp; tile_ptrs(t0, kp, vp);
#pragma unroll
        for (int s = 0; s < 4; ++s) kf[s] = *(const bf16x8*)(kp + (size_t)r * 512 + head * 64 + 16 * s + 8 * hh);
#pragma unroll
        for (int i = 0; i < 4; ++i) { const int c = lane + 64 * i; vn[i] = *(const u32x4*)(vp + (size_t)(c >> 3) * 512 + head * 64 + (c & 7) * 8); }
#pragma unroll
        for (int i = 0; i < 4; ++i) { const int c = lane + 64 * i; *(LAS u32x4*)(vbuf + (c >> 3) * 144 + (c & 7) * 16) = vn[i]; }
    }
    f32x16 o0, o1;
#pragma unroll
    for (int i = 0; i < 16; ++i) { o0[i] = 0.f; o1[i] = 0.f; }
    float mrun = -1e30f, lrun = 0.f;
    const int i16 = lane & 15, tq = i16 >> 2, tp = i16 & 3, blk = (lane >> 4) & 1;
    const LAS unsigned char* vtbase = vbuf + (4 * hh + tq) * 144 + (16 * blk) * 2 + 8 * tp;
    const int wq = w0 + r;
    const int cs = min(max(wq - 8, 0), 48);
    for (int t = t0; t < t1; ++t) {
        const bool more = (t + 1 < t1);
        if (more) {
            const bf16_t *kp, *vp; tile_ptrs(t + 1, kp, vp);
#pragma unroll
            for (int s = 0; s < 4; ++s) kn[s] = *(const bf16x8*)(kp + (size_t)r * 512 + head * 64 + 16 * s + 8 * hh);
#pragma unroll
            for (int i = 0; i < 4; ++i) { const int c = lane + 64 * i; vn[i] = *(const u32x4*)(vp + (size_t)(c >> 3) * 512 + head * 64 + (c & 7) * 8); }
        }
        f32x16 st;
#pragma unroll
        for (int i = 0; i < 16; ++i) st[i] = 0.f;
#pragma unroll
        for (int s = 0; s < 4; ++s) st = MFMA32(kf[s], qf[s], st);
        if (LATENT && t >= 16) {
            const int lt = t - 16, a = lt >> 1, c0 = ((lt & 1) * 32) ^ w0;
            const int row_off = si + a - gi + 7;
            const int d0 = c0 + 4 * hh - cs;
            const LAS float* bp = rpbL + head * 465 + row_off * 31 + (c0 + 4 * hh - wq + 15);
#pragma unroll
            for (int i = 0; i < 16; ++i) {
                const int ci = (i & 3) + 8 * (i >> 2);
                const bool valid = (unsigned)(d0 + ci) < 16u;
                const float bias = valid ? bp[ci] : 0.f;
                st[i] = valid ? st[i] + bias : -INFINITY;
            }
        }
        float tmax = st[0];
#pragma unroll
        for (int i = 1; i < 16; ++i) tmax = fmaxf(tmax, st[i]);
        tmax = fmaxf(tmax, __shfl_xor(tmax, 32));
        const float mnew = fmaxf(mrun, tmax);
        float ps = 0.f;
#pragma unroll
        for (int i = 0; i < 16; ++i) { st[i] = __builtin_amdgcn_exp2f(st[i] - mnew); ps += st[i]; }
        if (__builtin_amdgcn_ballot_w64(tmax > mrun) != 0ull) {
            const float alpha = __builtin_amdgcn_exp2f(mrun - mnew);
            lrun *= alpha;
#pragma unroll
            for (int i = 0; i < 16; ++i) { o0[i] *= alpha; o1[i] *= alpha; }
        }
        lrun += ps; mrun = mnew;
        bf16x8 pb[2];
#pragma unroll
        for (int s = 0; s < 2; ++s) { u32x4 w; w.x = pk2(st[8 * s], st[8 * s + 1]); w.y = pk2(st[8 * s + 2], st[8 * s + 3]); w.z = pk2(st[8 * s + 4], st[8 * s + 5]); w.w = pk2(st[8 * s + 6], st[8 * s + 7]); pb[s] = __builtin_bit_cast(bf16x8, w); }
        asm volatile("s_waitcnt lgkmcnt(0)" ::: "memory");
#pragma unroll
        for (int s = 0; s < 2; ++s) {
            const LAS unsigned char* bs = vtbase + (16 * s) * 144;
            const s16x4 lo0 = vtr(bs), hi0 = vtr(bs + 8 * 144), lo1 = vtr(bs + 64), hi1 = vtr(bs + 8 * 144 + 64);
            const bf16x8 va0 = __builtin_shufflevector(lo0, hi0, 0, 1, 2, 3, 4, 5, 6, 7), va1 = __builtin_shufflevector(lo1, hi1, 0, 1, 2, 3, 4, 5, 6, 7);
            o0 = MFMA32(va0, pb[s], o0); o1 = MFMA32(va1, pb[s], o1);
        }
        asm volatile("s_waitcnt lgkmcnt(0)" ::: "memory");
        if (more) {
#pragma unroll
            for (int i = 0; i < 4; ++i) { const int c = lane + 64 * i; *(LAS u32x4*)(vbuf + (c >> 3) * 144 + (c & 7) * 16) = vn[i]; }
#pragma unroll
            for (int s = 0; s < 4; ++s) kf[s] = kn[s];
        }
    }
    if (MODE == 1) {
#pragma unroll
        for (int i = 0; i < 16; ++i) { xch[i * 64 + lane] = o0[i]; xch[(16 + i) * 64 + lane] = o1[i]; }
        xch[32 * 64 + lane] = mrun; xch[33 * 64 + lane] = lrun;
        __syncthreads();
        return;
    }
    if (MODE == 2) {
        __syncthreads();
        const float mb = xch[32 * 64 + lane], lb = xch[33 * 64 + lane];
        const float mm = fmaxf(mrun, mb), fa = exp2f(mrun - mm), fb = exp2f(mb - mm);
#pragma unroll
        for (int i = 0; i < 16; ++i) { o0[i] = o0[i] * fa + xch[i * 64 + lane] * fb; o1[i] = o1[i] * fa + xch[(16 + i) * 64 + lane] * fb; }
        lrun = lrun * fa + lb * fb;
    }
    const float ltot = lrun + __shfl_xor(lrun, 32);
    const float inv = 1.f / ltot;
    bf16_t* orow = MIX + (size_t)(qrow0 + r) * D + head * 64;
#pragma unroll
    for (int g4 = 0; g4 < 4; ++g4) {
        const int d = 8 * g4 + 4 * hh;
        *(u32x2*)(orow + d) = (u32x2){pk2(o0[4 * g4] * inv, o0[4 * g4 + 1] * inv), pk2(o0[4 * g4 + 2] * inv, o0[4 * g4 + 3] * inv)};
        *(u32x2*)(orow + 32 + d) = (u32x2){pk2(o1[4 * g4] * inv, o1[4 * g4 + 1] * inv), pk2(o1[4 * g4 + 2] * inv, o1[4 * g4 + 3] * inv)};
    }
}

DI void prep_rows8(KP p, int r0, int lane) {
    const bf16_t* ZR = (const bf16_t*)(p->ws + WS_ZR); const float* wts = p->in[12]; const float* k_k = p->in[18];
    bf16_t* R = (bf16_t*)(p->ws + WS_R); bf16_t* KR = (bf16_t*)(p->ws + WS_KR); bf16_t* VV = (bf16_t*)(p->ws + WS_VV); bf16_t* KK = (bf16_t*)(p->ws + WS_KK);
    bf16_t* AL = (bf16_t*)(p->ws + WS_ALORA);
    const int t0 = r0 < NCTX ? (r0 & 255) : ((r0 - NCTX) & 2047); const int T = r0 < NCTX ? SEQ : DSEQ;
    const bool hp = t0 > 0, hn = t0 + 8 < T;
    const bf16_t* zb = ZR + (size_t)(r0 - 1) * RC;
    const f32x4 zero = {0, 0, 0, 0};
#pragma unroll 1
    for (int seg = 0; seg < 3; ++seg) {
        const int c = seg * 512 + lane * 8;
        f32x4 z[10][2];
#pragma unroll
        for (int i = 0; i < 10; ++i) { const bool ok = (i > 0 || hp) && (i < 9 || hn);
            if (ok) { const u32x4 w = *(const u32x4*)(zb + (size_t)i * RC + c); z[i][0] = unpk4((u32x2){w.x, w.y}); z[i][1] = unpk4((u32x2){w.z, w.w}); } else { z[i][0] = zero; z[i][1] = zero; } }
        const f32x4 wa0 = *(const f32x4*)(wts + c), wa1 = *(const f32x4*)(wts + c + 4), wb0 = *(const f32x4*)(wts + RC + c), wb1 = *(const f32x4*)(wts + RC + c + 4),
                    wc0 = *(const f32x4*)(wts + 2 * RC + c), wc1 = *(const f32x4*)(wts + 2 * RC + c + 4);
        const f32x4 k0 = *(const f32x4*)(k_k + lane * 8), k1 = *(const f32x4*)(k_k + lane * 8 + 4);
        bf16_t* dstb = (seg == 0 ? R : (seg == 1 ? KR : VV)) + (size_t)r0 * 512 + lane * 8;
#pragma unroll
        for (int i = 0; i < 8; ++i) {
            const f32x4 u0 = z[i][0] * wa0 + z[i + 1][0] * wb0 + z[i + 2][0] * wc0, u1 = z[i][1] * wa1 + z[i + 1][1] * wb1 + z[i + 2][1] * wc1;
            *(u32x4*)(dstb + (size_t)i * 512) = (u32x4){pk2(u0.x, u0.y), pk2(u0.z, u0.w), pk2(u1.x, u1.y), pk2(u1.z, u1.w)};
            if (seg == 1) {
                const f32x4 a = u0 * k0, bq = u1 * k1;
                float sq = (a.x * a.x + a.y * a.y) + (a.z * a.z + a.w * a.w) + (bq.x * bq.x + bq.y * bq.y) + (bq.z * bq.z + bq.w * bq.w);
                sq += __shfl_xor(sq, 1); sq += __shfl_xor(sq, 2); sq += __shfl_xor(sq, 4);
                const float rn = rsqrtf(sq + 1e-12f);
                const f32x4 ka_ = a * rn, kb_ = bq * rn; *(u32x4*)(KK + (size_t)(r0 + i) * 512 + lane * 8) = (u32x4){pk2(ka_.x, ka_.y), pk2(ka_.z, ka_.w), pk2(kb_.x, kb_.y), pk2(kb_.z, kb_.w)};
            }
        }
    }
    {
        const int cl = lane * 6, cc = 1536 + cl;
        const f32x2 zero2 = {0, 0};
        f32x2 z[10][3];
#pragma unroll
        for (int i = 0; i < 10; ++i) { const bool ok = (i > 0 || hp) && (i < 9 || hn);
#pragma unroll
            for (int q = 0; q < 3; ++q) { if (ok) { const unsigned w = *(const unsigned*)(zb + (size_t)i * RC + cc + 2 * q); z[i][q] = (f32x2){__builtin_bit_cast(float, w << 16), __builtin_bit_cast(float, w & 0xffff0000u)}; } else z[i][q] = zero2; } }
#pragma unroll
        for (int q = 0; q < 3; ++q) {
            const f32x2 wa = *(const f32x2*)(wts + cc + 2 * q), wb = *(const f32x2*)(wts + RC + cc + 2 * q), wcq = *(const f32x2*)(wts + 2 * RC + cc + 2 * q);
            const int cq = cl + 2 * q, grp = cq >> 7, k = cq & 127;
#pragma unroll
            for (int i = 0; i < 8; ++i) {
                f32x2 u = z[i][q] * wa + z[i + 1][q] * wb + z[i + 2][q] * wcq;
                if (grp == 0) { u.x = tanh_f(u.x); u.y = tanh_f(u.y); }
                else if (grp == 2) { u.x = sigmoid_f(u.x); u.y = sigmoid_f(u.y); }
                *(unsigned*)(AL + ((size_t)grp * NTOK + r0 + i) * 128 + k) = pk2(u.x, u.y);
            }
        }
    }
}

template <int CTRL> DI float dppf_(float x) { return __builtin_bit_cast(float, __builtin_amdgcn_mov_dpp(__builtin_bit_cast(int, x), CTRL, 0xf, 0xf, true)); }
template <int CTRL> DI float dpp_add(float x) { const int y = __builtin_amdgcn_mov_dpp(__builtin_bit_cast(int, x), CTRL, 0xf, 0xf, true); return x + __builtin_bit_cast(float, y); }
DI float red16(float x) { x = dpp_add<0xB1>(x); x = dpp_add<0x4E>(x); x = dpp_add<0x141>(x); x = dpp_add<0x140>(x); return x; }

constexpr int TC = 16;
DI float tred4(float q0, float q1, float q2, float q3, bool b0, bool b1) {
    const float ka = b0 ? q2 : q0, kb = b0 ? q3 : q1, sa = b0 ? q0 : q2, sb = b0 ? q1 : q3;
    const float a = ka + dppf_<0xB1>(sa), b = kb + dppf_<0xB1>(sb);
    float c = (b1 ? b : a) + dppf_<0x4E>(b1 ? a : b);
    c += dppf_<0x124>(c);
    c += dppf_<0x128>(c);
    return c;
}
DI f32x2 lo2(f32x4 v) { return __builtin_shufflevector(v, v, 0, 1); }
DI f32x2 hi2(f32x4 v) { return __builtin_shufflevector(v, v, 2, 3); }
struct ScanOps { f32x4 kk, rr, ww, bb, kd; float vv; };
struct ScanLd { f32x4 kk, r, dec, aa, kr, v; };
DI void scan_item(KP p, LAS unsigned char* lds, int latent, int sc, int qr, int tid) {
    const bf16_t* KK = (const bf16_t*)(p->ws + WS_KK); const bf16_t* R = (const bf16_t*)(p->ws + WS_R); const bf16_t* KR = (const bf16_t*)(p->ws + WS_KR);
    const bf16_t* VV = (const bf16_t*)(p->ws + WS_VV); const float* k_a = p->in[19];
    float* Y = (float*)(p->ws + WS_Y);
    const int b = sc >> 4, dir = (sc >> 3) & 1, h = sc & 7;
    const int T = latent ? DSEQ : SEQ; const size_t rowbase = latent ? (size_t)NCTX + (size_t)b * DSEQ : (size_t)b * SEQ;
    const float* DEC = (const float*)(p->ws + WS_DEC) + (size_t)dir * NTOK * 512; const bf16_t* AA = (const bf16_t*)(p->ws + WS_AA) + (size_t)dir * NTOK * 512;
    float* Yd = Y + (size_t)dir * NTOK * 512;
    LAS float* buf = (LAS float*)lds;
    LAS float* vb = (LAS float*)(lds + 2 * TC * 320 * 4);
    const int wave = tid >> 6, lane = tid & 63;
    const bool consumer = wave < 4;
    const int nchunk = T / TC;
    const int rl = lane >> 4, ks = lane & 15, row = 16 * qr + 4 * wave + rl;
    f32x2 S01 = {0, 0}, S23 = {0, 0};
    if (consumer && latent) { const f32x4 s4 = *(const f32x4*)(p->in[4] + ((((size_t)b * 2 + dir) * 8 + h) * 64 + row) * 64 + 4 * ks); S01 = lo2(s4); S23 = hi2(s4); }
    const int lt = tid - 256, lj = lt >> 4, li = lt & 15;
    ScanLd L0, L1; f32x4 ka4 = {0, 0, 0, 0};
    if (!consumer) ka4 = *(const f32x4*)(k_a + h * 64 + 4 * li);
    float* ybase = Yd + (rowbase)*512 + h * 64 + row;
    const bool kb0 = (ks & 1) != 0, kb1 = (ks & 2) != 0; const int ystep = 4 * (ks >> 2) + 2 * (ks & 1) + ((ks >> 1) & 1);
#define SCAN_LOAD(L, c) do { const int idx = (c) * TC + lj; const int tt = dir ? T - 1 - idx : idx; const size_t off = (rowbase + tt) * 512 + h * 64 + 4 * li; \
        L.kk = unpk4(*(const u32x2*)(KK + off)); L.r = unpk4(*(const u32x2*)(R + off)); L.dec = *(const f32x4*)(DEC + off); L.aa = unpk4(*(const u32x2*)(AA + off)); L.kr = unpk4(*(const u32x2*)(KR + off)); \
        if (lt < 64) { const int vj = lt >> 2, vq = lt & 3; const int idv = (c) * TC + vj; const int tv = dir ? T - 1 - idv : idv; L.v = unpk4(*(const u32x2*)(VV + (rowbase + tv) * 512 + h * 64 + 16 * qr + 4 * vq)); } } while (0)
#define SCAN_WRITE(L, bc, vc) do { const f32x4 bb_ = L.kk * L.aa; const f32x4 kd_ = L.kr * ((L.aa - 1.f) * ka4 + 1.f); LAS float* d_ = (bc) + lj * 320 + 4 * li; \
        *(LAS f32x4*)(d_) = L.kk; *(LAS f32x4*)(d_ + 64) = L.r; *(LAS f32x4*)(d_ + 128) = L.dec; *(LAS f32x4*)(d_ + 192) = bb_; *(LAS f32x4*)(d_ + 256) = kd_; \
        if (lt < 64) *(LAS f32x4*)((vc) + (lt >> 2) * 16 + 4 * (lt & 3)) = L.v; } while (0)
#define SCAN_LDOPS(o, bc, vc, j) do { const LAS float* d_ = (bc) + (j) * 320 + 4 * ks; o.kk = *(const LAS f32x4*)(d_); o.rr = *(const LAS f32x4*)(d_ + 64); o.ww = *(const LAS f32x4*)(d_ + 128); \
        o.bb = *(const LAS f32x4*)(d_ + 192); o.kd = *(const LAS f32x4*)(d_ + 256); o.vv = (vc)[(j) * 16 + 4 * wave + rl]; } while (0)
#define SCAN_COMPUTE(bc, vc, c) do { ScanOps oc, on, on2; SCAN_LDOPS(oc, bc, vc, 0); SCAN_LDOPS(on, bc, vc, 1); float ysel = 0.f; float yp0 = 0.f, yp1 = 0.f, yp2 = 0.f; \
        _Pragma("unroll") for (int j = 0; j < TC; ++j) { \
            if (j + 2 < TC) SCAN_LDOPS(on2, bc, vc, j + 2);     \
            f32x2 pq = S01 * lo2(oc.kk); pq = S23 * hi2(oc.kk) + pq; \
            const float sa = red16(pq.x + pq.y); \
            const f32x2 t01 = S01 * lo2(oc.ww) + lo2(oc.kd) * oc.vv, t23 = S23 * hi2(oc.ww) + hi2(oc.kd) * oc.vv; \
            S01 = t01 - lo2(oc.bb) * sa; S23 = t23 - hi2(oc.bb) * sa; \
            f32x2 yq = S01 * lo2(oc.rr); yq = S23 * hi2(oc.rr) + yq; \
            const float yp = yq.x + yq.y; \
            if ((j & 3) == 0) yp0 = yp; else if ((j & 3) == 1) yp1 = yp; else if ((j & 3) == 2) yp2 = yp; \
            else { const float yr = tred4(yp0, yp1, yp2, yp, kb0, kb1); ysel = ((ks >> 2) == (j >> 2)) ? yr : ysel; } \
            oc = on; on = on2; \
            asm volatile("" ::: "memory"); } \
        { const int idx = (c) * TC + ystep; const int tt = dir ? T - 1 - idx : idx; ybase[(size_t)tt * 512] = ysel; } } while (0)
    if (!consumer) { SCAN_LOAD(L0, 0); SCAN_LOAD(L1, 1); }
    for (int c = 0; c < nchunk; c += 2) {
        if (!consumer) SCAN_WRITE(L0, buf, vb);
        __syncthreads();
        if (!consumer) { if (c + 2 < nchunk) SCAN_LOAD(L0, c + 2); }
        else SCAN_COMPUTE(buf, vb, c);
        if (!consumer) SCAN_WRITE(L1, buf + TC * 320, vb + TC * 16);
        __syncthreads();
        if (!consumer) { if (c + 3 < nchunk) SCAN_LOAD(L1, c + 3); }
        else SCAN_COMPUTE(buf + TC * 320, vb + TC * 16, c + 1);
    }
#undef SCAN_LOAD
#undef SCAN_WRITE
#undef SCAN_LDOPS
#undef SCAN_COMPUTE
    if (consumer && !latent) *(f32x4*)(p->out + OUT_S + ((((size_t)b * 2 + dir) * 8 + h) * 64 + row) * 64 + 4 * ks) = (f32x4){S01.x, S01.y, S23.x, S23.y};
    __syncthreads();
}

constexpr int CS_L = 32, CS_LAT = 2048, CS_CHUNKS = 4096;
DI unsigned char* cs_mf(unsigned char* ws, int q) { return ws + 28 * MiB + (size_t)q * 8192; }
DI unsigned char* cs_q1(unsigned char* ws, int q) { return q < CS_LAT ? ws + 60 * MiB + (size_t)q * 4096 : ws + 76 * MiB + (size_t)(q - CS_LAT) * 4096; }
DI unsigned char* cs_q2(unsigned char* ws, int q) { return q < CS_LAT ? ws + 92 * MiB + (size_t)q * 4096 : ws + 108 * MiB + (size_t)(q - CS_LAT) * 4096; }
DI unsigned char* cs_nt(unsigned char* ws, int q) { return q < CS_LAT ? ws + 202 * MiB + (size_t)q * 8192 : ws + 234 * MiB + (size_t)(q - CS_LAT) * 8192; }
constexpr int CS_G = 49152;
DI bf16x8 frag_nat(const LAS unsigned char* img, int pitch, int rc, int s, int hh) { return *(const LAS bf16x8*)(img + rc * pitch + (16 * s + 8 * hh) * 2); }
DI bf16x8 frag_krow(const LAS unsigned char* img, int pitch, int rc, int s, int hh) {
    const s16x4 lo = *(const LAS s16x4*)(img + rc * pitch + (16 * s + 4 * hh) * 2), hi = *(const LAS s16x4*)(img + rc * pitch + (16 * s + 8 + 4 * hh) * 2);
    return __builtin_shufflevector(lo, hi, 0, 1, 2, 3, 4, 5, 6, 7); }
DI bf16x8 frag_tr(const LAS unsigned char* img, int pitch, int col0, int s, int lane) {
    const int i16 = lane & 15, tq = i16 >> 2, tp = i16 & 3, blk = (lane >> 4) & 1, hh = lane >> 5;
    const LAS unsigned char* bs = img + (16 * s + 4 * hh + tq) * pitch + (col0 + 16 * blk) * 2 + 8 * tp;
    const s16x4 lo = vtr(bs), hi = vtr(bs + 8 * pitch);
    return __builtin_shufflevector(lo, hi, 0, 1, 2, 3, 4, 5, 6, 7); }
template <int S> DI bf16x8 pack8(const f32x16& x, float sg) {
    u32x4 w; w.x = pk2(sg * x[8 * S], sg * x[8 * S + 1]); w.y = pk2(sg * x[8 * S + 2], sg * x[8 * S + 3]); w.z = pk2(sg * x[8 * S + 4], sg * x[8 * S + 5]); w.w = pk2(sg * x[8 * S + 6], sg * x[8 * S + 7]);
    return __builtin_bit_cast(bf16x8, w); }
template <int S> DI bf16x8 pack8lo(const f32x16& x, bf16x8 hi) {
    const u32x4 h = __builtin_bit_cast(u32x4, hi); float d[8];
#pragma unroll
    for (int j = 0; j < 4; ++j) { d[2 * j] = x[8 * S + 2 * j] - __builtin_bit_cast(float, h[j] << 16); d[2 * j + 1] = x[8 * S + 2 * j + 1] - __builtin_bit_cast(float, h[j] & 0xffff0000u); }
    u32x4 w; w.x = pk2(d[0], d[1]); w.y = pk2(d[2], d[3]); w.z = pk2(d[4], d[5]); w.w = pk2(d[6], d[7]);
    return __builtin_bit_cast(bf16x8, w); }
DI void lds_barrier() { asm volatile("s_waitcnt lgkmcnt(0)" ::: "memory"); __builtin_amdgcn_s_barrier(); asm volatile("" ::: "memory"); }
DI f32x16 zero16() { f32x16 z;
#pragma unroll
    for (int i = 0; i < 16; ++i) z[i] = 0.f;
    return z; }

DI void cs_phaseA(KP p, LAS unsigned char* lds, int tid, int qbase, int nit, int first, int stride) {
    const bf16_t* KK = (const bf16_t*)(p->ws + WS_KK); const bf16_t* R = (const bf16_t*)(p->ws + WS_R); const bf16_t* KR = (const bf16_t*)(p->ws + WS_KR);
    const bf16_t* VV = (const bf16_t*)(p->ws + WS_VV); const float* k_a = p->in[19];
    const int wave = tid >> 6, lane = tid & 63, g = wave >> 2, wq = wave & 3, tg = wq * 64 + lane, hh = lane >> 5, r32 = lane & 31;
    LAS unsigned char* L = lds + g * CS_G;
    LAS unsigned char* MKK = L, *MBT = L + 4608, *MKT = L + 2 * 4608, *MRT = L + 3 * 4608, *MBH = L + 4 * 4608, *MKH = L + 5 * 4608, *MVM = L + 6 * 4608;
    LAS float* AF = (LAS float*)(L + 32256);
    LAS unsigned char* ST = L + 36352, *SKK = ST + 2560, *SRB = ST + 2 * 2560, *SRK = ST + 3 * 2560;
    LAS float* SEG = (LAS float*)(L + 46592); LAS float* ELv = (LAS float*)(L + 48640);
    f32x2 lwN[4], kkN[4], aaN[4], krN[4], rN[4]; u32x4 vmN;
#define CSA_FETCH(it_) do { const int q_ = qbase + (it_) * 2 + g; const bool lat_ = q_ < CS_LAT; const int sc_ = lat_ ? (q_ >> 6) : ((q_ - CS_LAT) >> 3), ci_ = lat_ ? (q_ & 63) : (q_ & 7), TT_ = lat_ ? DSEQ : SEQ; \
        const int b_ = sc_ >> 4, dir_ = (sc_ >> 3) & 1, h_ = sc_ & 7; const int rb_ = lat_ ? NCTX + b_ * DSEQ : b_ * SEQ; \
          \
        const int t0_ = dir_ ? TT_ - 1 - ci_ * CS_L : ci_ * CS_L, sg_ = dir_ ? -512 : 512; \
        const unsigned ub_ = (unsigned)((rb_ + t0_) * 512 + h_ * 64); \
        const unsigned o0_ = ub_ + (unsigned)(sg_ * 4 * (tg >> 5) + 2 * (tg & 31)); \
        const float* DEC_ = (const float*)(p->ws + WS_DEC) + (size_t)dir_ * NTOK * 512; const bf16_t* AA_ = (const bf16_t*)(p->ws + WS_AA) + (size_t)dir_ * NTOK * 512; \
        _Pragma("unroll") for (int j = 0; j < 4; ++j) { const unsigned off = o0_ + (unsigned)(sg_ * j); \
            lwN[j] = *(const f32x2*)(DEC_ + off); kkN[j] = ldh2(KK + off); aaN[j] = ldh2(AA_ + off); krN[j] = ldh2(KR + off); rN[j] = ldh2(R + off); } \
        vmN = *(const u32x4*)(VV + (ub_ + (unsigned)(sg_ * (tg >> 3) + (tg & 7) * 8))); } while (0)
    if (first < nit) CSA_FETCH(first);
    for (int it = first; it < nit; it += stride) {
        const int q = qbase + it * 2 + g; const bool lat = q < CS_LAT;
        const int sc = lat ? (q >> 6) : ((q - CS_LAT) >> 3), ci = lat ? (q & 63) : (q & 7), TT = lat ? DSEQ : SEQ;
        const int b = sc >> 4, dir = (sc >> 3) & 1, h = sc & 7;
        const size_t rowbase = lat ? (size_t)NCTX + (size_t)b * DSEQ : (size_t)b * SEQ;
        const float* DEC = (const float*)(p->ws + WS_DEC) + (size_t)dir * NTOK * 512; const bf16_t* AA = (const bf16_t*)(p->ws + WS_AA) + (size_t)dir * NTOK * 512;
        {
            const int kp = tg & 31, seg = tg >> 5;
            f32x2 lw[4], kk2[4], aa2[4], kr2[4], r2[4];
#pragma unroll
            for (int j = 0; j < 4; ++j) { lw[j] = lwN[j]; kk2[j] = kkN[j]; aa2[j] = aaN[j]; kr2[j] = krN[j]; r2[j] = rN[j]; }
            const u32x4 vmC = vmN;
            if (it + stride < nit) CSA_FETCH(it + stride);
            f32x2 ss = {0.f, 0.f};
#pragma unroll
            for (int j = 0; j < 4; ++j) { lw[j].x = __logf(lw[j].x); lw[j].y = __logf(lw[j].y); ss += lw[j]; }
            *(LAS f32x2*)(SEG + seg * 64 + 2 * kp) = ss;
            { const int i = tg >> 3, v0 = (tg & 7) * 8; *(LAS u32x4*)(MVM + i * 144 + v0 * 2) = vmC; }
            lds_barrier();
            f32x2 pre = {0.f, 0.f}, tot = {0.f, 0.f};
#pragma unroll
            for (int s8 = 0; s8 < 8; ++s8) { const f32x2 v = *(const LAS f32x2*)(SEG + s8 * 64 + 2 * kp); tot += v; if (s8 < seg) pre += v; }
            if (seg == 0) *(LAS f32x2*)(ELv + 2 * kp) = (f32x2){__expf(tot.x), __expf(tot.y)};
            const f32x2 ka = *(const f32x2*)(k_a + h * 64 + 2 * kp);
            f32x2 cwp = pre;
#pragma unroll
            for (int j = 0; j < 4; ++j) {
                const f32x2 cw = cwp + lw[j];
                const f32x2 E = {__expf(cw.x), __expf(cw.y)}, Ei = {__expf(-cw.x), __expf(-cw.y)}, Ep = {__expf(cwp.x), __expf(cwp.y)}, Eh = {__expf(tot.x - cw.x), __expf(tot.y - cw.y)};
                const f32x2 bb = kk2[j] * aa2[j], kd = kr2[j] * ((aa2[j] - 1.f) * ka + 1.f);
                const int o = (4 * seg + j) * 144 + 4 * kp;
                const f32x2 x0 = kk2[j] * Ep, x1 = bb * Ei, x2 = kd * Ei, x3 = r2[j] * E, x4 = bb * Eh, x5 = kd * Eh;
                *(LAS unsigned*)(MKK + o) = pk2(x0.x, x0.y); *(LAS unsigned*)(MBT + o) = pk2(x1.x, x1.y); *(LAS unsigned*)(MKT + o) = pk2(x2.x, x2.y);
                *(LAS unsigned*)(MRT + o) = pk2(x3.x, x3.y); *(LAS unsigned*)(MBH + o) = pk2(x4.x, x4.y); *(LAS unsigned*)(MKH + o) = pk2(x5.x, x5.y);
                cwp = cw;
            }
        }
        lds_barrier();
        {
            const LAS unsigned char* ia = wq < 2 ? MKK : MRT; const LAS unsigned char* ib = (wq & 1) ? MKT : MBT;
            f32x16 acc = zero16();
#pragma unroll
            for (int s4 = 0; s4 < 4; ++s4) acc = MFMA32(frag_nat(ia, 144, r32, s4, hh), frag_nat(ib, 144, r32, s4, hh), acc);
#pragma unroll
            for (int i = 0; i < 16; ++i) { const int row = crow(i, hh); const bool keep = wq < 2 ? (row > r32) : (row >= r32); const float v = keep ? acc[i] : 0.f;
                if (wq == 0) AF[row * 32 + r32] = v;
                else *(LAS unsigned short*)((wq == 1 ? SKK : (wq == 2 ? SRB : SRK)) + row * 80 + r32 * 2) = (unsigned short)(pk2(v, 0.f) & 0xffffu); }
        }
        lds_barrier();
        f32x16 X = zero16(), NT0 = zero16(), NT1 = zero16(), Q2 = zero16();
        const int c = wq & 1;
        if (wq == 0) {
            float Tc[32];
#pragma unroll
            for (int i = 0; i < 32; ++i) {
                float a4[4] = {(i == r32) ? 1.f : 0.f, 0.f, 0.f, 0.f};
#pragma unroll
                for (int j4 = 0; j4 < (i + 3) / 4; ++j4) { const f32x4 ar = *(const LAS f32x4*)(AF + i * 32 + 4 * j4);
#pragma unroll
                    for (int e = 0; e < 4; ++e) if (4 * j4 + e < i) a4[e] -= ar[e] * Tc[4 * j4 + e]; }
                const float a = (a4[0] + a4[1]) + (a4[2] + a4[3]);
                Tc[i] = a;
                if (lane < 32) *(LAS unsigned short*)(ST + i * 80 + r32 * 2) = (unsigned short)(pk2(a, 0.f) & 0xffffu);
            }
        } else if (wq >= 2) {
#pragma unroll
            for (int s2 = 0; s2 < 2; ++s2) {
                const bf16x8 vm = frag_tr(MVM, 144, 32 * c, s2, lane);
                X = MFMA32(frag_krow(SKK, 80, r32, s2, hh), vm, X);
                Q2 = MFMA32(frag_krow(SRK, 80, r32, s2, hh), vm, Q2);
                NT0 = MFMA32(frag_tr(MKH, 144, 0, s2, lane), vm, NT0);
                NT1 = MFMA32(frag_tr(MKH, 144, 32, s2, lane), vm, NT1);
            }
        }
        lds_barrier();
        if (wq < 2) {
            f32x16 P1 = zero16();
#pragma unroll
            for (int s2 = 0; s2 < 2; ++s2) P1 = MFMA32(frag_krow(ST, 80, r32, s2, hh), frag_tr(MKK, 144, 32 * c, s2, lane), P1);
            const bf16x8 n0 = pack8<0>(P1, -1.f), n1 = pack8<1>(P1, -1.f);
            f32x16 Q1t;
#pragma unroll
            for (int g4 = 0; g4 < 4; ++g4) { const u32x2 w = *(const LAS u32x2*)(MRT + r32 * 144 + (32 * c + 8 * g4 + 4 * hh) * 2); const f32x4 f = unpk4(w);
                Q1t[4 * g4] = f.x; Q1t[4 * g4 + 1] = f.y; Q1t[4 * g4 + 2] = f.z; Q1t[4 * g4 + 3] = f.w; }
            Q1t = MFMA32(n0, frag_krow(SRB, 80, r32, 0, hh), Q1t); Q1t = MFMA32(n1, frag_krow(SRB, 80, r32, 1, hh), Q1t);
            u32x4* q1f = (u32x4*)cs_q1(p->ws, q) + (c * 2) * 64 + lane;
            q1f[0] = __builtin_bit_cast(u32x4, pack8<0>(Q1t, 1.f)); q1f[64] = __builtin_bit_cast(u32x4, pack8<1>(Q1t, 1.f));
#pragma unroll
            for (int bq = 0; bq < 2; ++bq) {
                f32x16 M = zero16();
                if (bq == c) {
#pragma unroll
                    for (int i = 0; i < 16; ++i) M[i] = (crow(i, hh) == r32) ? ELv[32 * c + r32] : 0.f;
                }
                M = MFMA32(n0, frag_tr(MBH, 144, 32 * bq, 0, lane), M); M = MFMA32(n1, frag_tr(MBH, 144, 32 * bq, 1, lane), M);
                u32x4* mf = (u32x4*)cs_mf(p->ws, q) + ((c * 2 + bq) * 2) * 64 + lane;
                mf[0] = __builtin_bit_cast(u32x4, pack8<0>(M, 1.f)); mf[64] = __builtin_bit_cast(u32x4, pack8<1>(M, 1.f));
            }
        } else {
            f32x16 P2 = zero16();
            P2 = MFMA32(frag_krow(ST, 80, r32, 0, hh), pack8<0>(X, 1.f), P2); P2 = MFMA32(frag_krow(ST, 80, r32, 1, hh), pack8<1>(X, 1.f), P2);
            const bf16x8 n0 = pack8<0>(P2, -1.f), n1 = pack8<1>(P2, -1.f);
            Q2 = MFMA32(frag_krow(SRB, 80, r32, 0, hh), n0, Q2); Q2 = MFMA32(frag_krow(SRB, 80, r32, 1, hh), n1, Q2);
            NT0 = MFMA32(frag_tr(MBH, 144, 0, 0, lane), n0, NT0); NT0 = MFMA32(frag_tr(MBH, 144, 0, 1, lane), n1, NT0);
            NT1 = MFMA32(frag_tr(MBH, 144, 32, 0, lane), n0, NT1); NT1 = MFMA32(frag_tr(MBH, 144, 32, 1, lane), n1, NT1);
            unsigned* q2f = (unsigned*)cs_q2(p->ws, q) + c * 512 + lane;
#pragma unroll
            for (int i = 0; i < 8; ++i) q2f[i * 64] = pk2(Q2[2 * i], Q2[2 * i + 1]);
            unsigned* ntf = (unsigned*)cs_nt(p->ws, q) + (c * 2) * 512 + lane;
#pragma unroll
            for (int i = 0; i < 8; ++i) { ntf[i * 64] = pk2(NT0[2 * i], NT0[2 * i + 1]); ntf[512 + i * 64] = pk2(NT1[2 * i], NT1[2 * i + 1]); }
        }
        lds_barrier();
    }
#undef CSA_FETCH
}


constexpr int CSB_SLOT = 24576;
DI void cs_phaseB(KP p, LAS unsigned char* lds, int latent, int sc, int tid) {
    const int wave = tid >> 6, lane = tid & 63, hh = lane >> 5, r32 = lane & 31;
    const int nch = latent ? 64 : 8, q0 = latent ? sc * 64 : CS_LAT + sc * 8, TT = latent ? DSEQ : SEQ;
    const int b = sc >> 4, dir = (sc >> 3) & 1, h = sc & 7, c = wave & 1;
    const size_t rowbase = latent ? (size_t)NCTX + (size_t)b * DSEQ : (size_t)b * SEQ;
    const bool consumer = wave < 2;
    float* Yu = p->out + (size_t)dir * NTOK * 512 + rowbase * 512 + h * 64 + 32 * c;
    const unsigned ylane = (unsigned)((dir ? 4 * (1 - hh) : 4 * hh) * 512 + r32);
    f32x16 Z0 = zero16(), Z1 = zero16();
    if (consumer && latent) { const float* s0 = p->in[4] + ((((size_t)b * 2 + dir) * 8 + h) * 64 + 32 * c + r32) * 64;
#pragma unroll
      for (int g4 = 0; g4 < 4; ++g4) { const f32x4 a = *(const f32x4*)(s0 + 8 * g4 + 4 * hh), bq = *(const f32x4*)(s0 + 32 + 8 * g4 + 4 * hh);
          Z0[4 * g4] = a.x; Z0[4 * g4 + 1] = a.y; Z0[4 * g4 + 2] = a.z; Z0[4 * g4 + 3] = a.w; Z1[4 * g4] = bq.x; Z1[4 * g4 + 1] = bq.y; Z1[4 * g4 + 2] = bq.z; Z1[4 * g4 + 3] = bq.w; } }
    const int lt = tid - 128;
    u32x4 RG[4][4];
#define CSB_LOADQ(set, ch) do { const int q_ = q0 + (ch); _Pragma("unroll") for (int k_ = 0; k_ < 4; ++k_) { const int pi_ = lt + 384 * k_; \
        const unsigned char* src_ = pi_ < 512 ? cs_mf(p->ws, q_) + pi_ * 16 : (pi_ < 768 ? cs_q1(p->ws, q_) + (pi_ - 512) * 16 : (pi_ < 1280 ? cs_nt(p->ws, q_) + (pi_ - 768) * 16 : cs_q2(p->ws, q_) + (pi_ - 1280) * 16)); \
        RG[set][k_] = *(const u32x4*)src_; } } while (0)
#define CSB_WRITEQ(set, slot) do { _Pragma("unroll") for (int k_ = 0; k_ < 4; ++k_) *(LAS u32x4*)(lds + (slot) * CSB_SLOT + (lt + 384 * k_) * 16) = RG[set][k_]; } while (0)
    if (!consumer) { CSB_LOADQ(0, 0); CSB_LOADQ(1, 1); CSB_LOADQ(2, 2); CSB_LOADQ(3, 3); CSB_WRITEQ(0, 0); CSB_LOADQ(0, 4); }
    else __builtin_amdgcn_s_setprio(3);
    for (int ci0 = 0; ci0 < nch; ci0 += 4) {
#pragma unroll
        for (int u = 0; u < 4; ++u) {
            const int ci = ci0 + u;
            lds_barrier();
            if (!consumer) {
                if (ci + 1 < nch) { CSB_WRITEQ((u + 1) & 3, (ci + 1) & 1); if (ci + 5 < nch) CSB_LOADQ((u + 1) & 3, ci + 5); }
            } else {
                const LAS unsigned char* sl = lds + (ci & 1) * CSB_SLOT;
                bf16x8 MF[8], Q1[4]; f32x16 Y, N0, N1;
#pragma unroll
                for (int i = 0; i < 8; ++i) MF[i] = *(const LAS bf16x8*)(sl + (i * 64 + lane) * 16);
#pragma unroll
                for (int i = 0; i < 4; ++i) Q1[i] = *(const LAS bf16x8*)(sl + 8192 + (i * 64 + lane) * 16);
#pragma unroll
                for (int i = 0; i < 8; ++i) { const unsigned w0 = *(const LAS unsigned*)(sl + 12288 + ((c * 2) * 512 + i * 64 + lane) * 4), w1 = *(const LAS unsigned*)(sl + 12288 + ((c * 2 + 1) * 512 + i * 64 + lane) * 4),
                                                         w2 = *(const LAS unsigned*)(sl + 20480 + (c * 512 + i * 64 + lane) * 4);
                    N0[2 * i] = __builtin_bit_cast(float, w0 << 16); N0[2 * i + 1] = __builtin_bit_cast(float, w0 & 0xffff0000u);
                    N1[2 * i] = __builtin_bit_cast(float, w1 << 16); N1[2 * i + 1] = __builtin_bit_cast(float, w1 & 0xffff0000u);
                    Y[2 * i] = __builtin_bit_cast(float, w2 << 16); Y[2 * i + 1] = __builtin_bit_cast(float, w2 & 0xffff0000u); }
                const bf16x8 z00 = pack8<0>(Z0, 1.f), z01 = pack8<1>(Z0, 1.f), z10 = pack8<0>(Z1, 1.f), z11 = pack8<1>(Z1, 1.f);
                const bf16x8 l00 = pack8lo<0>(Z0, z00), l01 = pack8lo<1>(Z0, z01), l10 = pack8lo<0>(Z1, z10), l11 = pack8lo<1>(Z1, z11);
                Y = MFMA32(Q1[0], z00, Y); Y = MFMA32(Q1[1], z01, Y); Y = MFMA32(Q1[2], z10, Y); Y = MFMA32(Q1[3], z11, Y);
                N0 = MFMA32(MF[0], z00, N0); N0 = MFMA32(MF[1], z01, N0); N0 = MFMA32(MF[4], z10, N0); N0 = MFMA32(MF[5], z11, N0);
                N0 = MFMA32(MF[0], l00, N0); N0 = MFMA32(MF[1], l01, N0); N0 = MFMA32(MF[4], l10, N0); N0 = MFMA32(MF[5], l11, N0);
                N1 = MFMA32(MF[2], z00, N1); N1 = MFMA32(MF[3], z01, N1); N1 = MFMA32(MF[6], z10, N1); N1 = MFMA32(MF[7], z11, N1);
                N1 = MFMA32(MF[2], l00, N1); N1 = MFMA32(MF[3], l01, N1); N1 = MFMA32(MF[6], l10, N1); N1 = MFMA32(MF[7], l11, N1);
                Z0 = N0; Z1 = N1;
                { const int t0 = dir ? TT - CS_L - ci * CS_L : ci * CS_L;
#pragma unroll
                  for (int i = 0; i < 16; ++i) { const int ci_ = (i & 3) + 8 * (i >> 2); float* Ys = Yu + (size_t)(t0 + (dir ? 27 - ci_ : ci_)) * 512; Ys[ylane] = Y[i]; } }
            }
        }
    }
#undef CSB_LOADQ
#undef CSB_WRITEQ
    __builtin_amdgcn_s_setprio(0);
    if (consumer && !latent) { float* so = p->out + OUT_S + ((((size_t)b * 2 + dir) * 8 + h) * 64 + 32 * c + r32) * 64;
#pragma unroll
        for (int g4 = 0; g4 < 4; ++g4) { *(f32x4*)(so + 8 * g4 + 4 * hh) = (f32x4){Z0[4 * g4], Z0[4 * g4 + 1], Z0[4 * g4 + 2], Z0[4 * g4 + 3]};
                                          *(f32x4*)(so + 32 + 8 * g4 + 4 * hh) = (f32x4){Z1[4 * g4], Z1[4 * g4 + 1], Z1[4 * g4 + 2], Z1[4 * g4 + 3]}; } }
    __syncthreads();
}

DI void post_row(KP p, int r, int lane) {
    const float* Y = p->out; const bf16_t* R = (const bf16_t*)(p->ws + WS_R); const bf16_t* KR = (const bf16_t*)(p->ws + WS_KR);
    const bf16_t* VV = (const bf16_t*)(p->ws + WS_VV); const bf16_t* AA = (const bf16_t*)(p->ws + WS_AA); const bf16_t* G = (const bf16_t*)(p->ws + WS_G);
    const float* k_a = p->in[19]; const float* r_k = p->in[20]; const float* lng = p->in[21]; const float* lnb = p->in[22];
    bf16_t* MIX = (bf16_t*)(p->ws + WS_MIX);
    const int c = lane * 8; const size_t off = (size_t)r * 512 + c;
    float y[8], rr[8], kr[8], vv[8], a0[8], a1[8], gg[8], ka[8], rk[8], lg[8], lb[8];
#define LD8(dst, ptr) do { const f32x4 _a = *(const f32x4*)(ptr), _b = *(const f32x4*)((ptr) + 4); dst[0] = _a.x; dst[1] = _a.y; dst[2] = _a.z; dst[3] = _a.w; dst[4] = _b.x; dst[5] = _b.y; dst[6] = _b.z; dst[7] = _b.w; } while (0)
#define LD8H(dst, ptr) do { const u32x4 _w = *(const u32x4*)(ptr); const f32x4 _a = unpk4((u32x2){_w.x, _w.y}), _b = unpk4((u32x2){_w.z, _w.w}); dst[0] = _a.x; dst[1] = _a.y; dst[2] = _a.z; dst[3] = _a.w; dst[4] = _b.x; dst[5] = _b.y; dst[6] = _b.z; dst[7] = _b.w; } while (0)
    LD8(y, Y + off); LD8(rr, Y + (size_t)NTOK * 512 + off);
#pragma unroll
    for (int j = 0; j < 8; ++j) y[j] += rr[j];
    LD8H(rr, R + off); LD8H(kr, KR + off); LD8H(vv, VV + off); LD8H(a0, AA + off); LD8H(a1, AA + (size_t)NTOK * 512 + off); LD8H(gg, G + off);
    LD8(ka, k_a + c); LD8(rk, r_k + c); LD8(lg, lng + c); LD8(lb, lnb + c);
#undef LD8
#undef LD8H
    float s = 0.f, d0 = 0.f, d1 = 0.f;
#pragma unroll
    for (int j = 0; j < 8; ++j) { s += y[j]; const float q = rr[j] * kr[j] * rk[j]; d0 += q * (1.f + (a0[j] - 1.f) * ka[j]); d1 += q * (1.f + (a1[j] - 1.f) * ka[j]); }
    float bd = d0 + d1;
    s += __shfl_xor(s, 1); s += __shfl_xor(s, 2); s += __shfl_xor(s, 4);
    bd += __shfl_xor(bd, 1); bd += __shfl_xor(bd, 2); bd += __shfl_xor(bd, 4);
    const float mu = s * (1.f / 64.f);
    float q2 = 0.f;
#pragma unroll
    for (int j = 0; j < 8; ++j) { y[j] -= mu; q2 += y[j] * y[j]; }
    q2 += __shfl_xor(q2, 1); q2 += __shfl_xor(q2, 2); q2 += __shfl_xor(q2, 4);
    const float rs = rsqrtf(q2 * (1.f / 64.f) + GN_EPS);
    float o[8];
#pragma unroll
    for (int j = 0; j < 8; ++j) o[j] = (y[j] * rs * lg[j] + lb[j] + bd * vv[j]) * gg[j];
    *(u32x4*)(MIX + (size_t)r * D + 512 + c) = (u32x4){pk2(o[0], o[1]), pk2(o[2], o[3]), pk2(o[4], o[5]), pk2(o[6], o[7])};
}

DI void act_fix(KP p, int idx) {
    const float* EDGE = (const float*)(p->ws + WS_EDGE); bf16_t* ACT = (bf16_t*)(p->ws + WS_ACT); const float* wc = p->in[27];
    const int c = (idx % 352) * 8, e = (idx / 352) & 1, pm = 16 + idx / 704;
    const bool need = e == 0 ? (pm != 16 && pm != 24) : (pm != 23 && pm != 31);
    if (!need) return;
    const int r = pm * 256 + (e ? 255 : 0), nbpm = e ? pm + 1 : pm - 1;
    const float* nb = EDGE + ((size_t)nbpm * 2 + (1 - e)) * DFF + c;
    const float* eu = EDGE + ((size_t)pm * 2 + e) * DFF + 64 * DFF + c; const float* e3 = eu + 64 * DFF;
    const float* w = wc + (e ? 2 * DFF : 0) + c;
    float o[8];
#pragma unroll
    for (int j = 0; j < 8; ++j) o[j] = silu_f(eu[j] + w[j] * nb[j]) * e3[j];
    *(u32x4*)(ACT + (size_t)r * DFF + c) = (u32x4){pk2(o[0], o[1]), pk2(o[2], o[3]), pk2(o[4], o[5]), pk2(o[6], o[7])};
}

template <int NR>
DI void final_rows(KP p, int rbase, int rstride, int lane) {
    const float* MODb = (const float*)(p->ws + WS_MOD);
    const bf16_t* PART = (const bf16_t*)(p->ws + WS_PART); const float* nf = p->in[29];
    f32x4 v[NR][4]; u32x2 p0[NR][4], p1[NR][4];
#pragma unroll
    for (int q = 0; q < NR; ++q) { const int r = rbase + q * rstride; const f32x4* xr = (const f32x4*)(p->out + (size_t)r * D) + lane;
#pragma unroll
        for (int j = 0; j < 4; ++j) { v[q][j] = xr[64 * j]; p0[q][j] = *((const u32x2*)(PART + (size_t)r * D) + lane + 64 * j); p1[q][j] = *((const u32x2*)(PART + (size_t)(NTOK + r) * D) + lane + 64 * j); } }
    float s[NR];
#pragma unroll
    for (int q = 0; q < NR; ++q) { const int r = rbase + q * rstride; const float* MOD = MODb + midx_of(r) * 6144; s[q] = 0.f;
#pragma unroll
        for (int j = 0; j < 4; ++j) { const f32x4 gt = *((const f32x4*)(MOD + 5 * D) + lane + 64 * j); v[q][j] = v[q][j] + gt * (unpk4(p0[q][j]) + unpk4(p1[q][j]));
            s[q] += (v[q][j].x * v[q][j].x + v[q][j].y * v[q][j].y) + (v[q][j].z * v[q][j].z + v[q][j].w * v[q][j].w); } }
#pragma unroll
    for (int o = 1; o < 64; o <<= 1) {
#pragma unroll
        for (int q = 0; q < NR; ++q) s[q] += __shfl_xor(s[q], o); }
#pragma unroll
    for (int q = 0; q < NR; ++q) { const int r = rbase + q * rstride; f32x4* xr = (f32x4*)(p->out + (size_t)r * D) + lane; const float rstd = rsqrtf(s[q] * (1.f / D) + EPS);
#pragma unroll
        for (int j = 0; j < 4; ++j) xr[64 * j] = v[q][j] * rstd * *((const f32x4*)nf + lane + 64 * j); }
}

DI int lane_id() { int l; asm volatile("v_mbcnt_lo_u32_b32 %0, -1, 0\n\tv_mbcnt_hi_u32_b32 %0, -1, %0" : "=v"(l)); return l; }
#define XB_TMO      128
#define XB_XCNT(j)  (256  + 64 * (j))
#define XB_XSUB(j)  (1280 + 64 * (j))
#define XB_XGEN(j)  (2304 + 64 * (j))
#define XB_TOP      3328
#define XB_TOPGEN   3392
#define XB_SUBBAR   3520
#define XB_SPIN_CAP (1u << 18)
DI unsigned xb_ld(unsigned* p)              { return __hip_atomic_load(p, __ATOMIC_RELAXED, __HIP_MEMORY_SCOPE_AGENT); }
DI unsigned xb_add(unsigned* p, unsigned v) { return __hip_atomic_fetch_add(p, v, __ATOMIC_RELAXED, __HIP_MEMORY_SCOPE_AGENT); }
DI unsigned xb_xcc_id() { return (unsigned)__builtin_amdgcn_s_getreg((3 << 11) | 20) & 0xFu; }
#define XB_SPIN(cond, bar) do { unsigned _sp = 0; while (cond) { __builtin_amdgcn_s_sleep(1); \
    if ((++_sp & 255u) == 0u) { if (xb_ld(&(bar)[XB_TMO])) break; if (_sp > XB_SPIN_CAP) { atomicAdd(&(bar)[XB_TMO], 1u); break; } } } } while (0)
DI void xcd_barrier_complete(unsigned* bar, unsigned x, unsigned G, unsigned& nloc, unsigned& nx) {
    unsigned sum, cnt, mine, sp = 0u;
    for (;;) {
        sum = 0u; cnt = 0u; mine = 0u;
#pragma unroll
        for (unsigned j = 0; j < 16; ++j) { const unsigned c = xb_ld(&bar[XB_XCNT(j)]); sum += c; cnt += (c > 0u) ? 1u : 0u; mine = (j == x) ? c : mine; }
        if (sum == G) break;
        __builtin_amdgcn_s_sleep(1);
        if ((++sp & 255u) == 0u) { if (xb_ld(&bar[XB_TMO])) break; if (sp > XB_SPIN_CAP) { atomicAdd(&bar[XB_TMO], 1u); break; } }
    }
    nloc = mine > 0u ? mine : 1u; nx = cnt > 0u ? cnt : 1u;
}
DI void grid_bar(unsigned* bar, volatile LAS unsigned* st, unsigned G, int wave_s) {
    asm volatile("s_waitcnt vmcnt(0)" ::: "memory");
    __syncthreads();
    int t = wave_s * 64 + lane_id(); asm volatile("" : "+v"(t));
    if (t == 0) {
        __builtin_amdgcn_s_waitcnt(0);
        const unsigned x = xb_xcc_id();
        unsigned nloc = st[0], nx = st[1];
        if (nloc == 0u) { xcd_barrier_complete(bar, x, G, nloc, nx); st[0] = nloc; st[1] = nx; }
        const unsigned old = xb_add(&bar[XB_XSUB(x)], 1u);
        const unsigned gen = old / nloc;
        if (old + 1u == (gen + 1u) * nloc) {
            __builtin_amdgcn_fence(__ATOMIC_RELEASE, "agent");
            asm volatile("s_waitcnt vmcnt(0)" ::: "memory");
            const unsigned og = xb_add(&bar[XB_TOP], 1u);
            const unsigned tg = og / nx;
            if (og + 1u == (tg + 1u) * nx) xb_add(&bar[XB_TOPGEN], 1u);
            else XB_SPIN(xb_ld(&bar[XB_TOPGEN]) == tg, bar);
            __builtin_amdgcn_fence(__ATOMIC_ACQUIRE, "agent");
            xb_add(&bar[XB_XGEN(x)], 1u);
            asm volatile("s_waitcnt vmcnt(0)" ::: "memory");
        } else {
            XB_SPIN(xb_ld(&bar[XB_XGEN(x)]) == gen, bar);
            __builtin_amdgcn_fence(__ATOMIC_ACQUIRE, "agent");
            asm volatile("s_waitcnt vmcnt(0)" ::: "memory");
        }
    }
    __syncthreads();
}

__global__ void __launch_bounds__(512, 2) fwd_megakernel(Params kparams) {
    const KP kp0 = (KP)__builtin_amdgcn_kernarg_segment_ptr();
    extern __shared__ __attribute__((aligned(16))) unsigned char lds_raw[];
    LAS unsigned char* lds = (LAS unsigned char*)lds_raw;
    const int wave_s = __builtin_amdgcn_readfirstlane((int)threadIdx.x >> 6);
    volatile LAS unsigned* xbst = (volatile LAS unsigned*)(lds + LDS_XB);
    {
        int t0_ = wave_s * 64 + lane_id();
        if (t0_ == 0) { xbst[0] = 0u; xbst[1] = 0u; (void)xb_add((unsigned*)(kp0->ws + WS_BAR) + XB_XCNT(xb_xcc_id()), 1u); }
        __syncthreads();
    }
#define GRID_SYNC() grid_bar((unsigned*)(kp0->ws + WS_BAR), xbst, (unsigned)G, wave_s)
    const int G = gridDim.x, bx = blockIdx.x, NGW = G * 8, NGT = G * 512;
#define PH_VARS KP p = kp0; asm volatile("" : "+s"(p)); unsigned char* ws = p->ws; (void)ws; \
    int tid = wave_s * 64 + lane_id(); asm volatile("" : "+v"(tid)); const int lane = tid & 63, wave = wave_s, gw = bx * 8 + wave, gtid = bx * 512 + tid; (void)lane; (void)gw; (void)gtid;

    const bool defer_ffn = (G == 256);
    { PH_VARS phase0(p, lds, gw, NGW, gtid, NGT, wave, lane, defer_ffn); }
    cg::this_grid().sync();
    { PH_VARS for (int r = gw; r < NTOK; r += 4 * NGW) norm_rows<0, 4>(p, r, NGW, lane, p->in[9], 0, D, 0, (bf16_t*)(ws + WS_H), nullptr); }
    GRID_SYNC();
    {
        PH_VARS
        pg8::Gemm g{(const bf16_t*)(ws + WS_H), (const bf16_t*)(ws + WS_WTIN), D, D, D};
        pg8::SchedPlain S; S.o.init(NTOK / 256, NINP / 256, G, bx);
        pg8::EpiIn E{(bf16_t*)(ws + WS_Q), (bf16_t*)(ws + WS_ZR), p->out + OUT_K, 0.125f * LOG2E};
        pg8::gemm_phase(lds, g, S, E, tid);
        if (defer_ffn && bx >= 192) ffn_transposes(p, lds, 0, (bx - 192) * 8 + wave, 64 * 8, wave, lane);
    }
    GRID_SYNC();
    {
        PH_VARS
        LAS float* rpbL = (LAS float*)lds;
        for (int i = tid; i < 8 * 465; i += 512) rpbL[i] = p->in[23][i] * LOG2E;
        __syncthreads();
        LAS unsigned char* vbuf = lds + 16384 + wave * 4608;
        LAS float* xch = (LAS float*)(lds + 65536) + (wave & 3) * 2176;
        for (int u0 = bx * 4; u0 < 1024; u0 += G * 4) {
            if (wave < 4) { attn_unit<true, 2>(p, vbuf, rpbL, u0 + wave, lane, 0, 20, xch); attn_unit<false, 0>(p, vbuf, rpbL, u0 + wave, lane, 0, 8, xch); }
            else { attn_unit<true, 1>(p, vbuf, rpbL, u0 + wave - 4, lane, 20, 32, xch); prep_rows8(p, (u0 + wave - 4) * 8, lane); }
            __syncthreads();
        }
    }
    GRID_SYNC();
    {
        PH_VARS
        int kl = 128; asm volatile("" : "+s"(kl));
        pg8::Gemm g{(const bf16_t*)(ws + WS_ALORA), (const bf16_t*)(ws + WS_WTLORA), kl, 128, 128};
        pg8::SchedLora S; S.G = G; S.c = bx;
        pg8::EpiLora E{(float*)(ws + WS_DEC), (float*)(ws + WS_AA), (float*)(ws + WS_G), p->in[13], p->in[15]};
        pg8::gemm_phase(lds, g, S, E, tid);
        if (defer_ffn && bx >= 64) ffn_transposes(p, lds, 1, (bx - 64) * 8 + wave, 192 * 8, wave, lane);
    }
    GRID_SYNC();
    {
        int nst = 2; asm volatile("" : "+s"(nst));
        const int nl = G > 64 ? 32 : 0;
        for (int st = 0; st < nst; ++st) {
            PH_VARS
            const bool lead = bx < nl;
            if (st == 0 || !lead) cs_phaseA(p, lds, tid, st ? CS_LAT : 0, CS_LAT / 2, st ? bx - nl : bx, st ? G - nl : G);
            if (st == 0) { GRID_SYNC(); continue; }
            if (!lead) {
                unsigned* sb = (unsigned*)(kp0->ws + WS_BAR) + XB_SUBBAR;
                __syncthreads();
                if (tid == 0) { __atomic_thread_fence(__ATOMIC_RELEASE); __hip_atomic_fetch_add(sb, 1u, __ATOMIC_RELAXED, __HIP_MEMORY_SCOPE_AGENT);
                    while (__hip_atomic_load(sb, __ATOMIC_RELAXED, __HIP_MEMORY_SCOPE_AGENT) < (unsigned)(G - nl)) __builtin_amdgcn_s_sleep(1);
                    __atomic_thread_fence(__ATOMIC_ACQUIRE); }
                __syncthreads();
            }
            const int tfirst = lead ? bx : (nl ? 32 + (bx - nl) : bx), tend = lead ? 32 : 288, tstride = lead ? 32 : (G - nl);
            for (int t = tfirst; t < tend; t += tstride) cs_phaseB(p, lds, t < 32 ? 1 : 0, t < 32 ? t : t - 32, tid);
        }
    }
    GRID_SYNC();
    { PH_VARS for (int r = gw; r < NTOK; r += NGW) post_row(p, r, lane); }
    GRID_SYNC();
    {
        PH_VARS
        pg8::Gemm g{(const bf16_t*)(ws + WS_MIX), (const bf16_t*)(ws + WS_WTOUT), 512, D, D};
        pg8::SchedSplit2 S; S.o.init(NTOK / 256, 8, G, bx); S.nN = 4; S.ksplit = 512;
        pg8::EpiPart E{(bf16_t*)(ws + WS_PART), 512};
        pg8::gemm_phase(lds, g, S, E, tid);
    }
    GRID_SYNC();
    { PH_VARS for (int r = gw; r < NTOK; r += 2 * NGW) norm_rows<1, 2>(p, r, NGW, lane, p->in[10], 3 * D, 4 * D, 2 * D, (bf16_t*)(ws + WS_H), p->out); }
    GRID_SYNC();
    {
        PH_VARS
        pg8::Gemm g{(const bf16_t*)(ws + WS_H), (const bf16_t*)(ws + WS_WT13), D, D, D};
        pg8::SchedPlain S; S.o.init(NTOK / 256, 2 * DFF / 256, G, bx);
        pg8::EpiFfnAct E{(bf16_t*)(ws + WS_ACT), (float*)(ws + WS_EDGE), p->in[27], lds};
        pg8::gemm_phase(lds, g, S, E, tid);
    }
    GRID_SYNC();
    { PH_VARS for (int i = gtid; i < 16 * 704; i += NGT) act_fix(p, i); }
    GRID_SYNC();
    {
        PH_VARS
        pg8::Gemm g{(const bf16_t*)(ws + WS_ACT), (const bf16_t*)(ws + WS_WT2), DFF / 2, DFF, DFF};
        pg8::SchedSplit2 S; S.o.init(NTOK / 256, 8, G, bx); S.nN = 4; S.ksplit = DFF / 2;
        pg8::EpiPart E{(bf16_t*)(ws + WS_PART), DFF / 2};
        pg8::gemm_phase(lds, g, S, E, tid);
    }
    GRID_SYNC();
    { PH_VARS for (int r = gw; r < NTOK; r += 2 * NGW) final_rows<2>(p, r, NGW, lane); }
}

extern "C" void kernel_launch(void* const* d_in, const int* in_sizes, int n_in, void* d_out, int out_size, void* d_ws, size_t ws_size, hipStream_t stream) {
    static int grid_blocks = 0;
    if (!grid_blocks) {
        int dev = 0, cus = 0, per_cu = 0;
        (void)hipGetDevice(&dev);
        (void)hipDeviceGetAttribute(&cus, hipDeviceAttributeMultiprocessorCount, dev);
        (void)hipFuncSetAttribute((const void*)fwd_megakernel, hipFuncAttributeMaxDynamicSharedMemorySize, LDS_BYTES);
        (void)hipOccupancyMaxActiveBlocksPerMultiprocessor(&per_cu, (const void*)fwd_megakernel, 512, LDS_BYTES);
        if (per_cu < 1) per_cu = 1;
        grid_blocks = cus * per_cu;
    }
    (void)hipMemsetAsync((char*)d_ws + WS_BAR, 0, 16384, stream);
    Params p{};
    for (int i = 0; i < 30; ++i) p.in[i] = (const float*)d_in[i];
    p.out = (float*)d_out; p.ws = (unsigned char*)d_ws;
    void* args[] = {&p};
    hipError_t e = hipLaunchCooperativeKernel((const void*)fwd_megakernel, dim3(grid_blocks), dim3(512), args, LDS_BYTES, stream);
    if (e != hipSuccess) fprintf(stderr, "cooperative launch failed: %s (grid %d)\n", hipGetErrorString(e), grid_blocks);
}
```

```cpp
#include <hip/hip_runtime.h>
#include <hip/hip_cooperative_groups.h>
#include <cstdio>
#include <cstdint>
namespace cg = cooperative_groups;

#define LAS __attribute__((address_space(3)))
typedef unsigned short bf16_t;
typedef short bf16x8 __attribute__((ext_vector_type(8)));
typedef short s16x4 __attribute__((ext_vector_type(4)));
typedef float f32x2 __attribute__((ext_vector_type(2)));
typedef float f32x4 __attribute__((ext_vector_type(4)));
typedef float f32x16 __attribute__((ext_vector_type(16)));
typedef unsigned u32x2 __attribute__((ext_vector_type(2)));
typedef unsigned u32x4 __attribute__((ext_vector_type(4)));
typedef __bf16 bf16x2_t __attribute__((ext_vector_type(2)));
#define DI __device__ __forceinline__

constexpr int D = 1024, NTOK = 8192, NCTX = 4096, SEQ = 256, DSEQ = 2048;
constexpr int NIN = 3456, NINP = 3584, RC = 1920, DFF = 2816;
constexpr float EPS = 1e-6f, GN_EPS = 64e-5f;
constexpr float LOG2E = 1.4426950408889634f;
constexpr size_t MiB = 1u << 20;
constexpr size_t WS_BAR = 128 * 1024, WS_MOD = 0, WS_WTIN = 1 * MiB, WS_WTOUT = 8 * MiB, WS_WT13 = 10 * MiB, WS_WT2 = 21 * MiB, WS_WTLORA = 27 * MiB,
                 WS_H = 28 * MiB, WS_Q = 44 * MiB, WS_K = 52 * MiB, WS_V = 60 * MiB, WS_R = 68 * MiB, WS_VV = 84 * MiB, WS_KK = 100 * MiB,
                 WS_KR = 116 * MiB, WS_ALORA = 132 * MiB, WS_MIX = 138 * MiB, WS_ZR = 154 * MiB, WS_DEC = 154 * MiB, WS_AA = 186 * MiB,
                 WS_G = 218 * MiB, WS_CK = 234 * MiB, WS_CV = 235 * MiB, WS_Y = 28 * MiB, WS_PART = 176 * MiB, WS_A1 = 44 * MiB,
                 WS_A3 = 88 * MiB, WS_ACT = 132 * MiB, WS_EDGE = 250 * MiB;
constexpr size_t OUT_K = (size_t)NTOK * D, OUT_V = OUT_K + (size_t)NCTX * 512, OUT_S = OUT_V + (size_t)NCTX * 512;
constexpr int LDS_BYTES = 135168 + 16;
constexpr int LDS_XB = 135168;

struct Params { const float* in[30]; float* out; unsigned char* ws; };
typedef const __attribute__((address_space(4))) Params* KP;

DI unsigned pk2(float lo, float hi) { f32x2 v = {lo, hi}; bf16x2_t b = __builtin_convertvector(v, bf16x2_t); return __builtin_bit_cast(unsigned, b); }
DI f32x4 unpk4(u32x2 w) { return (f32x4){__builtin_bit_cast(float, w.x << 16), __builtin_bit_cast(float, w.x & 0xffff0000u), __builtin_bit_cast(float, w.y << 16), __builtin_bit_cast(float, w.y & 0xffff0000u)}; }
DI f32x2 ldh2(const bf16_t* p) { const unsigned w = *(const unsigned*)p; return (f32x2){__builtin_bit_cast(float, w << 16), __builtin_bit_cast(float, w & 0xffff0000u)}; }
DI float bf2f(unsigned short u) { return __builtin_bit_cast(float, (unsigned)u << 16); }
DI float wave_sum(float v) {
#pragma unroll
    for (int o = 1; o < 64; o <<= 1) v += __shfl_xor(v, o);
    return v;
}
DI float sigmoid_f(float x) { return __builtin_amdgcn_rcpf(1.f + __builtin_amdgcn_exp2f(-1.4426950408889634f * x)); }
DI float silu_f(float x) { return x * sigmoid_f(x); }
DI float tanh_f(float x) { return 2.f * sigmoid_f(2.f * x) - 1.f; }
DI int midx_of(int r) { return r < NCTX ? 0 : 1 + ((r - NCTX) >> 11); }
DI const float* xrow_of(KP p, int r) { return r < NCTX ? p->in[0] + (size_t)r * D : p->in[1] + (size_t)(r - NCTX) * D; }

namespace pg8 {
constexpr int BM = 256, BK = 64, HALF = 128, HTB = HALF * BK * 2, NXCD = 8, WGM = 8;
__host__ __device__ __forceinline__ int lds_byte(int r, int c) { const int st = (r >> 4) * 2 + (c >> 5), rr = r & 15, cc = c & 31, ob = rr * 64 + cc * 2; return st * 1024 + (ob ^ (((ob >> 9) & 1) << 5)); }
__host__ __device__ __forceinline__ void stage_rc(int b, int& R, int& C) { const int st = b / 1024, sb = b % 1024, swz = sb ^ (((sb >> 9) & 1) << 5); R = (st >> 1) * 16 + swz / 64; C = (st & 1) * 32 + (swz % 64) / 2; }
__host__ __device__ __forceinline__ int perm32(int rho) { const int n = rho >> 4, i = rho & 15; return 8 * (i >> 2) + 4 * n + (i & 3); }
struct Unit { int pm, pn; int aoff, boff; };
struct Gemm { const bf16_t* A; const bf16_t* Bt; int K, lda, ldb; };
struct StaticOrder {
    int nM, nN, nwg, G, c;
    __device__ void init(int nM_, int nN_, int G_, int c_) { nM = nM_; nN = nN_; nwg = nM * nN; G = G_; c = c_; }
    __device__ bool next2(int i, int& pm, int& pn) const {
        const long L = (long)i * G + c; if (L >= nwg) return false;
        int wgid = (int)L; { const int q = nwg / NXCD, r = nwg % NXCD, xcd = wgid % NXCD, off = wgid / NXCD; wgid = (xcd < r ? xcd * (q + 1) : r * (q + 1) + (xcd - r) * q) + off; }
        const int nig = WGM * nN, gid = wgid / nig, fm = gid * WGM, gsz = (nM - fm) < WGM ? (nM - fm) : WGM;
        pm = fm + ((wgid % nig) % gsz); pn = (wgid % nig) / gsz; return true;
    }
};
struct SchedPlain { StaticOrder o; __device__ bool next(int i, Unit& u) const { u.aoff = 0; u.boff = 0; return o.next2(i, u.pm, u.pn); } };
struct SchedSplit2 { StaticOrder o; int nN, ksplit;
    __device__ bool next(int i, Unit& u) const { int pn2; if (!o.next2(i, u.pm, pn2)) return false; const int ks = pn2 / nN; u.pn = pn2 - ks * nN; u.aoff = ks * ksplit; u.boff = ks * ksplit; return true; } };
struct SchedLora { int G, c;
    __device__ bool next(int i, Unit& u) const { const int L = i * G + c; if (L >= 320) return false; u.pm = L & 31; u.pn = L >> 5; const int g = u.pn < 4 ? 0 : (u.pn < 8 ? 1 : 2); u.aoff = g * NTOK * 128; u.boff = 0; return true; } };

template <class Epi, class Sched>
__device__ __forceinline__ void gemm_phase(LAS unsigned char* lds, const Gemm g, const Sched& S, const Epi& E, int tid) {
    asm volatile("" : "+v"(tid));
    const int wid = __builtin_amdgcn_readfirstlane(tid >> 6), lane = tid & 63, wr = wid >> 2, wc = wid & 3, fr = lane & 15, fq = lane >> 4;
    const int nt = g.K / BK;
    unsigned voffA[2], voffB[2];
#pragma unroll
    for (int i = 0; i < 2; ++i) { int R, C; stage_rc(tid * 16 + i * 8192, R, C); const int Rb = (R & ~31) + perm32(R & 31);
        voffA[i] = (unsigned)(R * g.lda + C) * 2u; voffB[i] = (unsigned)(Rb * g.ldb + C) * 2u; }
    const size_t kstep = (size_t)(BK * 2);
    const size_t hA = (size_t)HALF * g.lda * 2, hB = (size_t)HALF * g.ldb * 2;
    const unsigned ldsw = (unsigned)wid * 1024u;
    const int aoff = lds_byte(wr * 64 + fr, fq * 8), boff = lds_byte(wc * 32 + fr, fq * 8);
#define PG8_SA(b, h) (((b) * 2 + (h)) * HTB)
#define PG8_SB(b, h) ((4 + (b) * 2 + (h)) * HTB)
#define PG8_STAGE(bufoff, gbase, voff) do { _Pragma("unroll") for (int _i = 0; _i < 2; ++_i) \
        __builtin_amdgcn_global_load_lds((const unsigned*)((const char*)(gbase) + (voff)[_i]), (LAS unsigned*)(lds + (bufoff) + ldsw + _i * 8192), 16, 0, 0); } while (0)
#define PG8_LDA(dst, b, h) do { _Pragma("unroll") for (int m = 0; m < 4; ++m) _Pragma("unroll") for (int k = 0; k < 2; ++k) dst[m][k] = *(const LAS bf16x8*)(lds + PG8_SA(b, h) + aoff + m * 2048 + k * 1024); } while (0)
#define PG8_LDB(dst, b, h) do { _Pragma("unroll") for (int n = 0; n < 2; ++n) _Pragma("unroll") for (int k = 0; k < 2; ++k) dst[n][k] = *(const LAS bf16x8*)(lds + PG8_SB(b, h) + boff + n * 2048 + k * 1024); } while (0)
#define PG8_MMA(ai, bj, At, Bt) do { __builtin_amdgcn_s_setprio(1); _Pragma("unroll") for (int m = 0; m < 4; ++m) _Pragma("unroll") for (int n = 0; n < 2; ++n) _Pragma("unroll") for (int k = 0; k < 2; ++k) \
        acc[ai][bj][m][n] = __builtin_amdgcn_mfma_f32_16x16x32_bf16(Bt[n][k], At[m][k], acc[ai][bj][m][n], 0, 0, 0); __builtin_amdgcn_s_setprio(0); } while (0)
#define PG8_WAIT_V(n) asm volatile("s_waitcnt vmcnt(" #n ")" ::: "memory")
#define PG8_WAIT_L(n) asm volatile("s_waitcnt lgkmcnt(" #n ")" ::: "memory")
#define PG8_BAR __builtin_amdgcn_s_barrier()
#define PG8_SCHED __builtin_amdgcn_sched_barrier(0)
#define PG8_TA(u) ((const char*)g.A + ((size_t)(u).pm * BM * g.lda + (size_t)(u).aoff) * 2)
#define PG8_TB(u) ((const char*)g.Bt + ((size_t)(u).pn * BM * g.ldb + (size_t)(u).boff) * 2)
    Unit cur, nxt; int ui = 0;
    if (!S.next(0, cur)) return;
    f32x4 acc[2][2][4][2];
#pragma unroll
    for (int a = 0; a < 2; ++a)
#pragma unroll
        for (int b = 0; b < 2; ++b)
#pragma unroll
            for (int m = 0; m < 4; ++m)
#pragma unroll
                for (int n = 0; n < 2; ++n) acc[a][b][m][n] = (f32x4){0.f, 0.f, 0.f, 0.f};
    bf16x8 At[4][2], B0[2][2], B1[2][2];
    const char* cA = PG8_TA(cur); const char* cB = PG8_TB(cur);
    PG8_STAGE(PG8_SB(0, 0), cB, voffB); PG8_STAGE(PG8_SB(0, 1), cB + hB, voffB); PG8_STAGE(PG8_SA(0, 0), cA, voffA); PG8_STAGE(PG8_SA(0, 1), cA + hA, voffA);
    if (wr == 1) PG8_BAR;
    PG8_WAIT_V(2); PG8_BAR;
    PG8_STAGE(PG8_SB(1, 0), cB + kstep, voffB); PG8_STAGE(PG8_SA(1, 0), cA + kstep, voffA); PG8_STAGE(PG8_SB(1, 1), cB + hB + kstep, voffB);
    PG8_WAIT_V(6); PG8_BAR;
    for (;;) {
        const bool has_next = S.next(ui + 1, nxt);
        const char* nA = has_next ? PG8_TA(nxt) : cA; const char* nB = has_next ? PG8_TB(nxt) : cB;
        for (int t = 0; t < nt; t += 2) {
            const bool last = (t == nt - 2);
            const char* a1 = cA + (size_t)(t + 1) * kstep;
            const char* a2 = last ? nA : cA + (size_t)(t + 2) * kstep; const char* b2 = last ? nB : cB + (size_t)(t + 2) * kstep;
            const char* a3 = a2 + kstep; const char* b3 = b2 + kstep;
            PG8_LDB(B0, 0, 0); PG8_LDB(B1, 0, 1); PG8_SCHED; PG8_LDA(At, 0, 0); PG8_STAGE(PG8_SA(1, 1), a1 + hA, voffA);
            PG8_WAIT_V(8); PG8_WAIT_L(0); PG8_BAR; PG8_MMA(0, 0, At, B0); PG8_MMA(0, 1, At, B1); PG8_BAR; PG8_SCHED;
            PG8_LDA(At, 0, 1); PG8_STAGE(PG8_SB(0, 0), b2, voffB); PG8_STAGE(PG8_SB(0, 1), b2 + hB, voffB); PG8_STAGE(PG8_SA(0, 0), a2, voffA);
            PG8_WAIT_V(8); PG8_WAIT_L(0); PG8_BAR; PG8_MMA(1, 0, At, B0); PG8_MMA(1, 1, At, B1); PG8_BAR; PG8_SCHED;
            PG8_LDB(B0, 1, 0); PG8_LDB(B1, 1, 1); PG8_SCHED; PG8_LDA(At, 1, 0); PG8_STAGE(PG8_SA(0, 1), a2 + hA, voffA);
            PG8_WAIT_V(8); PG8_WAIT_L(0); PG8_BAR; PG8_MMA(0, 0, At, B0); PG8_MMA(0, 1, At, B1); PG8_BAR; PG8_SCHED;
            PG8_LDA(At, 1, 1); PG8_STAGE(PG8_SB(1, 0), b3, voffB); PG8_STAGE(PG8_SB(1, 1), b3 + hB, voffB); PG8_STAGE(PG8_SA(1, 0), a3, voffA);
            PG8_WAIT_V(8); PG8_WAIT_L(0); PG8_BAR; PG8_MMA(1, 0, At, B0); PG8_MMA(1, 1, At, B1); PG8_BAR; PG8_SCHED;
        }
        E(acc, cur, wr, wc, fr, fq);
        if (!has_next) break;
#pragma unroll
        for (int a = 0; a < 2; ++a)
#pragma unroll
            for (int b = 0; b < 2; ++b)
#pragma unroll
                for (int m = 0; m < 4; ++m)
#pragma unroll
                    for (int n = 0; n < 2; ++n) acc[a][b][m][n] = (f32x4){0.f, 0.f, 0.f, 0.f};
        cur = nxt; cA = nA; cB = nB; ++ui;
    }
    PG8_WAIT_V(0);
    if (wr == 0) PG8_BAR;
    PG8_BAR;
#undef PG8_SA
#undef PG8_SB
#undef PG8_STAGE
#undef PG8_LDA
#undef PG8_LDB
#undef PG8_MMA
#undef PG8_WAIT_V
#undef PG8_WAIT_L
#undef PG8_BAR
#undef PG8_SCHED
#undef PG8_TA
#undef PG8_TB
}

struct EpiIn {
    bf16_t *Q; bf16_t* ZR; float* outK; float qscale;
    __device__ __forceinline__ void operator()(const f32x4 (&acc)[2][2][4][2], const Unit& u, int wr, int wc, int fr, int fq) const {
#pragma unroll
        for (int bj = 0; bj < 2; ++bj) {
            const int c0 = u.pn * BM + bj * HALF + wc * 32 + 8 * fq;
            if (c0 >= NIN) continue;
#pragma unroll
            for (int ai = 0; ai < 2; ++ai)
#pragma unroll
                for (int m = 0; m < 4; ++m) {
                    int r = u.pm * BM + ai * HALF + wr * 64 + m * 16 + fr; asm volatile("" : "+v"(r));
                    f32x4 v0 = acc[ai][bj][m][0], v1 = acc[ai][bj][m][1];
                    if (c0 < 1536) {
                        const int seg = c0 >> 9, cc = c0 & 511;
                        if (seg == 0) { v0 = v0 * qscale; v1 = v1 * qscale; }
                        else if (r < NCTX) { float* o = outK + (size_t)(seg - 1) * ((size_t)NCTX * 512) + (size_t)r * 512 + cc; *(f32x4*)o = v0; *(f32x4*)(o + 4) = v1; }
                        bf16_t* dst = Q + (size_t)seg * ((size_t)NTOK * 512) + (size_t)r * 512 + cc;
                        u32x4 w; w.x = pk2(v0[0], v0[1]); w.y = pk2(v0[2], v0[3]); w.z = pk2(v1[0], v1[1]); w.w = pk2(v1[2], v1[3]);
                        *(u32x4*)dst = w;
                    } else {
                        u32x4 w; w.x = pk2(v0[0], v0[1]); w.y = pk2(v0[2], v0[3]); w.z = pk2(v1[0], v1[1]); w.w = pk2(v1[2], v1[3]);
                        *(u32x4*)(ZR + (size_t)r * RC + (c0 - 1536)) = w;
                    }
                }
        }
    }
};
DI float decay1(float x) { return __expf(-0.60653065971f * sigmoid_f(x)); }
struct EpiLora {
    float *DEC, *AA, *G; const float *w0, *a0;
    __device__ __forceinline__ void operator()(const f32x4 (&acc)[2][2][4][2], const Unit& u, int wr, int wc, int fr, int fq) const {
#pragma unroll
        for (int bj = 0; bj < 2; ++bj) {
            const int c0 = u.pn * BM + bj * HALF + wc * 32 + 8 * fq;
            const int grp = c0 >> 10, cg = c0 & 1023, dir = cg >> 9, cc = cg & 511;
            const float* bp = (grp == 0 ? w0 : a0) + dir * 512 + cc;
            float* ob = DEC + (size_t)dir * NTOK * 512 + cc;
            bf16_t* obh = grp == 2 ? (bf16_t*)G + cc : (bf16_t*)AA + (size_t)dir * NTOK * 512 + cc;
#pragma unroll
            for (int ai = 0; ai < 2; ++ai)
#pragma unroll
                for (int m = 0; m < 4; ++m) {
                    int r = u.pm * BM + ai * HALF + wr * 64 + m * 16 + fr; asm volatile("" : "+v"(r));
                    f32x4 v0 = acc[ai][bj][m][0], v1 = acc[ai][bj][m][1];
                    if (grp < 2) { const float* bq = bp; asm volatile("" : "+v"(bq)); v0 += *(const f32x4*)bq; v1 += *(const f32x4*)(bq + 4); }
                    if (grp == 0) { v0.x = decay1(v0.x); v0.y = decay1(v0.y); v0.z = decay1(v0.z); v0.w = decay1(v0.w); v1.x = decay1(v1.x); v1.y = decay1(v1.y); v1.z = decay1(v1.z); v1.w = decay1(v1.w); }
                    else if (grp == 1) { v0.x = sigmoid_f(v0.x); v0.y = sigmoid_f(v0.y); v0.z = sigmoid_f(v0.z); v0.w = sigmoid_f(v0.w); v1.x = sigmoid_f(v1.x); v1.y = sigmoid_f(v1.y); v1.z = sigmoid_f(v1.z); v1.w = sigmoid_f(v1.w); }
                    if (grp == 0) { float* o = ob + (size_t)r * 512; *(f32x4*)o = v0; *(f32x4*)(o + 4) = v1; }
                    else { u32x4 w; w.x = pk2(v0[0], v0[1]); w.y = pk2(v0[2], v0[3]); w.z = pk2(v1[0], v1[1]); w.w = pk2(v1[2], v1[3]); *(u32x4*)(obh + (size_t)r * 512) = w; }
                }
        }
    }
};
struct EpiPart {
    bf16_t* P; int ksplit;
    __device__ __forceinline__ void operator()(const f32x4 (&acc)[2][2][4][2], const Unit& u, int wr, int wc, int fr, int fq) const {
        bf16_t* base = P + (u.aoff ? (size_t)NTOK * D : 0);
#pragma unroll
        for (int bj = 0; bj < 2; ++bj) {
            const int c0 = u.pn * BM + bj * HALF + wc * 32 + 8 * fq;
#pragma unroll
            for (int ai = 0; ai < 2; ++ai)
#pragma unroll
                for (int m = 0; m < 4; ++m) {
                    int r = u.pm * BM + ai * HALF + wr * 64 + m * 16 + fr; asm volatile("" : "+v"(r));
                    const f32x4 v0 = acc[ai][bj][m][0], v1 = acc[ai][bj][m][1];
                    u32x4 w; w.x = pk2(v0[0], v0[1]); w.y = pk2(v0[2], v0[3]); w.z = pk2(v1[0], v1[1]); w.w = pk2(v1[2], v1[3]);
                    *(u32x4*)(base + (size_t)r * D + c0) = w;
                }
        }
    }
};
template <int CTRL> DI float dppf(float x) { return __builtin_bit_cast(float, __builtin_amdgcn_mov_dpp(__builtin_bit_cast(int, x), CTRL, 0xf, 0xf, true)); }
struct EpiFfnAct {
    bf16_t* ACT; float* EDGE; const float* wcv; LAS unsigned char* ldsb;
    __device__ __forceinline__ void operator()(const f32x4 (&acc)[2][2][4][2], const Unit& u, int wr, int wc, int fr, int fq) const {
        LAS float* HL = (LAS float*)(ldsb + 131072);
        const int colh = wc * 32 + 8 * fq;
#pragma unroll
        for (int ai = 0; ai < 2; ++ai) { const int g = ai * 2 + wr;
            if (fr == 0) { *(LAS f32x4*)(HL + (g * 2 + 0) * 128 + colh) = acc[ai][0][0][0]; *(LAS f32x4*)(HL + (g * 2 + 0) * 128 + colh + 4) = acc[ai][0][0][1]; }
            if (fr == 15) { *(LAS f32x4*)(HL + (g * 2 + 1) * 128 + colh) = acc[ai][0][3][0]; *(LAS f32x4*)(HL + (g * 2 + 1) * 128 + colh + 4) = acc[ai][0][3][1]; } }
        asm volatile("s_waitcnt lgkmcnt(0)" ::: "memory");
        __builtin_amdgcn_s_barrier(); __builtin_amdgcn_s_barrier();
        asm volatile("" ::: "memory");
        const int cf = u.pn * HALF + colh;
        const f32x4 zero = {0.f, 0.f, 0.f, 0.f};
        const bool lat = u.pm >= 16;
#pragma unroll
        for (int ai = 0; ai < 2; ++ai) {
            const int g = ai * 2 + wr;
            f32x4 hp[2], hn[2];
            hp[0] = g > 0 ? *(const LAS f32x4*)(HL + ((g - 1) * 2 + 1) * 128 + colh) : zero; hp[1] = g > 0 ? *(const LAS f32x4*)(HL + ((g - 1) * 2 + 1) * 128 + colh + 4) : zero;
            hn[0] = g < 3 ? *(const LAS f32x4*)(HL + ((g + 1) * 2 + 0) * 128 + colh) : zero; hn[1] = g < 3 ? *(const LAS f32x4*)(HL + ((g + 1) * 2 + 0) * 128 + colh + 4) : zero;
#pragma unroll
            for (int m = 0; m < 4; ++m) {
                int r = u.pm * BM + ai * HALF + wr * 64 + m * 16 + fr; asm volatile("" : "+v"(r));
                const float* wq_ = wcv + cf; asm volatile("" : "+v"(wq_));
                f32x4 uu[2], av[2];
#pragma unroll
                for (int n = 0; n < 2; ++n) {
                    const f32x4 cur = acc[ai][0][m][n];
                    f32x4 pv, nx;
#pragma unroll
                    for (int j = 0; j < 4; ++j) {
                        if (m > 0) pv[j] = dppf<0x121>(fr == 15 ? acc[ai][0][m > 0 ? m - 1 : 0][n][j] : cur[j]);
                        else { const float a = dppf<0x121>(cur[j]); pv[j] = fr == 0 ? hp[n][j] : a; }
                        if (m < 3) nx[j] = dppf<0x12F>(fr == 0 ? acc[ai][0][m < 3 ? m + 1 : 3][n][j] : cur[j]);
                        else { const float c = dppf<0x12F>(cur[j]); nx[j] = fr == 15 ? hn[n][j] : c; }
                    }
                    const f32x4 w0 = *(const f32x4*)(wq_ + 4 * n), w1 = *(const f32x4*)(wq_ + DFF + 4 * n), w2 = *(const f32x4*)(wq_ + 2 * DFF + 4 * n);
                    uu[n] = pv * w0 + cur * w1 + nx * w2;
                    const f32x4 a3 = acc[ai][1][m][n];
                    av[n] = (f32x4){silu_f(uu[n].x) * a3.x, silu_f(uu[n].y) * a3.y, silu_f(uu[n].z) * a3.z, silu_f(uu[n].w) * a3.w};
                }
                u32x4 w; w.x = pk2(av[0][0], av[0][1]); w.y = pk2(av[0][2], av[0][3]); w.z = pk2(av[1][0], av[1][1]); w.w = pk2(av[1][2], av[1][3]);
                *(u32x4*)(ACT + (size_t)r * DFF + cf) = w;
                if (lat && ((ai == 0 && m == 0) || (ai == 1 && m == 3))) {
                    const int e = ai;
                    const bool mine = e == 0 ? (wr == 0 && fr == 0) : (wr == 1 && fr == 15);
                    if (mine) {
                        float* eb = EDGE + ((size_t)u.pm * 2 + e) * DFF + cf;
                        *(f32x4*)(eb) = acc[ai][0][m][0]; *(f32x4*)(eb + 4) = acc[ai][0][m][1];
                        *(f32x4*)(eb + 64 * DFF) = uu[0]; *(f32x4*)(eb + 64 * DFF + 4) = uu[1];
                        *(f32x4*)(eb + 128 * DFF) = acc[ai][1][m][0]; *(f32x4*)(eb + 128 * DFF + 4) = acc[ai][1][m][1];
                    }
                }
            }
        }
    }
};
}

template <int MODE>
DI void transpose_item(const float* W, int K, int N, bf16_t* WT, LAS float* scr, int item, int lane) {
    const int nblk = N / 32, kb = item / nblk, nb = item % nblk, k0 = 64 * kb, n0 = 32 * nb;
#pragma unroll 8
    for (int i = 0; i < 32; ++i) { const int kk = 2 * i + (lane >> 5); scr[kk * 33 + (lane & 31)] = W[(size_t)(k0 + kk) * N + n0 + (lane & 31)]; }
    asm volatile("s_waitcnt lgkmcnt(0)" ::: "memory");
    const int c = lane & 7;
#pragma unroll
    for (int j = 0; j < 4; ++j) { const int n = (lane >> 3) + 8 * j; const LAS float* s = scr + (8 * c) * 33 + n;
        u32x4 o; o.x = pk2(s[0 * 33], s[1 * 33]); o.y = pk2(s[2 * 33], s[3 * 33]); o.z = pk2(s[4 * 33], s[5 * 33]); o.w = pk2(s[6 * 33], s[7 * 33]);
        const int nn = n0 + n; const int drow = MODE == 0 ? nn : ((nn >> 7) * 256 + (nn & 127) + (MODE == 2 ? 128 : 0));
        *(u32x4*)(WT + (size_t)drow * K + k0 + 8 * c) = o; }
    asm volatile("s_waitcnt lgkmcnt(0)" ::: "memory");
}

DI void phase0(KP p, LAS unsigned char* lds, int gw, int NGW, int gtid, int NGT, int wave, int lane, bool defer_ffn) {
    unsigned char* ws = p->ws;
    {
        float* MOD = (float*)(ws + WS_MOD);
        const float* w_ada = p->in[7]; const float* b_ada = p->in[8]; const float* c_lat = p->in[5]; const float* c_ctx = p->in[6];
        LAS float* red = (LAS float*)(lds + 8 * 8448);
        const int tid = wave * 64 + lane, cgp = lane & 15, kr = lane >> 4;
        for (int nb = blockIdx.x; nb < 96; nb += gridDim.x) {
            f32x4 a0 = {0, 0, 0, 0}, a1 = a0, a2 = a0;
#pragma unroll 8
            for (int i = 0; i < 32; ++i) {
                const int k = wave * 128 + 4 * i + kr;
                const f32x4 w = *(const f32x4*)(w_ada + (size_t)k * 6144 + nb * 64 + 4 * cgp);
                a0 += w * silu_f(c_ctx[k]); a1 += w * silu_f(c_lat[k]); a2 += w * silu_f(c_lat[D + k]);
            }
#pragma unroll
            for (int j = 0; j < 4; ++j) {
                a0[j] += __shfl_xor(a0[j], 16); a0[j] += __shfl_xor(a0[j], 32);
                a1[j] += __shfl_xor(a1[j], 16); a1[j] += __shfl_xor(a1[j], 32);
                a2[j] += __shfl_xor(a2[j], 16); a2[j] += __shfl_xor(a2[j], 32);
            }
            if (kr == 0) { *(LAS f32x4*)(red + (wave * 3 + 0) * 64 + 4 * cgp) = a0; *(LAS f32x4*)(red + (wave * 3 + 1) * 64 + 4 * cgp) = a1; *(LAS f32x4*)(red + (wave * 3 + 2) * 64 + 4 * cgp) = a2; }
            __syncthreads();
            if (tid < 192) {
                const int i = tid >> 6, c = tid & 63; float s = b_ada[nb * 64 + c];
#pragma unroll
                for (int w = 0; w < 8; ++w) s += red[(w * 3 + i) * 64 + c];
                MOD[i * 6144 + nb * 64 + c] = s;
            }
            __syncthreads();
        }
    }
    {
        LAS float* scr = (LAS float*)(lds + wave * 8448);
        constexpr int I_IN = 16 * 108, I_OUT = 16 * 32, I_F = 16 * 88, I_2 = 44 * 32, NIT = I_IN + I_OUT + 2 * I_F + I_2;
        const int nit = defer_ffn ? I_IN + I_OUT : NIT;
        for (int it = gw; it < nit; it += NGW) {
            int r = it;
            if (r < I_IN) { transpose_item<0>(p->in[11], D, NIN, (bf16_t*)(ws + WS_WTIN), scr, r, lane); continue; } r -= I_IN;
            if (r < I_OUT) { transpose_item<0>(p->in[24], D, D, (bf16_t*)(ws + WS_WTOUT), scr, r, lane); continue; } r -= I_OUT;
            if (r < I_F) { transpose_item<1>(p->in[25], D, DFF, (bf16_t*)(ws + WS_WT13), scr, r, lane); continue; } r -= I_F;
            if (r < I_F) { transpose_item<2>(p->in[26], D, DFF, (bf16_t*)(ws + WS_WT13), scr, r, lane); continue; } r -= I_F;
            transpose_item<0>(p->in[28], DFF, D, (bf16_t*)(ws + WS_WT2), scr, r, lane);
        }
    }
    { u32x4* z = (u32x4*)((bf16_t*)(ws + WS_WTIN) + (size_t)NIN * D); for (int i = gtid; i < 128 * D / 8; i += NGT) z[i] = (u32x4){0, 0, 0, 0}; }
    {
        bf16_t* WL = (bf16_t*)(ws + WS_WTLORA); const float* w2 = p->in[14]; const float* a2 = p->in[16]; const float* g2 = p->in[17];
        for (int i = gtid; i < 2560 * 128; i += NGT) {
            const int n = i >> 7, k = i & 127; float v = 0.f;
            if (n < 2048) { const int grp = n >> 10, dir = (n >> 9) & 1, c = n & 511; const float* src = grp == 0 ? w2 : a2;
                if ((k >> 6) == dir) v = src[((size_t)dir * 64 + (k & 63)) * 512 + c]; }
            else v = g2[(size_t)k * 512 + (n - 2048)];
            WL[i] = (bf16_t)(pk2(v, 0.f) & 0xffffu);
        }
    }
    {
        const f32x4* ck = (const f32x4*)p->in[2]; const f32x4* cv = (const f32x4*)p->in[3]; u32x2* CK = (u32x2*)(ws + WS_CK); u32x2* CV = (u32x2*)(ws + WS_CV);
        for (int i = gtid; i < 1024 * 512 / 4; i += NGT) { const f32x4 a = ck[i], b = cv[i]; CK[i] = (u32x2){pk2(a[0], a[1]), pk2(a[2], a[3])}; CV[i] = (u32x2){pk2(b[0], b[1]), pk2(b[2], b[3])}; }
    }
}

DI void ffn_transposes(KP p, LAS unsigned char* lds, int which, int widx, int nw, int wave, int lane) {
    LAS float* scr = (LAS float*)(lds + wave * 8448);
    constexpr int I_F = 16 * 88, I_2 = 44 * 32;
    if (which == 0) { for (int it = widx; it < I_2; it += nw) transpose_item<0>(p->in[28], DFF, D, (bf16_t*)(p->ws + WS_WT2), scr, it, lane); }
    else { for (int it = widx; it < 2 * I_F; it += nw) { if (it < I_F) transpose_item<1>(p->in[25], D, DFF, (bf16_t*)(p->ws + WS_WT13), scr, it, lane);
                                                           else transpose_item<2>(p->in[26], D, DFF, (bf16_t*)(p->ws + WS_WT13), scr, it - I_F, lane); } }
}

template <int SRC, int NR>
DI void norm_rows(KP p, int rbase, int rstride, int lane, const float* normw, int sh_off, int sc_off, int gate_off, bf16_t* Hout, float* xout) {
    const float* MODb = (const float*)(p->ws + WS_MOD);
    const bf16_t* PART = (const bf16_t*)(p->ws + WS_PART);
    f32x4 v[NR][4];
#pragma unroll
    for (int q = 0; q < NR; ++q) { const f32x4* xr = (const f32x4*)xrow_of(p, rbase + q * rstride) + lane;
#pragma unroll
        for (int j = 0; j < 4; ++j) v[q][j] = xr[64 * j]; }
    if (SRC == 1) {
        u32x2 p0[NR][4], p1[NR][4];
#pragma unroll
        for (int q = 0; q < NR; ++q) { const int r = rbase + q * rstride;
#pragma unroll
            for (int j = 0; j < 4; ++j) { p0[q][j] = *((const u32x2*)(PART + (size_t)r * D) + lane + 64 * j); p1[q][j] = *((const u32x2*)(PART + (size_t)(NTOK + r) * D) + lane + 64 * j); } }
#pragma unroll
        for (int q = 0; q < NR; ++q) { const int r = rbase + q * rstride; const float* MOD = MODb + midx_of(r) * 6144;
#pragma unroll
            for (int j = 0; j < 4; ++j) { const f32x4 gt = *((const f32x4*)(MOD + gate_off) + lane + 64 * j); v[q][j] = v[q][j] + gt * (unpk4(p0[q][j]) + unpk4(p1[q][j])); } }
    }
    float s[NR];
#pragma unroll
    for (int q = 0; q < NR; ++q) { s[q] = 0.f;
#pragma unroll
        for (int j = 0; j < 4; ++j) s[q] += (v[q][j].x * v[q][j].x + v[q][j].y * v[q][j].y) + (v[q][j].z * v[q][j].z + v[q][j].w * v[q][j].w); }
#pragma unroll
    for (int o = 1; o < 64; o <<= 1) {
#pragma unroll
        for (int q = 0; q < NR; ++q) s[q] += __shfl_xor(s[q], o); }
#pragma unroll
    for (int q = 0; q < NR; ++q) {
        const int r = rbase + q * rstride; const float* MOD = MODb + midx_of(r) * 6144;
        const float rstd = rsqrtf(s[q] * (1.f / D) + EPS);
        u32x2* o = (u32x2*)(Hout + (size_t)r * D) + lane;
#pragma unroll
        for (int j = 0; j < 4; ++j) {
            if (SRC == 1) *((f32x4*)(xout + (size_t)r * D) + lane + 64 * j) = v[q][j];
            const f32x4 g = *((const f32x4*)normw + lane + 64 * j), sc = *((const f32x4*)(MOD + sc_off) + lane + 64 * j), sh = *((const f32x4*)(MOD + sh_off) + lane + 64 * j);
            const f32x4 h = v[q][j] * rstd * g * (sc + 1.f) + sh;
            o[64 * j] = (u32x2){pk2(h.x, h.y), pk2(h.z, h.w)};
        }
    }
}

#define MFMA32(a, b, c) __builtin_amdgcn_mfma_f32_32x32x16_bf16((a), (b), (c), 0, 0, 0)
DI int crow(int reg, int h) { return (reg & 3) + 8 * (reg >> 2) + 4 * h; }
typedef short v4i16_t __attribute__((ext_vector_type(4)));
DI s16x4 vtr(const LAS unsigned char* p) { return __builtin_bit_cast(s16x4, __builtin_amdgcn_ds_read_tr16_b64_v4i16((LAS v4i16_t*)p)); }

template <bool LATENT, int MODE>
DI void attn_unit(KP p, LAS unsigned char* vbuf, const LAS float* rpbL, int unit, int lane, int t0, int t1, LAS float* xch) {
    const bf16_t* Q = (const bf16_t*)(p->ws + WS_Q); const bf16_t* Kb = (const bf16_t*)(p->ws + WS_K); const bf16_t* Vb = (const bf16_t*)(p->ws + WS_V);
    const bf16_t* CK = (const bf16_t*)(p->ws + WS_CK); const bf16_t* CV = (const bf16_t*)(p->ws + WS_CV);
    bf16_t* MIX = (bf16_t*)(p->ws + WS_MIX);
    const int r = lane & 31, hh = lane >> 5;
    int head, qrow0, b, gi = 0, w0 = 0, si = 0, ntile;
    if (LATENT) { head = unit & 7; const int t = unit >> 3; w0 = (t & 1) * 32; gi = (t >> 1) & 31; b = t >> 6; qrow0 = NCTX + b * DSEQ + gi * 64 + w0; si = min(max(gi - 4, 0), 24); ntile = 32; }
    else { head = unit & 7; const int t = unit >> 3; const int qb = t & 7; b = t >> 3; qrow0 = b * SEQ + qb * 32; ntile = 8; }
    bf16x8 qf[4];
#pragma unroll
    for (int s = 0; s < 4; ++s) qf[s] = *(const bf16x8*)(Q + (size_t)(qrow0 + r) * 512 + head * 64 + 16 * s + 8 * hh);
    auto tile_ptrs = [&](int t, const bf16_t*& kp, const bf16_t*& vp) {
        if (LATENT) {
            if (t < 16) { const size_t row = (size_t)b * 512 + t * 32; kp = CK + row * 512; vp = CV + row * 512; }
            else { const int lt = t - 16; const size_t row = (size_t)NCTX + b * DSEQ + (si + (lt >> 1)) * 64 + (((lt & 1) * 32) ^ w0); kp = Kb + row * 512; vp = Vb + row * 512; }
        } else { const size_t row = (size_t)b * SEQ + t * 32; kp = Kb + row * 512; vp = Vb + row * 512; }
    };
    bf16x8 kf[4], kn[4]; u32x4 vn[4];
    {
        const bf16_t *kp, *vp; tile_ptrs(t0, kp, vp);
#pragma unroll
        for (int s = 0; s < 4; ++s) kf[s] = *(const bf16x8*)(kp + (size_t)r * 512 + head * 64 + 16 * s + 8 * hh);
#pragma unroll
        for (int i = 0; i < 4; ++i) { const int c = lane + 64 * i; vn[i] = *(const u32x4*)(vp + (size_t)(c >> 3) * 512 + head * 64 + (c & 7) * 8); }
#pragma unroll
        for (int i = 0; i < 4; ++i) { const int c = lane + 64 * i; *(LAS u32x4*)(vbuf + (c >> 3) * 144 + (c & 7) * 16) = vn[i]; }
    }
    f32x16 o0, o1;
#pragma unroll
    for (int i = 0; i < 16; ++i) { o0[i] = 0.f; o1[i] = 0.f; }
    float mrun = -1e30f, lrun = 0.f;
    const int i16 = lane & 15, tq = i16 >> 2, tp = i16 & 3, blk = (lane >> 4) & 1;
    const LAS unsigned char* vtbase = vbuf + (4 * hh + tq) * 144 + (16 * blk) * 2 + 8 * tp;
    const int wq = w0 + r;
    const int cs = min(max(wq - 8, 0), 48);
    for (int t = t0; t < t1; ++t) {
        const bool more = (t + 1 < t1);
        if (more) {
            const bf16_t *kp, *vp; tile_ptrs(t + 1, kp, vp);
#pragma unroll
            for (int s = 0; s < 4; ++s) kn[s] = *(const bf16x8*)(kp + (size_t)r * 512 + head * 64 + 16 * s + 8 * hh);
#pragma unroll
            for (int i = 0; i < 4; ++i) { const int c = lane + 64 * i; vn[i] = *(const u32x4*)(vp + (size_t)(c >> 3) * 512 + head * 64 + (c & 7) * 8); }
        }
        f32x16 st;
#pragma unroll
        for (int i = 0; i < 16; ++i) st[i] = 0.f;
#pragma unroll
        for (int s = 0; s < 4; ++s) st = MFMA32(kf[s], qf[s], st);
        if (LATENT && t >= 16) {
            const int lt = t - 16, a = lt >> 1, c0 = ((lt & 1) * 32) ^ w0;
            const int row_off = si + a - gi + 7;
            const int d0 = c0 + 4 * hh - cs;
            const LAS float* bp = rpbL + head * 465 + row_off * 31 + (c0 + 4 * hh - wq + 15);
#pragma unroll
            for (int i = 0; i < 16; ++i) {
                const int ci = (i & 3) + 8 * (i >> 2);
                const bool valid = (unsigned)(d0 + ci) < 16u;
                const float bias = valid ? bp[ci] : 0.f;
                st[i] = valid ? st[i] + bias : -INFINITY;
            }
        }
        float tmax = st[0];
#pragma unroll
        for (int i = 1; i < 16; ++i) tmax = fmaxf(tmax, st[i]);
        tmax = fmaxf(tmax, __shfl_xor(tmax, 32));
        const float mnew = fmaxf(mrun, tmax);
        float ps = 0.f;
#pragma unroll
        for (int i = 0; i < 16; ++i) { st[i] = __builtin_amdgcn_exp2f(st[i] - mnew); ps += st[i]; }
        if (__builtin_amdgcn_ballot_w64(tmax > mrun) != 0ull) {
            const float alpha = __builtin_amdgcn_exp2f(mrun - mnew);
            lrun *= alpha;
#pragma unroll
            for (int i = 0; i < 16; ++i) { o0[i] *= alpha; o1[i] *= alpha; }
        }
        lrun += ps; mrun = mnew;
        bf16x8 pb[2];
#pragma unroll
        for (int s = 0; s < 2; ++s) { u32x4 w; w.x = pk2(st[8 * s], st[8 * s + 1]); w.y = pk2(st[8 * s + 2], st[8 * s + 3]); w.z = pk2(st[8 * s + 4], st[8 * s + 5]); w.w = pk2(st[8 * s + 6], st[8 * s + 7]); pb[s] = __builtin_bit_cast(bf16x8, w); }
        asm volatile("s_waitcnt lgkmcnt(0)" ::: "memory");
#pragma unroll
        for (int s = 0; s < 2; ++s) {
            const LAS unsigned char* bs = vtbase + (16 * s) * 144;
            const s16x4 lo0 = vtr(bs), hi0 = vtr(bs + 8 * 144), lo1 = vtr(bs + 64), hi1 = vtr(bs + 8 * 144 + 64);
            const bf16x8 va0 = __builtin_shufflevector(lo0, hi0, 0, 1, 2, 3, 4, 5, 6, 7), va1 = __builtin_shufflevector(lo1, hi1, 0, 1, 2, 3, 4, 5, 6, 7);
            o0 = MFMA32(va0, pb[s], o0); o1 = MFMA32(va1, pb[s], o1);
        }
        asm volatile("s_waitcnt lgkmcnt(0)" ::: "memory");
        if (more) {
#pragma unroll
            for (int i = 0; i < 4; ++i) { const int c = lane + 64 * i; *(LAS u32x4*)(vbuf + (c >> 3) * 144 + (c & 7) * 16) = vn[i]; }
#pragma unroll
            for (int s = 0; s < 4; ++s) kf[s] = kn[s];
        }
    }
    if (MODE == 1) {
#pragma unroll
        for (int i = 0; i < 16; ++i) { xch[i * 64 + lane] = o0[i]; xch[(16 + i) * 64 + lane] = o1[i]; }
        xch[32 * 64 + lane] = mrun; xch[33 * 64 + lane] = lrun;
        __syncthreads();
        return;
    }
    if (MODE == 2) {
        __syncthreads();
        const float mb = xch[32 * 64 + lane], lb = xch[33 * 64 + lane];
        const float mm = fmaxf(mrun, mb), fa = exp2f(mrun - mm), fb = exp2f(mb - mm);
#pragma unroll
        for (int i = 0; i < 16; ++i) { o0[i] = o0[i] * fa + xch[i * 64 + lane] * fb; o1[i] = o1[i] * fa + xch[(16 + i) * 64 + lane] * fb; }
        lrun = lrun * fa + lb * fb;
    }
    const float ltot = lrun + __shfl_xor(lrun, 32);
    const float inv = 1.f / ltot;
    bf16_t* orow = MIX + (size_t)(qrow0 + r) * D + head * 64;
#pragma unroll
    for (int g4 = 0; g4 < 4; ++g4) {
        const int d = 8 * g4 + 4 * hh;
        *(u32x2*)(orow + d) = (u32x2){pk2(o0[4 * g4] * inv, o0[4 * g4 + 1] * inv), pk2(o0[4 * g4 + 2] * inv, o0[4 * g4 + 3] * inv)};
        *(u32x2*)(orow + 32 + d) = (u32x2){pk2(o1[4 * g4] * inv, o1[4 * g4 + 1] * inv), pk2(o1[4 * g4 + 2] * inv, o1[4 * g4 + 3] * inv)};
    }
}

DI void prep_rows8(KP p, int r0, int lane) {
    const bf16_t* ZR = (const bf16_t*)(p->ws + WS_ZR); const float* wts = p->in[12]; const float* k_k = p->in[18];
    bf16_t* R = (bf16_t*)(p->ws + WS_R); bf16_t* KR = (bf16_t*)(p->ws + WS_KR); bf16_t* VV = (bf16_t*)(p->ws + WS_VV); bf16_t* KK = (bf16_t*)(p->ws + WS_KK);
    bf16_t* AL = (bf16_t*)(p->ws + WS_ALORA);
    const int t0 = r0 < NCTX ? (r0 & 255) : ((r0 - NCTX) & 2047); const int T = r0 < NCTX ? SEQ : DSEQ;
    const bool hp = t0 > 0, hn = t0 + 8 < T;
    const bf16_t* zb = ZR + (size_t)(r0 - 1) * RC;
    const f32x4 zero = {0, 0, 0, 0};
#pragma unroll 1
    for (int seg = 0; seg < 3; ++seg) {
        const int c = seg * 512 + lane * 8;
        f32x4 z[10][2];
#pragma unroll
        for (int i = 0; i < 10; ++i) { const bool ok = (i > 0 || hp) && (i < 9 || hn);
            if (ok) { const u32x4 w = *(const u32x4*)(zb + (size_t)i * RC + c); z[i][0] = unpk4((u32x2){w.x, w.y}); z[i][1] = unpk4((u32x2){w.z, w.w}); } else { z[i][0] = zero; z[i][1] = zero; } }
        const f32x4 wa0 = *(const f32x4*)(wts + c), wa1 = *(const f32x4*)(wts + c + 4), wb0 = *(const f32x4*)(wts + RC + c), wb1 = *(const f32x4*)(wts + RC + c + 4),
                    wc0 = *(const f32x4*)(wts + 2 * RC + c), wc1 = *(const f32x4*)(wts + 2 * RC + c + 4);
        const f32x4 k0 = *(const f32x4*)(k_k + lane * 8), k1 = *(const f32x4*)(k_k + lane * 8 + 4);
        bf16_t* dstb = (seg == 0 ? R : (seg == 1 ? KR : VV)) + (size_t)r0 * 512 + lane * 8;
#pragma unroll
        for (int i = 0; i < 8; ++i) {
            const f32x4 u0 = z[i][0] * wa0 + z[i + 1][0] * wb0 + z[i + 2][0] * wc0, u1 = z[i][1] * wa1 + z[i + 1][1] * wb1 + z[i + 2][1] * wc1;
            *(u32x4*)(dstb + (size_t)i * 512) = (u32x4){pk2(u0.x, u0.y), pk2(u0.z, u0.w), pk2(u1.x, u1.y), pk2(u1.z, u1.w)};
            if (seg == 1) {
                const f32x4 a = u0 * k0, bq = u1 * k1;
                float sq = (a.x * a.x + a.y * a.y) + (a.z * a.z + a.w * a.w) + (bq.x * bq.x + bq.y * bq.y) + (bq.z * bq.z + bq.w * bq.w);
                sq += __shfl_xor(sq, 1); sq += __shfl_xor(sq, 2); sq += __shfl_xor(sq, 4);
                const float rn = rsqrtf(sq + 1e-12f);
                const f32x4 ka_ = a * rn, kb_ = bq * rn; *(u32x4*)(KK + (size_t)(r0 + i) * 512 + lane * 8) = (u32x4){pk2(ka_.x, ka_.y), pk2(ka_.z, ka_.w), pk2(kb_.x, kb_.y), pk2(kb_.z, kb_.w)};
            }
        }
    }
    {
        const int cl = lane * 6, cc = 1536 + cl;
        const f32x2 zero2 = {0, 0};
        f32x2 z[10][3];
#pragma unroll
        for (int i = 0; i < 10; ++i) { const bool ok = (i > 0 || hp) && (i < 9 || hn);
#pragma unroll
            for (int q = 0; q < 3; ++q) { if (ok) { const unsigned w = *(const unsigned*)(zb + (size_t)i * RC + cc + 2 * q); z[i][q] = (f32x2){__builtin_bit_cast(float, w << 16), __builtin_bit_cast(float, w & 0xffff0000u)}; } else z[i][q] = zero2; } }
#pragma unroll
        for (int q = 0; q < 3; ++q) {
            const f32x2 wa = *(const f32x2*)(wts + cc + 2 * q), wb = *(const f32x2*)(wts + RC + cc + 2 * q), wcq = *(const f32x2*)(wts + 2 * RC + cc + 2 * q);
            const int cq = cl + 2 * q, grp = cq >> 7, k = cq & 127;
#pragma unroll
            for (int i = 0; i < 8; ++i) {
                f32x2 u = z[i][q] * wa + z[i + 1][q] * wb + z[i + 2][q] * wcq;
                if (grp == 0) { u.x = tanh_f(u.x); u.y = tanh_f(u.y); }
                else if (grp == 2) { u.x = sigmoid_f(u.x); u.y = sigmoid_f(u.y); }
                *(unsigned*)(AL + ((size_t)grp * NTOK + r0 + i) * 128 + k) = pk2(u.x, u.y);
            }
        }
    }
}

template <int CTRL> DI float dppf_(float x) { return __builtin_bit_cast(float, __builtin_amdgcn_mov_dpp(__builtin_bit_cast(int, x), CTRL, 0xf, 0xf, true)); }
template <int CTRL> DI float dpp_add(float x) { const int y = __builtin_amdgcn_mov_dpp(__builtin_bit_cast(int, x), CTRL, 0xf, 0xf, true); return x + __builtin_bit_cast(float, y); }
DI float red16(float x) { x = dpp_add<0xB1>(x); x = dpp_add<0x4E>(x); x = dpp_add<0x141>(x); x = dpp_add<0x140>(x); return x; }

constexpr int TC = 16;
DI float tred4(float q0, float q1, float q2, float q3, bool b0, bool b1) {
    const float ka = b0 ? q2 : q0, kb = b0 ? q3 : q1, sa = b0 ? q0 : q2, sb = b0 ? q1 : q3;
    const float a = ka + dppf_<0xB1>(sa), b = kb + dppf_<0xB1>(sb);
    float c = (b1 ? b : a) + dppf_<0x4E>(b1 ? a : b);
    c += dppf_<0x124>(c);
    c += dppf_<0x128>(c);
    return c;
}
DI f32x2 lo2(f32x4 v) { return __builtin_shufflevector(v, v, 0, 1); }
DI f32x2 hi2(f32x4 v) { return __builtin_shufflevector(v, v, 2, 3); }
struct ScanOps { f32x4 kk, rr, ww, bb, kd; float vv; };
struct ScanLd { f32x4 kk, r, dec, aa, kr, v; };
DI void scan_item(KP p, LAS unsigned char* lds, int latent, int sc, int qr, int tid) {
    const bf16_t* KK = (const bf16_t*)(p->ws + WS_KK); const bf16_t* R = (const bf16_t*)(p->ws + WS_R); const bf16_t* KR = (const bf16_t*)(p->ws + WS_KR);
    const bf16_t* VV = (const bf16_t*)(p->ws + WS_VV); const float* k_a = p->in[19];
    float* Y = (float*)(p->ws + WS_Y);
    const int b = sc >> 4, dir = (sc >> 3) & 1, h = sc & 7;
    const int T = latent ? DSEQ : SEQ; const size_t rowbase = latent ? (size_t)NCTX + (size_t)b * DSEQ : (size_t)b * SEQ;
    const float* DEC = (const float*)(p->ws + WS_DEC) + (size_t)dir * NTOK * 512; const bf16_t* AA = (const bf16_t*)(p->ws + WS_AA) + (size_t)dir * NTOK * 512;
    float* Yd = Y + (size_t)dir * NTOK * 512;
    LAS float* buf = (LAS float*)lds;
    LAS float* vb = (LAS float*)(lds + 2 * TC * 320 * 4);
    const int wave = tid >> 6, lane = tid & 63;
    const bool consumer = wave < 4;
    const int nchunk = T / TC;
    const int rl = lane >> 4, ks = lane & 15, row = 16 * qr + 4 * wave + rl;
    f32x2 S01 = {0, 0}, S23 = {0, 0};
    if (consumer && latent) { const f32x4 s4 = *(const f32x4*)(p->in[4] + ((((size_t)b * 2 + dir) * 8 + h) * 64 + row) * 64 + 4 * ks); S01 = lo2(s4); S23 = hi2(s4); }
    const int lt = tid - 256, lj = lt >> 4, li = lt & 15;
    ScanLd L0, L1; f32x4 ka4 = {0, 0, 0, 0};
    if (!consumer) ka4 = *(const f32x4*)(k_a + h * 64 + 4 * li);
    float* ybase = Yd + (rowbase)*512 + h * 64 + row;
    const bool kb0 = (ks & 1) != 0, kb1 = (ks & 2) != 0; const int ystep = 4 * (ks >> 2) + 2 * (ks & 1) + ((ks >> 1) & 1);
#define SCAN_LOAD(L, c) do { const int idx = (c) * TC + lj; const int tt = dir ? T - 1 - idx : idx; const size_t off = (rowbase + tt) * 512 + h * 64 + 4 * li; \
        L.kk = unpk4(*(const u32x2*)(KK + off)); L.r = unpk4(*(const u32x2*)(R + off)); L.dec = *(const f32x4*)(DEC + off); L.aa = unpk4(*(const u32x2*)(AA + off)); L.kr = unpk4(*(const u32x2*)(KR + off)); \
        if (lt < 64) { const int vj = lt >> 2, vq = lt & 3; const int idv = (c) * TC + vj; const int tv = dir ? T - 1 - idv : idv; L.v = unpk4(*(const u32x2*)(VV + (rowbase + tv) * 512 + h * 64 + 16 * qr + 4 * vq)); } } while (0)
#define SCAN_WRITE(L, bc, vc) do { const f32x4 bb_ = L.kk * L.aa; const f32x4 kd_ = L.kr * ((L.aa - 1.f) * ka4 + 1.f); LAS float* d_ = (bc) + lj * 320 + 4 * li; \
        *(LAS f32x4*)(d_) = L.kk; *(LAS f32x4*)(d_ + 64) = L.r; *(LAS f32x4*)(d_ + 128) = L.dec; *(LAS f32x4*)(d_ + 192) = bb_; *(LAS f32x4*)(d_ + 256) = kd_; \
        if (lt < 64) *(LAS f32x4*)((vc) + (lt >> 2) * 16 + 4 * (lt & 3)) = L.v; } while (0)
#define SCAN_LDOPS(o, bc, vc, j) do { const LAS float* d_ = (bc) + (j) * 320 + 4 * ks; o.kk = *(const LAS f32x4*)(d_); o.rr = *(const LAS f32x4*)(d_ + 64); o.ww = *(const LAS f32x4*)(d_ + 128); \
        o.bb = *(const LAS f32x4*)(d_ + 192); o.kd = *(const LAS f32x4*)(d_ + 256); o.vv = (vc)[(j) * 16 + 4 * wave + rl]; } while (0)
#define SCAN_COMPUTE(bc, vc, c) do { ScanOps oc, on, on2; SCAN_LDOPS(oc, bc, vc, 0); SCAN_LDOPS(on, bc, vc, 1); float ysel = 0.f; float yp0 = 0.f, yp1 = 0.f, yp2 = 0.f; \
        _Pragma("unroll") for (int j = 0; j < TC; ++j) { \
            if (j + 2 < TC) SCAN_LDOPS(on2, bc, vc, j + 2);     \
            f32x2 pq = S01 * lo2(oc.kk); pq = S23 * hi2(oc.kk) + pq; \
            const float sa = red16(pq.x + pq.y); \
            const f32x2 t01 = S01 * lo2(oc.ww) + lo2(oc.kd) * oc.vv, t23 = S23 * hi2(oc.ww) + hi2(oc.kd) * oc.vv; \
            S01 = t01 - lo2(oc.bb) * sa; S23 = t23 - hi2(oc.bb) * sa; \
            f32x2 yq = S01 * lo2(oc.rr); yq = S23 * hi2(oc.rr) + yq; \
            const float yp = yq.x + yq.y; \
            if ((j & 3) == 0) yp0 = yp; else if ((j & 3) == 1) yp1 = yp; else if ((j & 3) == 2) yp2 = yp; \
            else { const float yr = tred4(yp0, yp1, yp2, yp, kb0, kb1); ysel = ((ks >> 2) == (j >> 2)) ? yr : ysel; } \
            oc = on; on = on2; \
            asm volatile("" ::: "memory"); } \
        { const int idx = (c) * TC + ystep; const int tt = dir ? T - 1 - idx : idx; ybase[(size_t)tt * 512] = ysel; } } while (0)
    if (!consumer) { SCAN_LOAD(L0, 0); SCAN_LOAD(L1, 1); }
    for (int c = 0; c < nchunk; c += 2) {
        if (!consumer) SCAN_WRITE(L0, buf, vb);
        __syncthreads();
        if (!consumer) { if (c + 2 < nchunk) SCAN_LOAD(L0, c + 2); }
        else SCAN_COMPUTE(buf, vb, c);
        if (!consumer) SCAN_WRITE(L1, buf + TC * 320, vb + TC * 16);
        __syncthreads();
        if (!consumer) { if (c + 3 < nchunk) SCAN_LOAD(L1, c + 3); }
        else SCAN_COMPUTE(buf + TC * 320, vb + TC * 16, c + 1);
    }
#undef SCAN_LOAD
#undef SCAN_WRITE
#undef SCAN_LDOPS
#undef SCAN_COMPUTE
    if (consumer && !latent) *(f32x4*)(p->out + OUT_S + ((((size_t)b * 2 + dir) * 8 + h) * 64 + row) * 64 + 4 * ks) = (f32x4){S01.x, S01.y, S23.x, S23.y};
    __syncthreads();
}

constexpr int CS_L = 32, CS_LAT = 2048, CS_CHUNKS = 4096;
DI unsigned char* cs_mf(unsigned char* ws, int q) { return ws + 28 * MiB + (size_t)q * 8192; }
DI unsigned char* cs_q1(unsigned char* ws, int q) { return q < CS_LAT ? ws + 60 * MiB + (size_t)q * 4096 : ws + 76 * MiB + (size_t)(q - CS_LAT) * 4096; }
DI unsigned char* cs_q2(unsigned char* ws, int q) { return q < CS_LAT ? ws + 92 * MiB + (size_t)q * 4096 : ws + 108 * MiB + (size_t)(q - CS_LAT) * 4096; }
DI unsigned char* cs_nt(unsigned char* ws, int q) { return q < CS_LAT ? ws + 202 * MiB + (size_t)q * 8192 : ws + 234 * MiB + (size_t)(q - CS_LAT) * 8192; }
constexpr int CS_G = 49152;
DI bf16x8 frag_nat(const LAS unsigned char* img, int pitch, int rc, int s, int hh) { return *(const LAS bf16x8*)(img + rc * pitch + (16 * s + 8 * hh) * 2); }
DI bf16x8 frag_krow(const LAS unsigned char* img, int pitch, int rc, int s, int hh) {
    const s16x4 lo = *(const LAS s16x4*)(img + rc * pitch + (16 * s + 4 * hh) * 2), hi = *(const LAS s16x4*)(img + rc * pitch + (16 * s + 8 + 4 * hh) * 2);
    return __builtin_shufflevector(lo, hi, 0, 1, 2, 3, 4, 5, 6, 7); }
DI bf16x8 frag_tr(const LAS unsigned char* img, int pitch, int col0, int s, int lane) {
    const int i16 = lane & 15, tq = i16 >> 2, tp = i16 & 3, blk = (lane >> 4) & 1, hh = lane >> 5;
    const LAS unsigned char* bs = img + (16 * s + 4 * hh + tq) * pitch + (col0 + 16 * blk) * 2 + 8 * tp;
    const s16x4 lo = vtr(bs), hi = vtr(bs + 8 * pitch);
    return __builtin_shufflevector(lo, hi, 0, 1, 2, 3, 4, 5, 6, 7); }
template <int S> DI bf16x8 pack8(const f32x16& x, float sg) {
    u32x4 w; w.x = pk2(sg * x[8 * S], sg * x[8 * S + 1]); w.y = pk2(sg * x[8 * S + 2], sg * x[8 * S + 3]); w.z = pk2(sg * x[8 * S + 4], sg * x[8 * S + 5]); w.w = pk2(sg * x[8 * S + 6], sg * x[8 * S + 7]);
    return __builtin_bit_cast(bf16x8, w); }
template <int S> DI bf16x8 pack8lo(const f32x16& x, bf16x8 hi) {
    const u32x4 h = __builtin_bit_cast(u32x4, hi); float d[8];
#pragma unroll
    for (int j = 0; j < 4; ++j) { d[2 * j] = x[8 * S + 2 * j] - __builtin_bit_cast(float, h[j] << 16); d[2 * j + 1] = x[8 * S + 2 * j + 1] - __builtin_bit_cast(float, h[j] & 0xffff0000u); }
    u32x4 w; w.x = pk2(d[0], d[1]); w.y = pk2(d[2], d[3]); w.z = pk2(d[4], d[5]); w.w = pk2(d[6], d[7]);
    return __builtin_bit_cast(bf16x8, w); }
DI void lds_barrier() { asm volatile("s_waitcnt lgkmcnt(0)" ::: "memory"); __builtin_amdgcn_s_barrier(); asm volatile("" ::: "memory"); }
DI f32x16 zero16() { f32x16 z;
#pragma unroll
    for (int i = 0; i < 16; ++i) z[i] = 0.f;
    return z; }

DI void cs_phaseA(KP p, LAS unsigned char* lds, int tid, int qbase, int nit, int first, int stride) {
    const bf16_t* KK = (const bf16_t*)(p->ws + WS_KK); const bf16_t* R = (const bf16_t*)(p->ws + WS_R); const bf16_t* KR = (const bf16_t*)(p->ws + WS_KR);
    const bf16_t* VV = (const bf16_t*)(p->ws + WS_VV); const float* k_a = p->in[19];
    const int wave = tid >> 6, lane = tid & 63, g = wave >> 2, wq = wave & 3, tg = wq * 64 + lane, hh = lane >> 5, r32 = lane & 31;
    LAS unsigned char* L = lds + g * CS_G;
    LAS unsigned char* MKK = L, *MBT = L + 4608, *MKT = L + 2 * 4608, *MRT = L + 3 * 4608, *MBH = L + 4 * 4608, *MKH = L + 5 * 4608, *MVM = L + 6 * 4608;
    LAS float* AF = (LAS float*)(L + 32256);
    LAS unsigned char* ST = L + 36352, *SKK = ST + 2560, *SRB = ST + 2 * 2560, *SRK = ST + 3 * 2560;
    LAS float* SEG = (LAS float*)(L + 46592); LAS float* ELv = (LAS float*)(L + 48640);
    f32x2 lwN[4], kkN[4], aaN[4], krN[4], rN[4]; u32x4 vmN;
#define CSA_FETCH(it_) do { const int q_ = qbase + (it_) * 2 + g; const bool lat_ = q_ < CS_LAT; const int sc_ = lat_ ? (q_ >> 6) : ((q_ - CS_LAT) >> 3), ci_ = lat_ ? (q_ & 63) : (q_ & 7), TT_ = lat_ ? DSEQ : SEQ; \
        const int b_ = sc_ >> 4, dir_ = (sc_ >> 3) & 1, h_ = sc_ & 7; const int rb_ = lat_ ? NCTX + b_ * DSEQ : b_ * SEQ; \
          \
        const int t0_ = dir_ ? TT_ - 1 - ci_ * CS_L : ci_ * CS_L, sg_ = dir_ ? -512 : 512; \
        const unsigned ub_ = (unsigned)((rb_ + t0_) * 512 + h_ * 64); \
        const unsigned o0_ = ub_ + (unsigned)(sg_ * 4 * (tg >> 5) + 2 * (tg & 31)); \
        const float* DEC_ = (const float*)(p->ws + WS_DEC) + (size_t)dir_ * NTOK * 512; const bf16_t* AA_ = (const bf16_t*)(p->ws + WS_AA) + (size_t)dir_ * NTOK * 512; \
        _Pragma("unroll") for (int j = 0; j < 4; ++j) { const unsigned off = o0_ + (unsigned)(sg_ * j); \
            lwN[j] = *(const f32x2*)(DEC_ + off); kkN[j] = ldh2(KK + off); aaN[j] = ldh2(AA_ + off); krN[j] = ldh2(KR + off); rN[j] = ldh2(R + off); } \
        vmN = *(const u32x4*)(VV + (ub_ + (unsigned)(sg_ * (tg >> 3) + (tg & 7) * 8))); } while (0)
    if (first < nit) CSA_FETCH(first);
    for (int it = first; it < nit; it += stride) {
        const int q = qbase + it * 2 + g; const bool lat = q < CS_LAT;
        const int sc = lat ? (q >> 6) : ((q - CS_LAT) >> 3), ci = lat ? (q & 63) : (q & 7), TT = lat ? DSEQ : SEQ;
        const int b = sc >> 4, dir = (sc >> 3) & 1, h = sc & 7;
        const size_t rowbase = lat ? (size_t)NCTX + (size_t)b * DSEQ : (size_t)b * SEQ;
        const float* DEC = (const float*)(p->ws + WS_DEC) + (size_t)dir * NTOK * 512; const bf16_t* AA = (const bf16_t*)(p->ws + WS_AA) + (size_t)dir * NTOK * 512;
        {
            const int kp = tg & 31, seg = tg >> 5;
            f32x2 lw[4], kk2[4], aa2[4], kr2[4], r2[4];
#pragma unroll
            for (int j = 0; j < 4; ++j) { lw[j] = lwN[j]; kk2[j] = kkN[j]; aa2[j] = aaN[j]; kr2[j] = krN[j]; r2[j] = rN[j]; }
            const u32x4 vmC = vmN;
            if (it + stride < nit) CSA_FETCH(it + stride);
            f32x2 ss = {0.f, 0.f};
#pragma unroll
            for (int j = 0; j < 4; ++j) { lw[j].x = __logf(lw[j].x); lw[j].y = __logf(lw[j].y); ss += lw[j]; }
            *(LAS f32x2*)(SEG + seg * 64 + 2 * kp) = ss;
            { const int i = tg >> 3, v0 = (tg & 7) * 8; *(LAS u32x4*)(MVM + i * 144 + v0 * 2) = vmC; }
            lds_barrier();
            f32x2 pre = {0.f, 0.f}, tot = {0.f, 0.f};
#pragma unroll
            for (int s8 = 0; s8 < 8; ++s8) { const f32x2 v = *(const LAS f32x2*)(SEG + s8 * 64 + 2 * kp); tot += v; if (s8 < seg) pre += v; }
            if (seg == 0) *(LAS f32x2*)(ELv + 2 * kp) = (f32x2){__expf(tot.x), __expf(tot.y)};
            const f32x2 ka = *(const f32x2*)(k_a + h * 64 + 2 * kp);
            f32x2 cwp = pre;
#pragma unroll
            for (int j = 0; j < 4; ++j) {
                const f32x2 cw = cwp + lw[j];
                const f32x2 E = {__expf(cw.x), __expf(cw.y)}, Ei = {__expf(-cw.x), __expf(-cw.y)}, Ep = {__expf(cwp.x), __expf(cwp.y)}, Eh = {__expf(tot.x - cw.x), __expf(tot.y - cw.y)};
                const f32x2 bb = kk2[j] * aa2[j], kd = kr2[j] * ((aa2[j] - 1.f) * ka + 1.f);
                const int o = (4 * seg + j) * 144 + 4 * kp;
                const f32x2 x0 = kk2[j] * Ep, x1 = bb * Ei, x2 = kd * Ei, x3 = r2[j] * E, x4 = bb * Eh, x5 = kd * Eh;
                *(LAS unsigned*)(MKK + o) = pk2(x0.x, x0.y); *(LAS unsigned*)(MBT + o) = pk2(x1.x, x1.y); *(LAS unsigned*)(MKT + o) = pk2(x2.x, x2.y);
                *(LAS unsigned*)(MRT + o) = pk2(x3.x, x3.y); *(LAS unsigned*)(MBH + o) = pk2(x4.x, x4.y); *(LAS unsigned*)(MKH + o) = pk2(x5.x, x5.y);
                cwp = cw;
            }
        }
        lds_barrier();
        {
            const LAS unsigned char* ia = wq < 2 ? MKK : MRT; const LAS unsigned char* ib = (wq & 1) ? MKT : MBT;
            f32x16 acc = zero16();
#pragma unroll
            for (int s4 = 0; s4 < 4; ++s4) acc = MFMA32(frag_nat(ia, 144, r32, s4, hh), frag_nat(ib, 144, r32, s4, hh), acc);
#pragma unroll
            for (int i = 0; i < 16; ++i) { const int row = crow(i, hh); const bool keep = wq < 2 ? (row > r32) : (row >= r32); const float v = keep ? acc[i] : 0.f;
                if (wq == 0) AF[row * 32 + r32] = v;
                else *(LAS unsigned short*)((wq == 1 ? SKK : (wq == 2 ? SRB : SRK)) + row * 80 + r32 * 2) = (unsigned short)(pk2(v, 0.f) & 0xffffu); }
        }
        lds_barrier();
        f32x16 X = zero16(), NT0 = zero16(), NT1 = zero16(), Q2 = zero16();
        const int c = wq & 1;
        if (wq == 0) {
            float Tc[32];
#pragma unroll
            for (int i = 0; i < 32; ++i) {
                float a4[4] = {(i == r32) ? 1.f : 0.f, 0.f, 0.f, 0.f};
#pragma unroll
                for (int j4 = 0; j4 < (i + 3) / 4; ++j4) { const f32x4 ar = *(const LAS f32x4*)(AF + i * 32 + 4 * j4);
#pragma unroll
                    for (int e = 0; e < 4; ++e) if (4 * j4 + e < i) a4[e] -= ar[e] * Tc[4 * j4 + e]; }
                const float a = (a4[0] + a4[1]) + (a4[2] + a4[3]);
                Tc[i] = a;
                if (lane < 32) *(LAS unsigned short*)(ST + i * 80 + r32 * 2) = (unsigned short)(pk2(a, 0.f) & 0xffffu);
            }
        } else if (wq >= 2) {
#pragma unroll
            for (int s2 = 0; s2 < 2; ++s2) {
                const bf16x8 vm = frag_tr(MVM, 144, 32 * c, s2, lane);
                X = MFMA32(frag_krow(SKK, 80, r32, s2, hh), vm, X);
                Q2 = MFMA32(frag_krow(SRK, 80, r32, s2, hh), vm, Q2);
                NT0 = MFMA32(frag_tr(MKH, 144, 0, s2, lane), vm, NT0);
                NT1 = MFMA32(frag_tr(MKH, 144, 32, s2, lane), vm, NT1);
            }
        }
        lds_barrier();
        if (wq < 2) {
            f32x16 P1 = zero16();
#pragma unroll
            for (int s2 = 0; s2 < 2; ++s2) P1 = MFMA32(frag_krow(ST, 80, r32, s2, hh), frag_tr(MKK, 144, 32 * c, s2, lane), P1);
            const bf16x8 n0 = pack8<0>(P1, -1.f), n1 = pack8<1>(P1, -1.f);
            f32x16 Q1t;
#pragma unroll
            for (int g4 = 0; g4 < 4; ++g4) { const u32x2 w = *(const LAS u32x2*)(MRT + r32 * 144 + (32 * c + 8 * g4 + 4 * hh) * 2); const f32x4 f = unpk4(w);
                Q1t[4 * g4] = f.x; Q1t[4 * g4 + 1] = f.y; Q1t[4 * g4 + 2] = f.z; Q1t[4 * g4 + 3] = f.w; }
            Q1t = MFMA32(n0, frag_krow(SRB, 80, r32, 0, hh), Q1t); Q1t = MFMA32(n1, frag_krow(SRB, 80, r32, 1, hh), Q1t);
            u32x4* q1f = (u32x4*)cs_q1(p->ws, q) + (c * 2) * 64 + lane;
            q1f[0] = __builtin_bit_cast(u32x4, pack8<0>(Q1t, 1.f)); q1f[64] = __builtin_bit_cast(u32x4, pack8<1>(Q1t, 1.f));
#pragma unroll
            for (int bq = 0; bq < 2; ++bq) {
                f32x16 M = zero16();
                if (bq == c) {
#pragma unroll
                    for (int i = 0; i < 16; ++i) M[i] = (crow(i, hh) == r32) ? ELv[32 * c + r32] : 0.f;
                }
                M = MFMA32(n0, frag_tr(MBH, 144, 32 * bq, 0, lane), M); M = MFMA32(n1, frag_tr(MBH, 144, 32 * bq, 1, lane), M);
                u32x4* mf = (u32x4*)cs_mf(p->ws, q) + ((c * 2 + bq) * 2) * 64 + lane;
                mf[0] = __builtin_bit_cast(u32x4, pack8<0>(M, 1.f)); mf[64] = __builtin_bit_cast(u32x4, pack8<1>(M, 1.f));
            }
        } else {
            f32x16 P2 = zero16();
            P2 = MFMA32(frag_krow(ST, 80, r32, 0, hh), pack8<0>(X, 1.f), P2); P2 = MFMA32(frag_krow(ST, 80, r32, 1, hh), pack8<1>(X, 1.f), P2);
            const bf16x8 n0 = pack8<0>(P2, -1.f), n1 = pack8<1>(P2, -1.f);
            Q2 = MFMA32(frag_krow(SRB, 80, r32, 0, hh), n0, Q2); Q2 = MFMA32(frag_krow(SRB, 80, r32, 1, hh), n1, Q2);
            NT0 = MFMA32(frag_tr(MBH, 144, 0, 0, lane), n0, NT0); NT0 = MFMA32(frag_tr(MBH, 144, 0, 1, lane), n1, NT0);
            NT1 = MFMA32(frag_tr(MBH, 144, 32, 0, lane), n0, NT1); NT1 = MFMA32(frag_tr(MBH, 144, 32, 1, lane), n1, NT1);
            unsigned* q2f = (unsigned*)cs_q2(p->ws, q) + c * 512 + lane;
#pragma unroll
            for (int i = 0; i < 8; ++i) q2f[i * 64] = pk2(Q2[2 * i], Q2[2 * i + 1]);
            unsigned* ntf = (unsigned*)cs_nt(p->ws, q) + (c * 2) * 512 + lane;
#pragma unroll
            for (int i = 0; i < 8; ++i) { ntf[i * 64] = pk2(NT0[2 * i], NT0[2 * i + 1]); ntf[512 + i * 64] = pk2(NT1[2 * i], NT1[2 * i + 1]); }
        }
        lds_barrier();
    }
#undef CSA_FETCH
}


constexpr int CSB_SLOT = 24576;
DI void cs_phaseB(KP p, LAS unsigned char* lds, int latent, int sc, int tid) {
    const int wave = tid >> 6, lane = tid & 63, hh = lane >> 5, r32 = lane & 31;
    const int nch = latent ? 64 : 8, q0 = latent ? sc * 64 : CS_LAT + sc * 8, TT = latent ? DSEQ : SEQ;
    const int b = sc >> 4, dir = (sc >> 3) & 1, h = sc & 7, c = wave & 1;
    const size_t rowbase = latent ? (size_t)NCTX + (size_t)b * DSEQ : (size_t)b * SEQ;
    const bool consumer = wave < 2;
    float* Yu = p->out + (size_t)dir * NTOK * 512 + rowbase * 512 + h * 64 + 32 * c;
    const unsigned ylane = (unsigned)((dir ? 4 * (1 - hh) : 4 * hh) * 512 + r32);
    f32x16 Z0 = zero16(), Z1 = zero16();
    if (consumer && latent) { const float* s0 = p->in[4] + ((((size_t)b * 2 + dir) * 8 + h) * 64 + 32 * c + r32) * 64;
#pragma unroll
      for (int g4 = 0; g4 < 4; ++g4) { const f32x4 a = *(const f32x4*)(s0 + 8 * g4 + 4 * hh), bq = *(const f32x4*)(s0 + 32 + 8 * g4 + 4 * hh);
          Z0[4 * g4] = a.x; Z0[4 * g4 + 1] = a.y; Z0[4 * g4 + 2] = a.z; Z0[4 * g4 + 3] = a.w; Z1[4 * g4] = bq.x; Z1[4 * g4 + 1] = bq.y; Z1[4 * g4 + 2] = bq.z; Z1[4 * g4 + 3] = bq.w; } }
    const int lt = tid - 128;
    u32x4 RG[4][4];
#define CSB_LOADQ(set, ch) do { const int q_ = q0 + (ch); _Pragma("unroll") for (int k_ = 0; k_ < 4; ++k_) { const int pi_ = lt + 384 * k_; \
        const unsigned char* src_ = pi_ < 512 ? cs_mf(p->ws, q_) + pi_ * 16 : (pi_ < 768 ? cs_q1(p->ws, q_) + (pi_ - 512) * 16 : (pi_ < 1280 ? cs_nt(p->ws, q_) + (pi_ - 768) * 16 : cs_q2(p->ws, q_) + (pi_ - 1280) * 16)); \
        RG[set][k_] = *(const u32x4*)src_; } } while (0)
#define CSB_WRITEQ(set, slot) do { _Pragma("unroll") for (int k_ = 0; k_ < 4; ++k_) *(LAS u32x4*)(lds + (slot) * CSB_SLOT + (lt + 384 * k_) * 16) = RG[set][k_]; } while (0)
    if (!consumer) { CSB_LOADQ(0, 0); CSB_LOADQ(1, 1); CSB_LOADQ(2, 2); CSB_LOADQ(3, 3); CSB_WRITEQ(0, 0); CSB_LOADQ(0, 4); }
    else __builtin_amdgcn_s_setprio(3);
    for (int ci0 = 0; ci0 < nch; ci0 += 4) {
#pragma unroll
        for (int u = 0; u < 4; ++u) {
            const int ci = ci0 + u;
            lds_barrier();
            if (!consumer) {
                if (ci + 1 < nch) { CSB_WRITEQ((u + 1) & 3, (ci + 1) & 1); if (ci + 5 < nch) CSB_LOADQ((u + 1) & 3, ci + 5); }
            } else {
                const LAS unsigned char* sl = lds + (ci & 1) * CSB_SLOT;
                bf16x8 MF[8], Q1[4]; f32x16 Y, N0, N1;
#pragma unroll
                for (int i = 0; i < 8; ++i) MF[i] = *(const LAS bf16x8*)(sl + (i * 64 + lane) * 16);
#pragma unroll
                for (int i = 0; i < 4; ++i) Q1[i] = *(const LAS bf16x8*)(sl + 8192 + (i * 64 + lane) * 16);
#pragma unroll
                for (int i = 0; i < 8; ++i) { const unsigned w0 = *(const LAS unsigned*)(sl + 12288 + ((c * 2) * 512 + i * 64 + lane) * 4), w1 = *(const LAS unsigned*)(sl + 12288 + ((c * 2 + 1) * 512 + i * 64 + lane) * 4),
                                                         w2 = *(const LAS unsigned*)(sl + 20480 + (c * 512 + i * 64 + lane) * 4);
                    N0[2 * i] = __builtin_bit_cast(float, w0 << 16); N0[2 * i + 1] = __builtin_bit_cast(float, w0 & 0xffff0000u);
                    N1[2 * i] = __builtin_bit_cast(float, w1 << 16); N1[2 * i + 1] = __builtin_bit_cast(float, w1 & 0xffff0000u);
                    Y[2 * i] = __builtin_bit_cast(float, w2 << 16); Y[2 * i + 1] = __builtin_bit_cast(float, w2 & 0xffff0000u); }
                const bf16x8 z00 = pack8<0>(Z0, 1.f), z01 = pack8<1>(Z0, 1.f), z10 = pack8<0>(Z1, 1.f), z11 = pack8<1>(Z1, 1.f);
                const bf16x8 l00 = pack8lo<0>(Z0, z00), l01 = pack8lo<1>(Z0, z01), l10 = pack8lo<0>(Z1, z10), l11 = pack8lo<1>(Z1, z11);
                Y = MFMA32(Q1[0], z00, Y); Y = MFMA32(Q1[1], z01, Y); Y = MFMA32(Q1[2], z10, Y); Y = MFMA32(Q1[3], z11, Y);
                N0 = MFMA32(MF[0], z00, N0); N0 = MFMA32(MF[1], z01, N0); N0 = MFMA32(MF[4], z10, N0); N0 = MFMA32(MF[5], z11, N0);
                N0 = MFMA32(MF[0], l00, N0); N0 = MFMA32(MF[1], l01, N0); N0 = MFMA32(MF[4], l10, N0); N0 = MFMA32(MF[5], l11, N0);
                N1 = MFMA32(MF[2], z00, N1); N1 = MFMA32(MF[3], z01, N1); N1 = MFMA32(MF[6], z10, N1); N1 = MFMA32(MF[7], z11, N1);
                N1 = MFMA32(MF[2], l00, N1); N1 = MFMA32(MF[3], l01, N1); N1 = MFMA32(MF[6], l10, N1); N1 = MFMA32(MF[7], l11, N1);
                Z0 = N0; Z1 = N1;
                { const int t0 = dir ? TT - CS_L - ci * CS_L : ci * CS_L;
#pragma unroll
                  for (int i = 0; i < 16; ++i) { const int ci_ = (i & 3) + 8 * (i >> 2); float* Ys = Yu + (size_t)(t0 + (dir ? 27 - ci_ : ci_)) * 512; Ys[ylane] = Y[i]; } }
            }
        }
    }
#undef CSB_LOADQ
#undef CSB_WRITEQ
    __builtin_amdgcn_s_setprio(0);
    if (consumer && !latent) { float* so = p->out + OUT_S + ((((size_t)b * 2 + dir) * 8 + h) * 64 + 32 * c + r32) * 64;
#pragma unroll
        for (int g4 = 0; g4 < 4; ++g4) { *(f32x4*)(so + 8 * g4 + 4 * hh) = (f32x4){Z0[4 * g4], Z0[4 * g4 + 1], Z0[4 * g4 + 2], Z0[4 * g4 + 3]};
                                          *(f32x4*)(so + 32 + 8 * g4 + 4 * hh) = (f32x4){Z1[4 * g4], Z1[4 * g4 + 1], Z1[4 * g4 + 2], Z1[4 * g4 + 3]}; } }
    __syncthreads();
}

DI void post_row(KP p, int r, int lane) {
    const float* Y = p->out; const bf16_t* R = (const bf16_t*)(p->ws + WS_R); const bf16_t* KR = (const bf16_t*)(p->ws + WS_KR);
    const bf16_t* VV = (const bf16_t*)(p->ws + WS_VV); const bf16_t* AA = (const bf16_t*)(p->ws + WS_AA); const bf16_t* G = (const bf16_t*)(p->ws + WS_G);
    const float* k_a = p->in[19]; const float* r_k = p->in[20]; const float* lng = p->in[21]; const float* lnb = p->in[22];
    bf16_t* MIX = (bf16_t*)(p->ws + WS_MIX);
    const int c = lane * 8; const size_t off = (size_t)r * 512 + c;
    float y[8], rr[8], kr[8], vv[8], a0[8], a1[8], gg[8], ka[8], rk[8], lg[8], lb[8];
#define LD8(dst, ptr) do { const f32x4 _a = *(const f32x4*)(ptr), _b = *(const f32x4*)((ptr) + 4); dst[0] = _a.x; dst[1] = _a.y; dst[2] = _a.z; dst[3] = _a.w; dst[4] = _b.x; dst[5] = _b.y; dst[6] = _b.z; dst[7] = _b.w; } while (0)
#define LD8H(dst, ptr) do { const u32x4 _w = *(const u32x4*)(ptr); const f32x4 _a = unpk4((u32x2){_w.x, _w.y}), _b = unpk4((u32x2){_w.z, _w.w}); dst[0] = _a.x; dst[1] = _a.y; dst[2] = _a.z; dst[3] = _a.w; dst[4] = _b.x; dst[5] = _b.y; dst[6] = _b.z; dst[7] = _b.w; } while (0)
    LD8(y, Y + off); LD8(rr, Y + (size_t)NTOK * 512 + off);
#pragma unroll
    for (int j = 0; j < 8; ++j) y[j] += rr[j];
    LD8H(rr, R + off); LD8H(kr, KR + off); LD8H(vv, VV + off); LD8H(a0, AA + off); LD8H(a1, AA + (size_t)NTOK * 512 + off); LD8H(gg, G + off);
    LD8(ka, k_a + c); LD8(rk, r_k + c); LD8(lg, lng + c); LD8(lb, lnb + c);
#undef LD8
#undef LD8H
    float s = 0.f, d0 = 0.f, d1 = 0.f;
#pragma unroll
    for (int j = 0; j < 8; ++j) { s += y[j]; const float q = rr[j] * kr[j] * rk[j]; d0 += q * (1.f + (a0[j] - 1.f) * ka[j]); d1 += q * (1.f + (a1[j] - 1.f) * ka[j]); }
    float bd = d0 + d1;
    s += __shfl_xor(s, 1); s += __shfl_xor(s, 2); s += __shfl_xor(s, 4);
    bd += __shfl_xor(bd, 1); bd += __shfl_xor(bd, 2); bd += __shfl_xor(bd, 4);
    const float mu = s * (1.f / 64.f);
    float q2 = 0.f;
#pragma unroll
    for (int j = 0; j < 8; ++j) { y[j] -= mu; q2 += y[j] * y[j]; }
    q2 += __shfl_xor(q2, 1); q2 += __shfl_xor(q2, 2); q2 += __shfl_xor(q2, 4);
    const float rs = rsqrtf(q2 * (1.f / 64.f) + GN_EPS);
    float o[8];
#pragma unroll
    for (int j = 0; j < 8; ++j) o[j] = (y[j] * rs * lg[j] + lb[j] + bd * vv[j]) * gg[j];
    *(u32x4*)(MIX + (size_t)r * D + 512 + c) = (u32x4){pk2(o[0], o[1]), pk2(o[2], o[3]), pk2(o[4], o[5]), pk2(o[6], o[7])};
}

DI void act_fix(KP p, int idx) {
    const float* EDGE = (const float*)(p->ws + WS_EDGE); bf16_t* ACT = (bf16_t*)(p->ws + WS_ACT); const float* wc = p->in[27];
    const int c = (idx % 352) * 8, e = (idx / 352) & 1, pm = 16 + idx / 704;
    const bool need = e == 0 ? (pm != 16 && pm != 24) : (pm != 23 && pm != 31);
    if (!need) return;
    const int r = pm * 256 + (e ? 255 : 0), nbpm = e ? pm + 1 : pm - 1;
    const float* nb = EDGE + ((size_t)nbpm * 2 + (1 - e)) * DFF + c;
    const float* eu = EDGE + ((size_t)pm * 2 + e) * DFF + 64 * DFF + c; const float* e3 = eu + 64 * DFF;
    const float* w = wc + (e ? 2 * DFF : 0) + c;
    float o[8];
#pragma unroll
    for (int j = 0; j < 8; ++j) o[j] = silu_f(eu[j] + w[j] * nb[j]) * e3[j];
    *(u32x4*)(ACT + (size_t)r * DFF + c) = (u32x4){pk2(o[0], o[1]), pk2(o[2], o[3]), pk2(o[4], o[5]), pk2(o[6], o[7])};
}

template <int NR>
DI void final_rows(KP p, int rbase, int rstride, int lane) {
    const float* MODb = (const float*)(p->ws + WS_MOD);
    const bf16_t* PART = (const bf16_t*)(p->ws + WS_PART); const float* nf = p->in[29];
    f32x4 v[NR][4]; u32x2 p0[NR][4], p1[NR][4];
#pragma unroll
    for (int q = 0; q < NR; ++q) { const int r = rbase + q * rstride; const f32x4* xr = (const f32x4*)(p->out + (size_t)r * D) + lane;
#pragma unroll
        for (int j = 0; j < 4; ++j) { v[q][j] = xr[64 * j]; p0[q][j] = *((const u32x2*)(PART + (size_t)r * D) + lane + 64 * j); p1[q][j] = *((const u32x2*)(PART + (size_t)(NTOK + r) * D) + lane + 64 * j); } }
    float s[NR];
#pragma unroll
    for (int q = 0; q < NR; ++q) { const int r = rbase + q * rstride; const float* MOD = MODb + midx_of(r) * 6144; s[q] = 0.f;
#pragma unroll
        for (int j = 0; j < 4; ++j) { const f32x4 gt = *((const f32x4*)(MOD + 5 * D) + lane + 64 * j); v[q][j] = v[q][j] + gt * (unpk4(p0[q][j]) + unpk4(p1[q][j]));
            s[q] += (v[q][j].x * v[q][j].x + v[q][j].y * v[q][j].y) + (v[q][j].z * v[q][j].z + v[q][j].w * v[q][j].w); } }
#pragma unroll
    for (int o = 1; o < 64; o <<= 1) {
#pragma unroll
        for (int q = 0; q < NR; ++q) s[q] += __shfl_xor(s[q], o); }
#pragma unroll
    for (int q = 0; q < NR; ++q) { const int r = rbase + q * rstride; f32x4* xr = (f32x4*)(p->out + (size_t)r * D) + lane; const float rstd = rsqrtf(s[q] * (1.f / D) + EPS);
#pragma unroll
        for (int j = 0; j < 4; ++j) xr[64 * j] = v[q][j] * rstd * *((const f32x4*)nf + lane + 64 * j); }
}

DI int lane_id() { int l; asm volatile("v_mbcnt_lo_u32_b32 %0, -1, 0\n\tv_mbcnt_hi_u32_b32 %0, -1, %0" : "=v"(l)); return l; }
#define XB_TMO      128
#define XB_XCNT(j)  (256  + 64 * (j))
#define XB_XSUB(j)  (1280 + 64 * (j))
#define XB_XGEN(j)  (2304 + 64 * (j))
#define XB_TOP      3328
#define XB_TOPGEN   3392
#define XB_SUBBAR   3520
#define XB_SPIN_CAP (1u << 18)
DI unsigned xb_ld(unsigned* p)              { return __hip_atomic_load(p, __ATOMIC_RELAXED, __HIP_MEMORY_SCOPE_AGENT); }
DI unsigned xb_add(unsigned* p, unsigned v) { return __hip_atomic_fetch_add(p, v, __ATOMIC_RELAXED, __HIP_MEMORY_SCOPE_AGENT); }
DI unsigned xb_xcc_id() { return (unsigned)__builtin_amdgcn_s_getreg((3 << 11) | 20) & 0xFu; }
#define XB_SPIN(cond, bar) do { unsigned _sp = 0; while (cond) { __builtin_amdgcn_s_sleep(1); \
    if ((++_sp & 255u) == 0u) { if (xb_ld(&(bar)[XB_TMO])) break; if (_sp > XB_SPIN_CAP) { atomicAdd(&(bar)[XB_TMO], 1u); break; } } } } while (0)
DI void xcd_barrier_complete(unsigned* bar, unsigned x, unsigned G, unsigned& nloc, unsigned& nx) {
    unsigned sum, cnt, mine, sp = 0u;
    for (;;) {
        sum = 0u; cnt = 0u; mine = 0u;
#pragma unroll
        for (unsigned j = 0; j < 16; ++j) { const unsigned c = xb_ld(&bar[XB_XCNT(j)]); sum += c; cnt += (c > 0u) ? 1u : 0u; mine = (j == x) ? c : mine; }
        if (sum == G) break;
        __builtin_amdgcn_s_sleep(1);
        if ((++sp & 255u) == 0u) { if (xb_ld(&bar[XB_TMO])) break; if (sp > XB_SPIN_CAP) { atomicAdd(&bar[XB_TMO], 1u); break; } }
    }
    nloc = mine > 0u ? mine : 1u; nx = cnt > 0u ? cnt : 1u;
}
DI void grid_bar(unsigned* bar, volatile LAS unsigned* st, unsigned G, int wave_s) {
    asm volatile("s_waitcnt vmcnt(0)" ::: "memory");
    __syncthreads();
    int t = wave_s * 64 + lane_id(); asm volatile("" : "+v"(t));
    if (t == 0) {
        __builtin_amdgcn_s_waitcnt(0);
        const unsigned x = xb_xcc_id();
        unsigned nloc = st[0], nx = st[1];
        if (nloc == 0u) { xcd_barrier_complete(bar, x, G, nloc, nx); st[0] = nloc; st[1] = nx; }
        const unsigned old = xb_add(&bar[XB_XSUB(x)], 1u);
        const unsigned gen = old / nloc;
        if (old + 1u == (gen + 1u) * nloc) {
            __builtin_amdgcn_fence(__ATOMIC_RELEASE, "agent");
            asm volatile("s_waitcnt vmcnt(0)" ::: "memory");
            const unsigned og = xb_add(&bar[XB_TOP], 1u);
            const unsigned tg = og / nx;
            if (og + 1u == (tg + 1u) * nx) xb_add(&bar[XB_TOPGEN], 1u);
            else XB_SPIN(xb_ld(&bar[XB_TOPGEN]) == tg, bar);
            __builtin_amdgcn_fence(__ATOMIC_ACQUIRE, "agent");
            xb_add(&bar[XB_XGEN(x)], 1u);
            asm volatile("s_waitcnt vmcnt(0)" ::: "memory");
        } else {
            XB_SPIN(xb_ld(&bar[XB_XGEN(x)]) == gen, bar);
            __builtin_amdgcn_fence(__ATOMIC_ACQUIRE, "agent");
            asm volatile("s_waitcnt vmcnt(0)" ::: "memory");
        }
    }
    __syncthreads();
}

__global__ void __launch_bounds__(512, 2) fwd_megakernel(Params kparams) {
    const KP kp0 = (KP)__builtin_amdgcn_kernarg_segment_ptr();
    extern __shared__ __attribute__((aligned(16))) unsigned char lds_raw[];
    LAS unsigned char* lds = (LAS unsigned char*)lds_raw;
    const int wave_s = __builtin_amdgcn_readfirstlane((int)threadIdx.x >> 6);
    volatile LAS unsigned* xbst = (volatile LAS unsigned*)(lds + LDS_XB);
    {
        int t0_ = wave_s * 64 + lane_id();
        if (t0_ == 0) { xbst[0] = 0u; xbst[1] = 0u; (void)xb_add((unsigned*)(kp0->ws + WS_BAR) + XB_XCNT(xb_xcc_id()), 1u); }
        __syncthreads();
    }
#define GRID_SYNC() grid_bar((unsigned*)(kp0->ws + WS_BAR), xbst, (unsigned)G, wave_s)
    const int G = gridDim.x, bx = blockIdx.x, NGW = G * 8, NGT = G * 512;
#define PH_VARS KP p = kp0; asm volatile("" : "+s"(p)); unsigned char* ws = p->ws; (void)ws; \
    int tid = wave_s * 64 + lane_id(); asm volatile("" : "+v"(tid)); const int lane = tid & 63, wave = wave_s, gw = bx * 8 + wave, gtid = bx * 512 + tid; (void)lane; (void)gw; (void)gtid;

    const bool defer_ffn = (G == 256);
    { PH_VARS phase0(p, lds, gw, NGW, gtid, NGT, wave, lane, defer_ffn); }
    GRID_SYNC();
    if (G > (1 << 20)) cg::this_grid().sync();
    { PH_VARS for (int r = gw; r < NTOK; r += 4 * NGW) norm_rows<0, 4>(p, r, NGW, lane, p->in[9], 0, D, 0, (bf16_t*)(ws + WS_H), nullptr); }
    GRID_SYNC();
    {
        PH_VARS
        pg8::Gemm g{(const bf16_t*)(ws + WS_H), (const bf16_t*)(ws + WS_WTIN), D, D, D};
        pg8::SchedPlain S; S.o.init(NTOK / 256, NINP / 256, G, bx);
        pg8::EpiIn E{(bf16_t*)(ws + WS_Q), (bf16_t*)(ws + WS_ZR), p->out + OUT_K, 0.125f * LOG2E};
        pg8::gemm_phase(lds, g, S, E, tid);
        if (defer_ffn && bx >= 192) ffn_transposes(p, lds, 0, (bx - 192) * 8 + wave, 64 * 8, wave, lane);
    }
    GRID_SYNC();
    {
        PH_VARS
        LAS float* rpbL = (LAS float*)lds;
        for (int i = tid; i < 8 * 465; i += 512) rpbL[i] = p->in[23][i] * LOG2E;
        __syncthreads();
        LAS unsigned char* vbuf = lds + 16384 + wave * 4608;
        LAS float* xch = (LAS float*)(lds + 65536) + (wave & 3) * 2176;
        for (int u0 = bx * 4; u0 < 1024; u0 += G * 4) {
            if (wave < 4) { attn_unit<true, 2>(p, vbuf, rpbL, u0 + wave, lane, 0, 20, xch); attn_unit<false, 0>(p, vbuf, rpbL, u0 + wave, lane, 0, 8, xch); }
            else { attn_unit<true, 1>(p, vbuf, rpbL, u0 + wave - 4, lane, 20, 32, xch); prep_rows8(p, (u0 + wave - 4) * 8, lane); }
            __syncthreads();
        }
    }
    GRID_SYNC();
    {
        PH_VARS
        int kl = 128; asm volatile("" : "+s"(kl));
        pg8::Gemm g{(const bf16_t*)(ws + WS_ALORA), (const bf16_t*)(ws + WS_WTLORA), kl, 128, 128};
        pg8::SchedLora S; S.G = G; S.c = bx;
        pg8::EpiLora E{(float*)(ws + WS_DEC), (float*)(ws + WS_AA), (float*)(ws + WS_G), p->in[13], p->in[15]};
        pg8::gemm_phase(lds, g, S, E, tid);
        if (defer_ffn && bx >= 64) ffn_transposes(p, lds, 1, (bx - 64) * 8 + wave, 192 * 8, wave, lane);
    }
    GRID_SYNC();
    {
        int nst = 2; asm volatile("" : "+s"(nst));
        const int nl = G > 64 ? 32 : 0;
        for (int st = 0; st < nst; ++st) {
            PH_VARS
            const bool lead = bx < nl;
            if (st == 0 || !lead) cs_phaseA(p, lds, tid, st ? CS_LAT : 0, CS_LAT / 2, st ? bx - nl : bx, st ? G - nl : G);
            if (st == 0) { GRID_SYNC(); continue; }
            if (!lead) {
                unsigned* sb = (unsigned*)(kp0->ws + WS_BAR) + XB_SUBBAR;
                __syncthreads();
                if (tid == 0) { __atomic_thread_fence(__ATOMIC_RELEASE); __hip_atomic_fetch_add(sb, 1u, __ATOMIC_RELAXED, __HIP_MEMORY_SCOPE_AGENT);
                    while (__hip_atomic_load(sb, __ATOMIC_RELAXED, __HIP_MEMORY_SCOPE_AGENT) < (unsigned)(G - nl)) __builtin_amdgcn_s_sleep(1);
                    __atomic_thread_fence(__ATOMIC_ACQUIRE); }
                __syncthreads();
            }
            const int tfirst = lead ? bx : (nl ? 32 + (bx - nl) : bx), tend = lead ? 32 : 288, tstride = lead ? 32 : (G - nl);
            for (int t = tfirst; t < tend; t += tstride) cs_phaseB(p, lds, t < 32 ? 1 : 0, t < 32 ? t : t - 32, tid);
        }
    }
    GRID_SYNC();
    { PH_VARS for (int r = gw; r < NTOK; r += NGW) post_row(p, r, lane); }
    GRID_SYNC();
    {
        PH_VARS
        pg8::Gemm g{(const bf16_t*)(ws + WS_MIX), (const bf16_t*)(ws + WS_WTOUT), 512, D, D};
        pg8::SchedSplit2 S; S.o.init(NTOK / 256, 8, G, bx); S.nN = 4; S.ksplit = 512;
        pg8::EpiPart E{(bf16_t*)(ws + WS_PART), 512};
        pg8::gemm_phase(lds, g, S, E, tid);
    }
    GRID_SYNC();
    { PH_VARS for (int r = gw; r < NTOK; r += 2 * NGW) norm_rows<1, 2>(p, r, NGW, lane, p->in[10], 3 * D, 4 * D, 2 * D, (bf16_t*)(ws + WS_H), p->out); }
    GRID_SYNC();
    {
        PH_VARS
        pg8::Gemm g{(const bf16_t*)(ws + WS_H), (const bf16_t*)(ws + WS_WT13), D, D, D};
        pg8::SchedPlain S; S.o.init(NTOK / 256, 2 * DFF / 256, G, bx);
        pg8::EpiFfnAct E{(bf16_t*)(ws + WS_ACT), (float*)(ws + WS_EDGE), p->in[27], lds};
        pg8::gemm_phase(lds, g, S, E, tid);
    }
    GRID_SYNC();
    { PH_VARS for (int i = gtid; i < 16 * 704; i += NGT) act_fix(p, i); }
    GRID_SYNC();
    {
        PH_VARS
        pg8::Gemm g{(const bf16_t*)(ws + WS_ACT), (const bf16_t*)(ws + WS_WT2), DFF / 2, DFF, DFF};
        pg8::SchedSplit2 S; S.o.init(NTOK / 256, 8, G, bx); S.nN = 4; S.ksplit = DFF / 2;
        pg8::EpiPart E{(bf16_t*)(ws + WS_PART), DFF / 2};
        pg8::gemm_phase(lds, g, S, E, tid);
    }
    GRID_SYNC();
    { PH_VARS for (int r = gw; r < NTOK; r += 2 * NGW) final_rows<2>(p, r, NGW, lane); }
}

extern "C" void kernel_launch(void* const* d_in, const int* in_sizes, int n_in, void* d_out, int out_size, void* d_ws, size_t ws_size, hipStream_t stream) {
    static int grid_blocks = 0;
    if (!grid_blocks) {
        int dev = 0, cus = 0, per_cu = 0;
        (void)hipGetDevice(&dev);
        (void)hipDeviceGetAttribute(&cus, hipDeviceAttributeMultiprocessorCount, dev);
        (void)hipFuncSetAttribute((const void*)fwd_megakernel, hipFuncAttributeMaxDynamicSharedMemorySize, LDS_BYTES);
        (void)hipOccupancyMaxActiveBlocksPerMultiprocessor(&per_cu, (const void*)fwd_megakernel, 512, LDS_BYTES);
        if (per_cu < 1) per_cu = 1;
        grid_blocks = cus * per_cu;
    }
    (void)hipMemsetAsync((char*)d_ws + WS_BAR, 0, 16384, stream);
    Params p{};
    for (int i = 0; i < 30; ++i) p.in[i] = (const float*)d_in[i];
    p.out = (float*)d_out; p.ws = (unsigned char*)d_ws;
    void* args[] = {&p};
    hipError_t e = hipLaunchCooperativeKernel((const void*)fwd_megakernel, dim3(grid_blocks), dim3(512), args, LDS_BYTES, stream);
    if (e != hipSuccess) fprintf(stderr, "cooperative launch failed: %s (grid %d)\n", hipGetErrorString(e), grid_blocks);
}
```

```cpp
#include <hip/hip_runtime.h>
#include <hip/hip_cooperative_groups.h>
#include <cstdio>
#include <cstdint>
namespace cg = cooperative_groups;

#define LAS __attribute__((address_space(3)))
typedef unsigned short bf16_t;
typedef short bf16x8 __attribute__((ext_vector_type(8)));
typedef short s16x4 __attribute__((ext_vector_type(4)));
typedef float f32x2 __attribute__((ext_vector_type(2)));
typedef float f32x4 __attribute__((ext_vector_type(4)));
typedef float f32x16 __attribute__((ext_vector_type(16)));
typedef unsigned u32x2 __attribute__((ext_vector_type(2)));
typedef unsigned u32x4 __attribute__((ext_vector_type(4)));
typedef __bf16 bf16x2_t __attribute__((ext_vector_type(2)));
#define DI __device__ __forceinline__

constexpr int D = 1024, NTOK = 8192, NCTX = 4096, SEQ = 256, DSEQ = 2048;
constexpr int NIN = 3456, NINP = 3584, RC = 1920, DFF = 2816;
constexpr float EPS = 1e-6f, GN_EPS = 64e-5f;
constexpr float LOG2E = 1.4426950408889634f;
constexpr size_t MiB = 1u << 20;
constexpr size_t WS_BAR = 128 * 1024, WS_MOD = 0, WS_WTIN = 1 * MiB, WS_WTOUT = 8 * MiB, WS_WT13 = 10 * MiB, WS_WT2 = 21 * MiB, WS_WTLORA = 27 * MiB,
                 WS_H = 28 * MiB, WS_Q = 44 * MiB, WS_K = 52 * MiB, WS_V = 60 * MiB, WS_R = 68 * MiB, WS_VV = 84 * MiB, WS_KK = 100 * MiB,
                 WS_KR = 116 * MiB, WS_ALORA = 132 * MiB, WS_MIX = 138 * MiB, WS_ZR = 154 * MiB, WS_DEC = 154 * MiB, WS_AA = 186 * MiB,
                 WS_G = 218 * MiB, WS_CK = 234 * MiB, WS_CV = 235 * MiB, WS_Y = 28 * MiB, WS_PART = 176 * MiB, WS_A1 = 44 * MiB,
                 WS_A3 = 88 * MiB, WS_ACT = 132 * MiB, WS_EDGE = 250 * MiB;
constexpr size_t OUT_K = (size_t)NTOK * D, OUT_V = OUT_K + (size_t)NCTX * 512, OUT_S = OUT_V + (size_t)NCTX * 512;
constexpr int LDS_BYTES = 135168 + 16;
constexpr int LDS_XB = 135168;

struct Params { const float* in[30]; float* out; unsigned char* ws; };
typedef const __attribute__((address_space(4))) Params* KP;

DI unsigned pk2(float lo, float hi) { f32x2 v = {lo, hi}; bf16x2_t b = __builtin_convertvector(v, bf16x2_t); return __builtin_bit_cast(unsigned, b); }
DI f32x4 unpk4(u32x2 w) { return (f32x4){__builtin_bit_cast(float, w.x << 16), __builtin_bit_cast(float, w.x & 0xffff0000u), __builtin_bit_cast(float, w.y << 16), __builtin_bit_cast(float, w.y & 0xffff0000u)}; }
DI f32x2 ldh2(const bf16_t* p) { const unsigned w = *(const unsigned*)p; return (f32x2){__builtin_bit_cast(float, w << 16), __builtin_bit_cast(float, w & 0xffff0000u)}; }
DI float bf2f(unsigned short u) { return __builtin_bit_cast(float, (unsigned)u << 16); }
DI float wave_sum(float v) {
#pragma unroll
    for (int o = 1; o < 64; o <<= 1) v += __shfl_xor(v, o);
    return v;
}
DI float sigmoid_f(float x) { return __builtin_amdgcn_rcpf(1.f + __builtin_amdgcn_exp2f(-1.4426950408889634f * x)); }
DI float silu_f(float x) { return x * sigmoid_f(x); }
DI float tanh_f(float x) { return 2.f * sigmoid_f(2.f * x) - 1.f; }
DI int midx_of(int r) { return r < NCTX ? 0 : 1 + ((r - NCTX) >> 11); }
DI const float* xrow_of(KP p, int r) { return r < NCTX ? p->in[0] + (size_t)r * D : p->in[1] + (size_t)(r - NCTX) * D; }

namespace pg8 {
constexpr int BM = 256, BK = 64, HALF = 128, HTB = HALF * BK * 2, NXCD = 8, WGM = 8;
__host__ __device__ __forceinline__ int lds_byte(int r, int c) { const int st = (r >> 4) * 2 + (c >> 5), rr = r & 15, cc = c & 31, ob = rr * 64 + cc * 2; return st * 1024 + (ob ^ (((ob >> 9) & 1) << 5)); }
__host__ __device__ __forceinline__ void stage_rc(int b, int& R, int& C) { const int st = b / 1024, sb = b % 1024, swz = sb ^ (((sb >> 9) & 1) << 5); R = (st >> 1) * 16 + swz / 64; C = (st & 1) * 32 + (swz % 64) / 2; }
__host__ __device__ __forceinline__ int perm32(int rho) { const int n = rho >> 4, i = rho & 15; return 8 * (i >> 2) + 4 * n + (i & 3); }
struct Unit { int pm, pn; int aoff, boff; };
struct Gemm { const bf16_t* A; const bf16_t* Bt; int K, lda, ldb; };
struct StaticOrder {
    int nM, nN, nwg, G, c;
    __device__ void init(int nM_, int nN_, int G_, int c_) { nM = nM_; nN = nN_; nwg = nM * nN; G = G_; c = c_; }
    __device__ bool next2(int i, int& pm, int& pn) const {
        const long L = (long)i * G + c; if (L >= nwg) return false;
        int wgid = (int)L; { const int q = nwg / NXCD, r = nwg % NXCD, xcd = wgid % NXCD, off = wgid / NXCD; wgid = (xcd < r ? xcd * (q + 1) : r * (q + 1) + (xcd - r) * q) + off; }
        const int nig = WGM * nN, gid = wgid / nig, fm = gid * WGM, gsz = (nM - fm) < WGM ? (nM - fm) : WGM;
        pm = fm + ((wgid % nig) % gsz); pn = (wgid % nig) / gsz; return true;
    }
};
struct SchedPlain { StaticOrder o; __device__ bool next(int i, Unit& u) const { u.aoff = 0; u.boff = 0; return o.next2(i, u.pm, u.pn); } };
struct SchedSplit2 { StaticOrder o; int nN, ksplit;
    __device__ bool next(int i, Unit& u) const { int pn2; if (!o.next2(i, u.pm, pn2)) return false; const int ks = pn2 / nN; u.pn = pn2 - ks * nN; u.aoff = ks * ksplit; u.boff = ks * ksplit; return true; } };
struct SchedLora { int G, c;
    __device__ bool next(int i, Unit& u) const { const int L = i * G + c; if (L >= 320) return false; u.pm = L & 31; u.pn = L >> 5; const int g = u.pn < 4 ? 0 : (u.pn < 8 ? 1 : 2); u.aoff = g * NTOK * 128; u.boff = 0; return true; } };

template <class Epi, class Sched>
__device__ __forceinline__ void gemm_phase(LAS unsigned char* lds, const Gemm g, const Sched& S, const Epi& E, int tid) {
    asm volatile("" : "+v"(tid));
    const int wid = __builtin_amdgcn_readfirstlane(tid >> 6), lane = tid & 63, wr = wid >> 2, wc = wid & 3, fr = lane & 15, fq = lane >> 4;
    const int nt = g.K / BK;
    unsigned voffA[2], voffB[2];
#pragma unroll
    for (int i = 0; i < 2; ++i) { int R, C; stage_rc(tid * 16 + i * 8192, R, C); const int Rb = (R & ~31) + perm32(R & 31);
        voffA[i] = (unsigned)(R * g.lda + C) * 2u; voffB[i] = (unsigned)(Rb * g.ldb + C) * 2u; }
    const size_t kstep = (size_t)(BK * 2);
    const size_t hA = (size_t)HALF * g.lda * 2, hB = (size_t)HALF * g.ldb * 2;
    const unsigned ldsw = (unsigned)wid * 1024u;
    const int aoff = lds_byte(wr * 64 + fr, fq * 8), boff = lds_byte(wc * 32 + fr, fq * 8);
#define PG8_SA(b, h) (((b) * 2 + (h)) * HTB)
#define PG8_SB(b, h) ((4 + (b) * 2 + (h)) * HTB)
#define PG8_STAGE(bufoff, gbase, voff) do { _Pragma("unroll") for (int _i = 0; _i < 2; ++_i) \
        __builtin_amdgcn_global_load_lds((const unsigned*)((const char*)(gbase) + (voff)[_i]), (LAS unsigned*)(lds + (bufoff) + ldsw + _i * 8192), 16, 0, 0); } while (0)
#define PG8_LDA(dst, b, h) do { _Pragma("unroll") for (int m = 0; m < 4; ++m) _Pragma("unroll") for (int k = 0; k < 2; ++k) dst[m][k] = *(const LAS bf16x8*)(lds + PG8_SA(b, h) + aoff + m * 2048 + k * 1024); } while (0)
#define PG8_LDB(dst, b, h) do { _Pragma("unroll") for (int n = 0; n < 2; ++n) _Pragma("unroll") for (int k = 0; k < 2; ++k) dst[n][k] = *(const LAS bf16x8*)(lds + PG8_SB(b, h) + boff + n * 2048 + k * 1024); } while (0)
#define PG8_MMA(ai, bj, At, Bt) do { __builtin_amdgcn_s_setprio(1); _Pragma("unroll") for (int m = 0; m < 4; ++m) _Pragma("unroll") for (int n = 0; n < 2; ++n) _Pragma("unroll") for (int k = 0; k < 2; ++k) \
        acc[ai][bj][m][n] = __builtin_amdgcn_mfma_f32_16x16x32_bf16(Bt[n][k], At[m][k], acc[ai][bj][m][n], 0, 0, 0); __builtin_amdgcn_s_setprio(0); } while (0)
#define PG8_WAIT_V(n) asm volatile("s_waitcnt vmcnt(" #n ")" ::: "memory")
#define PG8_WAIT_L(n) asm volatile("s_waitcnt lgkmcnt(" #n ")" ::: "memory")
#define PG8_BAR __builtin_amdgcn_s_barrier()
#define PG8_SCHED __builtin_amdgcn_sched_barrier(0)
#define PG8_TA(u) ((const char*)g.A + ((size_t)(u).pm * BM * g.lda + (size_t)(u).aoff) * 2)
#define PG8_TB(u) ((const char*)g.Bt + ((size_t)(u).pn * BM * g.ldb + (size_t)(u).boff) * 2)
    Unit cur, nxt; int ui = 0;
    if (!S.next(0, cur)) return;
    f32x4 acc[2][2][4][2];
#pragma unroll
    for (int a = 0; a < 2; ++a)
#pragma unroll
        for (int b = 0; b < 2; ++b)
#pragma unroll
            for (int m = 0; m < 4; ++m)
#pragma unroll
                for (int n = 0; n < 2; ++n) acc[a][b][m][n] = (f32x4){0.f, 0.f, 0.f, 0.f};
    bf16x8 At[4][2], B0[2][2], B1[2][2];
    const char* cA = PG8_TA(cur); const char* cB = PG8_TB(cur);
    PG8_STAGE(PG8_SB(0, 0), cB, voffB); PG8_STAGE(PG8_SB(0, 1), cB + hB, voffB); PG8_STAGE(PG8_SA(0, 0), cA, voffA); PG8_STAGE(PG8_SA(0, 1), cA + hA, voffA);
    if (wr == 1) PG8_BAR;
    PG8_WAIT_V(2); PG8_BAR;
    PG8_STAGE(PG8_SB(1, 0), cB + kstep, voffB); PG8_STAGE(PG8_SA(1, 0), cA + kstep, voffA); PG8_STAGE(PG8_SB(1, 1), cB + hB + kstep, voffB);
    PG8_WAIT_V(6); PG8_BAR;
    for (;;) {
        const bool has_next = S.next(ui + 1, nxt);
        const char* nA = has_next ? PG8_TA(nxt) : cA; const char* nB = has_next ? PG8_TB(nxt) : cB;
        for (int t = 0; t < nt; t += 2) {
            const bool last = (t == nt - 2);
            const char* a1 = cA + (size_t)(t + 1) * kstep;
            const char* a2 = last ? nA : cA + (size_t)(t + 2) * kstep; const char* b2 = last ? nB : cB + (size_t)(t + 2) * kstep;
            const char* a3 = a2 + kstep; const char* b3 = b2 + kstep;
            PG8_LDB(B0, 0, 0); PG8_LDB(B1, 0, 1); PG8_SCHED; PG8_LDA(At, 0, 0); PG8_STAGE(PG8_SA(1, 1), a1 + hA, voffA);
            PG8_WAIT_V(8); PG8_WAIT_L(0); PG8_BAR; PG8_MMA(0, 0, At, B0); PG8_MMA(0, 1, At, B1); PG8_BAR; PG8_SCHED;
            PG8_LDA(At, 0, 1); PG8_STAGE(PG8_SB(0, 0), b2, voffB); PG8_STAGE(PG8_SB(0, 1), b2 + hB, voffB); PG8_STAGE(PG8_SA(0, 0), a2, voffA);
            PG8_WAIT_V(8); PG8_WAIT_L(0); PG8_BAR; PG8_MMA(1, 0, At, B0); PG8_MMA(1, 1, At, B1); PG8_BAR; PG8_SCHED;
            PG8_LDB(B0, 1, 0); PG8_LDB(B1, 1, 1); PG8_SCHED; PG8_LDA(At, 1, 0); PG8_STAGE(PG8_SA(0, 1), a2 + hA, voffA);
            PG8_WAIT_V(8); PG8_WAIT_L(0); PG8_BAR; PG8_MMA(0, 0, At, B0); PG8_MMA(0, 1, At, B1); PG8_BAR; PG8_SCHED;
            PG8_LDA(At, 1, 1); PG8_STAGE(PG8_SB(1, 0), b3, voffB); PG8_STAGE(PG8_SB(1, 1), b3 + hB, voffB); PG8_STAGE(PG8_SA(1, 0), a3, voffA);
            PG8_WAIT_V(8); PG8_WAIT_L(0); PG8_BAR; PG8_MMA(1, 0, At, B0); PG8_MMA(1, 1, At, B1); PG8_BAR; PG8_SCHED;
        }
        E(acc, cur, wr, wc, fr, fq);
        if (!has_next) break;
#pragma unroll
        for (int a = 0; a < 2; ++a)
#pragma unroll
            for (int b = 0; b < 2; ++b)
#pragma unroll
                for (int m = 0; m < 4; ++m)
#pragma unroll
                    for (int n = 0; n < 2; ++n) acc[a][b][m][n] = (f32x4){0.f, 0.f, 0.f, 0.f};
        cur = nxt; cA = nA; cB = nB; ++ui;
    }
    PG8_WAIT_V(0);
    if (wr == 0) PG8_BAR;
    PG8_BAR;
#undef PG8_SA
#undef PG8_SB
#undef PG8_STAGE
#undef PG8_LDA
#undef PG8_LDB
#undef PG8_MMA
#undef PG8_WAIT_V
#undef PG8_WAIT_L
#undef PG8_BAR
#undef PG8_SCHED
#undef PG8_TA
#undef PG8_TB
}

struct EpiIn {
    bf16_t *Q; bf16_t* ZR; float* outK; float qscale;
    __device__ __forceinline__ void operator()(const f32x4 (&acc)[2][2][4][2], const Unit& u, int wr, int wc, int fr, int fq) const {
#pragma unroll
        for (int bj = 0; bj < 2; ++bj) {
            const int c0 = u.pn * BM + bj * HALF + wc * 32 + 8 * fq;
            if (c0 >= NIN) continue;
#pragma unroll
            for (int ai = 0; ai < 2; ++ai)
#pragma unroll
                for (int m = 0; m < 4; ++m) {
                    int r = u.pm * BM + ai * HALF + wr * 64 + m * 16 + fr; asm volatile("" : "+v"(r));
                    f32x4 v0 = acc[ai][bj][m][0], v1 = acc[ai][bj][m][1];
                    if (c0 < 1536) {
                        const int seg = c0 >> 9, cc = c0 & 511;
                        if (seg == 0) { v0 = v0 * qscale; v1 = v1 * qscale; }
                        else if (r < NCTX) { float* o = outK + (size_t)(seg - 1) * ((size_t)NCTX * 512) + (size_t)r * 512 + cc; *(f32x4*)o = v0; *(f32x4*)(o + 4) = v1; }
                        bf16_t* dst = Q + (size_t)seg * ((size_t)NTOK * 512) + (size_t)r * 512 + cc;
                        u32x4 w; w.x = pk2(v0[0], v0[1]); w.y = pk2(v0[2], v0[3]); w.z = pk2(v1[0], v1[1]); w.w = pk2(v1[2], v1[3]);
                        *(u32x4*)dst = w;
                    } else {
                        u32x4 w; w.x = pk2(v0[0], v0[1]); w.y = pk2(v0[2], v0[3]); w.z = pk2(v1[0], v1[1]); w.w = pk2(v1[2], v1[3]);
                        *(u32x4*)(ZR + (size_t)r * RC + (c0 - 1536)) = w;
                    }
                }
        }
    }
};
DI float decay1(float x) { return __expf(-0.60653065971f * sigmoid_f(x)); }
struct EpiLora {
    float *DEC, *AA, *G; const float *w0, *a0;
    __device__ __forceinline__ void operator()(const f32x4 (&acc)[2][2][4][2], const Unit& u, int wr, int wc, int fr, int fq) const {
#pragma unroll
        for (int bj = 0; bj < 2; ++bj) {
            const int c0 = u.pn * BM + bj * HALF + wc * 32 + 8 * fq;
            const int grp = c0 >> 10, cg = c0 & 1023, dir = cg >> 9, cc = cg & 511;
            const float* bp = (grp == 0 ? w0 : a0) + dir * 512 + cc;
            float* ob = DEC + (size_t)dir * NTOK * 512 + cc;
            bf16_t* obh = grp == 2 ? (bf16_t*)G + cc : (bf16_t*)AA + (size_t)dir * NTOK * 512 + cc;
#pragma unroll
            for (int ai = 0; ai < 2; ++ai)
#pragma unroll
                for (int m = 0; m < 4; ++m) {
                    int r = u.pm * BM + ai * HALF + wr * 64 + m * 16 + fr; asm volatile("" : "+v"(r));
                    f32x4 v0 = acc[ai][bj][m][0], v1 = acc[ai][bj][m][1];
                    if (grp < 2) { const float* bq = bp; asm volatile("" : "+v"(bq)); v0 += *(const f32x4*)bq; v1 += *(const f32x4*)(bq + 4); }
                    if (grp == 0) { v0.x = decay1(v0.x); v0.y = decay1(v0.y); v0.z = decay1(v0.z); v0.w = decay1(v0.w); v1.x = decay1(v1.x); v1.y = decay1(v1.y); v1.z = decay1(v1.z); v1.w = decay1(v1.w); }
                    else if (grp == 1) { v0.x = sigmoid_f(v0.x); v0.y = sigmoid_f(v0.y); v0.z = sigmoid_f(v0.z); v0.w = sigmoid_f(v0.w); v1.x = sigmoid_f(v1.x); v1.y = sigmoid_f(v1.y); v1.z = sigmoid_f(v1.z); v1.w = sigmoid_f(v1.w); }
                    if (grp == 0) { float* o = ob + (size_t)r * 512; *(f32x4*)o = v0; *(f32x4*)(o + 4) = v1; }
                    else { u32x4 w; w.x = pk2(v0[0], v0[1]); w.y = pk2(v0[2], v0[3]); w.z = pk2(v1[0], v1[1]); w.w = pk2(v1[2], v1[3]); *(u32x4*)(obh + (size_t)r * 512) = w; }
                }
        }
    }
};
struct EpiPart {
    bf16_t* P; int ksplit;
    __device__ __forceinline__ void operator()(const f32x4 (&acc)[2][2][4][2], const Unit& u, int wr, int wc, int fr, int fq) const {
        bf16_t* base = P + (u.aoff ? (size_t)NTOK * D : 0);
#pragma unroll
        for (int bj = 0; bj < 2; ++bj) {
            const int c0 = u.pn * BM + bj * HALF + wc * 32 + 8 * fq;
#pragma unroll
            for (int ai = 0; ai < 2; ++ai)
#pragma unroll
                for (int m = 0; m < 4; ++m) {
                    int r = u.pm * BM + ai * HALF + wr * 64 + m * 16 + fr; asm volatile("" : "+v"(r));
                    const f32x4 v0 = acc[ai][bj][m][0], v1 = acc[ai][bj][m][1];
                    u32x4 w; w.x = pk2(v0[0], v0[1]); w.y = pk2(v0[2], v0[3]); w.z = pk2(v1[0], v1[1]); w.w = pk2(v1[2], v1[3]);
                    *(u32x4*)(base + (size_t)r * D + c0) = w;
                }
        }
    }
};
template <int CTRL> DI float dppf(float x) { return __builtin_bit_cast(float, __builtin_amdgcn_mov_dpp(__builtin_bit_cast(int, x), CTRL, 0xf, 0xf, true)); }
struct EpiFfnAct {
    bf16_t* ACT; float* EDGE; const float* wcv; LAS unsigned char* ldsb;
    __device__ __forceinline__ void operator()(const f32x4 (&acc)[2][2][4][2], const Unit& u, int wr, int wc, int fr, int fq) const {
        LAS float* HL = (LAS float*)(ldsb + 131072);
        const int colh = wc * 32 + 8 * fq;
#pragma unroll
        for (int ai = 0; ai < 2; ++ai) { const int g = ai * 2 + wr;
            if (fr == 0) { *(LAS f32x4*)(HL + (g * 2 + 0) * 128 + colh) = acc[ai][0][0][0]; *(LAS f32x4*)(HL + (g * 2 + 0) * 128 + colh + 4) = acc[ai][0][0][1]; }
            if (fr == 15) { *(LAS f32x4*)(HL + (g * 2 + 1) * 128 + colh) = acc[ai][0][3][0]; *(LAS f32x4*)(HL + (g * 2 + 1) * 128 + colh + 4) = acc[ai][0][3][1]; } }
        asm volatile("s_waitcnt lgkmcnt(0)" ::: "memory");
        __builtin_amdgcn_s_barrier(); __builtin_amdgcn_s_barrier();
        asm volatile("" ::: "memory");
        const int cf = u.pn * HALF + colh;
        const f32x4 zero = {0.f, 0.f, 0.f, 0.f};
        const bool lat = u.pm >= 16;
#pragma unroll
        for (int ai = 0; ai < 2; ++ai) {
            const int g = ai * 2 + wr;
            f32x4 hp[2], hn[2];
            hp[0] = g > 0 ? *(const LAS f32x4*)(HL + ((g - 1) * 2 + 1) * 128 + colh) : zero; hp[1] = g > 0 ? *(const LAS f32x4*)(HL + ((g - 1) * 2 + 1) * 128 + colh + 4) : zero;
            hn[0] = g < 3 ? *(const LAS f32x4*)(HL + ((g + 1) * 2 + 0) * 128 + colh) : zero; hn[1] = g < 3 ? *(const LAS f32x4*)(HL + ((g + 1) * 2 + 0) * 128 + colh + 4) : zero;
#pragma unroll
            for (int m = 0; m < 4; ++m) {
                int r = u.pm * BM + ai * HALF + wr * 64 + m * 16 + fr; asm volatile("" : "+v"(r));
                const float* wq_ = wcv + cf; asm volatile("" : "+v"(wq_));
                f32x4 uu[2], av[2];
#pragma unroll
                for (int n = 0; n < 2; ++n) {
                    const f32x4 cur = acc[ai][0][m][n];
                    f32x4 pv, nx;
#pragma unroll
                    for (int j = 0; j < 4; ++j) {
                        if (m > 0) pv[j] = dppf<0x121>(fr == 15 ? acc[ai][0][m > 0 ? m - 1 : 0][n][j] : cur[j]);
                        else { const float a = dppf<0x121>(cur[j]); pv[j] = fr == 0 ? hp[n][j] : a; }
                        if (m < 3) nx[j] = dppf<0x12F>(fr == 0 ? acc[ai][0][m < 3 ? m + 1 : 3][n][j] : cur[j]);
                        else { const float c = dppf<0x12F>(cur[j]); nx[j] = fr == 15 ? hn[n][j] : c; }
                    }
                    const f32x4 w0 = *(const f32x4*)(wq_ + 4 * n), w1 = *(const f32x4*)(wq_ + DFF + 4 * n), w2 = *(const f32x4*)(wq_ + 2 * DFF + 4 * n);
                    uu[n] = pv * w0 + cur * w1 + nx * w2;
                    const f32x4 a3 = acc[ai][1][m][n];
                    av[n] = (f32x4){silu_f(uu[n].x) * a3.x, silu_f(uu[n].y) * a3.y, silu_f(uu[n].z) * a3.z, silu_f(uu[n].w) * a3.w};
                }
                u32x4 w; w.x = pk2(av[0][0], av[0][1]); w.y = pk2(av[0][2], av[0][3]); w.z = pk2(av[1][0], av[1][1]); w.w = pk2(av[1][2], av[1][3]);
                *(u32x4*)(ACT + (size_t)r * DFF + cf) = w;
                if (lat && ((ai == 0 && m == 0) || (ai == 1 && m == 3))) {
                    const int e = ai;
                    const bool mine = e == 0 ? (wr == 0 && fr == 0) : (wr == 1 && fr == 15);
                    if (mine) {
                        float* eb = EDGE + ((size_t)u.pm * 2 + e) * DFF + cf;
                        *(f32x4*)(eb) = acc[ai][0][m][0]; *(f32x4*)(eb + 4) = acc[ai][0][m][1];
                        *(f32x4*)(eb + 64 * DFF) = uu[0]; *(f32x4*)(eb + 64 * DFF + 4) = uu[1];
                        *(f32x4*)(eb + 128 * DFF) = acc[ai][1][m][0]; *(f32x4*)(eb + 128 * DFF + 4) = acc[ai][1][m][1];
                    }
                }
            }
        }
    }
};
}

template <int MODE>
DI void transpose_item(const float* W, int K, int N, bf16_t* WT, LAS float* scr, int item, int lane) {
    const int nblk = N / 32, kb = item / nblk, nb = item % nblk, k0 = 64 * kb, n0 = 32 * nb;
#pragma unroll 8
    for (int i = 0; i < 32; ++i) { const int kk = 2 * i + (lane >> 5); scr[kk * 33 + (lane & 31)] = W[(size_t)(k0 + kk) * N + n0 + (lane & 31)]; }
    asm volatile("s_waitcnt lgkmcnt(0)" ::: "memory");
    const int c = lane & 7;
#pragma unroll
    for (int j = 0; j < 4; ++j) { const int n = (lane >> 3) + 8 * j; const LAS float* s = scr + (8 * c) * 33 + n;
        u32x4 o; o.x = pk2(s[0 * 33], s[1 * 33]); o.y = pk2(s[2 * 33], s[3 * 33]); o.z = pk2(s[4 * 33], s[5 * 33]); o.w = pk2(s[6 * 33], s[7 * 33]);
        const int nn = n0 + n; const int drow = MODE == 0 ? nn : ((nn >> 7) * 256 + (nn & 127) + (MODE == 2 ? 128 : 0));
        *(u32x4*)(WT + (size_t)drow * K + k0 + 8 * c) = o; }
    asm volatile("s_waitcnt lgkmcnt(0)" ::: "memory");
}

DI void phase0(KP p, LAS unsigned char* lds, int gw, int NGW, int gtid, int NGT, int wave, int lane, bool defer_ffn) {
    unsigned char* ws = p->ws;
    {
        float* MOD = (float*)(ws + WS_MOD);
        const float* w_ada = p->in[7]; const float* b_ada = p->in[8]; const float* c_lat = p->in[5]; const float* c_ctx = p->in[6];
        LAS float* red = (LAS float*)(lds + 8 * 8448);
        const int tid = wave * 64 + lane, cgp = lane & 15, kr = lane >> 4;
        for (int nb = blockIdx.x; nb < 96; nb += gridDim.x) {
            f32x4 a0 = {0, 0, 0, 0}, a1 = a0, a2 = a0;
#pragma unroll 8
            for (int i = 0; i < 32; ++i) {
                const int k = wave * 128 + 4 * i + kr;
                const f32x4 w = *(const f32x4*)(w_ada + (size_t)k * 6144 + nb * 64 + 4 * cgp);
                a0 += w * silu_f(c_ctx[k]); a1 += w * silu_f(c_lat[k]); a2 += w * silu_f(c_lat[D + k]);
            }
#pragma unroll
            for (int j = 0; j < 4; ++j) {
                a0[j] += __shfl_xor(a0[j], 16); a0[j] += __shfl_xor(a0[j], 32);
                a1[j] += __shfl_xor(a1[j], 16); a1[j] += __shfl_xor(a1[j], 32);
                a2[j] += __shfl_xor(a2[j], 16); a2[j] += __shfl_xor(a2[j], 32);
            }
            if (kr == 0) { *(LAS f32x4*)(red + (wave * 3 + 0) * 64 + 4 * cgp) = a0; *(LAS f32x4*)(red + (wave * 3 + 1) * 64 + 4 * cgp) = a1; *(LAS f32x4*)(red + (wave * 3 + 2) * 64 + 4 * cgp) = a2; }
            __syncthreads();
            if (tid < 192) {
                const int i = tid >> 6, c = tid & 63; float s = b_ada[nb * 64 + c];
#pragma unroll
                for (int w = 0; w < 8; ++w) s += red[(w * 3 + i) * 64 + c];
                MOD[i * 6144 + nb * 64 + c] = s;
            }
            __syncthreads();
        }
    }
    {
        LAS float* scr = (LAS float*)(lds + wave * 8448);
        constexpr int I_IN = 16 * 108, I_OUT = 16 * 32, I_F = 16 * 88, I_2 = 44 * 32, NIT = I_IN + I_OUT + 2 * I_F + I_2;
        const int nit = defer_ffn ? I_IN + I_OUT : NIT;
        for (int it = gw; it < nit; it += NGW) {
            int r = it;
            if (r < I_IN) { transpose_item<0>(p->in[11], D, NIN, (bf16_t*)(ws + WS_WTIN), scr, r, lane); continue; } r -= I_IN;
            if (r < I_OUT) { transpose_item<0>(p->in[24], D, D, (bf16_t*)(ws + WS_WTOUT), scr, r, lane); continue; } r -= I_OUT;
            if (r < I_F) { transpose_item<1>(p->in[25], D, DFF, (bf16_t*)(ws + WS_WT13), scr, r, lane); continue; } r -= I_F;
            if (r < I_F) { transpose_item<2>(p->in[26], D, DFF, (bf16_t*)(ws + WS_WT13), scr, r, lane); continue; } r -= I_F;
            transpose_item<0>(p->in[28], DFF, D, (bf16_t*)(ws + WS_WT2), scr, r, lane);
        }
    }
    { u32x4* z = (u32x4*)((bf16_t*)(ws + WS_WTIN) + (size_t)NIN * D); for (int i = gtid; i < 128 * D / 8; i += NGT) z[i] = (u32x4){0, 0, 0, 0}; }
    {
        bf16_t* WL = (bf16_t*)(ws + WS_WTLORA); const float* w2 = p->in[14]; const float* a2 = p->in[16]; const float* g2 = p->in[17];
        for (int i = gtid; i < 2560 * 128; i += NGT) {
            const int n = i >> 7, k = i & 127; float v = 0.f;
            if (n < 2048) { const int grp = n >> 10, dir = (n >> 9) & 1, c = n & 511; const float* src = grp == 0 ? w2 : a2;
                if ((k >> 6) == dir) v = src[((size_t)dir * 64 + (k & 63)) * 512 + c]; }
            else v = g2[(size_t)k * 512 + (n - 2048)];
            WL[i] = (bf16_t)(pk2(v, 0.f) & 0xffffu);
        }
    }
    {
        const f32x4* ck = (const f32x4*)p->in[2]; const f32x4* cv = (const f32x4*)p->in[3]; u32x2* CK = (u32x2*)(ws + WS_CK); u32x2* CV = (u32x2*)(ws + WS_CV);
        for (int i = gtid; i < 1024 * 512 / 4; i += NGT) { const f32x4 a = ck[i], b = cv[i]; CK[i] = (u32x2){pk2(a[0], a[1]), pk2(a[2], a[3])}; CV[i] = (u32x2){pk2(b[0], b[1]), pk2(b[2], b[3])}; }
    }
}

DI void ffn_transposes(KP p, LAS unsigned char* lds, int which, int widx, int nw, int wave, int lane) {
    LAS float* scr = (LAS float*)(lds + wave * 8448);
    constexpr int I_F = 16 * 88, I_2 = 44 * 32;
    if (which == 0) { for (int it = widx; it < I_2; it += nw) transpose_item<0>(p->in[28], DFF, D, (bf16_t*)(p->ws + WS_WT2), scr, it, lane); }
    else { for (int it = widx; it < 2 * I_F; it += nw) { if (it < I_F) transpose_item<1>(p->in[25], D, DFF, (bf16_t*)(p->ws + WS_WT13), scr, it, lane);
                                                           else transpose_item<2>(p->in[26], D, DFF, (bf16_t*)(p->ws + WS_WT13), scr, it - I_F, lane); } }
}

template <int SRC, int NR>
DI void norm_rows(KP p, int rbase, int rstride, int lane, const float* normw, int sh_off, int sc_off, int gate_off, bf16_t* Hout, float* xout) {
    const float* MODb = (const float*)(p->ws + WS_MOD);
    const bf16_t* PART = (const bf16_t*)(p->ws + WS_PART);
    f32x4 v[NR][4];
#pragma unroll
    for (int q = 0; q < NR; ++q) { const f32x4* xr = (const f32x4*)xrow_of(p, rbase + q * rstride) + lane;
#pragma unroll
        for (int j = 0; j < 4; ++j) v[q][j] = xr[64 * j]; }
    if (SRC == 1) {
        u32x2 p0[NR][4], p1[NR][4];
#pragma unroll
        for (int q = 0; q < NR; ++q) { const int r = rbase + q * rstride;
#pragma unroll
            for (int j = 0; j < 4; ++j) { p0[q][j] = *((const u32x2*)(PART + (size_t)r * D) + lane + 64 * j); p1[q][j] = *((const u32x2*)(PART + (size_t)(NTOK + r) * D) + lane + 64 * j); } }
#pragma unroll
        for (int q = 0; q < NR; ++q) { const int r = rbase + q * rstride; const float* MOD = MODb + midx_of(r) * 6144;
#pragma unroll
            for (int j = 0; j < 4; ++j) { const f32x4 gt = *((const f32x4*)(MOD + gate_off) + lane + 64 * j); v[q][j] = v[q][j] + gt * (unpk4(p0[q][j]) + unpk4(p1[q][j])); } }
    }
    float s[NR];
#pragma unroll
    for (int q = 0; q < NR; ++q) { s[q] = 0.f;
#pragma unroll
        for (int j = 0; j < 4; ++j) s[q] += (v[q][j].x * v[q][j].x + v[q][j].y * v[q][j].y) + (v[q][j].z * v[q][j].z + v[q][j].w * v[q][j].w); }
#pragma unroll
    for (int o = 1; o < 64; o <<= 1) {
#pragma unroll
        for (int q = 0; q < NR; ++q) s[q] += __shfl_xor(s[q], o); }
#pragma unroll
    for (int q = 0; q < NR; ++q) {
        const int r = rbase + q * rstride; const float* MOD = MODb + midx_of(r) * 6144;
        const float rstd = rsqrtf(s[q] * (1.f / D) + EPS);
        u32x2* o = (u32x2*)(Hout + (size_t)r * D) + lane;
#pragma unroll
        for (int j = 0; j < 4; ++j) {
            if (SRC == 1) *((f32x4*)(xout + (size_t)r * D) + lane + 64 * j) = v[q][j];
            const f32x4 g = *((const f32x4*)normw + lane + 64 * j), sc = *((const f32x4*)(MOD + sc_off) + lane + 64 * j), sh = *((const f32x4*)(MOD + sh_off) + lane + 64 * j);
            const f32x4 h = v[q][j] * rstd * g * (sc + 1.f) + sh;
            o[64 * j] = (u32x2){pk2(h.x, h.y), pk2(h.z, h.w)};
        }
    }
}

#define MFMA32(a, b, c) __builtin_amdgcn_mfma_f32_32x32x16_bf16((a), (b), (c), 0, 0, 0)
DI int crow(int reg, int h) { return (reg & 3) + 8 * (reg >> 2) + 4 * h; }
typedef short v4i16_t __attribute__((ext_vector_type(4)));
DI s16x4 vtr(const LAS unsigned char* p) { return __builtin_bit_cast(s16x4, __builtin_amdgcn_ds_read_tr16_b64_v4i16((LAS v4i16_t*)p)); }

template <bool LATENT, int MODE>
DI void attn_unit(KP p, LAS unsigned char* vbuf, const LAS float* rpbL, int unit, int lane, int t0, int t1, LAS float* xch) {
    const bf16_t* Q = (const bf16_t*)(p->ws + WS_Q); const bf16_t* Kb = (const bf16_t*)(p->ws + WS_K); const bf16_t* Vb = (const bf16_t*)(p->ws + WS_V);
    const bf16_t* CK = (const bf16_t*)(p->ws + WS_CK); const bf16_t* CV = (const bf16_t*)(p->ws + WS_CV);
    bf16_t* MIX = (bf16_t*)(p->ws + WS_MIX);
    const int r = lane & 31, hh = lane >> 5;
    int head, qrow0, b, gi = 0, w0 = 0, si = 0, ntile;
    if (LATENT) { head = unit & 7; const int t = unit >> 3; w0 = (t & 1) * 32; gi = (t >> 1) & 31; b = t >> 6; qrow0 = NCTX + b * DSEQ + gi * 64 + w0; si = min(max(gi - 4, 0), 24); ntile = 32; }
    else { head = unit & 7; const int t = unit >> 3; const int qb = t & 7; b = t >> 3; qrow0 = b * SEQ + qb * 32; ntile = 8; }
    bf16x8 qf[4];
#pragma unroll
    for (int s = 0; s < 4; ++s) qf[s] = *(const bf16x8*)(Q + (size_t)(qrow0 + r) * 512 + head * 64 + 16 * s + 8 * hh);
    auto tile_ptrs = [&](int t, const bf16_t*& kp, const bf16_t*& vp) {
        if (LATENT) {
            if (t < 16) { const size_t row = (size_t)b * 512 + t * 32; kp = CK + row * 512; vp = CV + row * 512; }
            else { const int lt = t - 16; const size_t row = (size_t)NCTX + b * DSEQ + (si + (lt >> 1)) * 64 + (((lt & 1) * 32) ^ w0); kp = Kb + row * 512; vp = Vb + row * 512; }
        } else { const size_t row = (size_t)b * SEQ + t * 32; kp = Kb + row * 512; vp = Vb + row * 512; }
    };
    bf16x8 kf[4], kn[4]; u32x4 vn[4];
    {
        const bf16_t *kp, *vp; tile_ptrs(t0, kp, vp);
#pragma unroll
        for (int s = 0; s < 4; ++s) kf[s] = *(const bf16x8*)(kp + (size_t)r * 512 + head * 64 + 16 * s + 8 * hh);
#pragma unroll
        for (int i = 0; i < 4; ++i) { const int c = lane + 64 * i; vn[i] = *(const u32x4*)(vp + (size_t)(c >> 3) * 512 + head * 64 + (c & 7) * 8); }
#pragma unroll
        for (int i = 0; i < 4; ++i) { const int c = lane + 64 * i; *(LAS u32x4*)(vbuf + (c >> 3) * 144 + (c & 7) * 16) = vn[i]; }
    }
    f32x16 o0, o1;
#pragma unroll
    for (int i = 0; i < 16; ++i) { o0[i] = 0.f; o1[i] = 0.f; }
    float mrun = -1e30f, lrun = 0.f;
    const int i16 = lane & 15, tq = i16 >> 2, tp = i16 & 3, blk = (lane >> 4) & 1;
    const LAS unsigned char* vtbase = vbuf + (4 * hh + tq) * 144 + (16 * blk) * 2 + 8 * tp;
    const int wq = w0 + r;
    const int cs = min(max(wq - 8, 0), 48);
    for (int t = t0; t < t1; ++t) {
        const bool more = (t + 1 < t1);
        if (more) {
            const bf16_t *kp, *vp; tile_ptrs(t + 1, kp, vp);
#pragma unroll
            for (int s = 0; s < 4; ++s) kn[s] = *(const bf16x8*)(kp + (size_t)r * 512 + head * 64 + 16 * s + 8 * hh);
#pragma unroll
            for (int i = 0; i < 4; ++i) { const int c = lane + 64 * i; vn[i] = *(const u32x4*)(vp + (size_t)(c >> 3) * 512 + head * 64 + (c & 7) * 8); }
        }
        f32x16 st;
#pragma unroll
        for (int i = 0; i < 16; ++i) st[i] = 0.f;
#pragma unroll
        for (int s = 0; s < 4; ++s) st = MFMA32(kf[s], qf[s], st);
        if (LATENT && t >= 16) {
            const int lt = t - 16, a = lt >> 1, c0 = ((lt & 1) * 32) ^ w0;
            const int row_off = si + a - gi + 7;
            const int d0 = c0 + 4 * hh - cs;
            const LAS float* bp = rpbL + head * 465 + row_off * 31 + (c0 + 4 * hh - wq + 15);
#pragma unroll
            for (int i = 0; i < 16; ++i) {
                const int ci = (i & 3) + 8 * (i >> 2);
                const bool valid = (unsigned)(d0 + ci) < 16u;
                const float bias = valid ? bp[ci] : 0.f;
                st[i] = valid ? st[i] + bias : -INFINITY;
            }
        }
        float tmax = st[0];
#pragma unroll
        for (int i = 1; i < 16; ++i) tmax = fmaxf(tmax, st[i]);
        tmax = fmaxf(tmax, __shfl_xor(tmax, 32));
        const float mnew = fmaxf(mrun, tmax);
        float ps = 0.f;
#pragma unroll
        for (int i = 0; i < 16; ++i) { st[i] = __builtin_amdgcn_exp2f(st[i] - mnew); ps += st[i]; }
        if (__builtin_amdgcn_ballot_w64(tmax > mrun) != 0ull) {
            const float alpha = __builtin_amdgcn_exp2f(mrun - mnew);
            lrun *= alpha;
#pragma unroll
            for (int i = 0; i < 16; ++i) { o0[i] *= alpha; o1[i] *= alpha; }
        }
        lrun += ps; mrun = mnew;
        bf16x8 pb[2];
#pragma unroll
        for (int s = 0; s < 2; ++s) { u32x4 w; w.x = pk2(st[8 * s], st[8 * s + 1]); w.y = pk2(st[8 * s + 2], st[8 * s + 3]); w.z = pk2(st[8 * s + 4], st[8 * s + 5]); w.w = pk2(st[8 * s + 6], st[8 * s + 7]); pb[s] = __builtin_bit_cast(bf16x8, w); }
        asm volatile("s_waitcnt lgkmcnt(0)" ::: "memory");
#pragma unroll
        for (int s = 0; s < 2; ++s) {
            const LAS unsigned char* bs = vtbase + (16 * s) * 144;
            const s16x4 lo0 = vtr(bs), hi0 = vtr(bs + 8 * 144), lo1 = vtr(bs + 64), hi1 = vtr(bs + 8 * 144 + 64);
            const bf16x8 va0 = __builtin_shufflevector(lo0, hi0, 0, 1, 2, 3, 4, 5, 6, 7), va1 = __builtin_shufflevector(lo1, hi1, 0, 1, 2, 3, 4, 5, 6, 7);
            o0 = MFMA32(va0, pb[s], o0); o1 = MFMA32(va1, pb[s], o1);
        }
        asm volatile("s_waitcnt lgkmcnt(0)" ::: "memory");
        if (more) {
#pragma unroll
            for (int i = 0; i < 4; ++i) { const int c = lane + 64 * i; *(LAS u32x4*)(vbuf + (c >> 3) * 144 + (c & 7) * 16) = vn[i]; }
#pragma unroll
            for (int s = 0; s < 4; ++s) kf[s] = kn[s];
        }
    }
    if (MODE == 1) {
#pragma unroll
        for (int i = 0; i < 16; ++i) { xch[i * 64 + lane] = o0[i]; xch[(16 + i) * 64 + lane] = o1[i]; }
        xch[32 * 64 + lane] = mrun; xch[33 * 64 + lane] = lrun;
        __syncthreads();
        return;
    }
    if (MODE == 2) {
        __syncthreads();
        const float mb = xch[32 * 64 + lane], lb = xch[33 * 64 + lane];
        const float mm = fmaxf(mrun, mb), fa = exp2f(mrun - mm), fb = exp2f(mb - mm);
#pragma unroll
        for (int i = 0; i < 16; ++i) { o0[i] = o0[i] * fa + xch[i * 64 + lane] * fb; o1[i] = o1[i] * fa + xch[(16 + i) * 64 + lane] * fb; }
        lrun = lrun * fa + lb * fb;
    }
    const float ltot = lrun + __shfl_xor(lrun, 32);
    const float inv = 1.f / ltot;
    bf16_t* orow = MIX + (size_t)(qrow0 + r) * D + head * 64;
#pragma unroll
    for (int g4 = 0; g4 < 4; ++g4) {
        const int d = 8 * g4 + 4 * hh;
        *(u32x2*)(orow + d) = (u32x2){pk2(o0[4 * g4] * inv, o0[4 * g4 + 1] * inv), pk2(o0[4 * g4 + 2] * inv, o0[4 * g4 + 3] * inv)};
        *(u32x2*)(orow + 32 + d) = (u32x2){pk2(o1[4 * g4] * inv, o1[4 * g4 + 1] * inv), pk2(o1[4 * g4 + 2] * inv, o1[4 * g4 + 3] * inv)};
    }
}

DI void prep_rows8(KP p, int r0, int lane) {
    const bf16_t* ZR = (const bf16_t*)(p->ws + WS_ZR); const float* wts = p->in[12]; const float* k_k = p->in[18];
    bf16_t* R = (bf16_t*)(p->ws + WS_R); bf16_t* KR = (bf16_t*)(p->ws + WS_KR); bf16_t* VV = (bf16_t*)(p->ws + WS_VV); bf16_t* KK = (bf16_t*)(p->ws + WS_KK);
    bf16_t* AL = (bf16_t*)(p->ws + WS_ALORA);
    const int t0 = r0 < NCTX ? (r0 & 255) : ((r0 - NCTX) & 2047); const int T = r0 < NCTX ? SEQ : DSEQ;
    const bool hp = t0 > 0, hn = t0 + 8 < T;
    const bf16_t* zb = ZR + (size_t)(r0 - 1) * RC;
    const f32x4 zero = {0, 0, 0, 0};
#pragma unroll 1
    for (int seg = 0; seg < 3; ++seg) {
        const int c = seg * 512 + lane * 8;
        f32x4 z[10][2];
#pragma unroll
        for (int i = 0; i < 10; ++i) { const bool ok = (i > 0 || hp) && (i < 9 || hn);
            if (ok) { const u32x4 w = *(const u32x4*)(zb + (size_t)i * RC + c); z[i][0] = unpk4((u32x2){w.x, w.y}); z[i][1] = unpk4((u32x2){w.z, w.w}); } else { z[i][0] = zero; z[i][1] = zero; } }
        const f32x4 wa0 = *(const f32x4*)(wts + c), wa1 = *(const f32x4*)(wts + c + 4), wb0 = *(const f32x4*)(wts + RC + c), wb1 = *(const f32x4*)(wts + RC + c + 4),
                    wc0 = *(const f32x4*)(wts + 2 * RC + c), wc1 = *(const f32x4*)(wts + 2 * RC + c + 4);
        const f32x4 k0 = *(const f32x4*)(k_k + lane * 8), k1 = *(const f32x4*)(k_k + lane * 8 + 4);
        bf16_t* dstb = (seg == 0 ? R : (seg == 1 ? KR : VV)) + (size_t)r0 * 512 + lane * 8;
#pragma unroll
        for (int i = 0; i < 8; ++i) {
            const f32x4 u0 = z[i][0] * wa0 + z[i + 1][0] * wb0 + z[i + 2][0] * wc0, u1 = z[i][1] * wa1 + z[i + 1][1] * wb1 + z[i + 2][1] * wc1;
            *(u32x4*)(dstb + (size_t)i * 512) = (u32x4){pk2(u0.x, u0.y), pk2(u0.z, u0.w), pk2(u1.x, u1.y), pk2(u1.z, u1.w)};
            if (seg == 1) {
                const f32x4 a = u0 * k0, bq = u1 * k1;
                float sq = (a.x * a.x + a.y * a.y) + (a.z * a.z + a.w * a.w) + (bq.x * bq.x + bq.y * bq.y) + (bq.z * bq.z + bq.w * bq.w);
                sq += __shfl_xor(sq, 1); sq += __shfl_xor(sq, 2); sq += __shfl_xor(sq, 4);
                const float rn = rsqrtf(sq + 1e-12f);
                const f32x4 ka_ = a * rn, kb_ = bq * rn; *(u32x4*)(KK + (size_t)(r0 + i) * 512 + lane * 8) = (u32x4){pk2(ka_.x, ka_.y), pk2(ka_.z, ka_.w), pk2(kb_.x, kb_.y), pk2(kb_.z, kb_.w)};
            }
        }
    }
    {
        const int cl = lane * 6, cc = 1536 + cl;
        const f32x2 zero2 = {0, 0};
        f32x2 z[10][3];
#pragma unroll
        for (int i = 0; i < 10; ++i) { const bool ok = (i > 0 || hp) && (i < 9 || hn);
#pragma unroll
            for (int q = 0; q < 3; ++q) { if (ok) { const unsigned w = *(const unsigned*)(zb + (size_t)i * RC + cc + 2 * q); z[i][q] = (f32x2){__builtin_bit_cast(float, w << 16), __builtin_bit_cast(float, w & 0xffff0000u)}; } else z[i][q] = zero2; } }
#pragma unroll
        for (int q = 0; q < 3; ++q) {
            const f32x2 wa = *(const f32x2*)(wts + cc + 2 * q), wb = *(const f32x2*)(wts + RC + cc + 2 * q), wcq = *(const f32x2*)(wts + 2 * RC + cc + 2 * q);
            const int cq = cl + 2 * q, grp = cq >> 7, k = cq & 127;
#pragma unroll
            for (int i = 0; i < 8; ++i) {
                f32x2 u = z[i][q] * wa + z[i + 1][q] * wb + z[i + 2][q] * wcq;
                if (grp == 0) { u.x = tanh_f(u.x); u.y = tanh_f(u.y); }
                else if (grp == 2) { u.x = sigmoid_f(u.x); u.y = sigmoid_f(u.y); }
                *(unsigned*)(AL + ((size_t)grp * NTOK + r0 + i) * 128 + k) = pk2(u.x, u.y);
            }
        }
    }
}

template <int CTRL> DI float dppf_(float x) { return __builtin_bit_cast(float, __builtin_amdgcn_mov_dpp(__builtin_bit_cast(int, x), CTRL, 0xf, 0xf, true)); }
template <int CTRL> DI float dpp_add(float x) { const int y = __builtin_amdgcn_mov_dpp(__builtin_bit_cast(int, x), CTRL, 0xf, 0xf, true); return x + __builtin_bit_cast(float, y); }
DI float red16(float x) { x = dpp_add<0xB1>(x); x = dpp_add<0x4E>(x); x = dpp_add<0x141>(x); x = dpp_add<0x140>(x); return x; }

constexpr int TC = 16;
DI float tred4(float q0, float q1, float q2, float q3, bool b0, bool b1) {
    const float ka = b0 ? q2 : q0, kb = b0 ? q3 : q1, sa = b0 ? q0 : q2, sb = b0 ? q1 : q3;
    const float a = ka + dppf_<0xB1>(sa), b = kb + dppf_<0xB1>(sb);
    float c = (b1 ? b : a) + dppf_<0x4E>(b1 ? a : b);
    c += dppf_<0x124>(c);
    c += dppf_<0x128>(c);
    return c;
}
DI f32x2 lo2(f32x4 v) { return __builtin_shufflevector(v, v, 0, 1); }
DI f32x2 hi2(f32x4 v) { return __builtin_shufflevector(v, v, 2, 3); }
struct ScanOps { f32x4 kk, rr, ww, bb, kd; float vv; };
struct ScanLd { f32x4 kk, r, dec, aa, kr, v; };
DI void scan_item(KP p, LAS unsigned char* lds, int latent, int sc, int qr, int tid) {
    const bf16_t* KK = (const bf16_t*)(p->ws + WS_KK); const bf16_t* R = (const bf16_t*)(p->ws + WS_R); const bf16_t* KR = (const bf16_t*)(p->ws + WS_KR);
    const bf16_t* VV = (const bf16_t*)(p->ws + WS_VV); const float* k_a = p->in[19];
    float* Y = (float*)(p->ws + WS_Y);
    const int b = sc >> 4, dir = (sc >> 3) & 1, h = sc & 7;
    const int T = latent ? DSEQ : SEQ; const size_t rowbase = latent ? (size_t)NCTX + (size_t)b * DSEQ : (size_t)b * SEQ;
    const float* DEC = (const float*)(p->ws + WS_DEC) + (size_t)dir * NTOK * 512; const bf16_t* AA = (const bf16_t*)(p->ws + WS_AA) + (size_t)dir * NTOK * 512;
    float* Yd = Y + (size_t)dir * NTOK * 512;
    LAS float* buf = (LAS float*)lds;
    LAS float* vb = (LAS float*)(lds + 2 * TC * 320 * 4);
    const int wave = tid >> 6, lane = tid & 63;
    const bool consumer = wave < 4;
    const int nchunk = T / TC;
    const int rl = lane >> 4, ks = lane & 15, row = 16 * qr + 4 * wave + rl;
    f32x2 S01 = {0, 0}, S23 = {0, 0};
    if (consumer && latent) { const f32x4 s4 = *(const f32x4*)(p->in[4] + ((((size_t)b * 2 + dir) * 8 + h) * 64 + row) * 64 + 4 * ks); S01 = lo2(s4); S23 = hi2(s4); }
    const int lt = tid - 256, lj = lt >> 4, li = lt & 15;
    ScanLd L0, L1; f32x4 ka4 = {0, 0, 0, 0};
    if (!consumer) ka4 = *(const f32x4*)(k_a + h * 64 + 4 * li);
    float* ybase = Yd + (rowbase)*512 + h * 64 + row;
    const bool kb0 = (ks & 1) != 0, kb1 = (ks & 2) != 0; const int ystep = 4 * (ks >> 2) + 2 * (ks & 1) + ((ks >> 1) & 1);
#define SCAN_LOAD(L, c) do { const int idx = (c) * TC + lj; const int tt = dir ? T - 1 - idx : idx; const size_t off = (rowbase + tt) * 512 + h * 64 + 4 * li; \
        L.kk = unpk4(*(const u32x2*)(KK + off)); L.r = unpk4(*(const u32x2*)(R + off)); L.dec = *(const f32x4*)(DEC + off); L.aa = unpk4(*(const u32x2*)(AA + off)); L.kr = unpk4(*(const u32x2*)(KR + off)); \
        if (lt < 64) { const int vj = lt >> 2, vq = lt & 3; const int idv = (c) * TC + vj; const int tv = dir ? T - 1 - idv : idv; L.v = unpk4(*(const u32x2*)(VV + (rowbase + tv) * 512 + h * 64 + 16 * qr + 4 * vq)); } } while (0)
#define SCAN_WRITE(L, bc, vc) do { const f32x4 bb_ = L.kk * L.aa; const f32x4 kd_ = L.kr * ((L.aa - 1.f) * ka4 + 1.f); LAS float* d_ = (bc) + lj * 320 + 4 * li; \
        *(LAS f32x4*)(d_) = L.kk; *(LAS f32x4*)(d_ + 64) = L.r; *(LAS f32x4*)(d_ + 128) = L.dec; *(LAS f32x4*)(d_ + 192) = bb_; *(LAS f32x4*)(d_ + 256) = kd_; \
        if (lt < 64) *(LAS f32x4*)((vc) + (lt >> 2) * 16 + 4 * (lt & 3)) = L.v; } while (0)
#define SCAN_LDOPS(o, bc, vc, j) do { const LAS float* d_ = (bc) + (j) * 320 + 4 * ks; o.kk = *(const LAS f32x4*)(d_); o.rr = *(const LAS f32x4*)(d_ + 64); o.ww = *(const LAS f32x4*)(d_ + 128); \
        o.bb = *(const LAS f32x4*)(d_ + 192); o.kd = *(const LAS f32x4*)(d_ + 256); o.vv = (vc)[(j) * 16 + 4 * wave + rl]; } while (0)
#define SCAN_COMPUTE(bc, vc, c) do { ScanOps oc, on, on2; SCAN_LDOPS(oc, bc, vc, 0); SCAN_LDOPS(on, bc, vc, 1); float ysel = 0.f; float yp0 = 0.f, yp1 = 0.f, yp2 = 0.f; \
        _Pragma("unroll") for (int j = 0; j < TC; ++j) { \
            if (j + 2 < TC) SCAN_LDOPS(on2, bc, vc, j + 2);     \
            f32x2 pq = S01 * lo2(oc.kk); pq = S23 * hi2(oc.kk) + pq; \
            const float sa = red16(pq.x + pq.y); \
            const f32x2 t01 = S01 * lo2(oc.ww) + lo2(oc.kd) * oc.vv, t23 = S23 * hi2(oc.ww) + hi2(oc.kd) * oc.vv; \
            S01 = t01 - lo2(oc.bb) * sa; S23 = t23 - hi2(oc.bb) * sa; \
            f32x2 yq = S01 * lo2(oc.rr); yq = S23 * hi2(oc.rr) + yq; \
            const float yp = yq.x + yq.y; \
            if ((j & 3) == 0) yp0 = yp; else if ((j & 3) == 1) yp1 = yp; else if ((j & 3) == 2) yp2 = yp; \
            else { const float yr = tred4(yp0, yp1, yp2, yp, kb0, kb1); ysel = ((ks >> 2) == (j >> 2)) ? yr : ysel; } \
            oc = on; on = on2; \
            asm volatile("" ::: "memory"); } \
        { const int idx = (c) * TC + ystep; const int tt = dir ? T - 1 - idx : idx; ybase[(size_t)tt * 512] = ysel; } } while (0)
    if (!consumer) { SCAN_LOAD(L0, 0); SCAN_LOAD(L1, 1); }
    for (int c = 0; c < nchunk; c += 2) {
        if (!consumer) SCAN_WRITE(L0, buf, vb);
        __syncthreads();
        if (!consumer) { if (c + 2 < nchunk) SCAN_LOAD(L0, c + 2); }
        else SCAN_COMPUTE(buf, vb, c);
        if (!consumer) SCAN_WRITE(L1, buf + TC * 320, vb + TC * 16);
        __syncthreads();
        if (!consumer) { if (c + 3 < nchunk) SCAN_LOAD(L1, c + 3); }
        else SCAN_COMPUTE(buf + TC * 320, vb + TC * 16, c + 1);
    }
#undef SCAN_LOAD
#undef SCAN_WRITE
#undef SCAN_LDOPS
#undef SCAN_COMPUTE
    if (consumer && !latent) *(f32x4*)(p->out + OUT_S + ((((size_t)b * 2 + dir) * 8 + h) * 64 + row) * 64 + 4 * ks) = (f32x4){S01.x, S01.y, S23.x, S23.y};
    __syncthreads();
}

constexpr int CS_L = 32, CS_LAT = 2048, CS_CHUNKS = 4096;
DI unsigned char* cs_mf(unsigned char* ws, int q) { return ws + 28 * MiB + (size_t)q * 8192; }
DI unsigned char* cs_q1(unsigned char* ws, int q) { return q < CS_LAT ? ws + 60 * MiB + (size_t)q * 4096 : ws + 76 * MiB + (size_t)(q - CS_LAT) * 4096; }
DI unsigned char* cs_q2(unsigned char* ws, int q) { return q < CS_LAT ? ws + 92 * MiB + (size_t)q * 4096 : ws + 108 * MiB + (size_t)(q - CS_LAT) * 4096; }
DI unsigned char* cs_nt(unsigned char* ws, int q) { return q < CS_LAT ? ws + 202 * MiB + (size_t)q * 8192 : ws + 234 * MiB + (size_t)(q - CS_LAT) * 8192; }
constexpr int CS_G = 51456;
DI bf16x8 frag_nat(const LAS unsigned char* img, int pitch, int rc, int s, int hh) { return *(const LAS bf16x8*)(img + rc * pitch + (16 * s + 8 * hh) * 2); }
DI bf16x8 frag_krow(const LAS unsigned char* img, int pitch, int rc, int s, int hh) {
    const s16x4 lo = *(const LAS s16x4*)(img + rc * pitch + (16 * s + 4 * hh) * 2), hi = *(const LAS s16x4*)(img + rc * pitch + (16 * s + 8 + 4 * hh) * 2);
    return __builtin_shufflevector(lo, hi, 0, 1, 2, 3, 4, 5, 6, 7); }
DI bf16x8 frag_tr(const LAS unsigned char* img, int pitch, int col0, int s, int lane) {
    const int i16 = lane & 15, tq = i16 >> 2, tp = i16 & 3, blk = (lane >> 4) & 1, hh = lane >> 5;
    const LAS unsigned char* bs = img + (16 * s + 4 * hh + tq) * pitch + (col0 + 16 * blk) * 2 + 8 * tp;
    const s16x4 lo = vtr(bs), hi = vtr(bs + 8 * pitch);
    return __builtin_shufflevector(lo, hi, 0, 1, 2, 3, 4, 5, 6, 7); }
template <int S> DI bf16x8 pack8(const f32x16& x, float sg) {
    u32x4 w; w.x = pk2(sg * x[8 * S], sg * x[8 * S + 1]); w.y = pk2(sg * x[8 * S + 2], sg * x[8 * S + 3]); w.z = pk2(sg * x[8 * S + 4], sg * x[8 * S + 5]); w.w = pk2(sg * x[8 * S + 6], sg * x[8 * S + 7]);
    return __builtin_bit_cast(bf16x8, w); }
template <int S> DI bf16x8 pack8lo(const f32x16& x, bf16x8 hi) {
    const u32x4 h = __builtin_bit_cast(u32x4, hi); float d[8];
#pragma unroll
    for (int j = 0; j < 4; ++j) { d[2 * j] = x[8 * S + 2 * j] - __builtin_bit_cast(float, h[j] << 16); d[2 * j + 1] = x[8 * S + 2 * j + 1] - __builtin_bit_cast(float, h[j] & 0xffff0000u); }
    u32x4 w; w.x = pk2(d[0], d[1]); w.y = pk2(d[2], d[3]); w.z = pk2(d[4], d[5]); w.w = pk2(d[6], d[7]);
    return __builtin_bit_cast(bf16x8, w); }
DI void lds_barrier() { asm volatile("s_waitcnt lgkmcnt(0)" ::: "memory"); __builtin_amdgcn_s_barrier(); asm volatile("" ::: "memory"); }
DI f32x16 zero16() { f32x16 z;
#pragma unroll
    for (int i = 0; i < 16; ++i) z[i] = 0.f;
    return z; }

DI void cs_phaseA(KP p, LAS unsigned char* lds, int tid, int qbase, int nit, int first, int stride) {
    const bf16_t* KK = (const bf16_t*)(p->ws + WS_KK); const bf16_t* R = (const bf16_t*)(p->ws + WS_R); const bf16_t* KR = (const bf16_t*)(p->ws + WS_KR);
    const bf16_t* VV = (const bf16_t*)(p->ws + WS_VV); const float* k_a = p->in[19];
    const int wave = tid >> 6, lane = tid & 63, g = wave >> 2, wq = wave & 3, tg = wq * 64 + lane, hh = lane >> 5, r32 = lane & 31;
    LAS unsigned char* L = lds + g * CS_G;
    LAS unsigned char* MKK = L, *MBT = L + 4608, *MKT = L + 2 * 4608, *MRT = L + 3 * 4608, *MBH = L + 4 * 4608, *MKH = L + 5 * 4608, *MVM = L + 6 * 4608;
    LAS float* AF = (LAS float*)(L + 32256);
    LAS unsigned char* ST = L + 36352, *SKK = ST + 2560, *SRB = ST + 2 * 2560, *SRK = ST + 3 * 2560;
    LAS float* SEG = (LAS float*)(L + 46592); LAS float* ELv = (LAS float*)(L + 48640);
    LAS unsigned char* SA = L + 48896;
    f32x2 lwN[4], kkN[4], aaN[4], krN[4], rN[4]; u32x4 vmN;
#define CSA_FETCH(it_) do { const int q_ = qbase + (it_) * 2 + g; const bool lat_ = q_ < CS_LAT; const int sc_ = lat_ ? (q_ >> 6) : ((q_ - CS_LAT) >> 3), ci_ = lat_ ? (q_ & 63) : (q_ & 7), TT_ = lat_ ? DSEQ : SEQ; \
        const int b_ = sc_ >> 4, dir_ = (sc_ >> 3) & 1, h_ = sc_ & 7; const int rb_ = lat_ ? NCTX + b_ * DSEQ : b_ * SEQ; \
          \
        const int t0_ = dir_ ? TT_ - 1 - ci_ * CS_L : ci_ * CS_L, sg_ = dir_ ? -512 : 512; \
        const unsigned ub_ = (unsigned)((rb_ + t0_) * 512 + h_ * 64); \
        const unsigned o0_ = ub_ + (unsigned)(sg_ * 4 * (tg >> 5) + 2 * (tg & 31)); \
        const float* DEC_ = (const float*)(p->ws + WS_DEC) + (size_t)dir_ * NTOK * 512; const bf16_t* AA_ = (const bf16_t*)(p->ws + WS_AA) + (size_t)dir_ * NTOK * 512; \
        _Pragma("unroll") for (int j = 0; j < 4; ++j) { const unsigned off = o0_ + (unsigned)(sg_ * j); \
            lwN[j] = *(const f32x2*)(DEC_ + off); kkN[j] = ldh2(KK + off); aaN[j] = ldh2(AA_ + off); krN[j] = ldh2(KR + off); rN[j] = ldh2(R + off); } \
        vmN = *(const u32x4*)(VV + (ub_ + (unsigned)(sg_ * (tg >> 3) + (tg & 7) * 8))); } while (0)
    if (first < nit) CSA_FETCH(first);
    for (int it = first; it < nit; it += stride) {
        const int q = qbase + it * 2 + g; const bool lat = q < CS_LAT;
        const int sc = lat ? (q >> 6) : ((q - CS_LAT) >> 3), ci = lat ? (q & 63) : (q & 7), TT = lat ? DSEQ : SEQ;
        const int b = sc >> 4, dir = (sc >> 3) & 1, h = sc & 7;
        const size_t rowbase = lat ? (size_t)NCTX + (size_t)b * DSEQ : (size_t)b * SEQ;
        const float* DEC = (const float*)(p->ws + WS_DEC) + (size_t)dir * NTOK * 512; const bf16_t* AA = (const bf16_t*)(p->ws + WS_AA) + (size_t)dir * NTOK * 512;
        {
            const int kp = tg & 31, seg = tg >> 5;
            f32x2 lw[4], kk2[4], aa2[4], kr2[4], r2[4];
#pragma unroll
            for (int j = 0; j < 4; ++j) { lw[j] = lwN[j]; kk2[j] = kkN[j]; aa2[j] = aaN[j]; kr2[j] = krN[j]; r2[j] = rN[j]; }
            const u32x4 vmC = vmN;
            if (it + stride < nit) CSA_FETCH(it + stride);
            f32x2 ss = {0.f, 0.f};
#pragma unroll
            for (int j = 0; j < 4; ++j) { lw[j].x = __logf(lw[j].x); lw[j].y = __logf(lw[j].y); ss += lw[j]; }
            *(LAS f32x2*)(SEG + seg * 64 + 2 * kp) = ss;
            { const int i = tg >> 3, v0 = (tg & 7) * 8; *(LAS u32x4*)(MVM + i * 144 + v0 * 2) = vmC; }
            lds_barrier();
            f32x2 pre = {0.f, 0.f}, tot = {0.f, 0.f};
#pragma unroll
            for (int s8 = 0; s8 < 8; ++s8) { const f32x2 v = *(const LAS f32x2*)(SEG + s8 * 64 + 2 * kp); tot += v; if (s8 < seg) pre += v; }
            if (seg == 0) *(LAS f32x2*)(ELv + 2 * kp) = (f32x2){__expf(tot.x), __expf(tot.y)};
            const f32x2 ka = *(const f32x2*)(k_a + h * 64 + 2 * kp);
            f32x2 cwp = pre;
#pragma unroll
            for (int j = 0; j < 4; ++j) {
                const f32x2 cw = cwp + lw[j];
                const f32x2 E = {__expf(cw.x), __expf(cw.y)}, Ei = {__expf(-cw.x), __expf(-cw.y)}, Ep = {__expf(cwp.x), __expf(cwp.y)}, Eh = {__expf(tot.x - cw.x), __expf(tot.y - cw.y)};
                const f32x2 bb = kk2[j] * aa2[j], kd = kr2[j] * ((aa2[j] - 1.f) * ka + 1.f);
                const int o = (4 * seg + j) * 144 + 4 * kp;
                const f32x2 x0 = kk2[j] * Ep, x1 = bb * Ei, x2 = kd * Ei, x3 = r2[j] * E, x4 = bb * Eh, x5 = kd * Eh;
                *(LAS unsigned*)(MKK + o) = pk2(x0.x, x0.y); *(LAS unsigned*)(MBT + o) = pk2(x1.x, x1.y); *(LAS unsigned*)(MKT + o) = pk2(x2.x, x2.y);
                *(LAS unsigned*)(MRT + o) = pk2(x3.x, x3.y); *(LAS unsigned*)(MBH + o) = pk2(x4.x, x4.y); *(LAS unsigned*)(MKH + o) = pk2(x5.x, x5.y);
                cwp = cw;
            }
        }
        lds_barrier();
        {
            const LAS unsigned char* ia = wq < 2 ? MKK : MRT; const LAS unsigned char* ib = (wq & 1) ? MKT : MBT;
            f32x16 acc = zero16();
#pragma unroll
            for (int s4 = 0; s4 < 4; ++s4) acc = MFMA32(frag_nat(ia, 144, r32, s4, hh), frag_nat(ib, 144, r32, s4, hh), acc);
#pragma unroll
            for (int i = 0; i < 16; ++i) { const int row = crow(i, hh); const bool keep = wq < 2 ? (row > r32) : (row >= r32); const float v = keep ? acc[i] : 0.f;
                if (wq == 0) { AF[row * 32 + r32] = v; *(LAS unsigned short*)(SA + row * 80 + r32 * 2) = (row >= 16 && r32 < 16) ? (unsigned short)(pk2(v, 0.f) & 0xffffu) : (unsigned short)0; }
                else *(LAS unsigned short*)((wq == 1 ? SKK : (wq == 2 ? SRB : SRK)) + row * 80 + r32 * 2) = (unsigned short)(pk2(v, 0.f) & 0xffffu); }
        }
        lds_barrier();
        f32x16 X = zero16(), NT0 = zero16(), NT1 = zero16(), Q2 = zero16();
        const int c = wq & 1;
        if (wq == 0) {
            const int blk = r32 >> 4, cc = r32 & 15;
            float Tc[16];
#pragma unroll
            for (int i = 0; i < 16; ++i) {
                float a4[4] = {(i == cc) ? 1.f : 0.f, 0.f, 0.f, 0.f};
#pragma unroll
                for (int j4 = 0; j4 < (i + 3) / 4; ++j4) { const f32x4 ar = *(const LAS f32x4*)(AF + (16 * blk + i) * 32 + 16 * blk + 4 * j4);
#pragma unroll
                    for (int e = 0; e < 4; ++e) if (4 * j4 + e < i) a4[e] -= ar[e] * Tc[4 * j4 + e]; }
                const float a = (a4[0] + a4[1]) + (a4[2] + a4[3]);
                Tc[i] = a;
                if (lane < 32) { *(LAS unsigned short*)(ST + (16 * blk + i) * 80 + (16 * blk + cc) * 2) = (unsigned short)(pk2(a, 0.f) & 0xffffu);
                                 *(LAS unsigned short*)(ST + (16 * blk + i) * 80 + (16 * (1 - blk) + cc) * 2) = (unsigned short)0; }
            }
            asm volatile("s_waitcnt lgkmcnt(0)" ::: "memory");
            f32x16 E = zero16();
            E = MFMA32(frag_krow(SA, 80, r32, 0, hh), frag_tr(ST, 80, 0, 0, lane), E); E = MFMA32(frag_krow(SA, 80, r32, 1, hh), frag_tr(ST, 80, 0, 1, lane), E);
#pragma unroll
            for (int i = 0; i < 16; ++i) E[i] = ((crow(i, hh) == r32) ? 1.f : 0.f) - E[i];
            f32x16 Tm = zero16();
            Tm = MFMA32(frag_krow(ST, 80, r32, 0, hh), pack8<0>(E, 1.f), Tm); Tm = MFMA32(frag_krow(ST, 80, r32, 1, hh), pack8<1>(E, 1.f), Tm);
            asm volatile("s_waitcnt lgkmcnt(0)" ::: "memory");
#pragma unroll
            for (int i = 0; i < 16; ++i) *(LAS unsigned short*)(ST + crow(i, hh) * 80 + r32 * 2) = (unsigned short)(pk2(Tm[i], 0.f) & 0xffffu);
        } else if (wq >= 2) {
#pragma unroll
            for (int s2 = 0; s2 < 2; ++s2) {
                const bf16x8 vm = frag_tr(MVM, 144, 32 * c, s2, lane);
                X = MFMA32(frag_krow(SKK, 80, r32, s2, hh), vm, X);
                Q2 = MFMA32(frag_krow(SRK, 80, r32, s2, hh), vm, Q2);
                NT0 = MFMA32(frag_tr(MKH, 144, 0, s2, lane), vm, NT0);
                NT1 = MFMA32(frag_tr(MKH, 144, 32, s2, lane), vm, NT1);
            }
        }
        lds_barrier();
        if (wq < 2) {
            f32x16 P1 = zero16();
#pragma unroll
            for (int s2 = 0; s2 < 2; ++s2) P1 = MFMA32(frag_krow(ST, 80, r32, s2, hh), frag_tr(MKK, 144, 32 * c, s2, lane), P1);
            const bf16x8 n0 = pack8<0>(P1, -1.f), n1 = pack8<1>(P1, -1.f);
            f32x16 Q1t;
#pragma unroll
            for (int g4 = 0; g4 < 4; ++g4) { const u32x2 w = *(const LAS u32x2*)(MRT + r32 * 144 + (32 * c + 8 * g4 + 4 * hh) * 2); const f32x4 f = unpk4(w);
                Q1t[4 * g4] = f.x; Q1t[4 * g4 + 1] = f.y; Q1t[4 * g4 + 2] = f.z; Q1t[4 * g4 + 3] = f.w; }
            Q1t = MFMA32(n0, frag_krow(SRB, 80, r32, 0, hh), Q1t); Q1t = MFMA32(n1, frag_krow(SRB, 80, r32, 1, hh), Q1t);
            u32x4* q1f = (u32x4*)cs_q1(p->ws, q) + (c * 2) * 64 + lane;
            q1f[0] = __builtin_bit_cast(u32x4, pack8<0>(Q1t, 1.f)); q1f[64] = __builtin_bit_cast(u32x4, pack8<1>(Q1t, 1.f));
#pragma unroll
            for (int bq = 0; bq < 2; ++bq) {
                f32x16 M = zero16();
                if (bq == c) {
#pragma unroll
                    for (int i = 0; i < 16; ++i) M[i] = (crow(i, hh) == r32) ? ELv[32 * c + r32] : 0.f;
                }
                M = MFMA32(n0, frag_tr(MBH, 144, 32 * bq, 0, lane), M); M = MFMA32(n1, frag_tr(MBH, 144, 32 * bq, 1, lane), M);
                u32x4* mf = (u32x4*)cs_mf(p->ws, q) + ((c * 2 + bq) * 2) * 64 + lane;
                mf[0] = __builtin_bit_cast(u32x4, pack8<0>(M, 1.f)); mf[64] = __builtin_bit_cast(u32x4, pack8<1>(M, 1.f));
            }
        } else {
            f32x16 P2 = zero16();
            P2 = MFMA32(frag_krow(ST, 80, r32, 0, hh), pack8<0>(X, 1.f), P2); P2 = MFMA32(frag_krow(ST, 80, r32, 1, hh), pack8<1>(X, 1.f), P2);
            const bf16x8 n0 = pack8<0>(P2, -1.f), n1 = pack8<1>(P2, -1.f);
            Q2 = MFMA32(frag_krow(SRB, 80, r32, 0, hh), n0, Q2); Q2 = MFMA32(frag_krow(SRB, 80, r32, 1, hh), n1, Q2);
            NT0 = MFMA32(frag_tr(MBH, 144, 0, 0, lane), n0, NT0); NT0 = MFMA32(frag_tr(MBH, 144, 0, 1, lane), n1, NT0);
            NT1 = MFMA32(frag_tr(MBH, 144, 32, 0, lane), n0, NT1); NT1 = MFMA32(frag_tr(MBH, 144, 32, 1, lane), n1, NT1);
            unsigned* q2f = (unsigned*)cs_q2(p->ws, q) + c * 512 + lane;
#pragma unroll
            for (int i = 0; i < 8; ++i) q2f[i * 64] = pk2(Q2[2 * i], Q2[2 * i + 1]);
            unsigned* ntf = (unsigned*)cs_nt(p->ws, q) + (c * 2) * 512 + lane;
#pragma unroll
            for (int i = 0; i < 8; ++i) { ntf[i * 64] = pk2(NT0[2 * i], NT0[2 * i + 1]); ntf[512 + i * 64] = pk2(NT1[2 * i], NT1[2 * i + 1]); }
        }
        lds_barrier();
    }
#undef CSA_FETCH
}


constexpr int CSB_SLOT = 24576;
DI void cs_phaseB(KP p, LAS unsigned char* lds, int latent, int sc, int tid) {
    const int wave = tid >> 6, lane = tid & 63, hh = lane >> 5, r32 = lane & 31;
    const int nch = latent ? 64 : 8, q0 = latent ? sc * 64 : CS_LAT + sc * 8, TT = latent ? DSEQ : SEQ;
    const int b = sc >> 4, dir = (sc >> 3) & 1, h = sc & 7, c = wave & 1;
    const size_t rowbase = latent ? (size_t)NCTX + (size_t)b * DSEQ : (size_t)b * SEQ;
    const bool consumer = wave < 2;
    float* Yu = p->out + (size_t)dir * NTOK * 512 + rowbase * 512 + h * 64 + 32 * c;
    const unsigned ylane = (unsigned)((dir ? 4 * (1 - hh) : 4 * hh) * 512 + r32);
    f32x16 Z0 = zero16(), Z1 = zero16();
    if (consumer && latent) { const float* s0 = p->in[4] + ((((size_t)b * 2 + dir) * 8 + h) * 64 + 32 * c + r32) * 64;
#pragma unroll
      for (int g4 = 0; g4 < 4; ++g4) { const f32x4 a = *(const f32x4*)(s0 + 8 * g4 + 4 * hh), bq = *(const f32x4*)(s0 + 32 + 8 * g4 + 4 * hh);
          Z0[4 * g4] = a.x; Z0[4 * g4 + 1] = a.y; Z0[4 * g4 + 2] = a.z; Z0[4 * g4 + 3] = a.w; Z1[4 * g4] = bq.x; Z1[4 * g4 + 1] = bq.y; Z1[4 * g4 + 2] = bq.z; Z1[4 * g4 + 3] = bq.w; } }
    const int lt = tid - 128;
    u32x4 RG[4][4];
#define CSB_LOADQ(set, ch) do { const int q_ = q0 + (ch); _Pragma("unroll") for (int k_ = 0; k_ < 4; ++k_) { const int pi_ = lt + 384 * k_; \
        const unsigned char* src_ = pi_ < 512 ? cs_mf(p->ws, q_) + pi_ * 16 : (pi_ < 768 ? cs_q1(p->ws, q_) + (pi_ - 512) * 16 : (pi_ < 1280 ? cs_nt(p->ws, q_) + (pi_ - 768) * 16 : cs_q2(p->ws, q_) + (pi_ - 1280) * 16)); \
        RG[set][k_] = *(const u32x4*)src_; } } while (0)
#define CSB_WRITEQ(set, slot) do { _Pragma("unroll") for (int k_ = 0; k_ < 4; ++k_) *(LAS u32x4*)(lds + (slot) * CSB_SLOT + (lt + 384 * k_) * 16) = RG[set][k_]; } while (0)
    if (!consumer) { CSB_LOADQ(0, 0); CSB_LOADQ(1, 1); CSB_LOADQ(2, 2); CSB_LOADQ(3, 3); CSB_WRITEQ(0, 0); CSB_LOADQ(0, 4); }
    else __builtin_amdgcn_s_setprio(3);
    for (int ci0 = 0; ci0 < nch; ci0 += 4) {
#pragma unroll
        for (int u = 0; u < 4; ++u) {
            const int ci = ci0 + u;
            lds_barrier();
            if (!consumer) {
                if (ci + 1 < nch) { CSB_WRITEQ((u + 1) & 3, (ci + 1) & 1); if (ci + 5 < nch) CSB_LOADQ((u + 1) & 3, ci + 5); }
            } else {
                const LAS unsigned char* sl = lds + (ci & 1) * CSB_SLOT;
                bf16x8 MF[8], Q1[4]; f32x16 Y, N0, N1;
#pragma unroll
                for (int i = 0; i < 8; ++i) MF[i] = *(const LAS bf16x8*)(sl + (i * 64 + lane) * 16);
#pragma unroll
                for (int i = 0; i < 4; ++i) Q1[i] = *(const LAS bf16x8*)(sl + 8192 + (i * 64 + lane) * 16);
#pragma unroll
                for (int i = 0; i < 8; ++i) { const unsigned w0 = *(const LAS unsigned*)(sl + 12288 + ((c * 2) * 512 + i * 64 + lane) * 4), w1 = *(const LAS unsigned*)(sl + 12288 + ((c * 2 + 1) * 512 + i * 64 + lane) * 4),
                                                         w2 = *(const LAS unsigned*)(sl + 20480 + (c * 512 + i * 64 + lane) * 4);
                    N0[2 * i] = __builtin_bit_cast(float, w0 << 16); N0[2 * i + 1] = __builtin_bit_cast(float, w0 & 0xffff0000u);
                    N1[2 * i] = __builtin_bit_cast(float, w1 << 16); N1[2 * i + 1] = __builtin_bit_cast(float, w1 & 0xffff0000u);
                    Y[2 * i] = __builtin_bit_cast(float, w2 << 16); Y[2 * i + 1] = __builtin_bit_cast(float, w2 & 0xffff0000u); }
                const bf16x8 z00 = pack8<0>(Z0, 1.f), z01 = pack8<1>(Z0, 1.f), z10 = pack8<0>(Z1, 1.f), z11 = pack8<1>(Z1, 1.f);
                const bf16x8 l00 = pack8lo<0>(Z0, z00), l01 = pack8lo<1>(Z0, z01), l10 = pack8lo<0>(Z1, z10), l11 = pack8lo<1>(Z1, z11);
                Y = MFMA32(Q1[0], z00, Y); Y = MFMA32(Q1[1], z01, Y); Y = MFMA32(Q1[2], z10, Y); Y = MFMA32(Q1[3], z11, Y);
                N0 = MFMA32(MF[0], z00, N0); N0 = MFMA32(MF[1], z01, N0); N0 = MFMA32(MF[4], z10, N0); N0 = MFMA32(MF[5], z11, N0);
                N0 = MFMA32(MF[0], l00, N0); N0 = MFMA32(MF[1], l01, N0); N0 = MFMA32(MF[4], l10, N0); N0 = MFMA32(MF[5], l11, N0);
                N1 = MFMA32(MF[2], z00, N1); N1 = MFMA32(MF[3], z01, N1); N1 = MFMA32(MF[6], z10, N1); N1 = MFMA32(MF[7], z11, N1);
                N1 = MFMA32(MF[2], l00, N1); N1 = MFMA32(MF[3], l01, N1); N1 = MFMA32(MF[6], l10, N1); N1 = MFMA32(MF[7], l11, N1);
                Z0 = N0; Z1 = N1;
                { const int t0 = dir ? TT - CS_L - ci * CS_L : ci * CS_L;
#pragma unroll
                  for (int i = 0; i < 16; ++i) { const int ci_ = (i & 3) + 8 * (i >> 2); float* Ys = Yu + (size_t)(t0 + (dir ? 27 - ci_ : ci_)) * 512; Ys[ylane] = Y[i]; } }
            }
        }
    }
#undef CSB_LOADQ
#undef CSB_WRITEQ
    __builtin_amdgcn_s_setprio(0);
    if (consumer && !latent) { float* so = p->out + OUT_S + ((((size_t)b * 2 + dir) * 8 + h) * 64 + 32 * c + r32) * 64;
#pragma unroll
        for (int g4 = 0; g4 < 4; ++g4) { *(f32x4*)(so + 8 * g4 + 4 * hh) = (f32x4){Z0[4 * g4], Z0[4 * g4 + 1], Z0[4 * g4 + 2], Z0[4 * g4 + 3]};
                                          *(f32x4*)(so + 32 + 8 * g4 + 4 * hh) = (f32x4){Z1[4 * g4], Z1[4 * g4 + 1], Z1[4 * g4 + 2], Z1[4 * g4 + 3]}; } }
    __syncthreads();
}

DI void post_row(KP p, int r, int lane) {
    const float* Y = p->out; const bf16_t* R = (const bf16_t*)(p->ws + WS_R); const bf16_t* KR = (const bf16_t*)(p->ws + WS_KR);
    const bf16_t* VV = (const bf16_t*)(p->ws + WS_VV); const bf16_t* AA = (const bf16_t*)(p->ws + WS_AA); const bf16_t* G = (const bf16_t*)(p->ws + WS_G);
    const float* k_a = p->in[19]; const float* r_k = p->in[20]; const float* lng = p->in[21]; const float* lnb = p->in[22];
    bf16_t* MIX = (bf16_t*)(p->ws + WS_MIX);
    const int c = lane * 8; const size_t off = (size_t)r * 512 + c;
    float y[8], rr[8], kr[8], vv[8], a0[8], a1[8], gg[8], ka[8], rk[8], lg[8], lb[8];
#define LD8(dst, ptr) do { const f32x4 _a = *(const f32x4*)(ptr), _b = *(const f32x4*)((ptr) + 4); dst[0] = _a.x; dst[1] = _a.y; dst[2] = _a.z; dst[3] = _a.w; dst[4] = _b.x; dst[5] = _b.y; dst[6] = _b.z; dst[7] = _b.w; } while (0)
#define LD8H(dst, ptr) do { const u32x4 _w = *(const u32x4*)(ptr); const f32x4 _a = unpk4((u32x2){_w.x, _w.y}), _b = unpk4((u32x2){_w.z, _w.w}); dst[0] = _a.x; dst[1] = _a.y; dst[2] = _a.z; dst[3] = _a.w; dst[4] = _b.x; dst[5] = _b.y; dst[6] = _b.z; dst[7] = _b.w; } while (0)
    LD8(y, Y + off); LD8(rr, Y + (size_t)NTOK * 512 + off);
#pragma unroll
    for (int j = 0; j < 8; ++j) y[j] += rr[j];
    LD8H(rr, R + off); LD8H(kr, KR + off); LD8H(vv, VV + off); LD8H(a0, AA + off); LD8H(a1, AA + (size_t)NTOK * 512 + off); LD8H(gg, G + off);
    LD8(ka, k_a + c); LD8(rk, r_k + c); LD8(lg, lng + c); LD8(lb, lnb + c);
#undef LD8
#undef LD8H
    float s = 0.f, d0 = 0.f, d1 = 0.f;
#pragma unroll
    for (int j = 0; j < 8; ++j) { s += y[j]; const float q = rr[j] * kr[j] * rk[j]; d0 += q * (1.f + (a0[j] - 1.f) * ka[j]); d1 += q * (1.f + (a1[j] - 1.f) * ka[j]); }
    float bd = d0 + d1;
    s += __shfl_xor(s, 1); s += __shfl_xor(s, 2); s += __shfl_xor(s, 4);
    bd += __shfl_xor(bd, 1); bd += __shfl_xor(bd, 2); bd += __shfl_xor(bd, 4);
    const float mu = s * (1.f / 64.f);
    float q2 = 0.f;
#pragma unroll
    for (int j = 0; j < 8; ++j) { y[j] -= mu; q2 += y[j] * y[j]; }
    q2 += __shfl_xor(q2, 1); q2 += __shfl_xor(q2, 2); q2 += __shfl_xor(q2, 4);
    const float rs = rsqrtf(q2 * (1.f / 64.f) + GN_EPS);
    float o[8];
#pragma unroll
    for (int j = 0; j < 8; ++j) o[j] = (y[j] * rs * lg[j] + lb[j] + bd * vv[j]) * gg[j];
    *(u32x4*)(MIX + (size_t)r * D + 512 + c) = (u32x4){pk2(o[0], o[1]), pk2(o[2], o[3]), pk2(o[4], o[5]), pk2(o[6], o[7])};
}

DI void act_fix(KP p, int idx) {
    const float* EDGE = (const float*)(p->ws + WS_EDGE); bf16_t* ACT = (bf16_t*)(p->ws + WS_ACT); const float* wc = p->in[27];
    const int c = (idx % 352) * 8, e = (idx / 352) & 1, pm = 16 + idx / 704;
    const bool need = e == 0 ? (pm != 16 && pm != 24) : (pm != 23 && pm != 31);
    if (!need) return;
    const int r = pm * 256 + (e ? 255 : 0), nbpm = e ? pm + 1 : pm - 1;
    const float* nb = EDGE + ((size_t)nbpm * 2 + (1 - e)) * DFF + c;
    const float* eu = EDGE + ((size_t)pm * 2 + e) * DFF + 64 * DFF + c; const float* e3 = eu + 64 * DFF;
    const float* w = wc + (e ? 2 * DFF : 0) + c;
    float o[8];
#pragma unroll
    for (int j = 0; j < 8; ++j) o[j] = silu_f(eu[j] + w[j] * nb[j]) * e3[j];
    *(u32x4*)(ACT + (size_t)r * DFF + c) = (u32x4){pk2(o[0], o[1]), pk2(o[2], o[3]), pk2(o[4], o[5]), pk2(o[6], o[7])};
}

template <int NR>
DI void final_rows(KP p, int rbase, int rstride, int lane) {
    const float* MODb = (const float*)(p->ws + WS_MOD);
    const bf16_t* PART = (const bf16_t*)(p->ws + WS_PART); const float* nf = p->in[29];
    f32x4 v[NR][4]; u32x2 p0[NR][4], p1[NR][4];
#pragma unroll
    for (int q = 0; q < NR; ++q) { const int r = rbase + q * rstride; const f32x4* xr = (const f32x4*)(p->out + (size_t)r * D) + lane;
#pragma unroll
        for (int j = 0; j < 4; ++j) { v[q][j] = xr[64 * j]; p0[q][j] = *((const u32x2*)(PART + (size_t)r * D) + lane + 64 * j); p1[q][j] = *((const u32x2*)(PART + (size_t)(NTOK + r) * D) + lane + 64 * j); } }
    float s[NR];
#pragma unroll
    for (int q = 0; q < NR; ++q) { const int r = rbase + q * rstride; const float* MOD = MODb + midx_of(r) * 6144; s[q] = 0.f;
#pragma unroll
        for (int j = 0; j < 4; ++j) { const f32x4 gt = *((const f32x4*)(MOD + 5 * D) + lane + 64 * j); v[q][j] = v[q][j] + gt * (unpk4(p0[q][j]) + unpk4(p1[q][j]));
            s[q] += (v[q][j].x * v[q][j].x + v[q][j].y * v[q][j].y) + (v[q][j].z * v[q][j].z + v[q][j].w * v[q][j].w); } }
#pragma unroll
    for (int o = 1; o < 64; o <<= 1) {
#pragma unroll
        for (int q = 0; q < NR; ++q) s[q] += __shfl_xor(s[q], o); }
#pragma unroll
    for (int q = 0; q < NR; ++q) { const int r = rbase + q * rstride; f32x4* xr = (f32x4*)(p->out + (size_t)r * D) + lane; const float rstd = rsqrtf(s[q] * (1.f / D) + EPS);
#pragma unroll
        for (int j = 0; j < 4; ++j) xr[64 * j] = v[q][j] * rstd * *((const f32x4*)nf + lane + 64 * j); }
}

DI int lane_id() { int l; asm volatile("v_mbcnt_lo_u32_b32 %0, -1, 0\n\tv_mbcnt_hi_u32_b32 %0, -1, %0" : "=v"(l)); return l; }
#define XB_TMO      128
#define XB_XCNT(j)  (256  + 64 * (j))
#define XB_XSUB(j)  (1280 + 64 * (j))
#define XB_XGEN(j)  (2304 + 64 * (j))
#define XB_TOP      3328
#define XB_TOPGEN   3392
#define XB_SUBBAR   3520
#define XB_SPIN_CAP (1u << 18)
DI unsigned xb_ld(unsigned* p)              { return __hip_atomic_load(p, __ATOMIC_RELAXED, __HIP_MEMORY_SCOPE_AGENT); }
DI unsigned xb_add(unsigned* p, unsigned v) { return __hip_atomic_fetch_add(p, v, __ATOMIC_RELAXED, __HIP_MEMORY_SCOPE_AGENT); }
DI unsigned xb_xcc_id() { return (unsigned)__builtin_amdgcn_s_getreg((3 << 11) | 20) & 0xFu; }
#define XB_SPIN(cond, bar) do { unsigned _sp = 0; while (cond) { __builtin_amdgcn_s_sleep(1); \
    if ((++_sp & 255u) == 0u) { if (xb_ld(&(bar)[XB_TMO])) break; if (_sp > XB_SPIN_CAP) { atomicAdd(&(bar)[XB_TMO], 1u); break; } } } } while (0)
DI void xcd_barrier_complete(unsigned* bar, unsigned x, unsigned G, unsigned& nloc, unsigned& nx) {
    unsigned sum, cnt, mine, sp = 0u;
    for (;;) {
        sum = 0u; cnt = 0u; mine = 0u;
#pragma unroll
        for (unsigned j = 0; j < 16; ++j) { const unsigned c = xb_ld(&bar[XB_XCNT(j)]); sum += c; cnt += (c > 0u) ? 1u : 0u; mine = (j == x) ? c : mine; }
        if (sum == G) break;
        __builtin_amdgcn_s_sleep(1);
        if ((++sp & 255u) == 0u) { if (xb_ld(&bar[XB_TMO])) break; if (sp > XB_SPIN_CAP) { atomicAdd(&bar[XB_TMO], 1u); break; } }
    }
    nloc = mine > 0u ? mine : 1u; nx = cnt > 0u ? cnt : 1u;
}
DI void grid_bar(unsigned* bar, volatile LAS unsigned* st, unsigned G, int wave_s) {
    asm volatile("s_waitcnt vmcnt(0)" ::: "memory");
    __syncthreads();
    int t = wave_s * 64 + lane_id(); asm volatile("" : "+v"(t));
    if (t == 0) {
        __builtin_amdgcn_s_waitcnt(0);
        const unsigned x = xb_xcc_id();
        unsigned nloc = st[0], nx = st[1];
        if (nloc == 0u) { xcd_barrier_complete(bar, x, G, nloc, nx); st[0] = nloc; st[1] = nx; }
        const unsigned old = xb_add(&bar[XB_XSUB(x)], 1u);
        const unsigned gen = old / nloc;
        if (old + 1u == (gen + 1u) * nloc) {
            __builtin_amdgcn_fence(__ATOMIC_RELEASE, "agent");
            asm volatile("s_waitcnt vmcnt(0)" ::: "memory");
            const unsigned og = xb_add(&bar[XB_TOP], 1u);
            const unsigned tg = og / nx;
            if (og + 1u == (tg + 1u) * nx) xb_add(&bar[XB_TOPGEN], 1u);
            else XB_SPIN(xb_ld(&bar[XB_TOPGEN]) == tg, bar);
            __builtin_amdgcn_fence(__ATOMIC_ACQUIRE, "agent");
            xb_add(&bar[XB_XGEN(x)], 1u);
            asm volatile("s_waitcnt vmcnt(0)" ::: "memory");
        } else {
            XB_SPIN(xb_ld(&bar[XB_XGEN(x)]) == gen, bar);
            __builtin_amdgcn_fence(__ATOMIC_ACQUIRE, "agent");
            asm volatile("s_waitcnt vmcnt(0)" ::: "memory");
        }
    }
    __syncthreads();
}

__global__ void __launch_bounds__(512, 2) fwd_megakernel(Params kparams) {
    const KP kp0 = (KP)__builtin_amdgcn_kernarg_segment_ptr();
    extern __shared__ __attribute__((aligned(16))) unsigned char lds_raw[];
    LAS unsigned char* lds = (LAS unsigned char*)lds_raw;
    const int wave_s = __builtin_amdgcn_readfirstlane((int)threadIdx.x >> 6);
    volatile LAS unsigned* xbst = (volatile LAS unsigned*)(lds + LDS_XB);
    {
        int t0_ = wave_s * 64 + lane_id();
        if (t0_ == 0) { xbst[0] = 0u; xbst[1] = 0u; (void)xb_add((unsigned*)(kp0->ws + WS_BAR) + XB_XCNT(xb_xcc_id()), 1u); }
        __syncthreads();
    }
#define GRID_SYNC() grid_bar((unsigned*)(kp0->ws + WS_BAR), xbst, (unsigned)G, wave_s)
    const int G = gridDim.x, bx = blockIdx.x, NGW = G * 8, NGT = G * 512;
#define PH_VARS KP p = kp0; asm volatile("" : "+s"(p)); unsigned char* ws = p->ws; (void)ws; \
    int tid = wave_s * 64 + lane_id(); asm volatile("" : "+v"(tid)); const int lane = tid & 63, wave = wave_s, gw = bx * 8 + wave, gtid = bx * 512 + tid; (void)lane; (void)gw; (void)gtid;

    const bool defer_ffn = (G == 256);
    { PH_VARS phase0(p, lds, gw, NGW, gtid, NGT, wave, lane, defer_ffn); }
    GRID_SYNC();
    if (G > (1 << 20)) cg::this_grid().sync();
    { PH_VARS for (int r = gw; r < NTOK; r += 4 * NGW) norm_rows<0, 4>(p, r, NGW, lane, p->in[9], 0, D, 0, (bf16_t*)(ws + WS_H), nullptr); }
    GRID_SYNC();
    {
        PH_VARS
        pg8::Gemm g{(const bf16_t*)(ws + WS_H), (const bf16_t*)(ws + WS_WTIN), D, D, D};
        pg8::SchedPlain S; S.o.init(NTOK / 256, NINP / 256, G, bx);
        pg8::EpiIn E{(bf16_t*)(ws + WS_Q), (bf16_t*)(ws + WS_ZR), p->out + OUT_K, 0.125f * LOG2E};
        pg8::gemm_phase(lds, g, S, E, tid);
        if (defer_ffn && bx >= 192) ffn_transposes(p, lds, 0, (bx - 192) * 8 + wave, 64 * 8, wave, lane);
    }
    GRID_SYNC();
    {
        PH_VARS
        LAS float* rpbL = (LAS float*)lds;
        for (int i = tid; i < 8 * 465; i += 512) rpbL[i] = p->in[23][i] * LOG2E;
        __syncthreads();
        LAS unsigned char* vbuf = lds + 16384 + wave * 4608;
        LAS float* xch = (LAS float*)(lds + 65536) + (wave & 3) * 2176;
        for (int u0 = bx * 4; u0 < 1024; u0 += G * 4) {
            if (wave < 4) { attn_unit<true, 2>(p, vbuf, rpbL, u0 + wave, lane, 0, 20, xch); attn_unit<false, 0>(p, vbuf, rpbL, u0 + wave, lane, 0, 8, xch); }
            else { attn_unit<true, 1>(p, vbuf, rpbL, u0 + wave - 4, lane, 20, 32, xch); prep_rows8(p, (u0 + wave - 4) * 8, lane); }
            __syncthreads();
        }
    }
    GRID_SYNC();
    {
        PH_VARS
        int kl = 128; asm volatile("" : "+s"(kl));
        pg8::Gemm g{(const bf16_t*)(ws + WS_ALORA), (const bf16_t*)(ws + WS_WTLORA), kl, 128, 128};
        pg8::SchedLora S; S.G = G; S.c = bx;
        pg8::EpiLora E{(float*)(ws + WS_DEC), (float*)(ws + WS_AA), (float*)(ws + WS_G), p->in[13], p->in[15]};
        pg8::gemm_phase(lds, g, S, E, tid);
        if (defer_ffn && bx >= 64) ffn_transposes(p, lds, 1, (bx - 64) * 8 + wave, 192 * 8, wave, lane);
    }
    GRID_SYNC();
    {
        int nst = 2; asm volatile("" : "+s"(nst));
        const int nl = G > 64 ? 32 : 0;
        for (int st = 0; st < nst; ++st) {
            PH_VARS
            const bool lead = bx < nl;
            if (st == 0 || !lead) cs_phaseA(p, lds, tid, st ? CS_LAT : 0, CS_LAT / 2, st ? bx - nl : bx, st ? G - nl : G);
            if (st == 0) { GRID_SYNC(); continue; }
            if (!lead) {
                unsigned* sb = (unsigned*)(kp0->ws + WS_BAR) + XB_SUBBAR;
                __syncthreads();
                if (tid == 0) { __atomic_thread_fence(__ATOMIC_RELEASE); __hip_atomic_fetch_add(sb, 1u, __ATOMIC_RELAXED, __HIP_MEMORY_SCOPE_AGENT);
                    while (__hip_atomic_load(sb, __ATOMIC_RELAXED, __HIP_MEMORY_SCOPE_AGENT) < (unsigned)(G - nl)) __builtin_amdgcn_s_sleep(1);
                    __atomic_thread_fence(__ATOMIC_ACQUIRE); }
                __syncthreads();
            }
            const int tfirst = lead ? bx : (nl ? 32 + (bx - nl) : bx), tend = lead ? 32 : 288, tstride = lead ? 32 : (G - nl);
            for (int t = tfirst; t < tend; t += tstride) cs_phaseB(p, lds, t < 32 ? 1 : 0, t < 32 ? t : t - 32, tid);
        }
    }
    GRID_SYNC();
    { PH_VARS for (int r = gw; r < NTOK; r += NGW) post_row(p, r, lane); }
    GRID_SYNC();
    {
        PH_VARS
        pg8::Gemm g{(const bf16_t*)(ws + WS_MIX), (const bf16_t*)(ws + WS_WTOUT), 512, D, D};
        pg8::SchedSplit2 S; S.o.init(NTOK / 256, 8, G, bx); S.nN = 4; S.ksplit = 512;
        pg8::EpiPart E{(bf16_t*)(ws + WS_PART), 512};
        pg8::gemm_phase(lds, g, S, E, tid);
    }
    GRID_SYNC();
    { PH_VARS for (int r = gw; r < NTOK; r += 2 * NGW) norm_rows<1, 2>(p, r, NGW, lane, p->in[10], 3 * D, 4 * D, 2 * D, (bf16_t*)(ws + WS_H), p->out); }
    GRID_SYNC();
    {
        PH_VARS
        pg8::Gemm g{(const bf16_t*)(ws + WS_H), (const bf16_t*)(ws + WS_WT13), D, D, D};
        pg8::SchedPlain S; S.o.init(NTOK / 256, 2 * DFF / 256, G, bx);
        pg8::EpiFfnAct E{(bf16_t*)(ws + WS_ACT), (float*)(ws + WS_EDGE), p->in[27], lds};
        pg8::gemm_phase(lds, g, S, E, tid);
    }
    GRID_SYNC();
    { PH_VARS for (int i = gtid; i < 16 * 704; i += NGT) act_fix(p, i); }
    GRID_SYNC();
    {
        PH_VARS
        pg8::Gemm g{(const bf16_t*)(ws + WS_ACT), (const bf16_t*)(ws + WS_WT2), DFF / 2, DFF, DFF};
        pg8::SchedSplit2 S; S.o.init(NTOK / 256, 8, G, bx); S.nN = 4; S.ksplit = DFF / 2;
        pg8::EpiPart E{(bf16_t*)(ws + WS_PART), DFF / 2};
        pg8::gemm_phase(lds, g, S, E, tid);
    }
    GRID_SYNC();
    { PH_VARS for (int r = gw; r < NTOK; r += 2 * NGW) final_rows<2>(p, r, NGW, lane); }
}

extern "C" void kernel_launch(void* const* d_in, const int* in_sizes, int n_in, void* d_out, int out_size, void* d_ws, size_t ws_size, hipStream_t stream) {
    static int grid_blocks = 0;
    if (!grid_blocks) {
        int dev = 0, cus = 0, per_cu = 0;
        (void)hipGetDevice(&dev);
        (void)hipDeviceGetAttribute(&cus, hipDeviceAttributeMultiprocessorCount, dev);
        (void)hipFuncSetAttribute((const void*)fwd_megakernel, hipFuncAttributeMaxDynamicSharedMemorySize, LDS_BYTES);
        (void)hipOccupancyMaxActiveBlocksPerMultiprocessor(&per_cu, (const void*)fwd_megakernel, 512, LDS_BYTES);
        if (per_cu < 1) per_cu = 1;
        grid_blocks = cus * per_cu;
    }
    (void)hipMemsetAsync((char*)d_ws + WS_BAR, 0, 16384, stream);
    Params p{};
    for (int i = 0; i < 30; ++i) p.in[i] = (const float*)d_in[i];
    p.out = (float*)d_out; p.ws = (unsigned char*)d_ws;
    void* args[] = {&p};
    hipError_t e = hipLaunchCooperativeKernel((const void*)fwd_megakernel, dim3(grid_blocks), dim3(512), args, LDS_BYTES, stream);
    if (e != hipSuccess) fprintf(stderr, "cooperative launch failed: %s (grid %d)\n", hipGetErrorString(e), grid_blocks);
}
```

```cpp
#include <hip/hip_runtime.h>
#include <hip/hip_cooperative_groups.h>
#include <cstdio>
#include <cstdint>
namespace cg = cooperative_groups;

#define LAS __attribute__((address_space(3)))
typedef unsigned short bf16_t;
typedef short bf16x8 __attribute__((ext_vector_type(8)));
typedef short s16x4 __attribute__((ext_vector_type(4)));
typedef float f32x2 __attribute__((ext_vector_type(2)));
typedef float f32x4 __attribute__((ext_vector_type(4)));
typedef float f32x16 __attribute__((ext_vector_type(16)));
typedef unsigned u32x2 __attribute__((ext_vector_type(2)));
typedef unsigned u32x4 __attribute__((ext_vector_type(4)));
typedef __bf16 bf16x2_t __attribute__((ext_vector_type(2)));
#define DI __device__ __forceinline__

constexpr int D = 1024, NTOK = 8192, NCTX = 4096, SEQ = 256, DSEQ = 2048;
constexpr int NIN = 3456, NINP = 3584, RC = 1920, DFF = 2816;
constexpr float EPS = 1e-6f, GN_EPS = 64e-5f;
constexpr float LOG2E = 1.4426950408889634f;
constexpr size_t MiB = 1u << 20;
constexpr size_t WS_BAR = 128 * 1024, WS_MOD = 0, WS_WTIN = 1 * MiB, WS_WTOUT = 8 * MiB, WS_WT13 = 10 * MiB, WS_WT2 = 21 * MiB, WS_WTLORA = 27 * MiB,
                 WS_H = 28 * MiB, WS_Q = 44 * MiB, WS_K = 52 * MiB, WS_V = 60 * MiB, WS_R = 68 * MiB, WS_VV = 84 * MiB, WS_KK = 100 * MiB,
                 WS_KR = 116 * MiB, WS_ALORA = 132 * MiB, WS_MIX = 138 * MiB, WS_ZR = 154 * MiB, WS_DEC = 154 * MiB, WS_AA = 186 * MiB,
                 WS_G = 218 * MiB, WS_CK = 234 * MiB, WS_CV = 235 * MiB, WS_Y = 28 * MiB, WS_PART = 176 * MiB, WS_A1 = 44 * MiB,
                 WS_A3 = 88 * MiB, WS_ACT = 132 * MiB, WS_EDGE = 250 * MiB;
constexpr size_t OUT_K = (size_t)NTOK * D, OUT_V = OUT_K + (size_t)NCTX * 512, OUT_S = OUT_V + (size_t)NCTX * 512;
constexpr int LDS_BYTES = 135168 + 16;
constexpr int LDS_XB = 135168;

struct Params { const float* in[30]; float* out; unsigned char* ws; };
typedef const __attribute__((address_space(4))) Params* KP;

DI unsigned pk2(float lo, float hi) { f32x2 v = {lo, hi}; bf16x2_t b = __builtin_convertvector(v, bf16x2_t); return __builtin_bit_cast(unsigned, b); }
DI f32x4 unpk4(u32x2 w) { return (f32x4){__builtin_bit_cast(float, w.x << 16), __builtin_bit_cast(float, w.x & 0xffff0000u), __builtin_bit_cast(float, w.y << 16), __builtin_bit_cast(float, w.y & 0xffff0000u)}; }
DI f32x2 ldh2(const bf16_t* p) { const unsigned w = *(const unsigned*)p; return (f32x2){__builtin_bit_cast(float, w << 16), __builtin_bit_cast(float, w & 0xffff0000u)}; }
DI float bf2f(unsigned short u) { return __builtin_bit_cast(float, (unsigned)u << 16); }
DI float wave_sum(float v) {
#pragma unroll
    for (int o = 1; o < 64; o <<= 1) v += __shfl_xor(v, o);
    return v;
}
DI float sigmoid_f(float x) { return __builtin_amdgcn_rcpf(1.f + __builtin_amdgcn_exp2f(-1.4426950408889634f * x)); }
DI float silu_f(float x) { return x * sigmoid_f(x); }
DI float tanh_f(float x) { return 2.f * sigmoid_f(2.f * x) - 1.f; }
DI int midx_of(int r) { return r < NCTX ? 0 : 1 + ((r - NCTX) >> 11); }
DI const float* xrow_of(KP p, int r) { return r < NCTX ? p->in[0] + (size_t)r * D : p->in[1] + (size_t)(r - NCTX) * D; }

namespace pg8 {
constexpr int BM = 256, BK = 64, HALF = 128, HTB = HALF * BK * 2, NXCD = 8, WGM = 8;
__host__ __device__ __forceinline__ int lds_byte(int r, int c) { const int st = (r >> 4) * 2 + (c >> 5), rr = r & 15, cc = c & 31, ob = rr * 64 + cc * 2; return st * 1024 + (ob ^ (((ob >> 9) & 1) << 5)); }
__host__ __device__ __forceinline__ void stage_rc(int b, int& R, int& C) { const int st = b / 1024, sb = b % 1024, swz = sb ^ (((sb >> 9) & 1) << 5); R = (st >> 1) * 16 + swz / 64; C = (st & 1) * 32 + (swz % 64) / 2; }
__host__ __device__ __forceinline__ int perm32(int rho) { const int n = rho >> 4, i = rho & 15; return 8 * (i >> 2) + 4 * n + (i & 3); }
struct Unit { int pm, pn; int aoff, boff; };
struct Gemm { const bf16_t* A; const bf16_t* Bt; int K, lda, ldb; };
struct StaticOrder {
    int nM, nN, nwg, G, c;
    __device__ __forceinline__ void init(int nM_, int nN_, int G_, int c_) { nM = nM_; nN = nN_; nwg = nM * nN; G = G_; c = c_; }
    __device__ __forceinline__ bool next2(int i, int& pm, int& pn) const {
        const long L = (long)i * G + c; if (L >= nwg) return false;
        int wgid = (int)L; { const int q = nwg / NXCD, r = nwg % NXCD, xcd = wgid % NXCD, off = wgid / NXCD; wgid = (xcd < r ? xcd * (q + 1) : r * (q + 1) + (xcd - r) * q) + off; }
        const int nig = WGM * nN, gid = wgid / nig, fm = gid * WGM, gsz = (nM - fm) < WGM ? (nM - fm) : WGM;
        pm = fm + ((wgid % nig) % gsz); pn = (wgid % nig) / gsz; return true;
    }
};
struct SchedPlain { StaticOrder o; __device__ __forceinline__ bool next(int i, Unit& u) const { u.aoff = 0; u.boff = 0; return o.next2(i, u.pm, u.pn); } };
struct SchedSplit2 { StaticOrder o; int nN, ksplit;
    __device__ __forceinline__ bool next(int i, Unit& u) const { int pn2; if (!o.next2(i, u.pm, pn2)) return false; const int ks = pn2 / nN; u.pn = pn2 - ks * nN; u.aoff = ks * ksplit; u.boff = ks * ksplit; return true; } };
struct SchedLora { int G, c;
    __device__ __forceinline__ bool next(int i, Unit& u) const { const int L = i * G + c; if (L >= 320) return false; u.pm = L & 31; u.pn = L >> 5; const int g = u.pn < 4 ? 0 : (u.pn < 8 ? 1 : 2); u.aoff = g * NTOK * 128; u.boff = 0; return true; } };

template <class Epi, class Sched>
__device__ __forceinline__ void gemm_phase(LAS unsigned char* lds, const Gemm g, const Sched& S, const Epi& E, int tid) {
    asm volatile("" : "+v"(tid));
    const int wid = __builtin_amdgcn_readfirstlane(tid >> 6), lane = tid & 63, wr = wid >> 2, wc = wid & 3, fr = lane & 15, fq = lane >> 4;
    const int nt = g.K / BK;
    unsigned voffA[2], voffB[2];
#pragma unroll
    for (int i = 0; i < 2; ++i) { int R, C; stage_rc(tid * 16 + i * 8192, R, C); const int Rb = (R & ~31) + perm32(R & 31);
        voffA[i] = (unsigned)(R * g.lda + C) * 2u; voffB[i] = (unsigned)(Rb * g.ldb + C) * 2u; }
    const size_t kstep = (size_t)(BK * 2);
    const size_t hA = (size_t)HALF * g.lda * 2, hB = (size_t)HALF * g.ldb * 2;
    const unsigned ldsw = (unsigned)wid * 1024u;
    const int aoff = lds_byte(wr * 64 + fr, fq * 8), boff = lds_byte(wc * 32 + fr, fq * 8);
#define PG8_SA(b, h) (((b) * 2 + (h)) * HTB)
#define PG8_SB(b, h) ((4 + (b) * 2 + (h)) * HTB)
#define PG8_STAGE(bufoff, gbase, voff) do { _Pragma("unroll") for (int _i = 0; _i < 2; ++_i) \
        __builtin_amdgcn_global_load_lds((const unsigned*)((const char*)(gbase) + (voff)[_i]), (LAS unsigned*)(lds + (bufoff) + ldsw + _i * 8192), 16, 0, 0); } while (0)
#define PG8_LDA(dst, b, h) do { _Pragma("unroll") for (int m = 0; m < 4; ++m) _Pragma("unroll") for (int k = 0; k < 2; ++k) dst[m][k] = *(const LAS bf16x8*)(lds + PG8_SA(b, h) + aoff + m * 2048 + k * 1024); } while (0)
#define PG8_LDB(dst, b, h) do { _Pragma("unroll") for (int n = 0; n < 2; ++n) _Pragma("unroll") for (int k = 0; k < 2; ++k) dst[n][k] = *(const LAS bf16x8*)(lds + PG8_SB(b, h) + boff + n * 2048 + k * 1024); } while (0)
#define PG8_MMA(ai, bj, At, Bt) do { __builtin_amdgcn_s_setprio(1); _Pragma("unroll") for (int m = 0; m < 4; ++m) _Pragma("unroll") for (int n = 0; n < 2; ++n) _Pragma("unroll") for (int k = 0; k < 2; ++k) \
        acc[ai][bj][m][n] = __builtin_amdgcn_mfma_f32_16x16x32_bf16(Bt[n][k], At[m][k], acc[ai][bj][m][n], 0, 0, 0); __builtin_amdgcn_s_setprio(0); } while (0)
#define PG8_WAIT_V(n) asm volatile("s_waitcnt vmcnt(" #n ")" ::: "memory")
#define PG8_WAIT_L(n) asm volatile("s_waitcnt lgkmcnt(" #n ")" ::: "memory")
#define PG8_BAR __builtin_amdgcn_s_barrier()
#define PG8_SCHED __builtin_amdgcn_sched_barrier(0)
#define PG8_TA(u) ((const char*)g.A + ((size_t)(u).pm * BM * g.lda + (size_t)(u).aoff) * 2)
#define PG8_TB(u) ((const char*)g.Bt + ((size_t)(u).pn * BM * g.ldb + (size_t)(u).boff) * 2)
    Unit cur, nxt; int ui = 0;
    if (!S.next(0, cur)) return;
    f32x4 acc[2][2][4][2];
#pragma unroll
    for (int a = 0; a < 2; ++a)
#pragma unroll
        for (int b = 0; b < 2; ++b)
#pragma unroll
            for (int m = 0; m < 4; ++m)
#pragma unroll
                for (int n = 0; n < 2; ++n) acc[a][b][m][n] = (f32x4){0.f, 0.f, 0.f, 0.f};
    bf16x8 At[4][2], B0[2][2], B1[2][2];
    const char* cA = PG8_TA(cur); const char* cB = PG8_TB(cur);
    PG8_STAGE(PG8_SB(0, 0), cB, voffB); PG8_STAGE(PG8_SB(0, 1), cB + hB, voffB); PG8_STAGE(PG8_SA(0, 0), cA, voffA); PG8_STAGE(PG8_SA(0, 1), cA + hA, voffA);
    if (wr == 1) PG8_BAR;
    PG8_WAIT_V(2); PG8_BAR;
    PG8_STAGE(PG8_SB(1, 0), cB + kstep, voffB); PG8_STAGE(PG8_SA(1, 0), cA + kstep, voffA); PG8_STAGE(PG8_SB(1, 1), cB + hB + kstep, voffB);
    PG8_WAIT_V(6); PG8_BAR;
    for (;;) {
        const bool has_next = S.next(ui + 1, nxt);
        const char* nA = has_next ? PG8_TA(nxt) : cA; const char* nB = has_next ? PG8_TB(nxt) : cB;
        for (int t = 0; t < nt; t += 2) {
            const bool last = (t == nt - 2);
            const char* a1 = cA + (size_t)(t + 1) * kstep;
            const char* a2 = last ? nA : cA + (size_t)(t + 2) * kstep; const char* b2 = last ? nB : cB + (size_t)(t + 2) * kstep;
            const char* a3 = a2 + kstep; const char* b3 = b2 + kstep;
            PG8_LDB(B0, 0, 0); PG8_LDB(B1, 0, 1); PG8_SCHED; PG8_LDA(At, 0, 0); PG8_STAGE(PG8_SA(1, 1), a1 + hA, voffA);
            PG8_WAIT_V(8); PG8_WAIT_L(0); PG8_BAR; PG8_MMA(0, 0, At, B0); PG8_MMA(0, 1, At, B1); PG8_BAR; PG8_SCHED;
            PG8_LDA(At, 0, 1); PG8_STAGE(PG8_SB(0, 0), b2, voffB); PG8_STAGE(PG8_SB(0, 1), b2 + hB, voffB); PG8_STAGE(PG8_SA(0, 0), a2, voffA);
            PG8_WAIT_V(8); PG8_WAIT_L(0); PG8_BAR; PG8_MMA(1, 0, At, B0); PG8_MMA(1, 1, At, B1); PG8_BAR; PG8_SCHED;
            PG8_LDB(B0, 1, 0); PG8_LDB(B1, 1, 1); PG8_SCHED; PG8_LDA(At, 1, 0); PG8_STAGE(PG8_SA(0, 1), a2 + hA, voffA);
            PG8_WAIT_V(8); PG8_WAIT_L(0); PG8_BAR; PG8_MMA(0, 0, At, B0); PG8_MMA(0, 1, At, B1); PG8_BAR; PG8_SCHED;
            PG8_LDA(At, 1, 1); PG8_STAGE(PG8_SB(1, 0), b3, voffB); PG8_STAGE(PG8_SB(1, 1), b3 + hB, voffB); PG8_STAGE(PG8_SA(1, 0), a3, voffA);
            PG8_WAIT_V(8); PG8_WAIT_L(0); PG8_BAR; PG8_MMA(1, 0, At, B0); PG8_MMA(1, 1, At, B1); PG8_BAR; PG8_SCHED;
        }
        E(acc, cur, wr, wc, fr, fq);
        if (!has_next) break;
#pragma unroll
        for (int a = 0; a < 2; ++a)
#pragma unroll
            for (int b = 0; b < 2; ++b)
#pragma unroll
                for (int m = 0; m < 4; ++m)
#pragma unroll
                    for (int n = 0; n < 2; ++n) acc[a][b][m][n] = (f32x4){0.f, 0.f, 0.f, 0.f};
        cur = nxt; cA = nA; cB = nB; ++ui;
    }
    PG8_WAIT_V(0);
    if (wr == 0) PG8_BAR;
    PG8_BAR;
#undef PG8_SA
#undef PG8_SB
#undef PG8_STAGE
#undef PG8_LDA
#undef PG8_LDB
#undef PG8_MMA
#undef PG8_WAIT_V
#undef PG8_WAIT_L
#undef PG8_BAR
#undef PG8_SCHED
#undef PG8_TA
#undef PG8_TB
}

struct EpiIn {
    bf16_t *Q; bf16_t* ZR; float* outK; float qscale;
    __device__ __forceinline__ void operator()(const f32x4 (&acc)[2][2][4][2], const Unit& u, int wr, int wc, int fr, int fq) const {
#pragma unroll
        for (int bj = 0; bj < 2; ++bj) {
            const int c0 = u.pn * BM + bj * HALF + wc * 32 + 8 * fq;
            if (c0 >= NIN) continue;
#pragma unroll
            for (int ai = 0; ai < 2; ++ai)
#pragma unroll
                for (int m = 0; m < 4; ++m) {
                    int r = u.pm * BM + ai * HALF + wr * 64 + m * 16 + fr; asm volatile("" : "+v"(r));
                    f32x4 v0 = acc[ai][bj][m][0], v1 = acc[ai][bj][m][1];
                    if (c0 < 1536) {
                        const int seg = c0 >> 9, cc = c0 & 511;
                        if (seg == 0) { v0 = v0 * qscale; v1 = v1 * qscale; }
                        else if (r < NCTX) { float* o = outK + (size_t)(seg - 1) * ((size_t)NCTX * 512) + (size_t)r * 512 + cc; *(f32x4*)o = v0; *(f32x4*)(o + 4) = v1; }
                        bf16_t* dst = Q + (size_t)seg * ((size_t)NTOK * 512) + (size_t)r * 512 + cc;
                        u32x4 w; w.x = pk2(v0[0], v0[1]); w.y = pk2(v0[2], v0[3]); w.z = pk2(v1[0], v1[1]); w.w = pk2(v1[2], v1[3]);
                        *(u32x4*)dst = w;
                    } else {
                        u32x4 w; w.x = pk2(v0[0], v0[1]); w.y = pk2(v0[2], v0[3]); w.z = pk2(v1[0], v1[1]); w.w = pk2(v1[2], v1[3]);
                        *(u32x4*)(ZR + (size_t)r * RC + (c0 - 1536)) = w;
                    }
                }
        }
    }
};
DI float decay1(float x) { return __expf(-0.60653065971f * sigmoid_f(x)); }
struct EpiLora {
    float *DEC, *AA, *G; const float *w0, *a0;
    __device__ __forceinline__ void operator()(const f32x4 (&acc)[2][2][4][2], const Unit& u, int wr, int wc, int fr, int fq) const {
#pragma unroll
        for (int bj = 0; bj < 2; ++bj) {
            const int c0 = u.pn * BM + bj * HALF + wc * 32 + 8 * fq;
            const int grp = c0 >> 10, cg = c0 & 1023, dir = cg >> 9, cc = cg & 511;
            const float* bp = (grp == 0 ? w0 : a0) + dir * 512 + cc;
            float* ob = DEC + (size_t)dir * NTOK * 512 + cc;
            bf16_t* obh = grp == 2 ? (bf16_t*)G + cc : (bf16_t*)AA + (size_t)dir * NTOK * 512 + cc;
#pragma unroll
            for (int ai = 0; ai < 2; ++ai)
#pragma unroll
                for (int m = 0; m < 4; ++m) {
                    int r = u.pm * BM + ai * HALF + wr * 64 + m * 16 + fr; asm volatile("" : "+v"(r));
                    f32x4 v0 = acc[ai][bj][m][0], v1 = acc[ai][bj][m][1];
                    if (grp < 2) { const float* bq = bp; asm volatile("" : "+v"(bq)); v0 += *(const f32x4*)bq; v1 += *(const f32x4*)(bq + 4); }
                    if (grp == 0) { v0.x = decay1(v0.x); v0.y = decay1(v0.y); v0.z = decay1(v0.z); v0.w = decay1(v0.w); v1.x = decay1(v1.x); v1.y = decay1(v1.y); v1.z = decay1(v1.z); v1.w = decay1(v1.w); }
                    else if (grp == 1) { v0.x = sigmoid_f(v0.x); v0.y = sigmoid_f(v0.y); v0.z = sigmoid_f(v0.z); v0.w = sigmoid_f(v0.w); v1.x = sigmoid_f(v1.x); v1.y = sigmoid_f(v1.y); v1.z = sigmoid_f(v1.z); v1.w = sigmoid_f(v1.w); }
                    if (grp == 0) { float* o = ob + (size_t)r * 512; *(f32x4*)o = v0; *(f32x4*)(o + 4) = v1; }
                    else { u32x4 w; w.x = pk2(v0[0], v0[1]); w.y = pk2(v0[2], v0[3]); w.z = pk2(v1[0], v1[1]); w.w = pk2(v1[2], v1[3]); *(u32x4*)(obh + (size_t)r * 512) = w; }
                }
        }
    }
};
struct EpiPart {
    bf16_t* P; int ksplit;
    __device__ __forceinline__ void operator()(const f32x4 (&acc)[2][2][4][2], const Unit& u, int wr, int wc, int fr, int fq) const {
        bf16_t* base = P + (u.aoff ? (size_t)NTOK * D : 0);
#pragma unroll
        for (int bj = 0; bj < 2; ++bj) {
            const int c0 = u.pn * BM + bj * HALF + wc * 32 + 8 * fq;
#pragma unroll
            for (int ai = 0; ai < 2; ++ai)
#pragma unroll
                for (int m = 0; m < 4; ++m) {
                    int r = u.pm * BM + ai * HALF + wr * 64 + m * 16 + fr; asm volatile("" : "+v"(r));
                    const f32x4 v0 = acc[ai][bj][m][0], v1 = acc[ai][bj][m][1];
                    u32x4 w; w.x = pk2(v0[0], v0[1]); w.y = pk2(v0[2], v0[3]); w.z = pk2(v1[0], v1[1]); w.w = pk2(v1[2], v1[3]);
                    *(u32x4*)(base + (size_t)r * D + c0) = w;
                }
        }
    }
};
template <int CTRL> DI float dppf(float x) { return __builtin_bit_cast(float, __builtin_amdgcn_mov_dpp(__builtin_bit_cast(int, x), CTRL, 0xf, 0xf, true)); }
struct EpiFfnAct {
    bf16_t* ACT; float* EDGE; const float* wcv; LAS unsigned char* ldsb;
    __device__ __forceinline__ void operator()(const f32x4 (&acc)[2][2][4][2], const Unit& u, int wr, int wc, int fr, int fq) const {
        LAS float* HL = (LAS float*)(ldsb + 131072);
        const int colh = wc * 32 + 8 * fq;
#pragma unroll
        for (int ai = 0; ai < 2; ++ai) { const int g = ai * 2 + wr;
            if (fr == 0) { *(LAS f32x4*)(HL + (g * 2 + 0) * 128 + colh) = acc[ai][0][0][0]; *(LAS f32x4*)(HL + (g * 2 + 0) * 128 + colh + 4) = acc[ai][0][0][1]; }
            if (fr == 15) { *(LAS f32x4*)(HL + (g * 2 + 1) * 128 + colh) = acc[ai][0][3][0]; *(LAS f32x4*)(HL + (g * 2 + 1) * 128 + colh + 4) = acc[ai][0][3][1]; } }
        asm volatile("s_waitcnt lgkmcnt(0)" ::: "memory");
        __builtin_amdgcn_s_barrier(); __builtin_amdgcn_s_barrier();
        asm volatile("" ::: "memory");
        const int cf = u.pn * HALF + colh;
        const f32x4 zero = {0.f, 0.f, 0.f, 0.f};
        const bool lat = u.pm >= 16;
#pragma unroll
        for (int ai = 0; ai < 2; ++ai) {
            const int g = ai * 2 + wr;
            f32x4 hp[2], hn[2];
            hp[0] = g > 0 ? *(const LAS f32x4*)(HL + ((g - 1) * 2 + 1) * 128 + colh) : zero; hp[1] = g > 0 ? *(const LAS f32x4*)(HL + ((g - 1) * 2 + 1) * 128 + colh + 4) : zero;
            hn[0] = g < 3 ? *(const LAS f32x4*)(HL + ((g + 1) * 2 + 0) * 128 + colh) : zero; hn[1] = g < 3 ? *(const LAS f32x4*)(HL + ((g + 1) * 2 + 0) * 128 + colh + 4) : zero;
#pragma unroll
            for (int m = 0; m < 4; ++m) {
                int r = u.pm * BM + ai * HALF + wr * 64 + m * 16 + fr; asm volatile("" : "+v"(r));
                const float* wq_ = wcv + cf; asm volatile("" : "+v"(wq_));
                f32x4 uu[2], av[2];
#pragma unroll
                for (int n = 0; n < 2; ++n) {
                    const f32x4 cur = acc[ai][0][m][n];
                    f32x4 pv, nx;
#pragma unroll
                    for (int j = 0; j < 4; ++j) {
                        if (m > 0) pv[j] = dppf<0x121>(fr == 15 ? acc[ai][0][m > 0 ? m - 1 : 0][n][j] : cur[j]);
                        else { const float a = dppf<0x121>(cur[j]); pv[j] = fr == 0 ? hp[n][j] : a; }
                        if (m < 3) nx[j] = dppf<0x12F>(fr == 0 ? acc[ai][0][m < 3 ? m + 1 : 3][n][j] : cur[j]);
                        else { const float c = dppf<0x12F>(cur[j]); nx[j] = fr == 15 ? hn[n][j] : c; }
                    }
                    const f32x4 w0 = *(const f32x4*)(wq_ + 4 * n), w1 = *(const f32x4*)(wq_ + DFF + 4 * n), w2 = *(const f32x4*)(wq_ + 2 * DFF + 4 * n);
                    uu[n] = pv * w0 + cur * w1 + nx * w2;
                    const f32x4 a3 = acc[ai][1][m][n];
                    av[n] = (f32x4){silu_f(uu[n].x) * a3.x, silu_f(uu[n].y) * a3.y, silu_f(uu[n].z) * a3.z, silu_f(uu[n].w) * a3.w};
                }
                u32x4 w; w.x = pk2(av[0][0], av[0][1]); w.y = pk2(av[0][2], av[0][3]); w.z = pk2(av[1][0], av[1][1]); w.w = pk2(av[1][2], av[1][3]);
                *(u32x4*)(ACT + (size_t)r * DFF + cf) = w;
                if (lat && ((ai == 0 && m == 0) || (ai == 1 && m == 3))) {
                    const int e = ai;
                    const bool mine = e == 0 ? (wr == 0 && fr == 0) : (wr == 1 && fr == 15);
                    if (mine) {
                        float* eb = EDGE + ((size_t)u.pm * 2 + e) * DFF + cf;
                        *(f32x4*)(eb) = acc[ai][0][m][0]; *(f32x4*)(eb + 4) = acc[ai][0][m][1];
                        *(f32x4*)(eb + 64 * DFF) = uu[0]; *(f32x4*)(eb + 64 * DFF + 4) = uu[1];
                        *(f32x4*)(eb + 128 * DFF) = acc[ai][1][m][0]; *(f32x4*)(eb + 128 * DFF + 4) = acc[ai][1][m][1];
                    }
                }
            }
        }
    }
};
}

template <int MODE>
DI void transpose_item(const float* W, int K, int N, bf16_t* WT, LAS float* scr, int item, int lane) {
    const int nblk = N / 32, kb = item / nblk, nb = item % nblk, k0 = 64 * kb, n0 = 32 * nb;
#pragma unroll 8
    for (int i = 0; i < 32; ++i) { const int kk = 2 * i + (lane >> 5); scr[kk * 33 + (lane & 31)] = W[(size_t)(k0 + kk) * N + n0 + (lane & 31)]; }
    asm volatile("s_waitcnt lgkmcnt(0)" ::: "memory");
    const int c = lane & 7;
#pragma unroll
    for (int j = 0; j < 4; ++j) { const int n = (lane >> 3) + 8 * j; const LAS float* s = scr + (8 * c) * 33 + n;
        u32x4 o; o.x = pk2(s[0 * 33], s[1 * 33]); o.y = pk2(s[2 * 33], s[3 * 33]); o.z = pk2(s[4 * 33], s[5 * 33]); o.w = pk2(s[6 * 33], s[7 * 33]);
        const int nn = n0 + n; const int drow = MODE == 0 ? nn : ((nn >> 7) * 256 + (nn & 127) + (MODE == 2 ? 128 : 0));
        *(u32x4*)(WT + (size_t)drow * K + k0 + 8 * c) = o; }
    asm volatile("s_waitcnt lgkmcnt(0)" ::: "memory");
}

DI void phase0(KP p, LAS unsigned char* lds, int gw, int NGW, int gtid, int NGT, int wave, int lane, bool defer_ffn) {
    unsigned char* ws = p->ws;
    {
        float* MOD = (float*)(ws + WS_MOD);
        const float* w_ada = p->in[7]; const float* b_ada = p->in[8]; const float* c_lat = p->in[5]; const float* c_ctx = p->in[6];
        LAS float* red = (LAS float*)(lds + 8 * 8448);
        const int tid = wave * 64 + lane, cgp = lane & 15, kr = lane >> 4;
        for (int nb = blockIdx.x; nb < 96; nb += gridDim.x) {
            f32x4 a0 = {0, 0, 0, 0}, a1 = a0, a2 = a0;
#pragma unroll 8
            for (int i = 0; i < 32; ++i) {
                const int k = wave * 128 + 4 * i + kr;
                const f32x4 w = *(const f32x4*)(w_ada + (size_t)k * 6144 + nb * 64 + 4 * cgp);
                a0 += w * silu_f(c_ctx[k]); a1 += w * silu_f(c_lat[k]); a2 += w * silu_f(c_lat[D + k]);
            }
#pragma unroll
            for (int j = 0; j < 4; ++j) {
                a0[j] += __shfl_xor(a0[j], 16); a0[j] += __shfl_xor(a0[j], 32);
                a1[j] += __shfl_xor(a1[j], 16); a1[j] += __shfl_xor(a1[j], 32);
                a2[j] += __shfl_xor(a2[j], 16); a2[j] += __shfl_xor(a2[j], 32);
            }
            if (kr == 0) { *(LAS f32x4*)(red + (wave * 3 + 0) * 64 + 4 * cgp) = a0; *(LAS f32x4*)(red + (wave * 3 + 1) * 64 + 4 * cgp) = a1; *(LAS f32x4*)(red + (wave * 3 + 2) * 64 + 4 * cgp) = a2; }
            __syncthreads();
            if (tid < 192) {
                const int i = tid >> 6, c = tid & 63; float s = b_ada[nb * 64 + c];
#pragma unroll
                for (int w = 0; w < 8; ++w) s += red[(w * 3 + i) * 64 + c];
                MOD[i * 6144 + nb * 64 + c] = s;
            }
            __syncthreads();
        }
    }
    {
        LAS float* scr = (LAS float*)(lds + wave * 8448);
        constexpr int I_IN = 16 * 108, I_OUT = 16 * 32, I_F = 16 * 88, I_2 = 44 * 32, NIT = I_IN + I_OUT + 2 * I_F + I_2;
        const int nit = defer_ffn ? I_IN + I_OUT : NIT;
        for (int it = gw; it < nit; it += NGW) {
            int r = it;
            if (r < I_IN) { transpose_item<0>(p->in[11], D, NIN, (bf16_t*)(ws + WS_WTIN), scr, r, lane); continue; } r -= I_IN;
            if (r < I_OUT) { transpose_item<0>(p->in[24], D, D, (bf16_t*)(ws + WS_WTOUT), scr, r, lane); continue; } r -= I_OUT;
            if (r < I_F) { transpose_item<1>(p->in[25], D, DFF, (bf16_t*)(ws + WS_WT13), scr, r, lane); continue; } r -= I_F;
            if (r < I_F) { transpose_item<2>(p->in[26], D, DFF, (bf16_t*)(ws + WS_WT13), scr, r, lane); continue; } r -= I_F;
            transpose_item<0>(p->in[28], DFF, D, (bf16_t*)(ws + WS_WT2), scr, r, lane);
        }
    }
    { u32x4* z = (u32x4*)((bf16_t*)(ws + WS_WTIN) + (size_t)NIN * D); for (int i = gtid; i < 128 * D / 8; i += NGT) z[i] = (u32x4){0, 0, 0, 0}; }
    {
        bf16_t* WL = (bf16_t*)(ws + WS_WTLORA); const float* w2 = p->in[14]; const float* a2 = p->in[16]; const float* g2 = p->in[17];
        for (int i = gtid; i < 2560 * 128; i += NGT) {
            const int n = i >> 7, k = i & 127; float v = 0.f;
            if (n < 2048) { const int grp = n >> 10, dir = (n >> 9) & 1, c = n & 511; const float* src = grp == 0 ? w2 : a2;
                if ((k >> 6) == dir) v = src[((size_t)dir * 64 + (k & 63)) * 512 + c]; }
            else v = g2[(size_t)k * 512 + (n - 2048)];
            WL[i] = (bf16_t)(pk2(v, 0.f) & 0xffffu);
        }
    }
    {
        const f32x4* ck = (const f32x4*)p->in[2]; const f32x4* cv = (const f32x4*)p->in[3]; u32x2* CK = (u32x2*)(ws + WS_CK); u32x2* CV = (u32x2*)(ws + WS_CV);
        for (int i = gtid; i < 1024 * 512 / 4; i += NGT) { const f32x4 a = ck[i], b = cv[i]; CK[i] = (u32x2){pk2(a[0], a[1]), pk2(a[2], a[3])}; CV[i] = (u32x2){pk2(b[0], b[1]), pk2(b[2], b[3])}; }
    }
}

DI void ffn_transposes(KP p, LAS unsigned char* lds, int which, int widx, int nw, int wave, int lane) {
    LAS float* scr = (LAS float*)(lds + wave * 8448);
    constexpr int I_F = 16 * 88, I_2 = 44 * 32;
    if (which == 0) { for (int it = widx; it < I_2; it += nw) transpose_item<0>(p->in[28], DFF, D, (bf16_t*)(p->ws + WS_WT2), scr, it, lane); }
    else { for (int it = widx; it < 2 * I_F; it += nw) { if (it < I_F) transpose_item<1>(p->in[25], D, DFF, (bf16_t*)(p->ws + WS_WT13), scr, it, lane);
                                                           else transpose_item<2>(p->in[26], D, DFF, (bf16_t*)(p->ws + WS_WT13), scr, it - I_F, lane); } }
}

template <int SRC, int NR>
DI void norm_rows(KP p, int rbase, int rstride, int lane, const float* normw, int sh_off, int sc_off, int gate_off, bf16_t* Hout, float* xout) {
    const float* MODb = (const float*)(p->ws + WS_MOD);
    const bf16_t* PART = (const bf16_t*)(p->ws + WS_PART);
    f32x4 v[NR][4];
#pragma unroll
    for (int q = 0; q < NR; ++q) { const f32x4* xr = (const f32x4*)xrow_of(p, rbase + q * rstride) + lane;
#pragma unroll
        for (int j = 0; j < 4; ++j) v[q][j] = xr[64 * j]; }
    if (SRC == 1) {
        u32x2 p0[NR][4], p1[NR][4];
#pragma unroll
        for (int q = 0; q < NR; ++q) { const int r = rbase + q * rstride;
#pragma unroll
            for (int j = 0; j < 4; ++j) { p0[q][j] = *((const u32x2*)(PART + (size_t)r * D) + lane + 64 * j); p1[q][j] = *((const u32x2*)(PART + (size_t)(NTOK + r) * D) + lane + 64 * j); } }
#pragma unroll
        for (int q = 0; q < NR; ++q) { const int r = rbase + q * rstride; const float* MOD = MODb + midx_of(r) * 6144;
#pragma unroll
            for (int j = 0; j < 4; ++j) { const f32x4 gt = *((const f32x4*)(MOD + gate_off) + lane + 64 * j); v[q][j] = v[q][j] + gt * (unpk4(p0[q][j]) + unpk4(p1[q][j])); } }
    }
    float s[NR];
#pragma unroll
    for (int q = 0; q < NR; ++q) { s[q] = 0.f;
#pragma unroll
        for (int j = 0; j < 4; ++j) s[q] += (v[q][j].x * v[q][j].x + v[q][j].y * v[q][j].y) + (v[q][j].z * v[q][j].z + v[q][j].w * v[q][j].w); }
#pragma unroll
    for (int o = 1; o < 64; o <<= 1) {
#pragma unroll
        for (int q = 0; q < NR; ++q) s[q] += __shfl_xor(s[q], o); }
#pragma unroll
    for (int q = 0; q < NR; ++q) {
        const int r = rbase + q * rstride; const float* MOD = MODb + midx_of(r) * 6144;
        const float rstd = rsqrtf(s[q] * (1.f / D) + EPS);
        u32x2* o = (u32x2*)(Hout + (size_t)r * D) + lane;
#pragma unroll
        for (int j = 0; j < 4; ++j) {
            if (SRC == 1) *((f32x4*)(xout + (size_t)r * D) + lane + 64 * j) = v[q][j];
            const f32x4 g = *((const f32x4*)normw + lane + 64 * j), sc = *((const f32x4*)(MOD + sc_off) + lane + 64 * j), sh = *((const f32x4*)(MOD + sh_off) + lane + 64 * j);
            const f32x4 h = v[q][j] * rstd * g * (sc + 1.f) + sh;
            o[64 * j] = (u32x2){pk2(h.x, h.y), pk2(h.z, h.w)};
        }
    }
}

#define MFMA32(a, b, c) __builtin_amdgcn_mfma_f32_32x32x16_bf16((a), (b), (c), 0, 0, 0)
DI int crow(int reg, int h) { return (reg & 3) + 8 * (reg >> 2) + 4 * h; }
typedef short v4i16_t __attribute__((ext_vector_type(4)));
DI s16x4 vtr(const LAS unsigned char* p) { return __builtin_bit_cast(s16x4, __builtin_amdgcn_ds_read_tr16_b64_v4i16((LAS v4i16_t*)p)); }

template <bool LATENT, int MODE>
DI void attn_unit(KP p, LAS unsigned char* vbuf, const LAS float* rpbL, int unit, int lane, int t0, int t1, LAS float* xch) {
    const bf16_t* Q = (const bf16_t*)(p->ws + WS_Q); const bf16_t* Kb = (const bf16_t*)(p->ws + WS_K); const bf16_t* Vb = (const bf16_t*)(p->ws + WS_V);
    const bf16_t* CK = (const bf16_t*)(p->ws + WS_CK); const bf16_t* CV = (const bf16_t*)(p->ws + WS_CV);
    bf16_t* MIX = (bf16_t*)(p->ws + WS_MIX);
    const int r = lane & 31, hh = lane >> 5;
    int head, qrow0, b, gi = 0, w0 = 0, si = 0, ntile;
    if (LATENT) { head = unit & 7; const int t = unit >> 3; w0 = (t & 1) * 32; gi = (t >> 1) & 31; b = t >> 6; qrow0 = NCTX + b * DSEQ + gi * 64 + w0; si = min(max(gi - 4, 0), 24); ntile = 32; }
    else { head = unit & 7; const int t = unit >> 3; const int qb = t & 7; b = t >> 3; qrow0 = b * SEQ + qb * 32; ntile = 8; }
    bf16x8 qf[4];
#pragma unroll
    for (int s = 0; s < 4; ++s) qf[s] = *(const bf16x8*)(Q + (size_t)(qrow0 + r) * 512 + head * 64 + 16 * s + 8 * hh);
    auto tile_ptrs = [&](int t, const bf16_t*& kp, const bf16_t*& vp) {
        if (LATENT) {
            if (t < 16) { const size_t row = (size_t)b * 512 + t * 32; kp = CK + row * 512; vp = CV + row * 512; }
            else { const int lt = t - 16; const size_t row = (size_t)NCTX + b * DSEQ + (si + (lt >> 1)) * 64 + (((lt & 1) * 32) ^ w0); kp = Kb + row * 512; vp = Vb + row * 512; }
        } else { const size_t row = (size_t)b * SEQ + t * 32; kp = Kb + row * 512; vp = Vb + row * 512; }
    };
    bf16x8 kf[4], kn[4]; u32x4 vn[4];
    {
        const bf16_t *kp, *vp; tile_ptrs(t0, kp, vp);
#pragma unroll
        for (int s = 0; s < 4; ++s) kf[s] = *(const bf16x8*)(kp + (size_t)r * 512 + head * 64 + 16 * s + 8 * hh);
#pragma unroll
        for (int i = 0; i < 4; ++i) { const int c = lane + 64 * i; vn[i] = *(const u32x4*)(vp + (size_t)(c >> 3) * 512 + head * 64 + (c & 7) * 8); }
#pragma unroll
        for (int i = 0; i < 4; ++i) { const int c = lane + 64 * i; *(LAS u32x4*)(vbuf + (c >> 3) * 144 + (c & 7) * 16) = vn[i]; }
    }
    f32x16 o0, o1;
#pragma unroll
    for (int i = 0; i < 16; ++i) { o0[i] = 0.f; o1[i] = 0.f; }
    float mrun = -1e30f, lrun = 0.f;
    const int i16 = lane & 15, tq = i16 >> 2, tp = i16 & 3, blk = (lane >> 4) & 1;
    const LAS unsigned char* vtbase = vbuf + (4 * hh + tq) * 144 + (16 * blk) * 2 + 8 * tp;
    const int wq = w0 + r;
    const int cs = min(max(wq - 8, 0), 48);
    for (int t = t0; t < t1; ++t) {
        const bool more = (t + 1 < t1);
        if (more) {
            const bf16_t *kp, *vp; tile_ptrs(t + 1, kp, vp);
#pragma unroll
            for (int s = 0; s < 4; ++s) kn[s] = *(const bf16x8*)(kp + (size_t)r * 512 + head * 64 + 16 * s + 8 * hh);
#pragma unroll
            for (int i = 0; i < 4; ++i) { const int c = lane + 64 * i; vn[i] = *(const u32x4*)(vp + (size_t)(c >> 3) * 512 + head * 64 + (c & 7) * 8); }
        }
        f32x16 st;
#pragma unroll
        for (int i = 0; i < 16; ++i) st[i] = 0.f;
#pragma unroll
        for (int s = 0; s < 4; ++s) st = MFMA32(kf[s], qf[s], st);
        if (LATENT && t >= 16) {
            const int lt = t - 16, a = lt >> 1, c0 = ((lt & 1) * 32) ^ w0;
            const int row_off = si + a - gi + 7;
            const int d0 = c0 + 4 * hh - cs;
            const LAS float* bp = rpbL + head * 465 + row_off * 31 + (c0 + 4 * hh - wq + 15);
#pragma unroll
            for (int i = 0; i < 16; ++i) {
                const int ci = (i & 3) + 8 * (i >> 2);
                const bool valid = (unsigned)(d0 + ci) < 16u;
                const float bias = valid ? bp[ci] : 0.f;
                st[i] = valid ? st[i] + bias : -INFINITY;
            }
        }
        float tmax = st[0];
#pragma unroll
        for (int i = 1; i < 16; ++i) tmax = fmaxf(tmax, st[i]);
        tmax = fmaxf(tmax, __shfl_xor(tmax, 32));
        const float mnew = fmaxf(mrun, tmax);
        float ps = 0.f;
#pragma unroll
        for (int i = 0; i < 16; ++i) { st[i] = __builtin_amdgcn_exp2f(st[i] - mnew); ps += st[i]; }
        if (__builtin_amdgcn_ballot_w64(tmax > mrun) != 0ull) {
            const float alpha = __builtin_amdgcn_exp2f(mrun - mnew);
            lrun *= alpha;
#pragma unroll
            for (int i = 0; i < 16; ++i) { o0[i] *= alpha; o1[i] *= alpha; }
        }
        lrun += ps; mrun = mnew;
        bf16x8 pb[2];
#pragma unroll
        for (int s = 0; s < 2; ++s) { u32x4 w; w.x = pk2(st[8 * s], st[8 * s + 1]); w.y = pk2(st[8 * s + 2], st[8 * s + 3]); w.z = pk2(st[8 * s + 4], st[8 * s + 5]); w.w = pk2(st[8 * s + 6], st[8 * s + 7]); pb[s] = __builtin_bit_cast(bf16x8, w); }
        asm volatile("s_waitcnt lgkmcnt(0)" ::: "memory");
#pragma unroll
        for (int s = 0; s < 2; ++s) {
            const LAS unsigned char* bs = vtbase + (16 * s) * 144;
            const s16x4 lo0 = vtr(bs), hi0 = vtr(bs + 8 * 144), lo1 = vtr(bs + 64), hi1 = vtr(bs + 8 * 144 + 64);
            const bf16x8 va0 = __builtin_shufflevector(lo0, hi0, 0, 1, 2, 3, 4, 5, 6, 7), va1 = __builtin_shufflevector(lo1, hi1, 0, 1, 2, 3, 4, 5, 6, 7);
            o0 = MFMA32(va0, pb[s], o0); o1 = MFMA32(va1, pb[s], o1);
        }
        asm volatile("s_waitcnt lgkmcnt(0)" ::: "memory");
        if (more) {
#pragma unroll
            for (int i = 0; i < 4; ++i) { const int c = lane + 64 * i; *(LAS u32x4*)(vbuf + (c >> 3) * 144 + (c & 7) * 16) = vn[i]; }
#pragma unroll
            for (int s = 0; s < 4; ++s) kf[s] = kn[s];
        }
    }
    if (MODE == 1) {
#pragma unroll
        for (int i = 0; i < 16; ++i) { xch[i * 64 + lane] = o0[i]; xch[(16 + i) * 64 + lane] = o1[i]; }
        xch[32 * 64 + lane] = mrun; xch[33 * 64 + lane] = lrun;
        __syncthreads();
        return;
    }
    if (MODE == 2) {
        __syncthreads();
        const float mb = xch[32 * 64 + lane], lb = xch[33 * 64 + lane];
        const float mm = fmaxf(mrun, mb), fa = exp2f(mrun - mm), fb = exp2f(mb - mm);
#pragma unroll
        for (int i = 0; i < 16; ++i) { o0[i] = o0[i] * fa + xch[i * 64 + lane] * fb; o1[i] = o1[i] * fa + xch[(16 + i) * 64 + lane] * fb; }
        lrun = lrun * fa + lb * fb;
    }
    const float ltot = lrun + __shfl_xor(lrun, 32);
    const float inv = 1.f / ltot;
    bf16_t* orow = MIX + (size_t)(qrow0 + r) * D + head * 64;
#pragma unroll
    for (int g4 = 0; g4 < 4; ++g4) {
        const int d = 8 * g4 + 4 * hh;
        *(u32x2*)(orow + d) = (u32x2){pk2(o0[4 * g4] * inv, o0[4 * g4 + 1] * inv), pk2(o0[4 * g4 + 2] * inv, o0[4 * g4 + 3] * inv)};
        *(u32x2*)(orow + 32 + d) = (u32x2){pk2(o1[4 * g4] * inv, o1[4 * g4 + 1] * inv), pk2(o1[4 * g4 + 2] * inv, o1[4 * g4 + 3] * inv)};
    }
}

DI void prep_rows8(KP p, int r0, int lane) {
    const bf16_t* ZR = (const bf16_t*)(p->ws + WS_ZR); const float* wts = p->in[12]; const float* k_k = p->in[18];
    bf16_t* R = (bf16_t*)(p->ws + WS_R); bf16_t* KR = (bf16_t*)(p->ws + WS_KR); bf16_t* VV = (bf16_t*)(p->ws + WS_VV); bf16_t* KK = (bf16_t*)(p->ws + WS_KK);
    bf16_t* AL = (bf16_t*)(p->ws + WS_ALORA);
    const int t0 = r0 < NCTX ? (r0 & 255) : ((r0 - NCTX) & 2047); const int T = r0 < NCTX ? SEQ : DSEQ;
    const bool hp = t0 > 0, hn = t0 + 8 < T;
    const bf16_t* zb = ZR + (size_t)(r0 - 1) * RC;
    const f32x4 zero = {0, 0, 0, 0};
#pragma unroll 1
    for (int seg = 0; seg < 3; ++seg) {
        const int c = seg * 512 + lane * 8;
        f32x4 z[10][2];
#pragma unroll
        for (int i = 0; i < 10; ++i) { const bool ok = (i > 0 || hp) && (i < 9 || hn);
            if (ok) { const u32x4 w = *(const u32x4*)(zb + (size_t)i * RC + c); z[i][0] = unpk4((u32x2){w.x, w.y}); z[i][1] = unpk4((u32x2){w.z, w.w}); } else { z[i][0] = zero; z[i][1] = zero; } }
        const f32x4 wa0 = *(const f32x4*)(wts + c), wa1 = *(const f32x4*)(wts + c + 4), wb0 = *(const f32x4*)(wts + RC + c), wb1 = *(const f32x4*)(wts + RC + c + 4),
                    wc0 = *(const f32x4*)(wts + 2 * RC + c), wc1 = *(const f32x4*)(wts + 2 * RC + c + 4);
        const f32x4 k0 = *(const f32x4*)(k_k + lane * 8), k1 = *(const f32x4*)(k_k + lane * 8 + 4);
        bf16_t* dstb = (seg == 0 ? R : (seg == 1 ? KR : VV)) + (size_t)r0 * 512 + lane * 8;
#pragma unroll
        for (int i = 0; i < 8; ++i) {
            const f32x4 u0 = z[i][0] * wa0 + z[i + 1][0] * wb0 + z[i + 2][0] * wc0, u1 = z[i][1] * wa1 + z[i + 1][1] * wb1 + z[i + 2][1] * wc1;
            *(u32x4*)(dstb + (size_t)i * 512) = (u32x4){pk2(u0.x, u0.y), pk2(u0.z, u0.w), pk2(u1.x, u1.y), pk2(u1.z, u1.w)};
            if (seg == 1) {
                const f32x4 a = u0 * k0, bq = u1 * k1;
                float sq = (a.x * a.x + a.y * a.y) + (a.z * a.z + a.w * a.w) + (bq.x * bq.x + bq.y * bq.y) + (bq.z * bq.z + bq.w * bq.w);
                sq += __shfl_xor(sq, 1); sq += __shfl_xor(sq, 2); sq += __shfl_xor(sq, 4);
                const float rn = rsqrtf(sq + 1e-12f);
                const f32x4 ka_ = a * rn, kb_ = bq * rn; *(u32x4*)(KK + (size_t)(r0 + i) * 512 + lane * 8) = (u32x4){pk2(ka_.x, ka_.y), pk2(ka_.z, ka_.w), pk2(kb_.x, kb_.y), pk2(kb_.z, kb_.w)};
            }
        }
    }
    {
        const int cl = lane * 6, cc = 1536 + cl;
        const f32x2 zero2 = {0, 0};
        f32x2 z[10][3];
#pragma unroll
        for (int i = 0; i < 10; ++i) { const bool ok = (i > 0 || hp) && (i < 9 || hn);
#pragma unroll
            for (int q = 0; q < 3; ++q) { if (ok) { const unsigned w = *(const unsigned*)(zb + (size_t)i * RC + cc + 2 * q); z[i][q] = (f32x2){__builtin_bit_cast(float, w << 16), __builtin_bit_cast(float, w & 0xffff0000u)}; } else z[i][q] = zero2; } }
#pragma unroll
        for (int q = 0; q < 3; ++q) {
            const f32x2 wa = *(const f32x2*)(wts + cc + 2 * q), wb = *(const f32x2*)(wts + RC + cc + 2 * q), wcq = *(const f32x2*)(wts + 2 * RC + cc + 2 * q);
            const int cq = cl + 2 * q, grp = cq >> 7, k = cq & 127;
#pragma unroll
            for (int i = 0; i < 8; ++i) {
                f32x2 u = z[i][q] * wa + z[i + 1][q] * wb + z[i + 2][q] * wcq;
                if (grp == 0) { u.x = tanh_f(u.x); u.y = tanh_f(u.y); }
                else if (grp == 2) { u.x = sigmoid_f(u.x); u.y = sigmoid_f(u.y); }
                *(unsigned*)(AL + ((size_t)grp * NTOK + r0 + i) * 128 + k) = pk2(u.x, u.y);
            }
        }
    }
}

template <int CTRL> DI float dppf_(float x) { return __builtin_bit_cast(float, __builtin_amdgcn_mov_dpp(__builtin_bit_cast(int, x), CTRL, 0xf, 0xf, true)); }
template <int CTRL> DI float dpp_add(float x) { const int y = __builtin_amdgcn_mov_dpp(__builtin_bit_cast(int, x), CTRL, 0xf, 0xf, true); return x + __builtin_bit_cast(float, y); }
DI float red16(float x) { x = dpp_add<0xB1>(x); x = dpp_add<0x4E>(x); x = dpp_add<0x141>(x); x = dpp_add<0x140>(x); return x; }

constexpr int TC = 16;
DI float tred4(float q0, float q1, float q2, float q3, bool b0, bool b1) {
    const float ka = b0 ? q2 : q0, kb = b0 ? q3 : q1, sa = b0 ? q0 : q2, sb = b0 ? q1 : q3;
    const float a = ka + dppf_<0xB1>(sa), b = kb + dppf_<0xB1>(sb);
    float c = (b1 ? b : a) + dppf_<0x4E>(b1 ? a : b);
    c += dppf_<0x124>(c);
    c += dppf_<0x128>(c);
    return c;
}
DI f32x2 lo2(f32x4 v) { return __builtin_shufflevector(v, v, 0, 1); }
DI f32x2 hi2(f32x4 v) { return __builtin_shufflevector(v, v, 2, 3); }
struct ScanOps { f32x4 kk, rr, ww, bb, kd; float vv; };
struct ScanLd { f32x4 kk, r, dec, aa, kr, v; };
DI void scan_item(KP p, LAS unsigned char* lds, int latent, int sc, int qr, int tid) {
    const bf16_t* KK = (const bf16_t*)(p->ws + WS_KK); const bf16_t* R = (const bf16_t*)(p->ws + WS_R); const bf16_t* KR = (const bf16_t*)(p->ws + WS_KR);
    const bf16_t* VV = (const bf16_t*)(p->ws + WS_VV); const float* k_a = p->in[19];
    float* Y = (float*)(p->ws + WS_Y);
    const int b = sc >> 4, dir = (sc >> 3) & 1, h = sc & 7;
    const int T = latent ? DSEQ : SEQ; const size_t rowbase = latent ? (size_t)NCTX + (size_t)b * DSEQ : (size_t)b * SEQ;
    const float* DEC = (const float*)(p->ws + WS_DEC) + (size_t)dir * NTOK * 512; const bf16_t* AA = (const bf16_t*)(p->ws + WS_AA) + (size_t)dir * NTOK * 512;
    float* Yd = Y + (size_t)dir * NTOK * 512;
    LAS float* buf = (LAS float*)lds;
    LAS float* vb = (LAS float*)(lds + 2 * TC * 320 * 4);
    const int wave = tid >> 6, lane = tid & 63;
    const bool consumer = wave < 4;
    const int nchunk = T / TC;
    const int rl = lane >> 4, ks = lane & 15, row = 16 * qr + 4 * wave + rl;
    f32x2 S01 = {0, 0}, S23 = {0, 0};
    if (consumer && latent) { const f32x4 s4 = *(const f32x4*)(p->in[4] + ((((size_t)b * 2 + dir) * 8 + h) * 64 + row) * 64 + 4 * ks); S01 = lo2(s4); S23 = hi2(s4); }
    const int lt = tid - 256, lj = lt >> 4, li = lt & 15;
    ScanLd L0, L1; f32x4 ka4 = {0, 0, 0, 0};
    if (!consumer) ka4 = *(const f32x4*)(k_a + h * 64 + 4 * li);
    float* ybase = Yd + (rowbase)*512 + h * 64 + row;
    const bool kb0 = (ks & 1) != 0, kb1 = (ks & 2) != 0; const int ystep = 4 * (ks >> 2) + 2 * (ks & 1) + ((ks >> 1) & 1);
#define SCAN_LOAD(L, c) do { const int idx = (c) * TC + lj; const int tt = dir ? T - 1 - idx : idx; const size_t off = (rowbase + tt) * 512 + h * 64 + 4 * li; \
        L.kk = unpk4(*(const u32x2*)(KK + off)); L.r = unpk4(*(const u32x2*)(R + off)); L.dec = *(const f32x4*)(DEC + off); L.aa = unpk4(*(const u32x2*)(AA + off)); L.kr = unpk4(*(const u32x2*)(KR + off)); \
        if (lt < 64) { const int vj = lt >> 2, vq = lt & 3; const int idv = (c) * TC + vj; const int tv = dir ? T - 1 - idv : idv; L.v = unpk4(*(const u32x2*)(VV + (rowbase + tv) * 512 + h * 64 + 16 * qr + 4 * vq)); } } while (0)
#define SCAN_WRITE(L, bc, vc) do { const f32x4 bb_ = L.kk * L.aa; const f32x4 kd_ = L.kr * ((L.aa - 1.f) * ka4 + 1.f); LAS float* d_ = (bc) + lj * 320 + 4 * li; \
        *(LAS f32x4*)(d_) = L.kk; *(LAS f32x4*)(d_ + 64) = L.r; *(LAS f32x4*)(d_ + 128) = L.dec; *(LAS f32x4*)(d_ + 192) = bb_; *(LAS f32x4*)(d_ + 256) = kd_; \
        if (lt < 64) *(LAS f32x4*)((vc) + (lt >> 2) * 16 + 4 * (lt & 3)) = L.v; } while (0)
#define SCAN_LDOPS(o, bc, vc, j) do { const LAS float* d_ = (bc) + (j) * 320 + 4 * ks; o.kk = *(const LAS f32x4*)(d_); o.rr = *(const LAS f32x4*)(d_ + 64); o.ww = *(const LAS f32x4*)(d_ + 128); \
        o.bb = *(const LAS f32x4*)(d_ + 192); o.kd = *(const LAS f32x4*)(d_ + 256); o.vv = (vc)[(j) * 16 + 4 * wave + rl]; } while (0)
#define SCAN_COMPUTE(bc, vc, c) do { ScanOps oc, on, on2; SCAN_LDOPS(oc, bc, vc, 0); SCAN_LDOPS(on, bc, vc, 1); float ysel = 0.f; float yp0 = 0.f, yp1 = 0.f, yp2 = 0.f; \
        _Pragma("unroll") for (int j = 0; j < TC; ++j) { \
            if (j + 2 < TC) SCAN_LDOPS(on2, bc, vc, j + 2);     \
            f32x2 pq = S01 * lo2(oc.kk); pq = S23 * hi2(oc.kk) + pq; \
            const float sa = red16(pq.x + pq.y); \
            const f32x2 t01 = S01 * lo2(oc.ww) + lo2(oc.kd) * oc.vv, t23 = S23 * hi2(oc.ww) + hi2(oc.kd) * oc.vv; \
            S01 = t01 - lo2(oc.bb) * sa; S23 = t23 - hi2(oc.bb) * sa; \
            f32x2 yq = S01 * lo2(oc.rr); yq = S23 * hi2(oc.rr) + yq; \
            const float yp = yq.x + yq.y; \
            if ((j & 3) == 0) yp0 = yp; else if ((j & 3) == 1) yp1 = yp; else if ((j & 3) == 2) yp2 = yp; \
            else { const float yr = tred4(yp0, yp1, yp2, yp, kb0, kb1); ysel = ((ks >> 2) == (j >> 2)) ? yr : ysel; } \
            oc = on; on = on2; \
            asm volatile("" ::: "memory"); } \
        { const int idx = (c) * TC + ystep; const int tt = dir ? T - 1 - idx : idx; ybase[(size_t)tt * 512] = ysel; } } while (0)
    if (!consumer) { SCAN_LOAD(L0, 0); SCAN_LOAD(L1, 1); }
    for (int c = 0; c < nchunk; c += 2) {
        if (!consumer) SCAN_WRITE(L0, buf, vb);
        __syncthreads();
        if (!consumer) { if (c + 2 < nchunk) SCAN_LOAD(L0, c + 2); }
        else SCAN_COMPUTE(buf, vb, c);
        if (!consumer) SCAN_WRITE(L1, buf + TC * 320, vb + TC * 16);
        __syncthreads();
        if (!consumer) { if (c + 3 < nchunk) SCAN_LOAD(L1, c + 3); }
        else SCAN_COMPUTE(buf + TC * 320, vb + TC * 16, c + 1);
    }
#undef SCAN_LOAD
#undef SCAN_WRITE
#undef SCAN_LDOPS
#undef SCAN_COMPUTE
    if (consumer && !latent) *(f32x4*)(p->out + OUT_S + ((((size_t)b * 2 + dir) * 8 + h) * 64 + row) * 64 + 4 * ks) = (f32x4){S01.x, S01.y, S23.x, S23.y};
    __syncthreads();
}

constexpr int CS_L = 32, CS_LAT = 2048, CS_CHUNKS = 4096;
DI unsigned char* cs_mf(unsigned char* ws, int q) { return ws + 28 * MiB + (size_t)q * 8192; }
DI unsigned char* cs_q1(unsigned char* ws, int q) { return q < CS_LAT ? ws + 60 * MiB + (size_t)q * 4096 : ws + 76 * MiB + (size_t)(q - CS_LAT) * 4096; }
DI unsigned char* cs_q2(unsigned char* ws, int q) { return q < CS_LAT ? ws + 92 * MiB + (size_t)q * 4096 : ws + 108 * MiB + (size_t)(q - CS_LAT) * 4096; }
DI unsigned char* cs_nt(unsigned char* ws, int q) { return q < CS_LAT ? ws + 202 * MiB + (size_t)q * 8192 : ws + 234 * MiB + (size_t)(q - CS_LAT) * 8192; }
constexpr int CS_G = 51456;
DI bf16x8 frag_nat(const LAS unsigned char* img, int pitch, int rc, int s, int hh) { return *(const LAS bf16x8*)(img + rc * pitch + (16 * s + 8 * hh) * 2); }
DI bf16x8 frag_krow(const LAS unsigned char* img, int pitch, int rc, int s, int hh) {
    const s16x4 lo = *(const LAS s16x4*)(img + rc * pitch + (16 * s + 4 * hh) * 2), hi = *(const LAS s16x4*)(img + rc * pitch + (16 * s + 8 + 4 * hh) * 2);
    return __builtin_shufflevector(lo, hi, 0, 1, 2, 3, 4, 5, 6, 7); }
DI bf16x8 frag_tr(const LAS unsigned char* img, int pitch, int col0, int s, int lane) {
    const int i16 = lane & 15, tq = i16 >> 2, tp = i16 & 3, blk = (lane >> 4) & 1, hh = lane >> 5;
    const LAS unsigned char* bs = img + (16 * s + 4 * hh + tq) * pitch + (col0 + 16 * blk) * 2 + 8 * tp;
    const s16x4 lo = vtr(bs), hi = vtr(bs + 8 * pitch);
    return __builtin_shufflevector(lo, hi, 0, 1, 2, 3, 4, 5, 6, 7); }
template <int S> DI bf16x8 pack8(const f32x16& x, float sg) {
    u32x4 w; w.x = pk2(sg * x[8 * S], sg * x[8 * S + 1]); w.y = pk2(sg * x[8 * S + 2], sg * x[8 * S + 3]); w.z = pk2(sg * x[8 * S + 4], sg * x[8 * S + 5]); w.w = pk2(sg * x[8 * S + 6], sg * x[8 * S + 7]);
    return __builtin_bit_cast(bf16x8, w); }
template <int S> DI bf16x8 pack8lo(const f32x16& x, bf16x8 hi) {
    const u32x4 h = __builtin_bit_cast(u32x4, hi); float d[8];
#pragma unroll
    for (int j = 0; j < 4; ++j) { d[2 * j] = x[8 * S + 2 * j] - __builtin_bit_cast(float, h[j] << 16); d[2 * j + 1] = x[8 * S + 2 * j + 1] - __builtin_bit_cast(float, h[j] & 0xffff0000u); }
    u32x4 w; w.x = pk2(d[0], d[1]); w.y = pk2(d[2], d[3]); w.z = pk2(d[4], d[5]); w.w = pk2(d[6], d[7]);
    return __builtin_bit_cast(bf16x8, w); }
DI void lds_barrier() { asm volatile("s_waitcnt lgkmcnt(0)" ::: "memory"); __builtin_amdgcn_s_barrier(); asm volatile("" ::: "memory"); }
DI f32x16 zero16() { f32x16 z;
#pragma unroll
    for (int i = 0; i < 16; ++i) z[i] = 0.f;
    return z; }

DI void cs_phaseA(KP p, LAS unsigned char* lds, int tid, int qbase, int nit, int first, int stride) {
    const bf16_t* KK = (const bf16_t*)(p->ws + WS_KK); const bf16_t* R = (const bf16_t*)(p->ws + WS_R); const bf16_t* KR = (const bf16_t*)(p->ws + WS_KR);
    const bf16_t* VV = (const bf16_t*)(p->ws + WS_VV); const float* k_a = p->in[19];
    const int wave = tid >> 6, lane = tid & 63, g = wave >> 2, wq = wave & 3, tg = wq * 64 + lane, hh = lane >> 5, r32 = lane & 31;
    LAS unsigned char* L = lds + g * CS_G;
    LAS unsigned char* MKK = L, *MBT = L + 4608, *MKT = L + 2 * 4608, *MRT = L + 3 * 4608, *MBH = L + 4 * 4608, *MKH = L + 5 * 4608, *MVM = L + 6 * 4608;
    LAS float* AF = (LAS float*)(L + 32256);
    LAS unsigned char* ST = L + 36352, *SKK = ST + 2560, *SRB = ST + 2 * 2560, *SRK = ST + 3 * 2560;
    LAS float* SEG = (LAS float*)(L + 46592); LAS float* ELv = (LAS float*)(L + 48640);
    LAS unsigned char* SA = L + 48896;
    f32x2 lwN[4], kkN[4], aaN[4], krN[4], rN[4]; u32x4 vmN;
#define CSA_FETCH(it_) do { const int q_ = qbase + (it_) * 2 + g; const bool lat_ = q_ < CS_LAT; const int sc_ = lat_ ? (q_ >> 6) : ((q_ - CS_LAT) >> 3), ci_ = lat_ ? (q_ & 63) : (q_ & 7), TT_ = lat_ ? DSEQ : SEQ; \
        const int b_ = sc_ >> 4, dir_ = (sc_ >> 3) & 1, h_ = sc_ & 7; const int rb_ = lat_ ? NCTX + b_ * DSEQ : b_ * SEQ; \
          \
        const int t0_ = dir_ ? TT_ - 1 - ci_ * CS_L : ci_ * CS_L, sg_ = dir_ ? -512 : 512; \
        const unsigned ub_ = (unsigned)((rb_ + t0_) * 512 + h_ * 64); \
        const unsigned o0_ = ub_ + (unsigned)(sg_ * 4 * (tg >> 5) + 2 * (tg & 31)); \
        const float* DEC_ = (const float*)(p->ws + WS_DEC) + (size_t)dir_ * NTOK * 512; const bf16_t* AA_ = (const bf16_t*)(p->ws + WS_AA) + (size_t)dir_ * NTOK * 512; \
        _Pragma("unroll") for (int j = 0; j < 4; ++j) { const unsigned off = o0_ + (unsigned)(sg_ * j); \
            lwN[j] = *(const f32x2*)(DEC_ + off); kkN[j] = ldh2(KK + off); aaN[j] = ldh2(AA_ + off); krN[j] = ldh2(KR + off); rN[j] = ldh2(R + off); } \
        vmN = *(const u32x4*)(VV + (ub_ + (unsigned)(sg_ * (tg >> 3) + (tg & 7) * 8))); } while (0)
    if (first < nit) CSA_FETCH(first);
    for (int it = first; it < nit; it += stride) {
        const int q = qbase + it * 2 + g; const bool lat = q < CS_LAT;
        const int sc = lat ? (q >> 6) : ((q - CS_LAT) >> 3), ci = lat ? (q & 63) : (q & 7), TT = lat ? DSEQ : SEQ;
        const int b = sc >> 4, dir = (sc >> 3) & 1, h = sc & 7;
        const size_t rowbase = lat ? (size_t)NCTX + (size_t)b * DSEQ : (size_t)b * SEQ;
        const float* DEC = (const float*)(p->ws + WS_DEC) + (size_t)dir * NTOK * 512; const bf16_t* AA = (const bf16_t*)(p->ws + WS_AA) + (size_t)dir * NTOK * 512;
        {
            const int kp = tg & 31, seg = tg >> 5;
            f32x2 lw[4], kk2[4], aa2[4], kr2[4], r2[4];
#pragma unroll
            for (int j = 0; j < 4; ++j) { lw[j] = lwN[j]; kk2[j] = kkN[j]; aa2[j] = aaN[j]; kr2[j] = krN[j]; r2[j] = rN[j]; }
            const u32x4 vmC = vmN;
            if (it + stride < nit) CSA_FETCH(it + stride);
            f32x2 ss = {0.f, 0.f};
#pragma unroll
            for (int j = 0; j < 4; ++j) { lw[j].x = __logf(lw[j].x); lw[j].y = __logf(lw[j].y); ss += lw[j]; }
            *(LAS f32x2*)(SEG + seg * 64 + 2 * kp) = ss;
            { const int i = tg >> 3, v0 = (tg & 7) * 8; *(LAS u32x4*)(MVM + i * 144 + v0 * 2) = vmC; }
            lds_barrier();
            f32x2 pre = {0.f, 0.f}, tot = {0.f, 0.f};
#pragma unroll
            for (int s8 = 0; s8 < 8; ++s8) { const f32x2 v = *(const LAS f32x2*)(SEG + s8 * 64 + 2 * kp); tot += v; if (s8 < seg) pre += v; }
            if (seg == 0) *(LAS f32x2*)(ELv + 2 * kp) = (f32x2){__expf(tot.x), __expf(tot.y)};
            const f32x2 ka = *(const f32x2*)(k_a + h * 64 + 2 * kp);
            f32x2 cwp = pre;
#pragma unroll
            for (int j = 0; j < 4; ++j) {
                const f32x2 cw = cwp + lw[j];
                const f32x2 E = {__expf(cw.x), __expf(cw.y)}, Ei = {__expf(-cw.x), __expf(-cw.y)}, Ep = {__expf(cwp.x), __expf(cwp.y)}, Eh = {__expf(tot.x - cw.x), __expf(tot.y - cw.y)};
                const f32x2 bb = kk2[j] * aa2[j], kd = kr2[j] * ((aa2[j] - 1.f) * ka + 1.f);
                const int o = (4 * seg + j) * 144 + 4 * kp;
                const f32x2 x0 = kk2[j] * Ep, x1 = bb * Ei, x2 = kd * Ei, x3 = r2[j] * E, x4 = bb * Eh, x5 = kd * Eh;
                *(LAS unsigned*)(MKK + o) = pk2(x0.x, x0.y); *(LAS unsigned*)(MBT + o) = pk2(x1.x, x1.y); *(LAS unsigned*)(MKT + o) = pk2(x2.x, x2.y);
                *(LAS unsigned*)(MRT + o) = pk2(x3.x, x3.y); *(LAS unsigned*)(MBH + o) = pk2(x4.x, x4.y); *(LAS unsigned*)(MKH + o) = pk2(x5.x, x5.y);
                cwp = cw;
            }
        }
        lds_barrier();
        {
            const LAS unsigned char* ia = wq < 2 ? MKK : MRT; const LAS unsigned char* ib = (wq & 1) ? MKT : MBT;
            f32x16 acc = zero16();
#pragma unroll
            for (int s4 = 0; s4 < 4; ++s4) acc = MFMA32(frag_nat(ia, 144, r32, s4, hh), frag_nat(ib, 144, r32, s4, hh), acc);
#pragma unroll
            for (int i = 0; i < 16; ++i) { const int row = crow(i, hh); const bool keep = wq < 2 ? (row > r32) : (row >= r32); const float v = keep ? acc[i] : 0.f;
                if (wq == 0) { AF[row * 32 + r32] = v; *(LAS unsigned short*)(SA + row * 80 + r32 * 2) = (row >= 16 && r32 < 16) ? (unsigned short)(pk2(v, 0.f) & 0xffffu) : (unsigned short)0; }
                else *(LAS unsigned short*)((wq == 1 ? SKK : (wq == 2 ? SRB : SRK)) + row * 80 + r32 * 2) = (unsigned short)(pk2(v, 0.f) & 0xffffu); }
        }
        lds_barrier();
        f32x16 X = zero16(), NT0 = zero16(), NT1 = zero16(), Q2 = zero16();
        const int c = wq & 1;
        if (wq == 0) {
            const int blk = r32 >> 4, cc = r32 & 15;
            float Tc[16];
#pragma unroll
            for (int i = 0; i < 16; ++i) {
                float a4[4] = {(i == cc) ? 1.f : 0.f, 0.f, 0.f, 0.f};
#pragma unroll
                for (int j4 = 0; j4 < (i + 3) / 4; ++j4) { const f32x4 ar = *(const LAS f32x4*)(AF + (16 * blk + i) * 32 + 16 * blk + 4 * j4);
#pragma unroll
                    for (int e = 0; e < 4; ++e) if (4 * j4 + e < i) a4[e] -= ar[e] * Tc[4 * j4 + e]; }
                const float a = (a4[0] + a4[1]) + (a4[2] + a4[3]);
                Tc[i] = a;
                if (lane < 32) { *(LAS unsigned short*)(ST + (16 * blk + i) * 80 + (16 * blk + cc) * 2) = (unsigned short)(pk2(a, 0.f) & 0xffffu);
                                 *(LAS unsigned short*)(ST + (16 * blk + i) * 80 + (16 * (1 - blk) + cc) * 2) = (unsigned short)0; }
            }
            asm volatile("s_waitcnt lgkmcnt(0)" ::: "memory");
            f32x16 E = zero16();
            E = MFMA32(frag_krow(SA, 80, r32, 0, hh), frag_tr(ST, 80, 0, 0, lane), E); E = MFMA32(frag_krow(SA, 80, r32, 1, hh), frag_tr(ST, 80, 0, 1, lane), E);
#pragma unroll
            for (int i = 0; i < 16; ++i) E[i] = ((crow(i, hh) == r32) ? 1.f : 0.f) - E[i];
            f32x16 Tm = zero16();
            Tm = MFMA32(frag_krow(ST, 80, r32, 0, hh), pack8<0>(E, 1.f), Tm); Tm = MFMA32(frag_krow(ST, 80, r32, 1, hh), pack8<1>(E, 1.f), Tm);
            asm volatile("s_waitcnt lgkmcnt(0)" ::: "memory");
#pragma unroll
            for (int i = 0; i < 16; ++i) *(LAS unsigned short*)(ST + crow(i, hh) * 80 + r32 * 2) = (unsigned short)(pk2(Tm[i], 0.f) & 0xffffu);
        } else if (wq >= 2) {
#pragma unroll
            for (int s2 = 0; s2 < 2; ++s2) {
                const bf16x8 vm = frag_tr(MVM, 144, 32 * c, s2, lane);
                X = MFMA32(frag_krow(SKK, 80, r32, s2, hh), vm, X);
                Q2 = MFMA32(frag_krow(SRK, 80, r32, s2, hh), vm, Q2);
                NT0 = MFMA32(frag_tr(MKH, 144, 0, s2, lane), vm, NT0);
                NT1 = MFMA32(frag_tr(MKH, 144, 32, s2, lane), vm, NT1);
            }
        }
        lds_barrier();
        if (wq < 2) {
            f32x16 P1 = zero16();
#pragma unroll
            for (int s2 = 0; s2 < 2; ++s2) P1 = MFMA32(frag_krow(ST, 80, r32, s2, hh), frag_tr(MKK, 144, 32 * c, s2, lane), P1);
            const bf16x8 n0 = pack8<0>(P1, -1.f), n1 = pack8<1>(P1, -1.f);
            f32x16 Q1t;
#pragma unroll
            for (int g4 = 0; g4 < 4; ++g4) { const u32x2 w = *(const LAS u32x2*)(MRT + r32 * 144 + (32 * c + 8 * g4 + 4 * hh) * 2); const f32x4 f = unpk4(w);
                Q1t[4 * g4] = f.x; Q1t[4 * g4 + 1] = f.y; Q1t[4 * g4 + 2] = f.z; Q1t[4 * g4 + 3] = f.w; }
            Q1t = MFMA32(n0, frag_krow(SRB, 80, r32, 0, hh), Q1t); Q1t = MFMA32(n1, frag_krow(SRB, 80, r32, 1, hh), Q1t);
            u32x4* q1f = (u32x4*)cs_q1(p->ws, q) + (c * 2) * 64 + lane;
            q1f[0] = __builtin_bit_cast(u32x4, pack8<0>(Q1t, 1.f)); q1f[64] = __builtin_bit_cast(u32x4, pack8<1>(Q1t, 1.f));
#pragma unroll
            for (int bq = 0; bq < 2; ++bq) {
                f32x16 M = zero16();
                if (bq == c) {
#pragma unroll
                    for (int i = 0; i < 16; ++i) M[i] = (crow(i, hh) == r32) ? ELv[32 * c + r32] : 0.f;
                }
                M = MFMA32(n0, frag_tr(MBH, 144, 32 * bq, 0, lane), M); M = MFMA32(n1, frag_tr(MBH, 144, 32 * bq, 1, lane), M);
                u32x4* mf = (u32x4*)cs_mf(p->ws, q) + ((c * 2 + bq) * 2) * 64 + lane;
                mf[0] = __builtin_bit_cast(u32x4, pack8<0>(M, 1.f)); mf[64] = __builtin_bit_cast(u32x4, pack8<1>(M, 1.f));
            }
        } else {
            f32x16 P2 = zero16();
            P2 = MFMA32(frag_krow(ST, 80, r32, 0, hh), pack8<0>(X, 1.f), P2); P2 = MFMA32(frag_krow(ST, 80, r32, 1, hh), pack8<1>(X, 1.f), P2);
            const bf16x8 n0 = pack8<0>(P2, -1.f), n1 = pack8<1>(P2, -1.f);
            Q2 = MFMA32(frag_krow(SRB, 80, r32, 0, hh), n0, Q2); Q2 = MFMA32(frag_krow(SRB, 80, r32, 1, hh), n1, Q2);
            NT0 = MFMA32(frag_tr(MBH, 144, 0, 0, lane), n0, NT0); NT0 = MFMA32(frag_tr(MBH, 144, 0, 1, lane), n1, NT0);
            NT1 = MFMA32(frag_tr(MBH, 144, 32, 0, lane), n0, NT1); NT1 = MFMA32(frag_tr(MBH, 144, 32, 1, lane), n1, NT1);
            unsigned* q2f = (unsigned*)cs_q2(p->ws, q) + c * 512 + lane;
#pragma unroll
            for (int i = 0; i < 8; ++i) q2f[i * 64] = pk2(Q2[2 * i], Q2[2 * i + 1]);
            unsigned* ntf = (unsigned*)cs_nt(p->ws, q) + (c * 2) * 512 + lane;
#pragma unroll
            for (int i = 0; i < 8; ++i) { ntf[i * 64] = pk2(NT0[2 * i], NT0[2 * i + 1]); ntf[512 + i * 64] = pk2(NT1[2 * i], NT1[2 * i + 1]); }
        }
        lds_barrier();
    }
#undef CSA_FETCH
}


constexpr int CSB_SLOT = 24576;
DI void cs_phaseB(KP p, LAS unsigned char* lds, int latent, int sc, int tid) {
    const int wave = tid >> 6, lane = tid & 63, hh = lane >> 5, r32 = lane & 31;
    const int nch = latent ? 64 : 8, q0 = latent ? sc * 64 : CS_LAT + sc * 8, TT = latent ? DSEQ : SEQ;
    const int b = sc >> 4, dir = (sc >> 3) & 1, h = sc & 7, c = wave & 1;
    const size_t rowbase = latent ? (size_t)NCTX + (size_t)b * DSEQ : (size_t)b * SEQ;
    const bool consumer = wave < 2;
    float* Yu = p->out + (size_t)dir * NTOK * 512 + rowbase * 512 + h * 64 + 32 * c;
    const unsigned ylane = (unsigned)((dir ? 4 * (1 - hh) : 4 * hh) * 512 + r32);
    f32x16 Z0 = zero16(), Z1 = zero16();
    if (consumer && latent) { const float* s0 = p->in[4] + ((((size_t)b * 2 + dir) * 8 + h) * 64 + 32 * c + r32) * 64;
#pragma unroll
      for (int g4 = 0; g4 < 4; ++g4) { const f32x4 a = *(const f32x4*)(s0 + 8 * g4 + 4 * hh), bq = *(const f32x4*)(s0 + 32 + 8 * g4 + 4 * hh);
          Z0[4 * g4] = a.x; Z0[4 * g4 + 1] = a.y; Z0[4 * g4 + 2] = a.z; Z0[4 * g4 + 3] = a.w; Z1[4 * g4] = bq.x; Z1[4 * g4 + 1] = bq.y; Z1[4 * g4 + 2] = bq.z; Z1[4 * g4 + 3] = bq.w; } }
    const int lt = tid - 128;
    u32x4 RG[4][4];
#define CSB_LOADQ(set, ch) do { const int q_ = q0 + (ch); _Pragma("unroll") for (int k_ = 0; k_ < 4; ++k_) { const int pi_ = lt + 384 * k_; \
        const unsigned char* src_ = pi_ < 512 ? cs_mf(p->ws, q_) + pi_ * 16 : (pi_ < 768 ? cs_q1(p->ws, q_) + (pi_ - 512) * 16 : (pi_ < 1280 ? cs_nt(p->ws, q_) + (pi_ - 768) * 16 : cs_q2(p->ws, q_) + (pi_ - 1280) * 16)); \
        RG[set][k_] = *(const u32x4*)src_; } } while (0)
#define CSB_WRITEQ(set, slot) do { _Pragma("unroll") for (int k_ = 0; k_ < 4; ++k_) *(LAS u32x4*)(lds + (slot) * CSB_SLOT + (lt + 384 * k_) * 16) = RG[set][k_]; } while (0)
    if (!consumer) { CSB_LOADQ(0, 0); CSB_LOADQ(1, 1); CSB_LOADQ(2, 2); CSB_LOADQ(3, 3); CSB_WRITEQ(0, 0); CSB_LOADQ(0, 4); }
    else __builtin_amdgcn_s_setprio(3);
    for (int ci0 = 0; ci0 < nch; ci0 += 4) {
#pragma unroll
        for (int u = 0; u < 4; ++u) {
            const int ci = ci0 + u;
            lds_barrier();
            if (!consumer) {
                if (ci + 1 < nch) { CSB_WRITEQ((u + 1) & 3, (ci + 1) & 1); if (ci + 5 < nch) CSB_LOADQ((u + 1) & 3, ci + 5); }
            } else {
                const LAS unsigned char* sl = lds + (ci & 1) * CSB_SLOT;
                bf16x8 MF[8], Q1[4]; f32x16 Y, N0, N1;
#pragma unroll
                for (int i = 0; i < 8; ++i) MF[i] = *(const LAS bf16x8*)(sl + (i * 64 + lane) * 16);
#pragma unroll
                for (int i = 0; i < 4; ++i) Q1[i] = *(const LAS bf16x8*)(sl + 8192 + (i * 64 + lane) * 16);
#pragma unroll
                for (int i = 0; i < 8; ++i) { const unsigned w0 = *(const LAS unsigned*)(sl + 12288 + ((c * 2) * 512 + i * 64 + lane) * 4), w1 = *(const LAS unsigned*)(sl + 12288 + ((c * 2 + 1) * 512 + i * 64 + lane) * 4),
                                                         w2 = *(const LAS unsigned*)(sl + 20480 + (c * 512 + i * 64 + lane) * 4);
                    N0[2 * i] = __builtin_bit_cast(float, w0 << 16); N0[2 * i + 1] = __builtin_bit_cast(float, w0 & 0xffff0000u);
                    N1[2 * i] = __builtin_bit_cast(float, w1 << 16); N1[2 * i + 1] = __builtin_bit_cast(float, w1 & 0xffff0000u);
                    Y[2 * i] = __builtin_bit_cast(float, w2 << 16); Y[2 * i + 1] = __builtin_bit_cast(float, w2 & 0xffff0000u); }
                const bf16x8 z00 = pack8<0>(Z0, 1.f), z01 = pack8<1>(Z0, 1.f), z10 = pack8<0>(Z1, 1.f), z11 = pack8<1>(Z1, 1.f);
                const bf16x8 l00 = pack8lo<0>(Z0, z00), l01 = pack8lo<1>(Z0, z01), l10 = pack8lo<0>(Z1, z10), l11 = pack8lo<1>(Z1, z11);
                Y = MFMA32(Q1[0], z00, Y); Y = MFMA32(Q1[1], z01, Y); Y = MFMA32(Q1[2], z10, Y); Y = MFMA32(Q1[3], z11, Y);
                N0 = MFMA32(MF[0], z00, N0); N0 = MFMA32(MF[1], z01, N0); N0 = MFMA32(MF[4], z10, N0); N0 = MFMA32(MF[5], z11, N0);
                N0 = MFMA32(MF[0], l00, N0); N0 = MFMA32(MF[1], l01, N0); N0 = MFMA32(MF[4], l10, N0); N0 = MFMA32(MF[5], l11, N0);
                N1 = MFMA32(MF[2], z00, N1); N1 = MFMA32(MF[3], z01, N1); N1 = MFMA32(MF[6], z10, N1); N1 = MFMA32(MF[7], z11, N1);
                N1 = MFMA32(MF[2], l00, N1); N1 = MFMA32(MF[3], l01, N1); N1 = MFMA32(MF[6], l10, N1); N1 = MFMA32(MF[7], l11, N1);
                Z0 = N0; Z1 = N1;
                { const int t0 = dir ? TT - CS_L - ci * CS_L : ci * CS_L;
#pragma unroll
                  for (int i = 0; i < 16; ++i) { const int ci_ = (i & 3) + 8 * (i >> 2); float* Ys = Yu + (size_t)(t0 + (dir ? 27 - ci_ : ci_)) * 512; Ys[ylane] = Y[i]; } }
            }
        }
    }
#undef CSB_LOADQ
#undef CSB_WRITEQ
    __builtin_amdgcn_s_setprio(0);
    if (consumer && !latent) { float* so = p->out + OUT_S + ((((size_t)b * 2 + dir) * 8 + h) * 64 + 32 * c + r32) * 64;
#pragma unroll
        for (int g4 = 0; g4 < 4; ++g4) { *(f32x4*)(so + 8 * g4 + 4 * hh) = (f32x4){Z0[4 * g4], Z0[4 * g4 + 1], Z0[4 * g4 + 2], Z0[4 * g4 + 3]};
                                          *(f32x4*)(so + 32 + 8 * g4 + 4 * hh) = (f32x4){Z1[4 * g4], Z1[4 * g4 + 1], Z1[4 * g4 + 2], Z1[4 * g4 + 3]}; } }
    __syncthreads();
}

DI void post_row(KP p, int r, int lane) {
    const float* Y = p->out; const bf16_t* R = (const bf16_t*)(p->ws + WS_R); const bf16_t* KR = (const bf16_t*)(p->ws + WS_KR);
    const bf16_t* VV = (const bf16_t*)(p->ws + WS_VV); const bf16_t* AA = (const bf16_t*)(p->ws + WS_AA); const bf16_t* G = (const bf16_t*)(p->ws + WS_G);
    const float* k_a = p->in[19]; const float* r_k = p->in[20]; const float* lng = p->in[21]; const float* lnb = p->in[22];
    bf16_t* MIX = (bf16_t*)(p->ws + WS_MIX);
    const int c = lane * 8; const size_t off = (size_t)r * 512 + c;
    float y[8], rr[8], kr[8], vv[8], a0[8], a1[8], gg[8], ka[8], rk[8], lg[8], lb[8];
#define LD8(dst, ptr) do { const f32x4 _a = *(const f32x4*)(ptr), _b = *(const f32x4*)((ptr) + 4); dst[0] = _a.x; dst[1] = _a.y; dst[2] = _a.z; dst[3] = _a.w; dst[4] = _b.x; dst[5] = _b.y; dst[6] = _b.z; dst[7] = _b.w; } while (0)
#define LD8H(dst, ptr) do { const u32x4 _w = *(const u32x4*)(ptr); const f32x4 _a = unpk4((u32x2){_w.x, _w.y}), _b = unpk4((u32x2){_w.z, _w.w}); dst[0] = _a.x; dst[1] = _a.y; dst[2] = _a.z; dst[3] = _a.w; dst[4] = _b.x; dst[5] = _b.y; dst[6] = _b.z; dst[7] = _b.w; } while (0)
    LD8(y, Y + off); LD8(rr, Y + (size_t)NTOK * 512 + off);
#pragma unroll
    for (int j = 0; j < 8; ++j) y[j] += rr[j];
    LD8H(rr, R + off); LD8H(kr, KR + off); LD8H(vv, VV + off); LD8H(a0, AA + off); LD8H(a1, AA + (size_t)NTOK * 512 + off); LD8H(gg, G + off);
    LD8(ka, k_a + c); LD8(rk, r_k + c); LD8(lg, lng + c); LD8(lb, lnb + c);
#undef LD8
#undef LD8H
    float s = 0.f, d0 = 0.f, d1 = 0.f;
#pragma unroll
    for (int j = 0; j < 8; ++j) { s += y[j]; const float q = rr[j] * kr[j] * rk[j]; d0 += q * (1.f + (a0[j] - 1.f) * ka[j]); d1 += q * (1.f + (a1[j] - 1.f) * ka[j]); }
    float bd = d0 + d1;
    s += __shfl_xor(s, 1); s += __shfl_xor(s, 2); s += __shfl_xor(s, 4);
    bd += __shfl_xor(bd, 1); bd += __shfl_xor(bd, 2); bd += __shfl_xor(bd, 4);
    const float mu = s * (1.f / 64.f);
    float q2 = 0.f;
#pragma unroll
    for (int j = 0; j < 8; ++j) { y[j] -= mu; q2 += y[j] * y[j]; }
    q2 += __shfl_xor(q2, 1); q2 += __shfl_xor(q2, 2); q2 += __shfl_xor(q2, 4);
    const float rs = rsqrtf(q2 * (1.f / 64.f) + GN_EPS);
    float o[8];
#pragma unroll
    for (int j = 0; j < 8; ++j) o[j] = (y[j] * rs * lg[j] + lb[j] + bd * vv[j]) * gg[j];
    *(u32x4*)(MIX + (size_t)r * D + 512 + c) = (u32x4){pk2(o[0], o[1]), pk2(o[2], o[3]), pk2(o[4], o[5]), pk2(o[6], o[7])};
}

DI void act_fix(KP p, int pm, int e, int c) {
    const float* EDGE = (const float*)(p->ws + WS_EDGE); bf16_t* ACT = (bf16_t*)(p->ws + WS_ACT); const float* wc = p->in[27];
    const bool need = e == 0 ? (pm != 16 && pm != 24) : (pm != 23 && pm != 31);
    if (!need) return;
    const int r = pm * 256 + (e ? 255 : 0), nbpm = e ? pm + 1 : pm - 1;
    const float* nb = EDGE + ((size_t)nbpm * 2 + (1 - e)) * DFF + c;
    const float* eu = EDGE + ((size_t)pm * 2 + e) * DFF + 64 * DFF + c; const float* e3 = eu + 64 * DFF;
    const float* w = wc + (e ? 2 * DFF : 0) + c;
    float o[8];
#pragma unroll
    for (int j = 0; j < 8; ++j) o[j] = silu_f(eu[j] + w[j] * nb[j]) * e3[j];
    *(u32x4*)(ACT + (size_t)r * DFF + c) = (u32x4){pk2(o[0], o[1]), pk2(o[2], o[3]), pk2(o[4], o[5]), pk2(o[6], o[7])};
}

template <int NR>
DI void final_rows(KP p, int rbase, int rstride, int lane) {
    const float* MODb = (const float*)(p->ws + WS_MOD);
    const bf16_t* PART = (const bf16_t*)(p->ws + WS_PART); const float* nf = p->in[29];
    f32x4 v[NR][4]; u32x2 p0[NR][4], p1[NR][4];
#pragma unroll
    for (int q = 0; q < NR; ++q) { const int r = rbase + q * rstride; const f32x4* xr = (const f32x4*)(p->out + (size_t)r * D) + lane;
#pragma unroll
        for (int j = 0; j < 4; ++j) { v[q][j] = xr[64 * j]; p0[q][j] = *((const u32x2*)(PART + (size_t)r * D) + lane + 64 * j); p1[q][j] = *((const u32x2*)(PART + (size_t)(NTOK + r) * D) + lane + 64 * j); } }
    float s[NR];
#pragma unroll
    for (int q = 0; q < NR; ++q) { const int r = rbase + q * rstride; const float* MOD = MODb + midx_of(r) * 6144; s[q] = 0.f;
#pragma unroll
        for (int j = 0; j < 4; ++j) { const f32x4 gt = *((const f32x4*)(MOD + 5 * D) + lane + 64 * j); v[q][j] = v[q][j] + gt * (unpk4(p0[q][j]) + unpk4(p1[q][j]));
            s[q] += (v[q][j].x * v[q][j].x + v[q][j].y * v[q][j].y) + (v[q][j].z * v[q][j].z + v[q][j].w * v[q][j].w); } }
#pragma unroll
    for (int o = 1; o < 64; o <<= 1) {
#pragma unroll
        for (int q = 0; q < NR; ++q) s[q] += __shfl_xor(s[q], o); }
#pragma unroll
    for (int q = 0; q < NR; ++q) { const int r = rbase + q * rstride; f32x4* xr = (f32x4*)(p->out + (size_t)r * D) + lane; const float rstd = rsqrtf(s[q] * (1.f / D) + EPS);
#pragma unroll
        for (int j = 0; j < 4; ++j) xr[64 * j] = v[q][j] * rstd * *((const f32x4*)nf + lane + 64 * j); }
}

DI int lane_id() { int l; asm volatile("v_mbcnt_lo_u32_b32 %0, -1, 0\n\tv_mbcnt_hi_u32_b32 %0, -1, %0" : "=v"(l)); return l; }
#define XB_TMO      128
#define XB_XCNT(j)  (256  + 64 * (j))
#define XB_XSUB(j)  (1280 + 64 * (j))
#define XB_XGEN(j)  (2304 + 64 * (j))
#define XB_TOP      3328
#define XB_TOPGEN   3392
#define XB_SUBBAR   3520
#define XB_SPIN_CAP (1u << 18)
DI unsigned xb_ld(unsigned* p)              { return __hip_atomic_load(p, __ATOMIC_RELAXED, __HIP_MEMORY_SCOPE_AGENT); }
DI unsigned xb_add(unsigned* p, unsigned v) { return __hip_atomic_fetch_add(p, v, __ATOMIC_RELAXED, __HIP_MEMORY_SCOPE_AGENT); }
DI unsigned xb_xcc_id() { return (unsigned)__builtin_amdgcn_s_getreg((3 << 11) | 20) & 0xFu; }
#define XB_SPIN(cond, bar) do { unsigned _sp = 0; while (cond) { __builtin_amdgcn_s_sleep(1); \
    if ((++_sp & 255u) == 0u) { if (xb_ld(&(bar)[XB_TMO])) break; if (_sp > XB_SPIN_CAP) { atomicAdd(&(bar)[XB_TMO], 1u); break; } } } } while (0)
DI void xcd_barrier_complete(unsigned* bar, unsigned x, unsigned G, unsigned& nloc, unsigned& nx) {
    unsigned sum, cnt, mine, sp = 0u;
    for (;;) {
        sum = 0u; cnt = 0u; mine = 0u;
#pragma unroll
        for (unsigned j = 0; j < 16; ++j) { const unsigned c = xb_ld(&bar[XB_XCNT(j)]); sum += c; cnt += (c > 0u) ? 1u : 0u; mine = (j == x) ? c : mine; }
        if (sum == G) break;
        __builtin_amdgcn_s_sleep(1);
        if ((++sp & 255u) == 0u) { if (xb_ld(&bar[XB_TMO])) break; if (sp > XB_SPIN_CAP) { atomicAdd(&bar[XB_TMO], 1u); break; } }
    }
    nloc = mine > 0u ? mine : 1u; nx = cnt > 0u ? cnt : 1u;
}
DI void grid_bar(unsigned* bar, volatile LAS unsigned* st, unsigned G, int wave_s) {
    asm volatile("s_waitcnt vmcnt(0)" ::: "memory");
    __syncthreads();
    int t = wave_s * 64 + lane_id(); asm volatile("" : "+v"(t));
    if (t == 0) {
        __builtin_amdgcn_s_waitcnt(0);
        const unsigned x = xb_xcc_id();
        unsigned nloc = st[0], nx = st[1];
        if (nloc == 0u) { xcd_barrier_complete(bar, x, G, nloc, nx); st[0] = nloc; st[1] = nx; }
        const unsigned old = xb_add(&bar[XB_XSUB(x)], 1u);
        const unsigned gen = old / nloc;
        if (old + 1u == (gen + 1u) * nloc) {
            __builtin_amdgcn_fence(__ATOMIC_RELEASE, "agent");
            asm volatile("s_waitcnt vmcnt(0)" ::: "memory");
            const unsigned og = xb_add(&bar[XB_TOP], 1u);
            const unsigned tg = og / nx;
            if (og + 1u == (tg + 1u) * nx) xb_add(&bar[XB_TOPGEN], 1u);
            else XB_SPIN(xb_ld(&bar[XB_TOPGEN]) == tg, bar);
            __builtin_amdgcn_fence(__ATOMIC_ACQUIRE, "agent");
            xb_add(&bar[XB_XGEN(x)], 1u);
            asm volatile("s_waitcnt vmcnt(0)" ::: "memory");
        } else {
            XB_SPIN(xb_ld(&bar[XB_XGEN(x)]) == gen, bar);
            __builtin_amdgcn_fence(__ATOMIC_ACQUIRE, "agent");
            asm volatile("s_waitcnt vmcnt(0)" ::: "memory");
        }
    }
    __syncthreads();
}

__global__ void __launch_bounds__(512, 2) fwd_megakernel(Params kparams) {
    const KP kp0 = (KP)__builtin_amdgcn_kernarg_segment_ptr();
    extern __shared__ __attribute__((aligned(16))) unsigned char lds_raw[];
    LAS unsigned char* lds = (LAS unsigned char*)lds_raw;
    const int wave_s = __builtin_amdgcn_readfirstlane((int)threadIdx.x >> 6);
    volatile LAS unsigned* xbst = (volatile LAS unsigned*)(lds + LDS_XB);
    {
        int t0_ = wave_s * 64 + lane_id();
        if (t0_ == 0) { xbst[0] = 0u; xbst[1] = 0u; (void)xb_add((unsigned*)(kp0->ws + WS_BAR) + XB_XCNT(xb_xcc_id()), 1u); }
        __syncthreads();
    }
#define GRID_SYNC() grid_bar((unsigned*)(kp0->ws + WS_BAR), xbst, (unsigned)G, wave_s)
    const int G = gridDim.x, bx = blockIdx.x, NGW = G * 8, NGT = G * 512;
#define PH_VARS KP p = kp0; asm volatile("" : "+s"(p)); unsigned char* ws = p->ws; (void)ws; \
    int tid = wave_s * 64 + lane_id(); asm volatile("" : "+v"(tid)); const int lane = tid & 63, wave = wave_s, gw = bx * 8 + wave, gtid = bx * 512 + tid; (void)lane; (void)gw; (void)gtid;

    const bool defer_ffn = (G == 256);
    { PH_VARS phase0(p, lds, gw, NGW, gtid, NGT, wave, lane, defer_ffn); }
    GRID_SYNC();
    if (G > (1 << 20)) cg::this_grid().sync();
    { PH_VARS for (int r = gw; r < NTOK; r += 4 * NGW) norm_rows<0, 4>(p, r, NGW, lane, p->in[9], 0, D, 0, (bf16_t*)(ws + WS_H), nullptr); }
    GRID_SYNC();
    {
        PH_VARS
        pg8::Gemm g{(const bf16_t*)(ws + WS_H), (const bf16_t*)(ws + WS_WTIN), D, D, D};
        pg8::SchedPlain S; S.o.init(NTOK / 256, NINP / 256, G, bx);
        pg8::EpiIn E{(bf16_t*)(ws + WS_Q), (bf16_t*)(ws + WS_ZR), p->out + OUT_K, 0.125f * LOG2E};
        pg8::gemm_phase(lds, g, S, E, tid);
        if (defer_ffn && bx >= 192) ffn_transposes(p, lds, 0, (bx - 192) * 8 + wave, 64 * 8, wave, lane);
    }
    GRID_SYNC();
    {
        PH_VARS
        LAS float* rpbL = (LAS float*)lds;
        for (int i = tid; i < 8 * 465; i += 512) rpbL[i] = p->in[23][i] * LOG2E;
        __syncthreads();
        LAS unsigned char* vbuf = lds + 16384 + wave * 4608;
        LAS float* xch = (LAS float*)(lds + 65536) + (wave & 3) * 2176;
        for (int u0 = bx * 4; u0 < 1024; u0 += G * 4) {
            if (wave < 4) { attn_unit<true, 2>(p, vbuf, rpbL, u0 + wave, lane, 0, 20, xch); attn_unit<false, 0>(p, vbuf, rpbL, u0 + wave, lane, 0, 8, xch); }
            else { attn_unit<true, 1>(p, vbuf, rpbL, u0 + wave - 4, lane, 20, 32, xch); prep_rows8(p, (u0 + wave - 4) * 8, lane); }
            __syncthreads();
        }
    }
    GRID_SYNC();
    {
        PH_VARS
        int kl = 128; asm volatile("" : "+s"(kl));
        pg8::Gemm g{(const bf16_t*)(ws + WS_ALORA), (const bf16_t*)(ws + WS_WTLORA), kl, 128, 128};
        pg8::SchedLora S; S.G = G; S.c = bx;
        pg8::EpiLora E{(float*)(ws + WS_DEC), (float*)(ws + WS_AA), (float*)(ws + WS_G), p->in[13], p->in[15]};
        pg8::gemm_phase(lds, g, S, E, tid);
        if (defer_ffn && bx >= 64) ffn_transposes(p, lds, 1, (bx - 64) * 8 + wave, 192 * 8, wave, lane);
    }
    GRID_SYNC();
    {
        int nst = 2; asm volatile("" : "+s"(nst));
        const int nl = G > 64 ? 32 : 0;
        for (int st = 0; st < nst; ++st) {
            PH_VARS
            const bool lead = bx < nl;
            if (st == 0 || !lead) cs_phaseA(p, lds, tid, st ? CS_LAT : 0, CS_LAT / 2, st ? bx - nl : bx, st ? G - nl : G);
            if (st == 0) { GRID_SYNC(); continue; }
            if (!lead) {
                unsigned* sb = (unsigned*)(kp0->ws + WS_BAR) + XB_SUBBAR;
                __syncthreads();
                if (tid == 0) { __atomic_thread_fence(__ATOMIC_RELEASE); __hip_atomic_fetch_add(sb, 1u, __ATOMIC_RELAXED, __HIP_MEMORY_SCOPE_AGENT);
                    while (__hip_atomic_load(sb, __ATOMIC_RELAXED, __HIP_MEMORY_SCOPE_AGENT) < (unsigned)(G - nl)) __builtin_amdgcn_s_sleep(1);
                    __atomic_thread_fence(__ATOMIC_ACQUIRE); }
                __syncthreads();
            }
            const int tfirst = lead ? bx : (nl ? 32 + (bx - nl) : bx), tend = lead ? 32 : 288, tstride = lead ? 32 : (G - nl);
            for (int t = tfirst; t < tend; t += tstride) cs_phaseB(p, lds, t < 32 ? 1 : 0, t < 32 ? t : t - 32, tid);
        }
    }
    GRID_SYNC();
    { PH_VARS for (int r = gw; r < NTOK; r += NGW) post_row(p, r, lane); }
    GRID_SYNC();
    {
        PH_VARS
        pg8::Gemm g{(const bf16_t*)(ws + WS_MIX), (const bf16_t*)(ws + WS_WTOUT), 512, D, D};
        pg8::SchedSplit2 S; S.o.init(NTOK / 256, 8, G, bx); S.nN = 4; S.ksplit = 512;
        pg8::EpiPart E{(bf16_t*)(ws + WS_PART), 512};
        pg8::gemm_phase(lds, g, S, E, tid);
    }
    GRID_SYNC();
    { PH_VARS for (int r = gw; r < NTOK; r += 2 * NGW) norm_rows<1, 2>(p, r, NGW, lane, p->in[10], 3 * D, 4 * D, 2 * D, (bf16_t*)(ws + WS_H), p->out); }
    GRID_SYNC();
    {
        PH_VARS
        pg8::Gemm g{(const bf16_t*)(ws + WS_H), (const bf16_t*)(ws + WS_WT13), D, D, D};
        pg8::SchedPlain S; S.o.init(NTOK / 256, 2 * DFF / 256, G, bx);
        pg8::EpiFfnAct E{(bf16_t*)(ws + WS_ACT), (float*)(ws + WS_EDGE), p->in[27], lds};
        pg8::gemm_phase(lds, g, S, E, tid);
    }
    GRID_SYNC();
    {
        PH_VARS
        pg8::Gemm g{(const bf16_t*)(ws + WS_ACT), (const bf16_t*)(ws + WS_WT2), DFF / 2, DFF, DFF};
        pg8::SchedSplit2 S; S.o.init(NTOK / 256, 8, G, bx); S.nN = 4; S.ksplit = DFF / 2;
        { for (int i = 0; i < 8; ++i) { int pm_, pn2_; if (!S.o.next2(i, pm_, pn2_)) break; const int ks_ = pn2_ / 4;
              if (pm_ >= 16 && tid < 352) act_fix(p, pm_, tid / 176, ks_ * (DFF / 2) + (tid % 176) * 8); }
          asm volatile("s_waitcnt vmcnt(0)" ::: "memory"); __syncthreads(); }
        pg8::EpiPart E{(bf16_t*)(ws + WS_PART), DFF / 2};
        pg8::gemm_phase(lds, g, S, E, tid);
    }
    GRID_SYNC();
    { PH_VARS for (int r = gw; r < NTOK; r += 2 * NGW) final_rows<2>(p, r, NGW, lane); }
}

extern "C" void kernel_launch(void* const* d_in, const int* in_sizes, int n_in, void* d_out, int out_size, void* d_ws, size_t ws_size, hipStream_t stream) {
    static int grid_blocks = 0;
    if (!grid_blocks) {
        int dev = 0, cus = 0, per_cu = 0;
        (void)hipGetDevice(&dev);
        (void)hipDeviceGetAttribute(&cus, hipDeviceAttributeMultiprocessorCount, dev);
        (void)hipFuncSetAttribute((const void*)fwd_megakernel, hipFuncAttributeMaxDynamicSharedMemorySize, LDS_BYTES);
        (void)hipOccupancyMaxActiveBlocksPerMultiprocessor(&per_cu, (const void*)fwd_megakernel, 512, LDS_BYTES);
        if (per_cu < 1) per_cu = 1;
        grid_blocks = cus * per_cu;
    }
    (void)hipMemsetAsync((char*)d_ws + WS_BAR, 0, 16384, stream);
    Params p{};
    for (int i = 0; i < 30; ++i) p.in[i] = (const float*)d_in[i];
    p.out = (float*)d_out; p.ws = (unsigned char*)d_ws;
    void* args[] = {&p};
    hipError_t e = hipLaunchCooperativeKernel((const void*)fwd_megakernel, dim3(grid_blocks), dim3(512), args, LDS_BYTES, stream);
    if (e != hipSuccess) fprintf(stderr, "cooperative launch failed: %s (grid %d)\n", hipGetErrorString(e), grid_blocks);
}
```

```cpp
#include <hip/hip_runtime.h>
#include <hip/hip_cooperative_groups.h>
#include <cstdio>
#include <cstdint>
namespace cg = cooperative_groups;

#define LAS __attribute__((address_space(3)))
typedef unsigned short bf16_t;
typedef short bf16x8 __attribute__((ext_vector_type(8)));
typedef short s16x4 __attribute__((ext_vector_type(4)));
typedef float f32x2 __attribute__((ext_vector_type(2)));
typedef float f32x4 __attribute__((ext_vector_type(4)));
typedef float f32x16 __attribute__((ext_vector_type(16)));
typedef unsigned u32x2 __attribute__((ext_vector_type(2)));
typedef unsigned u32x4 __attribute__((ext_vector_type(4)));
typedef __bf16 bf16x2_t __attribute__((ext_vector_type(2)));
#define DI __device__ __forceinline__

constexpr int D = 1024, NTOK = 8192, NCTX = 4096, SEQ = 256, DSEQ = 2048;
constexpr int NIN = 3456, NINP = 3584, RC = 1920, DFF = 2816;
constexpr float EPS = 1e-6f, GN_EPS = 64e-5f;
constexpr float LOG2E = 1.4426950408889634f;
constexpr size_t MiB = 1u << 20;
constexpr size_t WS_BAR = 128 * 1024, WS_MOD = 0, WS_WTIN = 1 * MiB, WS_WTOUT = 8 * MiB, WS_WT13 = 10 * MiB, WS_WT2 = 21 * MiB, WS_WTLORA = 27 * MiB,
                 WS_H = 28 * MiB, WS_Q = 44 * MiB, WS_K = 52 * MiB, WS_V = 60 * MiB, WS_R = 68 * MiB, WS_VV = 84 * MiB, WS_KK = 100 * MiB,
                 WS_KR = 116 * MiB, WS_ALORA = 132 * MiB, WS_MIX = 138 * MiB, WS_ZR = 154 * MiB, WS_DEC = 154 * MiB, WS_AA = 186 * MiB,
                 WS_G = 218 * MiB, WS_CK = 234 * MiB, WS_CV = 235 * MiB, WS_Y = 28 * MiB, WS_PART = 176 * MiB, WS_A1 = 44 * MiB,
                 WS_A3 = 88 * MiB, WS_ACT = 132 * MiB, WS_EDGE = 250 * MiB;
constexpr size_t OUT_K = (size_t)NTOK * D, OUT_V = OUT_K + (size_t)NCTX * 512, OUT_S = OUT_V + (size_t)NCTX * 512;
constexpr int LDS_BYTES = 135168 + 16;
constexpr int LDS_XB = 135168;

struct Params { const float* in[30]; float* out; unsigned char* ws; };
typedef const __attribute__((address_space(4))) Params* KP;

DI unsigned pk2(float lo, float hi) { f32x2 v = {lo, hi}; bf16x2_t b = __builtin_convertvector(v, bf16x2_t); return __builtin_bit_cast(unsigned, b); }
DI f32x4 unpk4(u32x2 w) { return (f32x4){__builtin_bit_cast(float, w.x << 16), __builtin_bit_cast(float, w.x & 0xffff0000u), __builtin_bit_cast(float, w.y << 16), __builtin_bit_cast(float, w.y & 0xffff0000u)}; }
DI f32x2 ldh2(const bf16_t* p) { const unsigned w = *(const unsigned*)p; return (f32x2){__builtin_bit_cast(float, w << 16), __builtin_bit_cast(float, w & 0xffff0000u)}; }
DI float bf2f(unsigned short u) { return __builtin_bit_cast(float, (unsigned)u << 16); }
DI float wave_sum(float v) {
#pragma unroll
    for (int o = 1; o < 64; o <<= 1) v += __shfl_xor(v, o);
    return v;
}
DI float sigmoid_f(float x) { return __builtin_amdgcn_rcpf(1.f + __builtin_amdgcn_exp2f(-1.4426950408889634f * x)); }
DI float silu_f(float x) { return x * sigmoid_f(x); }
DI float tanh_f(float x) { return 2.f * sigmoid_f(2.f * x) - 1.f; }
DI int midx_of(int r) { return r < NCTX ? 0 : 1 + ((r - NCTX) >> 11); }
DI const float* xrow_of(KP p, int r) { return r < NCTX ? p->in[0] + (size_t)r * D : p->in[1] + (size_t)(r - NCTX) * D; }

namespace pg8 {
constexpr int BM = 256, BK = 64, HALF = 128, HTB = HALF * BK * 2, NXCD = 8, WGM = 8;
__host__ __device__ __forceinline__ int lds_byte(int r, int c) { const int st = (r >> 4) * 2 + (c >> 5), rr = r & 15, cc = c & 31, ob = rr * 64 + cc * 2; return st * 1024 + (ob ^ (((ob >> 9) & 1) << 5)); }
__host__ __device__ __forceinline__ void stage_rc(int b, int& R, int& C) { const int st = b / 1024, sb = b % 1024, swz = sb ^ (((sb >> 9) & 1) << 5); R = (st >> 1) * 16 + swz / 64; C = (st & 1) * 32 + (swz % 64) / 2; }
__host__ __device__ __forceinline__ int perm32(int rho) { const int n = rho >> 4, i = rho & 15; return 8 * (i >> 2) + 4 * n + (i & 3); }
struct Unit { int pm, pn; int aoff, boff; };
struct Gemm { const bf16_t* A; const bf16_t* Bt; int K, lda, ldb; };
struct StaticOrder {
    int nM, nN, nwg, G, c;
    __device__ __forceinline__ void init(int nM_, int nN_, int G_, int c_) { nM = nM_; nN = nN_; nwg = nM * nN; G = G_; c = c_; }
    __device__ __forceinline__ bool next2(int i, int& pm, int& pn) const {
        const long L = (long)i * G + c; if (L >= nwg) return false;
        int wgid = (int)L; { const int q = nwg / NXCD, r = nwg % NXCD, xcd = wgid % NXCD, off = wgid / NXCD; wgid = (xcd < r ? xcd * (q + 1) : r * (q + 1) + (xcd - r) * q) + off; }
        const int nig = WGM * nN, gid = wgid / nig, fm = gid * WGM, gsz = (nM - fm) < WGM ? (nM - fm) : WGM;
        pm = fm + ((wgid % nig) % gsz); pn = (wgid % nig) / gsz; return true;
    }
};
struct SchedPlain { StaticOrder o; __device__ __forceinline__ bool next(int i, Unit& u) const { u.aoff = 0; u.boff = 0; return o.next2(i, u.pm, u.pn); } };
struct SchedSplit2 { StaticOrder o; int nN, ksplit;
    __device__ __forceinline__ bool next(int i, Unit& u) const { int pn2; if (!o.next2(i, u.pm, pn2)) return false; const int ks = pn2 / nN; u.pn = pn2 - ks * nN; u.aoff = ks * ksplit; u.boff = ks * ksplit; return true; } };
struct SchedLora { int G, c;
    __device__ __forceinline__ bool next(int i, Unit& u) const { const int L = i * G + c; if (L >= 320) return false; u.pm = L & 31; u.pn = L >> 5; const int g = u.pn < 4 ? 0 : (u.pn < 8 ? 1 : 2); u.aoff = g * NTOK * 128; u.boff = 0; return true; } };

template <class Epi, class Sched>
__device__ __forceinline__ void gemm_phase(LAS unsigned char* lds, const Gemm g, const Sched& S, const Epi& E, int tid) {
    asm volatile("" : "+v"(tid));
    const int wid = __builtin_amdgcn_readfirstlane(tid >> 6), lane = tid & 63, wr = wid >> 2, wc = wid & 3, fr = lane & 15, fq = lane >> 4;
    const int nt = g.K / BK;
    unsigned voffA[2], voffB[2];
#pragma unroll
    for (int i = 0; i < 2; ++i) { int R, C; stage_rc(tid * 16 + i * 8192, R, C); const int Rb = (R & ~31) + perm32(R & 31);
        voffA[i] = (unsigned)(R * g.lda + C) * 2u; voffB[i] = (unsigned)(Rb * g.ldb + C) * 2u; }
    const size_t kstep = (size_t)(BK * 2);
    const size_t hA = (size_t)HALF * g.lda * 2, hB = (size_t)HALF * g.ldb * 2;
    const unsigned ldsw = (unsigned)wid * 1024u;
    const int aoff = lds_byte(wr * 64 + fr, fq * 8), boff = lds_byte(wc * 32 + fr, fq * 8);
#define PG8_SA(b, h) (((b) * 2 + (h)) * HTB)
#define PG8_SB(b, h) ((4 + (b) * 2 + (h)) * HTB)
#define PG8_STAGE(bufoff, gbase, voff) do { _Pragma("unroll") for (int _i = 0; _i < 2; ++_i) \
        __builtin_amdgcn_global_load_lds((const unsigned*)((const char*)(gbase) + (voff)[_i]), (LAS unsigned*)(lds + (bufoff) + ldsw + _i * 8192), 16, 0, 0); } while (0)
#define PG8_LDA(dst, b, h) do { _Pragma("unroll") for (int m = 0; m < 4; ++m) _Pragma("unroll") for (int k = 0; k < 2; ++k) dst[m][k] = *(const LAS bf16x8*)(lds + PG8_SA(b, h) + aoff + m * 2048 + k * 1024); } while (0)
#define PG8_LDB(dst, b, h) do { _Pragma("unroll") for (int n = 0; n < 2; ++n) _Pragma("unroll") for (int k = 0; k < 2; ++k) dst[n][k] = *(const LAS bf16x8*)(lds + PG8_SB(b, h) + boff + n * 2048 + k * 1024); } while (0)
#define PG8_MMA(ai, bj, At, Bt) do { __builtin_amdgcn_s_setprio(1); _Pragma("unroll") for (int m = 0; m < 4; ++m) _Pragma("unroll") for (int n = 0; n < 2; ++n) _Pragma("unroll") for (int k = 0; k < 2; ++k) \
        acc[ai][bj][m][n] = __builtin_amdgcn_mfma_f32_16x16x32_bf16(Bt[n][k], At[m][k], acc[ai][bj][m][n], 0, 0, 0); __builtin_amdgcn_s_setprio(0); } while (0)
#define PG8_WAIT_V(n) asm volatile("s_waitcnt vmcnt(" #n ")" ::: "memory")
#define PG8_WAIT_L(n) asm volatile("s_waitcnt lgkmcnt(" #n ")" ::: "memory")
#define PG8_BAR __builtin_amdgcn_s_barrier()
#define PG8_SCHED __builtin_amdgcn_sched_barrier(0)
#define PG8_TA(u) ((const char*)g.A + ((size_t)(u).pm * BM * g.lda + (size_t)(u).aoff) * 2)
#define PG8_TB(u) ((const char*)g.Bt + ((size_t)(u).pn * BM * g.ldb + (size_t)(u).boff) * 2)
    Unit cur, nxt; int ui = 0;
    if (!S.next(0, cur)) return;
    f32x4 acc[2][2][4][2];
#pragma unroll
    for (int a = 0; a < 2; ++a)
#pragma unroll
        for (int b = 0; b < 2; ++b)
#pragma unroll
            for (int m = 0; m < 4; ++m)
#pragma unroll
                for (int n = 0; n < 2; ++n) acc[a][b][m][n] = (f32x4){0.f, 0.f, 0.f, 0.f};
    bf16x8 At[4][2], B0[2][2], B1[2][2];
    const char* cA = PG8_TA(cur); const char* cB = PG8_TB(cur);
    PG8_STAGE(PG8_SB(0, 0), cB, voffB); PG8_STAGE(PG8_SB(0, 1), cB + hB, voffB); PG8_STAGE(PG8_SA(0, 0), cA, voffA); PG8_STAGE(PG8_SA(0, 1), cA + hA, voffA);
    if (wr == 1) PG8_BAR;
    PG8_WAIT_V(2); PG8_BAR;
    PG8_STAGE(PG8_SB(1, 0), cB + kstep, voffB); PG8_STAGE(PG8_SA(1, 0), cA + kstep, voffA); PG8_STAGE(PG8_SB(1, 1), cB + hB + kstep, voffB);
    PG8_WAIT_V(6); PG8_BAR;
    for (;;) {
        const bool has_next = S.next(ui + 1, nxt);
        const char* nA = has_next ? PG8_TA(nxt) : cA; const char* nB = has_next ? PG8_TB(nxt) : cB;
        for (int t = 0; t < nt; t += 2) {
            const bool last = (t == nt - 2);
            const char* a1 = cA + (size_t)(t + 1) * kstep;
            const char* a2 = last ? nA : cA + (size_t)(t + 2) * kstep; const char* b2 = last ? nB : cB + (size_t)(t + 2) * kstep;
            const char* a3 = a2 + kstep; const char* b3 = b2 + kstep;
            PG8_LDB(B0, 0, 0); PG8_LDB(B1, 0, 1); PG8_SCHED; PG8_LDA(At, 0, 0); PG8_STAGE(PG8_SA(1, 1), a1 + hA, voffA);
            PG8_WAIT_V(8); PG8_WAIT_L(0); PG8_BAR; PG8_MMA(0, 0, At, B0); PG8_MMA(0, 1, At, B1); PG8_BAR; PG8_SCHED;
            PG8_LDA(At, 0, 1); PG8_STAGE(PG8_SB(0, 0), b2, voffB); PG8_STAGE(PG8_SB(0, 1), b2 + hB, voffB); PG8_STAGE(PG8_SA(0, 0), a2, voffA);
            PG8_WAIT_V(8); PG8_WAIT_L(0); PG8_BAR; PG8_MMA(1, 0, At, B0); PG8_MMA(1, 1, At, B1); PG8_BAR; PG8_SCHED;
            PG8_LDB(B0, 1, 0); PG8_LDB(B1, 1, 1); PG8_SCHED; PG8_LDA(At, 1, 0); PG8_STAGE(PG8_SA(0, 1), a2 + hA, voffA);
            PG8_WAIT_V(8); PG8_WAIT_L(0); PG8_BAR; PG8_MMA(0, 0, At, B0); PG8_MMA(0, 1, At, B1); PG8_BAR; PG8_SCHED;
            PG8_LDA(At, 1, 1); PG8_STAGE(PG8_SB(1, 0), b3, voffB); PG8_STAGE(PG8_SB(1, 1), b3 + hB, voffB); PG8_STAGE(PG8_SA(1, 0), a3, voffA);
            PG8_WAIT_V(8); PG8_WAIT_L(0); PG8_BAR; PG8_MMA(1, 0, At, B0); PG8_MMA(1, 1, At, B1); PG8_BAR; PG8_SCHED;
        }
        E(acc, cur, wr, wc, fr, fq);
        if (!has_next) break;
#pragma unroll
        for (int a = 0; a < 2; ++a)
#pragma unroll
            for (int b = 0; b < 2; ++b)
#pragma unroll
                for (int m = 0; m < 4; ++m)
#pragma unroll
                    for (int n = 0; n < 2; ++n) acc[a][b][m][n] = (f32x4){0.f, 0.f, 0.f, 0.f};
        cur = nxt; cA = nA; cB = nB; ++ui;
    }
    PG8_WAIT_V(0);
    if (wr == 0) PG8_BAR;
    PG8_BAR;
#undef PG8_SA
#undef PG8_SB
#undef PG8_STAGE
#undef PG8_LDA
#undef PG8_LDB
#undef PG8_MMA
#undef PG8_WAIT_V
#undef PG8_WAIT_L
#undef PG8_BAR
#undef PG8_SCHED
#undef PG8_TA
#undef PG8_TB
}

struct EpiIn {
    bf16_t *Q; bf16_t* ZR; float* outK; float qscale;
    __device__ __forceinline__ void operator()(const f32x4 (&acc)[2][2][4][2], const Unit& u, int wr, int wc, int fr, int fq) const {
#pragma unroll
        for (int bj = 0; bj < 2; ++bj) {
            const int c0 = u.pn * BM + bj * HALF + wc * 32 + 8 * fq;
            if (c0 >= NIN) continue;
#pragma unroll
            for (int ai = 0; ai < 2; ++ai)
#pragma unroll
                for (int m = 0; m < 4; ++m) {
                    int r = u.pm * BM + ai * HALF + wr * 64 + m * 16 + fr; asm volatile("" : "+v"(r));
                    f32x4 v0 = acc[ai][bj][m][0], v1 = acc[ai][bj][m][1];
                    if (c0 < 1536) {
                        const int seg = c0 >> 9, cc = c0 & 511;
                        if (seg == 0) { v0 = v0 * qscale; v1 = v1 * qscale; }
                        else if (r < NCTX) { float* o = outK + (size_t)(seg - 1) * ((size_t)NCTX * 512) + (size_t)r * 512 + cc; *(f32x4*)o = v0; *(f32x4*)(o + 4) = v1; }
                        bf16_t* dst = Q + (size_t)seg * ((size_t)NTOK * 512) + (size_t)r * 512 + cc;
                        u32x4 w; w.x = pk2(v0[0], v0[1]); w.y = pk2(v0[2], v0[3]); w.z = pk2(v1[0], v1[1]); w.w = pk2(v1[2], v1[3]);
                        *(u32x4*)dst = w;
                    } else {
                        u32x4 w; w.x = pk2(v0[0], v0[1]); w.y = pk2(v0[2], v0[3]); w.z = pk2(v1[0], v1[1]); w.w = pk2(v1[2], v1[3]);
                        *(u32x4*)(ZR + (size_t)r * RC + (c0 - 1536)) = w;
                    }
                }
        }
    }
};
DI float decay1(float x) { return __expf(-0.60653065971f * sigmoid_f(x)); }
struct EpiLora {
    float *DEC, *AA, *G; const float *w0, *a0;
    __device__ __forceinline__ void operator()(const f32x4 (&acc)[2][2][4][2], const Unit& u, int wr, int wc, int fr, int fq) const {
#pragma unroll
        for (int bj = 0; bj < 2; ++bj) {
            const int c0 = u.pn * BM + bj * HALF + wc * 32 + 8 * fq;
            const int grp = c0 >> 10, cg = c0 & 1023, dir = cg >> 9, cc = cg & 511;
            const float* bp = (grp == 0 ? w0 : a0) + dir * 512 + cc;
            float* ob = DEC + (size_t)dir * NTOK * 512 + cc;
            bf16_t* obh = grp == 2 ? (bf16_t*)G + cc : (bf16_t*)AA + (size_t)dir * NTOK * 512 + cc;
#pragma unroll
            for (int ai = 0; ai < 2; ++ai)
#pragma unroll
                for (int m = 0; m < 4; ++m) {
                    int r = u.pm * BM + ai * HALF + wr * 64 + m * 16 + fr; asm volatile("" : "+v"(r));
                    f32x4 v0 = acc[ai][bj][m][0], v1 = acc[ai][bj][m][1];
                    if (grp < 2) { const float* bq = bp; asm volatile("" : "+v"(bq)); v0 += *(const f32x4*)bq; v1 += *(const f32x4*)(bq + 4); }
                    if (grp == 0) { v0.x = decay1(v0.x); v0.y = decay1(v0.y); v0.z = decay1(v0.z); v0.w = decay1(v0.w); v1.x = decay1(v1.x); v1.y = decay1(v1.y); v1.z = decay1(v1.z); v1.w = decay1(v1.w); }
                    else if (grp == 1) { v0.x = sigmoid_f(v0.x); v0.y = sigmoid_f(v0.y); v0.z = sigmoid_f(v0.z); v0.w = sigmoid_f(v0.w); v1.x = sigmoid_f(v1.x); v1.y = sigmoid_f(v1.y); v1.z = sigmoid_f(v1.z); v1.w = sigmoid_f(v1.w); }
                    if (grp == 0) { float* o = ob + (size_t)r * 512; *(f32x4*)o = v0; *(f32x4*)(o + 4) = v1; }
                    else { u32x4 w; w.x = pk2(v0[0], v0[1]); w.y = pk2(v0[2], v0[3]); w.z = pk2(v1[0], v1[1]); w.w = pk2(v1[2], v1[3]); *(u32x4*)(obh + (size_t)r * 512) = w; }
                }
        }
    }
};
struct EpiPart {
    bf16_t* P; int ksplit;
    __device__ __forceinline__ void operator()(const f32x4 (&acc)[2][2][4][2], const Unit& u, int wr, int wc, int fr, int fq) const {
        bf16_t* base = P + (u.aoff ? (size_t)NTOK * D : 0);
#pragma unroll
        for (int bj = 0; bj < 2; ++bj) {
            const int c0 = u.pn * BM + bj * HALF + wc * 32 + 8 * fq;
#pragma unroll
            for (int ai = 0; ai < 2; ++ai)
#pragma unroll
                for (int m = 0; m < 4; ++m) {
                    int r = u.pm * BM + ai * HALF + wr * 64 + m * 16 + fr; asm volatile("" : "+v"(r));
                    const f32x4 v0 = acc[ai][bj][m][0], v1 = acc[ai][bj][m][1];
                    u32x4 w; w.x = pk2(v0[0], v0[1]); w.y = pk2(v0[2], v0[3]); w.z = pk2(v1[0], v1[1]); w.w = pk2(v1[2], v1[3]);
                    *(u32x4*)(base + (size_t)r * D + c0) = w;
                }
        }
    }
};
template <int CTRL> DI float dppf(float x) { return __builtin_bit_cast(float, __builtin_amdgcn_mov_dpp(__builtin_bit_cast(int, x), CTRL, 0xf, 0xf, true)); }
struct EpiFfnAct {
    bf16_t* ACT; float* EDGE; const float* wcv; LAS unsigned char* ldsb;
    __device__ __forceinline__ void operator()(const f32x4 (&acc)[2][2][4][2], const Unit& u, int wr, int wc, int fr, int fq) const {
        LAS float* HL = (LAS float*)(ldsb + 131072);
        const int colh = wc * 32 + 8 * fq;
#pragma unroll
        for (int ai = 0; ai < 2; ++ai) { const int g = ai * 2 + wr;
            if (fr == 0) { *(LAS f32x4*)(HL + (g * 2 + 0) * 128 + colh) = acc[ai][0][0][0]; *(LAS f32x4*)(HL + (g * 2 + 0) * 128 + colh + 4) = acc[ai][0][0][1]; }
            if (fr == 15) { *(LAS f32x4*)(HL + (g * 2 + 1) * 128 + colh) = acc[ai][0][3][0]; *(LAS f32x4*)(HL + (g * 2 + 1) * 128 + colh + 4) = acc[ai][0][3][1]; } }
        asm volatile("s_waitcnt lgkmcnt(0)" ::: "memory");
        __builtin_amdgcn_s_barrier(); __builtin_amdgcn_s_barrier();
        asm volatile("" ::: "memory");
        const int cf = u.pn * HALF + colh;
        const f32x4 zero = {0.f, 0.f, 0.f, 0.f};
        const bool lat = u.pm >= 16;
#pragma unroll
        for (int ai = 0; ai < 2; ++ai) {
            const int g = ai * 2 + wr;
            f32x4 hp[2], hn[2];
            hp[0] = g > 0 ? *(const LAS f32x4*)(HL + ((g - 1) * 2 + 1) * 128 + colh) : zero; hp[1] = g > 0 ? *(const LAS f32x4*)(HL + ((g - 1) * 2 + 1) * 128 + colh + 4) : zero;
            hn[0] = g < 3 ? *(const LAS f32x4*)(HL + ((g + 1) * 2 + 0) * 128 + colh) : zero; hn[1] = g < 3 ? *(const LAS f32x4*)(HL + ((g + 1) * 2 + 0) * 128 + colh + 4) : zero;
#pragma unroll
            for (int m = 0; m < 4; ++m) {
                int r = u.pm * BM + ai * HALF + wr * 64 + m * 16 + fr; asm volatile("" : "+v"(r));
                const float* wq_ = wcv + cf; asm volatile("" : "+v"(wq_));
                f32x4 uu[2], av[2];
#pragma unroll
                for (int n = 0; n < 2; ++n) {
                    const f32x4 cur = acc[ai][0][m][n];
                    f32x4 pv, nx;
#pragma unroll
                    for (int j = 0; j < 4; ++j) {
                        if (m > 0) pv[j] = dppf<0x121>(fr == 15 ? acc[ai][0][m > 0 ? m - 1 : 0][n][j] : cur[j]);
                        else { const float a = dppf<0x121>(cur[j]); pv[j] = fr == 0 ? hp[n][j] : a; }
                        if (m < 3) nx[j] = dppf<0x12F>(fr == 0 ? acc[ai][0][m < 3 ? m + 1 : 3][n][j] : cur[j]);
                        else { const float c = dppf<0x12F>(cur[j]); nx[j] = fr == 15 ? hn[n][j] : c; }
                    }
                    const f32x4 w0 = *(const f32x4*)(wq_ + 4 * n), w1 = *(const f32x4*)(wq_ + DFF + 4 * n), w2 = *(const f32x4*)(wq_ + 2 * DFF + 4 * n);
                    uu[n] = pv * w0 + cur * w1 + nx * w2;
                    const f32x4 a3 = acc[ai][1][m][n];
                    av[n] = (f32x4){silu_f(uu[n].x) * a3.x, silu_f(uu[n].y) * a3.y, silu_f(uu[n].z) * a3.z, silu_f(uu[n].w) * a3.w};
                }
                u32x4 w; w.x = pk2(av[0][0], av[0][1]); w.y = pk2(av[0][2], av[0][3]); w.z = pk2(av[1][0], av[1][1]); w.w = pk2(av[1][2], av[1][3]);
                *(u32x4*)(ACT + (size_t)r * DFF + cf) = w;
                if (lat && ((ai == 0 && m == 0) || (ai == 1 && m == 3))) {
                    const int e = ai;
                    const bool mine = e == 0 ? (wr == 0 && fr == 0) : (wr == 1 && fr == 15);
                    if (mine) {
                        float* eb = EDGE + ((size_t)u.pm * 2 + e) * DFF + cf;
                        *(f32x4*)(eb) = acc[ai][0][m][0]; *(f32x4*)(eb + 4) = acc[ai][0][m][1];
                        *(f32x4*)(eb + 64 * DFF) = uu[0]; *(f32x4*)(eb + 64 * DFF + 4) = uu[1];
                        *(f32x4*)(eb + 128 * DFF) = acc[ai][1][m][0]; *(f32x4*)(eb + 128 * DFF + 4) = acc[ai][1][m][1];
                    }
                }
            }
        }
    }
};
}

template <int MODE>
DI void transpose_item(const float* W, int K, int N, bf16_t* WT, LAS float* scr, int item, int lane) {
    const int nblk = N / 32, kb = item / nblk, nb = item % nblk, k0 = 64 * kb, n0 = 32 * nb;
#pragma unroll 8
    for (int i = 0; i < 32; ++i) { const int kk = 2 * i + (lane >> 5); scr[kk * 33 + (lane & 31)] = W[(size_t)(k0 + kk) * N + n0 + (lane & 31)]; }
    asm volatile("s_waitcnt lgkmcnt(0)" ::: "memory");
    const int c = lane & 7;
#pragma unroll
    for (int j = 0; j < 4; ++j) { const int n = (lane >> 3) + 8 * j; const LAS float* s = scr + (8 * c) * 33 + n;
        u32x4 o; o.x = pk2(s[0 * 33], s[1 * 33]); o.y = pk2(s[2 * 33], s[3 * 33]); o.z = pk2(s[4 * 33], s[5 * 33]); o.w = pk2(s[6 * 33], s[7 * 33]);
        const int nn = n0 + n; const int drow = MODE == 0 ? nn : ((nn >> 7) * 256 + (nn & 127) + (MODE == 2 ? 128 : 0));
        *(u32x4*)(WT + (size_t)drow * K + k0 + 8 * c) = o; }
    asm volatile("s_waitcnt lgkmcnt(0)" ::: "memory");
}

DI void phase0(KP p, LAS unsigned char* lds, int gw, int NGW, int gtid, int NGT, int wave, int lane, bool defer_ffn) {
    unsigned char* ws = p->ws;
    {
        float* MOD = (float*)(ws + WS_MOD);
        const float* w_ada = p->in[7]; const float* b_ada = p->in[8]; const float* c_lat = p->in[5]; const float* c_ctx = p->in[6];
        LAS float* red = (LAS float*)(lds + 8 * 8448);
        const int tid = wave * 64 + lane, cgp = lane & 15, kr = lane >> 4;
        for (int nb = blockIdx.x; nb < 96; nb += gridDim.x) {
            f32x4 a0 = {0, 0, 0, 0}, a1 = a0, a2 = a0;
#pragma unroll 8
            for (int i = 0; i < 32; ++i) {
                const int k = wave * 128 + 4 * i + kr;
                const f32x4 w = *(const f32x4*)(w_ada + (size_t)k * 6144 + nb * 64 + 4 * cgp);
                a0 += w * silu_f(c_ctx[k]); a1 += w * silu_f(c_lat[k]); a2 += w * silu_f(c_lat[D + k]);
            }
#pragma unroll
            for (int j = 0; j < 4; ++j) {
                a0[j] += __shfl_xor(a0[j], 16); a0[j] += __shfl_xor(a0[j], 32);
                a1[j] += __shfl_xor(a1[j], 16); a1[j] += __shfl_xor(a1[j], 32);
                a2[j] += __shfl_xor(a2[j], 16); a2[j] += __shfl_xor(a2[j], 32);
            }
            if (kr == 0) { *(LAS f32x4*)(red + (wave * 3 + 0) * 64 + 4 * cgp) = a0; *(LAS f32x4*)(red + (wave * 3 + 1) * 64 + 4 * cgp) = a1; *(LAS f32x4*)(red + (wave * 3 + 2) * 64 + 4 * cgp) = a2; }
            __syncthreads();
            if (tid < 192) {
                const int i = tid >> 6, c = tid & 63; float s = b_ada[nb * 64 + c];
#pragma unroll
                for (int w = 0; w < 8; ++w) s += red[(w * 3 + i) * 64 + c];
                MOD[i * 6144 + nb * 64 + c] = s;
            }
            __syncthreads();
        }
    }
    {
        LAS float* scr = (LAS float*)(lds + wave * 8448);
        constexpr int I_IN = 16 * 108, I_OUT = 16 * 32, I_F = 16 * 88, I_2 = 44 * 32, NIT = I_IN + I_OUT + 2 * I_F + I_2;
        const int nit = defer_ffn ? I_IN + I_OUT : NIT;
        for (int it = gw; it < nit; it += NGW) {
            int r = it;
            if (r < I_IN) { transpose_item<0>(p->in[11], D, NIN, (bf16_t*)(ws + WS_WTIN), scr, r, lane); continue; } r -= I_IN;
            if (r < I_OUT) { transpose_item<0>(p->in[24], D, D, (bf16_t*)(ws + WS_WTOUT), scr, r, lane); continue; } r -= I_OUT;
            if (r < I_F) { transpose_item<1>(p->in[25], D, DFF, (bf16_t*)(ws + WS_WT13), scr, r, lane); continue; } r -= I_F;
            if (r < I_F) { transpose_item<2>(p->in[26], D, DFF, (bf16_t*)(ws + WS_WT13), scr, r, lane); continue; } r -= I_F;
            transpose_item<0>(p->in[28], DFF, D, (bf16_t*)(ws + WS_WT2), scr, r, lane);
        }
    }
    { u32x4* z = (u32x4*)((bf16_t*)(ws + WS_WTIN) + (size_t)NIN * D); for (int i = gtid; i < 128 * D / 8; i += NGT) z[i] = (u32x4){0, 0, 0, 0}; }
    {
        bf16_t* WL = (bf16_t*)(ws + WS_WTLORA); const float* w2 = p->in[14]; const float* a2 = p->in[16]; const float* g2 = p->in[17];
        for (int i = gtid; i < 2560 * 128; i += NGT) {
            const int n = i >> 7, k = i & 127; float v = 0.f;
            if (n < 2048) { const int grp = n >> 10, dir = (n >> 9) & 1, c = n & 511; const float* src = grp == 0 ? w2 : a2;
                if ((k >> 6) == dir) v = src[((size_t)dir * 64 + (k & 63)) * 512 + c]; }
            else v = g2[(size_t)k * 512 + (n - 2048)];
            WL[i] = (bf16_t)(pk2(v, 0.f) & 0xffffu);
        }
    }
    {
        const f32x4* ck = (const f32x4*)p->in[2]; const f32x4* cv = (const f32x4*)p->in[3]; u32x2* CK = (u32x2*)(ws + WS_CK); u32x2* CV = (u32x2*)(ws + WS_CV);
        for (int i = gtid; i < 1024 * 512 / 4; i += NGT) { const f32x4 a = ck[i], b = cv[i]; CK[i] = (u32x2){pk2(a[0], a[1]), pk2(a[2], a[3])}; CV[i] = (u32x2){pk2(b[0], b[1]), pk2(b[2], b[3])}; }
    }
}

DI void ffn_transposes(KP p, LAS unsigned char* lds, int which, int widx, int nw, int wave, int lane) {
    LAS float* scr = (LAS float*)(lds + wave * 8448);
    constexpr int I_F = 16 * 88, I_2 = 44 * 32;
    if (which == 0) { for (int it = widx; it < I_2; it += nw) transpose_item<0>(p->in[28], DFF, D, (bf16_t*)(p->ws + WS_WT2), scr, it, lane); }
    else { for (int it = widx; it < 2 * I_F; it += nw) { if (it < I_F) transpose_item<1>(p->in[25], D, DFF, (bf16_t*)(p->ws + WS_WT13), scr, it, lane);
                                                           else transpose_item<2>(p->in[26], D, DFF, (bf16_t*)(p->ws + WS_WT13), scr, it - I_F, lane); } }
}

template <int SRC, int NR>
DI void norm_rows(KP p, int rbase, int rstride, int lane, const float* normw, int sh_off, int sc_off, int gate_off, bf16_t* Hout, float* xout) {
    const float* MODb = (const float*)(p->ws + WS_MOD);
    const bf16_t* PART = (const bf16_t*)(p->ws + WS_PART);
    f32x4 v[NR][4];
#pragma unroll
    for (int q = 0; q < NR; ++q) { const f32x4* xr = (const f32x4*)xrow_of(p, rbase + q * rstride) + lane;
#pragma unroll
        for (int j = 0; j < 4; ++j) v[q][j] = xr[64 * j]; }
    if (SRC == 1) {
        u32x2 p0[NR][4], p1[NR][4];
#pragma unroll
        for (int q = 0; q < NR; ++q) { const int r = rbase + q * rstride;
#pragma unroll
            for (int j = 0; j < 4; ++j) { p0[q][j] = *((const u32x2*)(PART + (size_t)r * D) + lane + 64 * j); p1[q][j] = *((const u32x2*)(PART + (size_t)(NTOK + r) * D) + lane + 64 * j); } }
#pragma unroll
        for (int q = 0; q < NR; ++q) { const int r = rbase + q * rstride; const float* MOD = MODb + midx_of(r) * 6144;
#pragma unroll
            for (int j = 0; j < 4; ++j) { const f32x4 gt = *((const f32x4*)(MOD + gate_off) + lane + 64 * j); v[q][j] = v[q][j] + gt * (unpk4(p0[q][j]) + unpk4(p1[q][j])); } }
    }
    float s[NR];
#pragma unroll
    for (int q = 0; q < NR; ++q) { s[q] = 0.f;
#pragma unroll
        for (int j = 0; j < 4; ++j) s[q] += (v[q][j].x * v[q][j].x + v[q][j].y * v[q][j].y) + (v[q][j].z * v[q][j].z + v[q][j].w * v[q][j].w); }
#pragma unroll
    for (int o = 1; o < 64; o <<= 1) {
#pragma unroll
        for (int q = 0; q < NR; ++q) s[q] += __shfl_xor(s[q], o); }
#pragma unroll
    for (int q = 0; q < NR; ++q) {
        const int r = rbase + q * rstride; const float* MOD = MODb + midx_of(r) * 6144;
        const float rstd = rsqrtf(s[q] * (1.f / D) + EPS);
        u32x2* o = (u32x2*)(Hout + (size_t)r * D) + lane;
#pragma unroll
        for (int j = 0; j < 4; ++j) {
            if (SRC == 1) *((f32x4*)(xout + (size_t)r * D) + lane + 64 * j) = v[q][j];
            const f32x4 g = *((const f32x4*)normw + lane + 64 * j), sc = *((const f32x4*)(MOD + sc_off) + lane + 64 * j), sh = *((const f32x4*)(MOD + sh_off) + lane + 64 * j);
            const f32x4 h = v[q][j] * rstd * g * (sc + 1.f) + sh;
            o[64 * j] = (u32x2){pk2(h.x, h.y), pk2(h.z, h.w)};
        }
    }
}

#define MFMA32(a, b, c) __builtin_amdgcn_mfma_f32_32x32x16_bf16((a), (b), (c), 0, 0, 0)
DI int crow(int reg, int h) { return (reg & 3) + 8 * (reg >> 2) + 4 * h; }
typedef short v4i16_t __attribute__((ext_vector_type(4)));
DI s16x4 vtr(const LAS unsigned char* p) { return __builtin_bit_cast(s16x4, __builtin_amdgcn_ds_read_tr16_b64_v4i16((LAS v4i16_t*)p)); }

template <bool LATENT, int MODE>
DI void attn_unit(KP p, LAS unsigned char* vbuf, const LAS float* rpbL, int unit, int lane, int t0, int t1, LAS float* xch) {
    const bf16_t* Q = (const bf16_t*)(p->ws + WS_Q); const bf16_t* Kb = (const bf16_t*)(p->ws + WS_K); const bf16_t* Vb = (const bf16_t*)(p->ws + WS_V);
    const bf16_t* CK = (const bf16_t*)(p->ws + WS_CK); const bf16_t* CV = (const bf16_t*)(p->ws + WS_CV);
    bf16_t* MIX = (bf16_t*)(p->ws + WS_MIX);
    const int r = lane & 31, hh = lane >> 5;
    int head, qrow0, b, gi = 0, w0 = 0, si = 0, ntile;
    if (LATENT) { head = unit & 7; const int t = unit >> 3; w0 = (t & 1) * 32; gi = (t >> 1) & 31; b = t >> 6; qrow0 = NCTX + b * DSEQ + gi * 64 + w0; si = min(max(gi - 4, 0), 24); ntile = 32; }
    else { head = unit & 7; const int t = unit >> 3; const int qb = t & 7; b = t >> 3; qrow0 = b * SEQ + qb * 32; ntile = 8; }
    bf16x8 qf[4];
#pragma unroll
    for (int s = 0; s < 4; ++s) qf[s] = *(const bf16x8*)(Q + (size_t)(qrow0 + r) * 512 + head * 64 + 16 * s + 8 * hh);
    auto tile_ptrs = [&](int t, const bf16_t*& kp, const bf16_t*& vp) {
        if (LATENT) {
            if (t < 16) { const size_t row = (size_t)b * 512 + t * 32; kp = CK + row * 512; vp = CV + row * 512; }
            else { const int lt = t - 16; const size_t row = (size_t)NCTX + b * DSEQ + (si + (lt >> 1)) * 64 + (((lt & 1) * 32) ^ w0); kp = Kb + row * 512; vp = Vb + row * 512; }
        } else { const size_t row = (size_t)b * SEQ + t * 32; kp = Kb + row * 512; vp = Vb + row * 512; }
    };
    bf16x8 kf[4], kn[4]; u32x4 vn[4];
    {
        const bf16_t *kp, *vp; tile_ptrs(t0, kp, vp);
#pragma unroll
        for (int s = 0; s < 4; ++s) kf[s] = *(const bf16x8*)(kp + (size_t)r * 512 + head * 64 + 16 * s + 8 * hh);
#pragma unroll
        for (int i = 0; i < 4; ++i) { const int c = lane + 64 * i; vn[i] = *(const u32x4*)(vp + (size_t)(c >> 3) * 512 + head * 64 + (c & 7) * 8); }
#pragma unroll
        for (int i = 0; i < 4; ++i) { const int c = lane + 64 * i; *(LAS u32x4*)(vbuf + (c >> 3) * 144 + (c & 7) * 16) = vn[i]; }
    }
    f32x16 o0, o1;
#pragma unroll
    for (int i = 0; i < 16; ++i) { o0[i] = 0.f; o1[i] = 0.f; }
    float mrun = -1e30f, lrun = 0.f;
    const int i16 = lane & 15, tq = i16 >> 2, tp = i16 & 3, blk = (lane >> 4) & 1;
    const LAS unsigned char* vtbase = vbuf + (4 * hh + tq) * 144 + (16 * blk) * 2 + 8 * tp;
    const int wq = w0 + r;
    const int cs = min(max(wq - 8, 0), 48);
    for (int t = t0; t < t1; ++t) {
        const bool more = (t + 1 < t1);
        if (more) {
            const bf16_t *kp, *vp; tile_ptrs(t + 1, kp, vp);
#pragma unroll
            for (int s = 0; s < 4; ++s) kn[s] = *(const bf16x8*)(kp + (size_t)r * 512 + head * 64 + 16 * s + 8 * hh);
#pragma unroll
            for (int i = 0; i < 4; ++i) { const int c = lane + 64 * i; vn[i] = *(const u32x4*)(vp + (size_t)(c >> 3) * 512 + head * 64 + (c & 7) * 8); }
        }
        f32x16 st;
#pragma unroll
        for (int i = 0; i < 16; ++i) st[i] = 0.f;
#pragma unroll
        for (int s = 0; s < 4; ++s) st = MFMA32(kf[s], qf[s], st);
        if (LATENT && t >= 16) {
            const int lt = t - 16, a = lt >> 1, c0 = ((lt & 1) * 32) ^ w0;
            const int row_off = si + a - gi + 7;
            const int d0 = c0 + 4 * hh - cs;
            const LAS float* bp = rpbL + head * 465 + row_off * 31 + (c0 + 4 * hh - wq + 15);
#pragma unroll
            for (int i = 0; i < 16; ++i) {
                const int ci = (i & 3) + 8 * (i >> 2);
                const bool valid = (unsigned)(d0 + ci) < 16u;
                const float bias = valid ? bp[ci] : 0.f;
                st[i] = valid ? st[i] + bias : -INFINITY;
            }
        }
        float tmax = st[0];
#pragma unroll
        for (int i = 1; i < 16; ++i) tmax = fmaxf(tmax, st[i]);
        tmax = fmaxf(tmax, __shfl_xor(tmax, 32));
        const float mnew = fmaxf(mrun, tmax);
        float ps = 0.f;
#pragma unroll
        for (int i = 0; i < 16; ++i) { st[i] = __builtin_amdgcn_exp2f(st[i] - mnew); ps += st[i]; }
        if (__builtin_amdgcn_ballot_w64(tmax > mrun) != 0ull) {
            const float alpha = __builtin_amdgcn_exp2f(mrun - mnew);
            lrun *= alpha;
#pragma unroll
            for (int i = 0; i < 16; ++i) { o0[i] *= alpha; o1[i] *= alpha; }
        }
        lrun += ps; mrun = mnew;
        bf16x8 pb[2];
#pragma unroll
        for (int s = 0; s < 2; ++s) { u32x4 w; w.x = pk2(st[8 * s], st[8 * s + 1]); w.y = pk2(st[8 * s + 2], st[8 * s + 3]); w.z = pk2(st[8 * s + 4], st[8 * s + 5]); w.w = pk2(st[8 * s + 6], st[8 * s + 7]); pb[s] = __builtin_bit_cast(bf16x8, w); }
        asm volatile("s_waitcnt lgkmcnt(0)" ::: "memory");
#pragma unroll
        for (int s = 0; s < 2; ++s) {
            const LAS unsigned char* bs = vtbase + (16 * s) * 144;
            const s16x4 lo0 = vtr(bs), hi0 = vtr(bs + 8 * 144), lo1 = vtr(bs + 64), hi1 = vtr(bs + 8 * 144 + 64);
            const bf16x8 va0 = __builtin_shufflevector(lo0, hi0, 0, 1, 2, 3, 4, 5, 6, 7), va1 = __builtin_shufflevector(lo1, hi1, 0, 1, 2, 3, 4, 5, 6, 7);
            o0 = MFMA32(va0, pb[s], o0); o1 = MFMA32(va1, pb[s], o1);
        }
        asm volatile("s_waitcnt lgkmcnt(0)" ::: "memory");
        if (more) {
#pragma unroll
            for (int i = 0; i < 4; ++i) { const int c = lane + 64 * i; *(LAS u32x4*)(vbuf + (c >> 3) * 144 + (c & 7) * 16) = vn[i]; }
#pragma unroll
            for (int s = 0; s < 4; ++s) kf[s] = kn[s];
        }
    }
    if (MODE == 1) {
#pragma unroll
        for (int i = 0; i < 16; ++i) { xch[i * 64 + lane] = o0[i]; xch[(16 + i) * 64 + lane] = o1[i]; }
        xch[32 * 64 + lane] = mrun; xch[33 * 64 + lane] = lrun;
        __syncthreads();
        return;
    }
    if (MODE == 2) {
        __syncthreads();
        const float mb = xch[32 * 64 + lane], lb = xch[33 * 64 + lane];
        const float mm = fmaxf(mrun, mb), fa = exp2f(mrun - mm), fb = exp2f(mb - mm);
#pragma unroll
        for (int i = 0; i < 16; ++i) { o0[i] = o0[i] * fa + xch[i * 64 + lane] * fb; o1[i] = o1[i] * fa + xch[(16 + i) * 64 + lane] * fb; }
        lrun = lrun * fa + lb * fb;
    }
    const float ltot = lrun + __shfl_xor(lrun, 32);
    const float inv = 1.f / ltot;
    bf16_t* orow = MIX + (size_t)(qrow0 + r) * D + head * 64;
#pragma unroll
    for (int g4 = 0; g4 < 4; ++g4) {
        const int d = 8 * g4 + 4 * hh;
        *(u32x2*)(orow + d) = (u32x2){pk2(o0[4 * g4] * inv, o0[4 * g4 + 1] * inv), pk2(o0[4 * g4 + 2] * inv, o0[4 * g4 + 3] * inv)};
        *(u32x2*)(orow + 32 + d) = (u32x2){pk2(o1[4 * g4] * inv, o1[4 * g4 + 1] * inv), pk2(o1[4 * g4 + 2] * inv, o1[4 * g4 + 3] * inv)};
    }
}

DI void prep_rows8(KP p, int r0, int lane) {
    const bf16_t* ZR = (const bf16_t*)(p->ws + WS_ZR); const float* wts = p->in[12]; const float* k_k = p->in[18];
    bf16_t* R = (bf16_t*)(p->ws + WS_R); bf16_t* KR = (bf16_t*)(p->ws + WS_KR); bf16_t* VV = (bf16_t*)(p->ws + WS_VV); bf16_t* KK = (bf16_t*)(p->ws + WS_KK);
    bf16_t* AL = (bf16_t*)(p->ws + WS_ALORA);
    const int t0 = r0 < NCTX ? (r0 & 255) : ((r0 - NCTX) & 2047); const int T = r0 < NCTX ? SEQ : DSEQ;
    const bool hp = t0 > 0, hn = t0 + 8 < T;
    const bf16_t* zb = ZR + (size_t)(r0 - 1) * RC;
    const f32x4 zero = {0, 0, 0, 0};
#pragma unroll 1
    for (int seg = 0; seg < 3; ++seg) {
        const int c = seg * 512 + lane * 8;
        f32x4 z[10][2];
#pragma unroll
        for (int i = 0; i < 10; ++i) { const bool ok = (i > 0 || hp) && (i < 9 || hn);
            if (ok) { const u32x4 w = *(const u32x4*)(zb + (size_t)i * RC + c); z[i][0] = unpk4((u32x2){w.x, w.y}); z[i][1] = unpk4((u32x2){w.z, w.w}); } else { z[i][0] = zero; z[i][1] = zero; } }
        const f32x4 wa0 = *(const f32x4*)(wts + c), wa1 = *(const f32x4*)(wts + c + 4), wb0 = *(const f32x4*)(wts + RC + c), wb1 = *(const f32x4*)(wts + RC + c + 4),
                    wc0 = *(const f32x4*)(wts + 2 * RC + c), wc1 = *(const f32x4*)(wts + 2 * RC + c + 4);
        const f32x4 k0 = *(const f32x4*)(k_k + lane * 8), k1 = *(const f32x4*)(k_k + lane * 8 + 4);
        bf16_t* dstb = (seg == 0 ? R : (seg == 1 ? KR : VV)) + (size_t)r0 * 512 + lane * 8;
#pragma unroll
        for (int i = 0; i < 8; ++i) {
            const f32x4 u0 = z[i][0] * wa0 + z[i + 1][0] * wb0 + z[i + 2][0] * wc0, u1 = z[i][1] * wa1 + z[i + 1][1] * wb1 + z[i + 2][1] * wc1;
            *(u32x4*)(dstb + (size_t)i * 512) = (u32x4){pk2(u0.x, u0.y), pk2(u0.z, u0.w), pk2(u1.x, u1.y), pk2(u1.z, u1.w)};
            if (seg == 1) {
                const f32x4 a = u0 * k0, bq = u1 * k1;
                float sq = (a.x * a.x + a.y * a.y) + (a.z * a.z + a.w * a.w) + (bq.x * bq.x + bq.y * bq.y) + (bq.z * bq.z + bq.w * bq.w);
                sq += __shfl_xor(sq, 1); sq += __shfl_xor(sq, 2); sq += __shfl_xor(sq, 4);
                const float rn = rsqrtf(sq + 1e-12f);
                const f32x4 ka_ = a * rn, kb_ = bq * rn; *(u32x4*)(KK + (size_t)(r0 + i) * 512 + lane * 8) = (u32x4){pk2(ka_.x, ka_.y), pk2(ka_.z, ka_.w), pk2(kb_.x, kb_.y), pk2(kb_.z, kb_.w)};
            }
        }
    }
    {
        const int cl = lane * 6, cc = 1536 + cl;
        const f32x2 zero2 = {0, 0};
        f32x2 z[10][3];
#pragma unroll
        for (int i = 0; i < 10; ++i) { const bool ok = (i > 0 || hp) && (i < 9 || hn);
#pragma unroll
            for (int q = 0; q < 3; ++q) { if (ok) { const unsigned w = *(const unsigned*)(zb + (size_t)i * RC + cc + 2 * q); z[i][q] = (f32x2){__builtin_bit_cast(float, w << 16), __builtin_bit_cast(float, w & 0xffff0000u)}; } else z[i][q] = zero2; } }
#pragma unroll
        for (int q = 0; q < 3; ++q) {
            const f32x2 wa = *(const f32x2*)(wts + cc + 2 * q), wb = *(const f32x2*)(wts + RC + cc + 2 * q), wcq = *(const f32x2*)(wts + 2 * RC + cc + 2 * q);
            const int cq = cl + 2 * q, grp = cq >> 7, k = cq & 127;
#pragma unroll
            for (int i = 0; i < 8; ++i) {
                f32x2 u = z[i][q] * wa + z[i + 1][q] * wb + z[i + 2][q] * wcq;
                if (grp == 0) { u.x = tanh_f(u.x); u.y = tanh_f(u.y); }
                else if (grp == 2) { u.x = sigmoid_f(u.x); u.y = sigmoid_f(u.y); }
                *(unsigned*)(AL + ((size_t)grp * NTOK + r0 + i) * 128 + k) = pk2(u.x, u.y);
            }
        }
    }
}

template <int CTRL> DI float dppf_(float x) { return __builtin_bit_cast(float, __builtin_amdgcn_mov_dpp(__builtin_bit_cast(int, x), CTRL, 0xf, 0xf, true)); }
template <int CTRL> DI float dpp_add(float x) { const int y = __builtin_amdgcn_mov_dpp(__builtin_bit_cast(int, x), CTRL, 0xf, 0xf, true); return x + __builtin_bit_cast(float, y); }
DI float red16(float x) { x = dpp_add<0xB1>(x); x = dpp_add<0x4E>(x); x = dpp_add<0x141>(x); x = dpp_add<0x140>(x); return x; }

constexpr int TC = 16;
DI float tred4(float q0, float q1, float q2, float q3, bool b0, bool b1) {
    const float ka = b0 ? q2 : q0, kb = b0 ? q3 : q1, sa = b0 ? q0 : q2, sb = b0 ? q1 : q3;
    const float a = ka + dppf_<0xB1>(sa), b = kb + dppf_<0xB1>(sb);
    float c = (b1 ? b : a) + dppf_<0x4E>(b1 ? a : b);
    c += dppf_<0x124>(c);
    c += dppf_<0x128>(c);
    return c;
}
DI f32x2 lo2(f32x4 v) { return __builtin_shufflevector(v, v, 0, 1); }
DI f32x2 hi2(f32x4 v) { return __builtin_shufflevector(v, v, 2, 3); }
struct ScanOps { f32x4 kk, rr, ww, bb, kd; float vv; };
struct ScanLd { f32x4 kk, r, dec, aa, kr, v; };
DI void scan_item(KP p, LAS unsigned char* lds, int latent, int sc, int qr, int tid) {
    const bf16_t* KK = (const bf16_t*)(p->ws + WS_KK); const bf16_t* R = (const bf16_t*)(p->ws + WS_R); const bf16_t* KR = (const bf16_t*)(p->ws + WS_KR);
    const bf16_t* VV = (const bf16_t*)(p->ws + WS_VV); const float* k_a = p->in[19];
    float* Y = (float*)(p->ws + WS_Y);
    const int b = sc >> 4, dir = (sc >> 3) & 1, h = sc & 7;
    const int T = latent ? DSEQ : SEQ; const size_t rowbase = latent ? (size_t)NCTX + (size_t)b * DSEQ : (size_t)b * SEQ;
    const float* DEC = (const float*)(p->ws + WS_DEC) + (size_t)dir * NTOK * 512; const bf16_t* AA = (const bf16_t*)(p->ws + WS_AA) + (size_t)dir * NTOK * 512;
    float* Yd = Y + (size_t)dir * NTOK * 512;
    LAS float* buf = (LAS float*)lds;
    LAS float* vb = (LAS float*)(lds + 2 * TC * 320 * 4);
    const int wave = tid >> 6, lane = tid & 63;
    const bool consumer = wave < 4;
    const int nchunk = T / TC;
    const int rl = lane >> 4, ks = lane & 15, row = 16 * qr + 4 * wave + rl;
    f32x2 S01 = {0, 0}, S23 = {0, 0};
    if (consumer && latent) { const f32x4 s4 = *(const f32x4*)(p->in[4] + ((((size_t)b * 2 + dir) * 8 + h) * 64 + row) * 64 + 4 * ks); S01 = lo2(s4); S23 = hi2(s4); }
    const int lt = tid - 256, lj = lt >> 4, li = lt & 15;
    ScanLd L0, L1; f32x4 ka4 = {0, 0, 0, 0};
    if (!consumer) ka4 = *(const f32x4*)(k_a + h * 64 + 4 * li);
    float* ybase = Yd + (rowbase)*512 + h * 64 + row;
    const bool kb0 = (ks & 1) != 0, kb1 = (ks & 2) != 0; const int ystep = 4 * (ks >> 2) + 2 * (ks & 1) + ((ks >> 1) & 1);
#define SCAN_LOAD(L, c) do { const int idx = (c) * TC + lj; const int tt = dir ? T - 1 - idx : idx; const size_t off = (rowbase + tt) * 512 + h * 64 + 4 * li; \
        L.kk = unpk4(*(const u32x2*)(KK + off)); L.r = unpk4(*(const u32x2*)(R + off)); L.dec = *(const f32x4*)(DEC + off); L.aa = unpk4(*(const u32x2*)(AA + off)); L.kr = unpk4(*(const u32x2*)(KR + off)); \
        if (lt < 64) { const int vj = lt >> 2, vq = lt & 3; const int idv = (c) * TC + vj; const int tv = dir ? T - 1 - idv : idv; L.v = unpk4(*(const u32x2*)(VV + (rowbase + tv) * 512 + h * 64 + 16 * qr + 4 * vq)); } } while (0)
#define SCAN_WRITE(L, bc, vc) do { const f32x4 bb_ = L.kk * L.aa; const f32x4 kd_ = L.kr * ((L.aa - 1.f) * ka4 + 1.f); LAS float* d_ = (bc) + lj * 320 + 4 * li; \
        *(LAS f32x4*)(d_) = L.kk; *(LAS f32x4*)(d_ + 64) = L.r; *(LAS f32x4*)(d_ + 128) = L.dec; *(LAS f32x4*)(d_ + 192) = bb_; *(LAS f32x4*)(d_ + 256) = kd_; \
        if (lt < 64) *(LAS f32x4*)((vc) + (lt >> 2) * 16 + 4 * (lt & 3)) = L.v; } while (0)
#define SCAN_LDOPS(o, bc, vc, j) do { const LAS float* d_ = (bc) + (j) * 320 + 4 * ks; o.kk = *(const LAS f32x4*)(d_); o.rr = *(const LAS f32x4*)(d_ + 64); o.ww = *(const LAS f32x4*)(d_ + 128); \
        o.bb = *(const LAS f32x4*)(d_ + 192); o.kd = *(const LAS f32x4*)(d_ + 256); o.vv = (vc)[(j) * 16 + 4 * wave + rl]; } while (0)
#define SCAN_COMPUTE(bc, vc, c) do { ScanOps oc, on, on2; SCAN_LDOPS(oc, bc, vc, 0); SCAN_LDOPS(on, bc, vc, 1); float ysel = 0.f; float yp0 = 0.f, yp1 = 0.f, yp2 = 0.f; \
        _Pragma("unroll") for (int j = 0; j < TC; ++j) { \
            if (j + 2 < TC) SCAN_LDOPS(on2, bc, vc, j + 2);     \
            f32x2 pq = S01 * lo2(oc.kk); pq = S23 * hi2(oc.kk) + pq; \
            const float sa = red16(pq.x + pq.y); \
            const f32x2 t01 = S01 * lo2(oc.ww) + lo2(oc.kd) * oc.vv, t23 = S23 * hi2(oc.ww) + hi2(oc.kd) * oc.vv; \
            S01 = t01 - lo2(oc.bb) * sa; S23 = t23 - hi2(oc.bb) * sa; \
            f32x2 yq = S01 * lo2(oc.rr); yq = S23 * hi2(oc.rr) + yq; \
            const float yp = yq.x + yq.y; \
            if ((j & 3) == 0) yp0 = yp; else if ((j & 3) == 1) yp1 = yp; else if ((j & 3) == 2) yp2 = yp; \
            else { const float yr = tred4(yp0, yp1, yp2, yp, kb0, kb1); ysel = ((ks >> 2) == (j >> 2)) ? yr : ysel; } \
            oc = on; on = on2; \
            asm volatile("" ::: "memory"); } \
        { const int idx = (c) * TC + ystep; const int tt = dir ? T - 1 - idx : idx; ybase[(size_t)tt * 512] = ysel; } } while (0)
    if (!consumer) { SCAN_LOAD(L0, 0); SCAN_LOAD(L1, 1); }
    for (int c = 0; c < nchunk; c += 2) {
        if (!consumer) SCAN_WRITE(L0, buf, vb);
        __syncthreads();
        if (!consumer) { if (c + 2 < nchunk) SCAN_LOAD(L0, c + 2); }
        else SCAN_COMPUTE(buf, vb, c);
        if (!consumer) SCAN_WRITE(L1, buf + TC * 320, vb + TC * 16);
        __syncthreads();
        if (!consumer) { if (c + 3 < nchunk) SCAN_LOAD(L1, c + 3); }
        else SCAN_COMPUTE(buf + TC * 320, vb + TC * 16, c + 1);
    }
#undef SCAN_LOAD
#undef SCAN_WRITE
#undef SCAN_LDOPS
#undef SCAN_COMPUTE
    if (consumer && !latent) *(f32x4*)(p->out + OUT_S + ((((size_t)b * 2 + dir) * 8 + h) * 64 + row) * 64 + 4 * ks) = (f32x4){S01.x, S01.y, S23.x, S23.y};
    __syncthreads();
}

constexpr int CS_L = 32, CS_LAT = 2048, CS_CHUNKS = 4096;
DI unsigned char* cs_mf(unsigned char* ws, int q) { return ws + 28 * MiB + (size_t)q * 8192; }
DI unsigned char* cs_q1(unsigned char* ws, int q) { return q < CS_LAT ? ws + 60 * MiB + (size_t)q * 4096 : ws + 76 * MiB + (size_t)(q - CS_LAT) * 4096; }
DI unsigned char* cs_q2(unsigned char* ws, int q) { return q < CS_LAT ? ws + 92 * MiB + (size_t)q * 4096 : ws + 108 * MiB + (size_t)(q - CS_LAT) * 4096; }
DI unsigned char* cs_nt(unsigned char* ws, int q) { return q < CS_LAT ? ws + 202 * MiB + (size_t)q * 8192 : ws + 234 * MiB + (size_t)(q - CS_LAT) * 8192; }
constexpr int CS_G = 51456;
DI bf16x8 frag_nat(const LAS unsigned char* img, int pitch, int rc, int s, int hh) { return *(const LAS bf16x8*)(img + rc * pitch + (16 * s + 8 * hh) * 2); }
DI bf16x8 frag_krow(const LAS unsigned char* img, int pitch, int rc, int s, int hh) {
    const s16x4 lo = *(const LAS s16x4*)(img + rc * pitch + (16 * s + 4 * hh) * 2), hi = *(const LAS s16x4*)(img + rc * pitch + (16 * s + 8 + 4 * hh) * 2);
    return __builtin_shufflevector(lo, hi, 0, 1, 2, 3, 4, 5, 6, 7); }
DI bf16x8 frag_tr(const LAS unsigned char* img, int pitch, int col0, int s, int lane) {
    const int i16 = lane & 15, tq = i16 >> 2, tp = i16 & 3, blk = (lane >> 4) & 1, hh = lane >> 5;
    const LAS unsigned char* bs = img + (16 * s + 4 * hh + tq) * pitch + (col0 + 16 * blk) * 2 + 8 * tp;
    const s16x4 lo = vtr(bs), hi = vtr(bs + 8 * pitch);
    return __builtin_shufflevector(lo, hi, 0, 1, 2, 3, 4, 5, 6, 7); }
template <int S> DI bf16x8 pack8(const f32x16& x, float sg) {
    u32x4 w; w.x = pk2(sg * x[8 * S], sg * x[8 * S + 1]); w.y = pk2(sg * x[8 * S + 2], sg * x[8 * S + 3]); w.z = pk2(sg * x[8 * S + 4], sg * x[8 * S + 5]); w.w = pk2(sg * x[8 * S + 6], sg * x[8 * S + 7]);
    return __builtin_bit_cast(bf16x8, w); }
template <int S> DI bf16x8 pack8lo(const f32x16& x, bf16x8 hi) {
    const u32x4 h = __builtin_bit_cast(u32x4, hi); float d[8];
#pragma unroll
    for (int j = 0; j < 4; ++j) { d[2 * j] = x[8 * S + 2 * j] - __builtin_bit_cast(float, h[j] << 16); d[2 * j + 1] = x[8 * S + 2 * j + 1] - __builtin_bit_cast(float, h[j] & 0xffff0000u); }
    u32x4 w; w.x = pk2(d[0], d[1]); w.y = pk2(d[2], d[3]); w.z = pk2(d[4], d[5]); w.w = pk2(d[6], d[7]);
    return __builtin_bit_cast(bf16x8, w); }
DI void lds_barrier() { asm volatile("s_waitcnt lgkmcnt(0)" ::: "memory"); __builtin_amdgcn_s_barrier(); asm volatile("" ::: "memory"); }
DI f32x16 zero16() { f32x16 z;
#pragma unroll
    for (int i = 0; i < 16; ++i) z[i] = 0.f;
    return z; }

DI void cs_phaseA(KP p, LAS unsigned char* lds, int tid, int qbase, int nit, int first, int stride) {
    const bf16_t* KK = (const bf16_t*)(p->ws + WS_KK); const bf16_t* R = (const bf16_t*)(p->ws + WS_R); const bf16_t* KR = (const bf16_t*)(p->ws + WS_KR);
    const bf16_t* VV = (const bf16_t*)(p->ws + WS_VV); const float* k_a = p->in[19];
    const int wave = tid >> 6, lane = tid & 63, g = wave >> 2, wq = wave & 3, tg = wq * 64 + lane, hh = lane >> 5, r32 = lane & 31;
    LAS unsigned char* L = lds + g * CS_G;
    LAS unsigned char* MKK = L, *MBT = L + 4608, *MKT = L + 2 * 4608, *MRT = L + 3 * 4608, *MBH = L + 4 * 4608, *MKH = L + 5 * 4608, *MVM = L + 6 * 4608;
    LAS float* AF = (LAS float*)(L + 32256);
    LAS unsigned char* ST = L + 36352, *SKK = ST + 2560, *SRB = ST + 2 * 2560, *SRK = ST + 3 * 2560;
    LAS float* SEG = (LAS float*)(L + 46592); LAS float* ELv = (LAS float*)(L + 48640);
    LAS unsigned char* SA = L + 48896;
    f32x2 lwN[4], kkN[4], aaN[4], krN[4], rN[4]; u32x4 vmN;
#define CSA_FETCH(it_) do { const int q_ = qbase + (it_) * 2 + g; const bool lat_ = q_ < CS_LAT; const int sc_ = lat_ ? (q_ >> 6) : ((q_ - CS_LAT) >> 3), ci_ = lat_ ? (q_ & 63) : (q_ & 7), TT_ = lat_ ? DSEQ : SEQ; \
        const int b_ = sc_ >> 4, dir_ = (sc_ >> 3) & 1, h_ = sc_ & 7; const int rb_ = lat_ ? NCTX + b_ * DSEQ : b_ * SEQ; \
          \
        const int t0_ = dir_ ? TT_ - 1 - ci_ * CS_L : ci_ * CS_L, sg_ = dir_ ? -512 : 512; \
        const unsigned ub_ = (unsigned)((rb_ + t0_) * 512 + h_ * 64); \
        const unsigned o0_ = ub_ + (unsigned)(sg_ * 4 * (tg >> 5) + 2 * (tg & 31)); \
        const float* DEC_ = (const float*)(p->ws + WS_DEC) + (size_t)dir_ * NTOK * 512; const bf16_t* AA_ = (const bf16_t*)(p->ws + WS_AA) + (size_t)dir_ * NTOK * 512; \
        _Pragma("unroll") for (int j = 0; j < 4; ++j) { const unsigned off = o0_ + (unsigned)(sg_ * j); \
            lwN[j] = *(const f32x2*)(DEC_ + off); kkN[j] = ldh2(KK + off); aaN[j] = ldh2(AA_ + off); krN[j] = ldh2(KR + off); rN[j] = ldh2(R + off); } \
        vmN = *(const u32x4*)(VV + (ub_ + (unsigned)(sg_ * (tg >> 3) + (tg & 7) * 8))); } while (0)
    if (first < nit) CSA_FETCH(first);
    for (int it = first; it < nit; it += stride) {
        const int q = qbase + it * 2 + g; const bool lat = q < CS_LAT;
        const int sc = lat ? (q >> 6) : ((q - CS_LAT) >> 3), ci = lat ? (q & 63) : (q & 7), TT = lat ? DSEQ : SEQ;
        const int b = sc >> 4, dir = (sc >> 3) & 1, h = sc & 7;
        const size_t rowbase = lat ? (size_t)NCTX + (size_t)b * DSEQ : (size_t)b * SEQ;
        const float* DEC = (const float*)(p->ws + WS_DEC) + (size_t)dir * NTOK * 512; const bf16_t* AA = (const bf16_t*)(p->ws + WS_AA) + (size_t)dir * NTOK * 512;
        {
            const int kp = tg & 31, seg = tg >> 5;
            f32x2 lw[4], kk2[4], aa2[4], kr2[4], r2[4];
#pragma unroll
            for (int j = 0; j < 4; ++j) { lw[j] = lwN[j]; kk2[j] = kkN[j]; aa2[j] = aaN[j]; kr2[j] = krN[j]; r2[j] = rN[j]; }
            const u32x4 vmC = vmN;
            if (it + stride < nit) CSA_FETCH(it + stride);
            f32x2 ss = {0.f, 0.f};
#pragma unroll
            for (int j = 0; j < 4; ++j) { lw[j].x = __logf(lw[j].x); lw[j].y = __logf(lw[j].y); ss += lw[j]; }
            *(LAS f32x2*)(SEG + seg * 64 + 2 * kp) = ss;
            { const int i = tg >> 3, v0 = (tg & 7) * 8; *(LAS u32x4*)(MVM + i * 144 + v0 * 2) = vmC; }
            lds_barrier();
            f32x2 pre = {0.f, 0.f}, tot = {0.f, 0.f};
#pragma unroll
            for (int s8 = 0; s8 < 8; ++s8) { const f32x2 v = *(const LAS f32x2*)(SEG + s8 * 64 + 2 * kp); tot += v; if (s8 < seg) pre += v; }
            if (seg == 0) *(LAS f32x2*)(ELv + 2 * kp) = (f32x2){__expf(tot.x), __expf(tot.y)};
            const f32x2 ka = *(const f32x2*)(k_a + h * 64 + 2 * kp);
            f32x2 cwp = pre;
#pragma unroll
            for (int j = 0; j < 4; ++j) {
                const f32x2 cw = cwp + lw[j];
                const f32x2 E = {__expf(cw.x), __expf(cw.y)}, Ei = {__expf(-cw.x), __expf(-cw.y)}, Ep = {__expf(cwp.x), __expf(cwp.y)}, Eh = {__expf(tot.x - cw.x), __expf(tot.y - cw.y)};
                const f32x2 bb = kk2[j] * aa2[j], kd = kr2[j] * ((aa2[j] - 1.f) * ka + 1.f);
                const int o = (4 * seg + j) * 144 + 4 * kp;
                const f32x2 x0 = kk2[j] * Ep, x1 = bb * Ei, x2 = kd * Ei, x3 = r2[j] * E, x4 = bb * Eh, x5 = kd * Eh;
                *(LAS unsigned*)(MKK + o) = pk2(x0.x, x0.y); *(LAS unsigned*)(MBT + o) = pk2(x1.x, x1.y); *(LAS unsigned*)(MKT + o) = pk2(x2.x, x2.y);
                *(LAS unsigned*)(MRT + o) = pk2(x3.x, x3.y); *(LAS unsigned*)(MBH + o) = pk2(x4.x, x4.y); *(LAS unsigned*)(MKH + o) = pk2(x5.x, x5.y);
                cwp = cw;
            }
        }
        lds_barrier();
        {
            const LAS unsigned char* ia = wq < 2 ? MKK : MRT; const LAS unsigned char* ib = (wq & 1) ? MKT : MBT;
            f32x16 acc = zero16();
#pragma unroll
            for (int s4 = 0; s4 < 4; ++s4) acc = MFMA32(frag_nat(ia, 144, r32, s4, hh), frag_nat(ib, 144, r32, s4, hh), acc);
#pragma unroll
            for (int i = 0; i < 16; ++i) { const int row = crow(i, hh); const bool keep = wq < 2 ? (row > r32) : (row >= r32); const float v = keep ? acc[i] : 0.f;
                if (wq == 0) { AF[row * 32 + r32] = v; *(LAS unsigned short*)(SA + row * 80 + r32 * 2) = (row >= 16 && r32 < 16) ? (unsigned short)(pk2(v, 0.f) & 0xffffu) : (unsigned short)0; }
                else *(LAS unsigned short*)((wq == 1 ? SKK : (wq == 2 ? SRB : SRK)) + row * 80 + r32 * 2) = (unsigned short)(pk2(v, 0.f) & 0xffffu); }
        }
        lds_barrier();
        f32x16 X = zero16(), NT0 = zero16(), NT1 = zero16(), Q2 = zero16();
        const int c = wq & 1;
        if (wq == 0) {
            const int blk = r32 >> 4, cc = r32 & 15;
            float Tc[16];
#pragma unroll
            for (int i = 0; i < 16; ++i) {
                float a4[4] = {(i == cc) ? 1.f : 0.f, 0.f, 0.f, 0.f};
#pragma unroll
                for (int j4 = 0; j4 < (i + 3) / 4; ++j4) { const f32x4 ar = *(const LAS f32x4*)(AF + (16 * blk + i) * 32 + 16 * blk + 4 * j4);
#pragma unroll
                    for (int e = 0; e < 4; ++e) if (4 * j4 + e < i) a4[e] -= ar[e] * Tc[4 * j4 + e]; }
                const float a = (a4[0] + a4[1]) + (a4[2] + a4[3]);
                Tc[i] = a;
                if (lane < 32) { *(LAS unsigned short*)(ST + (16 * blk + i) * 80 + (16 * blk + cc) * 2) = (unsigned short)(pk2(a, 0.f) & 0xffffu);
                                 *(LAS unsigned short*)(ST + (16 * blk + i) * 80 + (16 * (1 - blk) + cc) * 2) = (unsigned short)0; }
            }
            asm volatile("s_waitcnt lgkmcnt(0)" ::: "memory");
            f32x16 E = zero16();
            E = MFMA32(frag_krow(SA, 80, r32, 0, hh), frag_tr(ST, 80, 0, 0, lane), E); E = MFMA32(frag_krow(SA, 80, r32, 1, hh), frag_tr(ST, 80, 0, 1, lane), E);
#pragma unroll
            for (int i = 0; i < 16; ++i) E[i] = ((crow(i, hh) == r32) ? 1.f : 0.f) - E[i];
            f32x16 Tm = zero16();
            Tm = MFMA32(frag_krow(ST, 80, r32, 0, hh), pack8<0>(E, 1.f), Tm); Tm = MFMA32(frag_krow(ST, 80, r32, 1, hh), pack8<1>(E, 1.f), Tm);
            asm volatile("s_waitcnt lgkmcnt(0)" ::: "memory");
#pragma unroll
            for (int i = 0; i < 16; ++i) *(LAS unsigned short*)(ST + crow(i, hh) * 80 + r32 * 2) = (unsigned short)(pk2(Tm[i], 0.f) & 0xffffu);
        } else if (wq >= 2) {
#pragma unroll
            for (int s2 = 0; s2 < 2; ++s2) {
                const bf16x8 vm = frag_tr(MVM, 144, 32 * c, s2, lane);
                X = MFMA32(frag_krow(SKK, 80, r32, s2, hh), vm, X);
                Q2 = MFMA32(frag_krow(SRK, 80, r32, s2, hh), vm, Q2);
                NT0 = MFMA32(frag_tr(MKH, 144, 0, s2, lane), vm, NT0);
                NT1 = MFMA32(frag_tr(MKH, 144, 32, s2, lane), vm, NT1);
            }
        }
        lds_barrier();
        if (wq < 2) {
            f32x16 P1 = zero16();
#pragma unroll
            for (int s2 = 0; s2 < 2; ++s2) P1 = MFMA32(frag_krow(ST, 80, r32, s2, hh), frag_tr(MKK, 144, 32 * c, s2, lane), P1);
            const bf16x8 n0 = pack8<0>(P1, -1.f), n1 = pack8<1>(P1, -1.f);
            f32x16 Q1t;
#pragma unroll
            for (int g4 = 0; g4 < 4; ++g4) { const u32x2 w = *(const LAS u32x2*)(MRT + r32 * 144 + (32 * c + 8 * g4 + 4 * hh) * 2); const f32x4 f = unpk4(w);
                Q1t[4 * g4] = f.x; Q1t[4 * g4 + 1] = f.y; Q1t[4 * g4 + 2] = f.z; Q1t[4 * g4 + 3] = f.w; }
            Q1t = MFMA32(n0, frag_krow(SRB, 80, r32, 0, hh), Q1t); Q1t = MFMA32(n1, frag_krow(SRB, 80, r32, 1, hh), Q1t);
            u32x4* q1f = (u32x4*)cs_q1(p->ws, q) + (c * 2) * 64 + lane;
            q1f[0] = __builtin_bit_cast(u32x4, pack8<0>(Q1t, 1.f)); q1f[64] = __builtin_bit_cast(u32x4, pack8<1>(Q1t, 1.f));
#pragma unroll
            for (int bq = 0; bq < 2; ++bq) {
                f32x16 M = zero16();
                if (bq == c) {
#pragma unroll
                    for (int i = 0; i < 16; ++i) M[i] = (crow(i, hh) == r32) ? ELv[32 * c + r32] : 0.f;
                }
                M = MFMA32(n0, frag_tr(MBH, 144, 32 * bq, 0, lane), M); M = MFMA32(n1, frag_tr(MBH, 144, 32 * bq, 1, lane), M);
                u32x4* mf = (u32x4*)cs_mf(p->ws, q) + ((c * 2 + bq) * 2) * 64 + lane;
                mf[0] = __builtin_bit_cast(u32x4, pack8<0>(M, 1.f)); mf[64] = __builtin_bit_cast(u32x4, pack8<1>(M, 1.f));
            }
        } else {
            f32x16 P2 = zero16();
            P2 = MFMA32(frag_krow(ST, 80, r32, 0, hh), pack8<0>(X, 1.f), P2); P2 = MFMA32(frag_krow(ST, 80, r32, 1, hh), pack8<1>(X, 1.f), P2);
            const bf16x8 n0 = pack8<0>(P2, -1.f), n1 = pack8<1>(P2, -1.f);
            Q2 = MFMA32(frag_krow(SRB, 80, r32, 0, hh), n0, Q2); Q2 = MFMA32(frag_krow(SRB, 80, r32, 1, hh), n1, Q2);
            NT0 = MFMA32(frag_tr(MBH, 144, 0, 0, lane), n0, NT0); NT0 = MFMA32(frag_tr(MBH, 144, 0, 1, lane), n1, NT0);
            NT1 = MFMA32(frag_tr(MBH, 144, 32, 0, lane), n0, NT1); NT1 = MFMA32(frag_tr(MBH, 144, 32, 1, lane), n1, NT1);
            unsigned* q2f = (unsigned*)cs_q2(p->ws, q) + c * 512 + lane;
#pragma unroll
            for (int i = 0; i < 8; ++i) q2f[i * 64] = pk2(Q2[2 * i], Q2[2 * i + 1]);
            unsigned* ntf = (unsigned*)cs_nt(p->ws, q) + (c * 2) * 512 + lane;
#pragma unroll
            for (int i = 0; i < 8; ++i) { ntf[i * 64] = pk2(NT0[2 * i], NT0[2 * i + 1]); ntf[512 + i * 64] = pk2(NT1[2 * i], NT1[2 * i + 1]); }
        }
        lds_barrier();
    }
#undef CSA_FETCH
}


constexpr int CSB_SLOT = 24576;
DI void cs_phaseB(KP p, LAS unsigned char* lds, int latent, int sc, int tid) {
    const int wave = tid >> 6, lane = tid & 63, hh = lane >> 5, r32 = lane & 31;
    const int nch = latent ? 64 : 8, q0 = latent ? sc * 64 : CS_LAT + sc * 8, TT = latent ? DSEQ : SEQ;
    const int b = sc >> 4, dir = (sc >> 3) & 1, h = sc & 7, c = wave & 1;
    const size_t rowbase = latent ? (size_t)NCTX + (size_t)b * DSEQ : (size_t)b * SEQ;
    const bool consumer = wave < 2;
    float* Yu = p->out + (size_t)dir * NTOK * 512 + rowbase * 512 + h * 64 + 32 * c;
    const unsigned ylane = (unsigned)((dir ? 4 * (1 - hh) : 4 * hh) * 512 + r32);
    unsigned yv[8];
#pragma unroll
    for (int k = 0; k < 8; ++k) { const int rr_ = 2 * (k & 1) + 8 * (k >> 1); yv[k] = (ylane + (unsigned)((dir ? TT - CS_L + 27 - rr_ : rr_) * 512)) * 4u; }
    const unsigned ystepb = dir ? 0u - (unsigned)(CS_L * 512 * 4) : (unsigned)(CS_L * 512 * 4);
    f32x16 Z0 = zero16(), Z1 = zero16();
    if (consumer && latent) { const float* s0 = p->in[4] + ((((size_t)b * 2 + dir) * 8 + h) * 64 + 32 * c + r32) * 64;
#pragma unroll
      for (int g4 = 0; g4 < 4; ++g4) { const f32x4 a = *(const f32x4*)(s0 + 8 * g4 + 4 * hh), bq = *(const f32x4*)(s0 + 32 + 8 * g4 + 4 * hh);
          Z0[4 * g4] = a.x; Z0[4 * g4 + 1] = a.y; Z0[4 * g4 + 2] = a.z; Z0[4 * g4 + 3] = a.w; Z1[4 * g4] = bq.x; Z1[4 * g4 + 1] = bq.y; Z1[4 * g4 + 2] = bq.z; Z1[4 * g4 + 3] = bq.w; } }
    const int lt = tid - 128;
    u32x4 RG[2][4];
#define CSB_LOADQ(set, ch) do { const int q_ = q0 + (ch); _Pragma("unroll") for (int k_ = 0; k_ < 4; ++k_) { const int pi_ = lt + 384 * k_; \
        const unsigned char* src_ = pi_ < 512 ? cs_mf(p->ws, q_) + pi_ * 16 : (pi_ < 768 ? cs_q1(p->ws, q_) + (pi_ - 512) * 16 : (pi_ < 1280 ? cs_nt(p->ws, q_) + (pi_ - 768) * 16 : cs_q2(p->ws, q_) + (pi_ - 1280) * 16)); \
        RG[set][k_] = *(const u32x4*)src_; } } while (0)
#define CSB_WRITEQ(set, slot) do { _Pragma("unroll") for (int k_ = 0; k_ < 4; ++k_) *(LAS u32x4*)(lds + (slot) * CSB_SLOT + (lt + 384 * k_) * 16) = RG[set][k_]; } while (0)
    if (!consumer) { CSB_LOADQ(0, 0); CSB_LOADQ(1, 1); CSB_WRITEQ(0, 0); CSB_LOADQ(0, 2); }
    else __builtin_amdgcn_s_setprio(3);
    for (int ci0 = 0; ci0 < nch; ci0 += 2) {
#pragma unroll
        for (int u = 0; u < 2; ++u) {
            const int ci = ci0 + u;
            lds_barrier();
            if (!consumer) {
                if (ci + 1 < nch) { CSB_WRITEQ((u + 1) & 1, (ci + 1) & 1); if (ci + 3 < nch) CSB_LOADQ((u + 1) & 1, ci + 3); }
            } else {
                const LAS unsigned char* sl = lds + (ci & 1) * CSB_SLOT;
                bf16x8 MF[8], Q1[4]; f32x16 Y, N0, N1;
#pragma unroll
                for (int i = 0; i < 8; ++i) MF[i] = *(const LAS bf16x8*)(sl + (i * 64 + lane) * 16);
#pragma unroll
                for (int i = 0; i < 4; ++i) Q1[i] = *(const LAS bf16x8*)(sl + 8192 + (i * 64 + lane) * 16);
#pragma unroll
                for (int i = 0; i < 8; ++i) { const unsigned w0 = *(const LAS unsigned*)(sl + 12288 + ((c * 2) * 512 + i * 64 + lane) * 4), w1 = *(const LAS unsigned*)(sl + 12288 + ((c * 2 + 1) * 512 + i * 64 + lane) * 4),
                                                         w2 = *(const LAS unsigned*)(sl + 20480 + (c * 512 + i * 64 + lane) * 4);
                    N0[2 * i] = __builtin_bit_cast(float, w0 << 16); N0[2 * i + 1] = __builtin_bit_cast(float, w0 & 0xffff0000u);
                    N1[2 * i] = __builtin_bit_cast(float, w1 << 16); N1[2 * i + 1] = __builtin_bit_cast(float, w1 & 0xffff0000u);
                    Y[2 * i] = __builtin_bit_cast(float, w2 << 16); Y[2 * i + 1] = __builtin_bit_cast(float, w2 & 0xffff0000u); }
                const bf16x8 z00 = pack8<0>(Z0, 1.f), z01 = pack8<1>(Z0, 1.f), z10 = pack8<0>(Z1, 1.f), z11 = pack8<1>(Z1, 1.f);
                const bf16x8 l00 = pack8lo<0>(Z0, z00), l01 = pack8lo<1>(Z0, z01), l10 = pack8lo<0>(Z1, z10), l11 = pack8lo<1>(Z1, z11);
                Y = MFMA32(Q1[0], z00, Y); Y = MFMA32(Q1[1], z01, Y); Y = MFMA32(Q1[2], z10, Y); Y = MFMA32(Q1[3], z11, Y);
                N0 = MFMA32(MF[0], z00, N0); N0 = MFMA32(MF[1], z01, N0); N0 = MFMA32(MF[4], z10, N0); N0 = MFMA32(MF[5], z11, N0);
                N0 = MFMA32(MF[0], l00, N0); N0 = MFMA32(MF[1], l01, N0); N0 = MFMA32(MF[4], l10, N0); N0 = MFMA32(MF[5], l11, N0);
                N1 = MFMA32(MF[2], z00, N1); N1 = MFMA32(MF[3], z01, N1); N1 = MFMA32(MF[6], z10, N1); N1 = MFMA32(MF[7], z11, N1);
                N1 = MFMA32(MF[2], l00, N1); N1 = MFMA32(MF[3], l01, N1); N1 = MFMA32(MF[6], l10, N1); N1 = MFMA32(MF[7], l11, N1);
                Z0 = N0; Z1 = N1;
                if (dir) {
#pragma unroll
                    for (int i = 0; i < 16; ++i) *(float*)((char*)Yu + yv[(i >> 2) * 2 + ((i & 3) >> 1)] - 2048 * (i & 1)) = Y[i];
                } else {
#pragma unroll
                    for (int i = 0; i < 16; ++i) *(float*)((char*)Yu + yv[(i >> 2) * 2 + ((i & 3) >> 1)] + 2048 * (i & 1)) = Y[i];
                }
#pragma unroll
                for (int k = 0; k < 8; ++k) yv[k] += ystepb;
            }
        }
    }
#undef CSB_LOADQ
#undef CSB_WRITEQ
    __builtin_amdgcn_s_setprio(0);
    if (consumer && !latent) { float* so = p->out + OUT_S + ((((size_t)b * 2 + dir) * 8 + h) * 64 + 32 * c + r32) * 64;
#pragma unroll
        for (int g4 = 0; g4 < 4; ++g4) { *(f32x4*)(so + 8 * g4 + 4 * hh) = (f32x4){Z0[4 * g4], Z0[4 * g4 + 1], Z0[4 * g4 + 2], Z0[4 * g4 + 3]};
                                          *(f32x4*)(so + 32 + 8 * g4 + 4 * hh) = (f32x4){Z1[4 * g4], Z1[4 * g4 + 1], Z1[4 * g4 + 2], Z1[4 * g4 + 3]}; } }
    __syncthreads();
}

DI void post_row(KP p, int r, int lane) {
    const float* Y = p->out; const bf16_t* R = (const bf16_t*)(p->ws + WS_R); const bf16_t* KR = (const bf16_t*)(p->ws + WS_KR);
    const bf16_t* VV = (const bf16_t*)(p->ws + WS_VV); const bf16_t* AA = (const bf16_t*)(p->ws + WS_AA); const bf16_t* G = (const bf16_t*)(p->ws + WS_G);
    const float* k_a = p->in[19]; const float* r_k = p->in[20]; const float* lng = p->in[21]; const float* lnb = p->in[22];
    bf16_t* MIX = (bf16_t*)(p->ws + WS_MIX);
    const int c = lane * 8; const size_t off = (size_t)r * 512 + c;
    float y[8], rr[8], kr[8], vv[8], a0[8], a1[8], gg[8], ka[8], rk[8], lg[8], lb[8];
#define LD8(dst, ptr) do { const f32x4 _a = *(const f32x4*)(ptr), _b = *(const f32x4*)((ptr) + 4); dst[0] = _a.x; dst[1] = _a.y; dst[2] = _a.z; dst[3] = _a.w; dst[4] = _b.x; dst[5] = _b.y; dst[6] = _b.z; dst[7] = _b.w; } while (0)
#define LD8H(dst, ptr) do { const u32x4 _w = *(const u32x4*)(ptr); const f32x4 _a = unpk4((u32x2){_w.x, _w.y}), _b = unpk4((u32x2){_w.z, _w.w}); dst[0] = _a.x; dst[1] = _a.y; dst[2] = _a.z; dst[3] = _a.w; dst[4] = _b.x; dst[5] = _b.y; dst[6] = _b.z; dst[7] = _b.w; } while (0)
    LD8(y, Y + off); LD8(rr, Y + (size_t)NTOK * 512 + off);
#pragma unroll
    for (int j = 0; j < 8; ++j) y[j] += rr[j];
    LD8H(rr, R + off); LD8H(kr, KR + off); LD8H(vv, VV + off); LD8H(a0, AA + off); LD8H(a1, AA + (size_t)NTOK * 512 + off); LD8H(gg, G + off);
    LD8(ka, k_a + c); LD8(rk, r_k + c); LD8(lg, lng + c); LD8(lb, lnb + c);
#undef LD8
#undef LD8H
    float s = 0.f, d0 = 0.f, d1 = 0.f;
#pragma unroll
    for (int j = 0; j < 8; ++j) { s += y[j]; const float q = rr[j] * kr[j] * rk[j]; d0 += q * (1.f + (a0[j] - 1.f) * ka[j]); d1 += q * (1.f + (a1[j] - 1.f) * ka[j]); }
    float bd = d0 + d1;
    s += __shfl_xor(s, 1); s += __shfl_xor(s, 2); s += __shfl_xor(s, 4);
    bd += __shfl_xor(bd, 1); bd += __shfl_xor(bd, 2); bd += __shfl_xor(bd, 4);
    const float mu = s * (1.f / 64.f);
    float q2 = 0.f;
#pragma unroll
    for (int j = 0; j < 8; ++j) { y[j] -= mu; q2 += y[j] * y[j]; }
    q2 += __shfl_xor(q2, 1); q2 += __shfl_xor(q2, 2); q2 += __shfl_xor(q2, 4);
    const float rs = rsqrtf(q2 * (1.f / 64.f) + GN_EPS);
    float o[8];
#pragma unroll
    for (int j = 0; j < 8; ++j) o[j] = (y[j] * rs * lg[j] + lb[j] + bd * vv[j]) * gg[j];
    *(u32x4*)(MIX + (size_t)r * D + 512 + c) = (u32x4){pk2(o[0], o[1]), pk2(o[2], o[3]), pk2(o[4], o[5]), pk2(o[6], o[7])};
}

DI void act_fix(KP p, int pm, int e, int c) {
    const float* EDGE = (const float*)(p->ws + WS_EDGE); bf16_t* ACT = (bf16_t*)(p->ws + WS_ACT); const float* wc = p->in[27];
    const bool need = e == 0 ? (pm != 16 && pm != 24) : (pm != 23 && pm != 31);
    if (!need) return;
    const int r = pm * 256 + (e ? 255 : 0), nbpm = e ? pm + 1 : pm - 1;
    const float* nb = EDGE + ((size_t)nbpm * 2 + (1 - e)) * DFF + c;
    const float* eu = EDGE + ((size_t)pm * 2 + e) * DFF + 64 * DFF + c; const float* e3 = eu + 64 * DFF;
    const float* w = wc + (e ? 2 * DFF : 0) + c;
    float o[8];
#pragma unroll
    for (int j = 0; j < 8; ++j) o[j] = silu_f(eu[j] + w[j] * nb[j]) * e3[j];
    *(u32x4*)(ACT + (size_t)r * DFF + c) = (u32x4){pk2(o[0], o[1]), pk2(o[2], o[3]), pk2(o[4], o[5]), pk2(o[6], o[7])};
}

template <int NR>
DI void final_rows(KP p, int rbase, int rstride, int lane) {
    const float* MODb = (const float*)(p->ws + WS_MOD);
    const bf16_t* PART = (const bf16_t*)(p->ws + WS_PART); const float* nf = p->in[29];
    f32x4 v[NR][4]; u32x2 p0[NR][4], p1[NR][4];
#pragma unroll
    for (int q = 0; q < NR; ++q) { const int r = rbase + q * rstride; const f32x4* xr = (const f32x4*)(p->out + (size_t)r * D) + lane;
#pragma unroll
        for (int j = 0; j < 4; ++j) { v[q][j] = xr[64 * j]; p0[q][j] = *((const u32x2*)(PART + (size_t)r * D) + lane + 64 * j); p1[q][j] = *((const u32x2*)(PART + (size_t)(NTOK + r) * D) + lane + 64 * j); } }
    float s[NR];
#pragma unroll
    for (int q = 0; q < NR; ++q) { const int r = rbase + q * rstride; const float* MOD = MODb + midx_of(r) * 6144; s[q] = 0.f;
#pragma unroll
        for (int j = 0; j < 4; ++j) { const f32x4 gt = *((const f32x4*)(MOD + 5 * D) + lane + 64 * j); v[q][j] = v[q][j] + gt * (unpk4(p0[q][j]) + unpk4(p1[q][j]));
            s[q] += (v[q][j].x * v[q][j].x + v[q][j].y * v[q][j].y) + (v[q][j].z * v[q][j].z + v[q][j].w * v[q][j].w); } }
#pragma unroll
    for (int o = 1; o < 64; o <<= 1) {
#pragma unroll
        for (int q = 0; q < NR; ++q) s[q] += __shfl_xor(s[q], o); }
#pragma unroll
    for (int q = 0; q < NR; ++q) { const int r = rbase + q * rstride; f32x4* xr = (f32x4*)(p->out + (size_t)r * D) + lane; const float rstd = rsqrtf(s[q] * (1.f / D) + EPS);
#pragma unroll
        for (int j = 0; j < 4; ++j) xr[64 * j] = v[q][j] * rstd * *((const f32x4*)nf + lane + 64 * j); }
}

DI int lane_id() { int l; asm volatile("v_mbcnt_lo_u32_b32 %0, -1, 0\n\tv_mbcnt_hi_u32_b32 %0, -1, %0" : "=v"(l)); return l; }
#define XB_TMO      128
#define XB_XCNT(j)  (256  + 64 * (j))
#define XB_XSUB(j)  (1280 + 64 * (j))
#define XB_XGEN(j)  (2304 + 64 * (j))
#define XB_TOP      3328
#define XB_TOPGEN   3392
#define XB_SUBBAR   3520
#define XB_SPIN_CAP (1u << 18)
DI unsigned xb_ld(unsigned* p)              { return __hip_atomic_load(p, __ATOMIC_RELAXED, __HIP_MEMORY_SCOPE_AGENT); }
DI unsigned xb_add(unsigned* p, unsigned v) { return __hip_atomic_fetch_add(p, v, __ATOMIC_RELAXED, __HIP_MEMORY_SCOPE_AGENT); }
DI unsigned xb_xcc_id() { return (unsigned)__builtin_amdgcn_s_getreg((3 << 11) | 20) & 0xFu; }
#define XB_SPIN(cond, bar) do { unsigned _sp = 0; while (cond) { __builtin_amdgcn_s_sleep(1); \
    if ((++_sp & 255u) == 0u) { if (xb_ld(&(bar)[XB_TMO])) break; if (_sp > XB_SPIN_CAP) { atomicAdd(&(bar)[XB_TMO], 1u); break; } } } } while (0)
DI void xcd_barrier_complete(unsigned* bar, unsigned x, unsigned G, unsigned& nloc, unsigned& nx) {
    unsigned sum, cnt, mine, sp = 0u;
    for (;;) {
        sum = 0u; cnt = 0u; mine = 0u;
#pragma unroll
        for (unsigned j = 0; j < 16; ++j) { const unsigned c = xb_ld(&bar[XB_XCNT(j)]); sum += c; cnt += (c > 0u) ? 1u : 0u; mine = (j == x) ? c : mine; }
        if (sum == G) break;
        __builtin_amdgcn_s_sleep(1);
        if ((++sp & 255u) == 0u) { if (xb_ld(&bar[XB_TMO])) break; if (sp > XB_SPIN_CAP) { atomicAdd(&bar[XB_TMO], 1u); break; } }
    }
    nloc = mine > 0u ? mine : 1u; nx = cnt > 0u ? cnt : 1u;
}
DI void grid_bar(unsigned* bar, volatile LAS unsigned* st, unsigned G, int wave_s) {
    asm volatile("s_waitcnt vmcnt(0)" ::: "memory");
    __syncthreads();
    int t = wave_s * 64 + lane_id(); asm volatile("" : "+v"(t));
    if (t == 0) {
        __builtin_amdgcn_s_waitcnt(0);
        const unsigned x = xb_xcc_id();
        unsigned nloc = st[0], nx = st[1];
        if (nloc == 0u) { xcd_barrier_complete(bar, x, G, nloc, nx); st[0] = nloc; st[1] = nx; }
        const unsigned old = xb_add(&bar[XB_XSUB(x)], 1u);
        const unsigned gen = old / nloc;
        if (old + 1u == (gen + 1u) * nloc) {
            __builtin_amdgcn_fence(__ATOMIC_RELEASE, "agent");
            asm volatile("s_waitcnt vmcnt(0)" ::: "memory");
            const unsigned og = xb_add(&bar[XB_TOP], 1u);
            const unsigned tg = og / nx;
            if (og + 1u == (tg + 1u) * nx) xb_add(&bar[XB_TOPGEN], 1u);
            else XB_SPIN(xb_ld(&bar[XB_TOPGEN]) == tg, bar);
            __builtin_amdgcn_fence(__ATOMIC_ACQUIRE, "agent");
            xb_add(&bar[XB_XGEN(x)], 1u);
            asm volatile("s_waitcnt vmcnt(0)" ::: "memory");
        } else {
            XB_SPIN(xb_ld(&bar[XB_XGEN(x)]) == gen, bar);
            __builtin_amdgcn_fence(__ATOMIC_ACQUIRE, "agent");
            asm volatile("s_waitcnt vmcnt(0)" ::: "memory");
        }
    }
    __syncthreads();
}

__global__ void __launch_bounds__(512, 2) fwd_megakernel(Params kparams) {
    const KP kp0 = (KP)__builtin_amdgcn_kernarg_segment_ptr();
    extern __shared__ __attribute__((aligned(16))) unsigned char lds_raw[];
    LAS unsigned char* lds = (LAS unsigned char*)lds_raw;
    const int wave_s = __builtin_amdgcn_readfirstlane((int)threadIdx.x >> 6);
    volatile LAS unsigned* xbst = (volatile LAS unsigned*)(lds + LDS_XB);
    {
        int t0_ = wave_s * 64 + lane_id();
        if (t0_ == 0) { xbst[0] = 0u; xbst[1] = 0u; (void)xb_add((unsigned*)(kp0->ws + WS_BAR) + XB_XCNT(xb_xcc_id()), 1u); }
        __syncthreads();
    }
#define GRID_SYNC() grid_bar((unsigned*)(kp0->ws + WS_BAR), xbst, (unsigned)G, wave_s)
    const int G = gridDim.x, bx = blockIdx.x, NGW = G * 8, NGT = G * 512;
#define PH_VARS KP p = kp0; asm volatile("" : "+s"(p)); unsigned char* ws = p->ws; (void)ws; \
    int tid = wave_s * 64 + lane_id(); asm volatile("" : "+v"(tid)); const int lane = tid & 63, wave = wave_s, gw = bx * 8 + wave, gtid = bx * 512 + tid; (void)lane; (void)gw; (void)gtid;

    const bool defer_ffn = (G == 256);
    { PH_VARS phase0(p, lds, gw, NGW, gtid, NGT, wave, lane, defer_ffn); }
    GRID_SYNC();
    if (G > (1 << 20)) cg::this_grid().sync();
    { PH_VARS for (int r = gw; r < NTOK; r += 4 * NGW) norm_rows<0, 4>(p, r, NGW, lane, p->in[9], 0, D, 0, (bf16_t*)(ws + WS_H), nullptr); }
    GRID_SYNC();
    {
        PH_VARS
        pg8::Gemm g{(const bf16_t*)(ws + WS_H), (const bf16_t*)(ws + WS_WTIN), D, D, D};
        pg8::SchedPlain S; S.o.init(NTOK / 256, NINP / 256, G, bx);
        pg8::EpiIn E{(bf16_t*)(ws + WS_Q), (bf16_t*)(ws + WS_ZR), p->out + OUT_K, 0.125f * LOG2E};
        pg8::gemm_phase(lds, g, S, E, tid);
        if (defer_ffn && bx >= 192) ffn_transposes(p, lds, 0, (bx - 192) * 8 + wave, 64 * 8, wave, lane);
    }
    GRID_SYNC();
    {
        PH_VARS
        LAS float* rpbL = (LAS float*)lds;
        for (int i = tid; i < 8 * 465; i += 512) rpbL[i] = p->in[23][i] * LOG2E;
        __syncthreads();
        LAS unsigned char* vbuf = lds + 16384 + wave * 4608;
        LAS float* xch = (LAS float*)(lds + 65536) + (wave & 3) * 2176;
        for (int u0 = bx * 4; u0 < 1024; u0 += G * 4) {
            if (wave < 4) { attn_unit<true, 2>(p, vbuf, rpbL, u0 + wave, lane, 0, 20, xch); attn_unit<false, 0>(p, vbuf, rpbL, u0 + wave, lane, 0, 8, xch); }
            else { attn_unit<true, 1>(p, vbuf, rpbL, u0 + wave - 4, lane, 20, 32, xch); prep_rows8(p, (u0 + wave - 4) * 8, lane); }
            __syncthreads();
        }
    }
    GRID_SYNC();
    {
        PH_VARS
        int kl = 128; asm volatile("" : "+s"(kl));
        pg8::Gemm g{(const bf16_t*)(ws + WS_ALORA), (const bf16_t*)(ws + WS_WTLORA), kl, 128, 128};
        pg8::SchedLora S; S.G = G; S.c = bx;
        pg8::EpiLora E{(float*)(ws + WS_DEC), (float*)(ws + WS_AA), (float*)(ws + WS_G), p->in[13], p->in[15]};
        pg8::gemm_phase(lds, g, S, E, tid);
        if (defer_ffn && bx >= 64) ffn_transposes(p, lds, 1, (bx - 64) * 8 + wave, 192 * 8, wave, lane);
    }
    GRID_SYNC();
    {
        int nst = 2; asm volatile("" : "+s"(nst));
        const int nl = G > 64 ? 32 : 0;
        for (int st = 0; st < nst; ++st) {
            PH_VARS
            const bool lead = bx < nl;
            if (st == 0 || !lead) cs_phaseA(p, lds, tid, st ? CS_LAT : 0, CS_LAT / 2, st ? bx - nl : bx, st ? G - nl : G);
            if (st == 0) { GRID_SYNC(); continue; }
            if (!lead) {
                unsigned* sb = (unsigned*)(kp0->ws + WS_BAR) + XB_SUBBAR;
                __syncthreads();
                if (tid == 0) { __atomic_thread_fence(__ATOMIC_RELEASE); __hip_atomic_fetch_add(sb, 1u, __ATOMIC_RELAXED, __HIP_MEMORY_SCOPE_AGENT);
                    while (__hip_atomic_load(sb, __ATOMIC_RELAXED, __HIP_MEMORY_SCOPE_AGENT) < (unsigned)(G - nl)) __builtin_amdgcn_s_sleep(1);
                    __atomic_thread_fence(__ATOMIC_ACQUIRE); }
                __syncthreads();
            }
            const int tfirst = lead ? bx : (nl ? 32 + (bx - nl) : bx), tend = lead ? 32 : 288, tstride = lead ? 32 : (G - nl);
            for (int t = tfirst; t < tend; t += tstride) cs_phaseB(p, lds, t < 32 ? 1 : 0, t < 32 ? t : t - 32, tid);
        }
    }
    GRID_SYNC();
    { PH_VARS for (int r = gw; r < NTOK; r += NGW) post_row(p, r, lane); }
    GRID_SYNC();
    {
        PH_VARS
        pg8::Gemm g{(const bf16_t*)(ws + WS_MIX), (const bf16_t*)(ws + WS_WTOUT), 512, D, D};
        pg8::SchedSplit2 S; S.o.init(NTOK / 256, 8, G, bx); S.nN = 4; S.ksplit = 512;
        pg8::EpiPart E{(bf16_t*)(ws + WS_PART), 512};
        pg8::gemm_phase(lds, g, S, E, tid);
    }
    GRID_SYNC();
    { PH_VARS for (int r = gw; r < NTOK; r += 2 * NGW) norm_rows<1, 2>(p, r, NGW, lane, p->in[10], 3 * D, 4 * D, 2 * D, (bf16_t*)(ws + WS_H), p->out); }
    GRID_SYNC();
    {
        PH_VARS
        pg8::Gemm g{(const bf16_t*)(ws + WS_H), (const bf16_t*)(ws + WS_WT13), D, D, D};
        pg8::SchedPlain S; S.o.init(NTOK / 256, 2 * DFF / 256, G, bx);
        pg8::EpiFfnAct E{(bf16_t*)(ws + WS_ACT), (float*)(ws + WS_EDGE), p->in[27], lds};
        pg8::gemm_phase(lds, g, S, E, tid);
    }
    GRID_SYNC();
    {
        PH_VARS
        pg8::Gemm g{(const bf16_t*)(ws + WS_ACT), (const bf16_t*)(ws + WS_WT2), DFF / 2, DFF, DFF};
        pg8::SchedSplit2 S; S.o.init(NTOK / 256, 8, G, bx); S.nN = 4; S.ksplit = DFF / 2;
        { for (int i = 0; i < 8; ++i) { int pm_, pn2_; if (!S.o.next2(i, pm_, pn2_)) break; const int ks_ = pn2_ / 4;
              if (pm_ >= 16 && tid < 352) act_fix(p, pm_, tid / 176, ks_ * (DFF / 2) + (tid % 176) * 8); }
          asm volatile("s_waitcnt vmcnt(0)" ::: "memory"); __syncthreads(); }
        pg8::EpiPart E{(bf16_t*)(ws + WS_PART), DFF / 2};
        pg8::gemm_phase(lds, g, S, E, tid);
    }
    GRID_SYNC();
    { PH_VARS for (int r = gw; r < NTOK; r += 2 * NGW) final_rows<2>(p, r, NGW, lane); }
}

extern "C" void kernel_launch(void* const* d_in, const int* in_sizes, int n_in, void* d_out, int out_size, void* d_ws, size_t ws_size, hipStream_t stream) {
    static int grid_blocks = 0;
    if (!grid_blocks) {
        int dev = 0, cus = 0, per_cu = 0;
        (void)hipGetDevice(&dev);
        (void)hipDeviceGetAttribute(&cus, hipDeviceAttributeMultiprocessorCount, dev);
        (void)hipFuncSetAttribute((const void*)fwd_megakernel, hipFuncAttributeMaxDynamicSharedMemorySize, LDS_BYTES);
        (void)hipOccupancyMaxActiveBlocksPerMultiprocessor(&per_cu, (const void*)fwd_megakernel, 512, LDS_BYTES);
        if (per_cu < 1) per_cu = 1;
        grid_blocks = cus * per_cu;
    }
    (void)hipMemsetAsync((char*)d_ws + WS_BAR, 0, 16384, stream);
    Params p{};
    for (int i = 0; i < 30; ++i) p.in[i] = (const float*)d_in[i];
    p.out = (float*)d_out; p.ws = (unsigned char*)d_ws;
    void* args[] = {&p};
    hipError_t e = hipLaunchCooperativeKernel((const void*)fwd_megakernel, dim3(grid_blocks), dim3(512), args, LDS_BYTES, stream);
    if (e != hipSuccess) fprintf(stderr, "cooperative launch failed: %s (grid %d)\n", hipGetErrorString(e), grid_blocks);
}
```

```cpp
#include <hip/hip_runtime.h>
#include <hip/hip_cooperative_groups.h>
#include <cstdio>
#include <cstdint>
namespace cg = cooperative_groups;

#define LAS __attribute__((address_space(3)))
typedef unsigned short bf16_t;
typedef short bf16x8 __attribute__((ext_vector_type(8)));
typedef short s16x4 __attribute__((ext_vector_type(4)));
typedef float f32x2 __attribute__((ext_vector_type(2)));
typedef float f32x4 __attribute__((ext_vector_type(4)));
typedef float f32x16 __attribute__((ext_vector_type(16)));
typedef unsigned u32x2 __attribute__((ext_vector_type(2)));
typedef unsigned u32x4 __attribute__((ext_vector_type(4)));
typedef __bf16 bf16x2_t __attribute__((ext_vector_type(2)));
#define DI __device__ __forceinline__

constexpr int D = 1024, NTOK = 8192, NCTX = 4096, SEQ = 256, DSEQ = 2048;
constexpr int NIN = 3456, NINP = 3584, RC = 1920, DFF = 2816;
constexpr float EPS = 1e-6f, GN_EPS = 64e-5f;
constexpr float LOG2E = 1.4426950408889634f;
constexpr size_t MiB = 1u << 20;
constexpr size_t WS_BAR = 128 * 1024, WS_MOD = 0, WS_WTIN = 1 * MiB, WS_WTOUT = 8 * MiB, WS_WT13 = 10 * MiB, WS_WT2 = 21 * MiB, WS_WTLORA = 27 * MiB,
                 WS_H = 28 * MiB, WS_Q = 44 * MiB, WS_K = 52 * MiB, WS_V = 60 * MiB, WS_R = 68 * MiB, WS_VV = 84 * MiB, WS_KK = 100 * MiB,
                 WS_KR = 116 * MiB, WS_ALORA = 132 * MiB, WS_MIX = 138 * MiB, WS_ZR = 154 * MiB, WS_DEC = 154 * MiB, WS_AA = 186 * MiB,
                 WS_G = 218 * MiB, WS_CK = 234 * MiB, WS_CV = 235 * MiB, WS_Y = 28 * MiB, WS_PART = 176 * MiB, WS_A1 = 44 * MiB,
                 WS_A3 = 88 * MiB, WS_ACT = 132 * MiB, WS_EDGE = 250 * MiB;
constexpr size_t OUT_K = (size_t)NTOK * D, OUT_V = OUT_K + (size_t)NCTX * 512, OUT_S = OUT_V + (size_t)NCTX * 512;
constexpr int LDS_BYTES = 135168 + 16;
constexpr int LDS_XB = 135168;

struct Params { const float* in[30]; float* out; unsigned char* ws; };
typedef const __attribute__((address_space(4))) Params* KP;

DI unsigned pk2(float lo, float hi) { f32x2 v = {lo, hi}; bf16x2_t b = __builtin_convertvector(v, bf16x2_t); return __builtin_bit_cast(unsigned, b); }
DI f32x4 unpk4(u32x2 w) { return (f32x4){__builtin_bit_cast(float, w.x << 16), __builtin_bit_cast(float, w.x & 0xffff0000u), __builtin_bit_cast(float, w.y << 16), __builtin_bit_cast(float, w.y & 0xffff0000u)}; }
DI f32x2 ldh2(const bf16_t* p) { const unsigned w = *(const unsigned*)p; return (f32x2){__builtin_bit_cast(float, w << 16), __builtin_bit_cast(float, w & 0xffff0000u)}; }
DI float bf2f(unsigned short u) { return __builtin_bit_cast(float, (unsigned)u << 16); }
DI float wave_sum(float v) {
#pragma unroll
    for (int o = 1; o < 64; o <<= 1) v += __shfl_xor(v, o);
    return v;
}
DI float sigmoid_f(float x) { return __builtin_amdgcn_rcpf(1.f + __builtin_amdgcn_exp2f(-1.4426950408889634f * x)); }
DI float silu_f(float x) { return x * sigmoid_f(x); }
DI float tanh_f(float x) { return 2.f * sigmoid_f(2.f * x) - 1.f; }
DI int midx_of(int r) { return r < NCTX ? 0 : 1 + ((r - NCTX) >> 11); }
DI const float* xrow_of(KP p, int r) { return r < NCTX ? p->in[0] + (size_t)r * D : p->in[1] + (size_t)(r - NCTX) * D; }

namespace pg8 {
constexpr int BM = 256, BK = 64, HALF = 128, HTB = HALF * BK * 2, NXCD = 8, WGM = 8;
__host__ __device__ __forceinline__ int lds_byte(int r, int c) { const int st = (r >> 4) * 2 + (c >> 5), rr = r & 15, cc = c & 31, ob = rr * 64 + cc * 2; return st * 1024 + (ob ^ (((ob >> 9) & 1) << 5)); }
__host__ __device__ __forceinline__ void stage_rc(int b, int& R, int& C) { const int st = b / 1024, sb = b % 1024, swz = sb ^ (((sb >> 9) & 1) << 5); R = (st >> 1) * 16 + swz / 64; C = (st & 1) * 32 + (swz % 64) / 2; }
__host__ __device__ __forceinline__ int perm32(int rho) { const int n = rho >> 4, i = rho & 15; return 8 * (i >> 2) + 4 * n + (i & 3); }
struct Unit { int pm, pn; int aoff, boff; };
struct Gemm { const bf16_t* A; const bf16_t* Bt; int K, lda, ldb; };
struct StaticOrder {
    int nM, nN, nwg, G, c;
    __device__ __forceinline__ void init(int nM_, int nN_, int G_, int c_) { nM = nM_; nN = nN_; nwg = nM * nN; G = G_; c = c_; }
    __device__ __forceinline__ bool next2(int i, int& pm, int& pn) const {
        const long L = (long)i * G + c; if (L >= nwg) return false;
        int wgid = (int)L; { const int q = nwg / NXCD, r = nwg % NXCD, xcd = wgid % NXCD, off = wgid / NXCD; wgid = (xcd < r ? xcd * (q + 1) : r * (q + 1) + (xcd - r) * q) + off; }
        const int nig = WGM * nN, gid = wgid / nig, fm = gid * WGM, gsz = (nM - fm) < WGM ? (nM - fm) : WGM;
        pm = fm + ((wgid % nig) % gsz); pn = (wgid % nig) / gsz; return true;
    }
};
struct SchedPlain { StaticOrder o; __device__ __forceinline__ bool next(int i, Unit& u) const { u.aoff = 0; u.boff = 0; return o.next2(i, u.pm, u.pn); } };
struct SchedSplit2 { StaticOrder o; int nN, ksplit;
    __device__ __forceinline__ bool next(int i, Unit& u) const { int pn2; if (!o.next2(i, u.pm, pn2)) return false; const int ks = pn2 / nN; u.pn = pn2 - ks * nN; u.aoff = ks * ksplit; u.boff = ks * ksplit; return true; } };
struct SchedLora { int G, c;
    __device__ __forceinline__ bool next(int i, Unit& u) const { const int L = i * G + c; if (L >= 320) return false; u.pm = L & 31; u.pn = L >> 5; const int g = u.pn < 4 ? 0 : (u.pn < 8 ? 1 : 2); u.aoff = g * NTOK * 128; u.boff = 0; return true; } };

template <class Epi, class Sched>
__device__ __forceinline__ void gemm_phase(LAS unsigned char* lds, const Gemm g, const Sched& S, const Epi& E, int tid) {
    asm volatile("" : "+v"(tid));
    const int wid = __builtin_amdgcn_readfirstlane(tid >> 6), lane = tid & 63, wr = wid >> 2, wc = wid & 3, fr = lane & 15, fq = lane >> 4;
    const int nt = g.K / BK;
    unsigned voffA[2], voffB[2];
#pragma unroll
    for (int i = 0; i < 2; ++i) { int R, C; stage_rc(tid * 16 + i * 8192, R, C); const int Rb = (R & ~31) + perm32(R & 31);
        voffA[i] = (unsigned)(R * g.lda + C) * 2u; voffB[i] = (unsigned)(Rb * g.ldb + C) * 2u; }
    const size_t kstep = (size_t)(BK * 2);
    const size_t hA = (size_t)HALF * g.lda * 2, hB = (size_t)HALF * g.ldb * 2;
    const unsigned ldsw = (unsigned)wid * 1024u;
    const int aoff = lds_byte(wr * 64 + fr, fq * 8), boff = lds_byte(wc * 32 + fr, fq * 8);
#define PG8_SA(b, h) (((b) * 2 + (h)) * HTB)
#define PG8_SB(b, h) ((4 + (b) * 2 + (h)) * HTB)
#define PG8_STAGE(bufoff, gbase, voff) do { _Pragma("unroll") for (int _i = 0; _i < 2; ++_i) \
        __builtin_amdgcn_global_load_lds((const unsigned*)((const char*)(gbase) + (voff)[_i]), (LAS unsigned*)(lds + (bufoff) + ldsw + _i * 8192), 16, 0, 0); } while (0)
#define PG8_LDA(dst, b, h) do { _Pragma("unroll") for (int m = 0; m < 4; ++m) _Pragma("unroll") for (int k = 0; k < 2; ++k) dst[m][k] = *(const LAS bf16x8*)(lds + PG8_SA(b, h) + aoff + m * 2048 + k * 1024); } while (0)
#define PG8_LDB(dst, b, h) do { _Pragma("unroll") for (int n = 0; n < 2; ++n) _Pragma("unroll") for (int k = 0; k < 2; ++k) dst[n][k] = *(const LAS bf16x8*)(lds + PG8_SB(b, h) + boff + n * 2048 + k * 1024); } while (0)
#define PG8_MMA(ai, bj, At, Bt) do { __builtin_amdgcn_s_setprio(1); _Pragma("unroll") for (int m = 0; m < 4; ++m) _Pragma("unroll") for (int n = 0; n < 2; ++n) _Pragma("unroll") for (int k = 0; k < 2; ++k) \
        acc[ai][bj][m][n] = __builtin_amdgcn_mfma_f32_16x16x32_bf16(Bt[n][k], At[m][k], acc[ai][bj][m][n], 0, 0, 0); __builtin_amdgcn_s_setprio(0); } while (0)
#define PG8_WAIT_V(n) asm volatile("s_waitcnt vmcnt(" #n ")" ::: "memory")
#define PG8_WAIT_L(n) asm volatile("s_waitcnt lgkmcnt(" #n ")" ::: "memory")
#define PG8_BAR __builtin_amdgcn_s_barrier()
#define PG8_SCHED __builtin_amdgcn_sched_barrier(0)
#define PG8_TA(u) ((const char*)g.A + ((size_t)(u).pm * BM * g.lda + (size_t)(u).aoff) * 2)
#define PG8_TB(u) ((const char*)g.Bt + ((size_t)(u).pn * BM * g.ldb + (size_t)(u).boff) * 2)
    Unit cur, nxt; int ui = 0;
    if (!S.next(0, cur)) return;
    f32x4 acc[2][2][4][2];
#pragma unroll
    for (int a = 0; a < 2; ++a)
#pragma unroll
        for (int b = 0; b < 2; ++b)
#pragma unroll
            for (int m = 0; m < 4; ++m)
#pragma unroll
                for (int n = 0; n < 2; ++n) acc[a][b][m][n] = (f32x4){0.f, 0.f, 0.f, 0.f};
    bf16x8 At[4][2], B0[2][2], B1[2][2];
    const char* cA = PG8_TA(cur); const char* cB = PG8_TB(cur);
    PG8_STAGE(PG8_SB(0, 0), cB, voffB); PG8_STAGE(PG8_SB(0, 1), cB + hB, voffB); PG8_STAGE(PG8_SA(0, 0), cA, voffA); PG8_STAGE(PG8_SA(0, 1), cA + hA, voffA);
    if (wr == 1) PG8_BAR;
    PG8_WAIT_V(2); PG8_BAR;
    PG8_STAGE(PG8_SB(1, 0), cB + kstep, voffB); PG8_STAGE(PG8_SA(1, 0), cA + kstep, voffA); PG8_STAGE(PG8_SB(1, 1), cB + hB + kstep, voffB);
    PG8_WAIT_V(6); PG8_BAR;
    for (;;) {
        const bool has_next = S.next(ui + 1, nxt);
        const char* nA = has_next ? PG8_TA(nxt) : cA; const char* nB = has_next ? PG8_TB(nxt) : cB;
        for (int t = 0; t < nt; t += 2) {
            const bool last = (t == nt - 2);
            const char* a1 = cA + (size_t)(t + 1) * kstep;
            const char* a2 = last ? nA : cA + (size_t)(t + 2) * kstep; const char* b2 = last ? nB : cB + (size_t)(t + 2) * kstep;
            const char* a3 = a2 + kstep; const char* b3 = b2 + kstep;
            PG8_LDB(B0, 0, 0); PG8_LDB(B1, 0, 1); PG8_SCHED; PG8_LDA(At, 0, 0); PG8_STAGE(PG8_SA(1, 1), a1 + hA, voffA);
            PG8_WAIT_V(8); PG8_WAIT_L(0); PG8_BAR; PG8_MMA(0, 0, At, B0); PG8_MMA(0, 1, At, B1); PG8_BAR; PG8_SCHED;
            PG8_LDA(At, 0, 1); PG8_STAGE(PG8_SB(0, 0), b2, voffB); PG8_STAGE(PG8_SB(0, 1), b2 + hB, voffB); PG8_STAGE(PG8_SA(0, 0), a2, voffA);
            PG8_WAIT_V(8); PG8_WAIT_L(0); PG8_BAR; PG8_MMA(1, 0, At, B0); PG8_MMA(1, 1, At, B1); PG8_BAR; PG8_SCHED;
            PG8_LDB(B0, 1, 0); PG8_LDB(B1, 1, 1); PG8_SCHED; PG8_LDA(At, 1, 0); PG8_STAGE(PG8_SA(0, 1), a2 + hA, voffA);
            PG8_WAIT_V(8); PG8_WAIT_L(0); PG8_BAR; PG8_MMA(0, 0, At, B0); PG8_MMA(0, 1, At, B1); PG8_BAR; PG8_SCHED;
            PG8_LDA(At, 1, 1); PG8_STAGE(PG8_SB(1, 0), b3, voffB); PG8_STAGE(PG8_SB(1, 1), b3 + hB, voffB); PG8_STAGE(PG8_SA(1, 0), a3, voffA);
            PG8_WAIT_V(8); PG8_WAIT_L(0); PG8_BAR; PG8_MMA(1, 0, At, B0); PG8_MMA(1, 1, At, B1); PG8_BAR; PG8_SCHED;
        }
        E(acc, cur, wr, wc, fr, fq);
        if (!has_next) break;
#pragma unroll
        for (int a = 0; a < 2; ++a)
#pragma unroll
            for (int b = 0; b < 2; ++b)
#pragma unroll
                for (int m = 0; m < 4; ++m)
#pragma unroll
                    for (int n = 0; n < 2; ++n) acc[a][b][m][n] = (f32x4){0.f, 0.f, 0.f, 0.f};
        cur = nxt; cA = nA; cB = nB; ++ui;
    }
    PG8_WAIT_V(0);
    if (wr == 0) PG8_BAR;
    PG8_BAR;
#undef PG8_SA
#undef PG8_SB
#undef PG8_STAGE
#undef PG8_LDA
#undef PG8_LDB
#undef PG8_MMA
#undef PG8_WAIT_V
#undef PG8_WAIT_L
#undef PG8_BAR
#undef PG8_SCHED
#undef PG8_TA
#undef PG8_TB
}

struct EpiIn {
    bf16_t *Q; bf16_t* ZR; float* outK; float qscale;
    __device__ __forceinline__ void operator()(const f32x4 (&acc)[2][2][4][2], const Unit& u, int wr, int wc, int fr, int fq) const {
#pragma unroll
        for (int bj = 0; bj < 2; ++bj) {
            const int c0 = u.pn * BM + bj * HALF + wc * 32 + 8 * fq;
            if (c0 >= NIN) continue;
#pragma unroll
            for (int ai = 0; ai < 2; ++ai)
#pragma unroll
                for (int m = 0; m < 4; ++m) {
                    int r = u.pm * BM + ai * HALF + wr * 64 + m * 16 + fr; asm volatile("" : "+v"(r));
                    f32x4 v0 = acc[ai][bj][m][0], v1 = acc[ai][bj][m][1];
                    if (c0 < 1536) {
                        const int seg = c0 >> 9, cc = c0 & 511;
                        if (seg == 0) { v0 = v0 * qscale; v1 = v1 * qscale; }
                        else if (r < NCTX) { float* o = outK + (size_t)(seg - 1) * ((size_t)NCTX * 512) + (size_t)r * 512 + cc; *(f32x4*)o = v0; *(f32x4*)(o + 4) = v1; }
                        bf16_t* dst = Q + (size_t)seg * ((size_t)NTOK * 512) + (size_t)r * 512 + cc;
                        u32x4 w; w.x = pk2(v0[0], v0[1]); w.y = pk2(v0[2], v0[3]); w.z = pk2(v1[0], v1[1]); w.w = pk2(v1[2], v1[3]);
                        *(u32x4*)dst = w;
                    } else {
                        u32x4 w; w.x = pk2(v0[0], v0[1]); w.y = pk2(v0[2], v0[3]); w.z = pk2(v1[0], v1[1]); w.w = pk2(v1[2], v1[3]);
                        *(u32x4*)(ZR + (size_t)r * RC + (c0 - 1536)) = w;
                    }
                }
        }
    }
};
DI float decay1(float x) { return __expf(-0.60653065971f * sigmoid_f(x)); }
struct EpiLora {
    float *DEC, *AA, *G; const float *w0, *a0;
    __device__ __forceinline__ void operator()(const f32x4 (&acc)[2][2][4][2], const Unit& u, int wr, int wc, int fr, int fq) const {
#pragma unroll
        for (int bj = 0; bj < 2; ++bj) {
            const int c0 = u.pn * BM + bj * HALF + wc * 32 + 8 * fq;
            const int grp = c0 >> 10, cg = c0 & 1023, dir = cg >> 9, cc = cg & 511;
            const float* bp = (grp == 0 ? w0 : a0) + dir * 512 + cc;
            float* ob = DEC + (size_t)dir * NTOK * 512 + cc;
            bf16_t* obh = grp == 2 ? (bf16_t*)G + cc : (bf16_t*)AA + (size_t)dir * NTOK * 512 + cc;
#pragma unroll
            for (int ai = 0; ai < 2; ++ai)
#pragma unroll
                for (int m = 0; m < 4; ++m) {
                    int r = u.pm * BM + ai * HALF + wr * 64 + m * 16 + fr; asm volatile("" : "+v"(r));
                    f32x4 v0 = acc[ai][bj][m][0], v1 = acc[ai][bj][m][1];
                    if (grp < 2) { const float* bq = bp; asm volatile("" : "+v"(bq)); v0 += *(const f32x4*)bq; v1 += *(const f32x4*)(bq + 4); }
                    if (grp == 0) { v0.x = decay1(v0.x); v0.y = decay1(v0.y); v0.z = decay1(v0.z); v0.w = decay1(v0.w); v1.x = decay1(v1.x); v1.y = decay1(v1.y); v1.z = decay1(v1.z); v1.w = decay1(v1.w); }
                    else if (grp == 1) { v0.x = sigmoid_f(v0.x); v0.y = sigmoid_f(v0.y); v0.z = sigmoid_f(v0.z); v0.w = sigmoid_f(v0.w); v1.x = sigmoid_f(v1.x); v1.y = sigmoid_f(v1.y); v1.z = sigmoid_f(v1.z); v1.w = sigmoid_f(v1.w); }
                    if (grp == 0) { float* o = ob + (size_t)r * 512; *(f32x4*)o = v0; *(f32x4*)(o + 4) = v1; }
                    else { u32x4 w; w.x = pk2(v0[0], v0[1]); w.y = pk2(v0[2], v0[3]); w.z = pk2(v1[0], v1[1]); w.w = pk2(v1[2], v1[3]); *(u32x4*)(obh + (size_t)r * 512) = w; }
                }
        }
    }
};
struct EpiPart {
    bf16_t* P; int ksplit;
    __device__ __forceinline__ void operator()(const f32x4 (&acc)[2][2][4][2], const Unit& u, int wr, int wc, int fr, int fq) const {
        bf16_t* base = P + (u.aoff ? (size_t)NTOK * D : 0);
#pragma unroll
        for (int bj = 0; bj < 2; ++bj) {
            const int c0 = u.pn * BM + bj * HALF + wc * 32 + 8 * fq;
#pragma unroll
            for (int ai = 0; ai < 2; ++ai)
#pragma unroll
                for (int m = 0; m < 4; ++m) {
                    int r = u.pm * BM + ai * HALF + wr * 64 + m * 16 + fr; asm volatile("" : "+v"(r));
                    const f32x4 v0 = acc[ai][bj][m][0], v1 = acc[ai][bj][m][1];
                    u32x4 w; w.x = pk2(v0[0], v0[1]); w.y = pk2(v0[2], v0[3]); w.z = pk2(v1[0], v1[1]); w.w = pk2(v1[2], v1[3]);
                    *(u32x4*)(base + (size_t)r * D + c0) = w;
                }
        }
    }
};
template <int CTRL> DI float dppf(float x) { return __builtin_bit_cast(float, __builtin_amdgcn_mov_dpp(__builtin_bit_cast(int, x), CTRL, 0xf, 0xf, true)); }
struct EpiFfnAct {
    bf16_t* ACT; float* EDGE; const float* wcv; LAS unsigned char* ldsb;
    __device__ __forceinline__ void operator()(const f32x4 (&acc)[2][2][4][2], const Unit& u, int wr, int wc, int fr, int fq) const {
        LAS float* HL = (LAS float*)(ldsb + 131072);
        const int colh = wc * 32 + 8 * fq;
#pragma unroll
        for (int ai = 0; ai < 2; ++ai) { const int g = ai * 2 + wr;
            if (fr == 0) { *(LAS f32x4*)(HL + (g * 2 + 0) * 128 + colh) = acc[ai][0][0][0]; *(LAS f32x4*)(HL + (g * 2 + 0) * 128 + colh + 4) = acc[ai][0][0][1]; }
            if (fr == 15) { *(LAS f32x4*)(HL + (g * 2 + 1) * 128 + colh) = acc[ai][0][3][0]; *(LAS f32x4*)(HL + (g * 2 + 1) * 128 + colh + 4) = acc[ai][0][3][1]; } }
        asm volatile("s_waitcnt lgkmcnt(0)" ::: "memory");
        __builtin_amdgcn_s_barrier(); __builtin_amdgcn_s_barrier();
        asm volatile("" ::: "memory");
        const int cf = u.pn * HALF + colh;
        const f32x4 zero = {0.f, 0.f, 0.f, 0.f};
        const bool lat = u.pm >= 16;
#pragma unroll
        for (int ai = 0; ai < 2; ++ai) {
            const int g = ai * 2 + wr;
            f32x4 hp[2], hn[2];
            hp[0] = g > 0 ? *(const LAS f32x4*)(HL + ((g - 1) * 2 + 1) * 128 + colh) : zero; hp[1] = g > 0 ? *(const LAS f32x4*)(HL + ((g - 1) * 2 + 1) * 128 + colh + 4) : zero;
            hn[0] = g < 3 ? *(const LAS f32x4*)(HL + ((g + 1) * 2 + 0) * 128 + colh) : zero; hn[1] = g < 3 ? *(const LAS f32x4*)(HL + ((g + 1) * 2 + 0) * 128 + colh + 4) : zero;
#pragma unroll
            for (int m = 0; m < 4; ++m) {
                int r = u.pm * BM + ai * HALF + wr * 64 + m * 16 + fr; asm volatile("" : "+v"(r));
                const float* wq_ = wcv + cf; asm volatile("" : "+v"(wq_));
                f32x4 uu[2], av[2];
#pragma unroll
                for (int n = 0; n < 2; ++n) {
                    const f32x4 cur = acc[ai][0][m][n];
                    f32x4 pv, nx;
#pragma unroll
                    for (int j = 0; j < 4; ++j) {
                        if (m > 0) pv[j] = dppf<0x121>(fr == 15 ? acc[ai][0][m > 0 ? m - 1 : 0][n][j] : cur[j]);
                        else { const float a = dppf<0x121>(cur[j]); pv[j] = fr == 0 ? hp[n][j] : a; }
                        if (m < 3) nx[j] = dppf<0x12F>(fr == 0 ? acc[ai][0][m < 3 ? m + 1 : 3][n][j] : cur[j]);
                        else { const float c = dppf<0x12F>(cur[j]); nx[j] = fr == 15 ? hn[n][j] : c; }
                    }
                    const f32x4 w0 = *(const f32x4*)(wq_ + 4 * n), w1 = *(const f32x4*)(wq_ + DFF + 4 * n), w2 = *(const f32x4*)(wq_ + 2 * DFF + 4 * n);
                    uu[n] = pv * w0 + cur * w1 + nx * w2;
                    const f32x4 a3 = acc[ai][1][m][n];
                    av[n] = (f32x4){silu_f(uu[n].x) * a3.x, silu_f(uu[n].y) * a3.y, silu_f(uu[n].z) * a3.z, silu_f(uu[n].w) * a3.w};
                }
                u32x4 w; w.x = pk2(av[0][0], av[0][1]); w.y = pk2(av[0][2], av[0][3]); w.z = pk2(av[1][0], av[1][1]); w.w = pk2(av[1][2], av[1][3]);
                *(u32x4*)(ACT + (size_t)r * DFF + cf) = w;
                if (lat && ((ai == 0 && m == 0) || (ai == 1 && m == 3))) {
                    const int e = ai;
                    const bool mine = e == 0 ? (wr == 0 && fr == 0) : (wr == 1 && fr == 15);
                    if (mine) {
                        float* eb = EDGE + ((size_t)u.pm * 2 + e) * DFF + cf;
                        *(f32x4*)(eb) = acc[ai][0][m][0]; *(f32x4*)(eb + 4) = acc[ai][0][m][1];
                        *(f32x4*)(eb + 64 * DFF) = uu[0]; *(f32x4*)(eb + 64 * DFF + 4) = uu[1];
                        *(f32x4*)(eb + 128 * DFF) = acc[ai][1][m][0]; *(f32x4*)(eb + 128 * DFF + 4) = acc[ai][1][m][1];
                    }
                }
            }
        }
    }
};
}

template <int MODE>
DI void transpose_item(const float* W, int K, int N, bf16_t* WT, LAS float* scr, int item, int lane) {
    const int nblk = N / 32, kb = item / nblk, nb = item % nblk, k0 = 64 * kb, n0 = 32 * nb;
#pragma unroll 8
    for (int i = 0; i < 32; ++i) { const int kk = 2 * i + (lane >> 5); scr[kk * 33 + (lane & 31)] = W[(size_t)(k0 + kk) * N + n0 + (lane & 31)]; }
    asm volatile("s_waitcnt lgkmcnt(0)" ::: "memory");
    const int c = lane & 7;
#pragma unroll
    for (int j = 0; j < 4; ++j) { const int n = (lane >> 3) + 8 * j; const LAS float* s = scr + (8 * c) * 33 + n;
        u32x4 o; o.x = pk2(s[0 * 33], s[1 * 33]); o.y = pk2(s[2 * 33], s[3 * 33]); o.z = pk2(s[4 * 33], s[5 * 33]); o.w = pk2(s[6 * 33], s[7 * 33]);
        const int nn = n0 + n; const int drow = MODE == 0 ? nn : ((nn >> 7) * 256 + (nn & 127) + (MODE == 2 ? 128 : 0));
        *(u32x4*)(WT + (size_t)drow * K + k0 + 8 * c) = o; }
    asm volatile("s_waitcnt lgkmcnt(0)" ::: "memory");
}

DI void phase0(KP p, LAS unsigned char* lds, int gw, int NGW, int gtid, int NGT, int wave, int lane, bool defer_ffn) {
    unsigned char* ws = p->ws;
    {
        float* MOD = (float*)(ws + WS_MOD);
        const float* w_ada = p->in[7]; const float* b_ada = p->in[8]; const float* c_lat = p->in[5]; const float* c_ctx = p->in[6];
        LAS float* red = (LAS float*)(lds + 8 * 8448);
        const int tid = wave * 64 + lane, cgp = lane & 15, kr = lane >> 4;
        for (int nb = blockIdx.x; nb < 96; nb += gridDim.x) {
            f32x4 a0 = {0, 0, 0, 0}, a1 = a0, a2 = a0;
#pragma unroll 8
            for (int i = 0; i < 32; ++i) {
                const int k = wave * 128 + 4 * i + kr;
                const f32x4 w = *(const f32x4*)(w_ada + (size_t)k * 6144 + nb * 64 + 4 * cgp);
                a0 += w * silu_f(c_ctx[k]); a1 += w * silu_f(c_lat[k]); a2 += w * silu_f(c_lat[D + k]);
            }
#pragma unroll
            for (int j = 0; j < 4; ++j) {
                a0[j] += __shfl_xor(a0[j], 16); a0[j] += __shfl_xor(a0[j], 32);
                a1[j] += __shfl_xor(a1[j], 16); a1[j] += __shfl_xor(a1[j], 32);
                a2[j] += __shfl_xor(a2[j], 16); a2[j] += __shfl_xor(a2[j], 32);
            }
            if (kr == 0) { *(LAS f32x4*)(red + (wave * 3 + 0) * 64 + 4 * cgp) = a0; *(LAS f32x4*)(red + (wave * 3 + 1) * 64 + 4 * cgp) = a1; *(LAS f32x4*)(red + (wave * 3 + 2) * 64 + 4 * cgp) = a2; }
            __syncthreads();
            if (tid < 192) {
                const int i = tid >> 6, c = tid & 63; float s = b_ada[nb * 64 + c];
#pragma unroll
                for (int w = 0; w < 8; ++w) s += red[(w * 3 + i) * 64 + c];
                MOD[i * 6144 + nb * 64 + c] = s;
            }
            __syncthreads();
        }
    }
    {
        LAS float* scr = (LAS float*)(lds + wave * 8448);
        constexpr int I_IN = 16 * 108, I_OUT = 16 * 32, I_F = 16 * 88, I_2 = 44 * 32, NIT = I_IN + I_OUT + 2 * I_F + I_2;
        const int nit = defer_ffn ? I_IN + I_OUT : NIT;
        for (int it = gw; it < nit; it += NGW) {
            int r = it;
            if (r < I_IN) { transpose_item<0>(p->in[11], D, NIN, (bf16_t*)(ws + WS_WTIN), scr, r, lane); continue; } r -= I_IN;
            if (r < I_OUT) { transpose_item<0>(p->in[24], D, D, (bf16_t*)(ws + WS_WTOUT), scr, r, lane); continue; } r -= I_OUT;
            if (r < I_F) { transpose_item<1>(p->in[25], D, DFF, (bf16_t*)(ws + WS_WT13), scr, r, lane); continue; } r -= I_F;
            if (r < I_F) { transpose_item<2>(p->in[26], D, DFF, (bf16_t*)(ws + WS_WT13), scr, r, lane); continue; } r -= I_F;
            transpose_item<0>(p->in[28], DFF, D, (bf16_t*)(ws + WS_WT2), scr, r, lane);
        }
    }
    { u32x4* z = (u32x4*)((bf16_t*)(ws + WS_WTIN) + (size_t)NIN * D); for (int i = gtid; i < 128 * D / 8; i += NGT) z[i] = (u32x4){0, 0, 0, 0}; }
    {
        bf16_t* WL = (bf16_t*)(ws + WS_WTLORA); const float* w2 = p->in[14]; const float* a2 = p->in[16]; const float* g2 = p->in[17];
        for (int i = gtid; i < 2560 * 128; i += NGT) {
            const int n = i >> 7, k = i & 127; float v = 0.f;
            if (n < 2048) { const int grp = n >> 10, dir = (n >> 9) & 1, c = n & 511; const float* src = grp == 0 ? w2 : a2;
                if ((k >> 6) == dir) v = src[((size_t)dir * 64 + (k & 63)) * 512 + c]; }
            else v = g2[(size_t)k * 512 + (n - 2048)];
            WL[i] = (bf16_t)(pk2(v, 0.f) & 0xffffu);
        }
    }
    {
        const f32x4* ck = (const f32x4*)p->in[2]; const f32x4* cv = (const f32x4*)p->in[3]; u32x2* CK = (u32x2*)(ws + WS_CK); u32x2* CV = (u32x2*)(ws + WS_CV);
        for (int i = gtid; i < 1024 * 512 / 4; i += NGT) { const f32x4 a = ck[i], b = cv[i]; CK[i] = (u32x2){pk2(a[0], a[1]), pk2(a[2], a[3])}; CV[i] = (u32x2){pk2(b[0], b[1]), pk2(b[2], b[3])}; }
    }
}

DI void ffn_transposes(KP p, LAS unsigned char* lds, int which, int widx, int nw, int wave, int lane) {
    LAS float* scr = (LAS float*)(lds + wave * 8448);
    constexpr int I_F = 16 * 88, I_2 = 44 * 32;
    if (which == 0) { for (int it = widx; it < I_2; it += nw) transpose_item<0>(p->in[28], DFF, D, (bf16_t*)(p->ws + WS_WT2), scr, it, lane); }
    else { for (int it = widx; it < 2 * I_F; it += nw) { if (it < I_F) transpose_item<1>(p->in[25], D, DFF, (bf16_t*)(p->ws + WS_WT13), scr, it, lane);
                                                           else transpose_item<2>(p->in[26], D, DFF, (bf16_t*)(p->ws + WS_WT13), scr, it - I_F, lane); } }
}

template <int SRC, int NR>
DI void norm_rows(KP p, int rbase, int rstride, int lane, const float* normw, int sh_off, int sc_off, int gate_off, bf16_t* Hout, float* xout) {
    const float* MODb = (const float*)(p->ws + WS_MOD);
    const bf16_t* PART = (const bf16_t*)(p->ws + WS_PART);
    f32x4 v[NR][4];
#pragma unroll
    for (int q = 0; q < NR; ++q) { const f32x4* xr = (const f32x4*)xrow_of(p, rbase + q * rstride) + lane;
#pragma unroll
        for (int j = 0; j < 4; ++j) v[q][j] = xr[64 * j]; }
    if (SRC == 1) {
        u32x2 p0[NR][4], p1[NR][4];
#pragma unroll
        for (int q = 0; q < NR; ++q) { const int r = rbase + q * rstride;
#pragma unroll
            for (int j = 0; j < 4; ++j) { p0[q][j] = *((const u32x2*)(PART + (size_t)r * D) + lane + 64 * j); p1[q][j] = *((const u32x2*)(PART + (size_t)(NTOK + r) * D) + lane + 64 * j); } }
#pragma unroll
        for (int q = 0; q < NR; ++q) { const int r = rbase + q * rstride; const float* MOD = MODb + midx_of(r) * 6144;
#pragma unroll
            for (int j = 0; j < 4; ++j) { const f32x4 gt = *((const f32x4*)(MOD + gate_off) + lane + 64 * j); v[q][j] = v[q][j] + gt * (unpk4(p0[q][j]) + unpk4(p1[q][j])); } }
    }
    float s[NR];
#pragma unroll
    for (int q = 0; q < NR; ++q) { s[q] = 0.f;
#pragma unroll
        for (int j = 0; j < 4; ++j) s[q] += (v[q][j].x * v[q][j].x + v[q][j].y * v[q][j].y) + (v[q][j].z * v[q][j].z + v[q][j].w * v[q][j].w); }
#pragma unroll
    for (int o = 1; o < 64; o <<= 1) {
#pragma unroll
        for (int q = 0; q < NR; ++q) s[q] += __shfl_xor(s[q], o); }
#pragma unroll
    for (int q = 0; q < NR; ++q) {
        const int r = rbase + q * rstride; const float* MOD = MODb + midx_of(r) * 6144;
        const float rstd = rsqrtf(s[q] * (1.f / D) + EPS);
        u32x2* o = (u32x2*)(Hout + (size_t)r * D) + lane;
#pragma unroll
        for (int j = 0; j < 4; ++j) {
            if (SRC == 1) *((f32x4*)(xout + (size_t)r * D) + lane + 64 * j) = v[q][j];
            const f32x4 g = *((const f32x4*)normw + lane + 64 * j), sc = *((const f32x4*)(MOD + sc_off) + lane + 64 * j), sh = *((const f32x4*)(MOD + sh_off) + lane + 64 * j);
            const f32x4 h = v[q][j] * rstd * g * (sc + 1.f) + sh;
            o[64 * j] = (u32x2){pk2(h.x, h.y), pk2(h.z, h.w)};
        }
    }
}

#define MFMA32(a, b, c) __builtin_amdgcn_mfma_f32_32x32x16_bf16((a), (b), (c), 0, 0, 0)
DI int crow(int reg, int h) { return (reg & 3) + 8 * (reg >> 2) + 4 * h; }
typedef short v4i16_t __attribute__((ext_vector_type(4)));
DI s16x4 vtr(const LAS unsigned char* p) { return __builtin_bit_cast(s16x4, __builtin_amdgcn_ds_read_tr16_b64_v4i16((LAS v4i16_t*)p)); }

template <bool LATENT, int MODE>
DI void attn_unit(KP p, LAS unsigned char* vbuf, const LAS float* rpbL, int unit, int lane, int t0, int t1, LAS float* xch) {
    const bf16_t* Q = (const bf16_t*)(p->ws + WS_Q); const bf16_t* Kb = (const bf16_t*)(p->ws + WS_K); const bf16_t* Vb = (const bf16_t*)(p->ws + WS_V);
    const bf16_t* CK = (const bf16_t*)(p->ws + WS_CK); const bf16_t* CV = (const bf16_t*)(p->ws + WS_CV);
    bf16_t* MIX = (bf16_t*)(p->ws + WS_MIX);
    const int r = lane & 31, hh = lane >> 5;
    int head, qrow0, b, gi = 0, w0 = 0, si = 0, ntile;
    if (LATENT) { head = unit & 7; const int t = unit >> 3; w0 = (t & 1) * 32; gi = (t >> 1) & 31; b = t >> 6; qrow0 = NCTX + b * DSEQ + gi * 64 + w0; si = min(max(gi - 4, 0), 24); ntile = 32; }
    else { head = unit & 7; const int t = unit >> 3; const int qb = t & 7; b = t >> 3; qrow0 = b * SEQ + qb * 32; ntile = 8; }
    bf16x8 qf[4];
#pragma unroll
    for (int s = 0; s < 4; ++s) qf[s] = *(const bf16x8*)(Q + (size_t)(qrow0 + r) * 512 + head * 64 + 16 * s + 8 * hh);
    auto tile_ptrs = [&](int t, const bf16_t*& kp, const bf16_t*& vp) {
        if (LATENT) {
            if (t < 16) { const size_t row = (size_t)b * 512 + t * 32; kp = CK + row * 512; vp = CV + row * 512; }
            else { const int lt = t - 16; const size_t row = (size_t)NCTX + b * DSEQ + (si + (lt >> 1)) * 64 + (((lt & 1) * 32) ^ w0); kp = Kb + row * 512; vp = Vb + row * 512; }
        } else { const size_t row = (size_t)b * SEQ + t * 32; kp = Kb + row * 512; vp = Vb + row * 512; }
    };
    bf16x8 kf[4], kn[4]; u32x4 vn[4];
    {
        const bf16_t *kp, *vp; tile_ptrs(t0, kp, vp);
#pragma unroll
        for (int s = 0; s < 4; ++s) kf[s] = *(const bf16x8*)(kp + (size_t)r * 512 + head * 64 + 16 * s + 8 * hh);
#pragma unroll
        for (int i = 0; i < 4; ++i) { const int c = lane + 64 * i; vn[i] = *(const u32x4*)(vp + (size_t)(c >> 3) * 512 + head * 64 + (c & 7) * 8); }
#pragma unroll
        for (int i = 0; i < 4; ++i) { const int c = lane + 64 * i; *(LAS u32x4*)(vbuf + (c >> 3) * 144 + (c & 7) * 16) = vn[i]; }
    }
    f32x16 o0, o1;
#pragma unroll
    for (int i = 0; i < 16; ++i) { o0[i] = 0.f; o1[i] = 0.f; }
    float mrun = -1e30f, lrun = 0.f;
    const int i16 = lane & 15, tq = i16 >> 2, tp = i16 & 3, blk = (lane >> 4) & 1;
    const LAS unsigned char* vtbase = vbuf + (4 * hh + tq) * 144 + (16 * blk) * 2 + 8 * tp;
    const int wq = w0 + r;
    const int cs = min(max(wq - 8, 0), 48);
    for (int t = t0; t < t1; ++t) {
        const bool more = (t + 1 < t1);
        if (more) {
            const bf16_t *kp, *vp; tile_ptrs(t + 1, kp, vp);
#pragma unroll
            for (int s = 0; s < 4; ++s) kn[s] = *(const bf16x8*)(kp + (size_t)r * 512 + head * 64 + 16 * s + 8 * hh);
#pragma unroll
            for (int i = 0; i < 4; ++i) { const int c = lane + 64 * i; vn[i] = *(const u32x4*)(vp + (size_t)(c >> 3) * 512 + head * 64 + (c & 7) * 8); }
        }
        f32x16 st;
#pragma unroll
        for (int i = 0; i < 16; ++i) st[i] = 0.f;
#pragma unroll
        for (int s = 0; s < 4; ++s) st = MFMA32(kf[s], qf[s], st);
        if (LATENT && t >= 16) {
            const int lt = t - 16, a = lt >> 1, c0 = ((lt & 1) * 32) ^ w0;
            const int row_off = si + a - gi + 7;
            const int d0 = c0 + 4 * hh - cs;
            const LAS float* bp = rpbL + head * 465 + row_off * 31 + (c0 + 4 * hh - wq + 15);
#pragma unroll
            for (int i = 0; i < 16; ++i) {
                const int ci = (i & 3) + 8 * (i >> 2);
                const bool valid = (unsigned)(d0 + ci) < 16u;
                const float bias = valid ? bp[ci] : 0.f;
                st[i] = valid ? st[i] + bias : -INFINITY;
            }
        }
        float tmax = st[0];
#pragma unroll
        for (int i = 1; i < 16; ++i) tmax = fmaxf(tmax, st[i]);
        tmax = fmaxf(tmax, __shfl_xor(tmax, 32));
        const float mnew = fmaxf(mrun, tmax);
        float ps = 0.f;
#pragma unroll
        for (int i = 0; i < 16; ++i) { st[i] = __builtin_amdgcn_exp2f(st[i] - mnew); ps += st[i]; }
        if (__builtin_amdgcn_ballot_w64(tmax > mrun) != 0ull) {
            const float alpha = __builtin_amdgcn_exp2f(mrun - mnew);
            lrun *= alpha;
#pragma unroll
            for (int i = 0; i < 16; ++i) { o0[i] *= alpha; o1[i] *= alpha; }
        }
        lrun += ps; mrun = mnew;
        bf16x8 pb[2];
#pragma unroll
        for (int s = 0; s < 2; ++s) { u32x4 w; w.x = pk2(st[8 * s], st[8 * s + 1]); w.y = pk2(st[8 * s + 2], st[8 * s + 3]); w.z = pk2(st[8 * s + 4], st[8 * s + 5]); w.w = pk2(st[8 * s + 6], st[8 * s + 7]); pb[s] = __builtin_bit_cast(bf16x8, w); }
        asm volatile("s_waitcnt lgkmcnt(0)" ::: "memory");
#pragma unroll
        for (int s = 0; s < 2; ++s) {
            const LAS unsigned char* bs = vtbase + (16 * s) * 144;
            const s16x4 lo0 = vtr(bs), hi0 = vtr(bs + 8 * 144), lo1 = vtr(bs + 64), hi1 = vtr(bs + 8 * 144 + 64);
            const bf16x8 va0 = __builtin_shufflevector(lo0, hi0, 0, 1, 2, 3, 4, 5, 6, 7), va1 = __builtin_shufflevector(lo1, hi1, 0, 1, 2, 3, 4, 5, 6, 7);
            o0 = MFMA32(va0, pb[s], o0); o1 = MFMA32(va1, pb[s], o1);
        }
        asm volatile("s_waitcnt lgkmcnt(0)" ::: "memory");
        if (more) {
#pragma unroll
            for (int i = 0; i < 4; ++i) { const int c = lane + 64 * i; *(LAS u32x4*)(vbuf + (c >> 3) * 144 + (c & 7) * 16) = vn[i]; }
#pragma unroll
            for (int s = 0; s < 4; ++s) kf[s] = kn[s];
        }
    }
    if (MODE == 1) {
#pragma unroll
        for (int i = 0; i < 16; ++i) { xch[i * 64 + lane] = o0[i]; xch[(16 + i) * 64 + lane] = o1[i]; }
        xch[32 * 64 + lane] = mrun; xch[33 * 64 + lane] = lrun;
        __syncthreads();
        return;
    }
    if (MODE == 2) {
        __syncthreads();
        const float mb = xch[32 * 64 + lane], lb = xch[33 * 64 + lane];
        const float mm = fmaxf(mrun, mb), fa = exp2f(mrun - mm), fb = exp2f(mb - mm);
#pragma unroll
        for (int i = 0; i < 16; ++i) { o0[i] = o0[i] * fa + xch[i * 64 + lane] * fb; o1[i] = o1[i] * fa + xch[(16 + i) * 64 + lane] * fb; }
        lrun = lrun * fa + lb * fb;
    }
    const float ltot = lrun + __shfl_xor(lrun, 32);
    const float inv = 1.f / ltot;
    bf16_t* orow = MIX + (size_t)(qrow0 + r) * D + head * 64;
#pragma unroll
    for (int g4 = 0; g4 < 4; ++g4) {
        const int d = 8 * g4 + 4 * hh;
        *(u32x2*)(orow + d) = (u32x2){pk2(o0[4 * g4] * inv, o0[4 * g4 + 1] * inv), pk2(o0[4 * g4 + 2] * inv, o0[4 * g4 + 3] * inv)};
        *(u32x2*)(orow + 32 + d) = (u32x2){pk2(o1[4 * g4] * inv, o1[4 * g4 + 1] * inv), pk2(o1[4 * g4 + 2] * inv, o1[4 * g4 + 3] * inv)};
    }
}

DI void prep_rows8(KP p, int r0, int lane) {
    const bf16_t* ZR = (const bf16_t*)(p->ws + WS_ZR); const float* wts = p->in[12]; const float* k_k = p->in[18];
    bf16_t* R = (bf16_t*)(p->ws + WS_R); bf16_t* KR = (bf16_t*)(p->ws + WS_KR); bf16_t* VV = (bf16_t*)(p->ws + WS_VV); bf16_t* KK = (bf16_t*)(p->ws + WS_KK);
    bf16_t* AL = (bf16_t*)(p->ws + WS_ALORA);
    const int t0 = r0 < NCTX ? (r0 & 255) : ((r0 - NCTX) & 2047); const int T = r0 < NCTX ? SEQ : DSEQ;
    const bool hp = t0 > 0, hn = t0 + 8 < T;
    const bf16_t* zb = ZR + (size_t)(r0 - 1) * RC;
    const f32x4 zero = {0, 0, 0, 0};
#pragma unroll 1
    for (int seg = 0; seg < 3; ++seg) {
        const int c = seg * 512 + lane * 8;
        f32x4 z[10][2];
#pragma unroll
        for (int i = 0; i < 10; ++i) { const bool ok = (i > 0 || hp) && (i < 9 || hn);
            if (ok) { const u32x4 w = *(const u32x4*)(zb + (size_t)i * RC + c); z[i][0] = unpk4((u32x2){w.x, w.y}); z[i][1] = unpk4((u32x2){w.z, w.w}); } else { z[i][0] = zero; z[i][1] = zero; } }
        const f32x4 wa0 = *(const f32x4*)(wts + c), wa1 = *(const f32x4*)(wts + c + 4), wb0 = *(const f32x4*)(wts + RC + c), wb1 = *(const f32x4*)(wts + RC + c + 4),
                    wc0 = *(const f32x4*)(wts + 2 * RC + c), wc1 = *(const f32x4*)(wts + 2 * RC + c + 4);
        const f32x4 k0 = *(const f32x4*)(k_k + lane * 8), k1 = *(const f32x4*)(k_k + lane * 8 + 4);
        bf16_t* dstb = (seg == 0 ? R : (seg == 1 ? KR : VV)) + (size_t)r0 * 512 + lane * 8;
#pragma unroll
        for (int i = 0; i < 8; ++i) {
            const f32x4 u0 = z[i][0] * wa0 + z[i + 1][0] * wb0 + z[i + 2][0] * wc0, u1 = z[i][1] * wa1 + z[i + 1][1] * wb1 + z[i + 2][1] * wc1;
            *(u32x4*)(dstb + (size_t)i * 512) = (u32x4){pk2(u0.x, u0.y), pk2(u0.z, u0.w), pk2(u1.x, u1.y), pk2(u1.z, u1.w)};
            if (seg == 1) {
                const f32x4 a = u0 * k0, bq = u1 * k1;
                float sq = (a.x * a.x + a.y * a.y) + (a.z * a.z + a.w * a.w) + (bq.x * bq.x + bq.y * bq.y) + (bq.z * bq.z + bq.w * bq.w);
                sq += __shfl_xor(sq, 1); sq += __shfl_xor(sq, 2); sq += __shfl_xor(sq, 4);
                const float rn = rsqrtf(sq + 1e-12f);
                const f32x4 ka_ = a * rn, kb_ = bq * rn; *(u32x4*)(KK + (size_t)(r0 + i) * 512 + lane * 8) = (u32x4){pk2(ka_.x, ka_.y), pk2(ka_.z, ka_.w), pk2(kb_.x, kb_.y), pk2(kb_.z, kb_.w)};
            }
        }
    }
    {
        const int cl = lane * 6, cc = 1536 + cl;
        const f32x2 zero2 = {0, 0};
        f32x2 z[10][3];
#pragma unroll
        for (int i = 0; i < 10; ++i) { const bool ok = (i > 0 || hp) && (i < 9 || hn);
#pragma unroll
            for (int q = 0; q < 3; ++q) { if (ok) { const unsigned w = *(const unsigned*)(zb + (size_t)i * RC + cc + 2 * q); z[i][q] = (f32x2){__builtin_bit_cast(float, w << 16), __builtin_bit_cast(float, w & 0xffff0000u)}; } else z[i][q] = zero2; } }
#pragma unroll
        for (int q = 0; q < 3; ++q) {
            const f32x2 wa = *(const f32x2*)(wts + cc + 2 * q), wb = *(const f32x2*)(wts + RC + cc + 2 * q), wcq = *(const f32x2*)(wts + 2 * RC + cc + 2 * q);
            const int cq = cl + 2 * q, grp = cq >> 7, k = cq & 127;
#pragma unroll
            for (int i = 0; i < 8; ++i) {
                f32x2 u = z[i][q] * wa + z[i + 1][q] * wb + z[i + 2][q] * wcq;
                if (grp == 0) { u.x = tanh_f(u.x); u.y = tanh_f(u.y); }
                else if (grp == 2) { u.x = sigmoid_f(u.x); u.y = sigmoid_f(u.y); }
                *(unsigned*)(AL + ((size_t)grp * NTOK + r0 + i) * 128 + k) = pk2(u.x, u.y);
            }
        }
    }
}

template <int CTRL> DI float dppf_(float x) { return __builtin_bit_cast(float, __builtin_amdgcn_mov_dpp(__builtin_bit_cast(int, x), CTRL, 0xf, 0xf, true)); }
template <int CTRL> DI float dpp_add(float x) { const int y = __builtin_amdgcn_mov_dpp(__builtin_bit_cast(int, x), CTRL, 0xf, 0xf, true); return x + __builtin_bit_cast(float, y); }
DI float red16(float x) { x = dpp_add<0xB1>(x); x = dpp_add<0x4E>(x); x = dpp_add<0x141>(x); x = dpp_add<0x140>(x); return x; }

constexpr int TC = 16;
DI float tred4(float q0, float q1, float q2, float q3, bool b0, bool b1) {
    const float ka = b0 ? q2 : q0, kb = b0 ? q3 : q1, sa = b0 ? q0 : q2, sb = b0 ? q1 : q3;
    const float a = ka + dppf_<0xB1>(sa), b = kb + dppf_<0xB1>(sb);
    float c = (b1 ? b : a) + dppf_<0x4E>(b1 ? a : b);
    c += dppf_<0x124>(c);
    c += dppf_<0x128>(c);
    return c;
}
DI f32x2 lo2(f32x4 v) { return __builtin_shufflevector(v, v, 0, 1); }
DI f32x2 hi2(f32x4 v) { return __builtin_shufflevector(v, v, 2, 3); }
struct ScanOps { f32x4 kk, rr, ww, bb, kd; float vv; };
struct ScanLd { f32x4 kk, r, dec, aa, kr, v; };
DI void scan_item(KP p, LAS unsigned char* lds, int latent, int sc, int qr, int tid) {
    const bf16_t* KK = (const bf16_t*)(p->ws + WS_KK); const bf16_t* R = (const bf16_t*)(p->ws + WS_R); const bf16_t* KR = (const bf16_t*)(p->ws + WS_KR);
    const bf16_t* VV = (const bf16_t*)(p->ws + WS_VV); const float* k_a = p->in[19];
    float* Y = (float*)(p->ws + WS_Y);
    const int b = sc >> 4, dir = (sc >> 3) & 1, h = sc & 7;
    const int T = latent ? DSEQ : SEQ; const size_t rowbase = latent ? (size_t)NCTX + (size_t)b * DSEQ : (size_t)b * SEQ;
    const float* DEC = (const float*)(p->ws + WS_DEC) + (size_t)dir * NTOK * 512; const bf16_t* AA = (const bf16_t*)(p->ws + WS_AA) + (size_t)dir * NTOK * 512;
    float* Yd = Y + (size_t)dir * NTOK * 512;
    LAS float* buf = (LAS float*)lds;
    LAS float* vb = (LAS float*)(lds + 2 * TC * 320 * 4);
    const int wave = tid >> 6, lane = tid & 63;
    const bool consumer = wave < 4;
    const int nchunk = T / TC;
    const int rl = lane >> 4, ks = lane & 15, row = 16 * qr + 4 * wave + rl;
    f32x2 S01 = {0, 0}, S23 = {0, 0};
    if (consumer && latent) { const f32x4 s4 = *(const f32x4*)(p->in[4] + ((((size_t)b * 2 + dir) * 8 + h) * 64 + row) * 64 + 4 * ks); S01 = lo2(s4); S23 = hi2(s4); }
    const int lt = tid - 256, lj = lt >> 4, li = lt & 15;
    ScanLd L0, L1; f32x4 ka4 = {0, 0, 0, 0};
    if (!consumer) ka4 = *(const f32x4*)(k_a + h * 64 + 4 * li);
    float* ybase = Yd + (rowbase)*512 + h * 64 + row;
    const bool kb0 = (ks & 1) != 0, kb1 = (ks & 2) != 0; const int ystep = 4 * (ks >> 2) + 2 * (ks & 1) + ((ks >> 1) & 1);
#define SCAN_LOAD(L, c) do { const int idx = (c) * TC + lj; const int tt = dir ? T - 1 - idx : idx; const size_t off = (rowbase + tt) * 512 + h * 64 + 4 * li; \
        L.kk = unpk4(*(const u32x2*)(KK + off)); L.r = unpk4(*(const u32x2*)(R + off)); L.dec = *(const f32x4*)(DEC + off); L.aa = unpk4(*(const u32x2*)(AA + off)); L.kr = unpk4(*(const u32x2*)(KR + off)); \
        if (lt < 64) { const int vj = lt >> 2, vq = lt & 3; const int idv = (c) * TC + vj; const int tv = dir ? T - 1 - idv : idv; L.v = unpk4(*(const u32x2*)(VV + (rowbase + tv) * 512 + h * 64 + 16 * qr + 4 * vq)); } } while (0)
#define SCAN_WRITE(L, bc, vc) do { const f32x4 bb_ = L.kk * L.aa; const f32x4 kd_ = L.kr * ((L.aa - 1.f) * ka4 + 1.f); LAS float* d_ = (bc) + lj * 320 + 4 * li; \
        *(LAS f32x4*)(d_) = L.kk; *(LAS f32x4*)(d_ + 64) = L.r; *(LAS f32x4*)(d_ + 128) = L.dec; *(LAS f32x4*)(d_ + 192) = bb_; *(LAS f32x4*)(d_ + 256) = kd_; \
        if (lt < 64) *(LAS f32x4*)((vc) + (lt >> 2) * 16 + 4 * (lt & 3)) = L.v; } while (0)
#define SCAN_LDOPS(o, bc, vc, j) do { const LAS float* d_ = (bc) + (j) * 320 + 4 * ks; o.kk = *(const LAS f32x4*)(d_); o.rr = *(const LAS f32x4*)(d_ + 64); o.ww = *(const LAS f32x4*)(d_ + 128); \
        o.bb = *(const LAS f32x4*)(d_ + 192); o.kd = *(const LAS f32x4*)(d_ + 256); o.vv = (vc)[(j) * 16 + 4 * wave + rl]; } while (0)
#define SCAN_COMPUTE(bc, vc, c) do { ScanOps oc, on, on2; SCAN_LDOPS(oc, bc, vc, 0); SCAN_LDOPS(on, bc, vc, 1); float ysel = 0.f; float yp0 = 0.f, yp1 = 0.f, yp2 = 0.f; \
        _Pragma("unroll") for (int j = 0; j < TC; ++j) { \
            if (j + 2 < TC) SCAN_LDOPS(on2, bc, vc, j + 2);     \
            f32x2 pq = S01 * lo2(oc.kk); pq = S23 * hi2(oc.kk) + pq; \
            const float sa = red16(pq.x + pq.y); \
            const f32x2 t01 = S01 * lo2(oc.ww) + lo2(oc.kd) * oc.vv, t23 = S23 * hi2(oc.ww) + hi2(oc.kd) * oc.vv; \
            S01 = t01 - lo2(oc.bb) * sa; S23 = t23 - hi2(oc.bb) * sa; \
            f32x2 yq = S01 * lo2(oc.rr); yq = S23 * hi2(oc.rr) + yq; \
            const float yp = yq.x + yq.y; \
            if ((j & 3) == 0) yp0 = yp; else if ((j & 3) == 1) yp1 = yp; else if ((j & 3) == 2) yp2 = yp; \
            else { const float yr = tred4(yp0, yp1, yp2, yp, kb0, kb1); ysel = ((ks >> 2) == (j >> 2)) ? yr : ysel; } \
            oc = on; on = on2; \
            asm volatile("" ::: "memory"); } \
        { const int idx = (c) * TC + ystep; const int tt = dir ? T - 1 - idx : idx; ybase[(size_t)tt * 512] = ysel; } } while (0)
    if (!consumer) { SCAN_LOAD(L0, 0); SCAN_LOAD(L1, 1); }
    for (int c = 0; c < nchunk; c += 2) {
        if (!consumer) SCAN_WRITE(L0, buf, vb);
        __syncthreads();
        if (!consumer) { if (c + 2 < nchunk) SCAN_LOAD(L0, c + 2); }
        else SCAN_COMPUTE(buf, vb, c);
        if (!consumer) SCAN_WRITE(L1, buf + TC * 320, vb + TC * 16);
        __syncthreads();
        if (!consumer) { if (c + 3 < nchunk) SCAN_LOAD(L1, c + 3); }
        else SCAN_COMPUTE(buf + TC * 320, vb + TC * 16, c + 1);
    }
#undef SCAN_LOAD
#undef SCAN_WRITE
#undef SCAN_LDOPS
#undef SCAN_COMPUTE
    if (consumer && !latent) *(f32x4*)(p->out + OUT_S + ((((size_t)b * 2 + dir) * 8 + h) * 64 + row) * 64 + 4 * ks) = (f32x4){S01.x, S01.y, S23.x, S23.y};
    __syncthreads();
}

constexpr int CS_L = 32, CS_LAT = 2048, CS_CHUNKS = 4096;
DI unsigned char* cs_mf(unsigned char* ws, int q) { return ws + 28 * MiB + (size_t)q * 8192; }
DI unsigned char* cs_q1(unsigned char* ws, int q) { return q < CS_LAT ? ws + 60 * MiB + (size_t)q * 4096 : ws + 76 * MiB + (size_t)(q - CS_LAT) * 4096; }
DI unsigned char* cs_q2(unsigned char* ws, int q) { return q < CS_LAT ? ws + 92 * MiB + (size_t)q * 4096 : ws + 108 * MiB + (size_t)(q - CS_LAT) * 4096; }
DI unsigned char* cs_nt(unsigned char* ws, int q) { return q < CS_LAT ? ws + 202 * MiB + (size_t)q * 8192 : ws + 234 * MiB + (size_t)(q - CS_LAT) * 8192; }
constexpr int CS_G = 51456;
DI bf16x8 frag_nat(const LAS unsigned char* img, int pitch, int rc, int s, int hh) { return *(const LAS bf16x8*)(img + rc * pitch + (16 * s + 8 * hh) * 2); }
DI bf16x8 frag_krow(const LAS unsigned char* img, int pitch, int rc, int s, int hh) {
    const s16x4 lo = *(const LAS s16x4*)(img + rc * pitch + (16 * s + 4 * hh) * 2), hi = *(const LAS s16x4*)(img + rc * pitch + (16 * s + 8 + 4 * hh) * 2);
    return __builtin_shufflevector(lo, hi, 0, 1, 2, 3, 4, 5, 6, 7); }
DI bf16x8 frag_tr(const LAS unsigned char* img, int pitch, int col0, int s, int lane) {
    const int i16 = lane & 15, tq = i16 >> 2, tp = i16 & 3, blk = (lane >> 4) & 1, hh = lane >> 5;
    const LAS unsigned char* bs = img + (16 * s + 4 * hh + tq) * pitch + (col0 + 16 * blk) * 2 + 8 * tp;
    const s16x4 lo = vtr(bs), hi = vtr(bs + 8 * pitch);
    return __builtin_shufflevector(lo, hi, 0, 1, 2, 3, 4, 5, 6, 7); }
template <int S> DI bf16x8 pack8(const f32x16& x, float sg) {
    u32x4 w; w.x = pk2(sg * x[8 * S], sg * x[8 * S + 1]); w.y = pk2(sg * x[8 * S + 2], sg * x[8 * S + 3]); w.z = pk2(sg * x[8 * S + 4], sg * x[8 * S + 5]); w.w = pk2(sg * x[8 * S + 6], sg * x[8 * S + 7]);
    return __builtin_bit_cast(bf16x8, w); }
template <int S> DI bf16x8 pack8lo(const f32x16& x, bf16x8 hi) {
    const u32x4 h = __builtin_bit_cast(u32x4, hi); float d[8];
#pragma unroll
    for (int j = 0; j < 4; ++j) { d[2 * j] = x[8 * S + 2 * j] - __builtin_bit_cast(float, h[j] << 16); d[2 * j + 1] = x[8 * S + 2 * j + 1] - __builtin_bit_cast(float, h[j] & 0xffff0000u); }
    u32x4 w; w.x = pk2(d[0], d[1]); w.y = pk2(d[2], d[3]); w.z = pk2(d[4], d[5]); w.w = pk2(d[6], d[7]);
    return __builtin_bit_cast(bf16x8, w); }
DI void lds_barrier() { asm volatile("s_waitcnt lgkmcnt(0)" ::: "memory"); __builtin_amdgcn_s_barrier(); asm volatile("" ::: "memory"); }
DI f32x16 zero16() { f32x16 z;
#pragma unroll
    for (int i = 0; i < 16; ++i) z[i] = 0.f;
    return z; }

DI void cs_phaseA(KP p, LAS unsigned char* lds, int tid, int qbase, int nit, int first, int stride) {
    const bf16_t* KK = (const bf16_t*)(p->ws + WS_KK); const bf16_t* R = (const bf16_t*)(p->ws + WS_R); const bf16_t* KR = (const bf16_t*)(p->ws + WS_KR);
    const bf16_t* VV = (const bf16_t*)(p->ws + WS_VV); const float* k_a = p->in[19];
    const int wave = tid >> 6, lane = tid & 63, g = wave >> 2, wq = wave & 3, tg = wq * 64 + lane, hh = lane >> 5, r32 = lane & 31;
    LAS unsigned char* L = lds + g * CS_G;
    LAS unsigned char* MKK = L, *MBT = L + 4608, *MKT = L + 2 * 4608, *MRT = L + 3 * 4608, *MBH = L + 4 * 4608, *MKH = L + 5 * 4608, *MVM = L + 6 * 4608;
    LAS float* AF = (LAS float*)(L + 32256);
    LAS unsigned char* ST = L + 36352, *SKK = ST + 2560, *SRB = ST + 2 * 2560, *SRK = ST + 3 * 2560;
    LAS float* SEG = (LAS float*)(L + 46592); LAS float* ELv = (LAS float*)(L + 48640);
    LAS unsigned char* SA = L + 48896;
    f32x2 lwN[4], kkN[4], aaN[4], krN[4], rN[4]; u32x4 vmN;
#define CSA_FETCH(it_) do { const int q_ = qbase + (it_) * 2 + g; const bool lat_ = q_ < CS_LAT; const int sc_ = lat_ ? (q_ >> 6) : ((q_ - CS_LAT) >> 3), ci_ = lat_ ? (q_ & 63) : (q_ & 7), TT_ = lat_ ? DSEQ : SEQ; \
        const int b_ = sc_ >> 4, dir_ = (sc_ >> 3) & 1, h_ = sc_ & 7; const int rb_ = lat_ ? NCTX + b_ * DSEQ : b_ * SEQ; \
          \
        const int t0_ = dir_ ? TT_ - 1 - ci_ * CS_L : ci_ * CS_L, sg_ = dir_ ? -512 : 512; \
        const unsigned ub_ = (unsigned)((rb_ + t0_) * 512 + h_ * 64); \
        const unsigned o0_ = ub_ + (unsigned)(sg_ * 4 * (tg >> 5) + 2 * (tg & 31)); \
        const float* DEC_ = (const float*)(p->ws + WS_DEC) + (size_t)dir_ * NTOK * 512; const bf16_t* AA_ = (const bf16_t*)(p->ws + WS_AA) + (size_t)dir_ * NTOK * 512; \
        _Pragma("unroll") for (int j = 0; j < 4; ++j) { const unsigned off = o0_ + (unsigned)(sg_ * j); \
            lwN[j] = *(const f32x2*)(DEC_ + off); kkN[j] = ldh2(KK + off); aaN[j] = ldh2(AA_ + off); krN[j] = ldh2(KR + off); rN[j] = ldh2(R + off); } \
        vmN = *(const u32x4*)(VV + (ub_ + (unsigned)(sg_ * (tg >> 3) + (tg & 7) * 8))); } while (0)
    if (first < nit) CSA_FETCH(first);
    for (int it = first; it < nit; it += stride) {
        const int q = qbase + it * 2 + g; const bool lat = q < CS_LAT;
        const int sc = lat ? (q >> 6) : ((q - CS_LAT) >> 3), ci = lat ? (q & 63) : (q & 7), TT = lat ? DSEQ : SEQ;
        const int b = sc >> 4, dir = (sc >> 3) & 1, h = sc & 7;
        const size_t rowbase = lat ? (size_t)NCTX + (size_t)b * DSEQ : (size_t)b * SEQ;
        const float* DEC = (const float*)(p->ws + WS_DEC) + (size_t)dir * NTOK * 512; const bf16_t* AA = (const bf16_t*)(p->ws + WS_AA) + (size_t)dir * NTOK * 512;
        {
            const int kp = tg & 31, seg = tg >> 5;
            f32x2 lw[4], kk2[4], aa2[4], kr2[4], r2[4];
#pragma unroll
            for (int j = 0; j < 4; ++j) { lw[j] = lwN[j]; kk2[j] = kkN[j]; aa2[j] = aaN[j]; kr2[j] = krN[j]; r2[j] = rN[j]; }
            const u32x4 vmC = vmN;
            if (it + stride < nit) CSA_FETCH(it + stride);
            f32x2 ss = {0.f, 0.f};
#pragma unroll
            for (int j = 0; j < 4; ++j) { lw[j].x = __logf(lw[j].x); lw[j].y = __logf(lw[j].y); ss += lw[j]; }
            *(LAS f32x2*)(SEG + seg * 64 + 2 * kp) = ss;
            { const int i = tg >> 3, v0 = (tg & 7) * 8; *(LAS u32x4*)(MVM + i * 144 + v0 * 2) = vmC; }
            lds_barrier();
            f32x2 pre = {0.f, 0.f}, tot = {0.f, 0.f};
#pragma unroll
            for (int s8 = 0; s8 < 8; ++s8) { const f32x2 v = *(const LAS f32x2*)(SEG + s8 * 64 + 2 * kp); tot += v; if (s8 < seg) pre += v; }
            if (seg == 0) *(LAS f32x2*)(ELv + 2 * kp) = (f32x2){__expf(tot.x), __expf(tot.y)};
            const f32x2 ka = *(const f32x2*)(k_a + h * 64 + 2 * kp);
            f32x2 cwp = pre;
#pragma unroll
            for (int j = 0; j < 4; ++j) {
                const f32x2 cw = cwp + lw[j];
                const f32x2 E = {__expf(cw.x), __expf(cw.y)}, Ei = {__expf(-cw.x), __expf(-cw.y)}, Ep = {__expf(cwp.x), __expf(cwp.y)}, Eh = {__expf(tot.x - cw.x), __expf(tot.y - cw.y)};
                const f32x2 bb = kk2[j] * aa2[j], kd = kr2[j] * ((aa2[j] - 1.f) * ka + 1.f);
                const int o = (4 * seg + j) * 144 + 4 * kp;
                const f32x2 x0 = kk2[j] * Ep, x1 = bb * Ei, x2 = kd * Ei, x3 = r2[j] * E, x4 = bb * Eh, x5 = kd * Eh;
                *(LAS unsigned*)(MKK + o) = pk2(x0.x, x0.y); *(LAS unsigned*)(MBT + o) = pk2(x1.x, x1.y); *(LAS unsigned*)(MKT + o) = pk2(x2.x, x2.y);
                *(LAS unsigned*)(MRT + o) = pk2(x3.x, x3.y); *(LAS unsigned*)(MBH + o) = pk2(x4.x, x4.y); *(LAS unsigned*)(MKH + o) = pk2(x5.x, x5.y);
                cwp = cw;
            }
        }
        lds_barrier();
        {
            const LAS unsigned char* ia = wq < 2 ? MKK : MRT; const LAS unsigned char* ib = (wq & 1) ? MKT : MBT;
            f32x16 acc = zero16();
#pragma unroll
            for (int s4 = 0; s4 < 4; ++s4) acc = MFMA32(frag_nat(ia, 144, r32, s4, hh), frag_nat(ib, 144, r32, s4, hh), acc);
#pragma unroll
            for (int i = 0; i < 16; ++i) { const int row = crow(i, hh); const bool keep = wq < 2 ? (row > r32) : (row >= r32); const float v = keep ? acc[i] : 0.f;
                if (wq == 0) { AF[row * 32 + r32] = v; *(LAS unsigned short*)(SA + row * 80 + r32 * 2) = (row >= 16 && r32 < 16) ? (unsigned short)(pk2(v, 0.f) & 0xffffu) : (unsigned short)0; }
                else *(LAS unsigned short*)((wq == 1 ? SKK : (wq == 2 ? SRB : SRK)) + row * 80 + r32 * 2) = (unsigned short)(pk2(v, 0.f) & 0xffffu); }
        }
        lds_barrier();
        f32x16 X = zero16(), NT0 = zero16(), NT1 = zero16(), Q2 = zero16();
        const int c = wq & 1;
        if (wq == 0) {
            const int blk = r32 >> 4, cc = r32 & 15;
            float Tc[16];
#pragma unroll
            for (int i = 0; i < 16; ++i) {
                float a4[4] = {(i == cc) ? 1.f : 0.f, 0.f, 0.f, 0.f};
#pragma unroll
                for (int j4 = 0; j4 < (i + 3) / 4; ++j4) { const f32x4 ar = *(const LAS f32x4*)(AF + (16 * blk + i) * 32 + 16 * blk + 4 * j4);
#pragma unroll
                    for (int e = 0; e < 4; ++e) if (4 * j4 + e < i) a4[e] -= ar[e] * Tc[4 * j4 + e]; }
                const float a = (a4[0] + a4[1]) + (a4[2] + a4[3]);
                Tc[i] = a;
                if (lane < 32) { *(LAS unsigned short*)(ST + (16 * blk + i) * 80 + (16 * blk + cc) * 2) = (unsigned short)(pk2(a, 0.f) & 0xffffu);
                                 *(LAS unsigned short*)(ST + (16 * blk + i) * 80 + (16 * (1 - blk) + cc) * 2) = (unsigned short)0; }
            }
            asm volatile("s_waitcnt lgkmcnt(0)" ::: "memory");
            f32x16 E = zero16();
            E = MFMA32(frag_krow(SA, 80, r32, 0, hh), frag_tr(ST, 80, 0, 0, lane), E); E = MFMA32(frag_krow(SA, 80, r32, 1, hh), frag_tr(ST, 80, 0, 1, lane), E);
#pragma unroll
            for (int i = 0; i < 16; ++i) E[i] = ((crow(i, hh) == r32) ? 1.f : 0.f) - E[i];
            f32x16 Tm = zero16();
            Tm = MFMA32(frag_krow(ST, 80, r32, 0, hh), pack8<0>(E, 1.f), Tm); Tm = MFMA32(frag_krow(ST, 80, r32, 1, hh), pack8<1>(E, 1.f), Tm);
            asm volatile("s_waitcnt lgkmcnt(0)" ::: "memory");
#pragma unroll
            for (int i = 0; i < 16; ++i) *(LAS unsigned short*)(ST + crow(i, hh) * 80 + r32 * 2) = (unsigned short)(pk2(Tm[i], 0.f) & 0xffffu);
        } else if (wq >= 2) {
#pragma unroll
            for (int s2 = 0; s2 < 2; ++s2) {
                const bf16x8 vm = frag_tr(MVM, 144, 32 * c, s2, lane);
                X = MFMA32(frag_krow(SKK, 80, r32, s2, hh), vm, X);
                Q2 = MFMA32(frag_krow(SRK, 80, r32, s2, hh), vm, Q2);
                NT0 = MFMA32(frag_tr(MKH, 144, 0, s2, lane), vm, NT0);
                NT1 = MFMA32(frag_tr(MKH, 144, 32, s2, lane), vm, NT1);
            }
        }
        lds_barrier();
        if (wq < 2) {
            f32x16 P1 = zero16();
#pragma unroll
            for (int s2 = 0; s2 < 2; ++s2) P1 = MFMA32(frag_krow(ST, 80, r32, s2, hh), frag_tr(MKK, 144, 32 * c, s2, lane), P1);
            const bf16x8 n0 = pack8<0>(P1, -1.f), n1 = pack8<1>(P1, -1.f);
            f32x16 Q1t;
#pragma unroll
            for (int g4 = 0; g4 < 4; ++g4) { const u32x2 w = *(const LAS u32x2*)(MRT + r32 * 144 + (32 * c + 8 * g4 + 4 * hh) * 2); const f32x4 f = unpk4(w);
                Q1t[4 * g4] = f.x; Q1t[4 * g4 + 1] = f.y; Q1t[4 * g4 + 2] = f.z; Q1t[4 * g4 + 3] = f.w; }
            Q1t = MFMA32(n0, frag_krow(SRB, 80, r32, 0, hh), Q1t); Q1t = MFMA32(n1, frag_krow(SRB, 80, r32, 1, hh), Q1t);
            u32x4* q1f = (u32x4*)cs_q1(p->ws, q) + (c * 2) * 64 + lane;
            q1f[0] = __builtin_bit_cast(u32x4, pack8<0>(Q1t, 1.f)); q1f[64] = __builtin_bit_cast(u32x4, pack8<1>(Q1t, 1.f));
#pragma unroll
            for (int bq = 0; bq < 2; ++bq) {
                f32x16 M = zero16();
                if (bq == c) {
#pragma unroll
                    for (int i = 0; i < 16; ++i) M[i] = (crow(i, hh) == r32) ? ELv[32 * c + r32] : 0.f;
                }
                M = MFMA32(n0, frag_tr(MBH, 144, 32 * bq, 0, lane), M); M = MFMA32(n1, frag_tr(MBH, 144, 32 * bq, 1, lane), M);
                u32x4* mf = (u32x4*)cs_mf(p->ws, q) + ((c * 2 + bq) * 2) * 64 + lane;
                mf[0] = __builtin_bit_cast(u32x4, pack8<0>(M, 1.f)); mf[64] = __builtin_bit_cast(u32x4, pack8<1>(M, 1.f));
            }
        } else {
            f32x16 P2 = zero16();
            P2 = MFMA32(frag_krow(ST, 80, r32, 0, hh), pack8<0>(X, 1.f), P2); P2 = MFMA32(frag_krow(ST, 80, r32, 1, hh), pack8<1>(X, 1.f), P2);
            const bf16x8 n0 = pack8<0>(P2, -1.f), n1 = pack8<1>(P2, -1.f);
            Q2 = MFMA32(frag_krow(SRB, 80, r32, 0, hh), n0, Q2); Q2 = MFMA32(frag_krow(SRB, 80, r32, 1, hh), n1, Q2);
            NT0 = MFMA32(frag_tr(MBH, 144, 0, 0, lane), n0, NT0); NT0 = MFMA32(frag_tr(MBH, 144, 0, 1, lane), n1, NT0);
            NT1 = MFMA32(frag_tr(MBH, 144, 32, 0, lane), n0, NT1); NT1 = MFMA32(frag_tr(MBH, 144, 32, 1, lane), n1, NT1);
            unsigned* q2f = (unsigned*)cs_q2(p->ws, q) + c * 512 + lane;
#pragma unroll
            for (int i = 0; i < 8; ++i) q2f[i * 64] = pk2(Q2[2 * i], Q2[2 * i + 1]);
            unsigned* ntf = (unsigned*)cs_nt(p->ws, q) + (c * 2) * 512 + lane;
#pragma unroll
            for (int i = 0; i < 8; ++i) { ntf[i * 64] = pk2(NT0[2 * i], NT0[2 * i + 1]); ntf[512 + i * 64] = pk2(NT1[2 * i], NT1[2 * i + 1]); }
        }
        lds_barrier();
    }
#undef CSA_FETCH
}


constexpr int CSB_SLOT = 24576;
DI void cs_phaseB(KP p, LAS unsigned char* lds, int latent, int sc, int tid) {
    const int wave = tid >> 6, lane = tid & 63, hh = lane >> 5, r32 = lane & 31;
    const int nch = latent ? 64 : 8, q0 = latent ? sc * 64 : CS_LAT + sc * 8, TT = latent ? DSEQ : SEQ;
    const int b = sc >> 4, dir = (sc >> 3) & 1, h = sc & 7, c = wave & 1;
    const size_t rowbase = latent ? (size_t)NCTX + (size_t)b * DSEQ : (size_t)b * SEQ;
    const bool consumer = wave < 2;
    float* Yu = p->out + (size_t)dir * NTOK * 512 + rowbase * 512 + h * 64 + 32 * c;
    const unsigned ylane = (unsigned)((dir ? 4 * (1 - hh) : 4 * hh) * 512 + r32);
    unsigned yv[8];
#pragma unroll
    for (int k = 0; k < 8; ++k) { const int rr_ = 2 * (k & 1) + 8 * (k >> 1); yv[k] = (ylane + (unsigned)((dir ? TT - CS_L + 27 - rr_ : rr_) * 512)) * 4u; }
    const unsigned ystepb = dir ? 0u - (unsigned)(CS_L * 512 * 4) : (unsigned)(CS_L * 512 * 4);
    f32x16 Z0 = zero16(), Z1 = zero16();
    if (consumer && latent) { const float* s0 = p->in[4] + ((((size_t)b * 2 + dir) * 8 + h) * 64 + 32 * c + r32) * 64;
#pragma unroll
      for (int g4 = 0; g4 < 4; ++g4) { const f32x4 a = *(const f32x4*)(s0 + 8 * g4 + 4 * hh), bq = *(const f32x4*)(s0 + 32 + 8 * g4 + 4 * hh);
          Z0[4 * g4] = a.x; Z0[4 * g4 + 1] = a.y; Z0[4 * g4 + 2] = a.z; Z0[4 * g4 + 3] = a.w; Z1[4 * g4] = bq.x; Z1[4 * g4 + 1] = bq.y; Z1[4 * g4 + 2] = bq.z; Z1[4 * g4 + 3] = bq.w; } }
    const int lt = tid - 128;
    u32x4 RG[2][4];
#define CSB_LOADQ(set, ch) do { const int q_ = q0 + (ch); _Pragma("unroll") for (int k_ = 0; k_ < 4; ++k_) { const int pi_ = lt + 384 * k_; \
        const unsigned char* src_ = pi_ < 512 ? cs_mf(p->ws, q_) + pi_ * 16 : (pi_ < 768 ? cs_q1(p->ws, q_) + (pi_ - 512) * 16 : (pi_ < 1280 ? cs_nt(p->ws, q_) + (pi_ - 768) * 16 : cs_q2(p->ws, q_) + (pi_ - 1280) * 16)); \
        RG[set][k_] = *(const u32x4*)src_; } } while (0)
#define CSB_WRITEQ(set, slot) do { _Pragma("unroll") for (int k_ = 0; k_ < 4; ++k_) *(LAS u32x4*)(lds + (slot) * CSB_SLOT + (lt + 384 * k_) * 16) = RG[set][k_]; } while (0)
    if (!consumer) { CSB_LOADQ(0, 0); CSB_LOADQ(1, 1); CSB_WRITEQ(0, 0); CSB_LOADQ(0, 2); }
    else __builtin_amdgcn_s_setprio(3);
    for (int ci0 = 0; ci0 < nch; ci0 += 2) {
#pragma unroll
        for (int u = 0; u < 2; ++u) {
            const int ci = ci0 + u;
            lds_barrier();
            if (!consumer) {
                if (ci + 1 < nch) { CSB_WRITEQ((u + 1) & 1, (ci + 1) & 1); if (ci + 3 < nch) CSB_LOADQ((u + 1) & 1, ci + 3); }
            } else {
                const LAS unsigned char* sl = lds + (ci & 1) * CSB_SLOT;
                bf16x8 MF[8], Q1[4]; f32x16 Y, N0, N1;
#pragma unroll
                for (int i = 0; i < 8; ++i) MF[i] = *(const LAS bf16x8*)(sl + (i * 64 + lane) * 16);
#pragma unroll
                for (int i = 0; i < 4; ++i) Q1[i] = *(const LAS bf16x8*)(sl + 8192 + (i * 64 + lane) * 16);
#pragma unroll
                for (int i = 0; i < 8; ++i) { const unsigned w0 = *(const LAS unsigned*)(sl + 12288 + ((c * 2) * 512 + i * 64 + lane) * 4), w1 = *(const LAS unsigned*)(sl + 12288 + ((c * 2 + 1) * 512 + i * 64 + lane) * 4),
                                                         w2 = *(const LAS unsigned*)(sl + 20480 + (c * 512 + i * 64 + lane) * 4);
                    N0[2 * i] = __builtin_bit_cast(float, w0 << 16); N0[2 * i + 1] = __builtin_bit_cast(float, w0 & 0xffff0000u);
                    N1[2 * i] = __builtin_bit_cast(float, w1 << 16); N1[2 * i + 1] = __builtin_bit_cast(float, w1 & 0xffff0000u);
                    Y[2 * i] = __builtin_bit_cast(float, w2 << 16); Y[2 * i + 1] = __builtin_bit_cast(float, w2 & 0xffff0000u); }
                const bf16x8 z00 = pack8<0>(Z0, 1.f), z01 = pack8<1>(Z0, 1.f), z10 = pack8<0>(Z1, 1.f), z11 = pack8<1>(Z1, 1.f);
                const bf16x8 l00 = pack8lo<0>(Z0, z00), l01 = pack8lo<1>(Z0, z01), l10 = pack8lo<0>(Z1, z10), l11 = pack8lo<1>(Z1, z11);
                Y = MFMA32(Q1[0], z00, Y); Y = MFMA32(Q1[1], z01, Y); Y = MFMA32(Q1[2], z10, Y); Y = MFMA32(Q1[3], z11, Y);
                N0 = MFMA32(MF[0], z00, N0); N0 = MFMA32(MF[1], z01, N0); N0 = MFMA32(MF[4], z10, N0); N0 = MFMA32(MF[5], z11, N0);
                N0 = MFMA32(MF[0], l00, N0); N0 = MFMA32(MF[1], l01, N0); N0 = MFMA32(MF[4], l10, N0); N0 = MFMA32(MF[5], l11, N0);
                N1 = MFMA32(MF[2], z00, N1); N1 = MFMA32(MF[3], z01, N1); N1 = MFMA32(MF[6], z10, N1); N1 = MFMA32(MF[7], z11, N1);
                N1 = MFMA32(MF[2], l00, N1); N1 = MFMA32(MF[3], l01, N1); N1 = MFMA32(MF[6], l10, N1); N1 = MFMA32(MF[7], l11, N1);
                Z0 = N0; Z1 = N1;
                if (dir) {
#pragma unroll
                    for (int i = 0; i < 16; ++i) *(float*)((char*)Yu + yv[(i >> 2) * 2 + ((i & 3) >> 1)] - 2048 * (i & 1)) = Y[i];
                } else {
#pragma unroll
                    for (int i = 0; i < 16; ++i) *(float*)((char*)Yu + yv[(i >> 2) * 2 + ((i & 3) >> 1)] + 2048 * (i & 1)) = Y[i];
                }
#pragma unroll
                for (int k = 0; k < 8; ++k) yv[k] += ystepb;
            }
        }
    }
#undef CSB_LOADQ
#undef CSB_WRITEQ
    __builtin_amdgcn_s_setprio(0);
    if (consumer && !latent) { float* so = p->out + OUT_S + ((((size_t)b * 2 + dir) * 8 + h) * 64 + 32 * c + r32) * 64;
#pragma unroll
        for (int g4 = 0; g4 < 4; ++g4) { *(f32x4*)(so + 8 * g4 + 4 * hh) = (f32x4){Z0[4 * g4], Z0[4 * g4 + 1], Z0[4 * g4 + 2], Z0[4 * g4 + 3]};
                                          *(f32x4*)(so + 32 + 8 * g4 + 4 * hh) = (f32x4){Z1[4 * g4], Z1[4 * g4 + 1], Z1[4 * g4 + 2], Z1[4 * g4 + 3]}; } }
    __syncthreads();
}

DI void post_row(KP p, int r, int lane) {
    const float* Y = p->out; const bf16_t* R = (const bf16_t*)(p->ws + WS_R); const bf16_t* KR = (const bf16_t*)(p->ws + WS_KR);
    const bf16_t* VV = (const bf16_t*)(p->ws + WS_VV); const bf16_t* AA = (const bf16_t*)(p->ws + WS_AA); const bf16_t* G = (const bf16_t*)(p->ws + WS_G);
    const float* k_a = p->in[19]; const float* r_k = p->in[20]; const float* lng = p->in[21]; const float* lnb = p->in[22];
    bf16_t* MIX = (bf16_t*)(p->ws + WS_MIX);
    const int c = lane * 8; const size_t off = (size_t)r * 512 + c;
    float y[8], rr[8], kr[8], vv[8], a0[8], a1[8], gg[8], ka[8], rk[8], lg[8], lb[8];
#define LD8(dst, ptr) do { const f32x4 _a = *(const f32x4*)(ptr), _b = *(const f32x4*)((ptr) + 4); dst[0] = _a.x; dst[1] = _a.y; dst[2] = _a.z; dst[3] = _a.w; dst[4] = _b.x; dst[5] = _b.y; dst[6] = _b.z; dst[7] = _b.w; } while (0)
#define LD8H(dst, ptr) do { const u32x4 _w = *(const u32x4*)(ptr); const f32x4 _a = unpk4((u32x2){_w.x, _w.y}), _b = unpk4((u32x2){_w.z, _w.w}); dst[0] = _a.x; dst[1] = _a.y; dst[2] = _a.z; dst[3] = _a.w; dst[4] = _b.x; dst[5] = _b.y; dst[6] = _b.z; dst[7] = _b.w; } while (0)
    LD8(y, Y + off); LD8(rr, Y + (size_t)NTOK * 512 + off);
#pragma unroll
    for (int j = 0; j < 8; ++j) y[j] += rr[j];
    LD8H(rr, R + off); LD8H(kr, KR + off); LD8H(vv, VV + off); LD8H(a0, AA + off); LD8H(a1, AA + (size_t)NTOK * 512 + off); LD8H(gg, G + off);
    LD8(ka, k_a + c); LD8(rk, r_k + c); LD8(lg, lng + c); LD8(lb, lnb + c);
#undef LD8
#undef LD8H
    float s = 0.f, d0 = 0.f, d1 = 0.f;
#pragma unroll
    for (int j = 0; j < 8; ++j) { s += y[j]; const float q = rr[j] * kr[j] * rk[j]; d0 += q * (1.f + (a0[j] - 1.f) * ka[j]); d1 += q * (1.f + (a1[j] - 1.f) * ka[j]); }
    float bd = d0 + d1;
    s += __shfl_xor(s, 1); s += __shfl_xor(s, 2); s += __shfl_xor(s, 4);
    bd += __shfl_xor(bd, 1); bd += __shfl_xor(bd, 2); bd += __shfl_xor(bd, 4);
    const float mu = s * (1.f / 64.f);
    float q2 = 0.f;
#pragma unroll
    for (int j = 0; j < 8; ++j) { y[j] -= mu; q2 += y[j] * y[j]; }
    q2 += __shfl_xor(q2, 1); q2 += __shfl_xor(q2, 2); q2 += __shfl_xor(q2, 4);
    const float rs = rsqrtf(q2 * (1.f / 64.f) + GN_EPS);
    float o[8];
#pragma unroll
    for (int j = 0; j < 8; ++j) o[j] = (y[j] * rs * lg[j] + lb[j] + bd * vv[j]) * gg[j];
    *(u32x4*)(MIX + (size_t)r * D + 512 + c) = (u32x4){pk2(o[0], o[1]), pk2(o[2], o[3]), pk2(o[4], o[5]), pk2(o[6], o[7])};
}

DI void act_fix(KP p, int pm, int e, int c) {
    const float* EDGE = (const float*)(p->ws + WS_EDGE); bf16_t* ACT = (bf16_t*)(p->ws + WS_ACT); const float* wc = p->in[27];
    const bool need = e == 0 ? (pm != 16 && pm != 24) : (pm != 23 && pm != 31);
    if (!need) return;
    const int r = pm * 256 + (e ? 255 : 0), nbpm = e ? pm + 1 : pm - 1;
    const float* nb = EDGE + ((size_t)nbpm * 2 + (1 - e)) * DFF + c;
    const float* eu = EDGE + ((size_t)pm * 2 + e) * DFF + 64 * DFF + c; const float* e3 = eu + 64 * DFF;
    const float* w = wc + (e ? 2 * DFF : 0) + c;
    float o[8];
#pragma unroll
    for (int j = 0; j < 8; ++j) o[j] = silu_f(eu[j] + w[j] * nb[j]) * e3[j];
    *(u32x4*)(ACT + (size_t)r * DFF + c) = (u32x4){pk2(o[0], o[1]), pk2(o[2], o[3]), pk2(o[4], o[5]), pk2(o[6], o[7])};
}

template <int NR>
DI void final_rows(KP p, int rbase, int rstride, int lane) {
    const float* MODb = (const float*)(p->ws + WS_MOD);
    const bf16_t* PART = (const bf16_t*)(p->ws + WS_PART); const float* nf = p->in[29];
    f32x4 v[NR][4]; u32x2 p0[NR][4], p1[NR][4];
#pragma unroll
    for (int q = 0; q < NR; ++q) { const int r = rbase + q * rstride; const f32x4* xr = (const f32x4*)(p->out + (size_t)r * D) + lane;
#pragma unroll
        for (int j = 0; j < 4; ++j) { v[q][j] = xr[64 * j]; p0[q][j] = *((const u32x2*)(PART + (size_t)r * D) + lane + 64 * j); p1[q][j] = *((const u32x2*)(PART + (size_t)(NTOK + r) * D) + lane + 64 * j); } }
    float s[NR];
#pragma unroll
    for (int q = 0; q < NR; ++q) { const int r = rbase + q * rstride; const float* MOD = MODb + midx_of(r) * 6144; s[q] = 0.f;
#pragma unroll
        for (int j = 0; j < 4; ++j) { const f32x4 gt = *((const f32x4*)(MOD + 5 * D) + lane + 64 * j); v[q][j] = v[q][j] + gt * (unpk4(p0[q][j]) + unpk4(p1[q][j]));
            s[q] += (v[q][j].x * v[q][j].x + v[q][j].y * v[q][j].y) + (v[q][j].z * v[q][j].z + v[q][j].w * v[q][j].w); } }
#pragma unroll
    for (int o = 1; o < 64; o <<= 1) {
#pragma unroll
        for (int q = 0; q < NR; ++q) s[q] += __shfl_xor(s[q], o); }
#pragma unroll
    for (int q = 0; q < NR; ++q) { const int r = rbase + q * rstride; f32x4* xr = (f32x4*)(p->out + (size_t)r * D) + lane; const float rstd = rsqrtf(s[q] * (1.f / D) + EPS);
#pragma unroll
        for (int j = 0; j < 4; ++j) xr[64 * j] = v[q][j] * rstd * *((const f32x4*)nf + lane + 64 * j); }
}

DI int lane_id() { int l; asm volatile("v_mbcnt_lo_u32_b32 %0, -1, 0\n\tv_mbcnt_hi_u32_b32 %0, -1, %0" : "=v"(l)); return l; }
#define XB_TMO      128
#define XB_XCNT(j)  (256  + 64 * (j))
#define XB_XSUB(j)  (1280 + 64 * (j))
#define XB_XGEN(j)  (2304 + 64 * (j))
#define XB_TOP      3328
#define XB_TOPGEN   3392
#define XB_SUBBAR   3520
#define XB_SPIN_CAP (1u << 18)
DI unsigned xb_ld(unsigned* p)              { return __hip_atomic_load(p, __ATOMIC_RELAXED, __HIP_MEMORY_SCOPE_AGENT); }
DI unsigned xb_add(unsigned* p, unsigned v) { return __hip_atomic_fetch_add(p, v, __ATOMIC_RELAXED, __HIP_MEMORY_SCOPE_AGENT); }
DI unsigned xb_xcc_id() { return (unsigned)__builtin_amdgcn_s_getreg((3 << 11) | 20) & 0xFu; }
#define XB_SPIN(cond, bar) do { unsigned _sp = 0; while (cond) { __builtin_amdgcn_s_sleep(1); \
    if ((++_sp & 255u) == 0u) { if (xb_ld(&(bar)[XB_TMO])) break; if (_sp > XB_SPIN_CAP) { atomicAdd(&(bar)[XB_TMO], 1u); break; } } } } while (0)
DI void xcd_barrier_complete(unsigned* bar, unsigned x, unsigned G, unsigned& nloc, unsigned& nx) {
    unsigned sum, cnt, mine, sp = 0u;
    for (;;) {
        sum = 0u; cnt = 0u; mine = 0u;
#pragma unroll
        for (unsigned j = 0; j < 16; ++j) { const unsigned c = xb_ld(&bar[XB_XCNT(j)]); sum += c; cnt += (c > 0u) ? 1u : 0u; mine = (j == x) ? c : mine; }
        if (sum == G) break;
        __builtin_amdgcn_s_sleep(1);
        if ((++sp & 255u) == 0u) { if (xb_ld(&bar[XB_TMO])) break; if (sp > XB_SPIN_CAP) { atomicAdd(&bar[XB_TMO], 1u); break; } }
    }
    nloc = mine > 0u ? mine : 1u; nx = cnt > 0u ? cnt : 1u;
}
DI void grid_bar(unsigned* bar, volatile LAS unsigned* st, unsigned G, int wave_s) {
    asm volatile("s_waitcnt vmcnt(0)" ::: "memory");
    __syncthreads();
    int t = wave_s * 64 + lane_id(); asm volatile("" : "+v"(t));
    if (t == 0) {
        __builtin_amdgcn_s_waitcnt(0);
        const unsigned x = xb_xcc_id();
        unsigned nloc = st[0], nx = st[1];
        if (nloc == 0u) { xcd_barrier_complete(bar, x, G, nloc, nx); st[0] = nloc; st[1] = nx; }
        const unsigned old = xb_add(&bar[XB_XSUB(x)], 1u);
        const unsigned gen = old / nloc;
        if (old + 1u == (gen + 1u) * nloc) {
            __builtin_amdgcn_fence(__ATOMIC_RELEASE, "agent");
            asm volatile("s_waitcnt vmcnt(0)" ::: "memory");
            const unsigned og = xb_add(&bar[XB_TOP], 1u);
            const unsigned tg = og / nx;
            if (og + 1u == (tg + 1u) * nx) xb_add(&bar[XB_TOPGEN], 1u);
            else XB_SPIN(xb_ld(&bar[XB_TOPGEN]) == tg, bar);
            __builtin_amdgcn_fence(__ATOMIC_ACQUIRE, "agent");
            xb_add(&bar[XB_XGEN(x)], 1u);
            asm volatile("s_waitcnt vmcnt(0)" ::: "memory");
        } else {
            XB_SPIN(xb_ld(&bar[XB_XGEN(x)]) == gen, bar);
            __builtin_amdgcn_fence(__ATOMIC_ACQUIRE, "agent");
            asm volatile("s_waitcnt vmcnt(0)" ::: "memory");
        }
    }
    __syncthreads();
}

__global__ void __launch_bounds__(512, 2) fwd_megakernel(Params kparams) {
    const KP kp0 = (KP)__builtin_amdgcn_kernarg_segment_ptr();
    extern __shared__ __attribute__((aligned(16))) unsigned char lds_raw[];
    LAS unsigned char* lds = (LAS unsigned char*)lds_raw;
    const int wave_s = __builtin_amdgcn_readfirstlane((int)threadIdx.x >> 6);
    volatile LAS unsigned* xbst = (volatile LAS unsigned*)(lds + LDS_XB);
    {
        int t0_ = wave_s * 64 + lane_id();
        if (t0_ == 0) { xbst[0] = 0u; xbst[1] = 0u; (void)xb_add((unsigned*)(kp0->ws + WS_BAR) + XB_XCNT(xb_xcc_id()), 1u); }
        __syncthreads();
    }
#define GRID_SYNC() grid_bar((unsigned*)(kp0->ws + WS_BAR), xbst, (unsigned)G, wave_s)
    const int G = gridDim.x, bx = blockIdx.x, NGW = G * 8, NGT = G * 512;
#define PH_VARS KP p = kp0; asm volatile("" : "+s"(p)); unsigned char* ws = p->ws; (void)ws; \
    int tid = wave_s * 64 + lane_id(); asm volatile("" : "+v"(tid)); const int lane = tid & 63, wave = wave_s, gw = bx * 8 + wave, gtid = bx * 512 + tid; (void)lane; (void)gw; (void)gtid;

    const bool defer_ffn = (G == 256);
    { PH_VARS phase0(p, lds, gw, NGW, gtid, NGT, wave, lane, defer_ffn); }
    GRID_SYNC();
    if (G > (1 << 20)) cg::this_grid().sync();
    { PH_VARS for (int r = gw; r < NTOK; r += 4 * NGW) norm_rows<0, 4>(p, r, NGW, lane, p->in[9], 0, D, 0, (bf16_t*)(ws + WS_H), nullptr); }
    GRID_SYNC();
    {
        PH_VARS
        pg8::Gemm g{(const bf16_t*)(ws + WS_H), (const bf16_t*)(ws + WS_WTIN), D, D, D};
        pg8::SchedPlain S; S.o.init(NTOK / 256, NINP / 256, G, bx);
        pg8::EpiIn E{(bf16_t*)(ws + WS_Q), (bf16_t*)(ws + WS_ZR), p->out + OUT_K, 0.125f * LOG2E};
        pg8::gemm_phase(lds, g, S, E, tid);
        if (defer_ffn && bx >= 192) ffn_transposes(p, lds, 0, (bx - 192) * 8 + wave, 64 * 8, wave, lane);
    }
    GRID_SYNC();
    {
        PH_VARS
        LAS float* rpbL = (LAS float*)lds;
        for (int i = tid; i < 8 * 465; i += 512) rpbL[i] = p->in[23][i] * LOG2E;
        __syncthreads();
        LAS unsigned char* vbuf = lds + 16384 + wave * 4608;
        LAS float* xch = (LAS float*)(lds + 65536) + (wave & 3) * 2176;
        for (int u0 = bx * 4; u0 < 1024; u0 += G * 4) {
            if (wave < 4) { attn_unit<true, 2>(p, vbuf, rpbL, u0 + wave, lane, 0, 20, xch); attn_unit<false, 0>(p, vbuf, rpbL, u0 + wave, lane, 0, 8, xch); }
            else { attn_unit<true, 1>(p, vbuf, rpbL, u0 + wave - 4, lane, 20, 32, xch); prep_rows8(p, (u0 + wave - 4) * 8, lane); }
            __syncthreads();
        }
    }
    GRID_SYNC();
    {
        PH_VARS
        int kl = 128; asm volatile("" : "+s"(kl));
        pg8::Gemm g{(const bf16_t*)(ws + WS_ALORA), (const bf16_t*)(ws + WS_WTLORA), kl, 128, 128};
        pg8::SchedLora S; S.G = G; S.c = bx;
        pg8::EpiLora E{(float*)(ws + WS_DEC), (float*)(ws + WS_AA), (float*)(ws + WS_G), p->in[13], p->in[15]};
        pg8::gemm_phase(lds, g, S, E, tid);
        if (defer_ffn && bx >= 64) ffn_transposes(p, lds, 1, (bx - 64) * 8 + wave, 192 * 8, wave, lane);
    }
    GRID_SYNC();
    {
        int nst = 2; asm volatile("" : "+s"(nst));
        const int nl = G > 64 ? 32 : 0;
        for (int st = 0; st < nst; ++st) {
            PH_VARS
            const bool lead = bx < nl;
            if (st == 0 || !lead) cs_phaseA(p, lds, tid, st ? CS_LAT : 0, CS_LAT / 2, st ? bx - nl : bx, st ? G - nl : G);
            if (st == 0) { GRID_SYNC(); continue; }
            if (!lead) {
                unsigned* sb = (unsigned*)(kp0->ws + WS_BAR) + XB_SUBBAR;
                __syncthreads();
                if (tid == 0) { __atomic_thread_fence(__ATOMIC_RELEASE); __hip_atomic_fetch_add(sb, 1u, __ATOMIC_RELAXED, __HIP_MEMORY_SCOPE_AGENT);
                    while (__hip_atomic_load(sb, __ATOMIC_RELAXED, __HIP_MEMORY_SCOPE_AGENT) < (unsigned)(G - nl)) __builtin_amdgcn_s_sleep(1);
                    __atomic_thread_fence(__ATOMIC_ACQUIRE); }
                __syncthreads();
            }
            const int tfirst = lead ? bx : (nl ? 32 + (bx - nl) : bx), tend = lead ? 32 : 288, tstride = lead ? 32 : (G - nl);
            for (int t = tfirst; t < tend; t += tstride) cs_phaseB(p, lds, t < 32 ? 1 : 0, t < 32 ? t : t - 32, tid);
        }
    }
    GRID_SYNC();
    { PH_VARS for (int r = gw; r < NTOK; r += NGW) post_row(p, r, lane); }
    GRID_SYNC();
    {
        PH_VARS
        pg8::Gemm g{(const bf16_t*)(ws + WS_MIX), (const bf16_t*)(ws + WS_WTOUT), 512, D, D};
        pg8::SchedSplit2 S; S.o.init(NTOK / 256, 8, G, bx); S.nN = 4; S.ksplit = 512;
        pg8::EpiPart E{(bf16_t*)(ws + WS_PART), 512};
        pg8::gemm_phase(lds, g, S, E, tid);
    }
    GRID_SYNC();
    { PH_VARS for (int r = gw; r < NTOK; r += 2 * NGW) norm_rows<1, 2>(p, r, NGW, lane, p->in[10], 3 * D, 4 * D, 2 * D, (bf16_t*)(ws + WS_H), p->out); }
    GRID_SYNC();
    {
        PH_VARS
        pg8::Gemm g{(const bf16_t*)(ws + WS_H), (const bf16_t*)(ws + WS_WT13), D, D, D};
        pg8::SchedPlain S; S.o.init(NTOK / 256, 2 * DFF / 256, G, bx);
        pg8::EpiFfnAct E{(bf16_t*)(ws + WS_ACT), (float*)(ws + WS_EDGE), p->in[27], lds};
        pg8::gemm_phase(lds, g, S, E, tid);
    }
    GRID_SYNC();
    {
        PH_VARS
        pg8::Gemm g{(const bf16_t*)(ws + WS_ACT), (const bf16_t*)(ws + WS_WT2), DFF / 2, DFF, DFF};
        pg8::SchedSplit2 S; S.o.init(NTOK / 256, 8, G, bx); S.nN = 4; S.ksplit = DFF / 2;
        { for (int i = 0; i < 8; ++i) { int pm_, pn2_; if (!S.o.next2(i, pm_, pn2_)) break; const int ks_ = pn2_ / 4;
              if (pm_ >= 16 && tid < 352) act_fix(p, pm_, tid / 176, ks_ * (DFF / 2) + (tid % 176) * 8); }
          asm volatile("s_waitcnt vmcnt(0)" ::: "memory"); __syncthreads(); }
        pg8::EpiPart E{(bf16_t*)(ws + WS_PART), DFF / 2};
        pg8::gemm_phase(lds, g, S, E, tid);
    }
    GRID_SYNC();
    { PH_VARS for (int r = gw; r < NTOK; r += 4 * NGW) final_rows<4>(p, r, NGW, lane); }
}

extern "C" void kernel_launch(void* const* d_in, const int* in_sizes, int n_in, void* d_out, int out_size, void* d_ws, size_t ws_size, hipStream_t stream) {
    static int grid_blocks = 0;
    if (!grid_blocks) {
        int dev = 0, cus = 0, per_cu = 0;
        (void)hipGetDevice(&dev);
        (void)hipDeviceGetAttribute(&cus, hipDeviceAttributeMultiprocessorCount, dev);
        (void)hipFuncSetAttribute((const void*)fwd_megakernel, hipFuncAttributeMaxDynamicSharedMemorySize, LDS_BYTES);
        (void)hipOccupancyMaxActiveBlocksPerMultiprocessor(&per_cu, (const void*)fwd_megakernel, 512, LDS_BYTES);
        if (per_cu < 1) per_cu = 1;
        grid_blocks = cus * per_cu;
    }
    (void)hipMemsetAsync((char*)d_ws + WS_BAR, 0, 16384, stream);
    Params p{};
    for (int i = 0; i < 30; ++i) p.in[i] = (const float*)d_in[i];
    p.out = (float*)d_out; p.ws = (unsigned char*)d_ws;
    void* args[] = {&p};
    hipError_t e = hipLaunchCooperativeKernel((const void*)fwd_megakernel, dim3(grid_blocks), dim3(512), args, LDS_BYTES, stream);
    if (e != hipSuccess) fprintf(stderr, "cooperative launch failed: %s (grid %d)\n", hipGetErrorString(e), grid_blocks);
}
```

```cpp
#include <hip/hip_runtime.h>
#include <hip/hip_cooperative_groups.h>
#include <cstdio>
#include <cstdint>
namespace cg = cooperative_groups;

#define LAS __attribute__((address_space(3)))
typedef unsigned short bf16_t;
typedef short bf16x8 __attribute__((ext_vector_type(8)));
typedef short s16x4 __attribute__((ext_vector_type(4)));
typedef float f32x2 __attribute__((ext_vector_type(2)));
typedef float f32x4 __attribute__((ext_vector_type(4)));
typedef float f32x16 __attribute__((ext_vector_type(16)));
typedef unsigned u32x2 __attribute__((ext_vector_type(2)));
typedef unsigned u32x4 __attribute__((ext_vector_type(4)));
typedef __bf16 bf16x2_t __attribute__((ext_vector_type(2)));
#define DI __device__ __forceinline__

constexpr int D = 1024, NTOK = 8192, NCTX = 4096, SEQ = 256, DSEQ = 2048;
constexpr int NIN = 3456, NINP = 3584, RC = 1920, DFF = 2816;
constexpr float EPS = 1e-6f, GN_EPS = 64e-5f;
constexpr float LOG2E = 1.4426950408889634f;
constexpr size_t MiB = 1u << 20;
constexpr size_t WS_BAR = 128 * 1024, WS_MOD = 0, WS_WTIN = 1 * MiB, WS_WTOUT = 8 * MiB, WS_WT13 = 10 * MiB, WS_WT2 = 21 * MiB, WS_WTLORA = 27 * MiB,
                 WS_H = 28 * MiB, WS_Q = 44 * MiB, WS_K = 52 * MiB, WS_V = 60 * MiB, WS_R = 68 * MiB, WS_VV = 84 * MiB, WS_KK = 100 * MiB,
                 WS_KR = 116 * MiB, WS_ALORA = 132 * MiB, WS_MIX = 138 * MiB, WS_ZR = 154 * MiB, WS_DEC = 154 * MiB, WS_AA = 186 * MiB,
                 WS_G = 218 * MiB, WS_CK = 234 * MiB, WS_CV = 235 * MiB, WS_Y = 28 * MiB, WS_PART = 176 * MiB, WS_A1 = 44 * MiB,
                 WS_A3 = 88 * MiB, WS_ACT = 132 * MiB, WS_EDGE = 250 * MiB;
constexpr size_t OUT_K = (size_t)NTOK * D, OUT_V = OUT_K + (size_t)NCTX * 512, OUT_S = OUT_V + (size_t)NCTX * 512;
constexpr int LDS_BYTES = 135168 + 16;
constexpr int LDS_XB = 135168;

struct Params { const float* in[30]; float* out; unsigned char* ws; };
typedef const __attribute__((address_space(4))) Params* KP;

DI unsigned pk2(float lo, float hi) { f32x2 v = {lo, hi}; bf16x2_t b = __builtin_convertvector(v, bf16x2_t); return __builtin_bit_cast(unsigned, b); }
DI f32x4 unpk4(u32x2 w) { return (f32x4){__builtin_bit_cast(float, w.x << 16), __builtin_bit_cast(float, w.x & 0xffff0000u), __builtin_bit_cast(float, w.y << 16), __builtin_bit_cast(float, w.y & 0xffff0000u)}; }
DI f32x2 ldh2(const bf16_t* p) { const unsigned w = *(const unsigned*)p; return (f32x2){__builtin_bit_cast(float, w << 16), __builtin_bit_cast(float, w & 0xffff0000u)}; }
DI float bf2f(unsigned short u) { return __builtin_bit_cast(float, (unsigned)u << 16); }
DI float wave_sum(float v) {
#pragma unroll
    for (int o = 1; o < 64; o <<= 1) v += __shfl_xor(v, o);
    return v;
}
DI float sigmoid_f(float x) { return __builtin_amdgcn_rcpf(1.f + __builtin_amdgcn_exp2f(-1.4426950408889634f * x)); }
DI float silu_f(float x) { return x * sigmoid_f(x); }
DI float tanh_f(float x) { return 2.f * sigmoid_f(2.f * x) - 1.f; }
DI int midx_of(int r) { return r < NCTX ? 0 : 1 + ((r - NCTX) >> 11); }
DI const float* xrow_of(KP p, int r) { return r < NCTX ? p->in[0] + (size_t)r * D : p->in[1] + (size_t)(r - NCTX) * D; }

namespace pg8 {
constexpr int BM = 256, BK = 64, HALF = 128, HTB = HALF * BK * 2, NXCD = 8, WGM = 8;
__host__ __device__ __forceinline__ int lds_byte(int r, int c) { const int st = (r >> 4) * 2 + (c >> 5), rr = r & 15, cc = c & 31, ob = rr * 64 + cc * 2; return st * 1024 + (ob ^ (((ob >> 9) & 1) << 5)); }
__host__ __device__ __forceinline__ void stage_rc(int b, int& R, int& C) { const int st = b / 1024, sb = b % 1024, swz = sb ^ (((sb >> 9) & 1) << 5); R = (st >> 1) * 16 + swz / 64; C = (st & 1) * 32 + (swz % 64) / 2; }
__host__ __device__ __forceinline__ int perm32(int rho) { const int n = rho >> 4, i = rho & 15; return 8 * (i >> 2) + 4 * n + (i & 3); }
struct Unit { int pm, pn; int aoff, boff; };
struct Gemm { const bf16_t* A; const bf16_t* Bt; int K, lda, ldb; };
struct StaticOrder {
    int nM, nN, nwg, G, c;
    __device__ __forceinline__ void init(int nM_, int nN_, int G_, int c_) { nM = nM_; nN = nN_; nwg = nM * nN; G = G_; c = c_; }
    __device__ __forceinline__ bool next2(int i, int& pm, int& pn) const {
        const long L = (long)i * G + c; if (L >= nwg) return false;
        int wgid = (int)L; { const int q = nwg / NXCD, r = nwg % NXCD, xcd = wgid % NXCD, off = wgid / NXCD; wgid = (xcd < r ? xcd * (q + 1) : r * (q + 1) + (xcd - r) * q) + off; }
        const int nig = WGM * nN, gid = wgid / nig, fm = gid * WGM, gsz = (nM - fm) < WGM ? (nM - fm) : WGM;
        pm = fm + ((wgid % nig) % gsz); pn = (wgid % nig) / gsz; return true;
    }
};
struct SchedPlain { StaticOrder o; __device__ __forceinline__ bool next(int i, Unit& u) const { u.aoff = 0; u.boff = 0; return o.next2(i, u.pm, u.pn); } };
struct SchedSplit2 { StaticOrder o; int nN, ksplit;
    __device__ __forceinline__ bool next(int i, Unit& u) const { int pn2; if (!o.next2(i, u.pm, pn2)) return false; const int ks = pn2 / nN; u.pn = pn2 - ks * nN; u.aoff = ks * ksplit; u.boff = ks * ksplit; return true; } };
struct SchedLora { int G, c;
    __device__ __forceinline__ bool next(int i, Unit& u) const { const int L = i * G + c; if (L >= 320) return false; u.pm = L & 31; u.pn = L >> 5; const int g = u.pn < 4 ? 0 : (u.pn < 8 ? 1 : 2); u.aoff = g * NTOK * 128; u.boff = 0; return true; } };

template <class Epi, class Sched>
__device__ __forceinline__ void gemm_phase(LAS unsigned char* lds, const Gemm g, const Sched& S, const Epi& E, int tid) {
    asm volatile("" : "+v"(tid));
    const int wid = __builtin_amdgcn_readfirstlane(tid >> 6), lane = tid & 63, wr = wid >> 2, wc = wid & 3, fr = lane & 15, fq = lane >> 4;
    const int nt = g.K / BK;
    unsigned voffA[2], voffB[2];
#pragma unroll
    for (int i = 0; i < 2; ++i) { int R, C; stage_rc(tid * 16 + i * 8192, R, C); const int Rb = (R & ~31) + perm32(R & 31);
        voffA[i] = (unsigned)(R * g.lda + C) * 2u; voffB[i] = (unsigned)(Rb * g.ldb + C) * 2u; }
    const size_t kstep = (size_t)(BK * 2);
    const size_t hA = (size_t)HALF * g.lda * 2, hB = (size_t)HALF * g.ldb * 2;
    const unsigned ldsw = (unsigned)wid * 1024u;
    const int aoff = lds_byte(wr * 64 + fr, fq * 8), boff = lds_byte(wc * 32 + fr, fq * 8);
#define PG8_SA(b, h) (((b) * 2 + (h)) * HTB)
#define PG8_SB(b, h) ((4 + (b) * 2 + (h)) * HTB)
#define PG8_STAGE(bufoff, gbase, voff) do { _Pragma("unroll") for (int _i = 0; _i < 2; ++_i) \
        __builtin_amdgcn_global_load_lds((const unsigned*)((const char*)(gbase) + (voff)[_i]), (LAS unsigned*)(lds + (bufoff) + ldsw + _i * 8192), 16, 0, 0); } while (0)
#define PG8_LDA(dst, b, h) do { _Pragma("unroll") for (int m = 0; m < 4; ++m) _Pragma("unroll") for (int k = 0; k < 2; ++k) dst[m][k] = *(const LAS bf16x8*)(lds + PG8_SA(b, h) + aoff + m * 2048 + k * 1024); } while (0)
#define PG8_LDB(dst, b, h) do { _Pragma("unroll") for (int n = 0; n < 2; ++n) _Pragma("unroll") for (int k = 0; k < 2; ++k) dst[n][k] = *(const LAS bf16x8*)(lds + PG8_SB(b, h) + boff + n * 2048 + k * 1024); } while (0)
#define PG8_MMA(ai, bj, At, Bt) do { __builtin_amdgcn_s_setprio(1); _Pragma("unroll") for (int m = 0; m < 4; ++m) _Pragma("unroll") for (int n = 0; n < 2; ++n) _Pragma("unroll") for (int k = 0; k < 2; ++k) \
        acc[ai][bj][m][n] = __builtin_amdgcn_mfma_f32_16x16x32_bf16(Bt[n][k], At[m][k], acc[ai][bj][m][n], 0, 0, 0); __builtin_amdgcn_s_setprio(0); } while (0)
#define PG8_WAIT_V(n) asm volatile("s_waitcnt vmcnt(" #n ")" ::: "memory")
#define PG8_WAIT_L(n) asm volatile("s_waitcnt lgkmcnt(" #n ")" ::: "memory")
#define PG8_BAR __builtin_amdgcn_s_barrier()
#define PG8_SCHED __builtin_amdgcn_sched_barrier(0)
#define PG8_TA(u) ((const char*)g.A + ((size_t)(u).pm * BM * g.lda + (size_t)(u).aoff) * 2)
#define PG8_TB(u) ((const char*)g.Bt + ((size_t)(u).pn * BM * g.ldb + (size_t)(u).boff) * 2)
    Unit cur, nxt; int ui = 0;
    if (!S.next(0, cur)) return;
    f32x4 acc[2][2][4][2];
#pragma unroll
    for (int a = 0; a < 2; ++a)
#pragma unroll
        for (int b = 0; b < 2; ++b)
#pragma unroll
            for (int m = 0; m < 4; ++m)
#pragma unroll
                for (int n = 0; n < 2; ++n) acc[a][b][m][n] = (f32x4){0.f, 0.f, 0.f, 0.f};
    bf16x8 At[4][2], B0[2][2], B1[2][2];
    const char* cA = PG8_TA(cur); const char* cB = PG8_TB(cur);
    PG8_STAGE(PG8_SB(0, 0), cB, voffB); PG8_STAGE(PG8_SB(0, 1), cB + hB, voffB); PG8_STAGE(PG8_SA(0, 0), cA, voffA); PG8_STAGE(PG8_SA(0, 1), cA + hA, voffA);
    if (wr == 1) PG8_BAR;
    PG8_WAIT_V(2); PG8_BAR;
    PG8_STAGE(PG8_SB(1, 0), cB + kstep, voffB); PG8_STAGE(PG8_SA(1, 0), cA + kstep, voffA); PG8_STAGE(PG8_SB(1, 1), cB + hB + kstep, voffB);
    PG8_WAIT_V(6); PG8_BAR;
    for (;;) {
        const bool has_next = S.next(ui + 1, nxt);
        const char* nA = has_next ? PG8_TA(nxt) : cA; const char* nB = has_next ? PG8_TB(nxt) : cB;
        for (int t = 0; t < nt; t += 2) {
            const bool last = (t == nt - 2);
            const char* a1 = cA + (size_t)(t + 1) * kstep;
            const char* a2 = last ? nA : cA + (size_t)(t + 2) * kstep; const char* b2 = last ? nB : cB + (size_t)(t + 2) * kstep;
            const char* a3 = a2 + kstep; const char* b3 = b2 + kstep;
            PG8_LDB(B0, 0, 0); PG8_LDB(B1, 0, 1); PG8_SCHED; PG8_LDA(At, 0, 0); PG8_STAGE(PG8_SA(1, 1), a1 + hA, voffA);
            PG8_WAIT_V(8); PG8_WAIT_L(0); PG8_BAR; PG8_MMA(0, 0, At, B0); PG8_MMA(0, 1, At, B1); PG8_BAR; PG8_SCHED;
            PG8_LDA(At, 0, 1); PG8_STAGE(PG8_SB(0, 0), b2, voffB); PG8_STAGE(PG8_SB(0, 1), b2 + hB, voffB); PG8_STAGE(PG8_SA(0, 0), a2, voffA);
            PG8_WAIT_V(8); PG8_WAIT_L(0); PG8_BAR; PG8_MMA(1, 0, At, B0); PG8_MMA(1, 1, At, B1); PG8_BAR; PG8_SCHED;
            PG8_LDB(B0, 1, 0); PG8_LDB(B1, 1, 1); PG8_SCHED; PG8_LDA(At, 1, 0); PG8_STAGE(PG8_SA(0, 1), a2 + hA, voffA);
            PG8_WAIT_V(8); PG8_WAIT_L(0); PG8_BAR; PG8_MMA(0, 0, At, B0); PG8_MMA(0, 1, At, B1); PG8_BAR; PG8_SCHED;
            PG8_LDA(At, 1, 1); PG8_STAGE(PG8_SB(1, 0), b3, voffB); PG8_STAGE(PG8_SB(1, 1), b3 + hB, voffB); PG8_STAGE(PG8_SA(1, 0), a3, voffA);
            PG8_WAIT_V(8); PG8_WAIT_L(0); PG8_BAR; PG8_MMA(1, 0, At, B0); PG8_MMA(1, 1, At, B1); PG8_BAR; PG8_SCHED;
        }
        E(acc, cur, wr, wc, fr, fq);
        if (!has_next) break;
#pragma unroll
        for (int a = 0; a < 2; ++a)
#pragma unroll
            for (int b = 0; b < 2; ++b)
#pragma unroll
                for (int m = 0; m < 4; ++m)
#pragma unroll
                    for (int n = 0; n < 2; ++n) acc[a][b][m][n] = (f32x4){0.f, 0.f, 0.f, 0.f};
        cur = nxt; cA = nA; cB = nB; ++ui;
    }
    PG8_WAIT_V(0);
    if (wr == 0) PG8_BAR;
    PG8_BAR;
#undef PG8_SA
#undef PG8_SB
#undef PG8_STAGE
#undef PG8_LDA
#undef PG8_LDB
#undef PG8_MMA
#undef PG8_WAIT_V
#undef PG8_WAIT_L
#undef PG8_BAR
#undef PG8_SCHED
#undef PG8_TA
#undef PG8_TB
}

struct EpiIn {
    bf16_t *Q; bf16_t* ZR; float* outK; float qscale;
    __device__ __forceinline__ void operator()(const f32x4 (&acc)[2][2][4][2], const Unit& u, int wr, int wc, int fr, int fq) const {
#pragma unroll
        for (int bj = 0; bj < 2; ++bj) {
            const int c0 = u.pn * BM + bj * HALF + wc * 32 + 8 * fq;
            if (c0 >= NIN) continue;
#pragma unroll
            for (int ai = 0; ai < 2; ++ai)
#pragma unroll
                for (int m = 0; m < 4; ++m) {
                    int r = u.pm * BM + ai * HALF + wr * 64 + m * 16 + fr; asm volatile("" : "+v"(r));
                    f32x4 v0 = acc[ai][bj][m][0], v1 = acc[ai][bj][m][1];
                    if (c0 < 1536) {
                        const int seg = c0 >> 9, cc = c0 & 511;
                        if (seg == 0) { v0 = v0 * qscale; v1 = v1 * qscale; }
                        else if (r < NCTX) { float* o = outK + (size_t)(seg - 1) * ((size_t)NCTX * 512) + (size_t)r * 512 + cc; *(f32x4*)o = v0; *(f32x4*)(o + 4) = v1; }
                        bf16_t* dst = Q + (size_t)seg * ((size_t)NTOK * 512) + (size_t)r * 512 + cc;
                        u32x4 w; w.x = pk2(v0[0], v0[1]); w.y = pk2(v0[2], v0[3]); w.z = pk2(v1[0], v1[1]); w.w = pk2(v1[2], v1[3]);
                        *(u32x4*)dst = w;
                    } else {
                        u32x4 w; w.x = pk2(v0[0], v0[1]); w.y = pk2(v0[2], v0[3]); w.z = pk2(v1[0], v1[1]); w.w = pk2(v1[2], v1[3]);
                        *(u32x4*)(ZR + (size_t)r * RC + (c0 - 1536)) = w;
                    }
                }
        }
    }
};
DI float decay1(float x) { return __expf(-0.60653065971f * sigmoid_f(x)); }
struct EpiLora {
    float *DEC, *AA, *G; const float *w0, *a0;
    __device__ __forceinline__ void operator()(const f32x4 (&acc)[2][2][4][2], const Unit& u, int wr, int wc, int fr, int fq) const {
#pragma unroll
        for (int bj = 0; bj < 2; ++bj) {
            const int c0 = u.pn * BM + bj * HALF + wc * 32 + 8 * fq;
            const int grp = c0 >> 10, cg = c0 & 1023, dir = cg >> 9, cc = cg & 511;
            const float* bp = (grp == 0 ? w0 : a0) + dir * 512 + cc;
            float* ob = DEC + (size_t)dir * NTOK * 512 + cc;
            bf16_t* obh = grp == 2 ? (bf16_t*)G + cc : (bf16_t*)AA + (size_t)dir * NTOK * 512 + cc;
#pragma unroll
            for (int ai = 0; ai < 2; ++ai)
#pragma unroll
                for (int m = 0; m < 4; ++m) {
                    int r = u.pm * BM + ai * HALF + wr * 64 + m * 16 + fr; asm volatile("" : "+v"(r));
                    f32x4 v0 = acc[ai][bj][m][0], v1 = acc[ai][bj][m][1];
                    if (grp < 2) { const float* bq = bp; asm volatile("" : "+v"(bq)); v0 += *(const f32x4*)bq; v1 += *(const f32x4*)(bq + 4); }
                    if (grp == 0) { v0.x = decay1(v0.x); v0.y = decay1(v0.y); v0.z = decay1(v0.z); v0.w = decay1(v0.w); v1.x = decay1(v1.x); v1.y = decay1(v1.y); v1.z = decay1(v1.z); v1.w = decay1(v1.w); }
                    else if (grp == 1) { v0.x = sigmoid_f(v0.x); v0.y = sigmoid_f(v0.y); v0.z = sigmoid_f(v0.z); v0.w = sigmoid_f(v0.w); v1.x = sigmoid_f(v1.x); v1.y = sigmoid_f(v1.y); v1.z = sigmoid_f(v1.z); v1.w = sigmoid_f(v1.w); }
                    if (grp == 0) { float* o = ob + (size_t)r * 512; *(f32x4*)o = v0; *(f32x4*)(o + 4) = v1; }
                    else { u32x4 w; w.x = pk2(v0[0], v0[1]); w.y = pk2(v0[2], v0[3]); w.z = pk2(v1[0], v1[1]); w.w = pk2(v1[2], v1[3]); *(u32x4*)(obh + (size_t)r * 512) = w; }
                }
        }
    }
};
struct EpiPart {
    bf16_t* P; int ksplit;
    __device__ __forceinline__ void operator()(const f32x4 (&acc)[2][2][4][2], const Unit& u, int wr, int wc, int fr, int fq) const {
        bf16_t* base = P + (u.aoff ? (size_t)NTOK * D : 0);
#pragma unroll
        for (int bj = 0; bj < 2; ++bj) {
            const int c0 = u.pn * BM + bj * HALF + wc * 32 + 8 * fq;
#pragma unroll
            for (int ai = 0; ai < 2; ++ai)
#pragma unroll
                for (int m = 0; m < 4; ++m) {
                    int r = u.pm * BM + ai * HALF + wr * 64 + m * 16 + fr; asm volatile("" : "+v"(r));
                    const f32x4 v0 = acc[ai][bj][m][0], v1 = acc[ai][bj][m][1];
                    u32x4 w; w.x = pk2(v0[0], v0[1]); w.y = pk2(v0[2], v0[3]); w.z = pk2(v1[0], v1[1]); w.w = pk2(v1[2], v1[3]);
                    *(u32x4*)(base + (size_t)r * D + c0) = w;
                }
        }
    }
};
template <int CTRL> DI float dppf(float x) { return __builtin_bit_cast(float, __builtin_amdgcn_mov_dpp(__builtin_bit_cast(int, x), CTRL, 0xf, 0xf, true)); }
struct EpiFfnAct {
    bf16_t* ACT; float* EDGE; const float* wcv; LAS unsigned char* ldsb;
    __device__ __forceinline__ void operator()(const f32x4 (&acc)[2][2][4][2], const Unit& u, int wr, int wc, int fr, int fq) const {
        LAS float* HL = (LAS float*)(ldsb + 131072);
        const int colh = wc * 32 + 8 * fq;
#pragma unroll
        for (int ai = 0; ai < 2; ++ai) { const int g = ai * 2 + wr;
            if (fr == 0) { *(LAS f32x4*)(HL + (g * 2 + 0) * 128 + colh) = acc[ai][0][0][0]; *(LAS f32x4*)(HL + (g * 2 + 0) * 128 + colh + 4) = acc[ai][0][0][1]; }
            if (fr == 15) { *(LAS f32x4*)(HL + (g * 2 + 1) * 128 + colh) = acc[ai][0][3][0]; *(LAS f32x4*)(HL + (g * 2 + 1) * 128 + colh + 4) = acc[ai][0][3][1]; } }
        asm volatile("s_waitcnt lgkmcnt(0)" ::: "memory");
        __builtin_amdgcn_s_barrier(); __builtin_amdgcn_s_barrier();
        asm volatile("" ::: "memory");
        const int cf = u.pn * HALF + colh;
        const f32x4 zero = {0.f, 0.f, 0.f, 0.f};
        const bool lat = u.pm >= 16;
#pragma unroll
        for (int ai = 0; ai < 2; ++ai) {
            const int g = ai * 2 + wr;
            f32x4 hp[2], hn[2];
            hp[0] = g > 0 ? *(const LAS f32x4*)(HL + ((g - 1) * 2 + 1) * 128 + colh) : zero; hp[1] = g > 0 ? *(const LAS f32x4*)(HL + ((g - 1) * 2 + 1) * 128 + colh + 4) : zero;
            hn[0] = g < 3 ? *(const LAS f32x4*)(HL + ((g + 1) * 2 + 0) * 128 + colh) : zero; hn[1] = g < 3 ? *(const LAS f32x4*)(HL + ((g + 1) * 2 + 0) * 128 + colh + 4) : zero;
#pragma unroll
            for (int m = 0; m < 4; ++m) {
                int r = u.pm * BM + ai * HALF + wr * 64 + m * 16 + fr; asm volatile("" : "+v"(r));
                const float* wq_ = wcv + cf; asm volatile("" : "+v"(wq_));
                f32x4 uu[2], av[2];
#pragma unroll
                for (int n = 0; n < 2; ++n) {
                    const f32x4 cur = acc[ai][0][m][n];
                    f32x4 pv, nx;
#pragma unroll
                    for (int j = 0; j < 4; ++j) {
                        if (m > 0) pv[j] = dppf<0x121>(fr == 15 ? acc[ai][0][m > 0 ? m - 1 : 0][n][j] : cur[j]);
                        else { const float a = dppf<0x121>(cur[j]); pv[j] = fr == 0 ? hp[n][j] : a; }
                        if (m < 3) nx[j] = dppf<0x12F>(fr == 0 ? acc[ai][0][m < 3 ? m + 1 : 3][n][j] : cur[j]);
                        else { const float c = dppf<0x12F>(cur[j]); nx[j] = fr == 15 ? hn[n][j] : c; }
                    }
                    const f32x4 w0 = *(const f32x4*)(wq_ + 4 * n), w1 = *(const f32x4*)(wq_ + DFF + 4 * n), w2 = *(const f32x4*)(wq_ + 2 * DFF + 4 * n);
                    uu[n] = pv * w0 + cur * w1 + nx * w2;
                    const f32x4 a3 = acc[ai][1][m][n];
                    av[n] = (f32x4){silu_f(uu[n].x) * a3.x, silu_f(uu[n].y) * a3.y, silu_f(uu[n].z) * a3.z, silu_f(uu[n].w) * a3.w};
                }
                u32x4 w; w.x = pk2(av[0][0], av[0][1]); w.y = pk2(av[0][2], av[0][3]); w.z = pk2(av[1][0], av[1][1]); w.w = pk2(av[1][2], av[1][3]);
                *(u32x4*)(ACT + (size_t)r * DFF + cf) = w;
                if (lat && ((ai == 0 && m == 0) || (ai == 1 && m == 3))) {
                    const int e = ai;
                    const bool mine = e == 0 ? (wr == 0 && fr == 0) : (wr == 1 && fr == 15);
                    if (mine) {
                        float* eb = EDGE + ((size_t)u.pm * 2 + e) * DFF + cf;
                        *(f32x4*)(eb) = acc[ai][0][m][0]; *(f32x4*)(eb + 4) = acc[ai][0][m][1];
                        *(f32x4*)(eb + 64 * DFF) = uu[0]; *(f32x4*)(eb + 64 * DFF + 4) = uu[1];
                        *(f32x4*)(eb + 128 * DFF) = acc[ai][1][m][0]; *(f32x4*)(eb + 128 * DFF + 4) = acc[ai][1][m][1];
                    }
                }
            }
        }
    }
};
}

template <int MODE>
DI void transpose_item(const float* W, int K, int N, bf16_t* WT, LAS float* scr, int item, int lane) {
    const int nblk = N / 32, kb = item / nblk, nb = item % nblk, k0 = 64 * kb, n0 = 32 * nb;
#pragma unroll 8
    for (int i = 0; i < 32; ++i) { const int kk = 2 * i + (lane >> 5); scr[kk * 33 + (lane & 31)] = W[(size_t)(k0 + kk) * N + n0 + (lane & 31)]; }
    asm volatile("s_waitcnt lgkmcnt(0)" ::: "memory");
    const int c = lane & 7;
#pragma unroll
    for (int j = 0; j < 4; ++j) { const int n = (lane >> 3) + 8 * j; const LAS float* s = scr + (8 * c) * 33 + n;
        u32x4 o; o.x = pk2(s[0 * 33], s[1 * 33]); o.y = pk2(s[2 * 33], s[3 * 33]); o.z = pk2(s[4 * 33], s[5 * 33]); o.w = pk2(s[6 * 33], s[7 * 33]);
        const int nn = n0 + n; const int drow = MODE == 0 ? nn : ((nn >> 7) * 256 + (nn & 127) + (MODE == 2 ? 128 : 0));
        *(u32x4*)(WT + (size_t)drow * K + k0 + 8 * c) = o; }
    asm volatile("s_waitcnt lgkmcnt(0)" ::: "memory");
}

DI void phase0(KP p, LAS unsigned char* lds, int gw, int NGW, int gtid, int NGT, int wave, int lane, bool defer_ffn) {
    unsigned char* ws = p->ws;
    {
        float* MOD = (float*)(ws + WS_MOD);
        const float* w_ada = p->in[7]; const float* b_ada = p->in[8]; const float* c_lat = p->in[5]; const float* c_ctx = p->in[6];
        LAS float* red = (LAS float*)(lds + 8 * 8448);
        const int tid = wave * 64 + lane, cgp = lane & 15, kr = lane >> 4;
        for (int nb = blockIdx.x; nb < 96; nb += gridDim.x) {
            f32x4 a0 = {0, 0, 0, 0}, a1 = a0, a2 = a0;
#pragma unroll 8
            for (int i = 0; i < 32; ++i) {
                const int k = wave * 128 + 4 * i + kr;
                const f32x4 w = *(const f32x4*)(w_ada + (size_t)k * 6144 + nb * 64 + 4 * cgp);
                a0 += w * silu_f(c_ctx[k]); a1 += w * silu_f(c_lat[k]); a2 += w * silu_f(c_lat[D + k]);
            }
#pragma unroll
            for (int j = 0; j < 4; ++j) {
                a0[j] += __shfl_xor(a0[j], 16); a0[j] += __shfl_xor(a0[j], 32);
                a1[j] += __shfl_xor(a1[j], 16); a1[j] += __shfl_xor(a1[j], 32);
                a2[j] += __shfl_xor(a2[j], 16); a2[j] += __shfl_xor(a2[j], 32);
            }
            if (kr == 0) { *(LAS f32x4*)(red + (wave * 3 + 0) * 64 + 4 * cgp) = a0; *(LAS f32x4*)(red + (wave * 3 + 1) * 64 + 4 * cgp) = a1; *(LAS f32x4*)(red + (wave * 3 + 2) * 64 + 4 * cgp) = a2; }
            __syncthreads();
            if (tid < 192) {
                const int i = tid >> 6, c = tid & 63; float s = b_ada[nb * 64 + c];
#pragma unroll
                for (int w = 0; w < 8; ++w) s += red[(w * 3 + i) * 64 + c];
                MOD[i * 6144 + nb * 64 + c] = s;
            }
            __syncthreads();
        }
    }
    {
        LAS float* scr = (LAS float*)(lds + wave * 8448);
        constexpr int I_IN = 16 * 108, I_OUT = 16 * 32, I_F = 16 * 88, I_2 = 44 * 32, NIT = I_IN + I_OUT + 2 * I_F + I_2;
        const int nit = defer_ffn ? I_IN + I_OUT : NIT;
        for (int it = gw; it < nit; it += NGW) {
            int r = it;
            if (r < I_IN) { transpose_item<0>(p->in[11], D, NIN, (bf16_t*)(ws + WS_WTIN), scr, r, lane); continue; } r -= I_IN;
            if (r < I_OUT) { transpose_item<0>(p->in[24], D, D, (bf16_t*)(ws + WS_WTOUT), scr, r, lane); continue; } r -= I_OUT;
            if (r < I_F) { transpose_item<1>(p->in[25], D, DFF, (bf16_t*)(ws + WS_WT13), scr, r, lane); continue; } r -= I_F;
            if (r < I_F) { transpose_item<2>(p->in[26], D, DFF, (bf16_t*)(ws + WS_WT13), scr, r, lane); continue; } r -= I_F;
            transpose_item<0>(p->in[28], DFF, D, (bf16_t*)(ws + WS_WT2), scr, r, lane);
        }
    }
    { u32x4* z = (u32x4*)((bf16_t*)(ws + WS_WTIN) + (size_t)NIN * D); for (int i = gtid; i < 128 * D / 8; i += NGT) z[i] = (u32x4){0, 0, 0, 0}; }
    {
        bf16_t* WL = (bf16_t*)(ws + WS_WTLORA); const float* w2 = p->in[14]; const float* a2 = p->in[16]; const float* g2 = p->in[17];
        for (int i = gtid; i < 2560 * 128; i += NGT) {
            const int n = i >> 7, k = i & 127; float v = 0.f;
            if (n < 2048) { const int grp = n >> 10, dir = (n >> 9) & 1, c = n & 511; const float* src = grp == 0 ? w2 : a2;
                if ((k >> 6) == dir) v = src[((size_t)dir * 64 + (k & 63)) * 512 + c]; }
            else v = g2[(size_t)k * 512 + (n - 2048)];
            WL[i] = (bf16_t)(pk2(v, 0.f) & 0xffffu);
        }
    }
    {
        const f32x4* ck = (const f32x4*)p->in[2]; const f32x4* cv = (const f32x4*)p->in[3]; u32x2* CK = (u32x2*)(ws + WS_CK); u32x2* CV = (u32x2*)(ws + WS_CV);
        for (int i = gtid; i < 1024 * 512 / 4; i += NGT) { const f32x4 a = ck[i], b = cv[i]; CK[i] = (u32x2){pk2(a[0], a[1]), pk2(a[2], a[3])}; CV[i] = (u32x2){pk2(b[0], b[1]), pk2(b[2], b[3])}; }
    }
}

DI void ffn_transposes(KP p, LAS unsigned char* lds, int which, int widx, int nw, int wave, int lane) {
    LAS float* scr = (LAS float*)(lds + wave * 8448);
    constexpr int I_F = 16 * 88, I_2 = 44 * 32;
    if (which == 0) { for (int it = widx; it < I_2; it += nw) transpose_item<0>(p->in[28], DFF, D, (bf16_t*)(p->ws + WS_WT2), scr, it, lane); }
    else { for (int it = widx; it < 2 * I_F; it += nw) { if (it < I_F) transpose_item<1>(p->in[25], D, DFF, (bf16_t*)(p->ws + WS_WT13), scr, it, lane);
                                                           else transpose_item<2>(p->in[26], D, DFF, (bf16_t*)(p->ws + WS_WT13), scr, it - I_F, lane); } }
}

template <int SRC, int NR>
DI void norm_rows(KP p, int rbase, int rstride, int lane, const float* normw, int sh_off, int sc_off, int gate_off, bf16_t* Hout, float* xout) {
    const float* MODb = (const float*)(p->ws + WS_MOD);
    const bf16_t* PART = (const bf16_t*)(p->ws + WS_PART);
    f32x4 v[NR][4];
#pragma unroll
    for (int q = 0; q < NR; ++q) { const f32x4* xr = (const f32x4*)xrow_of(p, rbase + q * rstride) + lane;
#pragma unroll
        for (int j = 0; j < 4; ++j) v[q][j] = xr[64 * j]; }
    if (SRC == 1) {
        u32x2 p0[NR][4], p1[NR][4];
#pragma unroll
        for (int q = 0; q < NR; ++q) { const int r = rbase + q * rstride;
#pragma unroll
            for (int j = 0; j < 4; ++j) { p0[q][j] = *((const u32x2*)(PART + (size_t)r * D) + lane + 64 * j); p1[q][j] = *((const u32x2*)(PART + (size_t)(NTOK + r) * D) + lane + 64 * j); } }
#pragma unroll
        for (int q = 0; q < NR; ++q) { const int r = rbase + q * rstride; const float* MOD = MODb + midx_of(r) * 6144;
#pragma unroll
            for (int j = 0; j < 4; ++j) { const f32x4 gt = *((const f32x4*)(MOD + gate_off) + lane + 64 * j); v[q][j] = v[q][j] + gt * (unpk4(p0[q][j]) + unpk4(p1[q][j])); } }
    }
    float s[NR];
#pragma unroll
    for (int q = 0; q < NR; ++q) { s[q] = 0.f;
#pragma unroll
        for (int j = 0; j < 4; ++j) s[q] += (v[q][j].x * v[q][j].x + v[q][j].y * v[q][j].y) + (v[q][j].z * v[q][j].z + v[q][j].w * v[q][j].w); }
#pragma unroll
    for (int o = 1; o < 64; o <<= 1) {
#pragma unroll
        for (int q = 0; q < NR; ++q) s[q] += __shfl_xor(s[q], o); }
#pragma unroll
    for (int q = 0; q < NR; ++q) {
        const int r = rbase + q * rstride; const float* MOD = MODb + midx_of(r) * 6144;
        const float rstd = rsqrtf(s[q] * (1.f / D) + EPS);
        u32x2* o = (u32x2*)(Hout + (size_t)r * D) + lane;
#pragma unroll
        for (int j = 0; j < 4; ++j) {
            if (SRC == 1) *((f32x4*)(xout + (size_t)r * D) + lane + 64 * j) = v[q][j];
            const f32x4 g = *((const f32x4*)normw + lane + 64 * j), sc = *((const f32x4*)(MOD + sc_off) + lane + 64 * j), sh = *((const f32x4*)(MOD + sh_off) + lane + 64 * j);
            const f32x4 h = v[q][j] * rstd * g * (sc + 1.f) + sh;
            o[64 * j] = (u32x2){pk2(h.x, h.y), pk2(h.z, h.w)};
        }
    }
}

#define MFMA32(a, b, c) __builtin_amdgcn_mfma_f32_32x32x16_bf16((a), (b), (c), 0, 0, 0)
DI int crow(int reg, int h) { return (reg & 3) + 8 * (reg >> 2) + 4 * h; }
typedef short v4i16_t __attribute__((ext_vector_type(4)));
DI s16x4 vtr(const LAS unsigned char* p) { return __builtin_bit_cast(s16x4, __builtin_amdgcn_ds_read_tr16_b64_v4i16((LAS v4i16_t*)p)); }

template <bool LATENT, int MODE>
DI void attn_unit(KP p, LAS unsigned char* vbuf, const LAS float* rpbL, int unit, int lane, int t0, int t1, LAS float* xch) {
    const bf16_t* Q = (const bf16_t*)(p->ws + WS_Q); const bf16_t* Kb = (const bf16_t*)(p->ws + WS_K); const bf16_t* Vb = (const bf16_t*)(p->ws + WS_V);
    const bf16_t* CK = (const bf16_t*)(p->ws + WS_CK); const bf16_t* CV = (const bf16_t*)(p->ws + WS_CV);
    bf16_t* MIX = (bf16_t*)(p->ws + WS_MIX);
    const int r = lane & 31, hh = lane >> 5;
    int head, qrow0, b, gi = 0, w0 = 0, si = 0, ntile;
    if (LATENT) { head = unit & 7; const int t = unit >> 3; w0 = (t & 1) * 32; gi = (t >> 1) & 31; b = t >> 6; qrow0 = NCTX + b * DSEQ + gi * 64 + w0; si = min(max(gi - 4, 0), 24); ntile = 32; }
    else { head = unit & 7; const int t = unit >> 3; const int qb = t & 7; b = t >> 3; qrow0 = b * SEQ + qb * 32; ntile = 8; }
    bf16x8 qf[4];
#pragma unroll
    for (int s = 0; s < 4; ++s) qf[s] = *(const bf16x8*)(Q + (size_t)(qrow0 + r) * 512 + head * 64 + 16 * s + 8 * hh);
    auto tile_ptrs = [&](int t, const bf16_t*& kp, const bf16_t*& vp) {
        if (LATENT) {
            if (t < 16) { const size_t row = (size_t)b * 512 + t * 32; kp = CK + row * 512; vp = CV + row * 512; }
            else { const int lt = t - 16; const size_t row = (size_t)NCTX + b * DSEQ + (si + (lt >> 1)) * 64 + (((lt & 1) * 32) ^ w0); kp = Kb + row * 512; vp = Vb + row * 512; }
        } else { const size_t row = (size_t)b * SEQ + t * 32; kp = Kb + row * 512; vp = Vb + row * 512; }
    };
    bf16x8 kf[4], kn[4]; u32x4 vn[4];
    {
        const bf16_t *kp, *vp; tile_ptrs(t0, kp, vp);
#pragma unroll
        for (int s = 0; s < 4; ++s) kf[s] = *(const bf16x8*)(kp + (size_t)r * 512 + head * 64 + 16 * s + 8 * hh);
#pragma unroll
        for (int i = 0; i < 4; ++i) { const int c = lane + 64 * i; vn[i] = *(const u32x4*)(vp + (size_t)(c >> 3) * 512 + head * 64 + (c & 7) * 8); }
#pragma unroll
        for (int i = 0; i < 4; ++i) { const int c = lane + 64 * i; *(LAS u32x4*)(vbuf + (c >> 3) * 144 + (c & 7) * 16) = vn[i]; }
    }
    f32x16 o0, o1;
#pragma unroll
    for (int i = 0; i < 16; ++i) { o0[i] = 0.f; o1[i] = 0.f; }
    float mrun = -1e30f, lrun = 0.f;
    const int i16 = lane & 15, tq = i16 >> 2, tp = i16 & 3, blk = (lane >> 4) & 1;
    const LAS unsigned char* vtbase = vbuf + (4 * hh + tq) * 144 + (16 * blk) * 2 + 8 * tp;
    const int wq = w0 + r;
    const int cs = min(max(wq - 8, 0), 48);
    for (int t = t0; t < t1; ++t) {
        const bool more = (t + 1 < t1);
        if (more) {
            const bf16_t *kp, *vp; tile_ptrs(t + 1, kp, vp);
#pragma unroll
            for (int s = 0; s < 4; ++s) kn[s] = *(const bf16x8*)(kp + (size_t)r * 512 + head * 64 + 16 * s + 8 * hh);
#pragma unroll
            for (int i = 0; i < 4; ++i) { const int c = lane + 64 * i; vn[i] = *(const u32x4*)(vp + (size_t)(c >> 3) * 512 + head * 64 + (c & 7) * 8); }
        }
        f32x16 st;
#pragma unroll
        for (int i = 0; i < 16; ++i) st[i] = 0.f;
#pragma unroll
        for (int s = 0; s < 4; ++s) st = MFMA32(kf[s], qf[s], st);
        if (LATENT && t >= 16) {
            const int lt = t - 16, a = lt >> 1, c0 = ((lt & 1) * 32) ^ w0;
            const int row_off = si + a - gi + 7;
            const int d0 = c0 + 4 * hh - cs;
            const LAS float* bp = rpbL + head * 465 + row_off * 31 + (c0 + 4 * hh - wq + 15);
#pragma unroll
            for (int i = 0; i < 16; ++i) {
                const int ci = (i & 3) + 8 * (i >> 2);
                const bool valid = (unsigned)(d0 + ci) < 16u;
                const float bias = valid ? bp[ci] : 0.f;
                st[i] = valid ? st[i] + bias : -INFINITY;
            }
        }
        float tmax = st[0];
#pragma unroll
        for (int i = 1; i < 16; ++i) tmax = fmaxf(tmax, st[i]);
        { const unsigned tb = __builtin_bit_cast(unsigned, tmax);
          const auto sw = __builtin_amdgcn_permlane32_swap(tb, tb, false, false);
          tmax = fmaxf(fmaxf(tmax, __builtin_bit_cast(float, (unsigned)sw[0])), __builtin_bit_cast(float, (unsigned)sw[1])); }
        if (__builtin_amdgcn_ballot_w64(tmax - mrun > 8.f) != 0ull) {
            const float mnew = fmaxf(mrun, tmax);
            const float alpha = __builtin_amdgcn_exp2f(mrun - mnew);
            lrun *= alpha; mrun = mnew;
#pragma unroll
            for (int i = 0; i < 16; ++i) { o0[i] *= alpha; o1[i] *= alpha; }
        }
        float ps = 0.f;
#pragma unroll
        for (int i = 0; i < 16; ++i) { st[i] = __builtin_amdgcn_exp2f(st[i] - mrun); ps += st[i]; }
        lrun += ps;
        bf16x8 pb[2];
#pragma unroll
        for (int s = 0; s < 2; ++s) { u32x4 w; w.x = pk2(st[8 * s], st[8 * s + 1]); w.y = pk2(st[8 * s + 2], st[8 * s + 3]); w.z = pk2(st[8 * s + 4], st[8 * s + 5]); w.w = pk2(st[8 * s + 6], st[8 * s + 7]); pb[s] = __builtin_bit_cast(bf16x8, w); }
        asm volatile("s_waitcnt lgkmcnt(0)" ::: "memory");
#pragma unroll
        for (int s = 0; s < 2; ++s) {
            const LAS unsigned char* bs = vtbase + (16 * s) * 144;
            const s16x4 lo0 = vtr(bs), hi0 = vtr(bs + 8 * 144), lo1 = vtr(bs + 64), hi1 = vtr(bs + 8 * 144 + 64);
            const bf16x8 va0 = __builtin_shufflevector(lo0, hi0, 0, 1, 2, 3, 4, 5, 6, 7), va1 = __builtin_shufflevector(lo1, hi1, 0, 1, 2, 3, 4, 5, 6, 7);
            o0 = MFMA32(va0, pb[s], o0); o1 = MFMA32(va1, pb[s], o1);
        }
        asm volatile("s_waitcnt lgkmcnt(0)" ::: "memory");
        if (more) {
#pragma unroll
            for (int i = 0; i < 4; ++i) { const int c = lane + 64 * i; *(LAS u32x4*)(vbuf + (c >> 3) * 144 + (c & 7) * 16) = vn[i]; }
#pragma unroll
            for (int s = 0; s < 4; ++s) kf[s] = kn[s];
        }
    }
    if (MODE == 1) {
#pragma unroll
        for (int i = 0; i < 16; ++i) { xch[i * 64 + lane] = o0[i]; xch[(16 + i) * 64 + lane] = o1[i]; }
        xch[32 * 64 + lane] = mrun; xch[33 * 64 + lane] = lrun;
        __syncthreads();
        return;
    }
    if (MODE == 2) {
        __syncthreads();
        const float mb = xch[32 * 64 + lane], lb = xch[33 * 64 + lane];
        const float mm = fmaxf(mrun, mb), fa = exp2f(mrun - mm), fb = exp2f(mb - mm);
#pragma unroll
        for (int i = 0; i < 16; ++i) { o0[i] = o0[i] * fa + xch[i * 64 + lane] * fb; o1[i] = o1[i] * fa + xch[(16 + i) * 64 + lane] * fb; }
        lrun = lrun * fa + lb * fb;
    }
    float ltot; { const unsigned lb_ = __builtin_bit_cast(unsigned, lrun); const auto sw = __builtin_amdgcn_permlane32_swap(lb_, lb_, false, false); ltot = __builtin_bit_cast(float, (unsigned)sw[0]) + __builtin_bit_cast(float, (unsigned)sw[1]); }
    const float inv = 1.f / ltot;
    bf16_t* orow = MIX + (size_t)(qrow0 + r) * D + head * 64;
#pragma unroll
    for (int g4 = 0; g4 < 4; ++g4) {
        const int d = 8 * g4 + 4 * hh;
        *(u32x2*)(orow + d) = (u32x2){pk2(o0[4 * g4] * inv, o0[4 * g4 + 1] * inv), pk2(o0[4 * g4 + 2] * inv, o0[4 * g4 + 3] * inv)};
        *(u32x2*)(orow + 32 + d) = (u32x2){pk2(o1[4 * g4] * inv, o1[4 * g4 + 1] * inv), pk2(o1[4 * g4 + 2] * inv, o1[4 * g4 + 3] * inv)};
    }
}

DI void prep_rows8(KP p, int r0, int lane) {
    const bf16_t* ZR = (const bf16_t*)(p->ws + WS_ZR); const float* wts = p->in[12]; const float* k_k = p->in[18];
    bf16_t* R = (bf16_t*)(p->ws + WS_R); bf16_t* KR = (bf16_t*)(p->ws + WS_KR); bf16_t* VV = (bf16_t*)(p->ws + WS_VV); bf16_t* KK = (bf16_t*)(p->ws + WS_KK);
    bf16_t* AL = (bf16_t*)(p->ws + WS_ALORA);
    const int t0 = r0 < NCTX ? (r0 & 255) : ((r0 - NCTX) & 2047); const int T = r0 < NCTX ? SEQ : DSEQ;
    const bool hp = t0 > 0, hn = t0 + 8 < T;
    const bf16_t* zb = ZR + (size_t)(r0 - 1) * RC;
    const f32x4 zero = {0, 0, 0, 0};
#pragma unroll 1
    for (int seg = 0; seg < 3; ++seg) {
        const int c = seg * 512 + lane * 8;
        f32x4 z[10][2];
#pragma unroll
        for (int i = 0; i < 10; ++i) { const bool ok = (i > 0 || hp) && (i < 9 || hn);
            if (ok) { const u32x4 w = *(const u32x4*)(zb + (size_t)i * RC + c); z[i][0] = unpk4((u32x2){w.x, w.y}); z[i][1] = unpk4((u32x2){w.z, w.w}); } else { z[i][0] = zero; z[i][1] = zero; } }
        const f32x4 wa0 = *(const f32x4*)(wts + c), wa1 = *(const f32x4*)(wts + c + 4), wb0 = *(const f32x4*)(wts + RC + c), wb1 = *(const f32x4*)(wts + RC + c + 4),
                    wc0 = *(const f32x4*)(wts + 2 * RC + c), wc1 = *(const f32x4*)(wts + 2 * RC + c + 4);
        const f32x4 k0 = *(const f32x4*)(k_k + lane * 8), k1 = *(const f32x4*)(k_k + lane * 8 + 4);
        bf16_t* dstb = (seg == 0 ? R : (seg == 1 ? KR : VV)) + (size_t)r0 * 512 + lane * 8;
#pragma unroll
        for (int i = 0; i < 8; ++i) {
            const f32x4 u0 = z[i][0] * wa0 + z[i + 1][0] * wb0 + z[i + 2][0] * wc0, u1 = z[i][1] * wa1 + z[i + 1][1] * wb1 + z[i + 2][1] * wc1;
            *(u32x4*)(dstb + (size_t)i * 512) = (u32x4){pk2(u0.x, u0.y), pk2(u0.z, u0.w), pk2(u1.x, u1.y), pk2(u1.z, u1.w)};
            if (seg == 1) {
                const f32x4 a = u0 * k0, bq = u1 * k1;
                float sq = (a.x * a.x + a.y * a.y) + (a.z * a.z + a.w * a.w) + (bq.x * bq.x + bq.y * bq.y) + (bq.z * bq.z + bq.w * bq.w);
                sq += __shfl_xor(sq, 1); sq += __shfl_xor(sq, 2); sq += __shfl_xor(sq, 4);
                const float rn = rsqrtf(sq + 1e-12f);
                const f32x4 ka_ = a * rn, kb_ = bq * rn; *(u32x4*)(KK + (size_t)(r0 + i) * 512 + lane * 8) = (u32x4){pk2(ka_.x, ka_.y), pk2(ka_.z, ka_.w), pk2(kb_.x, kb_.y), pk2(kb_.z, kb_.w)};
            }
        }
    }
    {
        const int cl = lane * 6, cc = 1536 + cl;
        const f32x2 zero2 = {0, 0};
        f32x2 z[10][3];
#pragma unroll
        for (int i = 0; i < 10; ++i) { const bool ok = (i > 0 || hp) && (i < 9 || hn);
#pragma unroll
            for (int q = 0; q < 3; ++q) { if (ok) { const unsigned w = *(const unsigned*)(zb + (size_t)i * RC + cc + 2 * q); z[i][q] = (f32x2){__builtin_bit_cast(float, w << 16), __builtin_bit_cast(float, w & 0xffff0000u)}; } else z[i][q] = zero2; } }
#pragma unroll
        for (int q = 0; q < 3; ++q) {
            const f32x2 wa = *(const f32x2*)(wts + cc + 2 * q), wb = *(const f32x2*)(wts + RC + cc + 2 * q), wcq = *(const f32x2*)(wts + 2 * RC + cc + 2 * q);
            const int cq = cl + 2 * q, grp = cq >> 7, k = cq & 127;
#pragma unroll
            for (int i = 0; i < 8; ++i) {
                f32x2 u = z[i][q] * wa + z[i + 1][q] * wb + z[i + 2][q] * wcq;
                if (grp == 0) { u.x = tanh_f(u.x); u.y = tanh_f(u.y); }
                else if (grp == 2) { u.x = sigmoid_f(u.x); u.y = sigmoid_f(u.y); }
                *(unsigned*)(AL + ((size_t)grp * NTOK + r0 + i) * 128 + k) = pk2(u.x, u.y);
            }
        }
    }
}

template <int CTRL> DI float dppf_(float x) { return __builtin_bit_cast(float, __builtin_amdgcn_mov_dpp(__builtin_bit_cast(int, x), CTRL, 0xf, 0xf, true)); }
template <int CTRL> DI float dpp_add(float x) { const int y = __builtin_amdgcn_mov_dpp(__builtin_bit_cast(int, x), CTRL, 0xf, 0xf, true); return x + __builtin_bit_cast(float, y); }
DI float red16(float x) { x = dpp_add<0xB1>(x); x = dpp_add<0x4E>(x); x = dpp_add<0x141>(x); x = dpp_add<0x140>(x); return x; }

constexpr int TC = 16;
DI float tred4(float q0, float q1, float q2, float q3, bool b0, bool b1) {
    const float ka = b0 ? q2 : q0, kb = b0 ? q3 : q1, sa = b0 ? q0 : q2, sb = b0 ? q1 : q3;
    const float a = ka + dppf_<0xB1>(sa), b = kb + dppf_<0xB1>(sb);
    float c = (b1 ? b : a) + dppf_<0x4E>(b1 ? a : b);
    c += dppf_<0x124>(c);
    c += dppf_<0x128>(c);
    return c;
}
DI f32x2 lo2(f32x4 v) { return __builtin_shufflevector(v, v, 0, 1); }
DI f32x2 hi2(f32x4 v) { return __builtin_shufflevector(v, v, 2, 3); }
struct ScanOps { f32x4 kk, rr, ww, bb, kd; float vv; };
struct ScanLd { f32x4 kk, r, dec, aa, kr, v; };
DI void scan_item(KP p, LAS unsigned char* lds, int latent, int sc, int qr, int tid) {
    const bf16_t* KK = (const bf16_t*)(p->ws + WS_KK); const bf16_t* R = (const bf16_t*)(p->ws + WS_R); const bf16_t* KR = (const bf16_t*)(p->ws + WS_KR);
    const bf16_t* VV = (const bf16_t*)(p->ws + WS_VV); const float* k_a = p->in[19];
    float* Y = (float*)(p->ws + WS_Y);
    const int b = sc >> 4, dir = (sc >> 3) & 1, h = sc & 7;
    const int T = latent ? DSEQ : SEQ; const size_t rowbase = latent ? (size_t)NCTX + (size_t)b * DSEQ : (size_t)b * SEQ;
    const float* DEC = (const float*)(p->ws + WS_DEC) + (size_t)dir * NTOK * 512; const bf16_t* AA = (const bf16_t*)(p->ws + WS_AA) + (size_t)dir * NTOK * 512;
    float* Yd = Y + (size_t)dir * NTOK * 512;
    LAS float* buf = (LAS float*)lds;
    LAS float* vb = (LAS float*)(lds + 2 * TC * 320 * 4);
    const int wave = tid >> 6, lane = tid & 63;
    const bool consumer = wave < 4;
    const int nchunk = T / TC;
    const int rl = lane >> 4, ks = lane & 15, row = 16 * qr + 4 * wave + rl;
    f32x2 S01 = {0, 0}, S23 = {0, 0};
    if (consumer && latent) { const f32x4 s4 = *(const f32x4*)(p->in[4] + ((((size_t)b * 2 + dir) * 8 + h) * 64 + row) * 64 + 4 * ks); S01 = lo2(s4); S23 = hi2(s4); }
    const int lt = tid - 256, lj = lt >> 4, li = lt & 15;
    ScanLd L0, L1; f32x4 ka4 = {0, 0, 0, 0};
    if (!consumer) ka4 = *(const f32x4*)(k_a + h * 64 + 4 * li);
    float* ybase = Yd + (rowbase)*512 + h * 64 + row;
    const bool kb0 = (ks & 1) != 0, kb1 = (ks & 2) != 0; const int ystep = 4 * (ks >> 2) + 2 * (ks & 1) + ((ks >> 1) & 1);
#define SCAN_LOAD(L, c) do { const int idx = (c) * TC + lj; const int tt = dir ? T - 1 - idx : idx; const size_t off = (rowbase + tt) * 512 + h * 64 + 4 * li; \
        L.kk = unpk4(*(const u32x2*)(KK + off)); L.r = unpk4(*(const u32x2*)(R + off)); L.dec = *(const f32x4*)(DEC + off); L.aa = unpk4(*(const u32x2*)(AA + off)); L.kr = unpk4(*(const u32x2*)(KR + off)); \
        if (lt < 64) { const int vj = lt >> 2, vq = lt & 3; const int idv = (c) * TC + vj; const int tv = dir ? T - 1 - idv : idv; L.v = unpk4(*(const u32x2*)(VV + (rowbase + tv) * 512 + h * 64 + 16 * qr + 4 * vq)); } } while (0)
#define SCAN_WRITE(L, bc, vc) do { const f32x4 bb_ = L.kk * L.aa; const f32x4 kd_ = L.kr * ((L.aa - 1.f) * ka4 + 1.f); LAS float* d_ = (bc) + lj * 320 + 4 * li; \
        *(LAS f32x4*)(d_) = L.kk; *(LAS f32x4*)(d_ + 64) = L.r; *(LAS f32x4*)(d_ + 128) = L.dec; *(LAS f32x4*)(d_ + 192) = bb_; *(LAS f32x4*)(d_ + 256) = kd_; \
        if (lt < 64) *(LAS f32x4*)((vc) + (lt >> 2) * 16 + 4 * (lt & 3)) = L.v; } while (0)
#define SCAN_LDOPS(o, bc, vc, j) do { const LAS float* d_ = (bc) + (j) * 320 + 4 * ks; o.kk = *(const LAS f32x4*)(d_); o.rr = *(const LAS f32x4*)(d_ + 64); o.ww = *(const LAS f32x4*)(d_ + 128); \
        o.bb = *(const LAS f32x4*)(d_ + 192); o.kd = *(const LAS f32x4*)(d_ + 256); o.vv = (vc)[(j) * 16 + 4 * wave + rl]; } while (0)
#define SCAN_COMPUTE(bc, vc, c) do { ScanOps oc, on, on2; SCAN_LDOPS(oc, bc, vc, 0); SCAN_LDOPS(on, bc, vc, 1); float ysel = 0.f; float yp0 = 0.f, yp1 = 0.f, yp2 = 0.f; \
        _Pragma("unroll") for (int j = 0; j < TC; ++j) { \
            if (j + 2 < TC) SCAN_LDOPS(on2, bc, vc, j + 2);     \
            f32x2 pq = S01 * lo2(oc.kk); pq = S23 * hi2(oc.kk) + pq; \
            const float sa = red16(pq.x + pq.y); \
            const f32x2 t01 = S01 * lo2(oc.ww) + lo2(oc.kd) * oc.vv, t23 = S23 * hi2(oc.ww) + hi2(oc.kd) * oc.vv; \
            S01 = t01 - lo2(oc.bb) * sa; S23 = t23 - hi2(oc.bb) * sa; \
            f32x2 yq = S01 * lo2(oc.rr); yq = S23 * hi2(oc.rr) + yq; \
            const float yp = yq.x + yq.y; \
            if ((j & 3) == 0) yp0 = yp; else if ((j & 3) == 1) yp1 = yp; else if ((j & 3) == 2) yp2 = yp; \
            else { const float yr = tred4(yp0, yp1, yp2, yp, kb0, kb1); ysel = ((ks >> 2) == (j >> 2)) ? yr : ysel; } \
            oc = on; on = on2; \
            asm volatile("" ::: "memory"); } \
        { const int idx = (c) * TC + ystep; const int tt = dir ? T - 1 - idx : idx; ybase[(size_t)tt * 512] = ysel; } } while (0)
    if (!consumer) { SCAN_LOAD(L0, 0); SCAN_LOAD(L1, 1); }
    for (int c = 0; c < nchunk; c += 2) {
        if (!consumer) SCAN_WRITE(L0, buf, vb);
        __syncthreads();
        if (!consumer) { if (c + 2 < nchunk) SCAN_LOAD(L0, c + 2); }
        else SCAN_COMPUTE(buf, vb, c);
        if (!consumer) SCAN_WRITE(L1, buf + TC * 320, vb + TC * 16);
        __syncthreads();
        if (!consumer) { if (c + 3 < nchunk) SCAN_LOAD(L1, c + 3); }
        else SCAN_COMPUTE(buf + TC * 320, vb + TC * 16, c + 1);
    }
#undef SCAN_LOAD
#undef SCAN_WRITE
#undef SCAN_LDOPS
#undef SCAN_COMPUTE
    if (consumer && !latent) *(f32x4*)(p->out + OUT_S + ((((size_t)b * 2 + dir) * 8 + h) * 64 + row) * 64 + 4 * ks) = (f32x4){S01.x, S01.y, S23.x, S23.y};
    __syncthreads();
}

constexpr int CS_L = 32, CS_LAT = 2048, CS_CHUNKS = 4096;
DI unsigned char* cs_mf(unsigned char* ws, int q) { return ws + 28 * MiB + (size_t)q * 8192; }
DI unsigned char* cs_q1(unsigned char* ws, int q) { return q < CS_LAT ? ws + 60 * MiB + (size_t)q * 4096 : ws + 76 * MiB + (size_t)(q - CS_LAT) * 4096; }
DI unsigned char* cs_q2(unsigned char* ws, int q) { return q < CS_LAT ? ws + 92 * MiB + (size_t)q * 4096 : ws + 108 * MiB + (size_t)(q - CS_LAT) * 4096; }
DI unsigned char* cs_nt(unsigned char* ws, int q) { return q < CS_LAT ? ws + 202 * MiB + (size_t)q * 8192 : ws + 234 * MiB + (size_t)(q - CS_LAT) * 8192; }
constexpr int CS_G = 51456;
DI bf16x8 frag_nat(const LAS unsigned char* img, int pitch, int rc, int s, int hh) { return *(const LAS bf16x8*)(img + rc * pitch + (16 * s + 8 * hh) * 2); }
DI bf16x8 frag_krow(const LAS unsigned char* img, int pitch, int rc, int s, int hh) {
    const s16x4 lo = *(const LAS s16x4*)(img + rc * pitch + (16 * s + 4 * hh) * 2), hi = *(const LAS s16x4*)(img + rc * pitch + (16 * s + 8 + 4 * hh) * 2);
    return __builtin_shufflevector(lo, hi, 0, 1, 2, 3, 4, 5, 6, 7); }
DI bf16x8 frag_tr(const LAS unsigned char* img, int pitch, int col0, int s, int lane) {
    const int i16 = lane & 15, tq = i16 >> 2, tp = i16 & 3, blk = (lane >> 4) & 1, hh = lane >> 5;
    const LAS unsigned char* bs = img + (16 * s + 4 * hh + tq) * pitch + (col0 + 16 * blk) * 2 + 8 * tp;
    const s16x4 lo = vtr(bs), hi = vtr(bs + 8 * pitch);
    return __builtin_shufflevector(lo, hi, 0, 1, 2, 3, 4, 5, 6, 7); }
template <int S> DI bf16x8 pack8(const f32x16& x, float sg) {
    u32x4 w; w.x = pk2(sg * x[8 * S], sg * x[8 * S + 1]); w.y = pk2(sg * x[8 * S + 2], sg * x[8 * S + 3]); w.z = pk2(sg * x[8 * S + 4], sg * x[8 * S + 5]); w.w = pk2(sg * x[8 * S + 6], sg * x[8 * S + 7]);
    return __builtin_bit_cast(bf16x8, w); }
template <int S> DI bf16x8 pack8lo(const f32x16& x, bf16x8 hi) {
    const u32x4 h = __builtin_bit_cast(u32x4, hi); float d[8];
#pragma unroll
    for (int j = 0; j < 4; ++j) { d[2 * j] = x[8 * S + 2 * j] - __builtin_bit_cast(float, h[j] << 16); d[2 * j + 1] = x[8 * S + 2 * j + 1] - __builtin_bit_cast(float, h[j] & 0xffff0000u); }
    u32x4 w; w.x = pk2(d[0], d[1]); w.y = pk2(d[2], d[3]); w.z = pk2(d[4], d[5]); w.w = pk2(d[6], d[7]);
    return __builtin_bit_cast(bf16x8, w); }
DI void lds_barrier() { asm volatile("s_waitcnt lgkmcnt(0)" ::: "memory"); __builtin_amdgcn_s_barrier(); asm volatile("" ::: "memory"); }
DI f32x16 zero16() { f32x16 z;
#pragma unroll
    for (int i = 0; i < 16; ++i) z[i] = 0.f;
    return z; }

DI void cs_phaseA(KP p, LAS unsigned char* lds, int tid, int qbase, int nit, int first, int stride) {
    const bf16_t* KK = (const bf16_t*)(p->ws + WS_KK); const bf16_t* R = (const bf16_t*)(p->ws + WS_R); const bf16_t* KR = (const bf16_t*)(p->ws + WS_KR);
    const bf16_t* VV = (const bf16_t*)(p->ws + WS_VV); const float* k_a = p->in[19];
    const int wave = tid >> 6, lane = tid & 63, g = wave >> 2, wq = wave & 3, tg = wq * 64 + lane, hh = lane >> 5, r32 = lane & 31;
    LAS unsigned char* L = lds + g * CS_G;
    LAS unsigned char* MKK = L, *MBT = L + 4608, *MKT = L + 2 * 4608, *MRT = L + 3 * 4608, *MBH = L + 4 * 4608, *MKH = L + 5 * 4608, *MVM = L + 6 * 4608;
    LAS float* AF = (LAS float*)(L + 32256);
    LAS unsigned char* ST = L + 36352, *SKK = ST + 2560, *SRB = ST + 2 * 2560, *SRK = ST + 3 * 2560;
    LAS float* SEG = (LAS float*)(L + 46592); LAS float* ELv = (LAS float*)(L + 48640);
    LAS unsigned char* SA = L + 48896;
    f32x2 lwN[4], kkN[4], aaN[4], krN[4], rN[4]; u32x4 vmN;
#define CSA_FETCH(it_) do { const int q_ = qbase + (it_) * 2 + g; const bool lat_ = q_ < CS_LAT; const int sc_ = lat_ ? (q_ >> 6) : ((q_ - CS_LAT) >> 3), ci_ = lat_ ? (q_ & 63) : (q_ & 7), TT_ = lat_ ? DSEQ : SEQ; \
        const int b_ = sc_ >> 4, dir_ = (sc_ >> 3) & 1, h_ = sc_ & 7; const int rb_ = lat_ ? NCTX + b_ * DSEQ : b_ * SEQ; \
          \
        const int t0_ = dir_ ? TT_ - 1 - ci_ * CS_L : ci_ * CS_L, sg_ = dir_ ? -512 : 512; \
        const unsigned ub_ = (unsigned)((rb_ + t0_) * 512 + h_ * 64); \
        const unsigned o0_ = ub_ + (unsigned)(sg_ * 4 * (tg >> 5) + 2 * (tg & 31)); \
        const float* DEC_ = (const float*)(p->ws + WS_DEC) + (size_t)dir_ * NTOK * 512; const bf16_t* AA_ = (const bf16_t*)(p->ws + WS_AA) + (size_t)dir_ * NTOK * 512; \
        _Pragma("unroll") for (int j = 0; j < 4; ++j) { const unsigned off = o0_ + (unsigned)(sg_ * j); \
            lwN[j] = *(const f32x2*)(DEC_ + off); kkN[j] = ldh2(KK + off); aaN[j] = ldh2(AA_ + off); krN[j] = ldh2(KR + off); rN[j] = ldh2(R + off); } \
        vmN = *(const u32x4*)(VV + (ub_ + (unsigned)(sg_ * (tg >> 3) + (tg & 7) * 8))); } while (0)
    if (first < nit) CSA_FETCH(first);
    for (int it = first; it < nit; it += stride) {
        const int q = qbase + it * 2 + g; const bool lat = q < CS_LAT;
        const int sc = lat ? (q >> 6) : ((q - CS_LAT) >> 3), ci = lat ? (q & 63) : (q & 7), TT = lat ? DSEQ : SEQ;
        const int b = sc >> 4, dir = (sc >> 3) & 1, h = sc & 7;
        const size_t rowbase = lat ? (size_t)NCTX + (size_t)b * DSEQ : (size_t)b * SEQ;
        const float* DEC = (const float*)(p->ws + WS_DEC) + (size_t)dir * NTOK * 512; const bf16_t* AA = (const bf16_t*)(p->ws + WS_AA) + (size_t)dir * NTOK * 512;
        {
            const int kp = tg & 31, seg = tg >> 5;
            f32x2 lw[4], kk2[4], aa2[4], kr2[4], r2[4];
#pragma unroll
            for (int j = 0; j < 4; ++j) { lw[j] = lwN[j]; kk2[j] = kkN[j]; aa2[j] = aaN[j]; kr2[j] = krN[j]; r2[j] = rN[j]; }
            const u32x4 vmC = vmN;
            if (it + stride < nit) CSA_FETCH(it + stride);
            f32x2 ss = {0.f, 0.f};
#pragma unroll
            for (int j = 0; j < 4; ++j) { lw[j].x = __logf(lw[j].x); lw[j].y = __logf(lw[j].y); ss += lw[j]; }
            *(LAS f32x2*)(SEG + seg * 64 + 2 * kp) = ss;
            { const int i = tg >> 3, v0 = (tg & 7) * 8; *(LAS u32x4*)(MVM + i * 144 + v0 * 2) = vmC; }
            lds_barrier();
            f32x2 pre = {0.f, 0.f}, tot = {0.f, 0.f};
#pragma unroll
            for (int s8 = 0; s8 < 8; ++s8) { const f32x2 v = *(const LAS f32x2*)(SEG + s8 * 64 + 2 * kp); tot += v; if (s8 < seg) pre += v; }
            if (seg == 0) *(LAS f32x2*)(ELv + 2 * kp) = (f32x2){__expf(tot.x), __expf(tot.y)};
            const f32x2 ka = *(const f32x2*)(k_a + h * 64 + 2 * kp);
            f32x2 cwp = pre;
#pragma unroll
            for (int j = 0; j < 4; ++j) {
                const f32x2 cw = cwp + lw[j];
                const f32x2 E = {__expf(cw.x), __expf(cw.y)}, Ei = {__expf(-cw.x), __expf(-cw.y)}, Ep = {__expf(cwp.x), __expf(cwp.y)}, Eh = {__expf(tot.x - cw.x), __expf(tot.y - cw.y)};
                const f32x2 bb = kk2[j] * aa2[j], kd = kr2[j] * ((aa2[j] - 1.f) * ka + 1.f);
                const int o = (4 * seg + j) * 144 + 4 * kp;
                const f32x2 x0 = kk2[j] * Ep, x1 = bb * Ei, x2 = kd * Ei, x3 = r2[j] * E, x4 = bb * Eh, x5 = kd * Eh;
                *(LAS unsigned*)(MKK + o) = pk2(x0.x, x0.y); *(LAS unsigned*)(MBT + o) = pk2(x1.x, x1.y); *(LAS unsigned*)(MKT + o) = pk2(x2.x, x2.y);
                *(LAS unsigned*)(MRT + o) = pk2(x3.x, x3.y); *(LAS unsigned*)(MBH + o) = pk2(x4.x, x4.y); *(LAS unsigned*)(MKH + o) = pk2(x5.x, x5.y);
                cwp = cw;
            }
        }
        lds_barrier();
        {
            const LAS unsigned char* ia = wq < 2 ? MKK : MRT; const LAS unsigned char* ib = (wq & 1) ? MKT : MBT;
            f32x16 acc = zero16();
#pragma unroll
            for (int s4 = 0; s4 < 4; ++s4) acc = MFMA32(frag_nat(ia, 144, r32, s4, hh), frag_nat(ib, 144, r32, s4, hh), acc);
#pragma unroll
            for (int i = 0; i < 16; ++i) { const int row = crow(i, hh); const bool keep = wq < 2 ? (row > r32) : (row >= r32); const float v = keep ? acc[i] : 0.f;
                if (wq == 0) { AF[row * 32 + r32] = v; *(LAS unsigned short*)(SA + row * 80 + r32 * 2) = (row >= 16 && r32 < 16) ? (unsigned short)(pk2(v, 0.f) & 0xffffu) : (unsigned short)0; }
                else *(LAS unsigned short*)((wq == 1 ? SKK : (wq == 2 ? SRB : SRK)) + row * 80 + r32 * 2) = (unsigned short)(pk2(v, 0.f) & 0xffffu); }
        }
        lds_barrier();
        f32x16 X = zero16(), NT0 = zero16(), NT1 = zero16(), Q2 = zero16();
        const int c = wq & 1;
        if (wq == 0) {
            const int blk = r32 >> 4, cc = r32 & 15;
            float Tc[16];
#pragma unroll
            for (int i = 0; i < 16; ++i) {
                float a4[4] = {(i == cc) ? 1.f : 0.f, 0.f, 0.f, 0.f};
#pragma unroll
                for (int j4 = 0; j4 < (i + 3) / 4; ++j4) { const f32x4 ar = *(const LAS f32x4*)(AF + (16 * blk + i) * 32 + 16 * blk + 4 * j4);
#pragma unroll
                    for (int e = 0; e < 4; ++e) if (4 * j4 + e < i) a4[e] -= ar[e] * Tc[4 * j4 + e]; }
                const float a = (a4[0] + a4[1]) + (a4[2] + a4[3]);
                Tc[i] = a;
                if (lane < 32) { *(LAS unsigned short*)(ST + (16 * blk + i) * 80 + (16 * blk + cc) * 2) = (unsigned short)(pk2(a, 0.f) & 0xffffu);
                                 *(LAS unsigned short*)(ST + (16 * blk + i) * 80 + (16 * (1 - blk) + cc) * 2) = (unsigned short)0; }
            }
            asm volatile("s_waitcnt lgkmcnt(0)" ::: "memory");
            f32x16 E = zero16();
            E = MFMA32(frag_krow(SA, 80, r32, 0, hh), frag_tr(ST, 80, 0, 0, lane), E); E = MFMA32(frag_krow(SA, 80, r32, 1, hh), frag_tr(ST, 80, 0, 1, lane), E);
#pragma unroll
            for (int i = 0; i < 16; ++i) E[i] = ((crow(i, hh) == r32) ? 1.f : 0.f) - E[i];
            f32x16 Tm = zero16();
            Tm = MFMA32(frag_krow(ST, 80, r32, 0, hh), pack8<0>(E, 1.f), Tm); Tm = MFMA32(frag_krow(ST, 80, r32, 1, hh), pack8<1>(E, 1.f), Tm);
            asm volatile("s_waitcnt lgkmcnt(0)" ::: "memory");
#pragma unroll
            for (int i = 0; i < 16; ++i) *(LAS unsigned short*)(ST + crow(i, hh) * 80 + r32 * 2) = (unsigned short)(pk2(Tm[i], 0.f) & 0xffffu);
        } else if (wq >= 2) {
#pragma unroll
            for (int s2 = 0; s2 < 2; ++s2) {
                const bf16x8 vm = frag_tr(MVM, 144, 32 * c, s2, lane);
                X = MFMA32(frag_krow(SKK, 80, r32, s2, hh), vm, X);
                Q2 = MFMA32(frag_krow(SRK, 80, r32, s2, hh), vm, Q2);
                NT0 = MFMA32(frag_tr(MKH, 144, 0, s2, lane), vm, NT0);
                NT1 = MFMA32(frag_tr(MKH, 144, 32, s2, lane), vm, NT1);
            }
        }
        lds_barrier();
        if (wq < 2) {
            f32x16 P1 = zero16();
#pragma unroll
            for (int s2 = 0; s2 < 2; ++s2) P1 = MFMA32(frag_krow(ST, 80, r32, s2, hh), frag_tr(MKK, 144, 32 * c, s2, lane), P1);
            const bf16x8 n0 = pack8<0>(P1, -1.f), n1 = pack8<1>(P1, -1.f);
            f32x16 Q1t;
#pragma unroll
            for (int g4 = 0; g4 < 4; ++g4) { const u32x2 w = *(const LAS u32x2*)(MRT + r32 * 144 + (32 * c + 8 * g4 + 4 * hh) * 2); const f32x4 f = unpk4(w);
                Q1t[4 * g4] = f.x; Q1t[4 * g4 + 1] = f.y; Q1t[4 * g4 + 2] = f.z; Q1t[4 * g4 + 3] = f.w; }
            Q1t = MFMA32(n0, frag_krow(SRB, 80, r32, 0, hh), Q1t); Q1t = MFMA32(n1, frag_krow(SRB, 80, r32, 1, hh), Q1t);
            u32x4* q1f = (u32x4*)cs_q1(p->ws, q) + (c * 2) * 64 + lane;
            q1f[0] = __builtin_bit_cast(u32x4, pack8<0>(Q1t, 1.f)); q1f[64] = __builtin_bit_cast(u32x4, pack8<1>(Q1t, 1.f));
#pragma unroll
            for (int bq = 0; bq < 2; ++bq) {
                f32x16 M = zero16();
                if (bq == c) {
#pragma unroll
                    for (int i = 0; i < 16; ++i) M[i] = (crow(i, hh) == r32) ? ELv[32 * c + r32] : 0.f;
                }
                M = MFMA32(n0, frag_tr(MBH, 144, 32 * bq, 0, lane), M); M = MFMA32(n1, frag_tr(MBH, 144, 32 * bq, 1, lane), M);
                u32x4* mf = (u32x4*)cs_mf(p->ws, q) + ((c * 2 + bq) * 2) * 64 + lane;
                mf[0] = __builtin_bit_cast(u32x4, pack8<0>(M, 1.f)); mf[64] = __builtin_bit_cast(u32x4, pack8<1>(M, 1.f));
            }
        } else {
            f32x16 P2 = zero16();
            P2 = MFMA32(frag_krow(ST, 80, r32, 0, hh), pack8<0>(X, 1.f), P2); P2 = MFMA32(frag_krow(ST, 80, r32, 1, hh), pack8<1>(X, 1.f), P2);
            const bf16x8 n0 = pack8<0>(P2, -1.f), n1 = pack8<1>(P2, -1.f);
            Q2 = MFMA32(frag_krow(SRB, 80, r32, 0, hh), n0, Q2); Q2 = MFMA32(frag_krow(SRB, 80, r32, 1, hh), n1, Q2);
            NT0 = MFMA32(frag_tr(MBH, 144, 0, 0, lane), n0, NT0); NT0 = MFMA32(frag_tr(MBH, 144, 0, 1, lane), n1, NT0);
            NT1 = MFMA32(frag_tr(MBH, 144, 32, 0, lane), n0, NT1); NT1 = MFMA32(frag_tr(MBH, 144, 32, 1, lane), n1, NT1);
            unsigned* q2f = (unsigned*)cs_q2(p->ws, q) + c * 512 + lane;
#pragma unroll
            for (int i = 0; i < 8; ++i) q2f[i * 64] = pk2(Q2[2 * i], Q2[2 * i + 1]);
            unsigned* ntf = (unsigned*)cs_nt(p->ws, q) + (c * 2) * 512 + lane;
#pragma unroll
            for (int i = 0; i < 8; ++i) { ntf[i * 64] = pk2(NT0[2 * i], NT0[2 * i + 1]); ntf[512 + i * 64] = pk2(NT1[2 * i], NT1[2 * i + 1]); }
        }
        lds_barrier();
    }
#undef CSA_FETCH
}


constexpr int CSB_SLOT = 24576;
DI void cs_phaseB(KP p, LAS unsigned char* lds, int latent, int sc, int tid) {
    const int wave = tid >> 6, lane = tid & 63, hh = lane >> 5, r32 = lane & 31;
    const int nch = latent ? 64 : 8, q0 = latent ? sc * 64 : CS_LAT + sc * 8, TT = latent ? DSEQ : SEQ;
    const int b = sc >> 4, dir = (sc >> 3) & 1, h = sc & 7, c = wave & 1;
    const size_t rowbase = latent ? (size_t)NCTX + (size_t)b * DSEQ : (size_t)b * SEQ;
    const bool consumer = wave < 2;
    float* Yu = p->out + (size_t)dir * NTOK * 512 + rowbase * 512 + h * 64 + 32 * c;
    const unsigned ylane = (unsigned)((dir ? 4 * (1 - hh) : 4 * hh) * 512 + r32);
    unsigned yv[8];
#pragma unroll
    for (int k = 0; k < 8; ++k) { const int rr_ = 2 * (k & 1) + 8 * (k >> 1); yv[k] = (ylane + (unsigned)((dir ? TT - CS_L + 27 - rr_ : rr_) * 512)) * 4u; }
    const unsigned ystepb = dir ? 0u - (unsigned)(CS_L * 512 * 4) : (unsigned)(CS_L * 512 * 4);
    f32x16 Z0 = zero16(), Z1 = zero16();
    if (consumer && latent) { const float* s0 = p->in[4] + ((((size_t)b * 2 + dir) * 8 + h) * 64 + 32 * c + r32) * 64;
#pragma unroll
      for (int g4 = 0; g4 < 4; ++g4) { const f32x4 a = *(const f32x4*)(s0 + 8 * g4 + 4 * hh), bq = *(const f32x4*)(s0 + 32 + 8 * g4 + 4 * hh);
          Z0[4 * g4] = a.x; Z0[4 * g4 + 1] = a.y; Z0[4 * g4 + 2] = a.z; Z0[4 * g4 + 3] = a.w; Z1[4 * g4] = bq.x; Z1[4 * g4 + 1] = bq.y; Z1[4 * g4 + 2] = bq.z; Z1[4 * g4 + 3] = bq.w; } }
    const int lt = tid - 128;
    u32x4 RG[2][4];
#define CSB_LOADQ(set, ch) do { const int q_ = q0 + (ch); _Pragma("unroll") for (int k_ = 0; k_ < 4; ++k_) { const int pi_ = lt + 384 * k_; \
        const unsigned char* src_ = pi_ < 512 ? cs_mf(p->ws, q_) + pi_ * 16 : (pi_ < 768 ? cs_q1(p->ws, q_) + (pi_ - 512) * 16 : (pi_ < 1280 ? cs_nt(p->ws, q_) + (pi_ - 768) * 16 : cs_q2(p->ws, q_) + (pi_ - 1280) * 16)); \
        RG[set][k_] = *(const u32x4*)src_; } } while (0)
#define CSB_WRITEQ(set, slot) do { _Pragma("unroll") for (int k_ = 0; k_ < 4; ++k_) *(LAS u32x4*)(lds + (slot) * CSB_SLOT + (lt + 384 * k_) * 16) = RG[set][k_]; } while (0)
    if (!consumer) { CSB_LOADQ(0, 0); CSB_LOADQ(1, 1); CSB_WRITEQ(0, 0); CSB_LOADQ(0, 2); }
    else __builtin_amdgcn_s_setprio(3);
    for (int ci0 = 0; ci0 < nch; ci0 += 2) {
#pragma unroll
        for (int u = 0; u < 2; ++u) {
            const int ci = ci0 + u;
            lds_barrier();
            if (!consumer) {
                if (ci + 1 < nch) { CSB_WRITEQ((u + 1) & 1, (ci + 1) & 1); if (ci + 3 < nch) CSB_LOADQ((u + 1) & 1, ci + 3); }
            } else {
                const LAS unsigned char* sl = lds + (ci & 1) * CSB_SLOT;
                bf16x8 MF[8], Q1[4]; f32x16 Y, N0, N1;
#pragma unroll
                for (int i = 0; i < 8; ++i) MF[i] = *(const LAS bf16x8*)(sl + (i * 64 + lane) * 16);
#pragma unroll
                for (int i = 0; i < 4; ++i) Q1[i] = *(const LAS bf16x8*)(sl + 8192 + (i * 64 + lane) * 16);
#pragma unroll
                for (int i = 0; i < 8; ++i) { const unsigned w0 = *(const LAS unsigned*)(sl + 12288 + ((c * 2) * 512 + i * 64 + lane) * 4), w1 = *(const LAS unsigned*)(sl + 12288 + ((c * 2 + 1) * 512 + i * 64 + lane) * 4),
                                                         w2 = *(const LAS unsigned*)(sl + 20480 + (c * 512 + i * 64 + lane) * 4);
                    N0[2 * i] = __builtin_bit_cast(float, w0 << 16); N0[2 * i + 1] = __builtin_bit_cast(float, w0 & 0xffff0000u);
                    N1[2 * i] = __builtin_bit_cast(float, w1 << 16); N1[2 * i + 1] = __builtin_bit_cast(float, w1 & 0xffff0000u);
                    Y[2 * i] = __builtin_bit_cast(float, w2 << 16); Y[2 * i + 1] = __builtin_bit_cast(float, w2 & 0xffff0000u); }
                const bf16x8 z00 = pack8<0>(Z0, 1.f), z01 = pack8<1>(Z0, 1.f), z10 = pack8<0>(Z1, 1.f), z11 = pack8<1>(Z1, 1.f);
                const bf16x8 l00 = pack8lo<0>(Z0, z00), l01 = pack8lo<1>(Z0, z01), l10 = pack8lo<0>(Z1, z10), l11 = pack8lo<1>(Z1, z11);
                Y = MFMA32(Q1[0], z00, Y); Y = MFMA32(Q1[1], z01, Y); Y = MFMA32(Q1[2], z10, Y); Y = MFMA32(Q1[3], z11, Y);
                N0 = MFMA32(MF[0], z00, N0); N0 = MFMA32(MF[1], z01, N0); N0 = MFMA32(MF[4], z10, N0); N0 = MFMA32(MF[5], z11, N0);
                N0 = MFMA32(MF[0], l00, N0); N0 = MFMA32(MF[1], l01, N0); N0 = MFMA32(MF[4], l10, N0); N0 = MFMA32(MF[5], l11, N0);
                N1 = MFMA32(MF[2], z00, N1); N1 = MFMA32(MF[3], z01, N1); N1 = MFMA32(MF[6], z10, N1); N1 = MFMA32(MF[7], z11, N1);
                N1 = MFMA32(MF[2], l00, N1); N1 = MFMA32(MF[3], l01, N1); N1 = MFMA32(MF[6], l10, N1); N1 = MFMA32(MF[7], l11, N1);
                Z0 = N0; Z1 = N1;
                if (dir) {
#pragma unroll
                    for (int i = 0; i < 16; ++i) *(float*)((char*)Yu + yv[(i >> 2) * 2 + ((i & 3) >> 1)] - 2048 * (i & 1)) = Y[i];
                } else {
#pragma unroll
                    for (int i = 0; i < 16; ++i) *(float*)((char*)Yu + yv[(i >> 2) * 2 + ((i & 3) >> 1)] + 2048 * (i & 1)) = Y[i];
                }
#pragma unroll
                for (int k = 0; k < 8; ++k) yv[k] += ystepb;
            }
        }
    }
#undef CSB_LOADQ
#undef CSB_WRITEQ
    __builtin_amdgcn_s_setprio(0);
    if (consumer && !latent) { float* so = p->out + OUT_S + ((((size_t)b * 2 + dir) * 8 + h) * 64 + 32 * c + r32) * 64;
#pragma unroll
        for (int g4 = 0; g4 < 4; ++g4) { *(f32x4*)(so + 8 * g4 + 4 * hh) = (f32x4){Z0[4 * g4], Z0[4 * g4 + 1], Z0[4 * g4 + 2], Z0[4 * g4 + 3]};
                                          *(f32x4*)(so + 32 + 8 * g4 + 4 * hh) = (f32x4){Z1[4 * g4], Z1[4 * g4 + 1], Z1[4 * g4 + 2], Z1[4 * g4 + 3]}; } }
    __syncthreads();
}

DI void post_row(KP p, int r, int lane) {
    const float* Y = p->out; const bf16_t* R = (const bf16_t*)(p->ws + WS_R); const bf16_t* KR = (const bf16_t*)(p->ws + WS_KR);
    const bf16_t* VV = (const bf16_t*)(p->ws + WS_VV); const bf16_t* AA = (const bf16_t*)(p->ws + WS_AA); const bf16_t* G = (const bf16_t*)(p->ws + WS_G);
    const float* k_a = p->in[19]; const float* r_k = p->in[20]; const float* lng = p->in[21]; const float* lnb = p->in[22];
    bf16_t* MIX = (bf16_t*)(p->ws + WS_MIX);
    const int c = lane * 8; const size_t off = (size_t)r * 512 + c;
    float y[8], rr[8], kr[8], vv[8], a0[8], a1[8], gg[8], ka[8], rk[8], lg[8], lb[8];
#define LD8(dst, ptr) do { const f32x4 _a = *(const f32x4*)(ptr), _b = *(const f32x4*)((ptr) + 4); dst[0] = _a.x; dst[1] = _a.y; dst[2] = _a.z; dst[3] = _a.w; dst[4] = _b.x; dst[5] = _b.y; dst[6] = _b.z; dst[7] = _b.w; } while (0)
#define LD8H(dst, ptr) do { const u32x4 _w = *(const u32x4*)(ptr); const f32x4 _a = unpk4((u32x2){_w.x, _w.y}), _b = unpk4((u32x2){_w.z, _w.w}); dst[0] = _a.x; dst[1] = _a.y; dst[2] = _a.z; dst[3] = _a.w; dst[4] = _b.x; dst[5] = _b.y; dst[6] = _b.z; dst[7] = _b.w; } while (0)
    LD8(y, Y + off); LD8(rr, Y + (size_t)NTOK * 512 + off);
#pragma unroll
    for (int j = 0; j < 8; ++j) y[j] += rr[j];
    LD8H(rr, R + off); LD8H(kr, KR + off); LD8H(vv, VV + off); LD8H(a0, AA + off); LD8H(a1, AA + (size_t)NTOK * 512 + off); LD8H(gg, G + off);
    LD8(ka, k_a + c); LD8(rk, r_k + c); LD8(lg, lng + c); LD8(lb, lnb + c);
#undef LD8
#undef LD8H
    float s = 0.f, d0 = 0.f, d1 = 0.f;
#pragma unroll
    for (int j = 0; j < 8; ++j) { s += y[j]; const float q = rr[j] * kr[j] * rk[j]; d0 += q * (1.f + (a0[j] - 1.f) * ka[j]); d1 += q * (1.f + (a1[j] - 1.f) * ka[j]); }
    float bd = d0 + d1;
    s += __shfl_xor(s, 1); s += __shfl_xor(s, 2); s += __shfl_xor(s, 4);
    bd += __shfl_xor(bd, 1); bd += __shfl_xor(bd, 2); bd += __shfl_xor(bd, 4);
    const float mu = s * (1.f / 64.f);
    float q2 = 0.f;
#pragma unroll
    for (int j = 0; j < 8; ++j) { y[j] -= mu; q2 += y[j] * y[j]; }
    q2 += __shfl_xor(q2, 1); q2 += __shfl_xor(q2, 2); q2 += __shfl_xor(q2, 4);
    const float rs = rsqrtf(q2 * (1.f / 64.f) + GN_EPS);
    float o[8];
#pragma unroll
    for (int j = 0; j < 8; ++j) o[j] = (y[j] * rs * lg[j] + lb[j] + bd * vv[j]) * gg[j];
    *(u32x4*)(MIX + (size_t)r * D + 512 + c) = (u32x4){pk2(o[0], o[1]), pk2(o[2], o[3]), pk2(o[4], o[5]), pk2(o[6], o[7])};
}

DI void act_fix(KP p, int pm, int e, int c) {
    const float* EDGE = (const float*)(p->ws + WS_EDGE); bf16_t* ACT = (bf16_t*)(p->ws + WS_ACT); const float* wc = p->in[27];
    const bool need = e == 0 ? (pm != 16 && pm != 24) : (pm != 23 && pm != 31);
    if (!need) return;
    const int r = pm * 256 + (e ? 255 : 0), nbpm = e ? pm + 1 : pm - 1;
    const float* nb = EDGE + ((size_t)nbpm * 2 + (1 - e)) * DFF + c;
    const float* eu = EDGE + ((size_t)pm * 2 + e) * DFF + 64 * DFF + c; const float* e3 = eu + 64 * DFF;
    const float* w = wc + (e ? 2 * DFF : 0) + c;
    float o[8];
#pragma unroll
    for (int j = 0; j < 8; ++j) o[j] = silu_f(eu[j] + w[j] * nb[j]) * e3[j];
    *(u32x4*)(ACT + (size_t)r * DFF + c) = (u32x4){pk2(o[0], o[1]), pk2(o[2], o[3]), pk2(o[4], o[5]), pk2(o[6], o[7])};
}

template <int NR>
DI void final_rows(KP p, int rbase, int rstride, int lane) {
    const float* MODb = (const float*)(p->ws + WS_MOD);
    const bf16_t* PART = (const bf16_t*)(p->ws + WS_PART); const float* nf = p->in[29];
    f32x4 v[NR][4]; u32x2 p0[NR][4], p1[NR][4];
#pragma unroll
    for (int q = 0; q < NR; ++q) { const int r = rbase + q * rstride; const f32x4* xr = (const f32x4*)(p->out + (size_t)r * D) + lane;
#pragma unroll
        for (int j = 0; j < 4; ++j) { v[q][j] = xr[64 * j]; p0[q][j] = *((const u32x2*)(PART + (size_t)r * D) + lane + 64 * j); p1[q][j] = *((const u32x2*)(PART + (size_t)(NTOK + r) * D) + lane + 64 * j); } }
    float s[NR];
#pragma unroll
    for (int q = 0; q < NR; ++q) { const int r = rbase + q * rstride; const float* MOD = MODb + midx_of(r) * 6144; s[q] = 0.f;
#pragma unroll
        for (int j = 0; j < 4; ++j) { const f32x4 gt = *((const f32x4*)(MOD + 5 * D) + lane + 64 * j); v[q][j] = v[q][j] + gt * (unpk4(p0[q][j]) + unpk4(p1[q][j]));
            s[q] += (v[q][j].x * v[q][j].x + v[q][j].y * v[q][j].y) + (v[q][j].z * v[q][j].z + v[q][j].w * v[q][j].w); } }
#pragma unroll
    for (int o = 1; o < 64; o <<= 1) {
#pragma unroll
        for (int q = 0; q < NR; ++q) s[q] += __shfl_xor(s[q], o); }
#pragma unroll
    for (int q = 0; q < NR; ++q) { const int r = rbase + q * rstride; f32x4* xr = (f32x4*)(p->out + (size_t)r * D) + lane; const float rstd = rsqrtf(s[q] * (1.f / D) + EPS);
#pragma unroll
        for (int j = 0; j < 4; ++j) xr[64 * j] = v[q][j] * rstd * *((const f32x4*)nf + lane + 64 * j); }
}

DI int lane_id() { int l; asm volatile("v_mbcnt_lo_u32_b32 %0, -1, 0\n\tv_mbcnt_hi_u32_b32 %0, -1, %0" : "=v"(l)); return l; }
#define XB_TMO      128
#define XB_XCNT(j)  (256  + 64 * (j))
#define XB_XSUB(j)  (1280 + 64 * (j))
#define XB_XGEN(j)  (2304 + 64 * (j))
#define XB_TOP      3328
#define XB_TOPGEN   3392
#define XB_SUBBAR   3520
#define XB_SPIN_CAP (1u << 18)
DI unsigned xb_ld(unsigned* p)              { return __hip_atomic_load(p, __ATOMIC_RELAXED, __HIP_MEMORY_SCOPE_AGENT); }
DI unsigned xb_add(unsigned* p, unsigned v) { return __hip_atomic_fetch_add(p, v, __ATOMIC_RELAXED, __HIP_MEMORY_SCOPE_AGENT); }
DI unsigned xb_xcc_id() { return (unsigned)__builtin_amdgcn_s_getreg((3 << 11) | 20) & 0xFu; }
#define XB_SPIN(cond, bar) do { unsigned _sp = 0; while (cond) { __builtin_amdgcn_s_sleep(1); \
    if ((++_sp & 255u) == 0u) { if (xb_ld(&(bar)[XB_TMO])) break; if (_sp > XB_SPIN_CAP) { atomicAdd(&(bar)[XB_TMO], 1u); break; } } } } while (0)
DI void xcd_barrier_complete(unsigned* bar, unsigned x, unsigned G, unsigned& nloc, unsigned& nx) {
    unsigned sum, cnt, mine, sp = 0u;
    for (;;) {
        sum = 0u; cnt = 0u; mine = 0u;
#pragma unroll
        for (unsigned j = 0; j < 16; ++j) { const unsigned c = xb_ld(&bar[XB_XCNT(j)]); sum += c; cnt += (c > 0u) ? 1u : 0u; mine = (j == x) ? c : mine; }
        if (sum == G) break;
        __builtin_amdgcn_s_sleep(1);
        if ((++sp & 255u) == 0u) { if (xb_ld(&bar[XB_TMO])) break; if (sp > XB_SPIN_CAP) { atomicAdd(&bar[XB_TMO], 1u); break; } }
    }
    nloc = mine > 0u ? mine : 1u; nx = cnt > 0u ? cnt : 1u;
}
DI void grid_bar(unsigned* bar, volatile LAS unsigned* st, unsigned G, int wave_s) {
    asm volatile("s_waitcnt vmcnt(0)" ::: "memory");
    __syncthreads();
    int t = wave_s * 64 + lane_id(); asm volatile("" : "+v"(t));
    if (t == 0) {
        __builtin_amdgcn_s_waitcnt(0);
        const unsigned x = xb_xcc_id();
        unsigned nloc = st[0], nx = st[1];
        if (nloc == 0u) { xcd_barrier_complete(bar, x, G, nloc, nx); st[0] = nloc; st[1] = nx; }
        const unsigned old = xb_add(&bar[XB_XSUB(x)], 1u);
        const unsigned gen = old / nloc;
        if (old + 1u == (gen + 1u) * nloc) {
            __builtin_amdgcn_fence(__ATOMIC_RELEASE, "agent");
            asm volatile("s_waitcnt vmcnt(0)" ::: "memory");
            const unsigned og = xb_add(&bar[XB_TOP], 1u);
            const unsigned tg = og / nx;
            if (og + 1u == (tg + 1u) * nx) xb_add(&bar[XB_TOPGEN], 1u);
            else XB_SPIN(xb_ld(&bar[XB_TOPGEN]) == tg, bar);
            __builtin_amdgcn_fence(__ATOMIC_ACQUIRE, "agent");
            xb_add(&bar[XB_XGEN(x)], 1u);
            asm volatile("s_waitcnt vmcnt(0)" ::: "memory");
        } else {
            XB_SPIN(xb_ld(&bar[XB_XGEN(x)]) == gen, bar);
            __builtin_amdgcn_fence(__ATOMIC_ACQUIRE, "agent");
            asm volatile("s_waitcnt vmcnt(0)" ::: "memory");
        }
    }
    __syncthreads();
}

__global__ void __launch_bounds__(512, 2) fwd_megakernel(Params kparams) {
    const KP kp0 = (KP)__builtin_amdgcn_kernarg_segment_ptr();
    extern __shared__ __attribute__((aligned(16))) unsigned char lds_raw[];
    LAS unsigned char* lds = (LAS unsigned char*)lds_raw;
    const int wave_s = __builtin_amdgcn_readfirstlane((int)threadIdx.x >> 6);
    volatile LAS unsigned* xbst = (volatile LAS unsigned*)(lds + LDS_XB);
    {
        int t0_ = wave_s * 64 + lane_id();
        if (t0_ == 0) { xbst[0] = 0u; xbst[1] = 0u; (void)xb_add((unsigned*)(kp0->ws + WS_BAR) + XB_XCNT(xb_xcc_id()), 1u); }
        __syncthreads();
    }
#define GRID_SYNC() grid_bar((unsigned*)(kp0->ws + WS_BAR), xbst, (unsigned)G, wave_s)
    const int G = gridDim.x, bx = blockIdx.x, NGW = G * 8, NGT = G * 512;
#define PH_VARS KP p = kp0; asm volatile("" : "+s"(p)); unsigned char* ws = p->ws; (void)ws; \
    int tid = wave_s * 64 + lane_id(); asm volatile("" : "+v"(tid)); const int lane = tid & 63, wave = wave_s, gw = bx * 8 + wave, gtid = bx * 512 + tid; (void)lane; (void)gw; (void)gtid;

    const bool defer_ffn = (G == 256);
    { PH_VARS phase0(p, lds, gw, NGW, gtid, NGT, wave, lane, defer_ffn); }
    GRID_SYNC();
    if (G > (1 << 20)) cg::this_grid().sync();
    { PH_VARS for (int r = gw; r < NTOK; r += 4 * NGW) norm_rows<0, 4>(p, r, NGW, lane, p->in[9], 0, D, 0, (bf16_t*)(ws + WS_H), nullptr); }
    GRID_SYNC();
    {
        PH_VARS
        pg8::Gemm g{(const bf16_t*)(ws + WS_H), (const bf16_t*)(ws + WS_WTIN), D, D, D};
        pg8::SchedPlain S; S.o.init(NTOK / 256, NINP / 256, G, bx);
        pg8::EpiIn E{(bf16_t*)(ws + WS_Q), (bf16_t*)(ws + WS_ZR), p->out + OUT_K, 0.125f * LOG2E};
        pg8::gemm_phase(lds, g, S, E, tid);
        if (defer_ffn && bx >= 192) ffn_transposes(p, lds, 0, (bx - 192) * 8 + wave, 64 * 8, wave, lane);
    }
    GRID_SYNC();
    {
        PH_VARS
        LAS float* rpbL = (LAS float*)lds;
        for (int i = tid; i < 8 * 465; i += 512) rpbL[i] = p->in[23][i] * LOG2E;
        __syncthreads();
        LAS unsigned char* vbuf = lds + 16384 + wave * 4608;
        LAS float* xch = (LAS float*)(lds + 65536) + (wave & 3) * 2176;
        const int vb = (G & 7) == 0 ? (bx & 7) * (G >> 3) + (bx >> 3) : bx;
        for (int u0 = vb * 4; u0 < 1024; u0 += G * 4) {
            if (wave < 4) { attn_unit<true, 2>(p, vbuf, rpbL, u0 + wave, lane, 0, 20, xch); attn_unit<false, 0>(p, vbuf, rpbL, u0 + wave, lane, 0, 8, xch); }
            else { attn_unit<true, 1>(p, vbuf, rpbL, u0 + wave - 4, lane, 20, 32, xch); prep_rows8(p, (u0 + wave - 4) * 8, lane); }
            __syncthreads();
        }
    }
    GRID_SYNC();
    {
        PH_VARS
        int kl = 128; asm volatile("" : "+s"(kl));
        pg8::Gemm g{(const bf16_t*)(ws + WS_ALORA), (const bf16_t*)(ws + WS_WTLORA), kl, 128, 128};
        pg8::SchedLora S; S.G = G; S.c = bx;
        pg8::EpiLora E{(float*)(ws + WS_DEC), (float*)(ws + WS_AA), (float*)(ws + WS_G), p->in[13], p->in[15]};
        pg8::gemm_phase(lds, g, S, E, tid);
        if (defer_ffn && bx >= 64) ffn_transposes(p, lds, 1, (bx - 64) * 8 + wave, 192 * 8, wave, lane);
    }
    GRID_SYNC();
    {
        int nst = 2; asm volatile("" : "+s"(nst));
        const int nl = G > 64 ? 32 : 0;
        for (int st = 0; st < nst; ++st) {
            PH_VARS
            const bool lead = bx < nl;
            if (st == 0 || !lead) cs_phaseA(p, lds, tid, st ? CS_LAT : 0, CS_LAT / 2, st ? bx - nl : bx, st ? G - nl : G);
            if (st == 0) { GRID_SYNC(); continue; }
            if (!lead) {
                unsigned* sb = (unsigned*)(kp0->ws + WS_BAR) + XB_SUBBAR;
                __syncthreads();
                if (tid == 0) { __atomic_thread_fence(__ATOMIC_RELEASE); __hip_atomic_fetch_add(sb, 1u, __ATOMIC_RELAXED, __HIP_MEMORY_SCOPE_AGENT);
                    while (__hip_atomic_load(sb, __ATOMIC_RELAXED, __HIP_MEMORY_SCOPE_AGENT) < (unsigned)(G - nl)) __builtin_amdgcn_s_sleep(1);
                    __atomic_thread_fence(__ATOMIC_ACQUIRE); }
                __syncthreads();
            }
            const int tfirst = lead ? bx : (nl ? 32 + (bx - nl) : bx), tend = lead ? 32 : 288, tstride = lead ? 32 : (G - nl);
            for (int t = tfirst; t < tend; t += tstride) cs_phaseB(p, lds, t < 32 ? 1 : 0, t < 32 ? t : t - 32, tid);
        }
    }
    GRID_SYNC();
    { PH_VARS for (int r = gw; r < NTOK; r += NGW) post_row(p, r, lane); }
    GRID_SYNC();
    {
        PH_VARS
        pg8::Gemm g{(const bf16_t*)(ws + WS_MIX), (const bf16_t*)(ws + WS_WTOUT), 512, D, D};
        pg8::SchedSplit2 S; S.o.init(NTOK / 256, 8, G, bx); S.nN = 4; S.ksplit = 512;
        pg8::EpiPart E{(bf16_t*)(ws + WS_PART), 512};
        pg8::gemm_phase(lds, g, S, E, tid);
    }
    GRID_SYNC();
    { PH_VARS for (int r = gw; r < NTOK; r += 2 * NGW) norm_rows<1, 2>(p, r, NGW, lane, p->in[10], 3 * D, 4 * D, 2 * D, (bf16_t*)(ws + WS_H), p->out); }
    GRID_SYNC();
    {
        PH_VARS
        pg8::Gemm g{(const bf16_t*)(ws + WS_H), (const bf16_t*)(ws + WS_WT13), D, D, D};
        pg8::SchedPlain S; S.o.init(NTOK / 256, 2 * DFF / 256, G, bx);
        pg8::EpiFfnAct E{(bf16_t*)(ws + WS_ACT), (float*)(ws + WS_EDGE), p->in[27], lds};
        pg8::gemm_phase(lds, g, S, E, tid);
    }
    GRID_SYNC();
    {
        PH_VARS
        pg8::Gemm g{(const bf16_t*)(ws + WS_ACT), (const bf16_t*)(ws + WS_WT2), DFF / 2, DFF, DFF};
        pg8::SchedSplit2 S; S.o.init(NTOK / 256, 8, G, bx); S.nN = 4; S.ksplit = DFF / 2;
        { for (int i = 0; i < 8; ++i) { int pm_, pn2_; if (!S.o.next2(i, pm_, pn2_)) break; const int ks_ = pn2_ / 4;
              if (pm_ >= 16 && tid < 352) act_fix(p, pm_, tid / 176, ks_ * (DFF / 2) + (tid % 176) * 8); }
          asm volatile("s_waitcnt vmcnt(0)" ::: "memory"); __syncthreads(); }
        pg8::EpiPart E{(bf16_t*)(ws + WS_PART), DFF / 2};
        pg8::gemm_phase(lds, g, S, E, tid);
    }
    GRID_SYNC();
    { PH_VARS for (int r = gw; r < NTOK; r += 4 * NGW) final_rows<4>(p, r, NGW, lane); }
}

extern "C" void kernel_launch(void* const* d_in, const int* in_sizes, int n_in, void* d_out, int out_size, void* d_ws, size_t ws_size, hipStream_t stream) {
    static int grid_blocks = 0;
    if (!grid_blocks) {
        int dev = 0, cus = 0, per_cu = 0;
        (void)hipGetDevice(&dev);
        (void)hipDeviceGetAttribute(&cus, hipDeviceAttributeMultiprocessorCount, dev);
        (void)hipFuncSetAttribute((const void*)fwd_megakernel, hipFuncAttributeMaxDynamicSharedMemorySize, LDS_BYTES);
        (void)hipOccupancyMaxActiveBlocksPerMultiprocessor(&per_cu, (const void*)fwd_megakernel, 512, LDS_BYTES);
        if (per_cu < 1) per_cu = 1;
        grid_blocks = cus * per_cu;
    }
    (void)hipMemsetAsync((char*)d_ws + WS_BAR, 0, 16384, stream);
    Params p{};
    for (int i = 0; i < 30; ++i) p.in[i] = (const float*)d_in[i];
    p.out = (float*)d_out; p.ws = (unsigned char*)d_ws;
    void* args[] = {&p};
    hipError_t e = hipLaunchCooperativeKernel((const void*)fwd_megakernel, dim3(grid_blocks), dim3(512), args, LDS_BYTES, stream);
    if (e != hipSuccess) fprintf(stderr, "cooperative launch failed: %s (grid %d)\n", hipGetErrorString(e), grid_blocks);
}
```

```cpp
#include <hip/hip_runtime.h>
#include <hip/hip_cooperative_groups.h>
#include <cstdio>
#include <cstdint>
namespace cg = cooperative_groups;

#define LAS __attribute__((address_space(3)))
typedef unsigned short bf16_t;
typedef short bf16x8 __attribute__((ext_vector_type(8)));
typedef short s16x4 __attribute__((ext_vector_type(4)));
typedef float f32x2 __attribute__((ext_vector_type(2)));
typedef float f32x4 __attribute__((ext_vector_type(4)));
typedef float f32x16 __attribute__((ext_vector_type(16)));
typedef unsigned u32x2 __attribute__((ext_vector_type(2)));
typedef unsigned u32x4 __attribute__((ext_vector_type(4)));
typedef __bf16 bf16x2_t __attribute__((ext_vector_type(2)));
#define DI __device__ __forceinline__

constexpr int D = 1024, NTOK = 8192, NCTX = 4096, SEQ = 256, DSEQ = 2048;
constexpr int NIN = 3456, NINP = 3584, RC = 1920, DFF = 2816;
constexpr float EPS = 1e-6f, GN_EPS = 64e-5f;
constexpr float LOG2E = 1.4426950408889634f;
constexpr size_t MiB = 1u << 20;
constexpr size_t WS_BAR = 128 * 1024, WS_MOD = 0, WS_WTIN = 1 * MiB, WS_WTOUT = 8 * MiB, WS_WT13 = 10 * MiB, WS_WT2 = 21 * MiB, WS_WTLORA = 27 * MiB,
                 WS_H = 28 * MiB, WS_Q = 44 * MiB, WS_K = 52 * MiB, WS_V = 60 * MiB, WS_R = 68 * MiB, WS_VV = 84 * MiB, WS_KK = 100 * MiB,
                 WS_KR = 116 * MiB, WS_ALORA = 132 * MiB, WS_MIX = 138 * MiB, WS_ZR = 154 * MiB, WS_DEC = 154 * MiB, WS_AA = 186 * MiB,
                 WS_G = 218 * MiB, WS_CK = 234 * MiB, WS_CV = 235 * MiB, WS_Y = 28 * MiB, WS_PART = 176 * MiB, WS_A1 = 44 * MiB,
                 WS_A3 = 88 * MiB, WS_ACT = 132 * MiB, WS_EDGE = 250 * MiB;
constexpr size_t OUT_K = (size_t)NTOK * D, OUT_V = OUT_K + (size_t)NCTX * 512, OUT_S = OUT_V + (size_t)NCTX * 512;
constexpr int LDS_BYTES = 135168 + 16;
constexpr int LDS_XB = 135168;

struct Params { const float* in[30]; float* out; unsigned char* ws; };
typedef const __attribute__((address_space(4))) Params* KP;

DI unsigned pk2(float lo, float hi) { f32x2 v = {lo, hi}; bf16x2_t b = __builtin_convertvector(v, bf16x2_t); return __builtin_bit_cast(unsigned, b); }
DI f32x4 unpk4(u32x2 w) { return (f32x4){__builtin_bit_cast(float, w.x << 16), __builtin_bit_cast(float, w.x & 0xffff0000u), __builtin_bit_cast(float, w.y << 16), __builtin_bit_cast(float, w.y & 0xffff0000u)}; }
DI f32x2 ldh2(const bf16_t* p) { const unsigned w = *(const unsigned*)p; return (f32x2){__builtin_bit_cast(float, w << 16), __builtin_bit_cast(float, w & 0xffff0000u)}; }
DI float bf2f(unsigned short u) { return __builtin_bit_cast(float, (unsigned)u << 16); }
DI float wave_sum(float v) {
#pragma unroll
    for (int o = 1; o < 64; o <<= 1) v += __shfl_xor(v, o);
    return v;
}
DI float sigmoid_f(float x) { return __builtin_amdgcn_rcpf(1.f + __builtin_amdgcn_exp2f(-1.4426950408889634f * x)); }
DI float silu_f(float x) { return x * sigmoid_f(x); }
DI float tanh_f(float x) { return 2.f * sigmoid_f(2.f * x) - 1.f; }
DI int midx_of(int r) { return r < NCTX ? 0 : 1 + ((r - NCTX) >> 11); }
DI const float* xrow_of(KP p, int r) { return r < NCTX ? p->in[0] + (size_t)r * D : p->in[1] + (size_t)(r - NCTX) * D; }

namespace pg8 {
constexpr int BM = 256, BK = 64, HALF = 128, HTB = HALF * BK * 2, NXCD = 8, WGM = 8;
__host__ __device__ __forceinline__ int lds_byte(int r, int c) { const int st = (r >> 4) * 2 + (c >> 5), rr = r & 15, cc = c & 31, ob = rr * 64 + cc * 2; return st * 1024 + (ob ^ (((ob >> 9) & 1) << 5)); }
__host__ __device__ __forceinline__ void stage_rc(int b, int& R, int& C) { const int st = b / 1024, sb = b % 1024, swz = sb ^ (((sb >> 9) & 1) << 5); R = (st >> 1) * 16 + swz / 64; C = (st & 1) * 32 + (swz % 64) / 2; }
__host__ __device__ __forceinline__ int perm32(int rho) { const int n = rho >> 4, i = rho & 15; return 8 * (i >> 2) + 4 * n + (i & 3); }
struct Unit { int pm, pn; int aoff, boff; };
struct Gemm { const bf16_t* A; const bf16_t* Bt; int K, lda, ldb; };
struct StaticOrder {
    int nM, nN, nwg, G, c;
    __device__ __forceinline__ void init(int nM_, int nN_, int G_, int c_) { nM = nM_; nN = nN_; nwg = nM * nN; G = G_; c = c_; }
    __device__ __forceinline__ bool next2(int i, int& pm, int& pn) const {
        const long L = (long)i * G + c; if (L >= nwg) return false;
        int wgid = (int)L; { const int q = nwg / NXCD, r = nwg % NXCD, xcd = wgid % NXCD, off = wgid / NXCD; wgid = (xcd < r ? xcd * (q + 1) : r * (q + 1) + (xcd - r) * q) + off; }
        const int nig = WGM * nN, gid = wgid / nig, fm = gid * WGM, gsz = (nM - fm) < WGM ? (nM - fm) : WGM;
        pm = fm + ((wgid % nig) % gsz); pn = (wgid % nig) / gsz; return true;
    }
};
struct SchedPlain { StaticOrder o; __device__ __forceinline__ bool next(int i, Unit& u) const { u.aoff = 0; u.boff = 0; return o.next2(i, u.pm, u.pn); } };
struct SchedSplit2 { StaticOrder o; int nN, ksplit;
    __device__ __forceinline__ bool next(int i, Unit& u) const { int pn2; if (!o.next2(i, u.pm, pn2)) return false; const int ks = pn2 / nN; u.pn = pn2 - ks * nN; u.aoff = ks * ksplit; u.boff = ks * ksplit; return true; } };
struct SchedLora { int G, c;
    __device__ __forceinline__ bool next(int i, Unit& u) const { const int L = i * G + c; if (L >= 320) return false; u.pm = L & 31; u.pn = L >> 5; const int g = u.pn < 4 ? 0 : (u.pn < 8 ? 1 : 2); u.aoff = g * NTOK * 128; u.boff = 0; return true; } };

template <class Epi, class Sched>
__device__ __forceinline__ void gemm_phase(LAS unsigned char* lds, const Gemm g, const Sched& S, const Epi& E, int tid) {
    asm volatile("" : "+v"(tid));
    const int wid = __builtin_amdgcn_readfirstlane(tid >> 6), lane = tid & 63, wr = wid >> 2, wc = wid & 3, fr = lane & 15, fq = lane >> 4;
    const int nt = g.K / BK;
    unsigned voffA[2], voffB[2];
#pragma unroll
    for (int i = 0; i < 2; ++i) { int R, C; stage_rc(tid * 16 + i * 8192, R, C); const int Rb = (R & ~31) + perm32(R & 31);
        voffA[i] = (unsigned)(R * g.lda + C) * 2u; voffB[i] = (unsigned)(Rb * g.ldb + C) * 2u; }
    const size_t kstep = (size_t)(BK * 2);
    const size_t hA = (size_t)HALF * g.lda * 2, hB = (size_t)HALF * g.ldb * 2;
    const unsigned ldsw = (unsigned)wid * 1024u;
    const int aoff = lds_byte(wr * 64 + fr, fq * 8), boff = lds_byte(wc * 32 + fr, fq * 8);
#define PG8_SA(b, h) (((b) * 2 + (h)) * HTB)
#define PG8_SB(b, h) ((4 + (b) * 2 + (h)) * HTB)
#define PG8_STAGE(bufoff, gbase, voff) do { _Pragma("unroll") for (int _i = 0; _i < 2; ++_i) \
        __builtin_amdgcn_global_load_lds((const unsigned*)((const char*)(gbase) + (voff)[_i]), (LAS unsigned*)(lds + (bufoff) + ldsw + _i * 8192), 16, 0, 0); } while (0)
#define PG8_LDA(dst, b, h) do { _Pragma("unroll") for (int m = 0; m < 4; ++m) _Pragma("unroll") for (int k = 0; k < 2; ++k) dst[m][k] = *(const LAS bf16x8*)(lds + PG8_SA(b, h) + aoff + m * 2048 + k * 1024); } while (0)
#define PG8_LDB(dst, b, h) do { _Pragma("unroll") for (int n = 0; n < 2; ++n) _Pragma("unroll") for (int k = 0; k < 2; ++k) dst[n][k] = *(const LAS bf16x8*)(lds + PG8_SB(b, h) + boff + n * 2048 + k * 1024); } while (0)
#define PG8_MMA(ai, bj, At, Bt) do { __builtin_amdgcn_s_setprio(1); _Pragma("unroll") for (int m = 0; m < 4; ++m) _Pragma("unroll") for (int n = 0; n < 2; ++n) _Pragma("unroll") for (int k = 0; k < 2; ++k) \
        acc[ai][bj][m][n] = __builtin_amdgcn_mfma_f32_16x16x32_bf16(Bt[n][k], At[m][k], acc[ai][bj][m][n], 0, 0, 0); __builtin_amdgcn_s_setprio(0); } while (0)
#define PG8_WAIT_V(n) asm volatile("s_waitcnt vmcnt(" #n ")" ::: "memory")
#define PG8_WAIT_L(n) asm volatile("s_waitcnt lgkmcnt(" #n ")" ::: "memory")
#define PG8_BAR __builtin_amdgcn_s_barrier()
#define PG8_SCHED __builtin_amdgcn_sched_barrier(0)
#define PG8_TA(u) ((const char*)g.A + ((size_t)(u).pm * BM * g.lda + (size_t)(u).aoff) * 2)
#define PG8_TB(u) ((const char*)g.Bt + ((size_t)(u).pn * BM * g.ldb + (size_t)(u).boff) * 2)
    Unit cur, nxt; int ui = 0;
    if (!S.next(0, cur)) return;
    f32x4 acc[2][2][4][2];
#pragma unroll
    for (int a = 0; a < 2; ++a)
#pragma unroll
        for (int b = 0; b < 2; ++b)
#pragma unroll
            for (int m = 0; m < 4; ++m)
#pragma unroll
                for (int n = 0; n < 2; ++n) acc[a][b][m][n] = (f32x4){0.f, 0.f, 0.f, 0.f};
    bf16x8 At[4][2], B0[2][2], B1[2][2];
    const char* cA = PG8_TA(cur); const char* cB = PG8_TB(cur);
    PG8_STAGE(PG8_SB(0, 0), cB, voffB); PG8_STAGE(PG8_SB(0, 1), cB + hB, voffB); PG8_STAGE(PG8_SA(0, 0), cA, voffA); PG8_STAGE(PG8_SA(0, 1), cA + hA, voffA);
    if (wr == 1) PG8_BAR;
    PG8_WAIT_V(2); PG8_BAR;
    PG8_STAGE(PG8_SB(1, 0), cB + kstep, voffB); PG8_STAGE(PG8_SA(1, 0), cA + kstep, voffA); PG8_STAGE(PG8_SB(1, 1), cB + hB + kstep, voffB);
    PG8_WAIT_V(6); PG8_BAR;
    for (;;) {
        const bool has_next = S.next(ui + 1, nxt);
        const char* nA = has_next ? PG8_TA(nxt) : cA; const char* nB = has_next ? PG8_TB(nxt) : cB;
        for (int t = 0; t < nt; t += 2) {
            const bool last = (t == nt - 2);
            const char* a1 = cA + (size_t)(t + 1) * kstep;
            const char* a2 = last ? nA : cA + (size_t)(t + 2) * kstep; const char* b2 = last ? nB : cB + (size_t)(t + 2) * kstep;
            const char* a3 = a2 + kstep; const char* b3 = b2 + kstep;
            PG8_LDB(B0, 0, 0); PG8_LDB(B1, 0, 1); PG8_SCHED; PG8_LDA(At, 0, 0); PG8_STAGE(PG8_SA(1, 1), a1 + hA, voffA);
            PG8_WAIT_V(8); PG8_WAIT_L(0); PG8_BAR; PG8_MMA(0, 0, At, B0); PG8_MMA(0, 1, At, B1); PG8_BAR; PG8_SCHED;
            PG8_LDA(At, 0, 1); PG8_STAGE(PG8_SB(0, 0), b2, voffB); PG8_STAGE(PG8_SB(0, 1), b2 + hB, voffB); PG8_STAGE(PG8_SA(0, 0), a2, voffA);
            PG8_WAIT_V(8); PG8_WAIT_L(0); PG8_BAR; PG8_MMA(1, 0, At, B0); PG8_MMA(1, 1, At, B1); PG8_BAR; PG8_SCHED;
            PG8_LDB(B0, 1, 0); PG8_LDB(B1, 1, 1); PG8_SCHED; PG8_LDA(At, 1, 0); PG8_STAGE(PG8_SA(0, 1), a2 + hA, voffA);
            PG8_WAIT_V(8); PG8_WAIT_L(0); PG8_BAR; PG8_MMA(0, 0, At, B0); PG8_MMA(0, 1, At, B1); PG8_BAR; PG8_SCHED;
            PG8_LDA(At, 1, 1); PG8_STAGE(PG8_SB(1, 0), b3, voffB); PG8_STAGE(PG8_SB(1, 1), b3 + hB, voffB); PG8_STAGE(PG8_SA(1, 0), a3, voffA);
            PG8_WAIT_V(8); PG8_WAIT_L(0); PG8_BAR; PG8_MMA(1, 0, At, B0); PG8_MMA(1, 1, At, B1); PG8_BAR; PG8_SCHED;
        }
        E(acc, cur, wr, wc, fr, fq);
        if (!has_next) break;
#pragma unroll
        for (int a = 0; a < 2; ++a)
#pragma unroll
            for (int b = 0; b < 2; ++b)
#pragma unroll
                for (int m = 0; m < 4; ++m)
#pragma unroll
                    for (int n = 0; n < 2; ++n) acc[a][b][m][n] = (f32x4){0.f, 0.f, 0.f, 0.f};
        cur = nxt; cA = nA; cB = nB; ++ui;
    }
    PG8_WAIT_V(0);
    if (wr == 0) PG8_BAR;
    PG8_BAR;
#undef PG8_SA
#undef PG8_SB
#undef PG8_STAGE
#undef PG8_LDA
#undef PG8_LDB
#undef PG8_MMA
#undef PG8_WAIT_V
#undef PG8_WAIT_L
#undef PG8_BAR
#undef PG8_SCHED
#undef PG8_TA
#undef PG8_TB
}

struct EpiIn {
    bf16_t *Q; bf16_t* ZR; float* outK; float qscale;
    __device__ __forceinline__ void operator()(const f32x4 (&acc)[2][2][4][2], const Unit& u, int wr, int wc, int fr, int fq) const {
#pragma unroll
        for (int bj = 0; bj < 2; ++bj) {
            const int c0 = u.pn * BM + bj * HALF + wc * 32 + 8 * fq;
            if (c0 >= NIN) continue;
#pragma unroll
            for (int ai = 0; ai < 2; ++ai)
#pragma unroll
                for (int m = 0; m < 4; ++m) {
                    int r = u.pm * BM + ai * HALF + wr * 64 + m * 16 + fr; asm volatile("" : "+v"(r));
                    f32x4 v0 = acc[ai][bj][m][0], v1 = acc[ai][bj][m][1];
                    if (c0 < 1536) {
                        const int seg = c0 >> 9, cc = c0 & 511;
                        if (seg == 0) { v0 = v0 * qscale; v1 = v1 * qscale; }
                        else if (r < NCTX) { float* o = outK + (size_t)(seg - 1) * ((size_t)NCTX * 512) + (size_t)r * 512 + cc; *(f32x4*)o = v0; *(f32x4*)(o + 4) = v1; }
                        bf16_t* dst = Q + (size_t)seg * ((size_t)NTOK * 512) + (size_t)r * 512 + cc;
                        u32x4 w; w.x = pk2(v0[0], v0[1]); w.y = pk2(v0[2], v0[3]); w.z = pk2(v1[0], v1[1]); w.w = pk2(v1[2], v1[3]);
                        *(u32x4*)dst = w;
                    } else {
                        u32x4 w; w.x = pk2(v0[0], v0[1]); w.y = pk2(v0[2], v0[3]); w.z = pk2(v1[0], v1[1]); w.w = pk2(v1[2], v1[3]);
                        *(u32x4*)(ZR + (size_t)r * RC + (c0 - 1536)) = w;
                    }
                }
        }
    }
};
DI float decay1(float x) { return __expf(-0.60653065971f * sigmoid_f(x)); }
struct EpiLora {
    float *DEC, *AA, *G; const float *w0, *a0;
    __device__ __forceinline__ void operator()(const f32x4 (&acc)[2][2][4][2], const Unit& u, int wr, int wc, int fr, int fq) const {
#pragma unroll
        for (int bj = 0; bj < 2; ++bj) {
            const int c0 = u.pn * BM + bj * HALF + wc * 32 + 8 * fq;
            const int grp = c0 >> 10, cg = c0 & 1023, dir = cg >> 9, cc = cg & 511;
            const float* bp = (grp == 0 ? w0 : a0) + dir * 512 + cc;
            float* ob = DEC + (size_t)dir * NTOK * 512 + cc;
            bf16_t* obh = grp == 2 ? (bf16_t*)G + cc : (bf16_t*)AA + (size_t)dir * NTOK * 512 + cc;
#pragma unroll
            for (int ai = 0; ai < 2; ++ai)
#pragma unroll
                for (int m = 0; m < 4; ++m) {
                    int r = u.pm * BM + ai * HALF + wr * 64 + m * 16 + fr; asm volatile("" : "+v"(r));
                    f32x4 v0 = acc[ai][bj][m][0], v1 = acc[ai][bj][m][1];
                    if (grp < 2) { const float* bq = bp; asm volatile("" : "+v"(bq)); v0 += *(const f32x4*)bq; v1 += *(const f32x4*)(bq + 4); }
                    if (grp == 0) { v0.x = decay1(v0.x); v0.y = decay1(v0.y); v0.z = decay1(v0.z); v0.w = decay1(v0.w); v1.x = decay1(v1.x); v1.y = decay1(v1.y); v1.z = decay1(v1.z); v1.w = decay1(v1.w); }
                    else if (grp == 1) { v0.x = sigmoid_f(v0.x); v0.y = sigmoid_f(v0.y); v0.z = sigmoid_f(v0.z); v0.w = sigmoid_f(v0.w); v1.x = sigmoid_f(v1.x); v1.y = sigmoid_f(v1.y); v1.z = sigmoid_f(v1.z); v1.w = sigmoid_f(v1.w); }
                    if (grp == 0) { float* o = ob + (size_t)r * 512; *(f32x4*)o = v0; *(f32x4*)(o + 4) = v1; }
                    else { u32x4 w; w.x = pk2(v0[0], v0[1]); w.y = pk2(v0[2], v0[3]); w.z = pk2(v1[0], v1[1]); w.w = pk2(v1[2], v1[3]); *(u32x4*)(obh + (size_t)r * 512) = w; }
                }
        }
    }
};
struct EpiPart {
    bf16_t* P; int ksplit;
    __device__ __forceinline__ void operator()(const f32x4 (&acc)[2][2][4][2], const Unit& u, int wr, int wc, int fr, int fq) const {
        bf16_t* base = P + (u.aoff ? (size_t)NTOK * D : 0);
#pragma unroll
        for (int bj = 0; bj < 2; ++bj) {
            const int c0 = u.pn * BM + bj * HALF + wc * 32 + 8 * fq;
#pragma unroll
            for (int ai = 0; ai < 2; ++ai)
#pragma unroll
                for (int m = 0; m < 4; ++m) {
                    int r = u.pm * BM + ai * HALF + wr * 64 + m * 16 + fr; asm volatile("" : "+v"(r));
                    const f32x4 v0 = acc[ai][bj][m][0], v1 = acc[ai][bj][m][1];
                    u32x4 w; w.x = pk2(v0[0], v0[1]); w.y = pk2(v0[2], v0[3]); w.z = pk2(v1[0], v1[1]); w.w = pk2(v1[2], v1[3]);
                    *(u32x4*)(base + (size_t)r * D + c0) = w;
                }
        }
    }
};
template <int CTRL> DI float dppf(float x) { return __builtin_bit_cast(float, __builtin_amdgcn_mov_dpp(__builtin_bit_cast(int, x), CTRL, 0xf, 0xf, true)); }
struct EpiFfnAct {
    bf16_t* ACT; float* EDGE; const float* wcv; LAS unsigned char* ldsb;
    __device__ __forceinline__ void operator()(const f32x4 (&acc)[2][2][4][2], const Unit& u, int wr, int wc, int fr, int fq) const {
        LAS float* HL = (LAS float*)(ldsb + 131072);
        const int colh = wc * 32 + 8 * fq;
#pragma unroll
        for (int ai = 0; ai < 2; ++ai) { const int g = ai * 2 + wr;
            if (fr == 0) { *(LAS f32x4*)(HL + (g * 2 + 0) * 128 + colh) = acc[ai][0][0][0]; *(LAS f32x4*)(HL + (g * 2 + 0) * 128 + colh + 4) = acc[ai][0][0][1]; }
            if (fr == 15) { *(LAS f32x4*)(HL + (g * 2 + 1) * 128 + colh) = acc[ai][0][3][0]; *(LAS f32x4*)(HL + (g * 2 + 1) * 128 + colh + 4) = acc[ai][0][3][1]; } }
        asm volatile("s_waitcnt lgkmcnt(0)" ::: "memory");
        __builtin_amdgcn_s_barrier(); __builtin_amdgcn_s_barrier();
        asm volatile("" ::: "memory");
        const int cf = u.pn * HALF + colh;
        const f32x4 zero = {0.f, 0.f, 0.f, 0.f};
        const bool lat = u.pm >= 16;
#pragma unroll
        for (int ai = 0; ai < 2; ++ai) {
            const int g = ai * 2 + wr;
            f32x4 hp[2], hn[2];
            hp[0] = g > 0 ? *(const LAS f32x4*)(HL + ((g - 1) * 2 + 1) * 128 + colh) : zero; hp[1] = g > 0 ? *(const LAS f32x4*)(HL + ((g - 1) * 2 + 1) * 128 + colh + 4) : zero;
            hn[0] = g < 3 ? *(const LAS f32x4*)(HL + ((g + 1) * 2 + 0) * 128 + colh) : zero; hn[1] = g < 3 ? *(const LAS f32x4*)(HL + ((g + 1) * 2 + 0) * 128 + colh + 4) : zero;
#pragma unroll
            for (int m = 0; m < 4; ++m) {
                int r = u.pm * BM + ai * HALF + wr * 64 + m * 16 + fr; asm volatile("" : "+v"(r));
                const float* wq_ = wcv + cf; asm volatile("" : "+v"(wq_));
                f32x4 uu[2], av[2];
#pragma unroll
                for (int n = 0; n < 2; ++n) {
                    const f32x4 cur = acc[ai][0][m][n];
                    f32x4 pv, nx;
#pragma unroll
                    for (int j = 0; j < 4; ++j) {
                        if (m > 0) pv[j] = dppf<0x121>(fr == 15 ? acc[ai][0][m > 0 ? m - 1 : 0][n][j] : cur[j]);
                        else { const float a = dppf<0x121>(cur[j]); pv[j] = fr == 0 ? hp[n][j] : a; }
                        if (m < 3) nx[j] = dppf<0x12F>(fr == 0 ? acc[ai][0][m < 3 ? m + 1 : 3][n][j] : cur[j]);
                        else { const float c = dppf<0x12F>(cur[j]); nx[j] = fr == 15 ? hn[n][j] : c; }
                    }
                    const f32x4 w0 = *(const f32x4*)(wq_ + 4 * n), w1 = *(const f32x4*)(wq_ + DFF + 4 * n), w2 = *(const f32x4*)(wq_ + 2 * DFF + 4 * n);
                    uu[n] = pv * w0 + cur * w1 + nx * w2;
                    const f32x4 a3 = acc[ai][1][m][n];
                    av[n] = (f32x4){silu_f(uu[n].x) * a3.x, silu_f(uu[n].y) * a3.y, silu_f(uu[n].z) * a3.z, silu_f(uu[n].w) * a3.w};
                }
                u32x4 w; w.x = pk2(av[0][0], av[0][1]); w.y = pk2(av[0][2], av[0][3]); w.z = pk2(av[1][0], av[1][1]); w.w = pk2(av[1][2], av[1][3]);
                *(u32x4*)(ACT + (size_t)r * DFF + cf) = w;
                if (lat && ((ai == 0 && m == 0) || (ai == 1 && m == 3))) {
                    const int e = ai;
                    const bool mine = e == 0 ? (wr == 0 && fr == 0) : (wr == 1 && fr == 15);
                    if (mine) {
                        float* eb = EDGE + ((size_t)u.pm * 2 + e) * DFF + cf;
                        *(f32x4*)(eb) = acc[ai][0][m][0]; *(f32x4*)(eb + 4) = acc[ai][0][m][1];
                        *(f32x4*)(eb + 64 * DFF) = uu[0]; *(f32x4*)(eb + 64 * DFF + 4) = uu[1];
                        *(f32x4*)(eb + 128 * DFF) = acc[ai][1][m][0]; *(f32x4*)(eb + 128 * DFF + 4) = acc[ai][1][m][1];
                    }
                }
            }
        }
    }
};
}

template <int MODE>
DI void transpose_item(const float* W, int K, int N, bf16_t* WT, LAS float* scr, int item, int lane) {
    const int nblk = N / 32, kb = item / nblk, nb = item % nblk, k0 = 64 * kb, n0 = 32 * nb;
#pragma unroll 8
    for (int i = 0; i < 32; ++i) { const int kk = 2 * i + (lane >> 5); scr[kk * 33 + (lane & 31)] = W[(size_t)(k0 + kk) * N + n0 + (lane & 31)]; }
    asm volatile("s_waitcnt lgkmcnt(0)" ::: "memory");
    const int c = lane & 7;
#pragma unroll
    for (int j = 0; j < 4; ++j) { const int n = (lane >> 3) + 8 * j; const LAS float* s = scr + (8 * c) * 33 + n;
        u32x4 o; o.x = pk2(s[0 * 33], s[1 * 33]); o.y = pk2(s[2 * 33], s[3 * 33]); o.z = pk2(s[4 * 33], s[5 * 33]); o.w = pk2(s[6 * 33], s[7 * 33]);
        const int nn = n0 + n; const int drow = MODE == 0 ? nn : ((nn >> 7) * 256 + (nn & 127) + (MODE == 2 ? 128 : 0));
        *(u32x4*)(WT + (size_t)drow * K + k0 + 8 * c) = o; }
    asm volatile("s_waitcnt lgkmcnt(0)" ::: "memory");
}

DI void phase0(KP p, LAS unsigned char* lds, int gw, int NGW, int gtid, int NGT, int wave, int lane, bool defer_ffn) {
    unsigned char* ws = p->ws;
    {
        float* MOD = (float*)(ws + WS_MOD);
        const float* w_ada = p->in[7]; const float* b_ada = p->in[8]; const float* c_lat = p->in[5]; const float* c_ctx = p->in[6];
        LAS float* red = (LAS float*)(lds + 8 * 8448);
        const int tid = wave * 64 + lane, cgp = lane & 15, kr = lane >> 4;
        for (int nb = blockIdx.x; nb < 96; nb += gridDim.x) {
            f32x4 a0 = {0, 0, 0, 0}, a1 = a0, a2 = a0;
#pragma unroll 8
            for (int i = 0; i < 32; ++i) {
                const int k = wave * 128 + 4 * i + kr;
                const f32x4 w = *(const f32x4*)(w_ada + (size_t)k * 6144 + nb * 64 + 4 * cgp);
                a0 += w * silu_f(c_ctx[k]); a1 += w * silu_f(c_lat[k]); a2 += w * silu_f(c_lat[D + k]);
            }
#pragma unroll
            for (int j = 0; j < 4; ++j) {
                a0[j] += __shfl_xor(a0[j], 16); a0[j] += __shfl_xor(a0[j], 32);
                a1[j] += __shfl_xor(a1[j], 16); a1[j] += __shfl_xor(a1[j], 32);
                a2[j] += __shfl_xor(a2[j], 16); a2[j] += __shfl_xor(a2[j], 32);
            }
            if (kr == 0) { *(LAS f32x4*)(red + (wave * 3 + 0) * 64 + 4 * cgp) = a0; *(LAS f32x4*)(red + (wave * 3 + 1) * 64 + 4 * cgp) = a1; *(LAS f32x4*)(red + (wave * 3 + 2) * 64 + 4 * cgp) = a2; }
            __syncthreads();
            if (tid < 192) {
                const int i = tid >> 6, c = tid & 63; float s = b_ada[nb * 64 + c];
#pragma unroll
                for (int w = 0; w < 8; ++w) s += red[(w * 3 + i) * 64 + c];
                MOD[i * 6144 + nb * 64 + c] = s;
            }
            __syncthreads();
        }
    }
    {
        LAS float* scr = (LAS float*)(lds + wave * 8448);
        constexpr int I_IN = 16 * 108, I_OUT = 16 * 32, I_F = 16 * 88, I_2 = 44 * 32, NIT = I_IN + I_OUT + 2 * I_F + I_2;
        const int nit = defer_ffn ? I_IN : NIT;
        for (int it = gw; it < nit; it += NGW) {
            int r = it;
            if (r < I_IN) { transpose_item<0>(p->in[11], D, NIN, (bf16_t*)(ws + WS_WTIN), scr, r, lane); continue; } r -= I_IN;
            if (r < I_OUT) { transpose_item<0>(p->in[24], D, D, (bf16_t*)(ws + WS_WTOUT), scr, r, lane); continue; } r -= I_OUT;
            if (r < I_F) { transpose_item<1>(p->in[25], D, DFF, (bf16_t*)(ws + WS_WT13), scr, r, lane); continue; } r -= I_F;
            if (r < I_F) { transpose_item<2>(p->in[26], D, DFF, (bf16_t*)(ws + WS_WT13), scr, r, lane); continue; } r -= I_F;
            transpose_item<0>(p->in[28], DFF, D, (bf16_t*)(ws + WS_WT2), scr, r, lane);
        }
    }
    { u32x4* z = (u32x4*)((bf16_t*)(ws + WS_WTIN) + (size_t)NIN * D); for (int i = gtid; i < 128 * D / 8; i += NGT) z[i] = (u32x4){0, 0, 0, 0}; }
    {
        bf16_t* WL = (bf16_t*)(ws + WS_WTLORA); const float* w2 = p->in[14]; const float* a2 = p->in[16]; const float* g2 = p->in[17];
        for (int i = gtid; i < 2560 * 128; i += NGT) {
            const int n = i >> 7, k = i & 127; float v = 0.f;
            if (n < 2048) { const int grp = n >> 10, dir = (n >> 9) & 1, c = n & 511; const float* src = grp == 0 ? w2 : a2;
                if ((k >> 6) == dir) v = src[((size_t)dir * 64 + (k & 63)) * 512 + c]; }
            else v = g2[(size_t)k * 512 + (n - 2048)];
            WL[i] = (bf16_t)(pk2(v, 0.f) & 0xffffu);
        }
    }
    {
        const f32x4* ck = (const f32x4*)p->in[2]; const f32x4* cv = (const f32x4*)p->in[3]; u32x2* CK = (u32x2*)(ws + WS_CK); u32x2* CV = (u32x2*)(ws + WS_CV);
        for (int i = gtid; i < 1024 * 512 / 4; i += NGT) { const f32x4 a = ck[i], b = cv[i]; CK[i] = (u32x2){pk2(a[0], a[1]), pk2(a[2], a[3])}; CV[i] = (u32x2){pk2(b[0], b[1]), pk2(b[2], b[3])}; }
    }
}

DI void ffn_transposes(KP p, LAS unsigned char* lds, int which, int widx, int nw, int wave, int lane) {
    LAS float* scr = (LAS float*)(lds + wave * 8448);
    constexpr int I_F = 16 * 88, I_2 = 44 * 32;
    if (which == 0) { constexpr int I_OUT = 16 * 32;
        for (int it = widx; it < I_OUT + I_2; it += nw) { if (it < I_OUT) transpose_item<0>(p->in[24], D, D, (bf16_t*)(p->ws + WS_WTOUT), scr, it, lane);
                                                            else transpose_item<0>(p->in[28], DFF, D, (bf16_t*)(p->ws + WS_WT2), scr, it - I_OUT, lane); } }
    else { for (int it = widx; it < 2 * I_F; it += nw) { if (it < I_F) transpose_item<1>(p->in[25], D, DFF, (bf16_t*)(p->ws + WS_WT13), scr, it, lane);
                                                           else transpose_item<2>(p->in[26], D, DFF, (bf16_t*)(p->ws + WS_WT13), scr, it - I_F, lane); } }
}

template <int SRC, int NR>
DI void norm_rows(KP p, int rbase, int rstride, int lane, const float* normw, int sh_off, int sc_off, int gate_off, bf16_t* Hout, float* xout) {
    const float* MODb = (const float*)(p->ws + WS_MOD);
    const bf16_t* PART = (const bf16_t*)(p->ws + WS_PART);
    f32x4 v[NR][4];
#pragma unroll
    for (int q = 0; q < NR; ++q) { const f32x4* xr = (const f32x4*)xrow_of(p, rbase + q * rstride) + lane;
#pragma unroll
        for (int j = 0; j < 4; ++j) v[q][j] = xr[64 * j]; }
    if (SRC == 1) {
        u32x2 p0[NR][4], p1[NR][4];
#pragma unroll
        for (int q = 0; q < NR; ++q) { const int r = rbase + q * rstride;
#pragma unroll
            for (int j = 0; j < 4; ++j) { p0[q][j] = *((const u32x2*)(PART + (size_t)r * D) + lane + 64 * j); p1[q][j] = *((const u32x2*)(PART + (size_t)(NTOK + r) * D) + lane + 64 * j); } }
#pragma unroll
        for (int q = 0; q < NR; ++q) { const int r = rbase + q * rstride; const float* MOD = MODb + midx_of(r) * 6144;
#pragma unroll
            for (int j = 0; j < 4; ++j) { const f32x4 gt = *((const f32x4*)(MOD + gate_off) + lane + 64 * j); v[q][j] = v[q][j] + gt * (unpk4(p0[q][j]) + unpk4(p1[q][j])); } }
    }
    float s[NR];
#pragma unroll
    for (int q = 0; q < NR; ++q) { s[q] = 0.f;
#pragma unroll
        for (int j = 0; j < 4; ++j) s[q] += (v[q][j].x * v[q][j].x + v[q][j].y * v[q][j].y) + (v[q][j].z * v[q][j].z + v[q][j].w * v[q][j].w); }
#pragma unroll
    for (int o = 1; o < 64; o <<= 1) {
#pragma unroll
        for (int q = 0; q < NR; ++q) s[q] += __shfl_xor(s[q], o); }
#pragma unroll
    for (int q = 0; q < NR; ++q) {
        const int r = rbase + q * rstride; const float* MOD = MODb + midx_of(r) * 6144;
        const float rstd = rsqrtf(s[q] * (1.f / D) + EPS);
        u32x2* o = (u32x2*)(Hout + (size_t)r * D) + lane;
#pragma unroll
        for (int j = 0; j < 4; ++j) {
            if (SRC == 1) *((f32x4*)(xout + (size_t)r * D) + lane + 64 * j) = v[q][j];
            const f32x4 g = *((const f32x4*)normw + lane + 64 * j), sc = *((const f32x4*)(MOD + sc_off) + lane + 64 * j), sh = *((const f32x4*)(MOD + sh_off) + lane + 64 * j);
            const f32x4 h = v[q][j] * rstd * g * (sc + 1.f) + sh;
            o[64 * j] = (u32x2){pk2(h.x, h.y), pk2(h.z, h.w)};
        }
    }
}

#define MFMA32(a, b, c) __builtin_amdgcn_mfma_f32_32x32x16_bf16((a), (b), (c), 0, 0, 0)
DI int crow(int reg, int h) { return (reg & 3) + 8 * (reg >> 2) + 4 * h; }
typedef short v4i16_t __attribute__((ext_vector_type(4)));
DI s16x4 vtr(const LAS unsigned char* p) { return __builtin_bit_cast(s16x4, __builtin_amdgcn_ds_read_tr16_b64_v4i16((LAS v4i16_t*)p)); }

template <bool LATENT, int MODE>
DI void attn_unit(KP p, LAS unsigned char* vbuf, const LAS float* rpbL, int unit, int lane, int t0, int t1, LAS float* xch) {
    const bf16_t* Q = (const bf16_t*)(p->ws + WS_Q); const bf16_t* Kb = (const bf16_t*)(p->ws + WS_K); const bf16_t* Vb = (const bf16_t*)(p->ws + WS_V);
    const bf16_t* CK = (const bf16_t*)(p->ws + WS_CK); const bf16_t* CV = (const bf16_t*)(p->ws + WS_CV);
    bf16_t* MIX = (bf16_t*)(p->ws + WS_MIX);
    const int r = lane & 31, hh = lane >> 5;
    int head, qrow0, b, gi = 0, w0 = 0, si = 0, ntile;
    if (LATENT) { head = unit & 7; const int t = unit >> 3; w0 = (t & 1) * 32; gi = (t >> 1) & 31; b = t >> 6; qrow0 = NCTX + b * DSEQ + gi * 64 + w0; si = min(max(gi - 4, 0), 24); ntile = 32; }
    else { head = unit & 7; const int t = unit >> 3; const int qb = t & 7; b = t >> 3; qrow0 = b * SEQ + qb * 32; ntile = 8; }
    bf16x8 qf[4];
#pragma unroll
    for (int s = 0; s < 4; ++s) qf[s] = *(const bf16x8*)(Q + (size_t)(qrow0 + r) * 512 + head * 64 + 16 * s + 8 * hh);
    auto tile_ptrs = [&](int t, const bf16_t*& kp, const bf16_t*& vp) {
        if (LATENT) {
            if (t < 16) { const size_t row = (size_t)b * 512 + t * 32; kp = CK + row * 512; vp = CV + row * 512; }
            else { const int lt = t - 16; const size_t row = (size_t)NCTX + b * DSEQ + (si + (lt >> 1)) * 64 + (((lt & 1) * 32) ^ w0); kp = Kb + row * 512; vp = Vb + row * 512; }
        } else { const size_t row = (size_t)b * SEQ + t * 32; kp = Kb + row * 512; vp = Vb + row * 512; }
    };
    bf16x8 kf[4], kn[4]; u32x4 vn[4];
    {
        const bf16_t *kp, *vp; tile_ptrs(t0, kp, vp);
#pragma unroll
        for (int s = 0; s < 4; ++s) kf[s] = *(const bf16x8*)(kp + (size_t)r * 512 + head * 64 + 16 * s + 8 * hh);
#pragma unroll
        for (int i = 0; i < 4; ++i) { const int c = lane + 64 * i; vn[i] = *(const u32x4*)(vp + (size_t)(c >> 3) * 512 + head * 64 + (c & 7) * 8); }
#pragma unroll
        for (int i = 0; i < 4; ++i) { const int c = lane + 64 * i; *(LAS u32x4*)(vbuf + (c >> 3) * 144 + (c & 7) * 16) = vn[i]; }
    }
    f32x16 o0, o1;
#pragma unroll
    for (int i = 0; i < 16; ++i) { o0[i] = 0.f; o1[i] = 0.f; }
    float mrun = -1e30f, lrun = 0.f;
    const int i16 = lane & 15, tq = i16 >> 2, tp = i16 & 3, blk = (lane >> 4) & 1;
    const LAS unsigned char* vtbase = vbuf + (4 * hh + tq) * 144 + (16 * blk) * 2 + 8 * tp;
    const int wq = w0 + r;
    const int cs = min(max(wq - 8, 0), 48);
    for (int t = t0; t < t1; ++t) {
        const bool more = (t + 1 < t1);
        if (more) {
            const bf16_t *kp, *vp; tile_ptrs(t + 1, kp, vp);
#pragma unroll
            for (int s = 0; s < 4; ++s) kn[s] = *(const bf16x8*)(kp + (size_t)r * 512 + head * 64 + 16 * s + 8 * hh);
#pragma unroll
            for (int i = 0; i < 4; ++i) { const int c = lane + 64 * i; vn[i] = *(const u32x4*)(vp + (size_t)(c >> 3) * 512 + head * 64 + (c & 7) * 8); }
        }
        f32x16 st;
#pragma unroll
        for (int i = 0; i < 16; ++i) st[i] = 0.f;
#pragma unroll
        for (int s = 0; s < 4; ++s) st = MFMA32(kf[s], qf[s], st);
        if (LATENT && t >= 16) {
            const int lt = t - 16, a = lt >> 1, c0 = ((lt & 1) * 32) ^ w0;
            const int row_off = si + a - gi + 7;
            const int d0 = c0 + 4 * hh - cs;
            const LAS float* bp = rpbL + head * 465 + row_off * 31 + (c0 + 4 * hh - wq + 15);
#pragma unroll
            for (int i = 0; i < 16; ++i) {
                const int ci = (i & 3) + 8 * (i >> 2);
                const bool valid = (unsigned)(d0 + ci) < 16u;
                const float bias = valid ? bp[ci] : 0.f;
                st[i] = valid ? st[i] + bias : -INFINITY;
            }
        }
        float tmax = st[0];
#pragma unroll
        for (int i = 1; i < 16; ++i) tmax = fmaxf(tmax, st[i]);
        { const unsigned tb = __builtin_bit_cast(unsigned, tmax);
          const auto sw = __builtin_amdgcn_permlane32_swap(tb, tb, false, false);
          tmax = fmaxf(fmaxf(tmax, __builtin_bit_cast(float, (unsigned)sw[0])), __builtin_bit_cast(float, (unsigned)sw[1])); }
        if (__builtin_amdgcn_ballot_w64(tmax - mrun > 8.f) != 0ull) {
            const float mnew = fmaxf(mrun, tmax);
            const float alpha = __builtin_amdgcn_exp2f(mrun - mnew);
            lrun *= alpha; mrun = mnew;
#pragma unroll
            for (int i = 0; i < 16; ++i) { o0[i] *= alpha; o1[i] *= alpha; }
        }
        float ps = 0.f;
#pragma unroll
        for (int i = 0; i < 16; ++i) { st[i] = __builtin_amdgcn_exp2f(st[i] - mrun); ps += st[i]; }
        lrun += ps;
        bf16x8 pb[2];
#pragma unroll
        for (int s = 0; s < 2; ++s) { u32x4 w; w.x = pk2(st[8 * s], st[8 * s + 1]); w.y = pk2(st[8 * s + 2], st[8 * s + 3]); w.z = pk2(st[8 * s + 4], st[8 * s + 5]); w.w = pk2(st[8 * s + 6], st[8 * s + 7]); pb[s] = __builtin_bit_cast(bf16x8, w); }
        asm volatile("s_waitcnt lgkmcnt(0)" ::: "memory");
#pragma unroll
        for (int s = 0; s < 2; ++s) {
            const LAS unsigned char* bs = vtbase + (16 * s) * 144;
            const s16x4 lo0 = vtr(bs), hi0 = vtr(bs + 8 * 144), lo1 = vtr(bs + 64), hi1 = vtr(bs + 8 * 144 + 64);
            const bf16x8 va0 = __builtin_shufflevector(lo0, hi0, 0, 1, 2, 3, 4, 5, 6, 7), va1 = __builtin_shufflevector(lo1, hi1, 0, 1, 2, 3, 4, 5, 6, 7);
            o0 = MFMA32(va0, pb[s], o0); o1 = MFMA32(va1, pb[s], o1);
        }
        asm volatile("s_waitcnt lgkmcnt(0)" ::: "memory");
        if (more) {
#pragma unroll
            for (int i = 0; i < 4; ++i) { const int c = lane + 64 * i; *(LAS u32x4*)(vbuf + (c >> 3) * 144 + (c & 7) * 16) = vn[i]; }
#pragma unroll
            for (int s = 0; s < 4; ++s) kf[s] = kn[s];
        }
    }
    if (MODE == 1) {
#pragma unroll
        for (int i = 0; i < 16; ++i) { xch[i * 64 + lane] = o0[i]; xch[(16 + i) * 64 + lane] = o1[i]; }
        xch[32 * 64 + lane] = mrun; xch[33 * 64 + lane] = lrun;
        __syncthreads();
        return;
    }
    if (MODE == 2) {
        __syncthreads();
        const float mb = xch[32 * 64 + lane], lb = xch[33 * 64 + lane];
        const float mm = fmaxf(mrun, mb), fa = exp2f(mrun - mm), fb = exp2f(mb - mm);
#pragma unroll
        for (int i = 0; i < 16; ++i) { o0[i] = o0[i] * fa + xch[i * 64 + lane] * fb; o1[i] = o1[i] * fa + xch[(16 + i) * 64 + lane] * fb; }
        lrun = lrun * fa + lb * fb;
    }
    float ltot; { const unsigned lb_ = __builtin_bit_cast(unsigned, lrun); const auto sw = __builtin_amdgcn_permlane32_swap(lb_, lb_, false, false); ltot = __builtin_bit_cast(float, (unsigned)sw[0]) + __builtin_bit_cast(float, (unsigned)sw[1]); }
    const float inv = 1.f / ltot;
    bf16_t* orow = MIX + (size_t)(qrow0 + r) * D + head * 64;
#pragma unroll
    for (int g4 = 0; g4 < 4; ++g4) {
        const int d = 8 * g4 + 4 * hh;
        *(u32x2*)(orow + d) = (u32x2){pk2(o0[4 * g4] * inv, o0[4 * g4 + 1] * inv), pk2(o0[4 * g4 + 2] * inv, o0[4 * g4 + 3] * inv)};
        *(u32x2*)(orow + 32 + d) = (u32x2){pk2(o1[4 * g4] * inv, o1[4 * g4 + 1] * inv), pk2(o1[4 * g4 + 2] * inv, o1[4 * g4 + 3] * inv)};
    }
}

DI void prep_rows8(KP p, int r0, int lane) {
    const bf16_t* ZR = (const bf16_t*)(p->ws + WS_ZR); const float* wts = p->in[12]; const float* k_k = p->in[18];
    bf16_t* R = (bf16_t*)(p->ws + WS_R); bf16_t* KR = (bf16_t*)(p->ws + WS_KR); bf16_t* VV = (bf16_t*)(p->ws + WS_VV); bf16_t* KK = (bf16_t*)(p->ws + WS_KK);
    bf16_t* AL = (bf16_t*)(p->ws + WS_ALORA);
    const int t0 = r0 < NCTX ? (r0 & 255) : ((r0 - NCTX) & 2047); const int T = r0 < NCTX ? SEQ : DSEQ;
    const bool hp = t0 > 0, hn = t0 + 8 < T;
    const bf16_t* zb = ZR + (size_t)(r0 - 1) * RC;
    const f32x4 zero = {0, 0, 0, 0};
#pragma unroll 1
    for (int seg = 0; seg < 3; ++seg) {
        const int c = seg * 512 + lane * 8;
        f32x4 z[10][2];
#pragma unroll
        for (int i = 0; i < 10; ++i) { const bool ok = (i > 0 || hp) && (i < 9 || hn);
            if (ok) { const u32x4 w = *(const u32x4*)(zb + (size_t)i * RC + c); z[i][0] = unpk4((u32x2){w.x, w.y}); z[i][1] = unpk4((u32x2){w.z, w.w}); } else { z[i][0] = zero; z[i][1] = zero; } }
        const f32x4 wa0 = *(const f32x4*)(wts + c), wa1 = *(const f32x4*)(wts + c + 4), wb0 = *(const f32x4*)(wts + RC + c), wb1 = *(const f32x4*)(wts + RC + c + 4),
                    wc0 = *(const f32x4*)(wts + 2 * RC + c), wc1 = *(const f32x4*)(wts + 2 * RC + c + 4);
        const f32x4 k0 = *(const f32x4*)(k_k + lane * 8), k1 = *(const f32x4*)(k_k + lane * 8 + 4);
        bf16_t* dstb = (seg == 0 ? R : (seg == 1 ? KR : VV)) + (size_t)r0 * 512 + lane * 8;
#pragma unroll
        for (int i = 0; i < 8; ++i) {
            const f32x4 u0 = z[i][0] * wa0 + z[i + 1][0] * wb0 + z[i + 2][0] * wc0, u1 = z[i][1] * wa1 + z[i + 1][1] * wb1 + z[i + 2][1] * wc1;
            *(u32x4*)(dstb + (size_t)i * 512) = (u32x4){pk2(u0.x, u0.y), pk2(u0.z, u0.w), pk2(u1.x, u1.y), pk2(u1.z, u1.w)};
            if (seg == 1) {
                const f32x4 a = u0 * k0, bq = u1 * k1;
                float sq = (a.x * a.x + a.y * a.y) + (a.z * a.z + a.w * a.w) + (bq.x * bq.x + bq.y * bq.y) + (bq.z * bq.z + bq.w * bq.w);
                sq += __shfl_xor(sq, 1); sq += __shfl_xor(sq, 2); sq += __shfl_xor(sq, 4);
                const float rn = rsqrtf(sq + 1e-12f);
                const f32x4 ka_ = a * rn, kb_ = bq * rn; *(u32x4*)(KK + (size_t)(r0 + i) * 512 + lane * 8) = (u32x4){pk2(ka_.x, ka_.y), pk2(ka_.z, ka_.w), pk2(kb_.x, kb_.y), pk2(kb_.z, kb_.w)};
            }
        }
    }
    {
        const int cl = lane * 6, cc = 1536 + cl;
        const f32x2 zero2 = {0, 0};
        f32x2 z[10][3];
#pragma unroll
        for (int i = 0; i < 10; ++i) { const bool ok = (i > 0 || hp) && (i < 9 || hn);
#pragma unroll
            for (int q = 0; q < 3; ++q) { if (ok) { const unsigned w = *(const unsigned*)(zb + (size_t)i * RC + cc + 2 * q); z[i][q] = (f32x2){__builtin_bit_cast(float, w << 16), __builtin_bit_cast(float, w & 0xffff0000u)}; } else z[i][q] = zero2; } }
#pragma unroll
        for (int q = 0; q < 3; ++q) {
            const f32x2 wa = *(const f32x2*)(wts + cc + 2 * q), wb = *(const f32x2*)(wts + RC + cc + 2 * q), wcq = *(const f32x2*)(wts + 2 * RC + cc + 2 * q);
            const int cq = cl + 2 * q, grp = cq >> 7, k = cq & 127;
#pragma unroll
            for (int i = 0; i < 8; ++i) {
                f32x2 u = z[i][q] * wa + z[i + 1][q] * wb + z[i + 2][q] * wcq;
                if (grp == 0) { u.x = tanh_f(u.x); u.y = tanh_f(u.y); }
                else if (grp == 2) { u.x = sigmoid_f(u.x); u.y = sigmoid_f(u.y); }
                *(unsigned*)(AL + ((size_t)grp * NTOK + r0 + i) * 128 + k) = pk2(u.x, u.y);
            }
        }
    }
}

template <int CTRL> DI float dppf_(float x) { return __builtin_bit_cast(float, __builtin_amdgcn_mov_dpp(__builtin_bit_cast(int, x), CTRL, 0xf, 0xf, true)); }
template <int CTRL> DI float dpp_add(float x) { const int y = __builtin_amdgcn_mov_dpp(__builtin_bit_cast(int, x), CTRL, 0xf, 0xf, true); return x + __builtin_bit_cast(float, y); }
DI float red16(float x) { x = dpp_add<0xB1>(x); x = dpp_add<0x4E>(x); x = dpp_add<0x141>(x); x = dpp_add<0x140>(x); return x; }

constexpr int TC = 16;
DI float tred4(float q0, float q1, float q2, float q3, bool b0, bool b1) {
    const float ka = b0 ? q2 : q0, kb = b0 ? q3 : q1, sa = b0 ? q0 : q2, sb = b0 ? q1 : q3;
    const float a = ka + dppf_<0xB1>(sa), b = kb + dppf_<0xB1>(sb);
    float c = (b1 ? b : a) + dppf_<0x4E>(b1 ? a : b);
    c += dppf_<0x124>(c);
    c += dppf_<0x128>(c);
    return c;
}
DI f32x2 lo2(f32x4 v) { return __builtin_shufflevector(v, v, 0, 1); }
DI f32x2 hi2(f32x4 v) { return __builtin_shufflevector(v, v, 2, 3); }
struct ScanOps { f32x4 kk, rr, ww, bb, kd; float vv; };
struct ScanLd { f32x4 kk, r, dec, aa, kr, v; };
DI void scan_item(KP p, LAS unsigned char* lds, int latent, int sc, int qr, int tid) {
    const bf16_t* KK = (const bf16_t*)(p->ws + WS_KK); const bf16_t* R = (const bf16_t*)(p->ws + WS_R); const bf16_t* KR = (const bf16_t*)(p->ws + WS_KR);
    const bf16_t* VV = (const bf16_t*)(p->ws + WS_VV); const float* k_a = p->in[19];
    float* Y = (float*)(p->ws + WS_Y);
    const int b = sc >> 4, dir = (sc >> 3) & 1, h = sc & 7;
    const int T = latent ? DSEQ : SEQ; const size_t rowbase = latent ? (size_t)NCTX + (size_t)b * DSEQ : (size_t)b * SEQ;
    const float* DEC = (const float*)(p->ws + WS_DEC) + (size_t)dir * NTOK * 512; const bf16_t* AA = (const bf16_t*)(p->ws + WS_AA) + (size_t)dir * NTOK * 512;
    float* Yd = Y + (size_t)dir * NTOK * 512;
    LAS float* buf = (LAS float*)lds;
    LAS float* vb = (LAS float*)(lds + 2 * TC * 320 * 4);
    const int wave = tid >> 6, lane = tid & 63;
    const bool consumer = wave < 4;
    const int nchunk = T / TC;
    const int rl = lane >> 4, ks = lane & 15, row = 16 * qr + 4 * wave + rl;
    f32x2 S01 = {0, 0}, S23 = {0, 0};
    if (consumer && latent) { const f32x4 s4 = *(const f32x4*)(p->in[4] + ((((size_t)b * 2 + dir) * 8 + h) * 64 + row) * 64 + 4 * ks); S01 = lo2(s4); S23 = hi2(s4); }
    const int lt = tid - 256, lj = lt >> 4, li = lt & 15;
    ScanLd L0, L1; f32x4 ka4 = {0, 0, 0, 0};
    if (!consumer) ka4 = *(const f32x4*)(k_a + h * 64 + 4 * li);
    float* ybase = Yd + (rowbase)*512 + h * 64 + row;
    const bool kb0 = (ks & 1) != 0, kb1 = (ks & 2) != 0; const int ystep = 4 * (ks >> 2) + 2 * (ks & 1) + ((ks >> 1) & 1);
#define SCAN_LOAD(L, c) do { const int idx = (c) * TC + lj; const int tt = dir ? T - 1 - idx : idx; const size_t off = (rowbase + tt) * 512 + h * 64 + 4 * li; \
        L.kk = unpk4(*(const u32x2*)(KK + off)); L.r = unpk4(*(const u32x2*)(R + off)); L.dec = *(const f32x4*)(DEC + off); L.aa = unpk4(*(const u32x2*)(AA + off)); L.kr = unpk4(*(const u32x2*)(KR + off)); \
        if (lt < 64) { const int vj = lt >> 2, vq = lt & 3; const int idv = (c) * TC + vj; const int tv = dir ? T - 1 - idv : idv; L.v = unpk4(*(const u32x2*)(VV + (rowbase + tv) * 512 + h * 64 + 16 * qr + 4 * vq)); } } while (0)
#define SCAN_WRITE(L, bc, vc) do { const f32x4 bb_ = L.kk * L.aa; const f32x4 kd_ = L.kr * ((L.aa - 1.f) * ka4 + 1.f); LAS float* d_ = (bc) + lj * 320 + 4 * li; \
        *(LAS f32x4*)(d_) = L.kk; *(LAS f32x4*)(d_ + 64) = L.r; *(LAS f32x4*)(d_ + 128) = L.dec; *(LAS f32x4*)(d_ + 192) = bb_; *(LAS f32x4*)(d_ + 256) = kd_; \
        if (lt < 64) *(LAS f32x4*)((vc) + (lt >> 2) * 16 + 4 * (lt & 3)) = L.v; } while (0)
#define SCAN_LDOPS(o, bc, vc, j) do { const LAS float* d_ = (bc) + (j) * 320 + 4 * ks; o.kk = *(const LAS f32x4*)(d_); o.rr = *(const LAS f32x4*)(d_ + 64); o.ww = *(const LAS f32x4*)(d_ + 128); \
        o.bb = *(const LAS f32x4*)(d_ + 192); o.kd = *(const LAS f32x4*)(d_ + 256); o.vv = (vc)[(j) * 16 + 4 * wave + rl]; } while (0)
#define SCAN_COMPUTE(bc, vc, c) do { ScanOps oc, on, on2; SCAN_LDOPS(oc, bc, vc, 0); SCAN_LDOPS(on, bc, vc, 1); float ysel = 0.f; float yp0 = 0.f, yp1 = 0.f, yp2 = 0.f; \
        _Pragma("unroll") for (int j = 0; j < TC; ++j) { \
            if (j + 2 < TC) SCAN_LDOPS(on2, bc, vc, j + 2);     \
            f32x2 pq = S01 * lo2(oc.kk); pq = S23 * hi2(oc.kk) + pq; \
            const float sa = red16(pq.x + pq.y); \
            const f32x2 t01 = S01 * lo2(oc.ww) + lo2(oc.kd) * oc.vv, t23 = S23 * hi2(oc.ww) + hi2(oc.kd) * oc.vv; \
            S01 = t01 - lo2(oc.bb) * sa; S23 = t23 - hi2(oc.bb) * sa; \
            f32x2 yq = S01 * lo2(oc.rr); yq = S23 * hi2(oc.rr) + yq; \
            const float yp = yq.x + yq.y; \
            if ((j & 3) == 0) yp0 = yp; else if ((j & 3) == 1) yp1 = yp; else if ((j & 3) == 2) yp2 = yp; \
            else { const float yr = tred4(yp0, yp1, yp2, yp, kb0, kb1); ysel = ((ks >> 2) == (j >> 2)) ? yr : ysel; } \
            oc = on; on = on2; \
            asm volatile("" ::: "memory"); } \
        { const int idx = (c) * TC + ystep; const int tt = dir ? T - 1 - idx : idx; ybase[(size_t)tt * 512] = ysel; } } while (0)
    if (!consumer) { SCAN_LOAD(L0, 0); SCAN_LOAD(L1, 1); }
    for (int c = 0; c < nchunk; c += 2) {
        if (!consumer) SCAN_WRITE(L0, buf, vb);
        __syncthreads();
        if (!consumer) { if (c + 2 < nchunk) SCAN_LOAD(L0, c + 2); }
        else SCAN_COMPUTE(buf, vb, c);
        if (!consumer) SCAN_WRITE(L1, buf + TC * 320, vb + TC * 16);
        __syncthreads();
        if (!consumer) { if (c + 3 < nchunk) SCAN_LOAD(L1, c + 3); }
        else SCAN_COMPUTE(buf + TC * 320, vb + TC * 16, c + 1);
    }
#undef SCAN_LOAD
#undef SCAN_WRITE
#undef SCAN_LDOPS
#undef SCAN_COMPUTE
    if (consumer && !latent) *(f32x4*)(p->out + OUT_S + ((((size_t)b * 2 + dir) * 8 + h) * 64 + row) * 64 + 4 * ks) = (f32x4){S01.x, S01.y, S23.x, S23.y};
    __syncthreads();
}

constexpr int CS_L = 32, CS_LAT = 2048, CS_CHUNKS = 4096;
DI unsigned char* cs_mf(unsigned char* ws, int q) { return ws + 28 * MiB + (size_t)q * 8192; }
DI unsigned char* cs_q1(unsigned char* ws, int q) { return q < CS_LAT ? ws + 60 * MiB + (size_t)q * 4096 : ws + 76 * MiB + (size_t)(q - CS_LAT) * 4096; }
DI unsigned char* cs_q2(unsigned char* ws, int q) { return q < CS_LAT ? ws + 92 * MiB + (size_t)q * 4096 : ws + 108 * MiB + (size_t)(q - CS_LAT) * 4096; }
DI unsigned char* cs_nt(unsigned char* ws, int q) { return q < CS_LAT ? ws + 202 * MiB + (size_t)q * 8192 : ws + 234 * MiB + (size_t)(q - CS_LAT) * 8192; }
constexpr int CS_G = 51456;
DI bf16x8 frag_nat(const LAS unsigned char* img, int pitch, int rc, int s, int hh) { return *(const LAS bf16x8*)(img + rc * pitch + (16 * s + 8 * hh) * 2); }
DI bf16x8 frag_krow(const LAS unsigned char* img, int pitch, int rc, int s, int hh) {
    const s16x4 lo = *(const LAS s16x4*)(img + rc * pitch + (16 * s + 4 * hh) * 2), hi = *(const LAS s16x4*)(img + rc * pitch + (16 * s + 8 + 4 * hh) * 2);
    return __builtin_shufflevector(lo, hi, 0, 1, 2, 3, 4, 5, 6, 7); }
DI bf16x8 frag_tr(const LAS unsigned char* img, int pitch, int col0, int s, int lane) {
    const int i16 = lane & 15, tq = i16 >> 2, tp = i16 & 3, blk = (lane >> 4) & 1, hh = lane >> 5;
    const LAS unsigned char* bs = img + (16 * s + 4 * hh + tq) * pitch + (col0 + 16 * blk) * 2 + 8 * tp;
    const s16x4 lo = vtr(bs), hi = vtr(bs + 8 * pitch);
    return __builtin_shufflevector(lo, hi, 0, 1, 2, 3, 4, 5, 6, 7); }
template <int S> DI bf16x8 pack8(const f32x16& x, float sg) {
    u32x4 w; w.x = pk2(sg * x[8 * S], sg * x[8 * S + 1]); w.y = pk2(sg * x[8 * S + 2], sg * x[8 * S + 3]); w.z = pk2(sg * x[8 * S + 4], sg * x[8 * S + 5]); w.w = pk2(sg * x[8 * S + 6], sg * x[8 * S + 7]);
    return __builtin_bit_cast(bf16x8, w); }
template <int S> DI bf16x8 pack8lo(const f32x16& x, bf16x8 hi) {
    const u32x4 h = __builtin_bit_cast(u32x4, hi); float d[8];
#pragma unroll
    for (int j = 0; j < 4; ++j) { d[2 * j] = x[8 * S + 2 * j] - __builtin_bit_cast(float, h[j] << 16); d[2 * j + 1] = x[8 * S + 2 * j + 1] - __builtin_bit_cast(float, h[j] & 0xffff0000u); }
    u32x4 w; w.x = pk2(d[0], d[1]); w.y = pk2(d[2], d[3]); w.z = pk2(d[4], d[5]); w.w = pk2(d[6], d[7]);
    return __builtin_bit_cast(bf16x8, w); }
DI void lds_barrier() { asm volatile("s_waitcnt lgkmcnt(0)" ::: "memory"); __builtin_amdgcn_s_barrier(); asm volatile("" ::: "memory"); }
DI f32x16 zero16() { f32x16 z;
#pragma unroll
    for (int i = 0; i < 16; ++i) z[i] = 0.f;
    return z; }

DI void cs_phaseA(KP p, LAS unsigned char* lds, int tid, int qbase, int nit, int first, int stride) {
    const bf16_t* KK = (const bf16_t*)(p->ws + WS_KK); const bf16_t* R = (const bf16_t*)(p->ws + WS_R); const bf16_t* KR = (const bf16_t*)(p->ws + WS_KR);
    const bf16_t* VV = (const bf16_t*)(p->ws + WS_VV); const float* k_a = p->in[19];
    const int wave = tid >> 6, lane = tid & 63, g = wave >> 2, wq = wave & 3, tg = wq * 64 + lane, hh = lane >> 5, r32 = lane & 31;
    LAS unsigned char* L = lds + g * CS_G;
    LAS unsigned char* MKK = L, *MBT = L + 4608, *MKT = L + 2 * 4608, *MRT = L + 3 * 4608, *MBH = L + 4 * 4608, *MKH = L + 5 * 4608, *MVM = L + 6 * 4608;
    LAS float* AF = (LAS float*)(L + 32256);
    LAS unsigned char* ST = L + 36352, *SKK = ST + 2560, *SRB = ST + 2 * 2560, *SRK = ST + 3 * 2560;
    LAS float* SEG = (LAS float*)(L + 46592); LAS float* ELv = (LAS float*)(L + 48640);
    LAS unsigned char* SA = L + 48896;
    f32x2 lwN[4], kkN[4], aaN[4], krN[4], rN[4]; u32x4 vmN;
#define CSA_FETCH(it_) do { const int q_ = qbase + (it_) * 2 + g; const bool lat_ = q_ < CS_LAT; const int sc_ = lat_ ? (q_ >> 6) : ((q_ - CS_LAT) >> 3), ci_ = lat_ ? (q_ & 63) : (q_ & 7), TT_ = lat_ ? DSEQ : SEQ; \
        const int b_ = sc_ >> 4, dir_ = (sc_ >> 3) & 1, h_ = sc_ & 7; const int rb_ = lat_ ? NCTX + b_ * DSEQ : b_ * SEQ; \
          \
        const int t0_ = dir_ ? TT_ - 1 - ci_ * CS_L : ci_ * CS_L, sg_ = dir_ ? -512 : 512; \
        const unsigned ub_ = (unsigned)((rb_ + t0_) * 512 + h_ * 64); \
        const unsigned o0_ = ub_ + (unsigned)(sg_ * 4 * (tg >> 5) + 2 * (tg & 31)); \
        const float* DEC_ = (const float*)(p->ws + WS_DEC) + (size_t)dir_ * NTOK * 512; const bf16_t* AA_ = (const bf16_t*)(p->ws + WS_AA) + (size_t)dir_ * NTOK * 512; \
        _Pragma("unroll") for (int j = 0; j < 4; ++j) { const unsigned off = o0_ + (unsigned)(sg_ * j); \
            lwN[j] = *(const f32x2*)(DEC_ + off); kkN[j] = ldh2(KK + off); aaN[j] = ldh2(AA_ + off); krN[j] = ldh2(KR + off); rN[j] = ldh2(R + off); } \
        vmN = *(const u32x4*)(VV + (ub_ + (unsigned)(sg_ * (tg >> 3) + (tg & 7) * 8))); } while (0)
    if (first < nit) CSA_FETCH(first);
    for (int it = first; it < nit; it += stride) {
        const int q = qbase + it * 2 + g; const bool lat = q < CS_LAT;
        const int sc = lat ? (q >> 6) : ((q - CS_LAT) >> 3), ci = lat ? (q & 63) : (q & 7), TT = lat ? DSEQ : SEQ;
        const int b = sc >> 4, dir = (sc >> 3) & 1, h = sc & 7;
        const size_t rowbase = lat ? (size_t)NCTX + (size_t)b * DSEQ : (size_t)b * SEQ;
        const float* DEC = (const float*)(p->ws + WS_DEC) + (size_t)dir * NTOK * 512; const bf16_t* AA = (const bf16_t*)(p->ws + WS_AA) + (size_t)dir * NTOK * 512;
        {
            const int kp = tg & 31, seg = tg >> 5;
            f32x2 lw[4], kk2[4], aa2[4], kr2[4], r2[4];
#pragma unroll
            for (int j = 0; j < 4; ++j) { lw[j] = lwN[j]; kk2[j] = kkN[j]; aa2[j] = aaN[j]; kr2[j] = krN[j]; r2[j] = rN[j]; }
            const u32x4 vmC = vmN;
            if (it + stride < nit) CSA_FETCH(it + stride);
            f32x2 ss = {0.f, 0.f};
#pragma unroll
            for (int j = 0; j < 4; ++j) { lw[j].x = __logf(lw[j].x); lw[j].y = __logf(lw[j].y); ss += lw[j]; }
            *(LAS f32x2*)(SEG + seg * 64 + 2 * kp) = ss;
            { const int i = tg >> 3, v0 = (tg & 7) * 8; *(LAS u32x4*)(MVM + i * 144 + v0 * 2) = vmC; }
            lds_barrier();
            f32x2 pre = {0.f, 0.f}, tot = {0.f, 0.f};
#pragma unroll
            for (int s8 = 0; s8 < 8; ++s8) { const f32x2 v = *(const LAS f32x2*)(SEG + s8 * 64 + 2 * kp); tot += v; if (s8 < seg) pre += v; }
            if (seg == 0) *(LAS f32x2*)(ELv + 2 * kp) = (f32x2){__expf(tot.x), __expf(tot.y)};
            const f32x2 ka = *(const f32x2*)(k_a + h * 64 + 2 * kp);
            f32x2 cwp = pre;
#pragma unroll
            for (int j = 0; j < 4; ++j) {
                const f32x2 cw = cwp + lw[j];
                const f32x2 E = {__expf(cw.x), __expf(cw.y)}, Ei = {__expf(-cw.x), __expf(-cw.y)}, Ep = {__expf(cwp.x), __expf(cwp.y)}, Eh = {__expf(tot.x - cw.x), __expf(tot.y - cw.y)};
                const f32x2 bb = kk2[j] * aa2[j], kd = kr2[j] * ((aa2[j] - 1.f) * ka + 1.f);
                const int o = (4 * seg + j) * 144 + 4 * kp;
                const f32x2 x0 = kk2[j] * Ep, x1 = bb * Ei, x2 = kd * Ei, x3 = r2[j] * E, x4 = bb * Eh, x5 = kd * Eh;
                *(LAS unsigned*)(MKK + o) = pk2(x0.x, x0.y); *(LAS unsigned*)(MBT + o) = pk2(x1.x, x1.y); *(LAS unsigned*)(MKT + o) = pk2(x2.x, x2.y);
                *(LAS unsigned*)(MRT + o) = pk2(x3.x, x3.y); *(LAS unsigned*)(MBH + o) = pk2(x4.x, x4.y); *(LAS unsigned*)(MKH + o) = pk2(x5.x, x5.y);
                cwp = cw;
            }
        }
        lds_barrier();
        {
            const LAS unsigned char* ia = wq < 2 ? MKK : MRT; const LAS unsigned char* ib = (wq & 1) ? MKT : MBT;
            f32x16 acc = zero16();
#pragma unroll
            for (int s4 = 0; s4 < 4; ++s4) acc = MFMA32(frag_nat(ia, 144, r32, s4, hh), frag_nat(ib, 144, r32, s4, hh), acc);
#pragma unroll
            for (int i = 0; i < 16; ++i) { const int row = crow(i, hh); const bool keep = wq < 2 ? (row > r32) : (row >= r32); const float v = keep ? acc[i] : 0.f;
                if (wq == 0) { AF[row * 32 + r32] = v; *(LAS unsigned short*)(SA + row * 80 + r32 * 2) = (row >= 16 && r32 < 16) ? (unsigned short)(pk2(v, 0.f) & 0xffffu) : (unsigned short)0; }
                else *(LAS unsigned short*)((wq == 1 ? SKK : (wq == 2 ? SRB : SRK)) + row * 80 + r32 * 2) = (unsigned short)(pk2(v, 0.f) & 0xffffu); }
        }
        lds_barrier();
        f32x16 X = zero16(), NT0 = zero16(), NT1 = zero16(), Q2 = zero16();
        const int c = wq & 1;
        if (wq == 0) {
            const int blk = r32 >> 4, cc = r32 & 15;
            float Tc[16];
#pragma unroll
            for (int i = 0; i < 16; ++i) {
                float a4[4] = {(i == cc) ? 1.f : 0.f, 0.f, 0.f, 0.f};
#pragma unroll
                for (int j4 = 0; j4 < (i + 3) / 4; ++j4) { const f32x4 ar = *(const LAS f32x4*)(AF + (16 * blk + i) * 32 + 16 * blk + 4 * j4);
#pragma unroll
                    for (int e = 0; e < 4; ++e) if (4 * j4 + e < i) a4[e] -= ar[e] * Tc[4 * j4 + e]; }
                const float a = (a4[0] + a4[1]) + (a4[2] + a4[3]);
                Tc[i] = a;
                if (lane < 32) { *(LAS unsigned short*)(ST + (16 * blk + i) * 80 + (16 * blk + cc) * 2) = (unsigned short)(pk2(a, 0.f) & 0xffffu);
                                 *(LAS unsigned short*)(ST + (16 * blk + i) * 80 + (16 * (1 - blk) + cc) * 2) = (unsigned short)0; }
            }
            asm volatile("s_waitcnt lgkmcnt(0)" ::: "memory");
            f32x16 E = zero16();
            E = MFMA32(frag_krow(SA, 80, r32, 0, hh), frag_tr(ST, 80, 0, 0, lane), E); E = MFMA32(frag_krow(SA, 80, r32, 1, hh), frag_tr(ST, 80, 0, 1, lane), E);
#pragma unroll
            for (int i = 0; i < 16; ++i) E[i] = ((crow(i, hh) == r32) ? 1.f : 0.f) - E[i];
            f32x16 Tm = zero16();
            Tm = MFMA32(frag_krow(ST, 80, r32, 0, hh), pack8<0>(E, 1.f), Tm); Tm = MFMA32(frag_krow(ST, 80, r32, 1, hh), pack8<1>(E, 1.f), Tm);
            asm volatile("s_waitcnt lgkmcnt(0)" ::: "memory");
#pragma unroll
            for (int i = 0; i < 16; ++i) *(LAS unsigned short*)(ST + crow(i, hh) * 80 + r32 * 2) = (unsigned short)(pk2(Tm[i], 0.f) & 0xffffu);
        } else if (wq >= 2) {
#pragma unroll
            for (int s2 = 0; s2 < 2; ++s2) {
                const bf16x8 vm = frag_tr(MVM, 144, 32 * c, s2, lane);
                X = MFMA32(frag_krow(SKK, 80, r32, s2, hh), vm, X);
                Q2 = MFMA32(frag_krow(SRK, 80, r32, s2, hh), vm, Q2);
                NT0 = MFMA32(frag_tr(MKH, 144, 0, s2, lane), vm, NT0);
                NT1 = MFMA32(frag_tr(MKH, 144, 32, s2, lane), vm, NT1);
            }
        }
        lds_barrier();
        if (wq < 2) {
            f32x16 P1 = zero16();
#pragma unroll
            for (int s2 = 0; s2 < 2; ++s2) P1 = MFMA32(frag_krow(ST, 80, r32, s2, hh), frag_tr(MKK, 144, 32 * c, s2, lane), P1);
            const bf16x8 n0 = pack8<0>(P1, -1.f), n1 = pack8<1>(P1, -1.f);
            f32x16 Q1t;
#pragma unroll
            for (int g4 = 0; g4 < 4; ++g4) { const u32x2 w = *(const LAS u32x2*)(MRT + r32 * 144 + (32 * c + 8 * g4 + 4 * hh) * 2); const f32x4 f = unpk4(w);
                Q1t[4 * g4] = f.x; Q1t[4 * g4 + 1] = f.y; Q1t[4 * g4 + 2] = f.z; Q1t[4 * g4 + 3] = f.w; }
            Q1t = MFMA32(n0, frag_krow(SRB, 80, r32, 0, hh), Q1t); Q1t = MFMA32(n1, frag_krow(SRB, 80, r32, 1, hh), Q1t);
            u32x4* q1f = (u32x4*)cs_q1(p->ws, q) + (c * 2) * 64 + lane;
            q1f[0] = __builtin_bit_cast(u32x4, pack8<0>(Q1t, 1.f)); q1f[64] = __builtin_bit_cast(u32x4, pack8<1>(Q1t, 1.f));
#pragma unroll
            for (int bq = 0; bq < 2; ++bq) {
                f32x16 M = zero16();
                if (bq == c) {
#pragma unroll
                    for (int i = 0; i < 16; ++i) M[i] = (crow(i, hh) == r32) ? ELv[32 * c + r32] : 0.f;
                }
                M = MFMA32(n0, frag_tr(MBH, 144, 32 * bq, 0, lane), M); M = MFMA32(n1, frag_tr(MBH, 144, 32 * bq, 1, lane), M);
                u32x4* mf = (u32x4*)cs_mf(p->ws, q) + ((c * 2 + bq) * 2) * 64 + lane;
                mf[0] = __builtin_bit_cast(u32x4, pack8<0>(M, 1.f)); mf[64] = __builtin_bit_cast(u32x4, pack8<1>(M, 1.f));
            }
        } else {
            f32x16 P2 = zero16();
            P2 = MFMA32(frag_krow(ST, 80, r32, 0, hh), pack8<0>(X, 1.f), P2); P2 = MFMA32(frag_krow(ST, 80, r32, 1, hh), pack8<1>(X, 1.f), P2);
            const bf16x8 n0 = pack8<0>(P2, -1.f), n1 = pack8<1>(P2, -1.f);
            Q2 = MFMA32(frag_krow(SRB, 80, r32, 0, hh), n0, Q2); Q2 = MFMA32(frag_krow(SRB, 80, r32, 1, hh), n1, Q2);
            NT0 = MFMA32(frag_tr(MBH, 144, 0, 0, lane), n0, NT0); NT0 = MFMA32(frag_tr(MBH, 144, 0, 1, lane), n1, NT0);
            NT1 = MFMA32(frag_tr(MBH, 144, 32, 0, lane), n0, NT1); NT1 = MFMA32(frag_tr(MBH, 144, 32, 1, lane), n1, NT1);
            unsigned* q2f = (unsigned*)cs_q2(p->ws, q) + c * 512 + lane;
#pragma unroll
            for (int i = 0; i < 8; ++i) q2f[i * 64] = pk2(Q2[2 * i], Q2[2 * i + 1]);
            unsigned* ntf = (unsigned*)cs_nt(p->ws, q) + (c * 2) * 512 + lane;
#pragma unroll
            for (int i = 0; i < 8; ++i) { ntf[i * 64] = pk2(NT0[2 * i], NT0[2 * i + 1]); ntf[512 + i * 64] = pk2(NT1[2 * i], NT1[2 * i + 1]); }
        }
        lds_barrier();
    }
#undef CSA_FETCH
}


constexpr int CSB_SLOT = 24576;
DI void cs_phaseB(KP p, LAS unsigned char* lds, int latent, int sc, int tid) {
    const int wave = tid >> 6, lane = tid & 63, hh = lane >> 5, r32 = lane & 31;
    const int nch = latent ? 64 : 8, q0 = latent ? sc * 64 : CS_LAT + sc * 8, TT = latent ? DSEQ : SEQ;
    const int b = sc >> 4, dir = (sc >> 3) & 1, h = sc & 7, c = wave & 1;
    const size_t rowbase = latent ? (size_t)NCTX + (size_t)b * DSEQ : (size_t)b * SEQ;
    const bool consumer = wave < 2;
    float* Yu = p->out + (size_t)dir * NTOK * 512 + rowbase * 512 + h * 64 + 32 * c;
    const unsigned ylane = (unsigned)((dir ? 4 * (1 - hh) : 4 * hh) * 512 + r32);
    unsigned yv[8];
#pragma unroll
    for (int k = 0; k < 8; ++k) { const int rr_ = 2 * (k & 1) + 8 * (k >> 1); yv[k] = (ylane + (unsigned)((dir ? TT - CS_L + 27 - rr_ : rr_) * 512)) * 4u; }
    const unsigned ystepb = dir ? 0u - (unsigned)(CS_L * 512 * 4) : (unsigned)(CS_L * 512 * 4);
    f32x16 Z0 = zero16(), Z1 = zero16();
    if (consumer && latent) { const float* s0 = p->in[4] + ((((size_t)b * 2 + dir) * 8 + h) * 64 + 32 * c + r32) * 64;
#pragma unroll
      for (int g4 = 0; g4 < 4; ++g4) { const f32x4 a = *(const f32x4*)(s0 + 8 * g4 + 4 * hh), bq = *(const f32x4*)(s0 + 32 + 8 * g4 + 4 * hh);
          Z0[4 * g4] = a.x; Z0[4 * g4 + 1] = a.y; Z0[4 * g4 + 2] = a.z; Z0[4 * g4 + 3] = a.w; Z1[4 * g4] = bq.x; Z1[4 * g4 + 1] = bq.y; Z1[4 * g4 + 2] = bq.z; Z1[4 * g4 + 3] = bq.w; } }
    const int lt = tid - 128;
    u32x4 RG[2][4];
#define CSB_LOADQ(set, ch) do { const int q_ = q0 + (ch); _Pragma("unroll") for (int k_ = 0; k_ < 4; ++k_) { const int pi_ = lt + 384 * k_; \
        const unsigned char* src_ = pi_ < 512 ? cs_mf(p->ws, q_) + pi_ * 16 : (pi_ < 768 ? cs_q1(p->ws, q_) + (pi_ - 512) * 16 : (pi_ < 1280 ? cs_nt(p->ws, q_) + (pi_ - 768) * 16 : cs_q2(p->ws, q_) + (pi_ - 1280) * 16)); \
        RG[set][k_] = *(const u32x4*)src_; } } while (0)
#define CSB_WRITEQ(set, slot) do { _Pragma("unroll") for (int k_ = 0; k_ < 4; ++k_) *(LAS u32x4*)(lds + (slot) * CSB_SLOT + (lt + 384 * k_) * 16) = RG[set][k_]; } while (0)
    if (!consumer) { CSB_LOADQ(0, 0); CSB_LOADQ(1, 1); CSB_WRITEQ(0, 0); CSB_LOADQ(0, 2); }
    else __builtin_amdgcn_s_setprio(3);
    for (int ci0 = 0; ci0 < nch; ci0 += 2) {
#pragma unroll
        for (int u = 0; u < 2; ++u) {
            const int ci = ci0 + u;
            lds_barrier();
            if (!consumer) {
                if (ci + 1 < nch) { CSB_WRITEQ((u + 1) & 1, (ci + 1) & 1); if (ci + 3 < nch) CSB_LOADQ((u + 1) & 1, ci + 3); }
            } else {
                const LAS unsigned char* sl = lds + (ci & 1) * CSB_SLOT;
                bf16x8 MF[8], Q1[4]; f32x16 Y, N0, N1;
#pragma unroll
                for (int i = 0; i < 8; ++i) MF[i] = *(const LAS bf16x8*)(sl + (i * 64 + lane) * 16);
#pragma unroll
                for (int i = 0; i < 4; ++i) Q1[i] = *(const LAS bf16x8*)(sl + 8192 + (i * 64 + lane) * 16);
#pragma unroll
                for (int i = 0; i < 8; ++i) { const unsigned w0 = *(const LAS unsigned*)(sl + 12288 + ((c * 2) * 512 + i * 64 + lane) * 4), w1 = *(const LAS unsigned*)(sl + 12288 + ((c * 2 + 1) * 512 + i * 64 + lane) * 4),
                                                         w2 = *(const LAS unsigned*)(sl + 20480 + (c * 512 + i * 64 + lane) * 4);
                    N0[2 * i] = __builtin_bit_cast(float, w0 << 16); N0[2 * i + 1] = __builtin_bit_cast(float, w0 & 0xffff0000u);
                    N1[2 * i] = __builtin_bit_cast(float, w1 << 16); N1[2 * i + 1] = __builtin_bit_cast(float, w1 & 0xffff0000u);
                    Y[2 * i] = __builtin_bit_cast(float, w2 << 16); Y[2 * i + 1] = __builtin_bit_cast(float, w2 & 0xffff0000u); }
                const bf16x8 z00 = pack8<0>(Z0, 1.f), z01 = pack8<1>(Z0, 1.f), z10 = pack8<0>(Z1, 1.f), z11 = pack8<1>(Z1, 1.f);
                const bf16x8 l00 = pack8lo<0>(Z0, z00), l01 = pack8lo<1>(Z0, z01), l10 = pack8lo<0>(Z1, z10), l11 = pack8lo<1>(Z1, z11);
                Y = MFMA32(Q1[0], z00, Y); Y = MFMA32(Q1[1], z01, Y); Y = MFMA32(Q1[2], z10, Y); Y = MFMA32(Q1[3], z11, Y);
                N0 = MFMA32(MF[0], z00, N0); N0 = MFMA32(MF[1], z01, N0); N0 = MFMA32(MF[4], z10, N0); N0 = MFMA32(MF[5], z11, N0);
                N0 = MFMA32(MF[0], l00, N0); N0 = MFMA32(MF[1], l01, N0); N0 = MFMA32(MF[4], l10, N0); N0 = MFMA32(MF[5], l11, N0);
                N1 = MFMA32(MF[2], z00, N1); N1 = MFMA32(MF[3], z01, N1); N1 = MFMA32(MF[6], z10, N1); N1 = MFMA32(MF[7], z11, N1);
                N1 = MFMA32(MF[2], l00, N1); N1 = MFMA32(MF[3], l01, N1); N1 = MFMA32(MF[6], l10, N1); N1 = MFMA32(MF[7], l11, N1);
                Z0 = N0; Z1 = N1;
                if (dir) {
#pragma unroll
                    for (int i = 0; i < 16; ++i) *(float*)((char*)Yu + yv[(i >> 2) * 2 + ((i & 3) >> 1)] - 2048 * (i & 1)) = Y[i];
                } else {
#pragma unroll
                    for (int i = 0; i < 16; ++i) *(float*)((char*)Yu + yv[(i >> 2) * 2 + ((i & 3) >> 1)] + 2048 * (i & 1)) = Y[i];
                }
#pragma unroll
                for (int k = 0; k < 8; ++k) yv[k] += ystepb;
            }
        }
    }
#undef CSB_LOADQ
#undef CSB_WRITEQ
    __builtin_amdgcn_s_setprio(0);
    if (consumer && !latent) { float* so = p->out + OUT_S + ((((size_t)b * 2 + dir) * 8 + h) * 64 + 32 * c + r32) * 64;
#pragma unroll
        for (int g4 = 0; g4 < 4; ++g4) { *(f32x4*)(so + 8 * g4 + 4 * hh) = (f32x4){Z0[4 * g4], Z0[4 * g4 + 1], Z0[4 * g4 + 2], Z0[4 * g4 + 3]};
                                          *(f32x4*)(so + 32 + 8 * g4 + 4 * hh) = (f32x4){Z1[4 * g4], Z1[4 * g4 + 1], Z1[4 * g4 + 2], Z1[4 * g4 + 3]}; } }
    __syncthreads();
}

DI void post_row(KP p, int r, int lane) {
    const float* Y = p->out; const bf16_t* R = (const bf16_t*)(p->ws + WS_R); const bf16_t* KR = (const bf16_t*)(p->ws + WS_KR);
    const bf16_t* VV = (const bf16_t*)(p->ws + WS_VV); const bf16_t* AA = (const bf16_t*)(p->ws + WS_AA); const bf16_t* G = (const bf16_t*)(p->ws + WS_G);
    const float* k_a = p->in[19]; const float* r_k = p->in[20]; const float* lng = p->in[21]; const float* lnb = p->in[22];
    bf16_t* MIX = (bf16_t*)(p->ws + WS_MIX);
    const int c = lane * 8; const size_t off = (size_t)r * 512 + c;
    float y[8], rr[8], kr[8], vv[8], a0[8], a1[8], gg[8], ka[8], rk[8], lg[8], lb[8];
#define LD8(dst, ptr) do { const f32x4 _a = *(const f32x4*)(ptr), _b = *(const f32x4*)((ptr) + 4); dst[0] = _a.x; dst[1] = _a.y; dst[2] = _a.z; dst[3] = _a.w; dst[4] = _b.x; dst[5] = _b.y; dst[6] = _b.z; dst[7] = _b.w; } while (0)
#define LD8H(dst, ptr) do { const u32x4 _w = *(const u32x4*)(ptr); const f32x4 _a = unpk4((u32x2){_w.x, _w.y}), _b = unpk4((u32x2){_w.z, _w.w}); dst[0] = _a.x; dst[1] = _a.y; dst[2] = _a.z; dst[3] = _a.w; dst[4] = _b.x; dst[5] = _b.y; dst[6] = _b.z; dst[7] = _b.w; } while (0)
    LD8(y, Y + off); LD8(rr, Y + (size_t)NTOK * 512 + off);
#pragma unroll
    for (int j = 0; j < 8; ++j) y[j] += rr[j];
    LD8H(rr, R + off); LD8H(kr, KR + off); LD8H(vv, VV + off); LD8H(a0, AA + off); LD8H(a1, AA + (size_t)NTOK * 512 + off); LD8H(gg, G + off);
    LD8(ka, k_a + c); LD8(rk, r_k + c); LD8(lg, lng + c); LD8(lb, lnb + c);
#undef LD8
#undef LD8H
    float s = 0.f, d0 = 0.f, d1 = 0.f;
#pragma unroll
    for (int j = 0; j < 8; ++j) { s += y[j]; const float q = rr[j] * kr[j] * rk[j]; d0 += q * (1.f + (a0[j] - 1.f) * ka[j]); d1 += q * (1.f + (a1[j] - 1.f) * ka[j]); }
    float bd = d0 + d1;
    s += __shfl_xor(s, 1); s += __shfl_xor(s, 2); s += __shfl_xor(s, 4);
    bd += __shfl_xor(bd, 1); bd += __shfl_xor(bd, 2); bd += __shfl_xor(bd, 4);
    const float mu = s * (1.f / 64.f);
    float q2 = 0.f;
#pragma unroll
    for (int j = 0; j < 8; ++j) { y[j] -= mu; q2 += y[j] * y[j]; }
    q2 += __shfl_xor(q2, 1); q2 += __shfl_xor(q2, 2); q2 += __shfl_xor(q2, 4);
    const float rs = rsqrtf(q2 * (1.f / 64.f) + GN_EPS);
    float o[8];
#pragma unroll
    for (int j = 0; j < 8; ++j) o[j] = (y[j] * rs * lg[j] + lb[j] + bd * vv[j]) * gg[j];
    *(u32x4*)(MIX + (size_t)r * D + 512 + c) = (u32x4){pk2(o[0], o[1]), pk2(o[2], o[3]), pk2(o[4], o[5]), pk2(o[6], o[7])};
}

DI void act_fix(KP p, int pm, int e, int c) {
    const float* EDGE = (const float*)(p->ws + WS_EDGE); bf16_t* ACT = (bf16_t*)(p->ws + WS_ACT); const float* wc = p->in[27];
    const bool need = e == 0 ? (pm != 16 && pm != 24) : (pm != 23 && pm != 31);
    if (!need) return;
    const int r = pm * 256 + (e ? 255 : 0), nbpm = e ? pm + 1 : pm - 1;
    const float* nb = EDGE + ((size_t)nbpm * 2 + (1 - e)) * DFF + c;
    const float* eu = EDGE + ((size_t)pm * 2 + e) * DFF + 64 * DFF + c; const float* e3 = eu + 64 * DFF;
    const float* w = wc + (e ? 2 * DFF : 0) + c;
    float o[8];
#pragma unroll
    for (int j = 0; j < 8; ++j) o[j] = silu_f(eu[j] + w[j] * nb[j]) * e3[j];
    *(u32x4*)(ACT + (size_t)r * DFF + c) = (u32x4){pk2(o[0], o[1]), pk2(o[2], o[3]), pk2(o[4], o[5]), pk2(o[6], o[7])};
}

template <int NR>
DI void final_rows(KP p, int rbase, int rstride, int lane) {
    const float* MODb = (const float*)(p->ws + WS_MOD);
    const bf16_t* PART = (const bf16_t*)(p->ws + WS_PART); const float* nf = p->in[29];
    f32x4 v[NR][4]; u32x2 p0[NR][4], p1[NR][4];
#pragma unroll
    for (int q = 0; q < NR; ++q) { const int r = rbase + q * rstride; const f32x4* xr = (const f32x4*)(p->out + (size_t)r * D) + lane;
#pragma unroll
        for (int j = 0; j < 4; ++j) { v[q][j] = xr[64 * j]; p0[q][j] = *((const u32x2*)(PART + (size_t)r * D) + lane + 64 * j); p1[q][j] = *((const u32x2*)(PART + (size_t)(NTOK + r) * D) + lane + 64 * j); } }
    float s[NR];
#pragma unroll
    for (int q = 0; q < NR; ++q) { const int r = rbase + q * rstride; const float* MOD = MODb + midx_of(r) * 6144; s[q] = 0.f;
#pragma unroll
        for (int j = 0; j < 4; ++j) { const f32x4 gt = *((const f32x4*)(MOD + 5 * D) + lane + 64 * j); v[q][j] = v[q][j] + gt * (unpk4(p0[q][j]) + unpk4(p1[q][j]));
            s[q] += (v[q][j].x * v[q][j].x + v[q][j].y * v[q][j].y) + (v[q][j].z * v[q][j].z + v[q][j].w * v[q][j].w); } }
#pragma unroll
    for (int o = 1; o < 64; o <<= 1) {
#pragma unroll
        for (int q = 0; q < NR; ++q) s[q] += __shfl_xor(s[q], o); }
#pragma unroll
    for (int q = 0; q < NR; ++q) { const int r = rbase + q * rstride; f32x4* xr = (f32x4*)(p->out + (size_t)r * D) + lane; const float rstd = rsqrtf(s[q] * (1.f / D) + EPS);
#pragma unroll
        for (int j = 0; j < 4; ++j) xr[64 * j] = v[q][j] * rstd * *((const f32x4*)nf + lane + 64 * j); }
}

DI int lane_id() { int l; asm volatile("v_mbcnt_lo_u32_b32 %0, -1, 0\n\tv_mbcnt_hi_u32_b32 %0, -1, %0" : "=v"(l)); return l; }
#define XB_TMO      128
#define XB_XCNT(j)  (256  + 64 * (j))
#define XB_XSUB(j)  (1280 + 64 * (j))
#define XB_XGEN(j)  (2304 + 64 * (j))
#define XB_TOP      3328
#define XB_TOPGEN   3392
#define XB_SUBBAR   3520
#define XB_SPIN_CAP (1u << 18)
DI unsigned xb_ld(unsigned* p)              { return __hip_atomic_load(p, __ATOMIC_RELAXED, __HIP_MEMORY_SCOPE_AGENT); }
DI unsigned xb_add(unsigned* p, unsigned v) { return __hip_atomic_fetch_add(p, v, __ATOMIC_RELAXED, __HIP_MEMORY_SCOPE_AGENT); }
DI unsigned xb_xcc_id() { return (unsigned)__builtin_amdgcn_s_getreg((3 << 11) | 20) & 0xFu; }
#define XB_SPIN(cond, bar) do { unsigned _sp = 0; while (cond) { __builtin_amdgcn_s_sleep(1); \
    if ((++_sp & 255u) == 0u) { if (xb_ld(&(bar)[XB_TMO])) break; if (_sp > XB_SPIN_CAP) { atomicAdd(&(bar)[XB_TMO], 1u); break; } } } } while (0)
DI void xcd_barrier_complete(unsigned* bar, unsigned x, unsigned G, unsigned& nloc, unsigned& nx) {
    unsigned sum, cnt, mine, sp = 0u;
    for (;;) {
        sum = 0u; cnt = 0u; mine = 0u;
#pragma unroll
        for (unsigned j = 0; j < 16; ++j) { const unsigned c = xb_ld(&bar[XB_XCNT(j)]); sum += c; cnt += (c > 0u) ? 1u : 0u; mine = (j == x) ? c : mine; }
        if (sum == G) break;
        __builtin_amdgcn_s_sleep(1);
        if ((++sp & 255u) == 0u) { if (xb_ld(&bar[XB_TMO])) break; if (sp > XB_SPIN_CAP) { atomicAdd(&bar[XB_TMO], 1u); break; } }
    }
    nloc = mine > 0u ? mine : 1u; nx = cnt > 0u ? cnt : 1u;
}
DI void grid_bar(unsigned* bar, volatile LAS unsigned* st, unsigned G, int wave_s) {
    asm volatile("s_waitcnt vmcnt(0)" ::: "memory");
    __syncthreads();
    int t = wave_s * 64 + lane_id(); asm volatile("" : "+v"(t));
    if (t == 0) {
        __builtin_amdgcn_s_waitcnt(0);
        const unsigned x = xb_xcc_id();
        unsigned nloc = st[0], nx = st[1];
        if (nloc == 0u) { xcd_barrier_complete(bar, x, G, nloc, nx); st[0] = nloc; st[1] = nx; }
        const unsigned old = xb_add(&bar[XB_XSUB(x)], 1u);
        const unsigned gen = old / nloc;
        if (old + 1u == (gen + 1u) * nloc) {
            __builtin_amdgcn_fence(__ATOMIC_RELEASE, "agent");
            asm volatile("s_waitcnt vmcnt(0)" ::: "memory");
            const unsigned og = xb_add(&bar[XB_TOP], 1u);
            const unsigned tg = og / nx;
            if (og + 1u == (tg + 1u) * nx) xb_add(&bar[XB_TOPGEN], 1u);
            else XB_SPIN(xb_ld(&bar[XB_TOPGEN]) == tg, bar);
            __builtin_amdgcn_fence(__ATOMIC_ACQUIRE, "agent");
            xb_add(&bar[XB_XGEN(x)], 1u);
            asm volatile("s_waitcnt vmcnt(0)" ::: "memory");
        } else {
            XB_SPIN(xb_ld(&bar[XB_XGEN(x)]) == gen, bar);
            __builtin_amdgcn_fence(__ATOMIC_ACQUIRE, "agent");
            asm volatile("s_waitcnt vmcnt(0)" ::: "memory");
        }
    }
    __syncthreads();
}

__global__ void __launch_bounds__(512, 2) fwd_megakernel(Params kparams) {
    const KP kp0 = (KP)__builtin_amdgcn_kernarg_segment_ptr();
    extern __shared__ __attribute__((aligned(16))) unsigned char lds_raw[];
    LAS unsigned char* lds = (LAS unsigned char*)lds_raw;
    const int wave_s = __builtin_amdgcn_readfirstlane((int)threadIdx.x >> 6);
    volatile LAS unsigned* xbst = (volatile LAS unsigned*)(lds + LDS_XB);
    {
        int t0_ = wave_s * 64 + lane_id();
        if (t0_ == 0) { xbst[0] = 0u; xbst[1] = 0u; (void)xb_add((unsigned*)(kp0->ws + WS_BAR) + XB_XCNT(xb_xcc_id()), 1u); }
        __syncthreads();
    }
#define GRID_SYNC() grid_bar((unsigned*)(kp0->ws + WS_BAR), xbst, (unsigned)G, wave_s)
    const int G = gridDim.x, bx = blockIdx.x, NGW = G * 8, NGT = G * 512;
#define PH_VARS KP p = kp0; asm volatile("" : "+s"(p)); unsigned char* ws = p->ws; (void)ws; \
    int tid = wave_s * 64 + lane_id(); asm volatile("" : "+v"(tid)); const int lane = tid & 63, wave = wave_s, gw = bx * 8 + wave, gtid = bx * 512 + tid; (void)lane; (void)gw; (void)gtid;

    const bool defer_ffn = (G == 256);
    { PH_VARS phase0(p, lds, gw, NGW, gtid, NGT, wave, lane, defer_ffn); }
    GRID_SYNC();
    if (G > (1 << 20)) cg::this_grid().sync();
    { PH_VARS for (int r = gw; r < NTOK; r += 4 * NGW) norm_rows<0, 4>(p, r, NGW, lane, p->in[9], 0, D, 0, (bf16_t*)(ws + WS_H), nullptr); }
    GRID_SYNC();
    {
        PH_VARS
        pg8::Gemm g{(const bf16_t*)(ws + WS_H), (const bf16_t*)(ws + WS_WTIN), D, D, D};
        pg8::SchedPlain S; S.o.init(NTOK / 256, NINP / 256, G, bx);
        pg8::EpiIn E{(bf16_t*)(ws + WS_Q), (bf16_t*)(ws + WS_ZR), p->out + OUT_K, 0.125f * LOG2E};
        pg8::gemm_phase(lds, g, S, E, tid);
        if (defer_ffn && bx >= 192) ffn_transposes(p, lds, 0, (bx - 192) * 8 + wave, 64 * 8, wave, lane);
    }
    GRID_SYNC();
    {
        PH_VARS
        LAS float* rpbL = (LAS float*)lds;
        for (int i = tid; i < 8 * 465; i += 512) rpbL[i] = p->in[23][i] * LOG2E;
        __syncthreads();
        LAS unsigned char* vbuf = lds + 16384 + wave * 4608;
        LAS float* xch = (LAS float*)(lds + 65536) + (wave & 3) * 2176;
        const int vb = (G & 7) == 0 ? (bx & 7) * (G >> 3) + (bx >> 3) : bx;
        for (int u0 = vb * 4; u0 < 1024; u0 += G * 4) {
            if (wave < 4) { attn_unit<true, 2>(p, vbuf, rpbL, u0 + wave, lane, 0, 20, xch); attn_unit<false, 0>(p, vbuf, rpbL, u0 + wave, lane, 0, 8, xch); }
            else { attn_unit<true, 1>(p, vbuf, rpbL, u0 + wave - 4, lane, 20, 32, xch); prep_rows8(p, (u0 + wave - 4) * 8, lane); }
            __syncthreads();
        }
    }
    GRID_SYNC();
    {
        PH_VARS
        int kl = 128; asm volatile("" : "+s"(kl));
        pg8::Gemm g{(const bf16_t*)(ws + WS_ALORA), (const bf16_t*)(ws + WS_WTLORA), kl, 128, 128};
        pg8::SchedLora S; S.G = G; S.c = bx;
        pg8::EpiLora E{(float*)(ws + WS_DEC), (float*)(ws + WS_AA), (float*)(ws + WS_G), p->in[13], p->in[15]};
        pg8::gemm_phase(lds, g, S, E, tid);
        if (defer_ffn && bx >= 64) ffn_transposes(p, lds, 1, (bx - 64) * 8 + wave, 192 * 8, wave, lane);
    }
    GRID_SYNC();
    {
        int nst = 2; asm volatile("" : "+s"(nst));
        const int nl = G > 64 ? 32 : 0;
        for (int st = 0; st < nst; ++st) {
            PH_VARS
            const bool lead = bx < nl;
            if (st == 0 || !lead) cs_phaseA(p, lds, tid, st ? CS_LAT : 0, CS_LAT / 2, st ? bx - nl : bx, st ? G - nl : G);
            if (st == 0) { GRID_SYNC(); continue; }
            if (!lead) {
                unsigned* sb = (unsigned*)(kp0->ws + WS_BAR) + XB_SUBBAR;
                __syncthreads();
                if (tid == 0) { __atomic_thread_fence(__ATOMIC_RELEASE); __hip_atomic_fetch_add(sb, 1u, __ATOMIC_RELAXED, __HIP_MEMORY_SCOPE_AGENT);
                    while (__hip_atomic_load(sb, __ATOMIC_RELAXED, __HIP_MEMORY_SCOPE_AGENT) < (unsigned)(G - nl)) __builtin_amdgcn_s_sleep(1);
                    __atomic_thread_fence(__ATOMIC_ACQUIRE); }
                __syncthreads();
            }
            const int tfirst = lead ? bx : (nl ? 32 + (bx - nl) : bx), tend = lead ? 32 : 288, tstride = lead ? 32 : (G - nl);
            for (int t = tfirst; t < tend; t += tstride) cs_phaseB(p, lds, t < 32 ? 1 : 0, t < 32 ? t : t - 32, tid);
        }
    }
    GRID_SYNC();
    { PH_VARS for (int r = gw; r < NTOK; r += NGW) post_row(p, r, lane); }
    GRID_SYNC();
    {
        PH_VARS
        pg8::Gemm g{(const bf16_t*)(ws + WS_MIX), (const bf16_t*)(ws + WS_WTOUT), 512, D, D};
        pg8::SchedSplit2 S; S.o.init(NTOK / 256, 8, G, bx); S.nN = 4; S.ksplit = 512;
        pg8::EpiPart E{(bf16_t*)(ws + WS_PART), 512};
        pg8::gemm_phase(lds, g, S, E, tid);
    }
    GRID_SYNC();
    { PH_VARS for (int r = gw; r < NTOK; r += 2 * NGW) norm_rows<1, 2>(p, r, NGW, lane, p->in[10], 3 * D, 4 * D, 2 * D, (bf16_t*)(ws + WS_H), p->out); }
    GRID_SYNC();
    {
        PH_VARS
        pg8::Gemm g{(const bf16_t*)(ws + WS_H), (const bf16_t*)(ws + WS_WT13), D, D, D};
        pg8::SchedPlain S; S.o.init(NTOK / 256, 2 * DFF / 256, G, bx);
        pg8::EpiFfnAct E{(bf16_t*)(ws + WS_ACT), (float*)(ws + WS_EDGE), p->in[27], lds};
        pg8::gemm_phase(lds, g, S, E, tid);
    }
    GRID_SYNC();
    {
        PH_VARS
        pg8::Gemm g{(const bf16_t*)(ws + WS_ACT), (const bf16_t*)(ws + WS_WT2), DFF / 2, DFF, DFF};
        pg8::SchedSplit2 S; S.o.init(NTOK / 256, 8, G, bx); S.nN = 4; S.ksplit = DFF / 2;
        { for (int i = 0; i < 8; ++i) { int pm_, pn2_; if (!S.o.next2(i, pm_, pn2_)) break; const int ks_ = pn2_ / 4;
              if (pm_ >= 16 && tid < 352) act_fix(p, pm_, tid / 176, ks_ * (DFF / 2) + (tid % 176) * 8); }
          asm volatile("s_waitcnt vmcnt(0)" ::: "memory"); __syncthreads(); }
        pg8::EpiPart E{(bf16_t*)(ws + WS_PART), DFF / 2};
        pg8::gemm_phase(lds, g, S, E, tid);
    }
    GRID_SYNC();
    { PH_VARS for (int r = gw; r < NTOK; r += 4 * NGW) final_rows<4>(p, r, NGW, lane); }
}

extern "C" void kernel_launch(void* const* d_in, const int* in_sizes, int n_in, void* d_out, int out_size, void* d_ws, size_t ws_size, hipStream_t stream) {
    static int grid_blocks = 0;
    if (!grid_blocks) {
        int dev = 0, cus = 0, per_cu = 0;
        (void)hipGetDevice(&dev);
        (void)hipDeviceGetAttribute(&cus, hipDeviceAttributeMultiprocessorCount, dev);
        (void)hipFuncSetAttribute((const void*)fwd_megakernel, hipFuncAttributeMaxDynamicSharedMemorySize, LDS_BYTES);
        (void)hipOccupancyMaxActiveBlocksPerMultiprocessor(&per_cu, (const void*)fwd_megakernel, 512, LDS_BYTES);
        if (per_cu < 1) per_cu = 1;
        grid_blocks = cus * per_cu;
    }
    (void)hipMemsetAsync((char*)d_ws + WS_BAR, 0, 16384, stream);
    Params p{};
    for (int i = 0; i < 30; ++i) p.in[i] = (const float*)d_in[i];
    p.out = (float*)d_out; p.ws = (unsigned char*)d_ws;
    void* args[] = {&p};
    hipError_t e = hipLaunchCooperativeKernel((const void*)fwd_megakernel, dim3(grid_blocks), dim3(512), args, LDS_BYTES, stream);
    if (e != hipSuccess) fprintf(stderr, "cooperative launch failed: %s (grid %d)\n", hipGetErrorString(e), grid_blocks);
}
```

```cpp
#include <hip/hip_runtime.h>
#include <hip/hip_cooperative_groups.h>
#include <cstdio>
#include <cstdint>
namespace cg = cooperative_groups;

#define LAS __attribute__((address_space(3)))
typedef unsigned short bf16_t;
typedef short bf16x8 __attribute__((ext_vector_type(8)));
typedef short s16x4 __attribute__((ext_vector_type(4)));
typedef float f32x2 __attribute__((ext_vector_type(2)));
typedef float f32x4 __attribute__((ext_vector_type(4)));
typedef float f32x16 __attribute__((ext_vector_type(16)));
typedef unsigned u32x2 __attribute__((ext_vector_type(2)));
typedef unsigned u32x4 __attribute__((ext_vector_type(4)));
typedef __bf16 bf16x2_t __attribute__((ext_vector_type(2)));
#define DI __device__ __forceinline__

constexpr int D = 1024, NTOK = 8192, NCTX = 4096, SEQ = 256, DSEQ = 2048;
constexpr int NIN = 3456, NINP = 3584, RC = 1920, DFF = 2816;
constexpr float EPS = 1e-6f, GN_EPS = 64e-5f;
constexpr float LOG2E = 1.4426950408889634f;
constexpr size_t MiB = 1u << 20;
constexpr size_t WS_BAR = 128 * 1024, WS_MOD = 0, WS_WTIN = 1 * MiB, WS_WTOUT = 8 * MiB, WS_WT13 = 10 * MiB, WS_WT2 = 21 * MiB, WS_WTLORA = 27 * MiB,
                 WS_H = 28 * MiB, WS_Q = 44 * MiB, WS_K = 52 * MiB, WS_V = 60 * MiB, WS_R = 68 * MiB, WS_VV = 84 * MiB, WS_KK = 100 * MiB,
                 WS_KR = 116 * MiB, WS_ALORA = 132 * MiB, WS_MIX = 138 * MiB, WS_ZR = 154 * MiB, WS_DEC = 154 * MiB, WS_AA = 186 * MiB,
                 WS_G = 218 * MiB, WS_CK = 234 * MiB, WS_CV = 235 * MiB, WS_Y = 28 * MiB, WS_PART = 176 * MiB, WS_A1 = 44 * MiB,
                 WS_A3 = 88 * MiB, WS_ACT = 132 * MiB, WS_EDGE = 250 * MiB;
constexpr size_t OUT_K = (size_t)NTOK * D, OUT_V = OUT_K + (size_t)NCTX * 512, OUT_S = OUT_V + (size_t)NCTX * 512;
constexpr int LDS_BYTES = 135168 + 16;
constexpr int LDS_XB = 135168;

struct Params { const float* in[30]; float* out; unsigned char* ws; };
typedef const __attribute__((address_space(4))) Params* KP;

DI unsigned pk2(float lo, float hi) { f32x2 v = {lo, hi}; bf16x2_t b = __builtin_convertvector(v, bf16x2_t); return __builtin_bit_cast(unsigned, b); }
DI f32x4 unpk4(u32x2 w) { return (f32x4){__builtin_bit_cast(float, w.x << 16), __builtin_bit_cast(float, w.x & 0xffff0000u), __builtin_bit_cast(float, w.y << 16), __builtin_bit_cast(float, w.y & 0xffff0000u)}; }
DI f32x2 ldh2(const bf16_t* p) { const unsigned w = *(const unsigned*)p; return (f32x2){__builtin_bit_cast(float, w << 16), __builtin_bit_cast(float, w & 0xffff0000u)}; }
DI float bf2f(unsigned short u) { return __builtin_bit_cast(float, (unsigned)u << 16); }
DI float wave_sum(float v) {
#pragma unroll
    for (int o = 1; o < 64; o <<= 1) v += __shfl_xor(v, o);
    return v;
}
DI float sigmoid_f(float x) { return __builtin_amdgcn_rcpf(1.f + __builtin_amdgcn_exp2f(-1.4426950408889634f * x)); }
DI float silu_f(float x) { return x * sigmoid_f(x); }
DI float tanh_f(float x) { return 2.f * sigmoid_f(2.f * x) - 1.f; }
DI int midx_of(int r) { return r < NCTX ? 0 : 1 + ((r - NCTX) >> 11); }
DI const float* xrow_of(KP p, int r) { return r < NCTX ? p->in[0] + (size_t)r * D : p->in[1] + (size_t)(r - NCTX) * D; }

namespace pg8 {
constexpr int BM = 256, BK = 64, HALF = 128, HTB = HALF * BK * 2, NXCD = 8, WGM = 8;
__host__ __device__ __forceinline__ int lds_byte(int r, int c) { const int st = (r >> 4) * 2 + (c >> 5), rr = r & 15, cc = c & 31, ob = rr * 64 + cc * 2; return st * 1024 + (ob ^ (((ob >> 9) & 1) << 5)); }
__host__ __device__ __forceinline__ void stage_rc(int b, int& R, int& C) { const int st = b / 1024, sb = b % 1024, swz = sb ^ (((sb >> 9) & 1) << 5); R = (st >> 1) * 16 + swz / 64; C = (st & 1) * 32 + (swz % 64) / 2; }
__host__ __device__ __forceinline__ int perm32(int rho) { const int n = rho >> 4, i = rho & 15; return 8 * (i >> 2) + 4 * n + (i & 3); }
struct Unit { int pm, pn; int aoff, boff; };
struct Gemm { const bf16_t* A; const bf16_t* Bt; int K, lda, ldb; };
struct StaticOrder {
    int nM, nN, nwg, G, c;
    __device__ __forceinline__ void init(int nM_, int nN_, int G_, int c_) { nM = nM_; nN = nN_; nwg = nM * nN; G = G_; c = c_; }
    __device__ __forceinline__ bool next2(int i, int& pm, int& pn) const {
        const long L = (long)i * G + c; if (L >= nwg) return false;
        int wgid = (int)L; { const int q = nwg / NXCD, r = nwg % NXCD, xcd = wgid % NXCD, off = wgid / NXCD; wgid = (xcd < r ? xcd * (q + 1) : r * (q + 1) + (xcd - r) * q) + off; }
        const int nig = WGM * nN, gid = wgid / nig, fm = gid * WGM, gsz = (nM - fm) < WGM ? (nM - fm) : WGM;
        pm = fm + ((wgid % nig) % gsz); pn = (wgid % nig) / gsz; return true;
    }
};
struct SchedPlain { StaticOrder o; __device__ __forceinline__ bool next(int i, Unit& u) const { u.aoff = 0; u.boff = 0; return o.next2(i, u.pm, u.pn); } };
struct SchedSplit2 { StaticOrder o; int nN, ksplit;
    __device__ __forceinline__ bool next(int i, Unit& u) const { int pn2; if (!o.next2(i, u.pm, pn2)) return false; const int ks = pn2 / nN; u.pn = pn2 - ks * nN; u.aoff = ks * ksplit; u.boff = ks * ksplit; return true; } };
struct SchedLora { int G, c;
    __device__ __forceinline__ bool next(int i, Unit& u) const { const int L = i * G + c; if (L >= 320) return false; u.pm = L & 31; u.pn = L >> 5; const int g = u.pn < 4 ? 0 : (u.pn < 8 ? 1 : 2); u.aoff = g * NTOK * 128; u.boff = 0; return true; } };

template <class Epi, class Sched>
__device__ __forceinline__ void gemm_phase(LAS unsigned char* lds, const Gemm g, const Sched& S, const Epi& E, int tid) {
    asm volatile("" : "+v"(tid));
    const int wid = __builtin_amdgcn_readfirstlane(tid >> 6), lane = tid & 63, wr = wid >> 2, wc = wid & 3, fr = lane & 15, fq = lane >> 4;
    const int nt = g.K / BK;
    unsigned voffA[2], voffB[2];
#pragma unroll
    for (int i = 0; i < 2; ++i) { int R, C; stage_rc(tid * 16 + i * 8192, R, C); const int Rb = (R & ~31) + perm32(R & 31);
        voffA[i] = (unsigned)(R * g.lda + C) * 2u; voffB[i] = (unsigned)(Rb * g.ldb + C) * 2u; }
    const size_t kstep = (size_t)(BK * 2);
    const size_t hA = (size_t)HALF * g.lda * 2, hB = (size_t)HALF * g.ldb * 2;
    const unsigned ldsw = (unsigned)wid * 1024u;
    const int aoff = lds_byte(wr * 64 + fr, fq * 8), boff = lds_byte(wc * 32 + fr, fq * 8);
#define PG8_SA(b, h) (((b) * 2 + (h)) * HTB)
#define PG8_SB(b, h) ((4 + (b) * 2 + (h)) * HTB)
#define PG8_STAGE(bufoff, gbase, voff) do { _Pragma("unroll") for (int _i = 0; _i < 2; ++_i) \
        __builtin_amdgcn_global_load_lds((const unsigned*)((const char*)(gbase) + (voff)[_i]), (LAS unsigned*)(lds + (bufoff) + ldsw + _i * 8192), 16, 0, 0); } while (0)
#define PG8_LDA(dst, b, h) do { _Pragma("unroll") for (int m = 0; m < 4; ++m) _Pragma("unroll") for (int k = 0; k < 2; ++k) dst[m][k] = *(const LAS bf16x8*)(lds + PG8_SA(b, h) + aoff + m * 2048 + k * 1024); } while (0)
#define PG8_LDB(dst, b, h) do { _Pragma("unroll") for (int n = 0; n < 2; ++n) _Pragma("unroll") for (int k = 0; k < 2; ++k) dst[n][k] = *(const LAS bf16x8*)(lds + PG8_SB(b, h) + boff + n * 2048 + k * 1024); } while (0)
#define PG8_MMA(ai, bj, At, Bt) do { __builtin_amdgcn_s_setprio(1); _Pragma("unroll") for (int m = 0; m < 4; ++m) _Pragma("unroll") for (int n = 0; n < 2; ++n) _Pragma("unroll") for (int k = 0; k < 2; ++k) \
        acc[ai][bj][m][n] = __builtin_amdgcn_mfma_f32_16x16x32_bf16(Bt[n][k], At[m][k], acc[ai][bj][m][n], 0, 0, 0); __builtin_amdgcn_s_setprio(0); } while (0)
#define PG8_WAIT_V(n) asm volatile("s_waitcnt vmcnt(" #n ")" ::: "memory")
#define PG8_WAIT_L(n) asm volatile("s_waitcnt lgkmcnt(" #n ")" ::: "memory")
#define PG8_BAR __builtin_amdgcn_s_barrier()
#define PG8_SCHED __builtin_amdgcn_sched_barrier(0)
#define PG8_TA(u) ((const char*)g.A + ((size_t)(u).pm * BM * g.lda + (size_t)(u).aoff) * 2)
#define PG8_TB(u) ((const char*)g.Bt + ((size_t)(u).pn * BM * g.ldb + (size_t)(u).boff) * 2)
    Unit cur, nxt; int ui = 0;
    if (!S.next(0, cur)) return;
    f32x4 acc[2][2][4][2];
#pragma unroll
    for (int a = 0; a < 2; ++a)
#pragma unroll
        for (int b = 0; b < 2; ++b)
#pragma unroll
            for (int m = 0; m < 4; ++m)
#pragma unroll
                for (int n = 0; n < 2; ++n) acc[a][b][m][n] = (f32x4){0.f, 0.f, 0.f, 0.f};
    bf16x8 At[4][2], B0[2][2], B1[2][2];
    const char* cA = PG8_TA(cur); const char* cB = PG8_TB(cur);
    PG8_STAGE(PG8_SB(0, 0), cB, voffB); PG8_STAGE(PG8_SB(0, 1), cB + hB, voffB); PG8_STAGE(PG8_SA(0, 0), cA, voffA); PG8_STAGE(PG8_SA(0, 1), cA + hA, voffA);
    if (wr == 1) PG8_BAR;
    PG8_WAIT_V(2); PG8_BAR;
    PG8_STAGE(PG8_SB(1, 0), cB + kstep, voffB); PG8_STAGE(PG8_SA(1, 0), cA + kstep, voffA); PG8_STAGE(PG8_SB(1, 1), cB + hB + kstep, voffB);
    PG8_WAIT_V(6); PG8_BAR;
    for (;;) {
        const bool has_next = S.next(ui + 1, nxt);
        const char* nA = has_next ? PG8_TA(nxt) : cA; const char* nB = has_next ? PG8_TB(nxt) : cB;
        for (int t = 0; t < nt; t += 2) {
            const bool last = (t == nt - 2);
            const char* a1 = cA + (size_t)(t + 1) * kstep;
            const char* a2 = last ? nA : cA + (size_t)(t + 2) * kstep; const char* b2 = last ? nB : cB + (size_t)(t + 2) * kstep;
            const char* a3 = a2 + kstep; const char* b3 = b2 + kstep;
            PG8_LDB(B0, 0, 0); PG8_LDB(B1, 0, 1); PG8_SCHED; PG8_LDA(At, 0, 0); PG8_STAGE(PG8_SA(1, 1), a1 + hA, voffA);
            PG8_WAIT_V(8); PG8_WAIT_L(0); PG8_BAR; PG8_MMA(0, 0, At, B0); PG8_MMA(0, 1, At, B1); PG8_BAR; PG8_SCHED;
            PG8_LDA(At, 0, 1); PG8_STAGE(PG8_SB(0, 0), b2, voffB); PG8_STAGE(PG8_SB(0, 1), b2 + hB, voffB); PG8_STAGE(PG8_SA(0, 0), a2, voffA);
            PG8_WAIT_V(8); PG8_WAIT_L(0); PG8_BAR; PG8_MMA(1, 0, At, B0); PG8_MMA(1, 1, At, B1); PG8_BAR; PG8_SCHED;
            PG8_LDB(B0, 1, 0); PG8_LDB(B1, 1, 1); PG8_SCHED; PG8_LDA(At, 1, 0); PG8_STAGE(PG8_SA(0, 1), a2 + hA, voffA);
            PG8_WAIT_V(8); PG8_WAIT_L(0); PG8_BAR; PG8_MMA(0, 0, At, B0); PG8_MMA(0, 1, At, B1); PG8_BAR; PG8_SCHED;
            PG8_LDA(At, 1, 1); PG8_STAGE(PG8_SB(1, 0), b3, voffB); PG8_STAGE(PG8_SB(1, 1), b3 + hB, voffB); PG8_STAGE(PG8_SA(1, 0), a3, voffA);
            PG8_WAIT_V(8); PG8_WAIT_L(0); PG8_BAR; PG8_MMA(1, 0, At, B0); PG8_MMA(1, 1, At, B1); PG8_BAR; PG8_SCHED;
        }
        E(acc, cur, wr, wc, fr, fq);
        if (!has_next) break;
#pragma unroll
        for (int a = 0; a < 2; ++a)
#pragma unroll
            for (int b = 0; b < 2; ++b)
#pragma unroll
                for (int m = 0; m < 4; ++m)
#pragma unroll
                    for (int n = 0; n < 2; ++n) acc[a][b][m][n] = (f32x4){0.f, 0.f, 0.f, 0.f};
        cur = nxt; cA = nA; cB = nB; ++ui;
    }
    PG8_WAIT_V(0);
    if (wr == 0) PG8_BAR;
    PG8_BAR;
#undef PG8_SA
#undef PG8_SB
#undef PG8_STAGE
#undef PG8_LDA
#undef PG8_LDB
#undef PG8_MMA
#undef PG8_WAIT_V
#undef PG8_WAIT_L
#undef PG8_BAR
#undef PG8_SCHED
#undef PG8_TA
#undef PG8_TB
}

struct EpiIn {
    bf16_t *Q; bf16_t* ZR; float* outK; float qscale;
    __device__ __forceinline__ void operator()(const f32x4 (&acc)[2][2][4][2], const Unit& u, int wr, int wc, int fr, int fq) const {
#pragma unroll
        for (int bj = 0; bj < 2; ++bj) {
            const int c0 = u.pn * BM + bj * HALF + wc * 32 + 8 * fq;
            if (c0 >= NIN) continue;
#pragma unroll
            for (int ai = 0; ai < 2; ++ai)
#pragma unroll
                for (int m = 0; m < 4; ++m) {
                    int r = u.pm * BM + ai * HALF + wr * 64 + m * 16 + fr; asm volatile("" : "+v"(r));
                    f32x4 v0 = acc[ai][bj][m][0], v1 = acc[ai][bj][m][1];
                    if (c0 < 1536) {
                        const int seg = c0 >> 9, cc = c0 & 511;
                        if (seg == 0) { v0 = v0 * qscale; v1 = v1 * qscale; }
                        else if (r < NCTX) { float* o = outK + (size_t)(seg - 1) * ((size_t)NCTX * 512) + (size_t)r * 512 + cc; *(f32x4*)o = v0; *(f32x4*)(o + 4) = v1; }
                        bf16_t* dst = Q + (size_t)seg * ((size_t)NTOK * 512) + (size_t)r * 512 + cc;
                        u32x4 w; w.x = pk2(v0[0], v0[1]); w.y = pk2(v0[2], v0[3]); w.z = pk2(v1[0], v1[1]); w.w = pk2(v1[2], v1[3]);
                        *(u32x4*)dst = w;
                    } else {
                        u32x4 w; w.x = pk2(v0[0], v0[1]); w.y = pk2(v0[2], v0[3]); w.z = pk2(v1[0], v1[1]); w.w = pk2(v1[2], v1[3]);
                        *(u32x4*)(ZR + (size_t)r * RC + (c0 - 1536)) = w;
                    }
                }
        }
    }
};
DI float decay1(float x) { return __expf(-0.60653065971f * sigmoid_f(x)); }
struct EpiLora {
    float *DEC, *AA, *G; const float *w0, *a0;
    __device__ __forceinline__ void operator()(const f32x4 (&acc)[2][2][4][2], const Unit& u, int wr, int wc, int fr, int fq) const {
#pragma unroll
        for (int bj = 0; bj < 2; ++bj) {
            const int c0 = u.pn * BM + bj * HALF + wc * 32 + 8 * fq;
            const int grp = c0 >> 10, cg = c0 & 1023, dir = cg >> 9, cc = cg & 511;
            const float* bp = (grp == 0 ? w0 : a0) + dir * 512 + cc;
            float* ob = DEC + (size_t)dir * NTOK * 512 + cc;
            bf16_t* obh = grp == 2 ? (bf16_t*)G + cc : (bf16_t*)AA + (size_t)dir * NTOK * 512 + cc;
#pragma unroll
            for (int ai = 0; ai < 2; ++ai)
#pragma unroll
                for (int m = 0; m < 4; ++m) {
                    int r = u.pm * BM + ai * HALF + wr * 64 + m * 16 + fr; asm volatile("" : "+v"(r));
                    f32x4 v0 = acc[ai][bj][m][0], v1 = acc[ai][bj][m][1];
                    if (grp < 2) { const float* bq = bp; asm volatile("" : "+v"(bq)); v0 += *(const f32x4*)bq; v1 += *(const f32x4*)(bq + 4); }
                    if (grp == 0) { v0.x = decay1(v0.x); v0.y = decay1(v0.y); v0.z = decay1(v0.z); v0.w = decay1(v0.w); v1.x = decay1(v1.x); v1.y = decay1(v1.y); v1.z = decay1(v1.z); v1.w = decay1(v1.w); }
                    else if (grp == 1) { v0.x = sigmoid_f(v0.x); v0.y = sigmoid_f(v0.y); v0.z = sigmoid_f(v0.z); v0.w = sigmoid_f(v0.w); v1.x = sigmoid_f(v1.x); v1.y = sigmoid_f(v1.y); v1.z = sigmoid_f(v1.z); v1.w = sigmoid_f(v1.w); }
                    if (grp == 0) { float* o = ob + (size_t)r * 512; *(f32x4*)o = v0; *(f32x4*)(o + 4) = v1; }
                    else { u32x4 w; w.x = pk2(v0[0], v0[1]); w.y = pk2(v0[2], v0[3]); w.z = pk2(v1[0], v1[1]); w.w = pk2(v1[2], v1[3]); *(u32x4*)(obh + (size_t)r * 512) = w; }
                }
        }
    }
};
struct EpiPart {
    bf16_t* P; int ksplit;
    __device__ __forceinline__ void operator()(const f32x4 (&acc)[2][2][4][2], const Unit& u, int wr, int wc, int fr, int fq) const {
        bf16_t* base = P + (u.aoff ? (size_t)NTOK * D : 0);
#pragma unroll
        for (int bj = 0; bj < 2; ++bj) {
            const int c0 = u.pn * BM + bj * HALF + wc * 32 + 8 * fq;
#pragma unroll
            for (int ai = 0; ai < 2; ++ai)
#pragma unroll
                for (int m = 0; m < 4; ++m) {
                    int r = u.pm * BM + ai * HALF + wr * 64 + m * 16 + fr; asm volatile("" : "+v"(r));
                    const f32x4 v0 = acc[ai][bj][m][0], v1 = acc[ai][bj][m][1];
                    u32x4 w; w.x = pk2(v0[0], v0[1]); w.y = pk2(v0[2], v0[3]); w.z = pk2(v1[0], v1[1]); w.w = pk2(v1[2], v1[3]);
                    *(u32x4*)(base + (size_t)r * D + c0) = w;
                }
        }
    }
};
template <int CTRL> DI float dppf(float x) { return __builtin_bit_cast(float, __builtin_amdgcn_mov_dpp(__builtin_bit_cast(int, x), CTRL, 0xf, 0xf, true)); }
struct EpiFfnAct {
    bf16_t* ACT; float* EDGE; const float* wcv; LAS unsigned char* ldsb;
    __device__ __forceinline__ void operator()(const f32x4 (&acc)[2][2][4][2], const Unit& u, int wr, int wc, int fr, int fq) const {
        LAS float* HL = (LAS float*)(ldsb + 131072);
        const int colh = wc * 32 + 8 * fq;
#pragma unroll
        for (int ai = 0; ai < 2; ++ai) { const int g = ai * 2 + wr;
            if (fr == 0) { *(LAS f32x4*)(HL + (g * 2 + 0) * 128 + colh) = acc[ai][0][0][0]; *(LAS f32x4*)(HL + (g * 2 + 0) * 128 + colh + 4) = acc[ai][0][0][1]; }
            if (fr == 15) { *(LAS f32x4*)(HL + (g * 2 + 1) * 128 + colh) = acc[ai][0][3][0]; *(LAS f32x4*)(HL + (g * 2 + 1) * 128 + colh + 4) = acc[ai][0][3][1]; } }
        asm volatile("s_waitcnt lgkmcnt(0)" ::: "memory");
        __builtin_amdgcn_s_barrier(); __builtin_amdgcn_s_barrier();
        asm volatile("" ::: "memory");
        const int cf = u.pn * HALF + colh;
        const f32x4 zero = {0.f, 0.f, 0.f, 0.f};
        const bool lat = u.pm >= 16;
#pragma unroll
        for (int ai = 0; ai < 2; ++ai) {
            const int g = ai * 2 + wr;
            f32x4 hp[2], hn[2];
            hp[0] = g > 0 ? *(const LAS f32x4*)(HL + ((g - 1) * 2 + 1) * 128 + colh) : zero; hp[1] = g > 0 ? *(const LAS f32x4*)(HL + ((g - 1) * 2 + 1) * 128 + colh + 4) : zero;
            hn[0] = g < 3 ? *(const LAS f32x4*)(HL + ((g + 1) * 2 + 0) * 128 + colh) : zero; hn[1] = g < 3 ? *(const LAS f32x4*)(HL + ((g + 1) * 2 + 0) * 128 + colh + 4) : zero;
#pragma unroll
            for (int m = 0; m < 4; ++m) {
                int r = u.pm * BM + ai * HALF + wr * 64 + m * 16 + fr; asm volatile("" : "+v"(r));
                const float* wq_ = wcv + cf; asm volatile("" : "+v"(wq_));
                f32x4 uu[2], av[2];
#pragma unroll
                for (int n = 0; n < 2; ++n) {
                    const f32x4 cur = acc[ai][0][m][n];
                    f32x4 pv, nx;
#pragma unroll
                    for (int j = 0; j < 4; ++j) {
                        if (m > 0) pv[j] = dppf<0x121>(fr == 15 ? acc[ai][0][m > 0 ? m - 1 : 0][n][j] : cur[j]);
                        else { const float a = dppf<0x121>(cur[j]); pv[j] = fr == 0 ? hp[n][j] : a; }
                        if (m < 3) nx[j] = dppf<0x12F>(fr == 0 ? acc[ai][0][m < 3 ? m + 1 : 3][n][j] : cur[j]);
                        else { const float c = dppf<0x12F>(cur[j]); nx[j] = fr == 15 ? hn[n][j] : c; }
                    }
                    const f32x4 w0 = *(const f32x4*)(wq_ + 4 * n), w1 = *(const f32x4*)(wq_ + DFF + 4 * n), w2 = *(const f32x4*)(wq_ + 2 * DFF + 4 * n);
                    uu[n] = pv * w0 + cur * w1 + nx * w2;
                    const f32x4 a3 = acc[ai][1][m][n];
                    av[n] = (f32x4){silu_f(uu[n].x) * a3.x, silu_f(uu[n].y) * a3.y, silu_f(uu[n].z) * a3.z, silu_f(uu[n].w) * a3.w};
                }
                u32x4 w; w.x = pk2(av[0][0], av[0][1]); w.y = pk2(av[0][2], av[0][3]); w.z = pk2(av[1][0], av[1][1]); w.w = pk2(av[1][2], av[1][3]);
                *(u32x4*)(ACT + (size_t)r * DFF + cf) = w;
                if (lat && ((ai == 0 && m == 0) || (ai == 1 && m == 3))) {
                    const int e = ai;
                    const bool mine = e == 0 ? (wr == 0 && fr == 0) : (wr == 1 && fr == 15);
                    if (mine) {
                        float* eb = EDGE + ((size_t)u.pm * 2 + e) * DFF + cf;
                        *(f32x4*)(eb) = acc[ai][0][m][0]; *(f32x4*)(eb + 4) = acc[ai][0][m][1];
                        *(f32x4*)(eb + 64 * DFF) = uu[0]; *(f32x4*)(eb + 64 * DFF + 4) = uu[1];
                        *(f32x4*)(eb + 128 * DFF) = acc[ai][1][m][0]; *(f32x4*)(eb + 128 * DFF + 4) = acc[ai][1][m][1];
                    }
                }
            }
        }
    }
};
}

template <int MODE>
DI void transpose_item(const float* W, int K, int N, bf16_t* WT, LAS float* scr, int item, int lane) {
    const int nblk = N / 32, kb = item / nblk, nb = item % nblk, k0 = 64 * kb, n0 = 32 * nb;
#pragma unroll 8
    for (int i = 0; i < 32; ++i) { const int kk = 2 * i + (lane >> 5); scr[kk * 33 + (lane & 31)] = W[(size_t)(k0 + kk) * N + n0 + (lane & 31)]; }
    asm volatile("s_waitcnt lgkmcnt(0)" ::: "memory");
    const int c = lane & 7;
#pragma unroll
    for (int j = 0; j < 4; ++j) { const int n = (lane >> 3) + 8 * j; const LAS float* s = scr + (8 * c) * 33 + n;
        u32x4 o; o.x = pk2(s[0 * 33], s[1 * 33]); o.y = pk2(s[2 * 33], s[3 * 33]); o.z = pk2(s[4 * 33], s[5 * 33]); o.w = pk2(s[6 * 33], s[7 * 33]);
        const int nn = n0 + n; const int drow = MODE == 0 ? nn : ((nn >> 7) * 256 + (nn & 127) + (MODE == 2 ? 128 : 0));
        *(u32x4*)(WT + (size_t)drow * K + k0 + 8 * c) = o; }
    asm volatile("s_waitcnt lgkmcnt(0)" ::: "memory");
}

DI void p0_misc(KP p, int gtid, int NGT) {
    unsigned char* ws = p->ws;
    {
        bf16_t* WL = (bf16_t*)(ws + WS_WTLORA); const float* w2 = p->in[14]; const float* a2 = p->in[16]; const float* g2 = p->in[17];
        for (int i = gtid; i < 2560 * 128; i += NGT) {
            const int n = i >> 7, k = i & 127; float v = 0.f;
            if (n < 2048) { const int grp = n >> 10, dir = (n >> 9) & 1, c = n & 511; const float* src = grp == 0 ? w2 : a2;
                if ((k >> 6) == dir) v = src[((size_t)dir * 64 + (k & 63)) * 512 + c]; }
            else v = g2[(size_t)k * 512 + (n - 2048)];
            WL[i] = (bf16_t)(pk2(v, 0.f) & 0xffffu);
        }
    }
    {
        const f32x4* ck = (const f32x4*)p->in[2]; const f32x4* cv = (const f32x4*)p->in[3]; u32x2* CK = (u32x2*)(ws + WS_CK); u32x2* CV = (u32x2*)(ws + WS_CV);
        for (int i = gtid; i < 1024 * 512 / 4; i += NGT) { const f32x4 a = ck[i], b = cv[i]; CK[i] = (u32x2){pk2(a[0], a[1]), pk2(a[2], a[3])}; CV[i] = (u32x2){pk2(b[0], b[1]), pk2(b[2], b[3])}; }
    }
}

DI void phase0(KP p, LAS unsigned char* lds, int gw, int NGW, int gtid, int NGT, int wave, int lane, bool defer_ffn) {
    unsigned char* ws = p->ws;
    {
        float* MOD = (float*)(ws + WS_MOD);
        const float* w_ada = p->in[7]; const float* b_ada = p->in[8]; const float* c_lat = p->in[5]; const float* c_ctx = p->in[6];
        LAS float* red = (LAS float*)(lds + 8 * 8448);
        const int tid = wave * 64 + lane, cgp = lane & 15, kr = lane >> 4;
        for (int nb = blockIdx.x; nb < 96; nb += gridDim.x) {
            f32x4 a0 = {0, 0, 0, 0}, a1 = a0, a2 = a0;
#pragma unroll 8
            for (int i = 0; i < 32; ++i) {
                const int k = wave * 128 + 4 * i + kr;
                const f32x4 w = *(const f32x4*)(w_ada + (size_t)k * 6144 + nb * 64 + 4 * cgp);
                a0 += w * silu_f(c_ctx[k]); a1 += w * silu_f(c_lat[k]); a2 += w * silu_f(c_lat[D + k]);
            }
#pragma unroll
            for (int j = 0; j < 4; ++j) {
                a0[j] += __shfl_xor(a0[j], 16); a0[j] += __shfl_xor(a0[j], 32);
                a1[j] += __shfl_xor(a1[j], 16); a1[j] += __shfl_xor(a1[j], 32);
                a2[j] += __shfl_xor(a2[j], 16); a2[j] += __shfl_xor(a2[j], 32);
            }
            if (kr == 0) { *(LAS f32x4*)(red + (wave * 3 + 0) * 64 + 4 * cgp) = a0; *(LAS f32x4*)(red + (wave * 3 + 1) * 64 + 4 * cgp) = a1; *(LAS f32x4*)(red + (wave * 3 + 2) * 64 + 4 * cgp) = a2; }
            __syncthreads();
            if (tid < 192) {
                const int i = tid >> 6, c = tid & 63; float s = b_ada[nb * 64 + c];
#pragma unroll
                for (int w = 0; w < 8; ++w) s += red[(w * 3 + i) * 64 + c];
                MOD[i * 6144 + nb * 64 + c] = s;
            }
            __syncthreads();
        }
    }
    {
        LAS float* scr = (LAS float*)(lds + wave * 8448);
        constexpr int I_IN = 16 * 108, I_OUT = 16 * 32, I_F = 16 * 88, I_2 = 44 * 32, NIT = I_IN + I_OUT + 2 * I_F + I_2;
        const int nit = defer_ffn ? I_IN : NIT;
        for (int it = gw; it < nit; it += NGW) {
            int r = it;
            if (r < I_IN) { transpose_item<0>(p->in[11], D, NIN, (bf16_t*)(ws + WS_WTIN), scr, r, lane); continue; } r -= I_IN;
            if (r < I_OUT) { transpose_item<0>(p->in[24], D, D, (bf16_t*)(ws + WS_WTOUT), scr, r, lane); continue; } r -= I_OUT;
            if (r < I_F) { transpose_item<1>(p->in[25], D, DFF, (bf16_t*)(ws + WS_WT13), scr, r, lane); continue; } r -= I_F;
            if (r < I_F) { transpose_item<2>(p->in[26], D, DFF, (bf16_t*)(ws + WS_WT13), scr, r, lane); continue; } r -= I_F;
            transpose_item<0>(p->in[28], DFF, D, (bf16_t*)(ws + WS_WT2), scr, r, lane);
        }
    }
    { u32x4* z = (u32x4*)((bf16_t*)(ws + WS_WTIN) + (size_t)NIN * D); for (int i = gtid; i < 128 * D / 8; i += NGT) z[i] = (u32x4){0, 0, 0, 0}; }
    if (!defer_ffn) p0_misc(p, gtid, NGT);
}

DI void ffn_transposes(KP p, LAS unsigned char* lds, int which, int widx, int nw, int wave, int lane) {
    LAS float* scr = (LAS float*)(lds + wave * 8448);
    constexpr int I_F = 16 * 88, I_2 = 44 * 32;
    if (which == 0) { constexpr int I_OUT = 16 * 32;
        for (int it = widx; it < I_OUT + I_2; it += nw) { if (it < I_OUT) transpose_item<0>(p->in[24], D, D, (bf16_t*)(p->ws + WS_WTOUT), scr, it, lane);
                                                            else transpose_item<0>(p->in[28], DFF, D, (bf16_t*)(p->ws + WS_WT2), scr, it - I_OUT, lane); } }
    else { for (int it = widx; it < 2 * I_F; it += nw) { if (it < I_F) transpose_item<1>(p->in[25], D, DFF, (bf16_t*)(p->ws + WS_WT13), scr, it, lane);
                                                           else transpose_item<2>(p->in[26], D, DFF, (bf16_t*)(p->ws + WS_WT13), scr, it - I_F, lane); } }
}

template <int SRC, int NR>
DI void norm_rows(KP p, int rbase, int rstride, int lane, const float* normw, int sh_off, int sc_off, int gate_off, bf16_t* Hout, float* xout) {
    const float* MODb = (const float*)(p->ws + WS_MOD);
    const bf16_t* PART = (const bf16_t*)(p->ws + WS_PART);
    f32x4 v[NR][4];
#pragma unroll
    for (int q = 0; q < NR; ++q) { const f32x4* xr = (const f32x4*)xrow_of(p, rbase + q * rstride) + lane;
#pragma unroll
        for (int j = 0; j < 4; ++j) v[q][j] = xr[64 * j]; }
    if (SRC == 1) {
        u32x2 p0[NR][4], p1[NR][4];
#pragma unroll
        for (int q = 0; q < NR; ++q) { const int r = rbase + q * rstride;
#pragma unroll
            for (int j = 0; j < 4; ++j) { p0[q][j] = *((const u32x2*)(PART + (size_t)r * D) + lane + 64 * j); p1[q][j] = *((const u32x2*)(PART + (size_t)(NTOK + r) * D) + lane + 64 * j); } }
#pragma unroll
        for (int q = 0; q < NR; ++q) { const int r = rbase + q * rstride; const float* MOD = MODb + midx_of(r) * 6144;
#pragma unroll
            for (int j = 0; j < 4; ++j) { const f32x4 gt = *((const f32x4*)(MOD + gate_off) + lane + 64 * j); v[q][j] = v[q][j] + gt * (unpk4(p0[q][j]) + unpk4(p1[q][j])); } }
    }
    float s[NR];
#pragma unroll
    for (int q = 0; q < NR; ++q) { s[q] = 0.f;
#pragma unroll
        for (int j = 0; j < 4; ++j) s[q] += (v[q][j].x * v[q][j].x + v[q][j].y * v[q][j].y) + (v[q][j].z * v[q][j].z + v[q][j].w * v[q][j].w); }
#pragma unroll
    for (int o = 1; o < 64; o <<= 1) {
#pragma unroll
        for (int q = 0; q < NR; ++q) s[q] += __shfl_xor(s[q], o); }
#pragma unroll
    for (int q = 0; q < NR; ++q) {
        const int r = rbase + q * rstride; const float* MOD = MODb + midx_of(r) * 6144;
        const float rstd = rsqrtf(s[q] * (1.f / D) + EPS);
        u32x2* o = (u32x2*)(Hout + (size_t)r * D) + lane;
#pragma unroll
        for (int j = 0; j < 4; ++j) {
            if (SRC == 1) *((f32x4*)(xout + (size_t)r * D) + lane + 64 * j) = v[q][j];
            const f32x4 g = *((const f32x4*)normw + lane + 64 * j), sc = *((const f32x4*)(MOD + sc_off) + lane + 64 * j), sh = *((const f32x4*)(MOD + sh_off) + lane + 64 * j);
            const f32x4 h = v[q][j] * rstd * g * (sc + 1.f) + sh;
            o[64 * j] = (u32x2){pk2(h.x, h.y), pk2(h.z, h.w)};
        }
    }
}

#define MFMA32(a, b, c) __builtin_amdgcn_mfma_f32_32x32x16_bf16((a), (b), (c), 0, 0, 0)
DI int crow(int reg, int h) { return (reg & 3) + 8 * (reg >> 2) + 4 * h; }
typedef short v4i16_t __attribute__((ext_vector_type(4)));
DI s16x4 vtr(const LAS unsigned char* p) { return __builtin_bit_cast(s16x4, __builtin_amdgcn_ds_read_tr16_b64_v4i16((LAS v4i16_t*)p)); }

template <bool LATENT, int MODE>
DI void attn_unit(KP p, LAS unsigned char* vbuf, const LAS float* rpbL, int unit, int lane, int t0, int t1, LAS float* xch) {
    const bf16_t* Q = (const bf16_t*)(p->ws + WS_Q); const bf16_t* Kb = (const bf16_t*)(p->ws + WS_K); const bf16_t* Vb = (const bf16_t*)(p->ws + WS_V);
    const bf16_t* CK = (const bf16_t*)(p->ws + WS_CK); const bf16_t* CV = (const bf16_t*)(p->ws + WS_CV);
    bf16_t* MIX = (bf16_t*)(p->ws + WS_MIX);
    const int r = lane & 31, hh = lane >> 5;
    int head, qrow0, b, gi = 0, w0 = 0, si = 0, ntile;
    if (LATENT) { head = unit & 7; const int t = unit >> 3; w0 = (t & 1) * 32; gi = (t >> 1) & 31; b = t >> 6; qrow0 = NCTX + b * DSEQ + gi * 64 + w0; si = min(max(gi - 4, 0), 24); ntile = 32; }
    else { head = unit & 7; const int t = unit >> 3; const int qb = t & 7; b = t >> 3; qrow0 = b * SEQ + qb * 32; ntile = 8; }
    bf16x8 qf[4];
#pragma unroll
    for (int s = 0; s < 4; ++s) qf[s] = *(const bf16x8*)(Q + (size_t)(qrow0 + r) * 512 + head * 64 + 16 * s + 8 * hh);
    auto tile_ptrs = [&](int t, const bf16_t*& kp, const bf16_t*& vp) {
        if (LATENT) {
            if (t < 16) { const size_t row = (size_t)b * 512 + t * 32; kp = CK + row * 512; vp = CV + row * 512; }
            else { const int lt = t - 16; const size_t row = (size_t)NCTX + b * DSEQ + (si + (lt >> 1)) * 64 + (((lt & 1) * 32) ^ w0); kp = Kb + row * 512; vp = Vb + row * 512; }
        } else { const size_t row = (size_t)b * SEQ + t * 32; kp = Kb + row * 512; vp = Vb + row * 512; }
    };
    bf16x8 kf[4], kn[4]; u32x4 vn[4];
    {
        const bf16_t *kp, *vp; tile_ptrs(t0, kp, vp);
#pragma unroll
        for (int s = 0; s < 4; ++s) kf[s] = *(const bf16x8*)(kp + (size_t)r * 512 + head * 64 + 16 * s + 8 * hh);
#pragma unroll
        for (int i = 0; i < 4; ++i) { const int c = lane + 64 * i; vn[i] = *(const u32x4*)(vp + (size_t)(c >> 3) * 512 + head * 64 + (c & 7) * 8); }
#pragma unroll
        for (int i = 0; i < 4; ++i) { const int c = lane + 64 * i; *(LAS u32x4*)(vbuf + (c >> 3) * 144 + (c & 7) * 16) = vn[i]; }
    }
    f32x16 o0, o1;
#pragma unroll
    for (int i = 0; i < 16; ++i) { o0[i] = 0.f; o1[i] = 0.f; }
    float mrun = -1e30f, lrun = 0.f;
    const int i16 = lane & 15, tq = i16 >> 2, tp = i16 & 3, blk = (lane >> 4) & 1;
    const LAS unsigned char* vtbase = vbuf + (4 * hh + tq) * 144 + (16 * blk) * 2 + 8 * tp;
    const int wq = w0 + r;
    const int cs = min(max(wq - 8, 0), 48);
    for (int t = t0; t < t1; ++t) {
        const bool more = (t + 1 < t1);
        if (more) {
            const bf16_t *kp, *vp; tile_ptrs(t + 1, kp, vp);
#pragma unroll
            for (int s = 0; s < 4; ++s) kn[s] = *(const bf16x8*)(kp + (size_t)r * 512 + head * 64 + 16 * s + 8 * hh);
#pragma unroll
            for (int i = 0; i < 4; ++i) { const int c = lane + 64 * i; vn[i] = *(const u32x4*)(vp + (size_t)(c >> 3) * 512 + head * 64 + (c & 7) * 8); }
        }
        f32x16 st;
#pragma unroll
        for (int i = 0; i < 16; ++i) st[i] = 0.f;
#pragma unroll
        for (int s = 0; s < 4; ++s) st = MFMA32(kf[s], qf[s], st);
        if (LATENT && t >= 16) {
            const int lt = t - 16, a = lt >> 1, c0 = ((lt & 1) * 32) ^ w0;
            const int row_off = si + a - gi + 7;
            const int d0 = c0 + 4 * hh - cs;
            const LAS float* bp = rpbL + head * 465 + row_off * 31 + (c0 + 4 * hh - wq + 15);
#pragma unroll
            for (int i = 0; i < 16; ++i) {
                const int ci = (i & 3) + 8 * (i >> 2);
                const bool valid = (unsigned)(d0 + ci) < 16u;
                const float bias = valid ? bp[ci] : 0.f;
                st[i] = valid ? st[i] + bias : -INFINITY;
            }
        }
        float tmax = st[0];
#pragma unroll
        for (int i = 1; i < 16; ++i) tmax = fmaxf(tmax, st[i]);
        { const unsigned tb = __builtin_bit_cast(unsigned, tmax);
          const auto sw = __builtin_amdgcn_permlane32_swap(tb, tb, false, false);
          tmax = fmaxf(fmaxf(tmax, __builtin_bit_cast(float, (unsigned)sw[0])), __builtin_bit_cast(float, (unsigned)sw[1])); }
        if (__builtin_amdgcn_ballot_w64(tmax - mrun > 8.f) != 0ull) {
            const float mnew = fmaxf(mrun, tmax);
            const float alpha = __builtin_amdgcn_exp2f(mrun - mnew);
            lrun *= alpha; mrun = mnew;
#pragma unroll
            for (int i = 0; i < 16; ++i) { o0[i] *= alpha; o1[i] *= alpha; }
        }
        float ps = 0.f;
#pragma unroll
        for (int i = 0; i < 16; ++i) { st[i] = __builtin_amdgcn_exp2f(st[i] - mrun); ps += st[i]; }
        lrun += ps;
        bf16x8 pb[2];
#pragma unroll
        for (int s = 0; s < 2; ++s) { u32x4 w; w.x = pk2(st[8 * s], st[8 * s + 1]); w.y = pk2(st[8 * s + 2], st[8 * s + 3]); w.z = pk2(st[8 * s + 4], st[8 * s + 5]); w.w = pk2(st[8 * s + 6], st[8 * s + 7]); pb[s] = __builtin_bit_cast(bf16x8, w); }
        asm volatile("s_waitcnt lgkmcnt(0)" ::: "memory");
#pragma unroll
        for (int s = 0; s < 2; ++s) {
            const LAS unsigned char* bs = vtbase + (16 * s) * 144;
            const s16x4 lo0 = vtr(bs), hi0 = vtr(bs + 8 * 144), lo1 = vtr(bs + 64), hi1 = vtr(bs + 8 * 144 + 64);
            const bf16x8 va0 = __builtin_shufflevector(lo0, hi0, 0, 1, 2, 3, 4, 5, 6, 7), va1 = __builtin_shufflevector(lo1, hi1, 0, 1, 2, 3, 4, 5, 6, 7);
            o0 = MFMA32(va0, pb[s], o0); o1 = MFMA32(va1, pb[s], o1);
        }
        asm volatile("s_waitcnt lgkmcnt(0)" ::: "memory");
        if (more) {
#pragma unroll
            for (int i = 0; i < 4; ++i) { const int c = lane + 64 * i; *(LAS u32x4*)(vbuf + (c >> 3) * 144 + (c & 7) * 16) = vn[i]; }
#pragma unroll
            for (int s = 0; s < 4; ++s) kf[s] = kn[s];
        }
    }
    if (MODE == 1) {
#pragma unroll
        for (int i = 0; i < 16; ++i) { xch[i * 64 + lane] = o0[i]; xch[(16 + i) * 64 + lane] = o1[i]; }
        xch[32 * 64 + lane] = mrun; xch[33 * 64 + lane] = lrun;
        __syncthreads();
        return;
    }
    if (MODE == 2) {
        __syncthreads();
        const float mb = xch[32 * 64 + lane], lb = xch[33 * 64 + lane];
        const float mm = fmaxf(mrun, mb), fa = exp2f(mrun - mm), fb = exp2f(mb - mm);
#pragma unroll
        for (int i = 0; i < 16; ++i) { o0[i] = o0[i] * fa + xch[i * 64 + lane] * fb; o1[i] = o1[i] * fa + xch[(16 + i) * 64 + lane] * fb; }
        lrun = lrun * fa + lb * fb;
    }
    float ltot; { const unsigned lb_ = __builtin_bit_cast(unsigned, lrun); const auto sw = __builtin_amdgcn_permlane32_swap(lb_, lb_, false, false); ltot = __builtin_bit_cast(float, (unsigned)sw[0]) + __builtin_bit_cast(float, (unsigned)sw[1]); }
    const float inv = 1.f / ltot;
    bf16_t* orow = MIX + (size_t)(qrow0 + r) * D + head * 64;
#pragma unroll
    for (int g4 = 0; g4 < 4; ++g4) {
        const int d = 8 * g4 + 4 * hh;
        *(u32x2*)(orow + d) = (u32x2){pk2(o0[4 * g4] * inv, o0[4 * g4 + 1] * inv), pk2(o0[4 * g4 + 2] * inv, o0[4 * g4 + 3] * inv)};
        *(u32x2*)(orow + 32 + d) = (u32x2){pk2(o1[4 * g4] * inv, o1[4 * g4 + 1] * inv), pk2(o1[4 * g4 + 2] * inv, o1[4 * g4 + 3] * inv)};
    }
}

DI void prep_rows8(KP p, int r0, int lane) {
    const bf16_t* ZR = (const bf16_t*)(p->ws + WS_ZR); const float* wts = p->in[12]; const float* k_k = p->in[18];
    bf16_t* R = (bf16_t*)(p->ws + WS_R); bf16_t* KR = (bf16_t*)(p->ws + WS_KR); bf16_t* VV = (bf16_t*)(p->ws + WS_VV); bf16_t* KK = (bf16_t*)(p->ws + WS_KK);
    bf16_t* AL = (bf16_t*)(p->ws + WS_ALORA);
    const int t0 = r0 < NCTX ? (r0 & 255) : ((r0 - NCTX) & 2047); const int T = r0 < NCTX ? SEQ : DSEQ;
    const bool hp = t0 > 0, hn = t0 + 8 < T;
    const bf16_t* zb = ZR + (size_t)(r0 - 1) * RC;
    const f32x4 zero = {0, 0, 0, 0};
#pragma unroll 1
    for (int seg = 0; seg < 3; ++seg) {
        const int c = seg * 512 + lane * 8;
        f32x4 z[10][2];
#pragma unroll
        for (int i = 0; i < 10; ++i) { const bool ok = (i > 0 || hp) && (i < 9 || hn);
            if (ok) { const u32x4 w = *(const u32x4*)(zb + (size_t)i * RC + c); z[i][0] = unpk4((u32x2){w.x, w.y}); z[i][1] = unpk4((u32x2){w.z, w.w}); } else { z[i][0] = zero; z[i][1] = zero; } }
        const f32x4 wa0 = *(const f32x4*)(wts + c), wa1 = *(const f32x4*)(wts + c + 4), wb0 = *(const f32x4*)(wts + RC + c), wb1 = *(const f32x4*)(wts + RC + c + 4),
                    wc0 = *(const f32x4*)(wts + 2 * RC + c), wc1 = *(const f32x4*)(wts + 2 * RC + c + 4);
        const f32x4 k0 = *(const f32x4*)(k_k + lane * 8), k1 = *(const f32x4*)(k_k + lane * 8 + 4);
        bf16_t* dstb = (seg == 0 ? R : (seg == 1 ? KR : VV)) + (size_t)r0 * 512 + lane * 8;
#pragma unroll
        for (int i = 0; i < 8; ++i) {
            const f32x4 u0 = z[i][0] * wa0 + z[i + 1][0] * wb0 + z[i + 2][0] * wc0, u1 = z[i][1] * wa1 + z[i + 1][1] * wb1 + z[i + 2][1] * wc1;
            *(u32x4*)(dstb + (size_t)i * 512) = (u32x4){pk2(u0.x, u0.y), pk2(u0.z, u0.w), pk2(u1.x, u1.y), pk2(u1.z, u1.w)};
            if (seg == 1) {
                const f32x4 a = u0 * k0, bq = u1 * k1;
                float sq = (a.x * a.x + a.y * a.y) + (a.z * a.z + a.w * a.w) + (bq.x * bq.x + bq.y * bq.y) + (bq.z * bq.z + bq.w * bq.w);
                sq += __shfl_xor(sq, 1); sq += __shfl_xor(sq, 2); sq += __shfl_xor(sq, 4);
                const float rn = rsqrtf(sq + 1e-12f);
                const f32x4 ka_ = a * rn, kb_ = bq * rn; *(u32x4*)(KK + (size_t)(r0 + i) * 512 + lane * 8) = (u32x4){pk2(ka_.x, ka_.y), pk2(ka_.z, ka_.w), pk2(kb_.x, kb_.y), pk2(kb_.z, kb_.w)};
            }
        }
    }
    {
        const int cl = lane * 6, cc = 1536 + cl;
        const f32x2 zero2 = {0, 0};
        f32x2 z[10][3];
#pragma unroll
        for (int i = 0; i < 10; ++i) { const bool ok = (i > 0 || hp) && (i < 9 || hn);
#pragma unroll
            for (int q = 0; q < 3; ++q) { if (ok) { const unsigned w = *(const unsigned*)(zb + (size_t)i * RC + cc + 2 * q); z[i][q] = (f32x2){__builtin_bit_cast(float, w << 16), __builtin_bit_cast(float, w & 0xffff0000u)}; } else z[i][q] = zero2; } }
#pragma unroll
        for (int q = 0; q < 3; ++q) {
            const f32x2 wa = *(const f32x2*)(wts + cc + 2 * q), wb = *(const f32x2*)(wts + RC + cc + 2 * q), wcq = *(const f32x2*)(wts + 2 * RC + cc + 2 * q);
            const int cq = cl + 2 * q, grp = cq >> 7, k = cq & 127;
#pragma unroll
            for (int i = 0; i < 8; ++i) {
                f32x2 u = z[i][q] * wa + z[i + 1][q] * wb + z[i + 2][q] * wcq;
                if (grp == 0) { u.x = tanh_f(u.x); u.y = tanh_f(u.y); }
                else if (grp == 2) { u.x = sigmoid_f(u.x); u.y = sigmoid_f(u.y); }
                *(unsigned*)(AL + ((size_t)grp * NTOK + r0 + i) * 128 + k) = pk2(u.x, u.y);
            }
        }
    }
}

template <int CTRL> DI float dppf_(float x) { return __builtin_bit_cast(float, __builtin_amdgcn_mov_dpp(__builtin_bit_cast(int, x), CTRL, 0xf, 0xf, true)); }
template <int CTRL> DI float dpp_add(float x) { const int y = __builtin_amdgcn_mov_dpp(__builtin_bit_cast(int, x), CTRL, 0xf, 0xf, true); return x + __builtin_bit_cast(float, y); }
DI float red16(float x) { x = dpp_add<0xB1>(x); x = dpp_add<0x4E>(x); x = dpp_add<0x141>(x); x = dpp_add<0x140>(x); return x; }

constexpr int TC = 16;
DI float tred4(float q0, float q1, float q2, float q3, bool b0, bool b1) {
    const float ka = b0 ? q2 : q0, kb = b0 ? q3 : q1, sa = b0 ? q0 : q2, sb = b0 ? q1 : q3;
    const float a = ka + dppf_<0xB1>(sa), b = kb + dppf_<0xB1>(sb);
    float c = (b1 ? b : a) + dppf_<0x4E>(b1 ? a : b);
    c += dppf_<0x124>(c);
    c += dppf_<0x128>(c);
    return c;
}
DI f32x2 lo2(f32x4 v) { return __builtin_shufflevector(v, v, 0, 1); }
DI f32x2 hi2(f32x4 v) { return __builtin_shufflevector(v, v, 2, 3); }
struct ScanOps { f32x4 kk, rr, ww, bb, kd; float vv; };
struct ScanLd { f32x4 kk, r, dec, aa, kr, v; };
DI void scan_item(KP p, LAS unsigned char* lds, int latent, int sc, int qr, int tid) {
    const bf16_t* KK = (const bf16_t*)(p->ws + WS_KK); const bf16_t* R = (const bf16_t*)(p->ws + WS_R); const bf16_t* KR = (const bf16_t*)(p->ws + WS_KR);
    const bf16_t* VV = (const bf16_t*)(p->ws + WS_VV); const float* k_a = p->in[19];
    float* Y = (float*)(p->ws + WS_Y);
    const int b = sc >> 4, dir = (sc >> 3) & 1, h = sc & 7;
    const int T = latent ? DSEQ : SEQ; const size_t rowbase = latent ? (size_t)NCTX + (size_t)b * DSEQ : (size_t)b * SEQ;
    const float* DEC = (const float*)(p->ws + WS_DEC) + (size_t)dir * NTOK * 512; const bf16_t* AA = (const bf16_t*)(p->ws + WS_AA) + (size_t)dir * NTOK * 512;
    float* Yd = Y + (size_t)dir * NTOK * 512;
    LAS float* buf = (LAS float*)lds;
    LAS float* vb = (LAS float*)(lds + 2 * TC * 320 * 4);
    const int wave = tid >> 6, lane = tid & 63;
    const bool consumer = wave < 4;
    const int nchunk = T / TC;
    const int rl = lane >> 4, ks = lane & 15, row = 16 * qr + 4 * wave + rl;
    f32x2 S01 = {0, 0}, S23 = {0, 0};
    if (consumer && latent) { const f32x4 s4 = *(const f32x4*)(p->in[4] + ((((size_t)b * 2 + dir) * 8 + h) * 64 + row) * 64 + 4 * ks); S01 = lo2(s4); S23 = hi2(s4); }
    const int lt = tid - 256, lj = lt >> 4, li = lt & 15;
    ScanLd L0, L1; f32x4 ka4 = {0, 0, 0, 0};
    if (!consumer) ka4 = *(const f32x4*)(k_a + h * 64 + 4 * li);
    float* ybase = Yd + (rowbase)*512 + h * 64 + row;
    const bool kb0 = (ks & 1) != 0, kb1 = (ks & 2) != 0; const int ystep = 4 * (ks >> 2) + 2 * (ks & 1) + ((ks >> 1) & 1);
#define SCAN_LOAD(L, c) do { const int idx = (c) * TC + lj; const int tt = dir ? T - 1 - idx : idx; const size_t off = (rowbase + tt) * 512 + h * 64 + 4 * li; \
        L.kk = unpk4(*(const u32x2*)(KK + off)); L.r = unpk4(*(const u32x2*)(R + off)); L.dec = *(const f32x4*)(DEC + off); L.aa = unpk4(*(const u32x2*)(AA + off)); L.kr = unpk4(*(const u32x2*)(KR + off)); \
        if (lt < 64) { const int vj = lt >> 2, vq = lt & 3; const int idv = (c) * TC + vj; const int tv = dir ? T - 1 - idv : idv; L.v = unpk4(*(const u32x2*)(VV + (rowbase + tv) * 512 + h * 64 + 16 * qr + 4 * vq)); } } while (0)
#define SCAN_WRITE(L, bc, vc) do { const f32x4 bb_ = L.kk * L.aa; const f32x4 kd_ = L.kr * ((L.aa - 1.f) * ka4 + 1.f); LAS float* d_ = (bc) + lj * 320 + 4 * li; \
        *(LAS f32x4*)(d_) = L.kk; *(LAS f32x4*)(d_ + 64) = L.r; *(LAS f32x4*)(d_ + 128) = L.dec; *(LAS f32x4*)(d_ + 192) = bb_; *(LAS f32x4*)(d_ + 256) = kd_; \
        if (lt < 64) *(LAS f32x4*)((vc) + (lt >> 2) * 16 + 4 * (lt & 3)) = L.v; } while (0)
#define SCAN_LDOPS(o, bc, vc, j) do { const LAS float* d_ = (bc) + (j) * 320 + 4 * ks; o.kk = *(const LAS f32x4*)(d_); o.rr = *(const LAS f32x4*)(d_ + 64); o.ww = *(const LAS f32x4*)(d_ + 128); \
        o.bb = *(const LAS f32x4*)(d_ + 192); o.kd = *(const LAS f32x4*)(d_ + 256); o.vv = (vc)[(j) * 16 + 4 * wave + rl]; } while (0)
#define SCAN_COMPUTE(bc, vc, c) do { ScanOps oc, on, on2; SCAN_LDOPS(oc, bc, vc, 0); SCAN_LDOPS(on, bc, vc, 1); float ysel = 0.f; float yp0 = 0.f, yp1 = 0.f, yp2 = 0.f; \
        _Pragma("unroll") for (int j = 0; j < TC; ++j) { \
            if (j + 2 < TC) SCAN_LDOPS(on2, bc, vc, j + 2);     \
            f32x2 pq = S01 * lo2(oc.kk); pq = S23 * hi2(oc.kk) + pq; \
            const float sa = red16(pq.x + pq.y); \
            const f32x2 t01 = S01 * lo2(oc.ww) + lo2(oc.kd) * oc.vv, t23 = S23 * hi2(oc.ww) + hi2(oc.kd) * oc.vv; \
            S01 = t01 - lo2(oc.bb) * sa; S23 = t23 - hi2(oc.bb) * sa; \
            f32x2 yq = S01 * lo2(oc.rr); yq = S23 * hi2(oc.rr) + yq; \
            const float yp = yq.x + yq.y; \
            if ((j & 3) == 0) yp0 = yp; else if ((j & 3) == 1) yp1 = yp; else if ((j & 3) == 2) yp2 = yp; \
            else { const float yr = tred4(yp0, yp1, yp2, yp, kb0, kb1); ysel = ((ks >> 2) == (j >> 2)) ? yr : ysel; } \
            oc = on; on = on2; \
            asm volatile("" ::: "memory"); } \
        { const int idx = (c) * TC + ystep; const int tt = dir ? T - 1 - idx : idx; ybase[(size_t)tt * 512] = ysel; } } while (0)
    if (!consumer) { SCAN_LOAD(L0, 0); SCAN_LOAD(L1, 1); }
    for (int c = 0; c < nchunk; c += 2) {
        if (!consumer) SCAN_WRITE(L0, buf, vb);
        __syncthreads();
        if (!consumer) { if (c + 2 < nchunk) SCAN_LOAD(L0, c + 2); }
        else SCAN_COMPUTE(buf, vb, c);
        if (!consumer) SCAN_WRITE(L1, buf + TC * 320, vb + TC * 16);
        __syncthreads();
        if (!consumer) { if (c + 3 < nchunk) SCAN_LOAD(L1, c + 3); }
        else SCAN_COMPUTE(buf + TC * 320, vb + TC * 16, c + 1);
    }
#undef SCAN_LOAD
#undef SCAN_WRITE
#undef SCAN_LDOPS
#undef SCAN_COMPUTE
    if (consumer && !latent) *(f32x4*)(p->out + OUT_S + ((((size_t)b * 2 + dir) * 8 + h) * 64 + row) * 64 + 4 * ks) = (f32x4){S01.x, S01.y, S23.x, S23.y};
    __syncthreads();
}

constexpr int CS_L = 32, CS_LAT = 2048, CS_CHUNKS = 4096;
DI unsigned char* cs_mf(unsigned char* ws, int q) { return ws + 28 * MiB + (size_t)q * 8192; }
DI unsigned char* cs_q1(unsigned char* ws, int q) { return q < CS_LAT ? ws + 60 * MiB + (size_t)q * 4096 : ws + 76 * MiB + (size_t)(q - CS_LAT) * 4096; }
DI unsigned char* cs_q2(unsigned char* ws, int q) { return q < CS_LAT ? ws + 92 * MiB + (size_t)q * 4096 : ws + 108 * MiB + (size_t)(q - CS_LAT) * 4096; }
DI unsigned char* cs_nt(unsigned char* ws, int q) { return q < CS_LAT ? ws + 202 * MiB + (size_t)q * 8192 : ws + 234 * MiB + (size_t)(q - CS_LAT) * 8192; }
constexpr int CS_G = 51456;
DI bf16x8 frag_nat(const LAS unsigned char* img, int pitch, int rc, int s, int hh) { return *(const LAS bf16x8*)(img + rc * pitch + (16 * s + 8 * hh) * 2); }
DI bf16x8 frag_krow(const LAS unsigned char* img, int pitch, int rc, int s, int hh) {
    const s16x4 lo = *(const LAS s16x4*)(img + rc * pitch + (16 * s + 4 * hh) * 2), hi = *(const LAS s16x4*)(img + rc * pitch + (16 * s + 8 + 4 * hh) * 2);
    return __builtin_shufflevector(lo, hi, 0, 1, 2, 3, 4, 5, 6, 7); }
DI bf16x8 frag_tr(const LAS unsigned char* img, int pitch, int col0, int s, int lane) {
    const int i16 = lane & 15, tq = i16 >> 2, tp = i16 & 3, blk = (lane >> 4) & 1, hh = lane >> 5;
    const LAS unsigned char* bs = img + (16 * s + 4 * hh + tq) * pitch + (col0 + 16 * blk) * 2 + 8 * tp;
    const s16x4 lo = vtr(bs), hi = vtr(bs + 8 * pitch);
    return __builtin_shufflevector(lo, hi, 0, 1, 2, 3, 4, 5, 6, 7); }
template <int S> DI bf16x8 pack8(const f32x16& x, float sg) {
    u32x4 w; w.x = pk2(sg * x[8 * S], sg * x[8 * S + 1]); w.y = pk2(sg * x[8 * S + 2], sg * x[8 * S + 3]); w.z = pk2(sg * x[8 * S + 4], sg * x[8 * S + 5]); w.w = pk2(sg * x[8 * S + 6], sg * x[8 * S + 7]);
    return __builtin_bit_cast(bf16x8, w); }
template <int S> DI bf16x8 pack8lo(const f32x16& x, bf16x8 hi) {
    const u32x4 h = __builtin_bit_cast(u32x4, hi); float d[8];
#pragma unroll
    for (int j = 0; j < 4; ++j) { d[2 * j] = x[8 * S + 2 * j] - __builtin_bit_cast(float, h[j] << 16); d[2 * j + 1] = x[8 * S + 2 * j + 1] - __builtin_bit_cast(float, h[j] & 0xffff0000u); }
    u32x4 w; w.x = pk2(d[0], d[1]); w.y = pk2(d[2], d[3]); w.z = pk2(d[4], d[5]); w.w = pk2(d[6], d[7]);
    return __builtin_bit_cast(bf16x8, w); }
DI void lds_barrier() { asm volatile("s_waitcnt lgkmcnt(0)" ::: "memory"); __builtin_amdgcn_s_barrier(); asm volatile("" ::: "memory"); }
DI f32x16 zero16() { f32x16 z;
#pragma unroll
    for (int i = 0; i < 16; ++i) z[i] = 0.f;
    return z; }

DI void cs_phaseA(KP p, LAS unsigned char* lds, int tid, int qbase, int nit, int first, int stride) {
    const bf16_t* KK = (const bf16_t*)(p->ws + WS_KK); const bf16_t* R = (const bf16_t*)(p->ws + WS_R); const bf16_t* KR = (const bf16_t*)(p->ws + WS_KR);
    const bf16_t* VV = (const bf16_t*)(p->ws + WS_VV); const float* k_a = p->in[19];
    const int wave = tid >> 6, lane = tid & 63, g = wave >> 2, wq = wave & 3, tg = wq * 64 + lane, hh = lane >> 5, r32 = lane & 31;
    LAS unsigned char* L = lds + g * CS_G;
    LAS unsigned char* MKK = L, *MBT = L + 4608, *MKT = L + 2 * 4608, *MRT = L + 3 * 4608, *MBH = L + 4 * 4608, *MKH = L + 5 * 4608, *MVM = L + 6 * 4608;
    LAS float* AF = (LAS float*)(L + 32256);
    LAS unsigned char* ST = L + 36352, *SKK = ST + 2560, *SRB = ST + 2 * 2560, *SRK = ST + 3 * 2560;
    LAS float* SEG = (LAS float*)(L + 46592); LAS float* ELv = (LAS float*)(L + 48640);
    LAS unsigned char* SA = L + 48896;
    f32x2 lwN[4], kkN[4], aaN[4], krN[4], rN[4]; u32x4 vmN;
#define CSA_FETCH(it_) do { const int q_ = qbase + (it_) * 2 + g; const bool lat_ = q_ < CS_LAT; const int sc_ = lat_ ? (q_ >> 6) : ((q_ - CS_LAT) >> 3), ci_ = lat_ ? (q_ & 63) : (q_ & 7), TT_ = lat_ ? DSEQ : SEQ; \
        const int b_ = sc_ >> 4, dir_ = (sc_ >> 3) & 1, h_ = sc_ & 7; const int rb_ = lat_ ? NCTX + b_ * DSEQ : b_ * SEQ; \
          \
        const int t0_ = dir_ ? TT_ - 1 - ci_ * CS_L : ci_ * CS_L, sg_ = dir_ ? -512 : 512; \
        const unsigned ub_ = (unsigned)((rb_ + t0_) * 512 + h_ * 64); \
        const unsigned o0_ = ub_ + (unsigned)(sg_ * 4 * (tg >> 5) + 2 * (tg & 31)); \
        const float* DEC_ = (const float*)(p->ws + WS_DEC) + (size_t)dir_ * NTOK * 512; const bf16_t* AA_ = (const bf16_t*)(p->ws + WS_AA) + (size_t)dir_ * NTOK * 512; \
        _Pragma("unroll") for (int j = 0; j < 4; ++j) { const unsigned off = o0_ + (unsigned)(sg_ * j); \
            lwN[j] = *(const f32x2*)(DEC_ + off); kkN[j] = ldh2(KK + off); aaN[j] = ldh2(AA_ + off); krN[j] = ldh2(KR + off); rN[j] = ldh2(R + off); } \
        vmN = *(const u32x4*)(VV + (ub_ + (unsigned)(sg_ * (tg >> 3) + (tg & 7) * 8))); } while (0)
    if (first < nit) CSA_FETCH(first);
    for (int it = first; it < nit; it += stride) {
        const int q = qbase + it * 2 + g; const bool lat = q < CS_LAT;
        const int sc = lat ? (q >> 6) : ((q - CS_LAT) >> 3), ci = lat ? (q & 63) : (q & 7), TT = lat ? DSEQ : SEQ;
        const int b = sc >> 4, dir = (sc >> 3) & 1, h = sc & 7;
        const size_t rowbase = lat ? (size_t)NCTX + (size_t)b * DSEQ : (size_t)b * SEQ;
        const float* DEC = (const float*)(p->ws + WS_DEC) + (size_t)dir * NTOK * 512; const bf16_t* AA = (const bf16_t*)(p->ws + WS_AA) + (size_t)dir * NTOK * 512;
        {
            const int kp = tg & 31, seg = tg >> 5;
            f32x2 lw[4], kk2[4], aa2[4], kr2[4], r2[4];
#pragma unroll
            for (int j = 0; j < 4; ++j) { lw[j] = lwN[j]; kk2[j] = kkN[j]; aa2[j] = aaN[j]; kr2[j] = krN[j]; r2[j] = rN[j]; }
            const u32x4 vmC = vmN;
            if (it + stride < nit) CSA_FETCH(it + stride);
            f32x2 ss = {0.f, 0.f};
#pragma unroll
            for (int j = 0; j < 4; ++j) { lw[j].x = __logf(lw[j].x); lw[j].y = __logf(lw[j].y); ss += lw[j]; }
            *(LAS f32x2*)(SEG + seg * 64 + 2 * kp) = ss;
            { const int i = tg >> 3, v0 = (tg & 7) * 8; *(LAS u32x4*)(MVM + i * 144 + v0 * 2) = vmC; }
            lds_barrier();
            f32x2 pre = {0.f, 0.f}, tot = {0.f, 0.f};
#pragma unroll
            for (int s8 = 0; s8 < 8; ++s8) { const f32x2 v = *(const LAS f32x2*)(SEG + s8 * 64 + 2 * kp); tot += v; if (s8 < seg) pre += v; }
            if (seg == 0) *(LAS f32x2*)(ELv + 2 * kp) = (f32x2){__expf(tot.x), __expf(tot.y)};
            const f32x2 ka = *(const f32x2*)(k_a + h * 64 + 2 * kp);
            f32x2 cwp = pre;
#pragma unroll
            for (int j = 0; j < 4; ++j) {
                const f32x2 cw = cwp + lw[j];
                const f32x2 E = {__expf(cw.x), __expf(cw.y)}, Ei = {__expf(-cw.x), __expf(-cw.y)}, Ep = {__expf(cwp.x), __expf(cwp.y)}, Eh = {__expf(tot.x - cw.x), __expf(tot.y - cw.y)};
                const f32x2 bb = kk2[j] * aa2[j], kd = kr2[j] * ((aa2[j] - 1.f) * ka + 1.f);
                const int o = (4 * seg + j) * 144 + 4 * kp;
                const f32x2 x0 = kk2[j] * Ep, x1 = bb * Ei, x2 = kd * Ei, x3 = r2[j] * E, x4 = bb * Eh, x5 = kd * Eh;
                *(LAS unsigned*)(MKK + o) = pk2(x0.x, x0.y); *(LAS unsigned*)(MBT + o) = pk2(x1.x, x1.y); *(LAS unsigned*)(MKT + o) = pk2(x2.x, x2.y);
                *(LAS unsigned*)(MRT + o) = pk2(x3.x, x3.y); *(LAS unsigned*)(MBH + o) = pk2(x4.x, x4.y); *(LAS unsigned*)(MKH + o) = pk2(x5.x, x5.y);
                cwp = cw;
            }
        }
        lds_barrier();
        {
            const LAS unsigned char* ia = wq < 2 ? MKK : MRT; const LAS unsigned char* ib = (wq & 1) ? MKT : MBT;
            f32x16 acc = zero16();
#pragma unroll
            for (int s4 = 0; s4 < 4; ++s4) acc = MFMA32(frag_nat(ia, 144, r32, s4, hh), frag_nat(ib, 144, r32, s4, hh), acc);
#pragma unroll
            for (int i = 0; i < 16; ++i) { const int row = crow(i, hh); const bool keep = wq < 2 ? (row > r32) : (row >= r32); const float v = keep ? acc[i] : 0.f;
                if (wq == 0) { AF[row * 32 + r32] = v; *(LAS unsigned short*)(SA + row * 80 + r32 * 2) = (row >= 16 && r32 < 16) ? (unsigned short)(pk2(v, 0.f) & 0xffffu) : (unsigned short)0; }
                else *(LAS unsigned short*)((wq == 1 ? SKK : (wq == 2 ? SRB : SRK)) + row * 80 + r32 * 2) = (unsigned short)(pk2(v, 0.f) & 0xffffu); }
        }
        lds_barrier();
        f32x16 X = zero16(), NT0 = zero16(), NT1 = zero16(), Q2 = zero16();
        const int c = wq & 1;
        if (wq == 0) {
            const int blk = r32 >> 4, cc = r32 & 15;
            float Tc[16];
#pragma unroll
            for (int i = 0; i < 16; ++i) {
                float a4[4] = {(i == cc) ? 1.f : 0.f, 0.f, 0.f, 0.f};
#pragma unroll
                for (int j4 = 0; j4 < (i + 3) / 4; ++j4) { const f32x4 ar = *(const LAS f32x4*)(AF + (16 * blk + i) * 32 + 16 * blk + 4 * j4);
#pragma unroll
                    for (int e = 0; e < 4; ++e) if (4 * j4 + e < i) a4[e] -= ar[e] * Tc[4 * j4 + e]; }
                const float a = (a4[0] + a4[1]) + (a4[2] + a4[3]);
                Tc[i] = a;
                if (lane < 32) { *(LAS unsigned short*)(ST + (16 * blk + i) * 80 + (16 * blk + cc) * 2) = (unsigned short)(pk2(a, 0.f) & 0xffffu);
                                 *(LAS unsigned short*)(ST + (16 * blk + i) * 80 + (16 * (1 - blk) + cc) * 2) = (unsigned short)0; }
            }
            asm volatile("s_waitcnt lgkmcnt(0)" ::: "memory");
            f32x16 E = zero16();
            E = MFMA32(frag_krow(SA, 80, r32, 0, hh), frag_tr(ST, 80, 0, 0, lane), E); E = MFMA32(frag_krow(SA, 80, r32, 1, hh), frag_tr(ST, 80, 0, 1, lane), E);
#pragma unroll
            for (int i = 0; i < 16; ++i) E[i] = ((crow(i, hh) == r32) ? 1.f : 0.f) - E[i];
            f32x16 Tm = zero16();
            Tm = MFMA32(frag_krow(ST, 80, r32, 0, hh), pack8<0>(E, 1.f), Tm); Tm = MFMA32(frag_krow(ST, 80, r32, 1, hh), pack8<1>(E, 1.f), Tm);
            asm volatile("s_waitcnt lgkmcnt(0)" ::: "memory");
#pragma unroll
            for (int i = 0; i < 16; ++i) *(LAS unsigned short*)(ST + crow(i, hh) * 80 + r32 * 2) = (unsigned short)(pk2(Tm[i], 0.f) & 0xffffu);
        } else if (wq >= 2) {
#pragma unroll
            for (int s2 = 0; s2 < 2; ++s2) {
                const bf16x8 vm = frag_tr(MVM, 144, 32 * c, s2, lane);
                X = MFMA32(frag_krow(SKK, 80, r32, s2, hh), vm, X);
                Q2 = MFMA32(frag_krow(SRK, 80, r32, s2, hh), vm, Q2);
                NT0 = MFMA32(frag_tr(MKH, 144, 0, s2, lane), vm, NT0);
                NT1 = MFMA32(frag_tr(MKH, 144, 32, s2, lane), vm, NT1);
            }
        }
        lds_barrier();
        if (wq < 2) {
            f32x16 P1 = zero16();
#pragma unroll
            for (int s2 = 0; s2 < 2; ++s2) P1 = MFMA32(frag_krow(ST, 80, r32, s2, hh), frag_tr(MKK, 144, 32 * c, s2, lane), P1);
            const bf16x8 n0 = pack8<0>(P1, -1.f), n1 = pack8<1>(P1, -1.f);
            f32x16 Q1t;
#pragma unroll
            for (int g4 = 0; g4 < 4; ++g4) { const u32x2 w = *(const LAS u32x2*)(MRT + r32 * 144 + (32 * c + 8 * g4 + 4 * hh) * 2); const f32x4 f = unpk4(w);
                Q1t[4 * g4] = f.x; Q1t[4 * g4 + 1] = f.y; Q1t[4 * g4 + 2] = f.z; Q1t[4 * g4 + 3] = f.w; }
            Q1t = MFMA32(n0, frag_krow(SRB, 80, r32, 0, hh), Q1t); Q1t = MFMA32(n1, frag_krow(SRB, 80, r32, 1, hh), Q1t);
            u32x4* q1f = (u32x4*)cs_q1(p->ws, q) + (c * 2) * 64 + lane;
            q1f[0] = __builtin_bit_cast(u32x4, pack8<0>(Q1t, 1.f)); q1f[64] = __builtin_bit_cast(u32x4, pack8<1>(Q1t, 1.f));
#pragma unroll
            for (int bq = 0; bq < 2; ++bq) {
                f32x16 M = zero16();
                if (bq == c) {
#pragma unroll
                    for (int i = 0; i < 16; ++i) M[i] = (crow(i, hh) == r32) ? ELv[32 * c + r32] : 0.f;
                }
                M = MFMA32(n0, frag_tr(MBH, 144, 32 * bq, 0, lane), M); M = MFMA32(n1, frag_tr(MBH, 144, 32 * bq, 1, lane), M);
                u32x4* mf = (u32x4*)cs_mf(p->ws, q) + ((c * 2 + bq) * 2) * 64 + lane;
                mf[0] = __builtin_bit_cast(u32x4, pack8<0>(M, 1.f)); mf[64] = __builtin_bit_cast(u32x4, pack8<1>(M, 1.f));
            }
        } else {
            f32x16 P2 = zero16();
            P2 = MFMA32(frag_krow(ST, 80, r32, 0, hh), pack8<0>(X, 1.f), P2); P2 = MFMA32(frag_krow(ST, 80, r32, 1, hh), pack8<1>(X, 1.f), P2);
            const bf16x8 n0 = pack8<0>(P2, -1.f), n1 = pack8<1>(P2, -1.f);
            Q2 = MFMA32(frag_krow(SRB, 80, r32, 0, hh), n0, Q2); Q2 = MFMA32(frag_krow(SRB, 80, r32, 1, hh), n1, Q2);
            NT0 = MFMA32(frag_tr(MBH, 144, 0, 0, lane), n0, NT0); NT0 = MFMA32(frag_tr(MBH, 144, 0, 1, lane), n1, NT0);
            NT1 = MFMA32(frag_tr(MBH, 144, 32, 0, lane), n0, NT1); NT1 = MFMA32(frag_tr(MBH, 144, 32, 1, lane), n1, NT1);
            unsigned* q2f = (unsigned*)cs_q2(p->ws, q) + c * 512 + lane;
#pragma unroll
            for (int i = 0; i < 8; ++i) q2f[i * 64] = pk2(Q2[2 * i], Q2[2 * i + 1]);
            unsigned* ntf = (unsigned*)cs_nt(p->ws, q) + (c * 2) * 512 + lane;
#pragma unroll
            for (int i = 0; i < 8; ++i) { ntf[i * 64] = pk2(NT0[2 * i], NT0[2 * i + 1]); ntf[512 + i * 64] = pk2(NT1[2 * i], NT1[2 * i + 1]); }
        }
        lds_barrier();
    }
#undef CSA_FETCH
}


constexpr int CSB_SLOT = 24576;
DI void cs_phaseB(KP p, LAS unsigned char* lds, int latent, int sc, int tid) {
    const int wave = tid >> 6, lane = tid & 63, hh = lane >> 5, r32 = lane & 31;
    const int nch = latent ? 64 : 8, q0 = latent ? sc * 64 : CS_LAT + sc * 8, TT = latent ? DSEQ : SEQ;
    const int b = sc >> 4, dir = (sc >> 3) & 1, h = sc & 7, c = wave & 1;
    const size_t rowbase = latent ? (size_t)NCTX + (size_t)b * DSEQ : (size_t)b * SEQ;
    const bool consumer = wave < 2;
    float* Yu = p->out + (size_t)dir * NTOK * 512 + rowbase * 512 + h * 64 + 32 * c;
    const unsigned ylane = (unsigned)((dir ? 4 * (1 - hh) : 4 * hh) * 512 + r32);
    unsigned yv[8];
#pragma unroll
    for (int k = 0; k < 8; ++k) { const int rr_ = 2 * (k & 1) + 8 * (k >> 1); yv[k] = (ylane + (unsigned)((dir ? TT - CS_L + 27 - rr_ : rr_) * 512)) * 4u; }
    const unsigned ystepb = dir ? 0u - (unsigned)(CS_L * 512 * 4) : (unsigned)(CS_L * 512 * 4);
    f32x16 Z0 = zero16(), Z1 = zero16();
    if (consumer && latent) { const float* s0 = p->in[4] + ((((size_t)b * 2 + dir) * 8 + h) * 64 + 32 * c + r32) * 64;
#pragma unroll
      for (int g4 = 0; g4 < 4; ++g4) { const f32x4 a = *(const f32x4*)(s0 + 8 * g4 + 4 * hh), bq = *(const f32x4*)(s0 + 32 + 8 * g4 + 4 * hh);
          Z0[4 * g4] = a.x; Z0[4 * g4 + 1] = a.y; Z0[4 * g4 + 2] = a.z; Z0[4 * g4 + 3] = a.w; Z1[4 * g4] = bq.x; Z1[4 * g4 + 1] = bq.y; Z1[4 * g4 + 2] = bq.z; Z1[4 * g4 + 3] = bq.w; } }
    const int lt = tid - 128;
    u32x4 RG[2][4];
#define CSB_LOADQ(set, ch) do { const int q_ = q0 + (ch); _Pragma("unroll") for (int k_ = 0; k_ < 4; ++k_) { const int pi_ = lt + 384 * k_; \
        const unsigned char* src_ = pi_ < 512 ? cs_mf(p->ws, q_) + pi_ * 16 : (pi_ < 768 ? cs_q1(p->ws, q_) + (pi_ - 512) * 16 : (pi_ < 1280 ? cs_nt(p->ws, q_) + (pi_ - 768) * 16 : cs_q2(p->ws, q_) + (pi_ - 1280) * 16)); \
        RG[set][k_] = *(const u32x4*)src_; } } while (0)
#define CSB_WRITEQ(set, slot) do { _Pragma("unroll") for (int k_ = 0; k_ < 4; ++k_) *(LAS u32x4*)(lds + (slot) * CSB_SLOT + (lt + 384 * k_) * 16) = RG[set][k_]; } while (0)
    if (!consumer) { CSB_LOADQ(0, 0); CSB_LOADQ(1, 1); CSB_WRITEQ(0, 0); CSB_LOADQ(0, 2); }
    else __builtin_amdgcn_s_setprio(3);
    for (int ci0 = 0; ci0 < nch; ci0 += 2) {
#pragma unroll
        for (int u = 0; u < 2; ++u) {
            const int ci = ci0 + u;
            lds_barrier();
            if (!consumer) {
                if (ci + 1 < nch) { CSB_WRITEQ((u + 1) & 1, (ci + 1) & 1); if (ci + 3 < nch) CSB_LOADQ((u + 1) & 1, ci + 3); }
            } else {
                const LAS unsigned char* sl = lds + (ci & 1) * CSB_SLOT;
                bf16x8 MF[8], Q1[4]; f32x16 Y, N0, N1;
#pragma unroll
                for (int i = 0; i < 8; ++i) MF[i] = *(const LAS bf16x8*)(sl + (i * 64 + lane) * 16);
#pragma unroll
                for (int i = 0; i < 4; ++i) Q1[i] = *(const LAS bf16x8*)(sl + 8192 + (i * 64 + lane) * 16);
#pragma unroll
                for (int i = 0; i < 8; ++i) { const unsigned w0 = *(const LAS unsigned*)(sl + 12288 + ((c * 2) * 512 + i * 64 + lane) * 4), w1 = *(const LAS unsigned*)(sl + 12288 + ((c * 2 + 1) * 512 + i * 64 + lane) * 4),
                                                         w2 = *(const LAS unsigned*)(sl + 20480 + (c * 512 + i * 64 + lane) * 4);
                    N0[2 * i] = __builtin_bit_cast(float, w0 << 16); N0[2 * i + 1] = __builtin_bit_cast(float, w0 & 0xffff0000u);
                    N1[2 * i] = __builtin_bit_cast(float, w1 << 16); N1[2 * i + 1] = __builtin_bit_cast(float, w1 & 0xffff0000u);
                    Y[2 * i] = __builtin_bit_cast(float, w2 << 16); Y[2 * i + 1] = __builtin_bit_cast(float, w2 & 0xffff0000u); }
                const bf16x8 z00 = pack8<0>(Z0, 1.f), z01 = pack8<1>(Z0, 1.f), z10 = pack8<0>(Z1, 1.f), z11 = pack8<1>(Z1, 1.f);
                const bf16x8 l00 = pack8lo<0>(Z0, z00), l01 = pack8lo<1>(Z0, z01), l10 = pack8lo<0>(Z1, z10), l11 = pack8lo<1>(Z1, z11);
                Y = MFMA32(Q1[0], z00, Y); Y = MFMA32(Q1[1], z01, Y); Y = MFMA32(Q1[2], z10, Y); Y = MFMA32(Q1[3], z11, Y);
                N0 = MFMA32(MF[0], z00, N0); N0 = MFMA32(MF[1], z01, N0); N0 = MFMA32(MF[4], z10, N0); N0 = MFMA32(MF[5], z11, N0);
                N0 = MFMA32(MF[0], l00, N0); N0 = MFMA32(MF[1], l01, N0); N0 = MFMA32(MF[4], l10, N0); N0 = MFMA32(MF[5], l11, N0);
                N1 = MFMA32(MF[2], z00, N1); N1 = MFMA32(MF[3], z01, N1); N1 = MFMA32(MF[6], z10, N1); N1 = MFMA32(MF[7], z11, N1);
                N1 = MFMA32(MF[2], l00, N1); N1 = MFMA32(MF[3], l01, N1); N1 = MFMA32(MF[6], l10, N1); N1 = MFMA32(MF[7], l11, N1);
                Z0 = N0; Z1 = N1;
                if (dir) {
#pragma unroll
                    for (int i = 0; i < 16; ++i) *(float*)((char*)Yu + yv[(i >> 2) * 2 + ((i & 3) >> 1)] - 2048 * (i & 1)) = Y[i];
                } else {
#pragma unroll
                    for (int i = 0; i < 16; ++i) *(float*)((char*)Yu + yv[(i >> 2) * 2 + ((i & 3) >> 1)] + 2048 * (i & 1)) = Y[i];
                }
#pragma unroll
                for (int k = 0; k < 8; ++k) yv[k] += ystepb;
            }
        }
    }
#undef CSB_LOADQ
#undef CSB_WRITEQ
    __builtin_amdgcn_s_setprio(0);
    if (consumer && !latent) { float* so = p->out + OUT_S + ((((size_t)b * 2 + dir) * 8 + h) * 64 + 32 * c + r32) * 64;
#pragma unroll
        for (int g4 = 0; g4 < 4; ++g4) { *(f32x4*)(so + 8 * g4 + 4 * hh) = (f32x4){Z0[4 * g4], Z0[4 * g4 + 1], Z0[4 * g4 + 2], Z0[4 * g4 + 3]};
                                          *(f32x4*)(so + 32 + 8 * g4 + 4 * hh) = (f32x4){Z1[4 * g4], Z1[4 * g4 + 1], Z1[4 * g4 + 2], Z1[4 * g4 + 3]}; } }
    __syncthreads();
}

DI void post_row(KP p, int r, int lane) {
    const float* Y = p->out; const bf16_t* R = (const bf16_t*)(p->ws + WS_R); const bf16_t* KR = (const bf16_t*)(p->ws + WS_KR);
    const bf16_t* VV = (const bf16_t*)(p->ws + WS_VV); const bf16_t* AA = (const bf16_t*)(p->ws + WS_AA); const bf16_t* G = (const bf16_t*)(p->ws + WS_G);
    const float* k_a = p->in[19]; const float* r_k = p->in[20]; const float* lng = p->in[21]; const float* lnb = p->in[22];
    bf16_t* MIX = (bf16_t*)(p->ws + WS_MIX);
    const int c = lane * 8; const size_t off = (size_t)r * 512 + c;
    float y[8], rr[8], kr[8], vv[8], a0[8], a1[8], gg[8], ka[8], rk[8], lg[8], lb[8];
#define LD8(dst, ptr) do { const f32x4 _a = *(const f32x4*)(ptr), _b = *(const f32x4*)((ptr) + 4); dst[0] = _a.x; dst[1] = _a.y; dst[2] = _a.z; dst[3] = _a.w; dst[4] = _b.x; dst[5] = _b.y; dst[6] = _b.z; dst[7] = _b.w; } while (0)
#define LD8H(dst, ptr) do { const u32x4 _w = *(const u32x4*)(ptr); const f32x4 _a = unpk4((u32x2){_w.x, _w.y}), _b = unpk4((u32x2){_w.z, _w.w}); dst[0] = _a.x; dst[1] = _a.y; dst[2] = _a.z; dst[3] = _a.w; dst[4] = _b.x; dst[5] = _b.y; dst[6] = _b.z; dst[7] = _b.w; } while (0)
    LD8(y, Y + off); LD8(rr, Y + (size_t)NTOK * 512 + off);
#pragma unroll
    for (int j = 0; j < 8; ++j) y[j] += rr[j];
    LD8H(rr, R + off); LD8H(kr, KR + off); LD8H(vv, VV + off); LD8H(a0, AA + off); LD8H(a1, AA + (size_t)NTOK * 512 + off); LD8H(gg, G + off);
    LD8(ka, k_a + c); LD8(rk, r_k + c); LD8(lg, lng + c); LD8(lb, lnb + c);
#undef LD8
#undef LD8H
    float s = 0.f, d0 = 0.f, d1 = 0.f;
#pragma unroll
    for (int j = 0; j < 8; ++j) { s += y[j]; const float q = rr[j] * kr[j] * rk[j]; d0 += q * (1.f + (a0[j] - 1.f) * ka[j]); d1 += q * (1.f + (a1[j] - 1.f) * ka[j]); }
    float bd = d0 + d1;
    s += __shfl_xor(s, 1); s += __shfl_xor(s, 2); s += __shfl_xor(s, 4);
    bd += __shfl_xor(bd, 1); bd += __shfl_xor(bd, 2); bd += __shfl_xor(bd, 4);
    const float mu = s * (1.f / 64.f);
    float q2 = 0.f;
#pragma unroll
    for (int j = 0; j < 8; ++j) { y[j] -= mu; q2 += y[j] * y[j]; }
    q2 += __shfl_xor(q2, 1); q2 += __shfl_xor(q2, 2); q2 += __shfl_xor(q2, 4);
    const float rs = rsqrtf(q2 * (1.f / 64.f) + GN_EPS);
    float o[8];
#pragma unroll
    for (int j = 0; j < 8; ++j) o[j] = (y[j] * rs * lg[j] + lb[j] + bd * vv[j]) * gg[j];
    *(u32x4*)(MIX + (size_t)r * D + 512 + c) = (u32x4){pk2(o[0], o[1]), pk2(o[2], o[3]), pk2(o[4], o[5]), pk2(o[6], o[7])};
}

DI void act_fix(KP p, int pm, int e, int c) {
    const float* EDGE = (const float*)(p->ws + WS_EDGE); bf16_t* ACT = (bf16_t*)(p->ws + WS_ACT); const float* wc = p->in[27];
    const bool need = e == 0 ? (pm != 16 && pm != 24) : (pm != 23 && pm != 31);
    if (!need) return;
    const int r = pm * 256 + (e ? 255 : 0), nbpm = e ? pm + 1 : pm - 1;
    const float* nb = EDGE + ((size_t)nbpm * 2 + (1 - e)) * DFF + c;
    const float* eu = EDGE + ((size_t)pm * 2 + e) * DFF + 64 * DFF + c; const float* e3 = eu + 64 * DFF;
    const float* w = wc + (e ? 2 * DFF : 0) + c;
    float o[8];
#pragma unroll
    for (int j = 0; j < 8; ++j) o[j] = silu_f(eu[j] + w[j] * nb[j]) * e3[j];
    *(u32x4*)(ACT + (size_t)r * DFF + c) = (u32x4){pk2(o[0], o[1]), pk2(o[2], o[3]), pk2(o[4], o[5]), pk2(o[6], o[7])};
}

template <int NR>
DI void final_rows(KP p, int rbase, int rstride, int lane) {
    const float* MODb = (const float*)(p->ws + WS_MOD);
    const bf16_t* PART = (const bf16_t*)(p->ws + WS_PART); const float* nf = p->in[29];
    f32x4 v[NR][4]; u32x2 p0[NR][4], p1[NR][4];
#pragma unroll
    for (int q = 0; q < NR; ++q) { const int r = rbase + q * rstride; const f32x4* xr = (const f32x4*)(p->out + (size_t)r * D) + lane;
#pragma unroll
        for (int j = 0; j < 4; ++j) { v[q][j] = xr[64 * j]; p0[q][j] = *((const u32x2*)(PART + (size_t)r * D) + lane + 64 * j); p1[q][j] = *((const u32x2*)(PART + (size_t)(NTOK + r) * D) + lane + 64 * j); } }
    float s[NR];
#pragma unroll
    for (int q = 0; q < NR; ++q) { const int r = rbase + q * rstride; const float* MOD = MODb + midx_of(r) * 6144; s[q] = 0.f;
#pragma unroll
        for (int j = 0; j < 4; ++j) { const f32x4 gt = *((const f32x4*)(MOD + 5 * D) + lane + 64 * j); v[q][j] = v[q][j] + gt * (unpk4(p0[q][j]) + unpk4(p1[q][j]));
            s[q] += (v[q][j].x * v[q][j].x + v[q][j].y * v[q][j].y) + (v[q][j].z * v[q][j].z + v[q][j].w * v[q][j].w); } }
#pragma unroll
    for (int o = 1; o < 64; o <<= 1) {
#pragma unroll
        for (int q = 0; q < NR; ++q) s[q] += __shfl_xor(s[q], o); }
#pragma unroll
    for (int q = 0; q < NR; ++q) { const int r = rbase + q * rstride; f32x4* xr = (f32x4*)(p->out + (size_t)r * D) + lane; const float rstd = rsqrtf(s[q] * (1.f / D) + EPS);
#pragma unroll
        for (int j = 0; j < 4; ++j) xr[64 * j] = v[q][j] * rstd * *((const f32x4*)nf + lane + 64 * j); }
}

DI int lane_id() { int l; asm volatile("v_mbcnt_lo_u32_b32 %0, -1, 0\n\tv_mbcnt_hi_u32_b32 %0, -1, %0" : "=v"(l)); return l; }
#define XB_TMO      128
#define XB_XCNT(j)  (256  + 64 * (j))
#define XB_XSUB(j)  (1280 + 64 * (j))
#define XB_XGEN(j)  (2304 + 64 * (j))
#define XB_TOP      3328
#define XB_TOPGEN   3392
#define XB_SUBBAR   3520
#define XB_SPIN_CAP (1u << 18)
DI unsigned xb_ld(unsigned* p)              { return __hip_atomic_load(p, __ATOMIC_RELAXED, __HIP_MEMORY_SCOPE_AGENT); }
DI unsigned xb_add(unsigned* p, unsigned v) { return __hip_atomic_fetch_add(p, v, __ATOMIC_RELAXED, __HIP_MEMORY_SCOPE_AGENT); }
DI unsigned xb_xcc_id() { return (unsigned)__builtin_amdgcn_s_getreg((3 << 11) | 20) & 0xFu; }
#define XB_SPIN(cond, bar) do { unsigned _sp = 0; while (cond) { __builtin_amdgcn_s_sleep(1); \
    if ((++_sp & 255u) == 0u) { if (xb_ld(&(bar)[XB_TMO])) break; if (_sp > XB_SPIN_CAP) { atomicAdd(&(bar)[XB_TMO], 1u); break; } } } } while (0)
DI void xcd_barrier_complete(unsigned* bar, unsigned x, unsigned G, unsigned& nloc, unsigned& nx) {
    unsigned sum, cnt, mine, sp = 0u;
    for (;;) {
        sum = 0u; cnt = 0u; mine = 0u;
#pragma unroll
        for (unsigned j = 0; j < 16; ++j) { const unsigned c = xb_ld(&bar[XB_XCNT(j)]); sum += c; cnt += (c > 0u) ? 1u : 0u; mine = (j == x) ? c : mine; }
        if (sum == G) break;
        __builtin_amdgcn_s_sleep(1);
        if ((++sp & 255u) == 0u) { if (xb_ld(&bar[XB_TMO])) break; if (sp > XB_SPIN_CAP) { atomicAdd(&bar[XB_TMO], 1u); break; } }
    }
    nloc = mine > 0u ? mine : 1u; nx = cnt > 0u ? cnt : 1u;
}
DI void grid_bar(unsigned* bar, volatile LAS unsigned* st, unsigned G, int wave_s) {
    asm volatile("s_waitcnt vmcnt(0)" ::: "memory");
    __syncthreads();
    int t = wave_s * 64 + lane_id(); asm volatile("" : "+v"(t));
    if (t == 0) {
        __builtin_amdgcn_s_waitcnt(0);
        const unsigned x = xb_xcc_id();
        unsigned nloc = st[0], nx = st[1];
        if (nloc == 0u) { xcd_barrier_complete(bar, x, G, nloc, nx); st[0] = nloc; st[1] = nx; }
        const unsigned old = xb_add(&bar[XB_XSUB(x)], 1u);
        const unsigned gen = old / nloc;
        if (old + 1u == (gen + 1u) * nloc) {
            __builtin_amdgcn_fence(__ATOMIC_RELEASE, "agent");
            asm volatile("s_waitcnt vmcnt(0)" ::: "memory");
            const unsigned og = xb_add(&bar[XB_TOP], 1u);
            const unsigned tg = og / nx;
            if (og + 1u == (tg + 1u) * nx) xb_add(&bar[XB_TOPGEN], 1u);
            else XB_SPIN(xb_ld(&bar[XB_TOPGEN]) == tg, bar);
            __builtin_amdgcn_fence(__ATOMIC_ACQUIRE, "agent");
            xb_add(&bar[XB_XGEN(x)], 1u);
            asm volatile("s_waitcnt vmcnt(0)" ::: "memory");
        } else {
            XB_SPIN(xb_ld(&bar[XB_XGEN(x)]) == gen, bar);
            __builtin_amdgcn_fence(__ATOMIC_ACQUIRE, "agent");
            asm volatile("s_waitcnt vmcnt(0)" ::: "memory");
        }
    }
    __syncthreads();
}

__global__ void __launch_bounds__(512, 2) fwd_megakernel(Params kparams) {
    const KP kp0 = (KP)__builtin_amdgcn_kernarg_segment_ptr();
    extern __shared__ __attribute__((aligned(16))) unsigned char lds_raw[];
    LAS unsigned char* lds = (LAS unsigned char*)lds_raw;
    const int wave_s = __builtin_amdgcn_readfirstlane((int)threadIdx.x >> 6);
    volatile LAS unsigned* xbst = (volatile LAS unsigned*)(lds + LDS_XB);
    {
        int t0_ = wave_s * 64 + lane_id();
        if (t0_ == 0) { xbst[0] = 0u; xbst[1] = 0u; (void)xb_add((unsigned*)(kp0->ws + WS_BAR) + XB_XCNT(xb_xcc_id()), 1u); }
        __syncthreads();
    }
#define GRID_SYNC() grid_bar((unsigned*)(kp0->ws + WS_BAR), xbst, (unsigned)G, wave_s)
    const int G = gridDim.x, bx = blockIdx.x, NGW = G * 8, NGT = G * 512;
#define PH_VARS KP p = kp0; asm volatile("" : "+s"(p)); unsigned char* ws = p->ws; (void)ws; \
    int tid = wave_s * 64 + lane_id(); asm volatile("" : "+v"(tid)); const int lane = tid & 63, wave = wave_s, gw = bx * 8 + wave, gtid = bx * 512 + tid; (void)lane; (void)gw; (void)gtid;

    const bool defer_ffn = (G == 256);
    { PH_VARS phase0(p, lds, gw, NGW, gtid, NGT, wave, lane, defer_ffn); }
    GRID_SYNC();
    if (G > (1 << 20)) cg::this_grid().sync();
    { PH_VARS for (int r = gw; r < NTOK; r += 4 * NGW) norm_rows<0, 4>(p, r, NGW, lane, p->in[9], 0, D, 0, (bf16_t*)(ws + WS_H), nullptr); }
    GRID_SYNC();
    {
        PH_VARS
        pg8::Gemm g{(const bf16_t*)(ws + WS_H), (const bf16_t*)(ws + WS_WTIN), D, D, D};
        pg8::SchedPlain S; S.o.init(NTOK / 256, NINP / 256, G, bx);
        pg8::EpiIn E{(bf16_t*)(ws + WS_Q), (bf16_t*)(ws + WS_ZR), p->out + OUT_K, 0.125f * LOG2E};
        pg8::gemm_phase(lds, g, S, E, tid);
        if (defer_ffn && bx >= 192) { p0_misc(p, (bx - 192) * 512 + tid, 64 * 512); ffn_transposes(p, lds, 0, (bx - 192) * 8 + wave, 64 * 8, wave, lane); }
    }
    GRID_SYNC();
    {
        PH_VARS
        LAS float* rpbL = (LAS float*)lds;
        for (int i = tid; i < 8 * 465; i += 512) rpbL[i] = p->in[23][i] * LOG2E;
        __syncthreads();
        LAS unsigned char* vbuf = lds + 16384 + wave * 4608;
        LAS float* xch = (LAS float*)(lds + 65536) + (wave & 3) * 2176;
        const int vb = (G & 7) == 0 ? (bx & 7) * (G >> 3) + (bx >> 3) : bx;
        for (int u0 = vb * 4; u0 < 1024; u0 += G * 4) {
            if (wave < 4) { attn_unit<true, 2>(p, vbuf, rpbL, u0 + wave, lane, 0, 20, xch); attn_unit<false, 0>(p, vbuf, rpbL, u0 + wave, lane, 0, 8, xch); }
            else { attn_unit<true, 1>(p, vbuf, rpbL, u0 + wave - 4, lane, 20, 32, xch); prep_rows8(p, (u0 + wave - 4) * 8, lane); }
            __syncthreads();
        }
    }
    GRID_SYNC();
    {
        PH_VARS
        int kl = 128; asm volatile("" : "+s"(kl));
        pg8::Gemm g{(const bf16_t*)(ws + WS_ALORA), (const bf16_t*)(ws + WS_WTLORA), kl, 128, 128};
        pg8::SchedLora S; S.G = G; S.c = bx;
        pg8::EpiLora E{(float*)(ws + WS_DEC), (float*)(ws + WS_AA), (float*)(ws + WS_G), p->in[13], p->in[15]};
        pg8::gemm_phase(lds, g, S, E, tid);
        if (defer_ffn && bx >= 64) ffn_transposes(p, lds, 1, (bx - 64) * 8 + wave, 192 * 8, wave, lane);
    }
    GRID_SYNC();
    {
        int nst = 2; asm volatile("" : "+s"(nst));
        const int nl = G > 64 ? 32 : 0;
        for (int st = 0; st < nst; ++st) {
            PH_VARS
            const bool lead = bx < nl;
            if (st == 0 || !lead) cs_phaseA(p, lds, tid, st ? CS_LAT : 0, CS_LAT / 2, st ? bx - nl : bx, st ? G - nl : G);
            if (st == 0) { GRID_SYNC(); continue; }
            if (!lead) {
                unsigned* sb = (unsigned*)(kp0->ws + WS_BAR) + XB_SUBBAR;
                __syncthreads();
                if (tid == 0) { __atomic_thread_fence(__ATOMIC_RELEASE); __hip_atomic_fetch_add(sb, 1u, __ATOMIC_RELAXED, __HIP_MEMORY_SCOPE_AGENT);
                    while (__hip_atomic_load(sb, __ATOMIC_RELAXED, __HIP_MEMORY_SCOPE_AGENT) < (unsigned)(G - nl)) __builtin_amdgcn_s_sleep(1);
                    __atomic_thread_fence(__ATOMIC_ACQUIRE); }
                __syncthreads();
            }
            const int tfirst = lead ? bx : (nl ? 32 + (bx - nl) : bx), tend = lead ? 32 : 288, tstride = lead ? 32 : (G - nl);
            for (int t = tfirst; t < tend; t += tstride) cs_phaseB(p, lds, t < 32 ? 1 : 0, t < 32 ? t : t - 32, tid);
        }
    }
    GRID_SYNC();
    { PH_VARS for (int r = gw; r < NTOK; r += NGW) post_row(p, r, lane); }
    GRID_SYNC();
    {
        PH_VARS
        pg8::Gemm g{(const bf16_t*)(ws + WS_MIX), (const bf16_t*)(ws + WS_WTOUT), 512, D, D};
        pg8::SchedSplit2 S; S.o.init(NTOK / 256, 8, G, bx); S.nN = 4; S.ksplit = 512;
        pg8::EpiPart E{(bf16_t*)(ws + WS_PART), 512};
        pg8::gemm_phase(lds, g, S, E, tid);
    }
    GRID_SYNC();
    { PH_VARS for (int r = gw; r < NTOK; r += 2 * NGW) norm_rows<1, 2>(p, r, NGW, lane, p->in[10], 3 * D, 4 * D, 2 * D, (bf16_t*)(ws + WS_H), p->out); }
    GRID_SYNC();
    {
        PH_VARS
        pg8::Gemm g{(const bf16_t*)(ws + WS_H), (const bf16_t*)(ws + WS_WT13), D, D, D};
        pg8::SchedPlain S; S.o.init(NTOK / 256, 2 * DFF / 256, G, bx);
        pg8::EpiFfnAct E{(bf16_t*)(ws + WS_ACT), (float*)(ws + WS_EDGE), p->in[27], lds};
        pg8::gemm_phase(lds, g, S, E, tid);
    }
    GRID_SYNC();
    {
        PH_VARS
        pg8::Gemm g{(const bf16_t*)(ws + WS_ACT), (const bf16_t*)(ws + WS_WT2), DFF / 2, DFF, DFF};
        pg8::SchedSplit2 S; S.o.init(NTOK / 256, 8, G, bx); S.nN = 4; S.ksplit = DFF / 2;
        { for (int i = 0; i < 8; ++i) { int pm_, pn2_; if (!S.o.next2(i, pm_, pn2_)) break; const int ks_ = pn2_ / 4;
              if (pm_ >= 16 && tid < 352) act_fix(p, pm_, tid / 176, ks_ * (DFF / 2) + (tid % 176) * 8); }
          asm volatile("s_waitcnt vmcnt(0)" ::: "memory"); __syncthreads(); }
        pg8::EpiPart E{(bf16_t*)(ws + WS_PART), DFF / 2};
        pg8::gemm_phase(lds, g, S, E, tid);
    }
    GRID_SYNC();
    { PH_VARS for (int r = gw; r < NTOK; r += 4 * NGW) final_rows<4>(p, r, NGW, lane); }
}

extern "C" void kernel_launch(void* const* d_in, const int* in_sizes, int n_in, void* d_out, int out_size, void* d_ws, size_t ws_size, hipStream_t stream) {
    static int grid_blocks = 0;
    if (!grid_blocks) {
        int dev = 0, cus = 0, per_cu = 0;
        (void)hipGetDevice(&dev);
        (void)hipDeviceGetAttribute(&cus, hipDeviceAttributeMultiprocessorCount, dev);
        (void)hipFuncSetAttribute((const void*)fwd_megakernel, hipFuncAttributeMaxDynamicSharedMemorySize, LDS_BYTES);
        (void)hipOccupancyMaxActiveBlocksPerMultiprocessor(&per_cu, (const void*)fwd_megakernel, 512, LDS_BYTES);
        if (per_cu < 1) per_cu = 1;
        grid_blocks = cus * per_cu;
    }
    (void)hipMemsetAsync((char*)d_ws + WS_BAR, 0, 16384, stream);
    Params p{};
    for (int i = 0; i < 30; ++i) p.in[i] = (const float*)d_in[i];
    p.out = (float*)d_out; p.ws = (unsigned char*)d_ws;
    void* args[] = {&p};
    hipError_t e = hipLaunchCooperativeKernel((const void*)fwd_megakernel, dim3(grid_blocks), dim3(512), args, LDS_BYTES, stream);
    if (e != hipSuccess) fprintf(stderr, "cooperative launch failed: %s (grid %d)\n", hipGetErrorString(e), grid_blocks);
}
```
